# Optimizing an MI355X kernel written in HIP

```python
import math
import jax, jax.numpy as jnp
from jax import lax
import numpy as np

D_MODEL = 2048
BATCH = 4
SEQ = 2048
DEPTH = 1

ATTN_HEADS = 8
HEAD_DIM = 128
ATTN_WIDTH = ATTN_HEADS * HEAD_DIM
MOBA_BLOCK = 256
MOBA_TOPK = 3
Q_CHUNK = 32
LRU_WIDTH = 1024
LRU_BLOCKS = 8
LRU_BLOCK_DIM = LRU_WIDTH // LRU_BLOCKS
CONV_WIDTH = 4
LRU_C = 8.0
N_BRANCHES = 2
IN_WIDTH = 3 * ATTN_WIDTH + 2 * LRU_WIDTH + N_BRANCHES * D_MODEL
REL_BUCKETS = 32
REL_MAX_DIST = 128
PEER_HEADS = 8
PEER_NKEYS = 128
PEER_EXPERTS = PEER_NKEYS * PEER_NKEYS
PEER_DKEY = 256
PEER_TOPK = 16
PEER_CHUNK = 128
EPS = 1e-6
NEG = -1e30

kernel_name = 'hybrid_moba_rglru_peer'


def rmsnorm(x, g):
    xf = x.astype(jnp.float32)
    y = xf * lax.rsqrt(jnp.mean(xf * xf, axis=-1, keepdims=True) + EPS)
    return (y * g.astype(jnp.float32)).astype(x.dtype)


def rel_bucket(dist):
    n = jnp.maximum(dist, 0)
    max_exact = REL_BUCKETS // 2
    nf = jnp.maximum(n, 1).astype(jnp.float32)
    large = max_exact + (jnp.log(nf / max_exact) / math.log(REL_MAX_DIST / max_exact)
                         * (REL_BUCKETS - max_exact)).astype(jnp.int32)
    large = jnp.minimum(large, REL_BUCKETS - 1)
    return jnp.where(n < max_exact, n, large)


def moba_attention(q, k, v, rel_bias):
    B, H, S, hd = q.shape
    nb = -(-S // MOBA_BLOCK)
    s_pad = nb * MOBA_BLOCK
    topk = min(MOBA_TOPK, nb)
    pad = ((0, 0), (0, 0), (0, s_pad - S), (0, 0))
    k_pad = jnp.pad(k, pad)
    v_pad = jnp.pad(v, pad)
    k_blocks = k_pad.reshape(B, H, nb, MOBA_BLOCK, hd)
    v_blocks = v_pad.reshape(B, H, nb, MOBA_BLOCK, hd)
    k_mean = jnp.mean(k_blocks.astype(jnp.float32), axis=3)
    bias_h = rel_bias.T.astype(jnp.float32)
    scale = HEAD_DIM ** -0.5
    b_idx = jnp.arange(B)[:, None, None, None]
    h_idx = jnp.arange(H)[None, :, None, None]
    h_idx5 = jnp.arange(H)[None, :, None, None, None]
    blk_ar = jnp.arange(nb)
    slot_ar = jnp.arange(topk)
    in_blk = jnp.arange(MOBA_BLOCK)

    def chunk(start):
        qs = lax.dynamic_slice_in_dim(q, start, Q_CHUNK, axis=2).astype(jnp.float32)
        q_pos = start + jnp.arange(Q_CHUNK)
        own = start // MOBA_BLOCK
        gate = jnp.einsum('bhqd,bhnd->bhqn', qs, k_mean)
        gate = jnp.where(blk_ar < own, gate, NEG)
        _, sel = lax.top_k(gate, topk)
        slot_ok = slot_ar < own
        k_sel = k_blocks[b_idx, h_idx, sel].astype(jnp.float32)
        v_sel = v_blocks[b_idx, h_idx, sel].astype(jnp.float32)
        k_pos_sel = sel[..., None] * MOBA_BLOCK + in_blk
        dist_sel = q_pos[:, None, None] - k_pos_sel
        bias_sel = bias_h[h_idx5, rel_bucket(dist_sel)]
        logit_sel = jnp.einsum('bhqd,bhqjkd->bhqjk', qs, k_sel) * scale + bias_sel
        logit_sel = jnp.where(slot_ok[:, None], logit_sel, NEG)
        k_own = lax.dynamic_slice_in_dim(k_pad, own * MOBA_BLOCK, MOBA_BLOCK, axis=2).astype(jnp.float32)
        v_own = lax.dynamic_slice_in_dim(v_pad, own * MOBA_BLOCK, MOBA_BLOCK, axis=2).astype(jnp.float32)
        dist_own = q_pos[:, None] - (own * MOBA_BLOCK + in_blk)[None, :]
        bias_own = bias_h[:, rel_bucket(dist_own)]
        logit_own = jnp.einsum('bhqd,bhkd->bhqk', qs, k_own) * scale + bias_own
        logit_own = jnp.where(dist_own >= 0, logit_own, NEG)
        logits = jnp.concatenate(
            [logit_sel.reshape(B, H, Q_CHUNK, topk * MOBA_BLOCK), logit_own], axis=-1)
        p = jax.nn.softmax(logits, axis=-1)
        p_sel = p[..., :topk * MOBA_BLOCK].reshape(B, H, Q_CHUNK, topk, MOBA_BLOCK)
        p_own = p[..., topk * MOBA_BLOCK:]
        out = (jnp.einsum('bhqjk,bhqjkd->bhqd', p_sel, v_sel)
               + jnp.einsum('bhqk,bhkd->bhqd', p_own, v_own))
        return out.astype(q.dtype)

    starts = jnp.arange(S // Q_CHUNK, dtype=jnp.int32) * Q_CHUNK
    out = lax.map(chunk, starts)
    return out.transpose(1, 0, 3, 2, 4).reshape(B, S, H * hd)


def causal_conv(x, w, b):
    C = x.shape[-1]
    y = lax.conv_general_dilated(
        x, w[:, None, :].astype(x.dtype), window_strides=(1,),
        padding=[(CONV_WIDTH - 1, 0)], dimension_numbers=('NWC', 'WIO', 'NWC'),
        feature_group_count=C)
    return y + b.astype(x.dtype)


def rg_lru(x, w_a, b_a, w_x, b_x, lam):
    B, S, C = x.shape
    xf = x.astype(jnp.float32)
    xb = xf.reshape(B, S, LRU_BLOCKS, LRU_BLOCK_DIM)
    r = jax.nn.sigmoid(jnp.einsum('bsgi,gij->bsgj', xb, w_a.astype(jnp.float32)).reshape(B, S, C)
                       + b_a.astype(jnp.float32))
    i = jax.nn.sigmoid(jnp.einsum('bsgi,gij->bsgj', xb, w_x.astype(jnp.float32)).reshape(B, S, C)
                       + b_x.astype(jnp.float32))
    log_a = -LRU_C * r * jax.nn.softplus(-lam.astype(jnp.float32))
    a = jnp.exp(log_a)
    u = jnp.sqrt(-jnp.expm1(2.0 * log_a)) * (i * xf)

    def combine(left, right):
        a1, b1 = left
        a2, b2 = right
        return a1 * a2, a2 * b1 + b2

    _, h = lax.associative_scan(combine, (a, u), axis=1)
    return h.astype(x.dtype)


def peer(x, w_q, sub_keys, u_tab, v_tab):
    B, S, D = x.shape
    T = B * S
    K = PEER_TOPK
    xt = x.reshape(T, D)
    q = (xt @ w_q).astype(jnp.float32).reshape(T, PEER_HEADS, 2, PEER_DKEY // 2)
    s = jnp.einsum('thcd,hcnd->thcn', q, sub_keys.astype(jnp.float32))
    sv, si = lax.top_k(s, K)
    cand = sv[:, :, 0, :, None] + sv[:, :, 1, None, :]
    cv, ci = lax.top_k(cand.reshape(T, PEER_HEADS, K * K), K)
    i1 = jnp.take_along_axis(si[:, :, 0], ci // K, axis=-1)
    i2 = jnp.take_along_axis(si[:, :, 1], ci % K, axis=-1)
    idx = (i1 * PEER_NKEYS + i2).reshape(T, PEER_HEADS * K)
    g = jax.nn.softmax(cv, axis=-1).reshape(T, PEER_HEADS * K)
    n_c = T // PEER_CHUNK

    def chunk(args):
        xc, ic, gc = args
        u = u_tab[ic]
        act = jax.nn.gelu(jnp.einsum('td,ted->te', xc, u).astype(jnp.float32)) * gc
        v = v_tab[ic]
        return jnp.einsum('te,ted->td', act.astype(v.dtype), v)

    out = lax.map(chunk, (xt.reshape(n_c, PEER_CHUNK, D),
                          idx.reshape(n_c, PEER_CHUNK, PEER_HEADS * K),
                          g.reshape(n_c, PEER_CHUNK, PEER_HEADS * K)))
    return out.reshape(B, S, D).astype(x.dtype)


def setup_inputs(seed: int = 0) -> dict:
    key = jax.random.key(seed)
    ks = jax.random.split(key, 20)

    def nrm(k, shape, scale):
        return jax.random.normal(k, shape, jnp.float32) * scale

    x = nrm(ks[0], (BATCH, SEQ, D_MODEL), 1.0)
    norm_mix_g = 1.0 + nrm(ks[1], (DEPTH, D_MODEL), 0.02)
    w_in = nrm(ks[2], (DEPTH, D_MODEL, IN_WIDTH), D_MODEL ** -0.5)
    conv_w = nrm(ks[3], (DEPTH, CONV_WIDTH, LRU_WIDTH), CONV_WIDTH ** -0.5)
    conv_b = nrm(ks[4], (DEPTH, LRU_WIDTH), 0.01)
    lru_wa = nrm(ks[5], (DEPTH, LRU_BLOCKS, LRU_BLOCK_DIM, LRU_BLOCK_DIM), LRU_BLOCK_DIM ** -0.5)
    lru_ba = nrm(ks[6], (DEPTH, LRU_WIDTH), 0.01)
    lru_wx = nrm(ks[7], (DEPTH, LRU_BLOCKS, LRU_BLOCK_DIM, LRU_BLOCK_DIM), LRU_BLOCK_DIM ** -0.5)
    lru_bx = nrm(ks[8], (DEPTH, LRU_WIDTH), 0.01)
    a_c = jax.random.uniform(ks[9], (DEPTH, LRU_WIDTH), jnp.float32, 0.9, 0.999)
    p = a_c ** (1.0 / LRU_C)
    lru_lambda = jnp.log(p) - jnp.log1p(-p)
    w_branch = nrm(ks[10], (DEPTH, N_BRANCHES, ATTN_WIDTH, D_MODEL), ATTN_WIDTH ** -0.5)
    w_out = nrm(ks[11], (DEPTH, D_MODEL, D_MODEL), D_MODEL ** -0.5)
    rel_bias = nrm(ks[12], (REL_BUCKETS, ATTN_HEADS), 0.1)
    norm_ffn_g = 1.0 + nrm(ks[13], (DEPTH, D_MODEL), 0.02)
    peer_wq = nrm(ks[14], (DEPTH, D_MODEL, PEER_HEADS * PEER_DKEY), D_MODEL ** -0.5)
    peer_keys = nrm(ks[15], (DEPTH, PEER_HEADS, 2, PEER_NKEYS, PEER_DKEY // 2), (PEER_DKEY // 2) ** -0.5)
    peer_u = nrm(ks[16], (DEPTH, PEER_EXPERTS, D_MODEL), D_MODEL ** -0.5)
    peer_v = nrm(ks[17], (DEPTH, PEER_EXPERTS, D_MODEL), PEER_HEADS ** -0.5)
    norm_final_g = 1.0 + nrm(ks[18], (D_MODEL,), 0.02)
    return {'x': x, 'norm_mix_g': norm_mix_g, 'w_in': w_in, 'conv_w': conv_w, 'conv_b': conv_b,
            'lru_wa': lru_wa, 'lru_ba': lru_ba, 'lru_wx': lru_wx, 'lru_bx': lru_bx,
            'lru_lambda': lru_lambda, 'w_branch': w_branch, 'w_out': w_out, 'rel_bias': rel_bias,
            'norm_ffn_g': norm_ffn_g, 'peer_wq': peer_wq, 'peer_keys': peer_keys,
            'peer_u': peer_u, 'peer_v': peer_v, 'norm_final_g': norm_final_g}


def reference(x, norm_mix_g, w_in, conv_w, conv_b, lru_wa, lru_ba, lru_wx, lru_bx, lru_lambda,
              w_branch, w_out, rel_bias, norm_ffn_g, peer_wq, peer_keys, peer_u, peer_v, norm_final_g):
    B, S, _ = x.shape
    splits = [ATTN_WIDTH, 2 * ATTN_WIDTH, 3 * ATTN_WIDTH,
              3 * ATTN_WIDTH + LRU_WIDTH, 3 * ATTN_WIDTH + 2 * LRU_WIDTH]
    for l in range(DEPTH):
        h = rmsnorm(x, norm_mix_g[l])
        proj = h @ w_in[l]
        q, k, v, xr, yr, gl = jnp.split(proj, splits, axis=-1)
        q = q.reshape(B, S, ATTN_HEADS, HEAD_DIM).transpose(0, 2, 1, 3)
        k = k.reshape(B, S, ATTN_HEADS, HEAD_DIM).transpose(0, 2, 1, 3)
        v = v.reshape(B, S, ATTN_HEADS, HEAD_DIM).transpose(0, 2, 1, 3)
        o_att = moba_attention(q, k, v, rel_bias)
        xr = causal_conv(xr, conv_w[l], conv_b[l])
        o_rec = rg_lru(xr, lru_wa[l], lru_ba[l], lru_wx[l], lru_bx[l], lru_lambda[l]) * jax.nn.gelu(yr)
        branches = jnp.stack([o_att, o_rec], axis=2)
        pb = jnp.einsum('bsnc,ncd->bsnd', branches, w_branch[l])
        gates = jax.nn.sigmoid(gl.astype(jnp.float32)).reshape(B, S, N_BRANCHES, D_MODEL)
        merged = jnp.sum(gates.astype(pb.dtype) * pb, axis=2)
        x = x + merged @ w_out[l]
        x = x + peer(rmsnorm(x, norm_ffn_g[l]), peer_wq[l], peer_keys[l], peer_u[l], peer_v[l])
    return rmsnorm(x, norm_final_g)
```

```cpp
#include <hip/hip_runtime.h>
#include <cstdio>
#include <cstdint>
namespace pg8 {
#define PG8_LAS __attribute__((address_space(3)))
typedef unsigned short bf16_t;
typedef short bf16x8 __attribute__((ext_vector_type(8)));
typedef float f32x4 __attribute__((ext_vector_type(4)));
typedef unsigned u32x4 __attribute__((ext_vector_type(4)));
constexpr int BM = 256, BK = 64, HALF = 128, HTB = HALF * BK * 2  , STAGE_BYTES = 8 * HTB, NXCD = 8, WGM = 8;

__host__ __device__ __forceinline__ int lds_byte(int r, int c) { const int st = (r >> 4) * 2 + (c >> 5), rr = r & 15, cc = c & 31, ob = rr * 64 + cc * 2; return st * 1024 + (ob ^ (((ob >> 9) & 1) << 5)); }
__host__ __device__ __forceinline__ void stage_rc(int b, int& R, int& C) { const int st = b / 1024, sb = b % 1024, swz = sb ^ (((sb >> 9) & 1) << 5); R = (st >> 1) * 16 + swz / 64; C = (st & 1) * 32 + (swz % 64) / 2; }
__host__ __device__ __forceinline__ int perm32(int rho) { const int n = rho >> 4, i = rho & 15; return 8 * (i >> 2) + 4 * n + (i & 3); }

struct Unit { int pm, pn; };
struct Gemm { const bf16_t* A; const bf16_t* Bt; int M, N, K; };

struct StaticOrder {
    int nM, nN, nwg, G, c;
    __host__ __device__ void init(int M, int N, int G_, int c_) { nM = M / BM; nN = N / BM; nwg = nM * nN; G = G_; c = c_; }
    __host__ __device__ bool next(int i, Unit& u) const {
        const long L = (long)i * G + c; if (L >= nwg) return false;
        int wgid = (int)L; { const int q = nwg / NXCD, r = nwg % NXCD, xcd = wgid % NXCD, off = wgid / NXCD; wgid = (xcd < r ? xcd * (q + 1) : r * (q + 1) + (xcd - r) * q) + off; }
        const int nig = WGM * nN, gid = wgid / nig, fm = gid * WGM, gsz = (nM - fm) < WGM ? (nM - fm) : WGM;
        u.pm = fm + ((wgid % nig) % gsz); u.pn = (wgid % nig) / gsz; return true;
    }
    __device__ __forceinline__ void a_ready(const Unit&) const {}
    __device__ __forceinline__ void done(const Unit&) const {}
};

__device__ __forceinline__ unsigned cvt_pk_bf16(float lo, float hi) { unsigned r; asm volatile("v_cvt_pk_bf16_f32 %0, %1, %2" : "=v"(r) : "v"(lo), "v"(hi)); return r; }
typedef float f32x2 __attribute__((ext_vector_type(2)));
__device__ __forceinline__ float sigmoid_f(float v) { return __builtin_amdgcn_rcpf(1.f + __builtin_amdgcn_exp2f(-1.4426950408889634f * v)); }
__device__ __forceinline__ float gelu_tanh_f(float v) { const float z = 1.5957691216057308f * (v + 0.044715f * v * v * v); return v * __builtin_amdgcn_rcpf(1.f + __builtin_amdgcn_exp2f(-1.4426950408889634f * z)); }
__device__ __forceinline__ u32x4 pack8(const f32x4& v0, const f32x4& v1) { u32x4 w; w.x = cvt_pk_bf16(v0[0], v0[1]); w.y = cvt_pk_bf16(v0[2], v0[3]); w.z = cvt_pk_bf16(v1[0], v1[1]); w.w = cvt_pk_bf16(v1[2], v1[3]); return w; }
__device__ __forceinline__ f32x4 bf4_lo(unsigned a, unsigned b) { f32x4 r; r[0] = __builtin_bit_cast(float, a << 16); r[1] = __builtin_bit_cast(float, a & 0xffff0000u); r[2] = __builtin_bit_cast(float, b << 16); r[3] = __builtin_bit_cast(float, b & 0xffff0000u); return r; }

struct EpiProj {
    static constexpr bool PERM = true, AFTER_DRAIN = false;
    bf16_t *Q, *K, *XR, *GY, *SG; float* KM; float qscale;
    __device__ __forceinline__ void operator()(const f32x4 (&acc)[2][2][4][2], const Unit& u, int wr, int wc, int fr, int fq) const {
        const int pn = u.pn; int kind, ldc, colt; bf16_t* base;
        if (pn < 4) { kind = 0; base = Q; ldc = 1024; colt = pn * 256; }
        else if (pn < 8) { kind = 1; base = K; ldc = 1024; colt = (pn - 4) * 256; }
        else if (pn < 12) { kind = 2; base = XR; ldc = 1024; colt = (pn - 8) * 256; }
        else if (pn < 16) { kind = 3; base = GY; ldc = 1024; colt = (pn - 12) * 256; }
        else { kind = 4; base = SG; ldc = 4096; colt = (pn - 16) * 256; }
        const int row0 = u.pm * BM + wr * 64 + fr, col0 = colt + wc * 32 + 8 * fq;
#pragma unroll
        for (int ai = 0; ai < 2; ++ai)
#pragma unroll
            for (int m = 0; m < 4; ++m) { bf16_t* rowp = base + (size_t)(row0 + ai * HALF + m * 16) * ldc + col0;
#pragma unroll
                for (int bj = 0; bj < 2; ++bj) { f32x4 v0 = acc[ai][bj][m][0], v1 = acc[ai][bj][m][1];
                    if (kind == 0) { v0 = v0 * qscale; v1 = v1 * qscale; }
                    else if (kind == 3) {
#pragma unroll
                        for (int e = 0; e < 4; ++e) { v0[e] = gelu_tanh_f(v0[e]); v1[e] = gelu_tanh_f(v1[e]); } }
                    else if (kind == 4) {
#pragma unroll
                        for (int e = 0; e < 4; ++e) { v0[e] = sigmoid_f(v0[e]); v1[e] = sigmoid_f(v1[e]); } }
                    *(u32x4*)(rowp + bj * HALF) = pack8(v0, v1); } }
        if (kind == 1) {
            const int b = u.pm >> 3, blk = u.pm & 7;
#pragma unroll
            for (int bj = 0; bj < 2; ++bj)
#pragma unroll
                for (int n = 0; n < 2; ++n) { f32x4 s = (f32x4){0.f, 0.f, 0.f, 0.f};
#pragma unroll
                    for (int ai = 0; ai < 2; ++ai)
#pragma unroll
                        for (int m = 0; m < 4; ++m) s = s + acc[ai][bj][m][n];
#pragma unroll
                    for (int e = 0; e < 4; ++e) { float v = s[e]; v += __shfl_xor(v, 1); v += __shfl_xor(v, 2); v += __shfl_xor(v, 4); v += __shfl_xor(v, 8); s[e] = v; }
                    if (fr == 0) { const int c = colt + bj * HALF + wc * 32 + 8 * fq + 4 * n;
                        float* dst = KM + ((size_t)((b * 8 + (c >> 7)) * 8 + blk)) * 128 + (c & 127);
#pragma unroll
                        for (int e = 0; e < 4; ++e) atomicAdd(dst + e, s[e]); } }
        }
    }
};
struct EpiStore {
    static constexpr bool PERM = true, AFTER_DRAIN = false;
    bf16_t* O; int ldc;
    __device__ __forceinline__ void operator()(const f32x4 (&acc)[2][2][4][2], const Unit& u, int wr, int wc, int fr, int fq) const {
        const int row0 = u.pm * BM + wr * 64 + fr, col0 = u.pn * BM + wc * 32 + 8 * fq;
#pragma unroll
        for (int ai = 0; ai < 2; ++ai)
#pragma unroll
            for (int m = 0; m < 4; ++m) { bf16_t* rowp = O + (size_t)(row0 + ai * HALF + m * 16) * ldc + col0;
#pragma unroll
                for (int bj = 0; bj < 2; ++bj) *(u32x4*)(rowp + bj * HALF) = pack8(acc[ai][bj][m][0], acc[ai][bj][m][1]); }
    }
};
template <bool FIRST> struct EpiMerge {
    static constexpr bool PERM = true, AFTER_DRAIN = false;
    const bf16_t* SG; float* TMP; bf16_t* MG;
    __device__ __forceinline__ void operator()(const f32x4 (&acc)[2][2][4][2], const Unit& u, int wr, int wc, int fr, int fq) const {
        const int row0 = u.pm * BM + wr * 64 + fr, col0 = u.pn * BM + wc * 32 + 8 * fq;
#pragma unroll
        for (int ai = 0; ai < 2; ++ai)
#pragma unroll
            for (int m = 0; m < 4; ++m) { const size_t row = (size_t)(row0 + ai * HALF + m * 16);
#pragma unroll
                for (int bj = 0; bj < 2; ++bj) { const int col = col0 + bj * HALF;
                    const u32x4 g = *(const u32x4*)(SG + row * 4096 + (FIRST ? 0 : 2048) + col);
                    f32x4 v0 = acc[ai][bj][m][0] * bf4_lo(g.x, g.y), v1 = acc[ai][bj][m][1] * bf4_lo(g.z, g.w);
                    float* tp = TMP + row * 2048 + col;
                    if (FIRST) { *(f32x4*)tp = v0; *(f32x4*)(tp + 4) = v1; }
                    else { v0 = v0 + *(const f32x4*)tp; v1 = v1 + *(const f32x4*)(tp + 4); *(u32x4*)(MG + row * 2048 + col) = pack8(v0, v1); } } }
    }
};
struct EpiResid {
    static constexpr bool PERM = true, AFTER_DRAIN = false;
    const float* X; float* X1; bf16_t* X1B; float* SSP;
    __device__ __forceinline__ void operator()(const f32x4 (&acc)[2][2][4][2], const Unit& u, int wr, int wc, int fr, int fq) const {
        const int row0 = u.pm * BM + wr * 64 + fr, col0 = u.pn * BM + wc * 32 + 8 * fq;
#pragma unroll
        for (int ai = 0; ai < 2; ++ai)
#pragma unroll
            for (int m = 0; m < 4; ++m) { const size_t row = (size_t)(row0 + ai * HALF + m * 16); float ss = 0.f;
#pragma unroll
                for (int bj = 0; bj < 2; ++bj) { const int col = col0 + bj * HALF; const float* xp = X + row * 2048 + col;
                    f32x4 v0 = acc[ai][bj][m][0] + *(const f32x4*)xp, v1 = acc[ai][bj][m][1] + *(const f32x4*)(xp + 4);
                    float* op = X1 + row * 2048 + col; *(f32x4*)op = v0; *(f32x4*)(op + 4) = v1;
                    *(u32x4*)(X1B + row * 2048 + col) = pack8(v0, v1);
                    ss += (v0[0] * v0[0] + v0[1] * v0[1]) + (v0[2] * v0[2] + v0[3] * v0[3]) + (v1[0] * v1[0] + v1[1] * v1[1]) + (v1[2] * v1[2] + v1[3] * v1[3]); }
                ss += __shfl_xor(ss, 16); ss += __shfl_xor(ss, 32);
                if (fq == 0) SSP[row * 32 + u.pn * 4 + wc] = ss; }
    }
};
struct EpiRowScale {
    static constexpr bool PERM = true, AFTER_DRAIN = false;
    const float* SSP; bf16_t* O;
    __device__ __forceinline__ void operator()(const f32x4 (&acc)[2][2][4][2], const Unit& u, int wr, int wc, int fr, int fq) const {
        const int row0 = u.pm * BM + wr * 64 + fr, col0 = u.pn * BM + wc * 32 + 8 * fq;
#pragma unroll
        for (int ai = 0; ai < 2; ++ai)
#pragma unroll
            for (int m = 0; m < 4; ++m) { const size_t row = (size_t)(row0 + ai * HALF + m * 16);
                const f32x4 a = *(const f32x4*)(SSP + row * 32 + 8 * fq), b = *(const f32x4*)(SSP + row * 32 + 8 * fq + 4);
                float ss = (a[0] + a[1]) + (a[2] + a[3]) + (b[0] + b[1]) + (b[2] + b[3]);
                ss += __shfl_xor(ss, 16); ss += __shfl_xor(ss, 32);
                const float rs = __builtin_amdgcn_rsqf(ss * (1.f / 2048.f) + 1e-6f);
#pragma unroll
                for (int bj = 0; bj < 2; ++bj) *(u32x4*)(O + row * 2048 + col0 + bj * HALF) = pack8(acc[ai][bj][m][0] * rs, acc[ai][bj][m][1] * rs); }
    }
};
template <class Epi, class Sched, bool ALIGN_EPI = false, bool SP2 = false>
__device__ __forceinline__ void gemm_phase(PG8_LAS unsigned char* lds, const Gemm g, const Sched& S, const Epi& E) {
    const int tid = threadIdx.x, wid = __builtin_amdgcn_readfirstlane(tid >> 6), lane = tid & 63, wr = wid >> 2, wc = wid & 3, fr = lane & 15, fq = lane >> 4;
    const int K = g.K, nt = K / BK;
    unsigned voffA[2], voffB[2];
#pragma unroll
    for (int i = 0; i < 2; ++i) { int R, C; stage_rc(tid * 16 + i * 8192, R, C); const int Rb = Epi::PERM ? ((R & ~31) + perm32(R & 31)) : R;
        voffA[i] = (unsigned)(R * K + C) * 2u; voffB[i] = (unsigned)(Rb * K + C) * 2u; }
    const size_t kstep = (size_t)(BK * 2);
    const size_t hstep = (size_t)HALF * K * 2;
    const size_t tstep = 2 * hstep;
    const unsigned ldsw = (unsigned)wid * 1024u;
    const int aoff = lds_byte(wr * 64 + fr, fq * 8), boff = lds_byte(wc * 32 + fr, fq * 8);
#define PG8_SA(b, h) (((b) * 2 + (h)) * HTB)
#define PG8_SB(b, h) ((4 + (b) * 2 + (h)) * HTB)
#define PG8_STAGE(bufoff, gbase, voff) do { _Pragma("unroll") for (int _i = 0; _i < 2; ++_i) \
        __builtin_amdgcn_global_load_lds((const unsigned*)((const char*)(gbase) + (voff)[_i]), (PG8_LAS unsigned*)(lds + (bufoff) + ldsw + _i * 8192), 16, 0, 0); } while (0)
#define PG8_LDA(dst, b, h) do { _Pragma("unroll") for (int m = 0; m < 4; ++m) _Pragma("unroll") for (int k = 0; k < 2; ++k) dst[m][k] = *(const PG8_LAS bf16x8*)(lds + PG8_SA(b, h) + aoff + m * 2048 + k * 1024); } while (0)
#define PG8_LDB(dst, b, h) do { _Pragma("unroll") for (int n = 0; n < 2; ++n) _Pragma("unroll") for (int k = 0; k < 2; ++k) dst[n][k] = *(const PG8_LAS bf16x8*)(lds + PG8_SB(b, h) + boff + n * 2048 + k * 1024); } while (0)
#define PG8_MMA(ai, bj, At, Bt) do { __builtin_amdgcn_s_setprio(1); _Pragma("unroll") for (int m = 0; m < 4; ++m) _Pragma("unroll") for (int n = 0; n < 2; ++n) _Pragma("unroll") for (int k = 0; k < 2; ++k) \
        acc[ai][bj][m][n] = __builtin_amdgcn_mfma_f32_16x16x32_bf16(Bt[n][k], At[m][k], acc[ai][bj][m][n], 0, 0, 0); __builtin_amdgcn_s_setprio(0); } while (0)
#define PG8_WAIT_V(n) asm volatile("s_waitcnt vmcnt(" #n ")" ::: "memory")
#define PG8_WAIT_L(n) asm volatile("s_waitcnt lgkmcnt(" #n ")" ::: "memory")
#define PG8_BAR __builtin_amdgcn_s_barrier()
#define PG8_SCHED __builtin_amdgcn_sched_barrier(0)
    Unit cur, nxt; int ui = 0;
    if (!S.next(0, cur)) return;
    f32x4 acc[2][2][4][2];
#pragma unroll
    for (int a = 0; a < 2; ++a)
#pragma unroll
        for (int b = 0; b < 2; ++b)
#pragma unroll
            for (int m = 0; m < 4; ++m)
#pragma unroll
                for (int n = 0; n < 2; ++n) acc[a][b][m][n] = (f32x4){0.f, 0.f, 0.f, 0.f};
    bf16x8 At[4][2], B0[2][2], B1[2][2];
    const char* cA = (const char*)g.A + (size_t)cur.pm * tstep; const char* cB = (const char*)g.Bt + (size_t)cur.pn * tstep;
    S.a_ready(cur);
    if constexpr (SP2) {
        PG8_STAGE(PG8_SB(0, 0), cB, voffB); PG8_STAGE(PG8_SB(0, 1), cB + hstep, voffB); PG8_STAGE(PG8_SA(0, 0), cA, voffA); PG8_STAGE(PG8_SA(0, 1), cA + hstep, voffA);
        if (wr == 1) PG8_BAR;
        PG8_WAIT_V(2); PG8_BAR;
        PG8_STAGE(PG8_SB(1, 0), cB + kstep, voffB); PG8_STAGE(PG8_SA(1, 0), cA + kstep, voffA); PG8_STAGE(PG8_SB(1, 1), cB + hstep + kstep, voffB);
        PG8_WAIT_V(6); PG8_BAR;
    } else {
        PG8_STAGE(PG8_SB(0, 0), cB, voffB); PG8_STAGE(PG8_SA(0, 0), cA, voffA); PG8_STAGE(PG8_SB(0, 1), cB + hstep, voffB); PG8_STAGE(PG8_SA(0, 1), cA + hstep, voffA);
        if (wr == 1) PG8_BAR;
        PG8_WAIT_V(4); PG8_BAR;
        PG8_STAGE(PG8_SB(1, 0), cB + kstep, voffB); PG8_STAGE(PG8_SA(1, 0), cA + kstep, voffA); PG8_STAGE(PG8_SB(1, 1), cB + hstep + kstep, voffB);
        PG8_WAIT_V(6); PG8_BAR;
    }
    for (;;) {
        const bool has_next = S.next(ui + 1, nxt);
        const char* nA = has_next ? (const char*)g.A + (size_t)nxt.pm * tstep : cA; const char* nB = has_next ? (const char*)g.Bt + (size_t)nxt.pn * tstep : cB;
        for (int t = 0; t < nt; t += 2) {
            const bool last = (t == nt - 2);
            const char* a1 = cA + (size_t)(t + 1) * kstep;
            const char* a2 = last ? nA : cA + (size_t)(t + 2) * kstep; const char* b2 = last ? nB : cB + (size_t)(t + 2) * kstep;
            const char* a3 = a2 + kstep; const char* b3 = b2 + kstep;
            if (last && has_next) S.a_ready(nxt);
            if constexpr (SP2) {
            PG8_LDB(B0, 0, 0); PG8_LDB(B1, 0, 1); PG8_SCHED; PG8_LDA(At, 0, 0); PG8_STAGE(PG8_SA(1, 1), a1 + hstep, voffA);
            PG8_WAIT_V(8); PG8_WAIT_L(0); PG8_BAR; PG8_MMA(0, 0, At, B0); PG8_MMA(0, 1, At, B1); PG8_BAR; PG8_SCHED;
            PG8_LDA(At, 0, 1); PG8_STAGE(PG8_SB(0, 0), b2, voffB); PG8_STAGE(PG8_SB(0, 1), b2 + hstep, voffB); PG8_STAGE(PG8_SA(0, 0), a2, voffA);
            PG8_WAIT_V(8); PG8_WAIT_L(0); PG8_BAR; PG8_MMA(1, 0, At, B0); PG8_MMA(1, 1, At, B1); PG8_BAR; PG8_SCHED;
            PG8_LDB(B0, 1, 0); PG8_LDB(B1, 1, 1); PG8_SCHED; PG8_LDA(At, 1, 0); PG8_STAGE(PG8_SA(0, 1), a2 + hstep, voffA);
            PG8_WAIT_V(8); PG8_WAIT_L(0); PG8_BAR; PG8_MMA(0, 0, At, B0); PG8_MMA(0, 1, At, B1); PG8_BAR; PG8_SCHED;
            PG8_LDA(At, 1, 1); PG8_STAGE(PG8_SB(1, 0), b3, voffB); PG8_STAGE(PG8_SB(1, 1), b3 + hstep, voffB); PG8_STAGE(PG8_SA(1, 0), a3, voffA);
            PG8_WAIT_V(8); PG8_WAIT_L(0); PG8_BAR; PG8_MMA(1, 0, At, B0); PG8_MMA(1, 1, At, B1); PG8_BAR; PG8_SCHED;
            } else {
            PG8_LDB(B0, 0, 0); PG8_SCHED; PG8_LDA(At, 0, 0); PG8_STAGE(PG8_SA(1, 1), a1 + hstep, voffA);
            PG8_WAIT_L(8); PG8_BAR; PG8_WAIT_L(0); PG8_MMA(0, 0, At, B0); PG8_BAR; PG8_SCHED;
            PG8_LDB(B1, 0, 1); PG8_STAGE(PG8_SB(0, 0), b2, voffB);
            PG8_BAR; PG8_WAIT_L(0); PG8_MMA(0, 1, At, B1); PG8_BAR;
            PG8_LDA(At, 0, 1); PG8_STAGE(PG8_SA(0, 0), a2, voffA);
            PG8_BAR; PG8_WAIT_L(0); PG8_MMA(1, 0, At, B0); PG8_BAR; PG8_SCHED;
            PG8_STAGE(PG8_SB(0, 1), b2 + hstep, voffB);
            PG8_WAIT_V(6); PG8_BAR; PG8_MMA(1, 1, At, B1); PG8_BAR;
            PG8_LDB(B0, 1, 0); PG8_SCHED; PG8_LDA(At, 1, 0); PG8_STAGE(PG8_SA(0, 1), a2 + hstep, voffA);
            PG8_WAIT_L(8); PG8_BAR; PG8_WAIT_L(0); PG8_MMA(0, 0, At, B0); PG8_BAR; PG8_SCHED;
            PG8_LDB(B1, 1, 1); PG8_STAGE(PG8_SB(1, 0), b3, voffB);
            PG8_BAR; PG8_WAIT_L(0); PG8_MMA(0, 1, At, B1); PG8_BAR;
            PG8_LDA(At, 1, 1); PG8_STAGE(PG8_SA(1, 0), a3, voffA);
            PG8_BAR; PG8_WAIT_L(0); PG8_MMA(1, 0, At, B0); PG8_BAR; PG8_SCHED;
            PG8_STAGE(PG8_SB(1, 1), b3 + hstep, voffB);
            PG8_WAIT_V(6); PG8_BAR; PG8_MMA(1, 1, At, B1); PG8_BAR;
            }
        }
        if constexpr (ALIGN_EPI) { if (wr == 0) PG8_BAR; }
        if constexpr (!Epi::AFTER_DRAIN) { E(acc, cur, wr, wc, fr, fq); S.done(cur); }
        if (!has_next) break;
#pragma unroll
        for (int a = 0; a < 2; ++a)
#pragma unroll
            for (int b = 0; b < 2; ++b)
#pragma unroll
                for (int m = 0; m < 4; ++m)
#pragma unroll
                    for (int n = 0; n < 2; ++n) acc[a][b][m][n] = (f32x4){0.f, 0.f, 0.f, 0.f};
        cur = nxt; cA = nA; cB = nB; ++ui;
        if constexpr (ALIGN_EPI) { if (wr == 1) PG8_BAR; }
    }
    PG8_WAIT_V(0);
    if constexpr (!ALIGN_EPI) { if (wr == 0) PG8_BAR; }
    PG8_BAR;
    if constexpr (Epi::AFTER_DRAIN) { E.fused(acc, cur, wr, wc, fr, fq, lds, wid, lane); S.done(cur); }
#undef PG8_SA
#undef PG8_SB
#undef PG8_STAGE
#undef PG8_LDA
#undef PG8_LDB
#undef PG8_MMA
#undef PG8_WAIT_V
#undef PG8_WAIT_L
#undef PG8_BAR
#undef PG8_SCHED
}
}
#define GAS __attribute__((address_space(1)))
#define LAS __attribute__((address_space(3)))
typedef unsigned short bf16;
typedef unsigned v4u __attribute__((ext_vector_type(4)));
typedef float f32x4 __attribute__((ext_vector_type(4)));
typedef short bf16x8 __attribute__((ext_vector_type(8)));
typedef GAS unsigned gu32;
typedef GAS unsigned long long gu64;
#define RLX_AGENT __ATOMIC_RELAXED, __HIP_MEMORY_SCOPE_AGENT
#define LDS_WAIT() asm volatile("s_waitcnt lgkmcnt(0)" ::: "memory")
#define VM_WAIT() asm volatile("s_waitcnt vmcnt(0)" ::: "memory")
__device__ __forceinline__ unsigned long long rt() { return __builtin_amdgcn_s_memrealtime(); }
__device__ __forceinline__ unsigned f2bf(float f) { unsigned u = __builtin_bit_cast(unsigned, f); return (u + 0x7fffu + ((u >> 16) & 1u)) >> 16; }
__device__ __forceinline__ unsigned pk2(float lo, float hi) { return f2bf(lo) | (f2bf(hi) << 16); }

#define XB_TMO      128
#define XB_XCNT(j)  (256  + 64 * (j))
#define XB_XSUB(j)  (1280 + 64 * (j))
#define XB_XGEN(j)  (2304 + 64 * (j))
#define XB_TOP      3328
#define XB_TOPGEN   3392
#define XCD_BAR_WORDS 3456
#define XB_SPIN_CAP (1u << 18)

__device__ __forceinline__ unsigned xb_ld(unsigned* p)              { return __hip_atomic_load(p, __ATOMIC_RELAXED, __HIP_MEMORY_SCOPE_AGENT); }
__device__ __forceinline__ unsigned xb_add(unsigned* p, unsigned v) { return __hip_atomic_fetch_add(p, v, __ATOMIC_RELAXED, __HIP_MEMORY_SCOPE_AGENT); }
__device__ __forceinline__ unsigned xb_xcc_id() { return (unsigned)__builtin_amdgcn_s_getreg((3 << 11) | 20) & 0xFu; }
#define XB_SPIN(cond, bar) do { unsigned _sp = 0; while (cond) { __builtin_amdgcn_s_sleep(1); \
    if ((++_sp & 255u) == 0u) { if (xb_ld(&(bar)[XB_TMO])) break; if (_sp > XB_SPIN_CAP) { atomicAdd(&(bar)[XB_TMO], 1u); break; } } } } while (0)

struct XcdBarrier {
    unsigned* bar; unsigned x;
    volatile LAS unsigned* st;
};

__device__ __forceinline__ XcdBarrier xcd_barrier_post(unsigned* bar, volatile LAS unsigned* st) {
    XcdBarrier b; b.bar = bar; b.x = xb_xcc_id(); b.st = st;
    if (threadIdx.x == 0) (void)xb_add(&bar[XB_XCNT(b.x)], 1u);
    return b;
}
__device__ __forceinline__ void xcd_barrier_complete(unsigned* bar, unsigned x, unsigned& nloc, unsigned& nx) {
    const unsigned G = gridDim.x * gridDim.y * gridDim.z;
    unsigned sum, cnt, mine, sp = 0u;
    for (;;) {
        sum = 0u; cnt = 0u; mine = 0u;
#pragma unroll
        for (unsigned j = 0; j < 16; ++j) { const unsigned c = xb_ld(&bar[XB_XCNT(j)]); sum += c; cnt += (c > 0u) ? 1u : 0u; mine = (j == x) ? c : mine; }
        if (sum == G) break;
        __builtin_amdgcn_s_sleep(1);
        if ((++sp & 255u) == 0u) { if (xb_ld(&bar[XB_TMO])) break; if (sp > XB_SPIN_CAP) { atomicAdd(&bar[XB_TMO], 1u); break; } }
    }
    nloc = mine > 0u ? mine : 1u; nx = cnt > 0u ? cnt : 1u;
}

__device__ __forceinline__ void xcd_barrier(const XcdBarrier& b) {
    asm volatile("s_waitcnt vmcnt(0)" ::: "memory");
    __syncthreads();
    if (threadIdx.x == 0) {
        unsigned* bar = b.bar;
        __builtin_amdgcn_s_waitcnt(0);
        unsigned nloc = b.st[0], nx = b.st[1];
        if (nloc == 0u) { xcd_barrier_complete(bar, b.x, nloc, nx); b.st[0] = nloc; b.st[1] = nx; }
        const unsigned old = xb_add(&bar[XB_XSUB(b.x)], 1u);
        const unsigned gen = old / nloc;
        if (old + 1u == (gen + 1u) * nloc) {
            __builtin_amdgcn_fence(__ATOMIC_RELEASE, "agent");
            asm volatile("s_waitcnt vmcnt(0)" ::: "memory");
            const unsigned og = xb_add(&bar[XB_TOP], 1u);
            const unsigned tg = og / nx;
            if (og + 1u == (tg + 1u) * nx) xb_add(&bar[XB_TOPGEN], 1u);
            else XB_SPIN(xb_ld(&bar[XB_TOPGEN]) == tg, bar);
            __builtin_amdgcn_fence(__ATOMIC_ACQUIRE, "agent");
            xb_add(&bar[XB_XGEN(b.x)], 1u);
            asm volatile("s_waitcnt vmcnt(0)" ::: "memory");
        } else {
            XB_SPIN(xb_ld(&bar[XB_XGEN(b.x)]) == gen, bar);
            __builtin_amdgcn_fence(__ATOMIC_ACQUIRE, "agent");
            asm volatile("s_waitcnt vmcnt(0)" ::: "memory");
        }
    }
    __syncthreads();
}

constexpr int NWAVES = 8;
constexpr int T_TOK = 8192, DM = 2048, AW = 1024, SEQ = 2048, NHEAD = 8;
constexpr int NWA = 8192;
constexpr int NEXP = 16384;
constexpr float RMS_EPS = 1e-6f, LOG2E = 1.4426950408889634f;
constexpr float QSCALE = 0.08838834764831845f * 1.4426950408889634f;

constexpr size_t MiB = 1u << 20;
constexpr size_t WS_CTL = 0, CTL_ZERO_BYTES = 1 * MiB;
constexpr size_t WS_WA = 2 * MiB;
constexpr size_t WS_WV = 34 * MiB;
constexpr size_t WS_WB = 38 * MiB;
constexpr size_t WS_WO = 46 * MiB;
constexpr size_t WS_WQ = 54 * MiB;
constexpr size_t WS_LWA = 62 * MiB;
constexpr size_t WS_LWX = 62 * MiB + 256 * 1024;
constexpr size_t WS_KEYS = 62 * MiB + 512 * 1024;
constexpr size_t WS_UB = 64 * MiB;
constexpr size_t WS_VB = 128 * MiB;
constexpr size_t WS_HN = 192 * MiB;
constexpr size_t WS_X1B = WS_HN;
constexpr size_t WS_Q = 224 * MiB;
constexpr size_t WS_K = 240 * MiB;
constexpr size_t WS_VT = 256 * MiB;
constexpr size_t WS_XR = 272 * MiB;
constexpr size_t WS_GY = 288 * MiB;
constexpr size_t WS_SG = 304 * MiB;
constexpr size_t WS_QP = WS_SG;
constexpr size_t WS_OATT = 368 * MiB;
constexpr size_t WS_OREC = 384 * MiB;
constexpr size_t WS_HL = 400 * MiB;
constexpr size_t WS_AC = 432 * MiB;
constexpr size_t WS_TMP = WS_HL;
constexpr size_t WS_SUM = 464 * MiB;
constexpr size_t WS_MG = 466 * MiB;
constexpr size_t WS_SSP = 498 * MiB;
constexpr size_t WS_IDX = 500 * MiB;
constexpr size_t WS_G = 504 * MiB;
constexpr size_t WS_END = 508 * MiB;
constexpr int CW_BAR = 4096;
constexpr int CW_Q2 = 8192;
constexpr int CW_KM = 65536;
static_assert((CW_KM + 32768) * 4 <= (int)CTL_ZERO_BYTES, "CTL");

constexpr int LDS_BYTES = 163840;
constexpr int MISC_OFF = 163840 - 256;
constexpr int SCR_BYTES = MISC_OFF;

typedef float f32x16 __attribute__((ext_vector_type(16)));
typedef float f32x2_t __attribute__((ext_vector_type(2)));
typedef __bf16 bf16x2_t __attribute__((ext_vector_type(2)));
typedef unsigned long long u64;
__device__ __forceinline__ unsigned cvtpk(float lo, float hi) { f32x2_t v = {lo, hi}; bf16x2_t b = __builtin_convertvector(v, bf16x2_t); return __builtin_bit_cast(unsigned, b); }
__device__ __forceinline__ float bf_lo(unsigned w) { return __builtin_bit_cast(float, w << 16); }
__device__ __forceinline__ float bf_hi(unsigned w) { return __builtin_bit_cast(float, w & 0xffff0000u); }
__device__ __forceinline__ float wave_sum(float v) {
#pragma unroll
    for (int o = 1; o < 64; o <<= 1) v += __shfl_xor(v, o);
    return v;
}
__device__ __forceinline__ float dot2bf(unsigned a, unsigned b, float acc) { return __builtin_amdgcn_fdot2_f32_bf16(__builtin_bit_cast(bf16x2_t, a), __builtin_bit_cast(bf16x2_t, b), acc, false); }

struct Params {
    const float *x, *g_mix, *w_in, *conv_w, *conv_b, *lru_wa, *lru_ba, *lru_wx, *lru_bx, *lru_lam, *w_branch, *w_out, *rel_bias, *g_ffn, *peer_wq, *peer_keys, *peer_u, *peer_v, *g_fin;
    float* out; unsigned char* ws; int ph_lo, ph_hi;
};

__device__ __forceinline__ void tr_item(const float* W, int K, int N, bf16* dst_row0, int k0, int n0, const float* kscale, LAS float* scr, int lane) {
#pragma unroll 8
    for (int i = 0; i < 32; ++i) { const int kk = 2 * i + (lane >> 5); float v = W[(size_t)(k0 + kk) * N + n0 + (lane & 31)]; if (kscale) v *= kscale[k0 + kk]; scr[kk * 33 + (lane & 31)] = v; }
    LDS_WAIT(); asm volatile("" ::: "memory");
    const int c = lane & 7;
#pragma unroll
    for (int j = 0; j < 4; ++j) { const int n = (lane >> 3) + 8 * j; const LAS float* s = scr + (8 * c) * 33 + n;
        v4u o; o.x = cvtpk(s[0 * 33], s[1 * 33]); o.y = cvtpk(s[2 * 33], s[3 * 33]); o.z = cvtpk(s[4 * 33], s[5 * 33]); o.w = cvtpk(s[6 * 33], s[7 * 33]);
        *(v4u*)(dst_row0 + (size_t)n * K + k0 + 8 * c) = o; }
    LDS_WAIT(); asm volatile("" ::: "memory");
}
template <int MODE> __device__ __forceinline__ void row_to_bf16(const float* src, bf16* dst, const float* colscale, int lane) {
    const f32x4* s = (const f32x4*)src + lane;
    f32x4 v[8]; float ss = 0.f;
#pragma unroll
    for (int j = 0; j < 8; ++j) { v[j] = s[64 * j]; ss += (v[j][0] * v[j][0] + v[j][1] * v[j][1]) + (v[j][2] * v[j][2] + v[j][3] * v[j][3]); }
    float rs = 1.f;
    if (MODE == 1) rs = __builtin_amdgcn_rsqf(wave_sum(ss) * (1.f / 2048.f) + RMS_EPS);
    u64* o8 = (u64*)dst + lane;
#pragma unroll
    for (int j = 0; j < 8; ++j) { f32x4 w = v[j] * rs; if (colscale) w = w * ((const f32x4*)colscale)[64 * j + lane];
        o8[64 * j] = (u64)cvtpk(w[0], w[1]) | ((u64)cvtpk(w[2], w[3]) << 32); }
}
__device__ __forceinline__ void p0_prologue(const Params& P, LAS unsigned char* lds, int gw, int NGW, int wave, int lane) {
    LAS float* scr = (LAS float*)(lds + wave * 16384);
    unsigned char* ws = P.ws;
    bf16* WA = (bf16*)(ws + WS_WA); bf16* WV = (bf16*)(ws + WS_WV); bf16* WB = (bf16*)(ws + WS_WB); bf16* WO = (bf16*)(ws + WS_WO); bf16* WQ = (bf16*)(ws + WS_WQ);
    bf16* LWA = (bf16*)(ws + WS_LWA); bf16* LWX = (bf16*)(ws + WS_LWX);
    constexpr int I_IN = 32 * 288, I_BR = 16 * 64, I_SQ = 32 * 64, I_L = 8 * 8;
    constexpr int NITEMS = I_IN + 2 * I_BR + 2 * I_SQ + 2 * I_L;
    for (int it = gw; it < NITEMS; it += NGW) {
        int r = it;
        if (r < I_IN) { const int kb = r / 288, nb = r % 288, n0 = 32 * nb;
            bf16* d = (n0 < 2048) ? WA + (size_t)n0 * 2048 : (n0 < 3072 ? WV + (size_t)(n0 - 2048) * 2048 : WA + (size_t)(n0 - 1024) * 2048);
            tr_item(P.w_in, 2048, 9216, d, 64 * kb, n0, nullptr, scr, lane); continue; } r -= I_IN;
        if (r < 2 * I_BR) { const int br = r / I_BR, q = r % I_BR, kb = q / 64, nb = q % 64;
            tr_item(P.w_branch + (size_t)br * 1024 * 2048, 1024, 2048, WB + (size_t)br * 2048 * 1024 + (size_t)(32 * nb) * 1024, 64 * kb, 32 * nb, nullptr, scr, lane); continue; } r -= 2 * I_BR;
        if (r < I_SQ) { const int kb = r / 64, nb = r % 64; tr_item(P.w_out, 2048, 2048, WO + (size_t)(32 * nb) * 2048, 64 * kb, 32 * nb, nullptr, scr, lane); continue; } r -= I_SQ;
        if (r < I_SQ) { const int kb = r / 64, nb = r % 64; tr_item(P.peer_wq, 2048, 2048, WQ + (size_t)(32 * nb) * 2048, 64 * kb, 32 * nb, P.g_ffn, scr, lane); continue; } r -= I_SQ;
        { const int which = r / I_L, q = r % I_L, g = q / 8, kb = (q % 8) / 4, nb = q % 4;
          tr_item((which ? P.lru_wx : P.lru_wa) + (size_t)g * 16384, 128, 128, (which ? LWX : LWA) + (size_t)g * 16384 + (size_t)(32 * nb) * 128, 64 * kb, 32 * nb, nullptr, scr, lane); }
    }
    { bf16* KB = (bf16*)(ws + WS_KEYS);
      for (int i = gw * 64 + lane; i < 262144 / 8; i += NGW * 64) { const f32x4 a = ((const f32x4*)P.peer_keys)[2 * i], b = ((const f32x4*)P.peer_keys)[2 * i + 1];
          v4u o; o.x = cvtpk(a[0], a[1]); o.y = cvtpk(a[2], a[3]); o.z = cvtpk(b[0], b[1]); o.w = cvtpk(b[2], b[3]); ((v4u*)KB)[i] = o; } }
    { bf16* HN = (bf16*)(ws + WS_HN);
      for (int m = gw; m < T_TOK; m += NGW) row_to_bf16<1>(P.x + (size_t)m * DM, HN + (size_t)m * DM, P.g_mix, lane); }
    { bf16* UB = (bf16*)(ws + WS_UB); bf16* VB = (bf16*)(ws + WS_VB);
      for (int m = gw; m < NEXP; m += NGW) row_to_bf16<0>(P.peer_u + (size_t)m * DM, UB + (size_t)m * DM, P.g_ffn, lane);
      for (int m = gw; m < NEXP; m += NGW) row_to_bf16<0>(P.peer_v + (size_t)m * DM, VB + (size_t)m * DM, nullptr, lane); }
}

constexpr int AT_KT = 0, AT_VT = 17408, AT_KM = 35840, AT_B2 = AT_KM + 4096, AT_SEL = AT_B2 + 512, AT_ANY = AT_SEL + 1024;
#define MFMA32(a, b, c) __builtin_amdgcn_mfma_f32_32x32x16_bf16((a), (b), (c), 0, 0, 0)
__device__ __forceinline__ void attn_unit(const Params& P, LAS unsigned char* lds, int b, int h, int blk, int tid, int wave, int lane) {
    unsigned char* ws = P.ws;
    const bf16* Qb = (const bf16*)(ws + WS_Q); const bf16* Kb = (const bf16*)(ws + WS_K); const bf16* VTg = (const bf16*)(ws + WS_VT); bf16* OATT = (bf16*)(ws + WS_OATT);
    const float* KMg = (const float*)(ws + WS_CTL) + CW_KM;
    LAS unsigned char* KT = lds + AT_KT; LAS unsigned char* VTl = lds + AT_VT;
    LAS float* KMs = (LAS float*)(lds + AT_KM); LAS float* B2 = (LAS float*)(lds + AT_B2); LAS unsigned* SELM = (LAS unsigned*)(lds + AT_SEL); LAS unsigned* UANY = (LAS unsigned*)(lds + AT_ANY);
    const int row_blk0 = b * SEQ + blk * 256;
    __syncthreads();
    for (int i = tid; i < 1024; i += 512) KMs[i] = KMg[(size_t)(b * 8 + h) * 1024 + i] * (1.f / 256.f);
    if (tid < 128) { const int d = tid; int bucket = d;
        if (d >= 16) { bucket = 16 + (int)(__logf((float)d * (1.f / 16.f)) * (16.f / 2.0794415416798357f)); bucket = bucket > 31 ? 31 : bucket; }
        B2[d] = P.rel_bias[bucket * 8 + h] * LOG2E; }
    if (tid == 0) *UANY = 0u;
    __syncthreads();
    if (tid < 256) {
        unsigned mask;
        if (blk <= 3) mask = (1u << blk) - 1u;
        else {
            const bf16* qrow = Qb + (size_t)(row_blk0 + tid) * AW + h * 128;
            float g0 = 0.f, g1 = 0.f, g2 = 0.f, g3 = 0.f, g4 = 0.f, g5 = 0.f, g6 = 0.f;
            for (int d8 = 0; d8 < 16; ++d8) { const v4u qv = *(const v4u*)(qrow + d8 * 8);
                float q[8] = {bf_lo(qv.x), bf_hi(qv.x), bf_lo(qv.y), bf_hi(qv.y), bf_lo(qv.z), bf_hi(qv.z), bf_lo(qv.w), bf_hi(qv.w)};
#pragma unroll
                for (int e = 0; e < 8; ++e) { const LAS float* km = KMs + d8 * 8 + e;
                    g0 += q[e] * km[0]; g1 += q[e] * km[128]; g2 += q[e] * km[256]; g3 += q[e] * km[384]; g4 += q[e] * km[512]; g5 += q[e] * km[640]; g6 += q[e] * km[768]; } }
            const float NEGG = -3.0e38f;
            if (blk < 7) g6 = NEGG; if (blk < 6) g5 = NEGG; if (blk < 5) g4 = NEGG;
            mask = 0u;
#pragma unroll
            for (int s = 0; s < 3; ++s) { float best = g0; int bj = 0;
                if (g1 > best) { best = g1; bj = 1; } if (g2 > best) { best = g2; bj = 2; } if (g3 > best) { best = g3; bj = 3; }
                if (g4 > best) { best = g4; bj = 4; } if (g5 > best) { best = g5; bj = 5; } if (g6 > best) { best = g6; bj = 6; }
                mask |= 1u << bj;
                g0 = bj == 0 ? NEGG : g0; g1 = bj == 1 ? NEGG : g1; g2 = bj == 2 ? NEGG : g2; g3 = bj == 3 ? NEGG : g3; g4 = bj == 4 ? NEGG : g4; g5 = bj == 5 ? NEGG : g5; g6 = bj == 6 ? NEGG : g6; }
        }
        SELM[tid] = mask; __hip_atomic_fetch_or(UANY, mask, __ATOMIC_RELAXED, __HIP_MEMORY_SCOPE_WORKGROUP);
    }
    __syncthreads();
    const unsigned uany = *UANY;
    unsigned blist = (unsigned)blk; int nb = 1;
    for (int j = blk - 1; j >= 0; --j) if ((uany >> j) & 1u) { blist |= (unsigned)j << (4 * nb); ++nb; }
    const int nsteps = 4 * nb;
    const int qi = 32 * wave + (lane & 31), hh = lane >> 5;
    const unsigned mymask = SELM[qi];
    bf16x8 Qf[8];
    { const bf16* qp = Qb + (size_t)(row_blk0 + qi) * AW + h * 128 + 8 * hh;
#pragma unroll
      for (int ks = 0; ks < 8; ++ks) Qf[ks] = *(const bf16x8*)(qp + 16 * ks); }
    float m_run = -1.0e30f, lsum = 0.f;
    f32x16 O[4];
#pragma unroll
    for (int dt = 0; dt < 4; ++dt)
#pragma unroll
        for (int r = 0; r < 16; ++r) O[dt][r] = 0.f;
    const int kkey0 = tid >> 4, kpart = tid & 15;
    const int vd0 = tid >> 3, vcc = tid & 7;
    const unsigned kl0 = kkey0 * 272 + kpart * 16, kl1 = kl0 + 32 * 272;
    const unsigned vl0 = vd0 * 144 + ((((vcc >> 2) * 2 + ((vcc & 3) >> 1)) * 2) * 16) + (vcc & 1) * 8, vl1 = vl0 + 64 * 144;
    v4u kr0, kr1, vr0, vr1;
    { const int j = blist & 15; const size_t krow0 = (size_t)b * SEQ + j * 256;
      kr0 = *(const v4u*)(Kb + (krow0 + kkey0) * AW + h * 128 + kpart * 8); kr1 = *(const v4u*)(Kb + (krow0 + kkey0 + 32) * AW + h * 128 + kpart * 8);
      vr0 = *(const v4u*)(VTg + (size_t)(h * 128 + vd0) * T_TOK + krow0 + vcc * 8); vr1 = *(const v4u*)(VTg + (size_t)(h * 128 + vd0 + 64) * T_TOK + krow0 + vcc * 8); }
    for (int s = 0; s < nsteps; ++s) {
        const int j = (blist >> (4 * (s >> 2))) & 15, kt = s & 3;
        __syncthreads();
        *(LAS v4u*)(KT + kl0) = kr0; *(LAS v4u*)(KT + kl1) = kr1;
        *(LAS u64*)(VTl + vl0) = (u64)vr0.x | ((u64)vr0.y << 32); *(LAS u64*)(VTl + vl0 + 16) = (u64)vr0.z | ((u64)vr0.w << 32);
        *(LAS u64*)(VTl + vl1) = (u64)vr1.x | ((u64)vr1.y << 32); *(LAS u64*)(VTl + vl1 + 16) = (u64)vr1.z | ((u64)vr1.w << 32);
        __syncthreads();
        if (s + 1 < nsteps) { const int j2 = (blist >> (4 * ((s + 1) >> 2))) & 15, kt2 = (s + 1) & 3; const size_t krow0 = (size_t)b * SEQ + j2 * 256 + kt2 * 64;
            kr0 = *(const v4u*)(Kb + (krow0 + kkey0) * AW + h * 128 + kpart * 8); kr1 = *(const v4u*)(Kb + (krow0 + kkey0 + 32) * AW + h * 128 + kpart * 8);
            vr0 = *(const v4u*)(VTg + (size_t)(h * 128 + vd0) * T_TOK + krow0 + vcc * 8); vr1 = *(const v4u*)(VTg + (size_t)(h * 128 + vd0 + 64) * T_TOK + krow0 + vcc * 8); }
        bool part;
        if (j == blk) part = (64 * kt <= 32 * wave + 31);
        else part = (__ballot((mymask >> j) & 1u) != 0ull);
        if (part) {
            f32x16 S0, S1;
#pragma unroll
            for (int r = 0; r < 16; ++r) { S0[r] = 0.f; S1[r] = 0.f; }
            const LAS unsigned char* kp = KT + (lane & 31) * 272 + hh * 16;
#pragma unroll
            for (int ks = 0; ks < 8; ++ks) { const bf16x8 a0 = *(const LAS bf16x8*)(kp + ks * 32), a1 = *(const LAS bf16x8*)(kp + 32 * 272 + ks * 32);
                S0 = MFMA32(a0, Qf[ks], S0); S1 = MFMA32(a1, Qf[ks], S1); }
            const bool sel = ((mymask >> j) & 1u) != 0u;
            float mx = -1.0e30f;
            if (j >= blk - 1) {
                const int dbase = (j == blk) ? (qi - 64 * kt - 4 * hh) : (qi + 256 - 64 * kt - 4 * hh);
                const bool okrow = (j == blk) ? true : sel;
#pragma unroll
                for (int r = 0; r < 16; ++r) { const int kk = (r & 3) + 8 * (r >> 2);
                    { const int dist = dbase - kk; const int di = dist < 0 ? 0 : (dist > 127 ? 127 : dist); const float v = (okrow && dist >= 0) ? S0[r] + B2[di] : -1.0e30f; S0[r] = v; mx = fmaxf(mx, v); }
                    { const int dist = dbase - 32 - kk; const int di = dist < 0 ? 0 : (dist > 127 ? 127 : dist); const float v = (okrow && dist >= 0) ? S1[r] + B2[di] : -1.0e30f; S1[r] = v; mx = fmaxf(mx, v); } }
            } else {
                const float bc = B2[127];
#pragma unroll
                for (int r = 0; r < 16; ++r) { const float v0 = sel ? S0[r] + bc : -1.0e30f, v1 = sel ? S1[r] + bc : -1.0e30f; S0[r] = v0; S1[r] = v1; mx = fmaxf(mx, fmaxf(v0, v1)); }
            }
            mx = fmaxf(mx, __shfl_xor(mx, 32));
            const float m_new = fmaxf(m_run, mx), alpha = __builtin_amdgcn_exp2f(m_run - m_new);
            m_run = m_new;
            float ps = 0.f;
#pragma unroll
            for (int r = 0; r < 16; ++r) { S0[r] = __builtin_amdgcn_exp2f(S0[r] - m_new); S1[r] = __builtin_amdgcn_exp2f(S1[r] - m_new); ps += S0[r] + S1[r]; }
            lsum = lsum * alpha + ps;
#pragma unroll
            for (int dt = 0; dt < 4; ++dt)
#pragma unroll
                for (int r = 0; r < 16; ++r) O[dt][r] *= alpha;
            bf16x8 Pf[2][2];
#pragma unroll
            for (int s2 = 0; s2 < 2; ++s2) {
                v4u p0, p1;
                p0.x = cvtpk(S0[8 * s2], S0[8 * s2 + 1]); p0.y = cvtpk(S0[8 * s2 + 2], S0[8 * s2 + 3]); p0.z = cvtpk(S0[8 * s2 + 4], S0[8 * s2 + 5]); p0.w = cvtpk(S0[8 * s2 + 6], S0[8 * s2 + 7]);
                p1.x = cvtpk(S1[8 * s2], S1[8 * s2 + 1]); p1.y = cvtpk(S1[8 * s2 + 2], S1[8 * s2 + 3]); p1.z = cvtpk(S1[8 * s2 + 4], S1[8 * s2 + 5]); p1.w = cvtpk(S1[8 * s2 + 6], S1[8 * s2 + 7]);
                Pf[0][s2] = __builtin_bit_cast(bf16x8, p0); Pf[1][s2] = __builtin_bit_cast(bf16x8, p1); }
            const LAS unsigned char* vp = VTl + (lane & 31) * 144 + hh * 16;
#pragma unroll
            for (int dt = 0; dt < 4; ++dt)
#pragma unroll
                for (int mt = 0; mt < 2; ++mt)
#pragma unroll
                    for (int s2 = 0; s2 < 2; ++s2) { const bf16x8 a = *(const LAS bf16x8*)(vp + dt * 32 * 144 + (mt * 2 + s2) * 32); O[dt] = MFMA32(a, Pf[mt][s2], O[dt]); }
        }
    }
    const float ltot = lsum + __shfl_xor(lsum, 32), inv = 1.f / ltot;
    bf16* orow = OATT + (size_t)(row_blk0 + qi) * AW + h * 128 + 4 * hh;
#pragma unroll
    for (int dt = 0; dt < 4; ++dt)
#pragma unroll
        for (int g4 = 0; g4 < 4; ++g4) { const u64 w = (u64)cvtpk(O[dt][4 * g4] * inv, O[dt][4 * g4 + 1] * inv) | ((u64)cvtpk(O[dt][4 * g4 + 2] * inv, O[dt][4 * g4 + 3] * inv) << 32);
            *(u64*)(orow + 32 * dt + 8 * g4) = w; }
}

constexpr int LR_XC = 0, LR_A = 17408, LR_U = LR_A + 32768;
#define MFMA16(a, b, c) __builtin_amdgcn_mfma_f32_16x16x32_bf16((a), (b), (c), 0, 0, 0)
__device__ __forceinline__ void lru_unit(const Params& P, LAS unsigned char* lds, int b, int g, int c, int tid, int wave, int lane) {
    unsigned char* ws = P.ws;
    const bf16* XR = (const bf16*)(ws + WS_XR); const bf16* LWA = (const bf16*)(ws + WS_LWA) + (size_t)g * 16384; const bf16* LWX = (const bf16*)(ws + WS_LWX) + (size_t)g * 16384;
    float* HL = (float*)(ws + WS_HL); float* AC = (float*)(ws + WS_AC); float* SUM = (float*)(ws + WS_SUM);
    LAS unsigned short* XC = (LAS unsigned short*)(lds + LR_XC);
    LAS float* AB = (LAS float*)(lds + LR_A); LAS float* UB = (LAS float*)(lds + LR_U);
    const int t0 = c * 64; const size_t R0 = (size_t)b * SEQ + t0;
    __syncthreads();
    {
      const int ch = tid & 127, tq = tid >> 7, C = g * 128 + ch;
      const float w0 = P.conv_w[C], w1 = P.conv_w[1024 + C], w2 = P.conv_w[2048 + C], w3 = P.conv_w[3072 + C], cb = P.conv_b[C];
      const int ts = t0 + tq * 16;
      float x0 = (ts - 3 >= 0) ? bf_lo((unsigned)XR[((size_t)b * SEQ + ts - 3) * AW + C]) : 0.f;
      float x1 = (ts - 2 >= 0) ? bf_lo((unsigned)XR[((size_t)b * SEQ + ts - 2) * AW + C]) : 0.f;
      float x2 = (ts - 1 >= 0) ? bf_lo((unsigned)XR[((size_t)b * SEQ + ts - 1) * AW + C]) : 0.f;
#pragma unroll 4
      for (int i = 0; i < 16; ++i) { const float x3 = bf_lo((unsigned)XR[((size_t)b * SEQ + ts + i) * AW + C]);
          const float y = x0 * w0 + x1 * w1 + x2 * w2 + x3 * w3 + cb;
          XC[(tq * 16 + i) * 136 + ch] = (unsigned short)(cvtpk(y, 0.f) & 0xffffu);
          x0 = x1; x1 = x2; x2 = x3; } }
    __syncthreads();
    { const int mtile = wave & 3, nhalf = wave >> 2, fr = lane & 15, fq = lane >> 4;
      f32x4 aA[4], aX[4];
#pragma unroll
      for (int nt = 0; nt < 4; ++nt) { aA[nt] = (f32x4){0.f, 0.f, 0.f, 0.f}; aX[nt] = (f32x4){0.f, 0.f, 0.f, 0.f}; }
#pragma unroll
      for (int ks = 0; ks < 4; ++ks) { const bf16x8 a = *(const LAS bf16x8*)((LAS unsigned char*)XC + (16 * mtile + fr) * 272 + (32 * ks + 8 * fq) * 2);
#pragma unroll
          for (int nt = 0; nt < 4; ++nt) { const size_t wo = (size_t)(64 * nhalf + 16 * nt + fr) * 128 + 32 * ks + 8 * fq;
              const bf16x8 ba = *(const bf16x8*)(LWA + wo), bx = *(const bf16x8*)(LWX + wo);
              aA[nt] = MFMA16(a, ba, aA[nt]); aX[nt] = MFMA16(a, bx, aX[nt]); } }
#pragma unroll
      for (int nt = 0; nt < 4; ++nt) { const int ch = 64 * nhalf + 16 * nt + fr, C = g * 128 + ch;
          const float ba = P.lru_ba[C], bx = P.lru_bx[C], lam = P.lru_lam[C];
          const float sp = log1pf(__expf(-lam));
#pragma unroll
          for (int r = 0; r < 4; ++r) { const int tok = 16 * mtile + 4 * fq + r;
              const float rg = pg8::sigmoid_f(aA[nt][r] + ba), ig = pg8::sigmoid_f(aX[nt][r] + bx);
              const float log_a = -8.f * rg * sp, a = __expf(log_a);
              const float mult = sqrtf(-expm1f(2.f * log_a));
              const float xc = bf_lo((unsigned)XC[tok * 136 + ch]);
              AB[tok * 128 + ch] = a; UB[tok * 128 + ch] = mult * (ig * xc); } } }
    __syncthreads();
    if (tid < 128) { const int ch = tid; float hv = 0.f, Ac = 1.f;
        for (int t = 0; t < 64; ++t) { const float a = AB[t * 128 + ch], u = UB[t * 128 + ch]; hv = a * hv + u; Ac *= a; UB[t * 128 + ch] = hv; AB[t * 128 + ch] = Ac; }
        float* sm = SUM + ((size_t)(b * 32 + c) * 1024 + g * 128 + ch) * 2; sm[0] = Ac; sm[1] = hv; }
    __syncthreads();
#pragma unroll
    for (int i = 0; i < 4; ++i) { const int q = tid + 512 * i, t = q >> 5, c4 = (q & 31) * 4;
        *(f32x4*)(HL + (R0 + t) * AW + g * 128 + c4) = *(const LAS f32x4*)(UB + t * 128 + c4);
        *(f32x4*)(AC + (R0 + t) * AW + g * 128 + c4) = *(const LAS f32x4*)(AB + t * 128 + c4); }
}

constexpr int SC_STR = 129, P7_IL = 2 * 128 * SC_STR * 4;
__device__ __forceinline__ unsigned ord_key(float v) { const unsigned u = __builtin_bit_cast(unsigned, v); return (u & 0x80000000u) ? ~u : (u | 0x80000000u); }
#define TOPK_INSERT(arr, val) do { unsigned _v = (val); _Pragma("unroll") for (int _j = 0; _j < 16; ++_j) { const unsigned _hi = arr[_j] > _v ? arr[_j] : _v; _v = arr[_j] > _v ? _v : arr[_j]; arr[_j] = _hi; } } while (0)
__device__ __forceinline__ void peer_topk_unit(const Params& P, LAS unsigned char* lds, int t0, int h, int tid, int wave, int lane) {
    unsigned char* ws = P.ws;
    const bf16* QP = (const bf16*)(ws + WS_QP); const bf16* KEYS = (const bf16*)(ws + WS_KEYS);
    int* IDX = (int*)(ws + WS_IDX); float* GW = (float*)(ws + WS_G);
    LAS float* SC = (LAS float*)lds; LAS int* IL = (LAS int*)(lds + P7_IL);
    __syncthreads();
    { const int mtile = wave & 3, c = wave >> 2, r31 = lane & 31, hh = lane >> 5;
      bf16x8 A[8];
      const bf16* qp = QP + (size_t)(t0 + 32 * mtile + r31) * DM + h * 256 + c * 128 + 8 * hh;
#pragma unroll
      for (int ks = 0; ks < 8; ++ks) A[ks] = *(const bf16x8*)(qp + 16 * ks);
#pragma unroll
      for (int nt = 0; nt < 4; ++nt) { f32x16 acc;
#pragma unroll
          for (int r = 0; r < 16; ++r) acc[r] = 0.f;
          const bf16* kp = KEYS + ((size_t)((h * 2 + c) * 128 + 32 * nt + r31)) * 128 + 8 * hh;
#pragma unroll
          for (int ks = 0; ks < 8; ++ks) { const bf16x8 bk = *(const bf16x8*)(kp + 16 * ks); acc = MFMA32(A[ks], bk, acc); }
#pragma unroll
          for (int r = 0; r < 16; ++r) { const int tok = 32 * mtile + (r & 3) + 8 * (r >> 2) + 4 * hh; SC[(c * 128 + tok) * SC_STR + 32 * nt + r31] = acc[r]; } } }
    __syncthreads();
    const int half = tid & 1, c = (tid >> 1) & 1, tok = tid >> 2;
    unsigned a[16];
#pragma unroll
    for (int j = 0; j < 16; ++j) a[j] = 0u;
    { const LAS float* sp = SC + (c * 128 + tok) * SC_STR + half * 64; const int rot = 8 * (2 * c + half);
      for (int i = 0; i < 64; ++i) { const int n = (i + rot) & 63; const float v = sp[n]; const unsigned key = (ord_key(v) & ~127u) | (unsigned)(127 - (half * 64 + n)); TOPK_INSERT(a, key); } }
    { unsigned o[16];
#pragma unroll
      for (int j = 0; j < 16; ++j) o[j] = (unsigned)__shfl_xor((int)a[j], 1);
#pragma unroll
      for (int j = 0; j < 16; ++j) TOPK_INSERT(a, o[j]); }
    unsigned bl[16];
#pragma unroll
    for (int j = 0; j < 16; ++j) bl[j] = (unsigned)__shfl_xor((int)a[j], 2);
    if ((tid & 3) == 0) {
        float sa[16], sb[16];
#pragma unroll
        for (int j = 0; j < 16; ++j) { const int na = 127 - (int)(a[j] & 127u), nb = 127 - (int)(bl[j] & 127u);
            sa[j] = SC[tok * SC_STR + na]; sb[j] = SC[(128 + tok) * SC_STR + nb]; IL[tok * 33 + j] = na; IL[tok * 33 + 16 + j] = nb; }
        unsigned cd[16];
#pragma unroll
        for (int j = 0; j < 16; ++j) cd[j] = 0u;
#pragma unroll
        for (int ia = 0; ia < 16; ++ia)
#pragma unroll
            for (int ib = 0; ib < 16; ++ib) if ((ia + 1) * (ib + 1) <= 16) { const unsigned key = (ord_key(sa[ia] + sb[ib]) & ~255u) | (unsigned)(255 - (ia * 16 + ib)); TOPK_INSERT(cd, key); }
        float cv[16]; int id[16];
#pragma unroll
        for (int s = 0; s < 16; ++s) { const int code = 255 - (int)(cd[s] & 255u), ia = code >> 4, ib = code & 15; const int na = IL[tok * 33 + ia], nb = IL[tok * 33 + 16 + ib];
            cv[s] = SC[tok * SC_STR + na] + SC[(128 + tok) * SC_STR + nb]; id[s] = na * 128 + nb; }
        float mx = cv[0];
#pragma unroll
        for (int s = 1; s < 16; ++s) mx = fmaxf(mx, cv[s]);
        float sum = 0.f;
#pragma unroll
        for (int s = 0; s < 16; ++s) { cv[s] = __builtin_amdgcn_exp2f((cv[s] - mx) * LOG2E); sum += cv[s]; }
        const float inv = 1.f / sum;
        int* ip = IDX + (size_t)(t0 + tok) * 128 + h * 16; float* gp = GW + (size_t)(t0 + tok) * 128 + h * 16;
#pragma unroll
        for (int s4 = 0; s4 < 4; ++s4) { *(int4*)(ip + 4 * s4) = make_int4(id[4 * s4], id[4 * s4 + 1], id[4 * s4 + 2], id[4 * s4 + 3]);
            *(f32x4*)(gp + 4 * s4) = (f32x4){cv[4 * s4] * inv, cv[4 * s4 + 1] * inv, cv[4 * s4 + 2] * inv, cv[4 * s4 + 3] * inv}; }
    }
}

__device__ __forceinline__ void peer_token(const Params& P, int t, int lane) {
    unsigned char* ws = P.ws;
    const bf16* X1B = (const bf16*)(ws + WS_X1B); const bf16* UB = (const bf16*)(ws + WS_UB); const bf16* VB = (const bf16*)(ws + WS_VB);
    const int* IDX = (const int*)(ws + WS_IDX); const float* GW = (const float*)(ws + WS_G); const float* SSP = (const float*)(ws + WS_SSP);
    v4u xq[4];
#pragma unroll
    for (int q = 0; q < 4; ++q) xq[q] = *(const v4u*)(X1B + (size_t)t * DM + 512 * q + 8 * lane);
    const float rs = __builtin_amdgcn_rsqf(wave_sum(lane < 32 ? SSP[(size_t)t * 32 + lane] : 0.f) * (1.f / 2048.f) + RMS_EPS);
    const int id0 = IDX[(size_t)t * 128 + lane], id1 = IDX[(size_t)t * 128 + 64 + lane];
    const float gw0 = GW[(size_t)t * 128 + lane], gw1 = GW[(size_t)t * 128 + 64 + lane];
    float d0 = 0.f, d1 = 0.f;
    for (int e = 0; e < 128; e += 4) {
        v4u u[4][4];
#pragma unroll
        for (int i = 0; i < 4; ++i) { const int ee = e + i; const int id = __builtin_amdgcn_readlane(ee < 64 ? id0 : id1, ee & 63);
            const bf16* up = UB + (size_t)id * DM + 8 * lane;
#pragma unroll
            for (int q = 0; q < 4; ++q) u[i][q] = *(const v4u*)(up + 512 * q); }
#pragma unroll
        for (int i = 0; i < 4; ++i) { const int ee = e + i; float p0 = 0.f, p1 = 0.f;
#pragma unroll
            for (int q = 0; q < 4; ++q) { p0 = dot2bf(u[i][q].x, xq[q].x, p0); p1 = dot2bf(u[i][q].y, xq[q].y, p1); p0 = dot2bf(u[i][q].z, xq[q].z, p0); p1 = dot2bf(u[i][q].w, xq[q].w, p1); }
            const float dsum = wave_sum(p0 + p1);
            if (ee < 64) d0 = (lane == ee) ? dsum : d0; else d1 = (lane == ee - 64) ? dsum : d1; }
    }
    const float act0 = pg8::gelu_tanh_f(d0 * rs) * gw0, act1 = pg8::gelu_tanh_f(d1 * rs) * gw1;
    float acc[32];
#pragma unroll
    for (int i = 0; i < 32; ++i) acc[i] = 0.f;
    for (int e = 0; e < 128; e += 4) {
        v4u v[4][4]; float av[4];
#pragma unroll
        for (int i = 0; i < 4; ++i) { const int ee = e + i; const int id = __builtin_amdgcn_readlane(ee < 64 ? id0 : id1, ee & 63);
            av[i] = __builtin_bit_cast(float, __builtin_amdgcn_readlane(__builtin_bit_cast(int, ee < 64 ? act0 : act1), ee & 63));
            const bf16* vp = VB + (size_t)id * DM + 8 * lane;
#pragma unroll
            for (int q = 0; q < 4; ++q) v[i][q] = *(const v4u*)(vp + 512 * q); }
#pragma unroll
        for (int i = 0; i < 4; ++i)
#pragma unroll
            for (int q = 0; q < 4; ++q) { const float a = av[i];
                acc[8 * q + 0] += a * bf_lo(v[i][q].x); acc[8 * q + 1] += a * bf_hi(v[i][q].x); acc[8 * q + 2] += a * bf_lo(v[i][q].y); acc[8 * q + 3] += a * bf_hi(v[i][q].y);
                acc[8 * q + 4] += a * bf_lo(v[i][q].z); acc[8 * q + 5] += a * bf_hi(v[i][q].z); acc[8 * q + 6] += a * bf_lo(v[i][q].w); acc[8 * q + 7] += a * bf_hi(v[i][q].w); }
    }
    float* orow = P.out + (size_t)t * DM; float ss = 0.f;
#pragma unroll
    for (int q = 0; q < 4; ++q) { const f32x4 a = *(const f32x4*)(orow + 512 * q + 8 * lane), b = *(const f32x4*)(orow + 512 * q + 8 * lane + 4);
#pragma unroll
        for (int i = 0; i < 4; ++i) { acc[8 * q + i] += a[i]; acc[8 * q + 4 + i] += b[i]; }
#pragma unroll
        for (int i = 0; i < 8; ++i) ss += acc[8 * q + i] * acc[8 * q + i]; }
    const float rf = __builtin_amdgcn_rsqf(wave_sum(ss) * (1.f / 2048.f) + RMS_EPS);
#pragma unroll
    for (int q = 0; q < 4; ++q) { const f32x4 ga = *(const f32x4*)(P.g_fin + 512 * q + 8 * lane), gb = *(const f32x4*)(P.g_fin + 512 * q + 8 * lane + 4);
        f32x4 oa, ob;
#pragma unroll
        for (int i = 0; i < 4; ++i) { oa[i] = acc[8 * q + i] * rf * ga[i]; ob[i] = acc[8 * q + 4 + i] * rf * gb[i]; }
        *(f32x4*)(orow + 512 * q + 8 * lane) = oa; *(f32x4*)(orow + 512 * q + 8 * lane + 4) = ob; }
}

#ifndef MK_PER_PHASE
#define MK_PER_PHASE 0
#endif
constexpr int N_PHASES = 9;
__global__ void __launch_bounds__(NWAVES * 64, 2) fwd_kernel(Params P) {
    extern __shared__ __attribute__((aligned(16))) unsigned char lds_raw[];
    LAS unsigned char* lds = (LAS unsigned char*)lds_raw;
    volatile LAS unsigned* MISC = (volatile LAS unsigned*)(lds + MISC_OFF);
    const int tid = threadIdx.x, lane = tid & 63, wave = __builtin_amdgcn_readfirstlane(tid >> 6);
    const int G = gridDim.x; const int bx = blockIdx.x;
    const int vcu = (G % 8 == 0) ? (bx % 8) * (G / 8) + bx / 8 : bx;
    const int gw = vcu * NWAVES + wave, NGW = G * NWAVES;
    unsigned char* ws = P.ws;
    gu32* ctl = (gu32*)(ws + WS_CTL);
    for (int u = tid; u < 64; u += NWAVES * 64) MISC[u] = 0u;
    __syncthreads();
    XcdBarrier bar; bar.bar = (unsigned*)ctl + CW_BAR; bar.x = 0; bar.st = nullptr;
    if (!MK_PER_PHASE) bar = xcd_barrier_post((unsigned*)ctl + CW_BAR, MISC + 8);
    const int lo = P.ph_lo, hi = P.ph_hi;
#ifndef PH_MASK
#define PH_MASK 0x1ff
#endif
#define IN(k) (((PH_MASK >> (k)) & 1) && lo <= (k) && (k) < hi)
#define BOTH(k) (IN(k) && IN((k) + 1))
#define GRID_BAR() do { if (!MK_PER_PHASE) xcd_barrier(bar); } while (0)

    bf16* HN = (bf16*)(ws + WS_HN); bf16* WA = (bf16*)(ws + WS_WA); bf16* WV = (bf16*)(ws + WS_WV); bf16* WB = (bf16*)(ws + WS_WB); bf16* WO = (bf16*)(ws + WS_WO); bf16* WQ = (bf16*)(ws + WS_WQ);

    if (IN(0)) { p0_prologue(P, lds, gw, NGW, wave, lane); if (BOTH(0)) GRID_BAR(); }

    if (IN(1)) {
        { pg8::Gemm g{HN, WA, T_TOK, NWA, DM}; pg8::StaticOrder S; S.init(T_TOK, NWA, G, bx);
          pg8::EpiProj E{(bf16*)(ws + WS_Q), (bf16*)(ws + WS_K), (bf16*)(ws + WS_XR), (bf16*)(ws + WS_GY), (bf16*)(ws + WS_SG), (float*)(ws + WS_CTL) + CW_KM, QSCALE};
          pg8::gemm_phase<pg8::EpiProj, pg8::StaticOrder, true, true>(lds, g, S, E); }
        { pg8::Gemm g{WV, HN, AW, T_TOK, DM}; pg8::StaticOrder S; S.init(AW, T_TOK, G, bx);
          pg8::EpiStore E{(bf16*)(ws + WS_VT), T_TOK};
          pg8::gemm_phase<pg8::EpiStore, pg8::StaticOrder, true, true>(lds, g, S, E); }
        if (BOTH(1)) GRID_BAR();
    }

    if (IN(2)) {
        LAS int* tick = (LAS int*)(lds + MISC_OFF + 128);
#define NEXT_TICKET(dst) do { __syncthreads(); if (tid == 0) *tick = (int)__hip_atomic_fetch_add((unsigned*)(ctl + CW_Q2), 1u, __ATOMIC_RELAXED, __HIP_MEMORY_SCOPE_AGENT); __syncthreads(); dst = *tick; } while (0)
        int it; NEXT_TICKET(it);
        while (it < 256) { const int blk = 7 - (it >> 5), bh = it & 31; attn_unit(P, lds, bh >> 3, bh & 7, blk, tid, wave, lane); NEXT_TICKET(it); }
        while (it < 256 + 1024) { const int r = it - 256; lru_unit(P, lds, r >> 8, (r >> 5) & 7, r & 31, tid, wave, lane); NEXT_TICKET(it); }
#undef NEXT_TICKET
        if (BOTH(2)) GRID_BAR();
    }

    if (IN(3)) {
        const float* HL = (const float*)(ws + WS_HL); const float* AC = (const float*)(ws + WS_AC); const float* SUM = (const float*)(ws + WS_SUM);
        const bf16* GY = (const bf16*)(ws + WS_GY); bf16* OREC = (bf16*)(ws + WS_OREC);
        for (int u = vcu; u < 256; u += G) { const int b = u >> 6, c = (u >> 1) & 31, C = (u & 1) * 512 + tid;
            float carry = 0.f;
            for (int cc = 0; cc < c; ++cc) { const float* sm = SUM + ((size_t)(b * 32 + cc) * 1024 + C) * 2; carry = sm[0] * carry + sm[1]; }
            const size_t R0 = (size_t)b * SEQ + c * 64;
#pragma unroll 4
            for (int t = 0; t < 64; ++t) { const size_t o = (R0 + t) * AW + C; const float hv = HL[o] + AC[o] * carry;
                OREC[o] = (bf16)(cvtpk(hv * bf_lo((unsigned)GY[o]), 0.f) & 0xffffu); } }
        if (BOTH(3)) GRID_BAR();
    }

    if (IN(4)) {
        { pg8::Gemm g{(bf16*)(ws + WS_OATT), WB, T_TOK, DM, AW}; pg8::StaticOrder S; S.init(T_TOK, DM, G, bx);
          pg8::EpiMerge<true> E{(const bf16*)(ws + WS_SG), (float*)(ws + WS_TMP), (bf16*)(ws + WS_MG)};
          pg8::gemm_phase<pg8::EpiMerge<true>, pg8::StaticOrder, true, true>(lds, g, S, E); }
        { pg8::Gemm g{(bf16*)(ws + WS_OREC), WB + (size_t)DM * AW, T_TOK, DM, AW}; pg8::StaticOrder S; S.init(T_TOK, DM, G, bx);
          pg8::EpiMerge<false> E{(const bf16*)(ws + WS_SG), (float*)(ws + WS_TMP), (bf16*)(ws + WS_MG)};
          pg8::gemm_phase<pg8::EpiMerge<false>, pg8::StaticOrder, true, true>(lds, g, S, E); }
        if (BOTH(4)) GRID_BAR();
    }

    if (IN(5)) {
        pg8::Gemm g{(bf16*)(ws + WS_MG), WO, T_TOK, DM, DM}; pg8::StaticOrder S; S.init(T_TOK, DM, G, bx);
        pg8::EpiResid E{P.x, P.out, (bf16*)(ws + WS_X1B), (float*)(ws + WS_SSP)};
        pg8::gemm_phase<pg8::EpiResid, pg8::StaticOrder, true, true>(lds, g, S, E);
        if (BOTH(5)) GRID_BAR();
    }

    if (IN(6)) {
        pg8::Gemm g{(bf16*)(ws + WS_X1B), WQ, T_TOK, DM, DM}; pg8::StaticOrder S; S.init(T_TOK, DM, G, bx);
        pg8::EpiRowScale E{(const float*)(ws + WS_SSP), (bf16*)(ws + WS_QP)};
        pg8::gemm_phase<pg8::EpiRowScale, pg8::StaticOrder, true, true>(lds, g, S, E);
        if (BOTH(6)) GRID_BAR();
    }

    if (IN(7)) {
        for (int u = vcu; u < 512; u += G) peer_topk_unit(P, lds, (u >> 3) * 128, u & 7, tid, wave, lane);
        if (BOTH(7)) GRID_BAR();
    }

    if (IN(8)) {
        for (int t = gw; t < T_TOK; t += NGW) peer_token(P, t, lane);
    }
#undef IN
#undef BOTH
#undef GRID_BAR
}

extern "C" void kernel_launch(void* const* d_in, const int* in_sizes, int n_in, void* d_out, int out_size, void* d_ws, size_t ws_size, hipStream_t stream) {
    static int grid = 0;
    if (grid == 0) {
        if (n_in != 19 || out_size != T_TOK * DM || ws_size < WS_END) { fprintf(stderr, "kernel_launch: unexpected problem (n_in %d, out %d, ws %zu); nothing launched\n", n_in, out_size, ws_size); grid = -1; return; }
        int dev = 0, cus = 0, per_cu = 0;
        if (hipGetDevice(&dev) != hipSuccess || hipDeviceGetAttribute(&cus, hipDeviceAttributeMultiprocessorCount, dev) != hipSuccess) { grid = -1; return; }
        if (hipFuncSetAttribute((const void*)fwd_kernel, hipFuncAttributeMaxDynamicSharedMemorySize, LDS_BYTES) != hipSuccess) { fprintf(stderr, "kernel_launch: hipFuncSetAttribute failed\n"); grid = -1; return; }
        if (hipOccupancyMaxActiveBlocksPerMultiprocessor(&per_cu, (const void*)fwd_kernel, NWAVES * 64, LDS_BYTES) != hipSuccess || per_cu < 1) { fprintf(stderr, "kernel_launch: occupancy query says %d blocks per CU\n", per_cu); }
        (void)hipGetLastError();
        grid = cus;
    }
    if (grid < 0) return;
    if (hipMemsetAsync((char*)d_ws + WS_CTL, 0, CTL_ZERO_BYTES, stream) != hipSuccess) return;
    Params p{};
    const float** pp = (const float**)&p;
    for (int i = 0; i < 19; ++i) pp[i] = (const float*)d_in[i];
    p.out = (float*)d_out; p.ws = (unsigned char*)d_ws;
#if MK_PER_PHASE
    for (int ph = 0; ph < N_PHASES; ++ph) { p.ph_lo = ph; p.ph_hi = ph + 1; hipLaunchKernelGGL(fwd_kernel, dim3(grid), dim3(NWAVES * 64), LDS_BYTES, stream, p); }
#else
    p.ph_lo = 0; p.ph_hi = N_PHASES;
    hipLaunchKernelGGL(fwd_kernel, dim3(grid), dim3(NWAVES * 64), LDS_BYTES, stream, p);
#endif
}
```

```cpp
#include <hip/hip_runtime.h>
#include <cstdio>
#include <cstdint>
namespace pg8 {
#define PG8_LAS __attribute__((address_space(3)))
typedef unsigned short bf16_t;
typedef short bf16x8 __attribute__((ext_vector_type(8)));
typedef float f32x4 __attribute__((ext_vector_type(4)));
typedef unsigned u32x4 __attribute__((ext_vector_type(4)));
typedef int i32x4 __attribute__((ext_vector_type(4)));
typedef int i32x8 __attribute__((ext_vector_type(8)));
__device__ __forceinline__ i32x8 cat8(bf16x8 a, bf16x8 b) { return __builtin_shufflevector(__builtin_bit_cast(i32x4, a), __builtin_bit_cast(i32x4, b), 0, 1, 2, 3, 4, 5, 6, 7); }
constexpr int BM = 256, BK = 64, HALF = 128, HTB = HALF * BK * 2  , STAGE_BYTES = 8 * HTB, NXCD = 8, WGM = 8;

__host__ __device__ __forceinline__ int lds_byte(int r, int c) { const int st = (r >> 4) * 2 + (c >> 5), rr = r & 15, cc = c & 31, ob = rr * 64 + cc * 2; return st * 1024 + (ob ^ (((ob >> 9) & 1) << 5)); }
__host__ __device__ __forceinline__ void stage_rc(int b, int& R, int& C) { const int st = b / 1024, sb = b % 1024, swz = sb ^ (((sb >> 9) & 1) << 5); R = (st >> 1) * 16 + swz / 64; C = (st & 1) * 32 + (swz % 64) / 2; }
__host__ __device__ __forceinline__ int perm32(int rho) { const int n = rho >> 4, i = rho & 15; return 8 * (i >> 2) + 4 * n + (i & 3); }

struct Unit { int pm, pn, sel; };
struct Gemm { const bf16_t* A; const bf16_t* Bt; int M, N, K; const bf16_t* A2; const bf16_t* Bt2; const void* rbase; unsigned rbytes; };

struct StaticOrder {
    int nM, nN, nwg, G, c;
    __host__ __device__ __forceinline__ void init(int M, int N, int G_, int c_) { nM = M / BM; nN = N / BM; nwg = nM * nN; G = G_; c = c_; }
    __host__ __device__ __forceinline__ bool next(int i, Unit& u) const {
        const long L = (long)i * G + c; if (L >= nwg) return false;
        int wgid = (int)L; { const int q = nwg / NXCD, r = nwg % NXCD, xcd = wgid % NXCD, off = wgid / NXCD; wgid = (xcd < r ? xcd * (q + 1) : r * (q + 1) + (xcd - r) * q) + off; }
        const int nig = WGM * nN, gid = wgid / nig, fm = gid * WGM, gsz = (nM - fm) < WGM ? (nM - fm) : WGM;
        u.pm = fm + ((wgid % nig) % gsz); u.pn = (wgid % nig) / gsz; u.sel = 0; return true;
    }
    __device__ __forceinline__ void a_ready(const Unit&) const {}
    __device__ __forceinline__ void done(const Unit&) const {}
};

struct StaticOrder2 {
    StaticOrder s0, s1; int G, c;
    __host__ __device__ __forceinline__ void init(int M0, int N0, int M1, int N1, int G_, int c_) { s0.init(M0, N0, 1, 0); s1.init(M1, N1, 1, 0); G = G_; c = c_; }
    __host__ __device__ __forceinline__ bool next(int i, Unit& u) const {
        const long L = (long)i * G + c;
        if (L < s0.nwg) return s0.next((int)L, u);
        if (L < s0.nwg + s1.nwg) { const bool ok = s1.next((int)(L - s0.nwg), u); u.sel = 1; return ok; }
        return false;
    }
    __device__ __forceinline__ void a_ready(const Unit&) const {}
    __device__ __forceinline__ void done(const Unit&) const {}
};

__device__ __forceinline__ unsigned cvt_pk_bf16(float lo, float hi) { unsigned r; asm volatile("v_cvt_pk_bf16_f32 %0, %1, %2" : "=v"(r) : "v"(lo), "v"(hi)); return r; }
typedef float f32x2 __attribute__((ext_vector_type(2)));
__device__ __forceinline__ float c8(float v) { return __builtin_fminf(__builtin_fmaxf(v, -448.f), 448.f); }
__device__ __forceinline__ float sigmoid_f(float v) { return __builtin_amdgcn_rcpf(1.f + __builtin_amdgcn_exp2f(-1.4426950408889634f * v)); }
__device__ __forceinline__ float gelu_tanh_f(float v) { const float z = 1.5957691216057308f * (v + 0.044715f * v * v * v); return v * __builtin_amdgcn_rcpf(1.f + __builtin_amdgcn_exp2f(-1.4426950408889634f * z)); }
__device__ __forceinline__ u32x4 pack8(const f32x4& v0, const f32x4& v1) { u32x4 w; w.x = cvt_pk_bf16(v0[0], v0[1]); w.y = cvt_pk_bf16(v0[2], v0[3]); w.z = cvt_pk_bf16(v1[0], v1[1]); w.w = cvt_pk_bf16(v1[2], v1[3]); return w; }
__device__ __forceinline__ f32x4 bf4_lo(unsigned a, unsigned b) { f32x4 r; r[0] = __builtin_bit_cast(float, a << 16); r[1] = __builtin_bit_cast(float, a & 0xffff0000u); r[2] = __builtin_bit_cast(float, b << 16); r[3] = __builtin_bit_cast(float, b & 0xffff0000u); return r; }

struct EpiProj {
    static constexpr bool PERM = true, AFTER_DRAIN = false, MIDK = false;
    bf16_t *Q, *K, *XR, *GY, *SG, *VT; float* KM; float qscale, oscale;
    __device__ __forceinline__ void operator()(const f32x4 (&acc)[2][2][4][2], const Unit& u, int wr, int wc, int fr, int fq) const {
        { const int l_ = (int)__builtin_amdgcn_mbcnt_hi(~0u, __builtin_amdgcn_mbcnt_lo(~0u, 0u)); fr = l_ & 15; fq = l_ >> 4; }
        const int pn = u.pn; int kind, ldc, colt; bf16_t* base;
        if (u.sel) { kind = 2; base = VT; ldc = 8192; colt = pn * 256; }
        else if (pn < 4) { kind = 0; base = Q; ldc = 1024; colt = pn * 256; }
        else if (pn < 8) { kind = 1; base = K; ldc = 1024; colt = (pn - 4) * 256; }
        else if (pn < 12) { kind = 2; base = XR; ldc = 1024; colt = (pn - 8) * 256; }
        else if (pn < 16) { kind = 3; base = GY; ldc = 1024; colt = (pn - 12) * 256; }
        else { kind = 4; base = SG; ldc = 4096; colt = (pn - 16) * 256; }
        const int row0 = u.pm * BM + wr * 64 + fr, col0 = colt + wc * 32 + 8 * fq;
#pragma unroll
        for (int ai = 0; ai < 2; ++ai)
#pragma unroll
            for (int m = 0; m < 4; ++m) { bf16_t* rowp = base + (size_t)(row0 + ai * HALF + m * 16) * ldc + col0;
#pragma unroll
                for (int bj = 0; bj < 2; ++bj) { f32x4 v0 = acc[ai][bj][m][0] * oscale, v1 = acc[ai][bj][m][1] * oscale;
                    if (kind == 0) { v0 = v0 * qscale; v1 = v1 * qscale; }
                    else if (kind == 3) {
#pragma unroll
                        for (int e = 0; e < 4; ++e) { v0[e] = gelu_tanh_f(v0[e]); v1[e] = gelu_tanh_f(v1[e]); } }
                    else if (kind == 4) {
#pragma unroll
                        for (int e = 0; e < 4; ++e) { v0[e] = sigmoid_f(v0[e]); v1[e] = sigmoid_f(v1[e]); } }
                    *(u32x4*)(rowp + bj * HALF) = pack8(v0, v1); } }
        if (kind == 1 && KM != nullptr) {
            const int b = u.pm >> 3, blk = u.pm & 7;
#pragma unroll
            for (int bj = 0; bj < 2; ++bj)
#pragma unroll
                for (int n = 0; n < 2; ++n) { f32x4 s = (f32x4){0.f, 0.f, 0.f, 0.f};
#pragma unroll
                    for (int ai = 0; ai < 2; ++ai)
#pragma unroll
                        for (int m = 0; m < 4; ++m) s = s + acc[ai][bj][m][n];
#pragma unroll
                    for (int e = 0; e < 4; ++e) { float v = s[e]; v += __shfl_xor(v, 1); v += __shfl_xor(v, 2); v += __shfl_xor(v, 4); v += __shfl_xor(v, 8); s[e] = v; }
                    if (fr == 0) { const int c = colt + bj * HALF + wc * 32 + 8 * fq + 4 * n;
                        float* dst = KM + ((size_t)((b * 8 + (c >> 7)) * 8 + blk)) * 128 + (c & 127);
#pragma unroll
                        for (int e = 0; e < 4; ++e) atomicAdd(dst + e, s[e] * oscale); } }
        }
    }
};
struct EpiStore {
    static constexpr bool PERM = true, AFTER_DRAIN = false, MIDK = false;
    bf16_t* O; int ldc;
    __device__ __forceinline__ void operator()(const f32x4 (&acc)[2][2][4][2], const Unit& u, int wr, int wc, int fr, int fq) const {
        { const int l_ = (int)__builtin_amdgcn_mbcnt_hi(~0u, __builtin_amdgcn_mbcnt_lo(~0u, 0u)); fr = l_ & 15; fq = l_ >> 4; }
        const int row0 = u.pm * BM + wr * 64 + fr, col0 = u.pn * BM + wc * 32 + 8 * fq;
#pragma unroll
        for (int ai = 0; ai < 2; ++ai)
#pragma unroll
            for (int m = 0; m < 4; ++m) { bf16_t* rowp = O + (size_t)(row0 + ai * HALF + m * 16) * ldc + col0;
#pragma unroll
                for (int bj = 0; bj < 2; ++bj) *(u32x4*)(rowp + bj * HALF) = pack8(acc[ai][bj][m][0], acc[ai][bj][m][1]); }
    }
};
struct EpiMerge2 {
    static constexpr bool PERM = true, AFTER_DRAIN = false, MIDK = true;
    const bf16_t* SG; bf16_t* MG; float mgscale;
    __device__ __forceinline__ void midk(f32x4 (&acc)[2][2][4][2], const Unit& u, int wr, int wc, int fr, int fq) const {
        int row0 = u.pm * BM + wr * 64 + fr, col0 = u.pn * BM + wc * 32 + 8 * fq;
        asm volatile("" : "+v"(row0), "+v"(col0));
#pragma unroll
        for (int ai = 0; ai < 2; ++ai)
#pragma unroll
            for (int m = 0; m < 4; ++m) { const size_t row = (size_t)(row0 + ai * HALF + m * 16);
#pragma unroll
                for (int bj = 0; bj < 2; ++bj) { const int col = col0 + bj * HALF;
                    const u32x4 g0 = *(const u32x4*)(SG + row * 4096 + col), g1 = *(const u32x4*)(SG + row * 4096 + 2048 + col);
                    const f32x4 n0 = bf4_lo(g0.x, g0.y), n1 = bf4_lo(g0.z, g0.w), d0 = bf4_lo(g1.x, g1.y), d1 = bf4_lo(g1.z, g1.w);
#pragma unroll
                    for (int e2 = 0; e2 < 4; ++e2) { acc[ai][bj][m][0][e2] *= n0[e2] * __builtin_amdgcn_rcpf(fmaxf(d0[e2], 1e-18f)); acc[ai][bj][m][1][e2] *= n1[e2] * __builtin_amdgcn_rcpf(fmaxf(d1[e2], 1e-18f)); } } }
    }
    __device__ __forceinline__ void operator()(const f32x4 (&acc)[2][2][4][2], const Unit& u, int wr, int wc, int fr, int fq) const {
        { const int l_ = (int)__builtin_amdgcn_mbcnt_hi(~0u, __builtin_amdgcn_mbcnt_lo(~0u, 0u)); fr = l_ & 15; fq = l_ >> 4; }
        const int row0 = u.pm * BM + wr * 64 + fr, col0 = u.pn * BM + wc * 32 + 8 * fq;
#pragma unroll
        for (int ai = 0; ai < 2; ++ai)
#pragma unroll
            for (int m = 0; m < 4; ++m) { const size_t row = (size_t)(row0 + ai * HALF + m * 16);
#pragma unroll
                for (int bj = 0; bj < 2; ++bj) { const int col = col0 + bj * HALF;
                    const u32x4 g1 = *(const u32x4*)(SG + row * 4096 + 2048 + col);
                    const f32x4 v0 = acc[ai][bj][m][0] * bf4_lo(g1.x, g1.y) * mgscale, v1 = acc[ai][bj][m][1] * bf4_lo(g1.z, g1.w) * mgscale;
                    int p0 = __builtin_amdgcn_cvt_pk_fp8_f32(c8(v0[0]), c8(v0[1]), 0, false); p0 = __builtin_amdgcn_cvt_pk_fp8_f32(c8(v0[2]), c8(v0[3]), p0, true);
                    int p1 = __builtin_amdgcn_cvt_pk_fp8_f32(c8(v1[0]), c8(v1[1]), 0, false); p1 = __builtin_amdgcn_cvt_pk_fp8_f32(c8(v1[2]), c8(v1[3]), p1, true);
                    *(unsigned long long*)((unsigned char*)MG + row * 2048 + col) = (unsigned long long)(unsigned)p0 | ((unsigned long long)(unsigned)p1 << 32); } }
    }
};
struct EpiResid {
    static constexpr bool PERM = true, AFTER_DRAIN = false, MIDK = false;
    const float* X; bf16_t* X1B; float* SSP; float oscale;
    __device__ __forceinline__ void operator()(const f32x4 (&acc)[2][2][4][2], const Unit& u, int wr, int wc, int fr, int fq) const {
        { const int l_ = (int)__builtin_amdgcn_mbcnt_hi(~0u, __builtin_amdgcn_mbcnt_lo(~0u, 0u)); fr = l_ & 15; fq = l_ >> 4; }
        const int row0 = u.pm * BM + wr * 64 + fr, col0 = u.pn * BM + wc * 32 + 8 * fq;
#pragma unroll
        for (int ai = 0; ai < 2; ++ai)
#pragma unroll
            for (int m = 0; m < 4; ++m) { const size_t row = (size_t)(row0 + ai * HALF + m * 16); float ss = 0.f;
#pragma unroll
                for (int bj = 0; bj < 2; ++bj) { const int col = col0 + bj * HALF; const float* xp = X + row * 2048 + col;
                    f32x4 v0 = acc[ai][bj][m][0] * oscale + *(const f32x4*)xp, v1 = acc[ai][bj][m][1] * oscale + *(const f32x4*)(xp + 4);
                    *(u32x4*)(X1B + row * 2048 + col) = pack8(v0, v1);
                    ss += (v0[0] * v0[0] + v0[1] * v0[1]) + (v0[2] * v0[2] + v0[3] * v0[3]) + (v1[0] * v1[0] + v1[1] * v1[1]) + (v1[2] * v1[2] + v1[3] * v1[3]); }
                ss += __shfl_xor(ss, 16); ss += __shfl_xor(ss, 32);
                if (fq == 0) SSP[row * 32 + u.pn * 4 + wc] = ss; }
    }
};
struct EpiRowScale {
    static constexpr bool PERM = true, AFTER_DRAIN = false, MIDK = false;
    const float* SSP; bf16_t* O;
    __device__ __forceinline__ void operator()(const f32x4 (&acc)[2][2][4][2], const Unit& u, int wr, int wc, int fr, int fq) const {
        { const int l_ = (int)__builtin_amdgcn_mbcnt_hi(~0u, __builtin_amdgcn_mbcnt_lo(~0u, 0u)); fr = l_ & 15; fq = l_ >> 4; }
        const int row0 = u.pm * BM + wr * 64 + fr, col0 = u.pn * BM + wc * 32 + 8 * fq;
#pragma unroll
        for (int ai = 0; ai < 2; ++ai)
#pragma unroll
            for (int m = 0; m < 4; ++m) { const size_t row = (size_t)(row0 + ai * HALF + m * 16);
                const f32x4 a = *(const f32x4*)(SSP + row * 32 + 8 * fq), b = *(const f32x4*)(SSP + row * 32 + 8 * fq + 4);
                float ss = (a[0] + a[1]) + (a[2] + a[3]) + (b[0] + b[1]) + (b[2] + b[3]);
                ss += __shfl_xor(ss, 16); ss += __shfl_xor(ss, 32);
                const float rs = __builtin_amdgcn_rsqf(ss * (1.f / 2048.f) + 1e-6f);
#pragma unroll
                for (int bj = 0; bj < 2; ++bj) *(u32x4*)(O + row * 2048 + col0 + bj * HALF) = pack8(acc[ai][bj][m][0] * rs, acc[ai][bj][m][1] * rs); }
    }
};
template <class Epi, class Sched, bool ALIGN_EPI = false, bool SP2 = false, bool FP8 = false>
__device__ __forceinline__ void gemm_phase(PG8_LAS unsigned char* lds, const Gemm g, const Sched& S, const Epi& E) {
    const int tid = threadIdx.x, wid = __builtin_amdgcn_readfirstlane(tid >> 6), lane = tid & 63, wr = wid >> 2, wc = wid & 3, fr = lane & 15, fq = lane >> 4;
    const int K = g.K, nt = K / BK;
    const __amdgpu_buffer_rsrc_t rsrc = __builtin_amdgcn_make_buffer_rsrc((void*)g.rbase, 0, (int)g.rbytes, 0x00020000);
    unsigned voffA[2], voffB[2];
#pragma unroll
    for (int i = 0; i < 2; ++i) { int R, C; stage_rc(tid * 16 + i * 8192, R, C); const int Rb = Epi::PERM ? ((R & ~31) + perm32(R & 31)) : R;
        voffA[i] = (unsigned)(R * K + C) * 2u; voffB[i] = (unsigned)(Rb * K + C) * 2u; }
    const size_t kstep = (size_t)(BK * 2);
    const size_t hstep = (size_t)HALF * K * 2;
    const size_t tstep = 2 * hstep;
    const unsigned ldsw = (unsigned)wid * 1024u;
    const int aoff = lds_byte(wr * 64 + fr, fq * 8), boff = lds_byte(wc * 32 + fr, fq * 8);
#define PG8_SA(b, h) (((b) * 2 + (h)) * HTB)
#define PG8_SB(b, h) ((4 + (b) * 2 + (h)) * HTB)
#define PG8_STAGE(bufoff, gbase, voff) do { const unsigned so_ = (unsigned)((const char*)(gbase) - (const char*)g.rbase); _Pragma("unroll") for (int _i = 0; _i < 2; ++_i) \
        __builtin_amdgcn_raw_ptr_buffer_load_lds(rsrc, (PG8_LAS unsigned*)(lds + (bufoff) + ldsw + _i * 8192), 16, (voff)[_i], so_, 0, 0); } while (0)
#define PG8_LDA(dst, b, h) do { _Pragma("unroll") for (int m = 0; m < 4; ++m) { const PG8_LAS unsigned char* p_ = lds + PG8_SA(b, h) + aoff + m * 2048; \
        if constexpr (FP8) dst##8[m] = cat8(*(const PG8_LAS bf16x8*)p_, *(const PG8_LAS bf16x8*)(p_ + 1024)); else { dst[m][0] = *(const PG8_LAS bf16x8*)p_; dst[m][1] = *(const PG8_LAS bf16x8*)(p_ + 1024); } } } while (0)
#define PG8_LDB(dst, b, h) do { _Pragma("unroll") for (int n = 0; n < 2; ++n) { const PG8_LAS unsigned char* p_ = lds + PG8_SB(b, h) + boff + n * 2048; \
        if constexpr (FP8) dst##8[n] = cat8(*(const PG8_LAS bf16x8*)p_, *(const PG8_LAS bf16x8*)(p_ + 1024)); else { dst[n][0] = *(const PG8_LAS bf16x8*)p_; dst[n][1] = *(const PG8_LAS bf16x8*)(p_ + 1024); } } } while (0)
#define PG8_MMA(ai, bj, At, Bt) do { __builtin_amdgcn_s_setprio(1); _Pragma("unroll") for (int m = 0; m < 4; ++m) _Pragma("unroll") for (int n = 0; n < 2; ++n) { \
        if constexpr (FP8) acc[ai][bj][m][n] = __builtin_amdgcn_mfma_scale_f32_16x16x128_f8f6f4(Bt##8[n], At##8[m], acc[ai][bj][m][n], 0, 0, 0, 0x7f7f7f7f, 0, 0x7f7f7f7f); \
        else { _Pragma("unroll") for (int k = 0; k < 2; ++k) acc[ai][bj][m][n] = __builtin_amdgcn_mfma_f32_16x16x32_bf16(Bt[n][k], At[m][k], acc[ai][bj][m][n], 0, 0, 0); } } __builtin_amdgcn_s_setprio(0); } while (0)
#define PG8_WAIT_V(n) asm volatile("s_waitcnt vmcnt(" #n ")" ::: "memory")
#define PG8_WAIT_L(n) asm volatile("s_waitcnt lgkmcnt(" #n ")" ::: "memory")
#define PG8_BAR __builtin_amdgcn_s_barrier()
#define PG8_SCHED __builtin_amdgcn_sched_barrier(0)
    Unit cur, nxt; int ui = 0;
    if (!S.next(0, cur)) return;
    f32x4 acc[2][2][4][2];
#pragma unroll
    for (int a = 0; a < 2; ++a)
#pragma unroll
        for (int b = 0; b < 2; ++b)
#pragma unroll
            for (int m = 0; m < 4; ++m)
#pragma unroll
                for (int n = 0; n < 2; ++n) acc[a][b][m][n] = (f32x4){0.f, 0.f, 0.f, 0.f};
    bf16x8 At[4][2], B0[2][2], B1[2][2];
    i32x8 At8[4], B08[2], B18[2];
    const char* cA = (const char*)(cur.sel ? g.A2 : g.A) + (size_t)cur.pm * tstep; const char* cB = (const char*)(cur.sel ? g.Bt2 : g.Bt) + (size_t)cur.pn * tstep;
    S.a_ready(cur);
    if constexpr (SP2) {
        PG8_STAGE(PG8_SB(0, 0), cB, voffB); PG8_STAGE(PG8_SB(0, 1), cB + hstep, voffB); PG8_STAGE(PG8_SA(0, 0), cA, voffA); PG8_STAGE(PG8_SA(0, 1), cA + hstep, voffA);
        if (wr == 1) PG8_BAR;
        PG8_WAIT_V(2); PG8_BAR;
        PG8_STAGE(PG8_SB(1, 0), cB + kstep, voffB); PG8_STAGE(PG8_SA(1, 0), cA + kstep, voffA); PG8_STAGE(PG8_SB(1, 1), cB + hstep + kstep, voffB);
        PG8_WAIT_V(6); PG8_BAR;
    } else {
        PG8_STAGE(PG8_SB(0, 0), cB, voffB); PG8_STAGE(PG8_SA(0, 0), cA, voffA); PG8_STAGE(PG8_SB(0, 1), cB + hstep, voffB); PG8_STAGE(PG8_SA(0, 1), cA + hstep, voffA);
        if (wr == 1) PG8_BAR;
        PG8_WAIT_V(4); PG8_BAR;
        PG8_STAGE(PG8_SB(1, 0), cB + kstep, voffB); PG8_STAGE(PG8_SA(1, 0), cA + kstep, voffA); PG8_STAGE(PG8_SB(1, 1), cB + hstep + kstep, voffB);
        PG8_WAIT_V(6); PG8_BAR;
    }
    for (;;) {
        const bool has_next = S.next(ui + 1, nxt);
        const char* nA = has_next ? (const char*)(nxt.sel ? g.A2 : g.A) + (size_t)nxt.pm * tstep : cA; const char* nB = has_next ? (const char*)(nxt.sel ? g.Bt2 : g.Bt) + (size_t)nxt.pn * tstep : cB;
        for (int t = 0; t < nt; t += 2) {
            if constexpr (Epi::MIDK) { if (t == nt / 2) E.midk(acc, cur, wr, wc, fr, fq); }
            const bool last = (t == nt - 2);
            const char* a1 = cA + (size_t)(t + 1) * kstep;
            const char* a2 = last ? nA : cA + (size_t)(t + 2) * kstep; const char* b2 = last ? nB : cB + (size_t)(t + 2) * kstep;
            const char* a3 = a2 + kstep; const char* b3 = b2 + kstep;
            if (last && has_next) S.a_ready(nxt);
            if constexpr (SP2) {
            PG8_LDB(B0, 0, 0); PG8_LDB(B1, 0, 1); PG8_SCHED; PG8_LDA(At, 0, 0); PG8_STAGE(PG8_SA(1, 1), a1 + hstep, voffA);
            PG8_WAIT_V(8); PG8_WAIT_L(0); PG8_BAR; PG8_MMA(0, 0, At, B0); PG8_MMA(0, 1, At, B1); PG8_BAR; PG8_SCHED;
            PG8_LDA(At, 0, 1); PG8_STAGE(PG8_SB(0, 0), b2, voffB); PG8_STAGE(PG8_SB(0, 1), b2 + hstep, voffB); PG8_STAGE(PG8_SA(0, 0), a2, voffA);
            PG8_WAIT_V(8); PG8_WAIT_L(0); PG8_BAR; PG8_MMA(1, 0, At, B0); PG8_MMA(1, 1, At, B1); PG8_BAR; PG8_SCHED;
            PG8_LDB(B0, 1, 0); PG8_LDB(B1, 1, 1); PG8_SCHED; PG8_LDA(At, 1, 0); PG8_STAGE(PG8_SA(0, 1), a2 + hstep, voffA);
            PG8_WAIT_V(8); PG8_WAIT_L(0); PG8_BAR; PG8_MMA(0, 0, At, B0); PG8_MMA(0, 1, At, B1); PG8_BAR; PG8_SCHED;
            PG8_LDA(At, 1, 1); PG8_STAGE(PG8_SB(1, 0), b3, voffB); PG8_STAGE(PG8_SB(1, 1), b3 + hstep, voffB); PG8_STAGE(PG8_SA(1, 0), a3, voffA);
            PG8_WAIT_V(8); PG8_WAIT_L(0); PG8_BAR; PG8_MMA(1, 0, At, B0); PG8_MMA(1, 1, At, B1); PG8_BAR; PG8_SCHED;
            } else {
            PG8_LDB(B0, 0, 0); PG8_SCHED; PG8_LDA(At, 0, 0); PG8_STAGE(PG8_SA(1, 1), a1 + hstep, voffA);
            PG8_WAIT_L(8); PG8_BAR; PG8_WAIT_L(0); PG8_MMA(0, 0, At, B0); PG8_BAR; PG8_SCHED;
            PG8_LDB(B1, 0, 1); PG8_STAGE(PG8_SB(0, 0), b2, voffB);
            PG8_BAR; PG8_WAIT_L(0); PG8_MMA(0, 1, At, B1); PG8_BAR;
            PG8_LDA(At, 0, 1); PG8_STAGE(PG8_SA(0, 0), a2, voffA);
            PG8_BAR; PG8_WAIT_L(0); PG8_MMA(1, 0, At, B0); PG8_BAR; PG8_SCHED;
            PG8_STAGE(PG8_SB(0, 1), b2 + hstep, voffB);
            PG8_WAIT_V(6); PG8_BAR; PG8_MMA(1, 1, At, B1); PG8_BAR;
            PG8_LDB(B0, 1, 0); PG8_SCHED; PG8_LDA(At, 1, 0); PG8_STAGE(PG8_SA(0, 1), a2 + hstep, voffA);
            PG8_WAIT_L(8); PG8_BAR; PG8_WAIT_L(0); PG8_MMA(0, 0, At, B0); PG8_BAR; PG8_SCHED;
            PG8_LDB(B1, 1, 1); PG8_STAGE(PG8_SB(1, 0), b3, voffB);
            PG8_BAR; PG8_WAIT_L(0); PG8_MMA(0, 1, At, B1); PG8_BAR;
            PG8_LDA(At, 1, 1); PG8_STAGE(PG8_SA(1, 0), a3, voffA);
            PG8_BAR; PG8_WAIT_L(0); PG8_MMA(1, 0, At, B0); PG8_BAR; PG8_SCHED;
            PG8_STAGE(PG8_SB(1, 1), b3 + hstep, voffB);
            PG8_WAIT_V(6); PG8_BAR; PG8_MMA(1, 1, At, B1); PG8_BAR;
            }
        }
        if constexpr (ALIGN_EPI) { if (wr == 0) PG8_BAR; }
        if constexpr (!Epi::AFTER_DRAIN) { E(acc, cur, wr, wc, fr, fq); S.done(cur); }
        if (!has_next) break;
#pragma unroll
        for (int a = 0; a < 2; ++a)
#pragma unroll
            for (int b = 0; b < 2; ++b)
#pragma unroll
                for (int m = 0; m < 4; ++m)
#pragma unroll
                    for (int n = 0; n < 2; ++n) acc[a][b][m][n] = (f32x4){0.f, 0.f, 0.f, 0.f};
        cur = nxt; cA = nA; cB = nB; ++ui;
        if constexpr (ALIGN_EPI) { if (wr == 1) PG8_BAR; }
    }
    PG8_WAIT_V(0);
    if constexpr (!ALIGN_EPI) { if (wr == 0) PG8_BAR; }
    PG8_BAR;
    if constexpr (Epi::AFTER_DRAIN) { E.fused(acc, cur, wr, wc, fr, fq, lds, wid, lane); S.done(cur); }
#undef PG8_SA
#undef PG8_SB
#undef PG8_STAGE
#undef PG8_LDA
#undef PG8_LDB
#undef PG8_MMA
#undef PG8_WAIT_V
#undef PG8_WAIT_L
#undef PG8_BAR
#undef PG8_SCHED
}
}
#define GAS __attribute__((address_space(1)))
#define LAS __attribute__((address_space(3)))
typedef unsigned short bf16;
typedef unsigned v4u __attribute__((ext_vector_type(4)));
typedef float f32x4 __attribute__((ext_vector_type(4)));
typedef short bf16x8 __attribute__((ext_vector_type(8)));
typedef GAS unsigned gu32;
typedef GAS unsigned long long gu64;
#define RLX_AGENT __ATOMIC_RELAXED, __HIP_MEMORY_SCOPE_AGENT
#define LDS_WAIT() asm volatile("s_waitcnt lgkmcnt(0)" ::: "memory")
#define VM_WAIT() asm volatile("s_waitcnt vmcnt(0)" ::: "memory")
__device__ __forceinline__ unsigned long long rt() { return __builtin_amdgcn_s_memrealtime(); }
__device__ __forceinline__ unsigned f2bf(float f) { unsigned u = __builtin_bit_cast(unsigned, f); return (u + 0x7fffu + ((u >> 16) & 1u)) >> 16; }
__device__ __forceinline__ unsigned pk2(float lo, float hi) { return f2bf(lo) | (f2bf(hi) << 16); }

#define XB_TMO      128
#define XB_XCNT(j)  (256  + 64 * (j))
#define XB_XSUB(j)  (1280 + 64 * (j))
#define XB_XGEN(j)  (2304 + 64 * (j))
#define XB_TOP      3328
#define XB_TOPGEN   3392
#define XCD_BAR_WORDS 3456
#define XB_SPIN_CAP (1u << 18)

__device__ __forceinline__ unsigned xb_ld(unsigned* p)              { return __hip_atomic_load(p, __ATOMIC_RELAXED, __HIP_MEMORY_SCOPE_AGENT); }
__device__ __forceinline__ unsigned xb_add(unsigned* p, unsigned v) { return __hip_atomic_fetch_add(p, v, __ATOMIC_RELAXED, __HIP_MEMORY_SCOPE_AGENT); }
__device__ __forceinline__ unsigned xb_xcc_id() { return (unsigned)__builtin_amdgcn_s_getreg((3 << 11) | 20) & 0xFu; }
#define XB_SPIN(cond, bar) do { unsigned _sp = 0; while (cond) { __builtin_amdgcn_s_sleep(1); \
    if ((++_sp & 255u) == 0u) { if (xb_ld(&(bar)[XB_TMO])) break; if (_sp > XB_SPIN_CAP) { atomicAdd(&(bar)[XB_TMO], 1u); break; } } } } while (0)

struct XcdBarrier {
    unsigned* bar; unsigned x;
    volatile LAS unsigned* st;
};

__device__ __forceinline__ XcdBarrier xcd_barrier_post(unsigned* bar, volatile LAS unsigned* st) {
    XcdBarrier b; b.bar = bar; b.x = xb_xcc_id(); b.st = st;
    if (threadIdx.x == 0) (void)xb_add(&bar[XB_XCNT(b.x)], 1u);
    return b;
}
__device__ __forceinline__ void xcd_barrier_complete(unsigned* bar, unsigned x, unsigned& nloc, unsigned& nx) {
    const unsigned G = gridDim.x * gridDim.y * gridDim.z;
    unsigned sum, cnt, mine, sp = 0u;
    for (;;) {
        sum = 0u; cnt = 0u; mine = 0u;
#pragma unroll
        for (unsigned j = 0; j < 16; ++j) { const unsigned c = xb_ld(&bar[XB_XCNT(j)]); sum += c; cnt += (c > 0u) ? 1u : 0u; mine = (j == x) ? c : mine; }
        if (sum == G) break;
        __builtin_amdgcn_s_sleep(1);
        if ((++sp & 255u) == 0u) { if (xb_ld(&bar[XB_TMO])) break; if (sp > XB_SPIN_CAP) { atomicAdd(&bar[XB_TMO], 1u); break; } }
    }
    nloc = mine > 0u ? mine : 1u; nx = cnt > 0u ? cnt : 1u;
}

__device__ __forceinline__ void xcd_barrier(const XcdBarrier& b) {
    asm volatile("s_waitcnt vmcnt(0)" ::: "memory");
    __syncthreads();
    if (threadIdx.x == 0) {
        unsigned* bar = b.bar;
        __builtin_amdgcn_s_waitcnt(0);
        unsigned nloc = b.st[0], nx = b.st[1];
        if (nloc == 0u) { xcd_barrier_complete(bar, b.x, nloc, nx); b.st[0] = nloc; b.st[1] = nx; }
        const unsigned old = xb_add(&bar[XB_XSUB(b.x)], 1u);
        const unsigned gen = old / nloc;
        if (old + 1u == (gen + 1u) * nloc) {
            __builtin_amdgcn_fence(__ATOMIC_RELEASE, "agent");
            asm volatile("s_waitcnt vmcnt(0)" ::: "memory");
            const unsigned og = xb_add(&bar[XB_TOP], 1u);
            const unsigned tg = og / nx;
            if (og + 1u == (tg + 1u) * nx) xb_add(&bar[XB_TOPGEN], 1u);
            else XB_SPIN(xb_ld(&bar[XB_TOPGEN]) == tg, bar);
            __builtin_amdgcn_fence(__ATOMIC_ACQUIRE, "agent");
            xb_add(&bar[XB_XGEN(b.x)], 1u);
            asm volatile("s_waitcnt vmcnt(0)" ::: "memory");
        } else {
            XB_SPIN(xb_ld(&bar[XB_XGEN(b.x)]) == gen, bar);
            __builtin_amdgcn_fence(__ATOMIC_ACQUIRE, "agent");
            asm volatile("s_waitcnt vmcnt(0)" ::: "memory");
        }
    }
    __syncthreads();
}

constexpr int NWAVES = 8;
constexpr int T_TOK = 8192, DM = 2048, AW = 1024, SEQ = 2048, NHEAD = 8;
constexpr int NWA = 8192;
constexpr int NEXP = 16384;
constexpr float RMS_EPS = 1e-6f, LOG2E = 1.4426950408889634f;
constexpr float W8SCALE = 64.f;
constexpr float OC8SCALE = 8.f, WB8SCALE = 32.f;
constexpr float MG8SCALE = 16.f;
constexpr float QSCALE = 0.08838834764831845f * 1.4426950408889634f;

constexpr size_t MiB = 1u << 20;
constexpr size_t WS_CTL = 0, CTL_ZERO_BYTES = 1 * MiB;
constexpr size_t WS_WA = 2 * MiB;
constexpr size_t WS_WV = 34 * MiB;
constexpr size_t WS_WB = 38 * MiB;
constexpr size_t WS_WO = 46 * MiB;
constexpr size_t WS_WQ = 54 * MiB;
constexpr size_t WS_LWA = 62 * MiB;
constexpr size_t WS_LWX = 62 * MiB + 256 * 1024;
constexpr size_t WS_KEYS = 62 * MiB + 512 * 1024;
constexpr size_t WS_U8 = 64 * MiB;
constexpr size_t WS_V8 = 96 * MiB;
constexpr size_t WS_US = 128 * MiB;
constexpr size_t WS_VS = 128 * MiB + 65536;
constexpr size_t WS_HN = 192 * MiB;
constexpr size_t WS_X1B = WS_HN;
constexpr size_t WS_Q = 224 * MiB;
constexpr size_t WS_K = 240 * MiB;
constexpr size_t WS_VT = 256 * MiB;
constexpr size_t WS_XR = 272 * MiB;
constexpr size_t WS_GY = 288 * MiB;
constexpr size_t WS_SG = 304 * MiB;
constexpr size_t WS_QP = WS_SG;
constexpr size_t WS_OCAT = 368 * MiB;
constexpr size_t WS_HL = 400 * MiB;
constexpr size_t WS_AC = 432 * MiB;
constexpr size_t WS_TMP = WS_HL;
constexpr size_t WS_SUM = 464 * MiB;
constexpr size_t WS_MG = 466 * MiB;
constexpr size_t WS_SSP = 498 * MiB;
constexpr size_t WS_IDX = 500 * MiB;
constexpr size_t WS_G = 504 * MiB;
constexpr size_t WS_PD = WS_Q;
constexpr size_t WS_ACT = WS_VT;
constexpr size_t WS_OUTP = WS_HL;
constexpr size_t WS_END = 508 * MiB;
constexpr int CW_BAR = 4096;
constexpr int CW_XC = 12288;
constexpr int CW_Q2 = 8192;
constexpr int CW_KM = 65536;
static_assert((CW_KM + 32768) * 4 <= (int)CTL_ZERO_BYTES, "CTL");

constexpr int LDS_BYTES = 163840;
constexpr int MISC_OFF = 163840 - 256;
constexpr int SCR_BYTES = MISC_OFF;

typedef float f32x16 __attribute__((ext_vector_type(16)));
typedef float f32x2_t __attribute__((ext_vector_type(2)));
typedef __bf16 bf16x2_t __attribute__((ext_vector_type(2)));
typedef unsigned long long u64;
__device__ __forceinline__ float clamp8(float v) { return fminf(fmaxf(v, -448.f), 448.f); }
__device__ __forceinline__ unsigned cvtpk(float lo, float hi) { f32x2_t v = {lo, hi}; bf16x2_t b = __builtin_convertvector(v, bf16x2_t); return __builtin_bit_cast(unsigned, b); }
__device__ __forceinline__ float bf_lo(unsigned w) { return __builtin_bit_cast(float, w << 16); }
__device__ __forceinline__ float bf_hi(unsigned w) { return __builtin_bit_cast(float, w & 0xffff0000u); }
__device__ __forceinline__ f32x4 bf4_lo2(unsigned a, unsigned b) { f32x4 r; r[0] = bf_lo(a); r[1] = bf_hi(a); r[2] = bf_lo(b); r[3] = bf_hi(b); return r; }
__device__ __forceinline__ float wave_sum(float v) {
#pragma unroll
    for (int o = 1; o < 64; o <<= 1) v += __shfl_xor(v, o);
    return v;
}
__device__ __forceinline__ float dot2bf(unsigned a, unsigned b, float acc) { return __builtin_amdgcn_fdot2_f32_bf16(__builtin_bit_cast(bf16x2_t, a), __builtin_bit_cast(bf16x2_t, b), acc, false); }

struct Params {
    const float *x, *g_mix, *w_in, *conv_w, *conv_b, *lru_wa, *lru_ba, *lru_wx, *lru_bx, *lru_lam, *w_branch, *w_out, *rel_bias, *g_ffn, *peer_wq, *peer_keys, *peer_u, *peer_v, *g_fin;
    float* out; unsigned char* ws; int ph_lo, ph_hi;
};

template <bool F8 = false> __device__ __forceinline__ void tr_item(const float* W, int K, int N, bf16* dst_row0, int ldd, int k0, int n0, const float* kscale, LAS float* scr, int lane, float f8scale = 1.f) {
    f32x4 wv[8];
#pragma unroll
    for (int i = 0; i < 8; ++i) wv[i] = *(const f32x4*)(W + (size_t)(k0 + (lane >> 3) + 8 * i) * N + n0 + 4 * (lane & 7));
#pragma unroll
    for (int i = 0; i < 8; ++i) { const int kk = (lane >> 3) + 8 * i; f32x4 v = wv[i]; if (kscale) v = v * kscale[k0 + kk];
#pragma unroll
        for (int e = 0; e < 4; ++e) scr[kk * 33 + 4 * (lane & 7) + e] = v[e]; }
    LDS_WAIT(); asm volatile("" ::: "memory");
    const int c = lane & 7;
#pragma unroll
    for (int j = 0; j < 4; ++j) { const int n = (lane >> 3) + 8 * j; const LAS float* s = scr + (8 * c) * 33 + n;
        if (F8) {
            int p0 = __builtin_amdgcn_cvt_pk_fp8_f32(clamp8(s[0 * 33] * f8scale), clamp8(s[1 * 33] * f8scale), 0, false); p0 = __builtin_amdgcn_cvt_pk_fp8_f32(clamp8(s[2 * 33] * f8scale), clamp8(s[3 * 33] * f8scale), p0, true);
            int p1 = __builtin_amdgcn_cvt_pk_fp8_f32(clamp8(s[4 * 33] * f8scale), clamp8(s[5 * 33] * f8scale), 0, false); p1 = __builtin_amdgcn_cvt_pk_fp8_f32(clamp8(s[6 * 33] * f8scale), clamp8(s[7 * 33] * f8scale), p1, true);
            *(u64*)((unsigned char*)dst_row0 + (size_t)n * ldd + k0 + 8 * c) = (u64)(unsigned)p0 | ((u64)(unsigned)p1 << 32);
        } else {
        v4u o; o.x = cvtpk(s[0 * 33], s[1 * 33]); o.y = cvtpk(s[2 * 33], s[3 * 33]); o.z = cvtpk(s[4 * 33], s[5 * 33]); o.w = cvtpk(s[6 * 33], s[7 * 33]);
        *(v4u*)(dst_row0 + (size_t)n * ldd + k0 + 8 * c) = o; } }
    LDS_WAIT(); asm volatile("" ::: "memory");
}
template <int MODE> __device__ __forceinline__ void row_to_bf16(const float* src, bf16* dst, const float* colscale, int lane) {
    const f32x4* s = (const f32x4*)src + lane;
    f32x4 v[8]; float ss = 0.f;
#pragma unroll
    for (int j = 0; j < 8; ++j) { v[j] = s[64 * j]; ss += (v[j][0] * v[j][0] + v[j][1] * v[j][1]) + (v[j][2] * v[j][2] + v[j][3] * v[j][3]); }
    float rs = 1.f;
    if (MODE == 1) rs = __builtin_amdgcn_rsqf(wave_sum(ss) * (1.f / 2048.f) + RMS_EPS);
    u64* o8 = (u64*)dst + lane;
#pragma unroll
    for (int j = 0; j < 8; ++j) { f32x4 w = v[j] * rs; if (colscale) w = w * ((const f32x4*)colscale)[64 * j + lane];
        o8[64 * j] = (u64)cvtpk(w[0], w[1]) | ((u64)cvtpk(w[2], w[3]) << 32); }
}
template <bool I8> __device__ __forceinline__ void row_finish8(f32x4 (&v)[8], unsigned char* dst, float* scale_out, int lane) {
    float am = 0.f;
#pragma unroll
    for (int j = 0; j < 8; ++j) am = fmaxf(am, fmaxf(fmaxf(fabsf(v[j][0]), fabsf(v[j][1])), fmaxf(fabsf(v[j][2]), fabsf(v[j][3]))));
#pragma unroll
    for (int o = 1; o < 64; o <<= 1) am = fmaxf(am, __shfl_xor(am, o));
    const float qmax = I8 ? 127.f : 448.f;
    const float sc = am > 0.f ? am / qmax : 1.f, inv = 1.f / sc;
    unsigned* o4 = (unsigned*)(dst + (size_t)(lane >> 5) * NEXP * 128) + (lane & 31);
#pragma unroll
    for (int j = 0; j < 8; ++j) { unsigned w;
        if (I8) { const int q0 = (int)rintf(v[j][0] * inv), q1 = (int)rintf(v[j][1] * inv), q2 = (int)rintf(v[j][2] * inv), q3 = (int)rintf(v[j][3] * inv);
            w = (unsigned)(q0 & 255) | ((unsigned)(q1 & 255) << 8) | ((unsigned)(q2 & 255) << 16) | ((unsigned)q3 << 24); }
        else { int p = __builtin_amdgcn_cvt_pk_fp8_f32(v[j][0] * inv, v[j][1] * inv, 0, false); p = __builtin_amdgcn_cvt_pk_fp8_f32(v[j][2] * inv, v[j][3] * inv, p, true); w = (unsigned)p; }
        o4[(size_t)(2 * j) * NEXP * 32] = w; }
    if (lane == 0) *scale_out = sc;
}
template <bool I8> __device__ __forceinline__ void table_rows8(const float* src, unsigned char* dst, float* scales, const float* colscale, int r0, int r1, int wv, int nwv, int lane) {
    f32x4 cs[8];
#pragma unroll
    for (int j = 0; j < 8; ++j) cs[j] = colscale ? ((const f32x4*)colscale)[64 * j + lane] : (f32x4){1.f, 1.f, 1.f, 1.f};
    for (int m = r0 + wv; m < r1; m += 2 * nwv) {
        const int m2 = m + nwv; const bool two = m2 < r1;
        f32x4 va[8], vb[8];
#pragma unroll
        for (int j = 0; j < 8; ++j) va[j] = ((const f32x4*)(src + (size_t)m * DM))[64 * j + lane];
        if (two) {
#pragma unroll
            for (int j = 0; j < 8; ++j) vb[j] = ((const f32x4*)(src + (size_t)m2 * DM))[64 * j + lane]; }
#pragma unroll
        for (int j = 0; j < 8; ++j) va[j] = va[j] * cs[j];
        row_finish8<I8>(va, dst + (size_t)m * 128, scales + m, lane);
        if (two) {
#pragma unroll
            for (int j = 0; j < 8; ++j) vb[j] = vb[j] * cs[j];
            row_finish8<I8>(vb, dst + (size_t)m2 * 128, scales + m2, lane); }
    }
}
__device__ __forceinline__ void peer_tables(const Params& P, int r0, int r1, int wv, int nwv, int lane) {
    unsigned char* ws = P.ws; unsigned char* U8 = ws + WS_U8; unsigned char* V8 = ws + WS_V8; float* US = (float*)(ws + WS_US); float* VS = (float*)(ws + WS_VS);
    table_rows8<true>(P.peer_u, U8, US, P.g_ffn, r0, r1, wv, nwv, lane);
    table_rows8<false>(P.peer_v, V8, VS, nullptr, r0, r1, wv, nwv, lane);
}
__device__ __forceinline__ void p0_prologue(const Params& P, LAS unsigned char* lds, int gw, int NGW, int wave, int lane, int r1) {
    LAS float* scr = (LAS float*)(lds + wave * 16384);
    unsigned char* ws = P.ws;
    bf16* WA = (bf16*)(ws + WS_WA); bf16* WV = (bf16*)(ws + WS_WV); bf16* WB = (bf16*)(ws + WS_WB); bf16* WO = (bf16*)(ws + WS_WO); bf16* WQ = (bf16*)(ws + WS_WQ);
    bf16* LWA = (bf16*)(ws + WS_LWA); bf16* LWX = (bf16*)(ws + WS_LWX);
    constexpr int I_IN = 32 * 288, I_BR = 16 * 64, I_SQ = 32 * 64, I_L = 8 * 8;
    constexpr int NITEMS = I_IN + 2 * I_BR + 2 * I_SQ + 2 * I_L;
    for (int it = gw; it < NITEMS; it += NGW) {
        int r = it;
        if (r < I_IN) { const int kb = r / 288, nb = r % 288, n0 = 32 * nb;
            unsigned char* d = (n0 < 2048) ? (unsigned char*)WA + (size_t)n0 * 2048 : (n0 < 3072 ? (unsigned char*)WV + (size_t)(n0 - 2048) * 2048 : (unsigned char*)WA + (size_t)(n0 - 1024) * 2048);
            tr_item<true>(P.w_in, 2048, 9216, (bf16*)d, 2048, 64 * kb, n0, nullptr, scr, lane, W8SCALE); continue; } r -= I_IN;
        if (r < 2 * I_BR) { const int br = r / I_BR, q = r % I_BR, kb = q / 64, nb = q % 64;
            tr_item<true>(P.w_branch + (size_t)br * 1024 * 2048, 1024, 2048, (bf16*)((unsigned char*)WB + (size_t)(32 * nb) * 2048 + br * 1024), 2048, 64 * kb, 32 * nb, nullptr, scr, lane, WB8SCALE); continue; } r -= 2 * I_BR;
        if (r < I_SQ) { const int kb = r / 64, nb = r % 64; tr_item<true>(P.w_out, 2048, 2048, (bf16*)((unsigned char*)WO + (size_t)(32 * nb) * 2048), 2048, 64 * kb, 32 * nb, nullptr, scr, lane, W8SCALE); continue; } r -= I_SQ;
        if (r < I_SQ) { const int kb = r / 64, nb = r % 64; tr_item(P.peer_wq, 2048, 2048, WQ + (size_t)(32 * nb) * 2048, 2048, 64 * kb, 32 * nb, P.g_ffn, scr, lane); continue; } r -= I_SQ;
        { const int which = r / I_L, q = r % I_L, g = q / 8, kb = (q % 8) / 4, nb = q % 4;
          tr_item((which ? P.lru_wx : P.lru_wa) + (size_t)g * 16384, 128, 128, (which ? LWX : LWA) + (size_t)g * 16384 + (size_t)(32 * nb) * 128, 128, 64 * kb, 32 * nb, nullptr, scr, lane); }
    }
    { bf16* KB = (bf16*)(ws + WS_KEYS);
      for (int i = gw * 64 + lane; i < 262144 / 8; i += NGW * 64) { const f32x4 a = ((const f32x4*)P.peer_keys)[2 * i], b = ((const f32x4*)P.peer_keys)[2 * i + 1];
          v4u o; o.x = cvtpk(a[0], a[1]); o.y = cvtpk(a[2], a[3]); o.z = cvtpk(b[0], b[1]); o.w = cvtpk(b[2], b[3]); ((v4u*)KB)[i] = o; } }
    { bf16* HN = (bf16*)(ws + WS_HN);
      for (int m = gw; m < T_TOK; m += 2 * NGW) {
          const int m2 = m + NGW; const bool two = m2 < T_TOK;
          f32x4 va[8], vb[8]; float sa = 0.f, sb = 0.f;
#pragma unroll
          for (int j = 0; j < 8; ++j) va[j] = ((const f32x4*)(P.x + (size_t)m * DM))[64 * j + lane];
          if (two) {
#pragma unroll
              for (int j = 0; j < 8; ++j) vb[j] = ((const f32x4*)(P.x + (size_t)m2 * DM))[64 * j + lane]; }
#pragma unroll
          for (int j = 0; j < 8; ++j) sa += (va[j][0] * va[j][0] + va[j][1] * va[j][1]) + (va[j][2] * va[j][2] + va[j][3] * va[j][3]);
          const float ra = __builtin_amdgcn_rsqf(wave_sum(sa) * (1.f / 2048.f) + RMS_EPS);
          unsigned* oa = (unsigned*)((unsigned char*)HN + (size_t)m * DM) + lane;
#pragma unroll
          for (int j = 0; j < 8; ++j) { const f32x4 w = va[j] * ra * ((const f32x4*)P.g_mix)[64 * j + lane]; int p = __builtin_amdgcn_cvt_pk_fp8_f32(w[0], w[1], 0, false); p = __builtin_amdgcn_cvt_pk_fp8_f32(w[2], w[3], p, true); oa[64 * j] = (unsigned)p; }
          if (two) {
#pragma unroll
              for (int j = 0; j < 8; ++j) sb += (vb[j][0] * vb[j][0] + vb[j][1] * vb[j][1]) + (vb[j][2] * vb[j][2] + vb[j][3] * vb[j][3]);
              const float rb = __builtin_amdgcn_rsqf(wave_sum(sb) * (1.f / 2048.f) + RMS_EPS);
              unsigned* ob = (unsigned*)((unsigned char*)HN + (size_t)m2 * DM) + lane;
#pragma unroll
              for (int j = 0; j < 8; ++j) { const f32x4 w = vb[j] * rb * ((const f32x4*)P.g_mix)[64 * j + lane]; int p = __builtin_amdgcn_cvt_pk_fp8_f32(w[0], w[1], 0, false); p = __builtin_amdgcn_cvt_pk_fp8_f32(w[2], w[3], p, true); ob[64 * j] = (unsigned)p; } } } }
    peer_tables(P, 0, r1, gw, NGW, lane);
}

constexpr int AT_KT = 0, AT_VT = 2 * 17408, AT_KM = AT_VT + 2 * 18432, AT_B2 = AT_KM + 4096, AT_SEL = AT_B2 + 512, AT_ANY = AT_SEL + 1024;
#define MFMA32(a, b, c) __builtin_amdgcn_mfma_f32_32x32x16_bf16((a), (b), (c), 0, 0, 0)
__device__ __forceinline__ void attn_unit(const Params& P, LAS unsigned char* lds, int b, int h, int blk, int tid, int wave, int lane) {
    unsigned char* ws = P.ws;
    const bf16* Qb = (const bf16*)(ws + WS_Q); const bf16* Kb = (const bf16*)(ws + WS_K); const bf16* VTg = (const bf16*)(ws + WS_VT); bf16* OATT = (bf16*)(ws + WS_OCAT);
    const float* KMg = (const float*)(ws + WS_CTL) + CW_KM;
    LAS float* KMs = (LAS float*)(lds + AT_KM); LAS float* B2 = (LAS float*)(lds + AT_B2); LAS unsigned* SELM = (LAS unsigned*)(lds + AT_SEL); LAS unsigned* UANY = (LAS unsigned*)(lds + AT_ANY);
    const int row_blk0 = b * SEQ + blk * 256;
    __syncthreads();
    for (int i = tid; i < 1024; i += 512) KMs[i] = KMg[(size_t)(b * 8 + h) * 1024 + i] * (1.f / 256.f);
    if (tid < 128) { const int d = tid; int bucket = d;
        if (d >= 16) { bucket = 16 + (int)(__logf((float)d * (1.f / 16.f)) * (16.f / 2.0794415416798357f)); bucket = bucket > 31 ? 31 : bucket; }
        B2[d] = (P.rel_bias[bucket * 8 + h] - P.rel_bias[31 * 8 + h]) * LOG2E; }
    if (tid == 0) *UANY = 0u;
    __syncthreads();
    {
        const int qq = tid >> 1, q2 = tid & 1;
        unsigned mask = (1u << blk) - 1u;
        if (blk > 3) {
            const bf16* qrow = Qb + (size_t)(row_blk0 + qq) * AW + h * 128;
            v4u qv[8];
#pragma unroll
            for (int c8 = 0; c8 < 8; ++c8) qv[c8] = *(const v4u*)(qrow + 8 * (q2 + 2 * c8));
            float g0 = 0.f, g1 = 0.f, g2 = 0.f, g3 = 0.f, g4 = 0.f, g5 = 0.f, g6 = 0.f;
#pragma unroll
            for (int c8 = 0; c8 < 8; ++c8) { const float q[8] = {bf_lo(qv[c8].x), bf_hi(qv[c8].x), bf_lo(qv[c8].y), bf_hi(qv[c8].y), bf_lo(qv[c8].z), bf_hi(qv[c8].z), bf_lo(qv[c8].w), bf_hi(qv[c8].w)};
#pragma unroll
                for (int e = 0; e < 8; ++e) { const LAS float* km = KMs + 8 * (q2 + 2 * c8) + e;
                    g0 += q[e] * km[0]; g1 += q[e] * km[128]; g2 += q[e] * km[256]; g3 += q[e] * km[384]; g4 += q[e] * km[512]; g5 += q[e] * km[640]; g6 += q[e] * km[768]; } }
            g0 += __shfl_xor(g0, 1); g1 += __shfl_xor(g1, 1); g2 += __shfl_xor(g2, 1); g3 += __shfl_xor(g3, 1); g4 += __shfl_xor(g4, 1); g5 += __shfl_xor(g5, 1); g6 += __shfl_xor(g6, 1);
            const float NEGG = -3.0e38f;
            if (blk < 7) g6 = NEGG; if (blk < 6) g5 = NEGG; if (blk < 5) g4 = NEGG;
            mask = 0u;
#pragma unroll
            for (int s = 0; s < 3; ++s) { float best = g0; int bj = 0;
                if (g1 > best) { best = g1; bj = 1; } if (g2 > best) { best = g2; bj = 2; } if (g3 > best) { best = g3; bj = 3; }
                if (g4 > best) { best = g4; bj = 4; } if (g5 > best) { best = g5; bj = 5; } if (g6 > best) { best = g6; bj = 6; }
                mask |= 1u << bj;
                g0 = bj == 0 ? NEGG : g0; g1 = bj == 1 ? NEGG : g1; g2 = bj == 2 ? NEGG : g2; g3 = bj == 3 ? NEGG : g3; g4 = bj == 4 ? NEGG : g4; g5 = bj == 5 ? NEGG : g5; g6 = bj == 6 ? NEGG : g6; }
        }
        if (q2 == 0) { SELM[qq] = mask; __hip_atomic_fetch_or(UANY, mask, __ATOMIC_RELAXED, __HIP_MEMORY_SCOPE_WORKGROUP); }
    }
    __syncthreads();
    const unsigned uany = *UANY;
    unsigned blist = (unsigned)blk; int nb = 1;
    for (int j = blk - 1; j >= 0; --j) if ((uany >> j) & 1u) { blist |= (unsigned)j << (4 * nb); ++nb; }
    const int nsteps = 4 * nb;
    const int qi = 32 * wave + (lane & 31), hh = lane >> 5;
    const unsigned mymask = SELM[qi];
    bf16x8 Qf[8];
    { const bf16* qp = Qb + (size_t)(row_blk0 + qi) * AW + h * 128 + 8 * hh;
#pragma unroll
      for (int ks = 0; ks < 8; ++ks) Qf[ks] = *(const bf16x8*)(qp + 16 * ks); }
    float m_run = -1.0e30f, lsum = 0.f;
    f32x16 O[4];
#pragma unroll
    for (int dt = 0; dt < 4; ++dt)
#pragma unroll
        for (int r = 0; r < 16; ++r) O[dt][r] = 0.f;
    const int kkey0 = tid >> 4, kpart = tid & 15;
    const int vd0 = tid >> 3, vcc = tid & 7;
    const unsigned kl0 = kkey0 * 272 + kpart * 16, kl1 = kl0 + 32 * 272;
    const unsigned vl0 = vd0 * 144 + ((((vcc >> 2) * 2 + ((vcc & 3) >> 1)) * 2) * 16) + (vcc & 1) * 8, vl1 = vl0 + 64 * 144;
    v4u ka0, ka1, va0, va1, kb0, kb1, vb0, vb1;
#define AT_LOAD(s, k0, k1, v0, v1) do { const int j_ = (blist >> (4 * ((s) >> 2))) & 15, kt_ = (s) & 3; const size_t krow0 = (size_t)b * SEQ + j_ * 256 + kt_ * 64; \
        k0 = *(const v4u*)(Kb + (krow0 + kkey0) * AW + h * 128 + kpart * 8); k1 = *(const v4u*)(Kb + (krow0 + kkey0 + 32) * AW + h * 128 + kpart * 8); \
        v0 = *(const v4u*)(VTg + (size_t)(h * 128 + vd0) * T_TOK + krow0 + vcc * 8); v1 = *(const v4u*)(VTg + (size_t)(h * 128 + vd0 + 64) * T_TOK + krow0 + vcc * 8); } while (0)
#define AT_STORE(bufi, k0, k1, v0, v1) do { LAS unsigned char* KT_ = lds + AT_KT + (bufi) * 17408; LAS unsigned char* VT_ = lds + AT_VT + (bufi) * 18432; \
        *(LAS v4u*)(KT_ + kl0) = k0; *(LAS v4u*)(KT_ + kl1) = k1; \
        *(LAS u64*)(VT_ + vl0) = (u64)v0.x | ((u64)v0.y << 32); *(LAS u64*)(VT_ + vl0 + 16) = (u64)v0.z | ((u64)v0.w << 32); \
        *(LAS u64*)(VT_ + vl1) = (u64)v1.x | ((u64)v1.y << 32); *(LAS u64*)(VT_ + vl1 + 16) = (u64)v1.z | ((u64)v1.w << 32); } while (0)
    AT_LOAD(0, ka0, ka1, va0, va1); AT_STORE(0, ka0, ka1, va0, va1);
    if (1 < nsteps) AT_LOAD(1, ka0, ka1, va0, va1);
    if (2 < nsteps) AT_LOAD(2, kb0, kb1, vb0, vb1);
    for (int s = 0; s < nsteps; ++s) {
        const int j = (blist >> (4 * (s >> 2))) & 15, kt = s & 3;
        __syncthreads();
        if ((s & 1) == 0) { if (s + 1 < nsteps) AT_STORE((s + 1) & 1, ka0, ka1, va0, va1); if (s + 3 < nsteps) AT_LOAD(s + 3, ka0, ka1, va0, va1); }
        else              { if (s + 1 < nsteps) AT_STORE((s + 1) & 1, kb0, kb1, vb0, vb1); if (s + 3 < nsteps) AT_LOAD(s + 3, kb0, kb1, vb0, vb1); }
        const LAS unsigned char* KT = lds + AT_KT + (s & 1) * 17408; const LAS unsigned char* VTl = lds + AT_VT + (s & 1) * 18432;
        bool part;
        if (j == blk) part = (64 * kt <= 32 * wave + 31);
        else part = (__ballot((mymask >> j) & 1u) != 0ull);
        if (part) {
            f32x16 S0, S1;
#pragma unroll
            for (int r = 0; r < 16; ++r) { S0[r] = 0.f; S1[r] = 0.f; }
            const LAS unsigned char* kp = KT + (lane & 31) * 272 + hh * 16;
#pragma unroll
            for (int ks = 0; ks < 8; ++ks) { const bf16x8 a0 = *(const LAS bf16x8*)(kp + ks * 32), a1 = *(const LAS bf16x8*)(kp + 32 * 272 + ks * 32);
                S0 = MFMA32(a0, Qf[ks], S0); S1 = MFMA32(a1, Qf[ks], S1); }
            const bool sel = ((mymask >> j) & 1u) != 0u;
            float mx = -1.0e30f; bool ok_row = true;
            const int dmin = 32 * wave + 256 * (blk - j) - 64 * kt - 63;
            if (dmin < 113) {
                const int dbase = (j == blk) ? (qi - 64 * kt - 4 * hh) : (qi + 256 - 64 * kt - 4 * hh);
                const bool okrow = (j == blk) ? true : sel;
#pragma unroll
                for (int r = 0; r < 16; ++r) { const int kk = (r & 3) + 8 * (r >> 2);
                    { const int dist = dbase - kk; const int di = dist < 0 ? 0 : (dist > 127 ? 127 : dist); const float v = (okrow && dist >= 0) ? S0[r] + B2[di] : -1.0e30f; S0[r] = v; mx = fmaxf(mx, v); }
                    { const int dist = dbase - 32 - kk; const int di = dist < 0 ? 0 : (dist > 127 ? 127 : dist); const float v = (okrow && dist >= 0) ? S1[r] + B2[di] : -1.0e30f; S1[r] = v; mx = fmaxf(mx, v); } }
            } else {
                ok_row = sel || (j == blk);
#pragma unroll
                for (int r = 0; r < 16; ++r) mx = fmaxf(mx, fmaxf(S0[r], S1[r]));
                mx = ok_row ? mx : -1.0e30f;
            }
            mx = fmaxf(mx, __shfl_xor(mx, 32));
            const bool need = mx > m_run + 8.f;
            if (__any(need)) { const float m_new = need ? mx : m_run, alpha = __builtin_amdgcn_exp2f(m_run - m_new);
                m_run = m_new; lsum *= alpha;
#pragma unroll
                for (int dt = 0; dt < 4; ++dt)
#pragma unroll
                    for (int r = 0; r < 16; ++r) O[dt][r] *= alpha; }
            float ps = 0.f;
            const float m_eff = ok_row ? m_run : 1.0e30f;
#pragma unroll
            for (int r = 0; r < 16; ++r) { S0[r] = __builtin_amdgcn_exp2f(S0[r] - m_eff); S1[r] = __builtin_amdgcn_exp2f(S1[r] - m_eff); ps += S0[r] + S1[r]; }
            lsum += ps;
            bf16x8 Pf[2][2];
#pragma unroll
            for (int s2 = 0; s2 < 2; ++s2) {
                v4u p0, p1;
                p0.x = cvtpk(S0[8 * s2], S0[8 * s2 + 1]); p0.y = cvtpk(S0[8 * s2 + 2], S0[8 * s2 + 3]); p0.z = cvtpk(S0[8 * s2 + 4], S0[8 * s2 + 5]); p0.w = cvtpk(S0[8 * s2 + 6], S0[8 * s2 + 7]);
                p1.x = cvtpk(S1[8 * s2], S1[8 * s2 + 1]); p1.y = cvtpk(S1[8 * s2 + 2], S1[8 * s2 + 3]); p1.z = cvtpk(S1[8 * s2 + 4], S1[8 * s2 + 5]); p1.w = cvtpk(S1[8 * s2 + 6], S1[8 * s2 + 7]);
                Pf[0][s2] = __builtin_bit_cast(bf16x8, p0); Pf[1][s2] = __builtin_bit_cast(bf16x8, p1); }
            const LAS unsigned char* vp = VTl + (lane & 31) * 144 + hh * 16;
#pragma unroll
            for (int dt = 0; dt < 4; ++dt)
#pragma unroll
                for (int mt = 0; mt < 2; ++mt)
#pragma unroll
                    for (int s2 = 0; s2 < 2; ++s2) { const bf16x8 a = *(const LAS bf16x8*)(vp + dt * 32 * 144 + (mt * 2 + s2) * 32); O[dt] = MFMA32(a, Pf[mt][s2], O[dt]); }
        }
    }
#undef AT_LOAD
#undef AT_STORE
    const float ltot = lsum + __shfl_xor(lsum, 32), inv = 1.f / ltot;
    unsigned char* orow = (unsigned char*)OATT + (size_t)(row_blk0 + qi) * DM + h * 128 + 4 * hh;
    const float osc = inv * OC8SCALE;
#pragma unroll
    for (int dt = 0; dt < 4; ++dt)
#pragma unroll
        for (int g4 = 0; g4 < 4; ++g4) { int p = __builtin_amdgcn_cvt_pk_fp8_f32(clamp8(O[dt][4 * g4] * osc), clamp8(O[dt][4 * g4 + 1] * osc), 0, false); p = __builtin_amdgcn_cvt_pk_fp8_f32(clamp8(O[dt][4 * g4 + 2] * osc), clamp8(O[dt][4 * g4 + 3] * osc), p, true);
            *(unsigned*)(orow + 32 * dt + 8 * g4) = (unsigned)p; }
}

constexpr int LR_XC = 0, LR_SEG = 2 * 17408, LR_W = LR_SEG + 2 * 4096;
#define MFMA16(a, b, c) __builtin_amdgcn_mfma_f32_16x16x32_bf16((a), (b), (c), 0, 0, 0)
__device__ __forceinline__ void lru_pair(const Params& P, LAS unsigned char* lds, int pair, int tid, int wave, int lane, unsigned* tkword, int& tk_next) {
    unsigned char* ws = P.ws;
    const int grp = wave >> 2, wq = wave & 3, tg = tid & 255;
    const int unit = 2 * pair + grp, b = unit >> 8, g = (unit >> 5) & 7, c = unit & 31;
    const bf16* XR = (const bf16*)(ws + WS_XR); const bf16* LWA = (const bf16*)(ws + WS_LWA) + (size_t)g * 16384; const bf16* LWX = (const bf16*)(ws + WS_LWX) + (size_t)g * 16384;
    float* HL = (float*)(ws + WS_HL); float* AC = (float*)(ws + WS_AC); float* SUM = (float*)(ws + WS_SUM);
    LAS unsigned short* XC = (LAS unsigned short*)(lds + LR_XC + grp * 17408);
    LAS float* SEG = (LAS float*)(lds + LR_SEG + grp * 4096);
    LAS unsigned char* WL = lds + LR_W;
    const int t0 = c * 64; const size_t R0 = (size_t)b * SEQ + t0;
    __syncthreads();
    {
      v4u wv[8];
#pragma unroll
      for (int i = 0; i < 8; ++i) { const int q = tid + 512 * i, mat = q >> 11, row = (q >> 4) & 127, part = q & 15; wv[i] = *(const v4u*)((mat ? LWX : LWA) + row * 128 + part * 8); }
      const int cpart = tg & 15, C8 = g * 128 + 8 * cpart;
      f32x4 cw[4][2], cbv[2];
#pragma unroll
      for (int w = 0; w < 4; ++w) { cw[w][0] = *(const f32x4*)(P.conv_w + w * 1024 + C8); cw[w][1] = *(const f32x4*)(P.conv_w + w * 1024 + C8 + 4); }
      cbv[0] = *(const f32x4*)(P.conv_b + C8); cbv[1] = *(const f32x4*)(P.conv_b + C8 + 4);
#define LR_CONV_LOAD(xr, base) do { _Pragma("unroll") for (int i2 = 0; i2 < 2; ++i2) { const int tl = (tg >> 4) + 16 * ((base) + i2); \
          _Pragma("unroll") for (int w = 0; w < 4; ++w) { const int ts = t0 + tl - 3 + w; xr[i2][w] = (ts >= 0) ? *(const v4u*)(XR + ((size_t)b * SEQ + ts) * AW + C8) : (v4u){0u, 0u, 0u, 0u}; } } } while (0)
#define LR_CONV_DO(xr, base) do { _Pragma("unroll") for (int i2 = 0; i2 < 2; ++i2) { const int tl = (tg >> 4) + 16 * ((base) + i2); f32x4 y0 = cbv[0], y1 = cbv[1]; \
          _Pragma("unroll") for (int w = 0; w < 4; ++w) { y0 = y0 + bf4_lo2(xr[i2][w].x, xr[i2][w].y) * cw[w][0]; y1 = y1 + bf4_lo2(xr[i2][w].z, xr[i2][w].w) * cw[w][1]; } \
          v4u o; o.x = cvtpk(y0[0], y0[1]); o.y = cvtpk(y0[2], y0[3]); o.z = cvtpk(y1[0], y1[1]); o.w = cvtpk(y1[2], y1[3]); \
          *(LAS v4u*)((LAS unsigned char*)XC + tl * 272 + cpart * 16) = o; } } while (0)
      { v4u xr[2][4]; LR_CONV_LOAD(xr, 0);
#pragma unroll
        for (int i = 0; i < 8; ++i) { const int q = tid + 512 * i, mat = q >> 11, row = (q >> 4) & 127, part = q & 15; *(LAS v4u*)(WL + (mat * 128 + row) * 272 + part * 16) = wv[i]; }
        LR_CONV_DO(xr, 0); }
      { v4u xr[2][4]; LR_CONV_LOAD(xr, 2); LR_CONV_DO(xr, 2); }
#undef LR_CONV_LOAD
#undef LR_CONV_DO
    }
    __syncthreads();
    if (tid == 0) tk_next = (int)__hip_atomic_fetch_add(tkword, 1u, __ATOMIC_RELAXED, __HIP_MEMORY_SCOPE_AGENT);
    const int fr = lane & 15, fq = lane >> 4;
    float Ar[2][4][4], Hr[2][4][4], AE[2][4], HE[2][4];
#pragma unroll
    for (int nh = 0; nh < 2; ++nh) {
        f32x4 aA[4], aX[4];
#pragma unroll
        for (int nt = 0; nt < 4; ++nt) { aA[nt] = (f32x4){0.f, 0.f, 0.f, 0.f}; aX[nt] = (f32x4){0.f, 0.f, 0.f, 0.f}; }
#pragma unroll 1
        for (int ks = 0; ks < 4; ++ks) { const bf16x8 a = *(const LAS bf16x8*)((LAS unsigned char*)XC + (16 * wq + fr) * 272 + (32 * ks + 8 * fq) * 2);
#pragma unroll
            for (int nt = 0; nt < 4; ++nt) { const int wo = (64 * nh + 16 * nt + fr) * 272 + (32 * ks + 8 * fq) * 2;
                const bf16x8 ba = *(const LAS bf16x8*)(WL + wo), bx = *(const LAS bf16x8*)(WL + 128 * 272 + wo);
                aA[nt] = MFMA16(a, ba, aA[nt]); aX[nt] = MFMA16(a, bx, aX[nt]); } }
#pragma unroll
        for (int nt = 0; nt < 4; ++nt) { const int ch = 64 * nh + 16 * nt + fr, C = g * 128 + ch;
            const float ba = P.lru_ba[C], bx = P.lru_bx[C], lam = P.lru_lam[C];
            const float sp8 = 8.f * log1pf(__expf(-lam));
            float Ac = 1.f, Hc = 0.f;
#pragma unroll
            for (int r = 0; r < 4; ++r) { const int tok = 16 * wq + 4 * fq + r;
                const float rg = pg8::sigmoid_f(aA[nt][r] + ba), ig = pg8::sigmoid_f(aX[nt][r] + bx);
                const float log_a = -rg * sp8, a = __builtin_amdgcn_exp2f(log_a * 1.4426950408889634f);
                const float y = 2.f * log_a;
                const float em = (y > -0.25f) ? -y * (1.f + y * (0.5f + y * (0.16666667f + y * (0.041666668f + y * (0.0083333338f + y * 0.0013888889f))))) : 1.f - a * a;
                const float u = __builtin_amdgcn_sqrtf(em) * (ig * bf_lo((unsigned)XC[tok * 136 + ch]));
                Hc = a * Hc + u; Ac *= a; Ar[nh][nt][r] = Ac; Hr[nh][nt][r] = Hc; }
            float AI = Ac, HI = Hc;
            { const float Ap = __shfl_up(AI, 16), Hp = __shfl_up(HI, 16); if (fq >= 1) { HI = AI * Hp + HI; AI = AI * Ap; } }
            { const float Ap = __shfl_up(AI, 32), Hp = __shfl_up(HI, 32); if (fq >= 2) { HI = AI * Hp + HI; AI = AI * Ap; } }
            { const float Ap = __shfl_up(AI, 16), Hp = __shfl_up(HI, 16); AE[nh][nt] = fq >= 1 ? Ap : 1.f; HE[nh][nt] = fq >= 1 ? Hp : 0.f; }
            if (fq == 3) { SEG[(wq * 128 + ch) * 2] = AI; SEG[(wq * 128 + ch) * 2 + 1] = HI; } }
    }
    __syncthreads();
#pragma unroll
    for (int nh = 0; nh < 2; ++nh)
#pragma unroll
        for (int nt = 0; nt < 4; ++nt) { const int ch = 64 * nh + 16 * nt + fr, C = g * 128 + ch;
            float Aw = 1.f, Hw = 0.f;
#pragma unroll
            for (int w2 = 0; w2 < 3; ++w2) if (w2 < wq) { const float As = SEG[(w2 * 128 + ch) * 2], Hs = SEG[(w2 * 128 + ch) * 2 + 1]; Hw = As * Hw + Hs; Aw *= As; }
            const float hin = AE[nh][nt] * Hw + HE[nh][nt], ain = AE[nh][nt] * Aw;
            float* hl = HL + (R0 + 16 * wq + 4 * fq) * AW + C; float* ac = AC + (R0 + 16 * wq + 4 * fq) * AW + C;
#pragma unroll
            for (int r = 0; r < 4; ++r) { hl[(size_t)r * AW] = Ar[nh][nt][r] * hin + Hr[nh][nt][r]; ac[(size_t)r * AW] = Ar[nh][nt][r] * ain; }
            if (wq == 3 && fq == 3) { float* sm = SUM + ((size_t)(b * 32 + c) * 1024 + C) * 2; sm[0] = Ar[nh][nt][3] * ain; sm[1] = Ar[nh][nt][3] * hin + Hr[nh][nt][3]; } }
}

constexpr int SC_STR = 129, P7_SAB = 2 * 128 * SC_STR * 4, P7_IL = P7_SAB + 128 * 33 * 4, P7_CT = P7_IL + 128 * 34 * 2;
static_assert(P7_CT + 64 <= MISC_OFF, "P7 LDS map");
__device__ __forceinline__ unsigned ord_key(float v) { const unsigned u = __builtin_bit_cast(unsigned, v); return (u & 0x80000000u) ? ~u : (u | 0x80000000u); }
#define CE_DESC(x, y) do { const unsigned _x = (x), _y = (y); (x) = _x > _y ? _x : _y; (y) = _x > _y ? _y : _x; } while (0)
template <int B, int NA> __device__ __forceinline__ void sort16_desc(unsigned (&a)[NA]) {
#pragma unroll
    for (int k = 2; k <= 16; k <<= 1)
#pragma unroll
        for (int j = k >> 1; j > 0; j >>= 1)
#pragma unroll
            for (int i = 0; i < 16; ++i) { const int l = i ^ j; if (l > i) { if ((i & k) == 0) CE_DESC(a[B + i], a[B + l]); else CE_DESC(a[B + l], a[B + i]); } }
}
template <int A, int Bo, int NA, int NB> __device__ __forceinline__ void merge16_desc(unsigned (&a)[NA], const unsigned (&b)[NB]) {
#pragma unroll
    for (int i = 0; i < 16; ++i) a[A + i] = a[A + i] > b[Bo + 15 - i] ? a[A + i] : b[Bo + 15 - i];
#pragma unroll
    for (int j = 8; j > 0; j >>= 1)
#pragma unroll
        for (int i = 0; i < 16; ++i) { const int l = i ^ j; if (l > i) CE_DESC(a[A + i], a[A + l]); }
}
__device__ __forceinline__ void peer_topk_unit(const Params& P, LAS unsigned char* lds, int t0, int h, int tid, int wave, int lane) {
    unsigned char* ws = P.ws;
    const bf16* QP = (const bf16*)(ws + WS_QP); const bf16* KEYS = (const bf16*)(ws + WS_KEYS);
    int* IDX = (int*)(ws + WS_IDX); float* GW = (float*)(ws + WS_G);
    LAS float* SC = (LAS float*)lds; LAS float* SAB = (LAS float*)(lds + P7_SAB); LAS unsigned short* IL = (LAS unsigned short*)(lds + P7_IL); LAS unsigned char* CT = lds + P7_CT;
    __syncthreads();
    if (tid < 64) { int ia = 0, rem = tid; while (ia < 16 && rem >= 16 / (ia + 1)) { rem -= 16 / (ia + 1); ++ia; }
        CT[tid] = (unsigned char)(ia < 16 ? ia * 16 + rem : 255); }
    { const int mtile = wave & 3, c = wave >> 2, r31 = lane & 31, hh = lane >> 5;
      bf16x8 A[8];
      const bf16* qp = QP + (size_t)(t0 + 32 * mtile + r31) * DM + h * 256 + c * 128 + 8 * hh;
#pragma unroll
      for (int ks = 0; ks < 8; ++ks) A[ks] = *(const bf16x8*)(qp + 16 * ks);
#pragma unroll
      for (int nt = 0; nt < 4; ++nt) { f32x16 acc;
#pragma unroll
          for (int r = 0; r < 16; ++r) acc[r] = 0.f;
          const bf16* kp = KEYS + ((size_t)((h * 2 + c) * 128 + 32 * nt + r31)) * 128 + 8 * hh;
#pragma unroll
          for (int ks = 0; ks < 8; ++ks) { const bf16x8 bk = *(const bf16x8*)(kp + 16 * ks); acc = MFMA32(A[ks], bk, acc); }
#pragma unroll
          for (int r = 0; r < 16; ++r) { const int tok = 32 * mtile + (r & 3) + 8 * (r >> 2) + 4 * hh; SC[(c * 128 + tok) * SC_STR + 32 * nt + r31] = acc[r]; } } }
    __syncthreads();
    const int half = tid & 1, c = (tid >> 1) & 1, tok = tid >> 2;
    unsigned a[64];
    { const LAS float* sp = SC + (c * 128 + tok) * SC_STR + half * 64; const int rot = 8 * (2 * c + half);
#pragma unroll
      for (int i = 0; i < 64; ++i) { const int n = (i + rot) & 63; a[i] = (ord_key(sp[n]) & ~127u) | (unsigned)(127 - (half * 64 + n)); } }
    sort16_desc<0>(a); sort16_desc<16>(a); sort16_desc<32>(a); sort16_desc<48>(a);
    merge16_desc<0, 16>(a, a); merge16_desc<32, 48>(a, a); merge16_desc<0, 32>(a, a);
    { unsigned o[16];
#pragma unroll
      for (int j = 0; j < 16; ++j) o[j] = (unsigned)__shfl_xor((int)a[j], 1);
      merge16_desc<0, 0>(a, o); }
    if (half == 0) {
#pragma unroll
        for (int j = 0; j < 16; ++j) { const int n = 127 - (int)(a[j] & 127u); SAB[tok * 33 + c * 16 + j] = SC[(c * 128 + tok) * SC_STR + n]; IL[tok * 34 + c * 16 + j] = (unsigned short)n; } }
    __syncthreads();
    const int q = tid & 3;
    unsigned cd[16];
#pragma unroll
    for (int j = 0; j < 13; ++j) { const unsigned code = CT[q + 4 * j]; const float s = SAB[tok * 33 + ((code >> 4) & 15u)] + SAB[tok * 33 + 16 + (code & 15u)];
        cd[j] = code == 255u ? 0u : ((ord_key(s) & ~255u) | (255u - code)); }
    cd[13] = 0u; cd[14] = 0u; cd[15] = 0u;
    sort16_desc<0>(cd);
    { unsigned o[16];
#pragma unroll
      for (int j = 0; j < 16; ++j) o[j] = (unsigned)__shfl_xor((int)cd[j], 1);
      merge16_desc<0, 0>(cd, o);
#pragma unroll
      for (int j = 0; j < 16; ++j) o[j] = (unsigned)__shfl_xor((int)cd[j], 2);
      merge16_desc<0, 0>(cd, o); }
    if (q == 0) {
        float cv[16]; int id[16];
#pragma unroll
        for (int s = 0; s < 16; ++s) { const unsigned code = 255u - (cd[s] & 255u); const int ia = (int)(code >> 4), ib = (int)(code & 15u); const int na = IL[tok * 34 + ia], nb = IL[tok * 34 + 16 + ib];
            cv[s] = SAB[tok * 33 + ia] + SAB[tok * 33 + 16 + ib]; id[s] = na * 128 + nb; }
        float mx = cv[0];
#pragma unroll
        for (int s = 1; s < 16; ++s) mx = fmaxf(mx, cv[s]);
        float sum = 0.f;
#pragma unroll
        for (int s = 0; s < 16; ++s) { cv[s] = __builtin_amdgcn_exp2f((cv[s] - mx) * LOG2E); sum += cv[s]; }
        const float inv = 1.f / sum;
        int* ip = IDX + (size_t)(t0 + tok) * 128 + h * 16; float* gp = GW + (size_t)(t0 + tok) * 128 + h * 16;
#pragma unroll
        for (int s4 = 0; s4 < 4; ++s4) { *(int4*)(ip + 4 * s4) = make_int4(id[4 * s4], id[4 * s4 + 1], id[4 * s4 + 2], id[4 * s4 + 3]);
            *(f32x4*)(gp + 4 * s4) = (f32x4){cv[4 * s4] * inv, cv[4 * s4 + 1] * inv, cv[4 * s4 + 2] * inv, cv[4 * s4 + 3] * inv}; }
    }
}

__device__ __forceinline__ void fp8x16_to_f32(const v4u& w, float (&f)[16]) {
#pragma unroll
    for (int i = 0; i < 4; ++i) { const f32x2_t lo = __builtin_amdgcn_cvt_pk_f32_fp8((int)w[i], false), hi = __builtin_amdgcn_cvt_pk_f32_fp8((int)w[i], true);
        f[4 * i] = lo[0]; f[4 * i + 1] = lo[1]; f[4 * i + 2] = hi[0]; f[4 * i + 3] = hi[1]; }
}
#define LD16I(dst, p) do { _Pragma("unroll") for (int q_ = 0; q_ < 4; ++q_) { const int4 v_ = ((const int4*)(p))[q_]; dst[4 * q_] = v_.x; dst[4 * q_ + 1] = v_.y; dst[4 * q_ + 2] = v_.z; dst[4 * q_ + 3] = v_.w; } } while (0)
#define LD16F(dst, p) do { _Pragma("unroll") for (int q_ = 0; q_ < 4; ++q_) { const f32x4 v_ = ((const f32x4*)(p))[q_]; dst[4 * q_] = v_[0]; dst[4 * q_ + 1] = v_[1]; dst[4 * q_ + 2] = v_[2]; dst[4 * q_ + 3] = v_[3]; } } while (0)
__device__ __forceinline__ void peer_u_phase(const Params& P, int xg, int slot, int nslots, int lane) {
    unsigned char* ws = P.ws;
    const bf16* X1B = (const bf16*)(ws + WS_X1B); const unsigned char* U8 = ws + WS_U8; const int* IDX = (const int*)(ws + WS_IDX); float* PD = (float*)(ws + WS_PD) + (size_t)xg * T_TOK * 128;
    const int ntok = slot < T_TOK ? (T_TOK - slot + nslots - 1) / nslots : 0, N = 2 * ntok;
    if (N == 0) return;
    const int R = lane >> 3, p = lane & 7;
    const bool b2 = (lane & 4) != 0, b1 = (lane & 2) != 0, b0 = (lane & 1) != 0;
    int idn[16], idq[16]; v4u xc[2], xn[2]; v4u B0[8], B1[8], B2[8];
#define U_ITEM(n, t, s) const int n_##t = (n) < N ? (n) : N - 1; const int t = slot + (n_##t >= ntok ? n_##t - ntok : n_##t) * nslots, s = 2 * xg + (n_##t >= ntok ? 1 : 0)
#define U_ROWS(buf, ids, off, s) do { const unsigned char* ub_ = U8 + (size_t)(s) * NEXP * 128; _Pragma("unroll") for (int i = 0; i < 8; ++i) buf[i] = *(const v4u*)(ub_ + (unsigned)(((unsigned)ids[(off) + i] << 7) + 16u * p)); } while (0)
#define U_HALF(buf, off) do { _Pragma("unroll") for (int i = 0; i < 8; ++i) { int d = 0; _Pragma("unroll") for (int w = 0; w < 4; ++w) d = __builtin_amdgcn_sdot4((int)buf[i][w], xq[w], d, false); part[(off) + i] = d; } } while (0)
    { U_ITEM(0, t0, s0); U_ITEM(1, t1, s1);
      int id0[16];
#pragma unroll
      LD16I(id0, IDX + (size_t)t0 * 128 + 16 * R); LD16I(idn, IDX + (size_t)t1 * 128 + 16 * R);
      const bf16* xp = X1B + (size_t)t0 * DM + 128 * s0 + 16 * p; xc[0] = *(const v4u*)xp; xc[1] = *(const v4u*)(xp + 8);
      U_ROWS(B0, id0, 0, s0); U_ROWS(B1, id0, 8, s0); }
#define U_BODY(n, Ba, Bb, Bc) do { \
        U_ITEM(n, t, s); U_ITEM((n) + 1, t1, s1); U_ITEM((n) + 2, t2, s2); (void)s; (void)s2; \
        U_ROWS(Bc, idn, 0, s1); \
        LD16I(idq, IDX + (size_t)t2 * 128 + 16 * R); \
        { const bf16* xp = X1B + (size_t)t1 * DM + 128 * s1 + 16 * p; xn[0] = *(const v4u*)xp; xn[1] = *(const v4u*)(xp + 8); } \
        float x[16]; float am = 0.f; \
        _Pragma("unroll") for (int k = 0; k < 4; ++k) { x[2 * k] = bf_lo(xc[0][k]); x[2 * k + 1] = bf_hi(xc[0][k]); x[8 + 2 * k] = bf_lo(xc[1][k]); x[8 + 2 * k + 1] = bf_hi(xc[1][k]); } \
        _Pragma("unroll") for (int k = 0; k < 16; ++k) am = fmaxf(am, fabsf(x[k])); \
        am = fmaxf(am, __shfl_xor(am, 1)); am = fmaxf(am, __shfl_xor(am, 2)); am = fmaxf(am, __shfl_xor(am, 4)); \
        const float xs = am > 0.f ? am * (1.f / 127.f) : 1.f, xinv = 1.f / xs; \
        int xq[4]; \
        _Pragma("unroll") for (int w = 0; w < 4; ++w) { const int q0 = (int)rintf(x[4 * w] * xinv), q1 = (int)rintf(x[4 * w + 1] * xinv), q2 = (int)rintf(x[4 * w + 2] * xinv), q3 = (int)rintf(x[4 * w + 3] * xinv); \
            xq[w] = (int)((unsigned)(q0 & 255) | ((unsigned)(q1 & 255) << 8) | ((unsigned)(q2 & 255) << 16) | ((unsigned)q3 << 24)); } \
        int part[16]; \
        U_HALF(Ba, 0); \
        U_ROWS(Ba, idn, 8, s1); \
        U_HALF(Bb, 8); \
        if ((n) < N) { \
            int a8[8], a4[4], a2i[2]; \
            _Pragma("unroll") for (int k = 0; k < 8; ++k) { const int send = b2 ? part[k] : part[k + 8], keep = b2 ? part[k + 8] : part[k]; a8[k] = keep + __shfl_xor(send, 4); } \
            _Pragma("unroll") for (int k = 0; k < 4; ++k) { const int send = b1 ? a8[k] : a8[k + 4], keep = b1 ? a8[k + 4] : a8[k]; a4[k] = keep + __shfl_xor(send, 2); } \
            _Pragma("unroll") for (int k = 0; k < 2; ++k) { const int send = b0 ? a4[k] : a4[k + 2], keep = b0 ? a4[k + 2] : a4[k]; a2i[k] = keep + __shfl_xor(send, 1); } \
            const float a2[2] = {(float)a2i[0] * xs, (float)a2i[1] * xs}; \
            const int i0 = (b2 ? 8 : 0) + (b1 ? 4 : 0) + (b0 ? 2 : 0); \
            f32x2_t* pp = (f32x2_t*)(PD + (size_t)t * 128 + 16 * R + i0); \
            f32x2_t pv_ = (f32x2_t){a2[0], a2[1]}; if ((n) >= ntok) pv_ = pv_ + *pp; \
            *pp = pv_; } \
        _Pragma("unroll") for (int i = 0; i < 16; ++i) idn[i] = idq[i]; \
        xc[0] = xn[0]; xc[1] = xn[1]; } while (0)
    for (int n = 0; n < N; n += 3) { U_BODY(n, B0, B1, B2); U_BODY(n + 1, B2, B0, B1); U_BODY(n + 2, B1, B2, B0); }
#undef U_ITEM
#undef U_ROWS
#undef U_HALF
#undef U_BODY
}
__device__ __forceinline__ void peer_act_tokens(const Params& P, int t, int t2, int lane) {
    unsigned char* ws = P.ws;
    const float* PD = (const float*)(ws + WS_PD); const int* IDX = (const int*)(ws + WS_IDX); const float* GW = (const float*)(ws + WS_G); const float* SSP = (const float*)(ws + WS_SSP);
    const float* US = (const float*)(ws + WS_US); const float* VS = (const float*)(ws + WS_VS); float* ACT = (float*)(ws + WS_ACT);
    const bool two = t2 >= 0; const int tt[2] = {t, two ? t2 : t};
    float ss[2], d[2][2], gw[2][2], us[2][2], vs[2][2]; int id[2][2];
#pragma unroll
    for (int k = 0; k < 2; ++k) { ss[k] = lane < 32 ? SSP[(size_t)tt[k] * 32 + lane] : 0.f;
#pragma unroll
        for (int s = 0; s < 2; ++s) { const int slot = 64 * s + lane; id[k][s] = IDX[(size_t)tt[k] * 128 + slot]; gw[k][s] = GW[(size_t)tt[k] * 128 + slot]; float a = 0.f;
#pragma unroll
            for (int xg = 0; xg < 8; ++xg) a += PD[((size_t)xg * T_TOK + tt[k]) * 128 + slot];
            d[k][s] = a; } }
#pragma unroll
    for (int k = 0; k < 2; ++k)
#pragma unroll
        for (int s = 0; s < 2; ++s) { us[k][s] = US[id[k][s]]; vs[k][s] = VS[id[k][s]]; }
#pragma unroll
    for (int k = 0; k < 2; ++k) { const float rs = __builtin_amdgcn_rsqf(wave_sum(ss[k]) * (1.f / 2048.f) + RMS_EPS);
        if (k == 0 || two) {
#pragma unroll
            for (int s = 0; s < 2; ++s) ACT[(size_t)tt[k] * 128 + 64 * s + lane] = pg8::gelu_tanh_f(d[k][s] * us[k][s] * rs) * gw[k][s] * vs[k][s]; } }
}
#define PIN16(a) asm volatile("" : "+v"(a[0]), "+v"(a[1]), "+v"(a[2]), "+v"(a[3]), "+v"(a[4]), "+v"(a[5]), "+v"(a[6]), "+v"(a[7]), "+v"(a[8]), "+v"(a[9]), "+v"(a[10]), "+v"(a[11]), "+v"(a[12]), "+v"(a[13]), "+v"(a[14]), "+v"(a[15]))
__device__ __forceinline__ void peer_v_phase(const Params& P, int xg, int slot, int nslots, int lane) {
    unsigned char* ws = P.ws;
    const unsigned char* V8 = ws + WS_V8; const int* IDX = (const int*)(ws + WS_IDX); const float* ACT = (const float*)(ws + WS_ACT); bf16* OUTP = (bf16*)(ws + WS_OUTP);
    const int ntok = slot < T_TOK ? (T_TOK - slot + nslots - 1) / nslots : 0, N = 2 * ntok;
    if (N == 0) return;
    const int R = lane >> 3, p = lane & 7;
    const bool b5 = (lane & 32) != 0, b4 = (lane & 16) != 0, b3 = (lane & 8) != 0;
    int idn[16], idq[16]; float avc[16], avn[16]; v4u B0[8], B1[8], B2[8];
#define V_ITEM(n, t, s) const int n_##t = (n) < N ? (n) : N - 1; const int t = slot + (n_##t >= ntok ? n_##t - ntok : n_##t) * nslots, s = 2 * xg + (n_##t >= ntok ? 1 : 0)
#define V_ROWS(buf, ids, off, s) do { const unsigned char* vb_ = V8 + (size_t)(s) * NEXP * 128; _Pragma("unroll") for (int i = 0; i < 8; ++i) buf[i] = *(const v4u*)(vb_ + (unsigned)(((unsigned)ids[(off) + i] << 7) + 16u * p)); } while (0)
#define V_HALF(buf, off) do { _Pragma("unroll") for (int i = 0; i < 8; ++i) { asm volatile("" : "+v"(buf[i][0]), "+v"(buf[i][1]), "+v"(buf[i][2]), "+v"(buf[i][3])); \
            float f[16]; fp8x16_to_f32(buf[i], f); _Pragma("unroll") for (int k = 0; k < 16; ++k) acc[k] += avc[(off) + i] * f[k]; PIN16(acc); } } while (0)
    { V_ITEM(0, t0, s0); V_ITEM(1, t1, s1);
      int id0[16];
#pragma unroll
      for (int i = 0; i < 1; ++i) { LD16I(id0, IDX + (size_t)t0 * 128 + 16 * R); LD16I(idn, IDX + (size_t)t1 * 128 + 16 * R); LD16F(avc, ACT + (size_t)t0 * 128 + 16 * R); }
      V_ROWS(B0, id0, 0, s0); V_ROWS(B1, id0, 8, s0); }
#define V_BODY(n, Ba, Bb, Bc) do { \
        V_ITEM(n, t, s); V_ITEM((n) + 1, t1, s1); V_ITEM((n) + 2, t2, s2); (void)s2; \
        V_ROWS(Bc, idn, 0, s1); \
        LD16I(idq, IDX + (size_t)t2 * 128 + 16 * R); LD16F(avn, ACT + (size_t)t1 * 128 + 16 * R); \
        float acc[16]; \
        _Pragma("unroll") for (int k = 0; k < 16; ++k) acc[k] = 0.f; \
        V_HALF(Ba, 0); \
        V_ROWS(Ba, idn, 8, s1); \
        V_HALF(Bb, 8); \
        if ((n) < N) { \
            float a8[8], a4[4], a2[2]; \
            _Pragma("unroll") for (int k = 0; k < 8; ++k) { const float send = b5 ? acc[k] : acc[k + 8], keep = b5 ? acc[k + 8] : acc[k]; a8[k] = keep + __shfl_xor(send, 32); } \
            _Pragma("unroll") for (int k = 0; k < 4; ++k) { const float send = b4 ? a8[k] : a8[k + 4], keep = b4 ? a8[k + 4] : a8[k]; a4[k] = keep + __shfl_xor(send, 16); } \
            _Pragma("unroll") for (int k = 0; k < 2; ++k) { const float send = b3 ? a4[k] : a4[k + 2], keep = b3 ? a4[k + 2] : a4[k]; a2[k] = keep + __shfl_xor(send, 8); } \
            const int col = 128 * s + 16 * p + (b5 ? 8 : 0) + (b4 ? 4 : 0) + (b3 ? 2 : 0); \
            *(unsigned*)(OUTP + (size_t)t * DM + col) = cvtpk(a2[0], a2[1]); } \
        _Pragma("unroll") for (int i = 0; i < 16; ++i) { idn[i] = idq[i]; avc[i] = avn[i]; } } while (0)
    for (int n = 0; n < N; n += 3) { V_BODY(n, B0, B1, B2); V_BODY(n + 1, B2, B0, B1); V_BODY(n + 2, B1, B2, B0); }
#undef V_ITEM
#undef V_ROWS
#undef V_HALF
#undef V_BODY
}
__device__ __forceinline__ void peer_final_token(const Params& P, int t, int lane, float* outp) {
    const bf16* xrow = (const bf16*)(P.ws + WS_X1B) + (size_t)t * DM; const bf16* prow = (const bf16*)(P.ws + WS_OUTP) + (size_t)t * DM; float* orow = outp + (size_t)t * DM;
    float v[4][8]; float ss = 0.f;
#pragma unroll
    for (int j = 0; j < 4; ++j) { const v4u a = *(const v4u*)(xrow + 512 * j + 8 * lane), b = *(const v4u*)(prow + 512 * j + 8 * lane);
#pragma unroll
        for (int i = 0; i < 4; ++i) { v[j][2 * i] = bf_lo(a[i]) + bf_lo(b[i]); v[j][2 * i + 1] = bf_hi(a[i]) + bf_hi(b[i]); }
#pragma unroll
        for (int i = 0; i < 8; ++i) ss += v[j][i] * v[j][i]; }
    const float rf = __builtin_amdgcn_rsqf(wave_sum(ss) * (1.f / 2048.f) + RMS_EPS);
#pragma unroll
    for (int j = 0; j < 4; ++j) { const f32x4 g0 = *(const f32x4*)(P.g_fin + 512 * j + 8 * lane), g1 = *(const f32x4*)(P.g_fin + 512 * j + 8 * lane + 4); f32x4 o0, o1;
#pragma unroll
        for (int i = 0; i < 4; ++i) { o0[i] = v[j][i] * rf * g0[i]; o1[i] = v[j][4 + i] * rf * g1[i]; }
        *(f32x4*)(orow + 512 * j + 8 * lane) = o0; *(f32x4*)(orow + 512 * j + 8 * lane + 4) = o1; }
}

#ifndef MK_PER_PHASE
#define MK_PER_PHASE 0
#endif
constexpr int N_PHASES = 12;
#ifndef TAB_P0_ROWS
#define TAB_P0_ROWS 2048
#endif
__global__ void __launch_bounds__(NWAVES * 64, 2) fwd_kernel(Params P) {
    extern __shared__ __attribute__((aligned(16))) unsigned char lds_raw[];
    LAS unsigned char* lds = (LAS unsigned char*)lds_raw;
    volatile LAS unsigned* MISC = (volatile LAS unsigned*)(lds + MISC_OFF);
    const int tid = threadIdx.x, lane = tid & 63, wave = __builtin_amdgcn_readfirstlane(tid >> 6);
    const int G = gridDim.x; const int bx = blockIdx.x;
    const int vcu = (G % 8 == 0) ? (bx % 8) * (G / 8) + bx / 8 : bx;
    const int gw = vcu * NWAVES + wave, NGW = G * NWAVES;
    unsigned char* ws = P.ws;
    gu32* ctl = (gu32*)(ws + WS_CTL);
    for (int u = tid; u < 64; u += NWAVES * 64) MISC[u] = 0u;
    __syncthreads();
    XcdBarrier bar; bar.bar = (unsigned*)ctl + CW_BAR; bar.x = 0; bar.st = nullptr;
    if (!MK_PER_PHASE) bar = xcd_barrier_post((unsigned*)ctl + CW_BAR, MISC + 8);
    const unsigned my_xcc = xb_xcc_id();
    if (!MK_PER_PHASE) { if (tid == 0) MISC[16] = __hip_atomic_fetch_add((unsigned*)(ctl + CW_XC + 64 * (my_xcc & 7u)), 1u, __ATOMIC_RELAXED, __HIP_MEMORY_SCOPE_AGENT); }
    const int lo = P.ph_lo, hi = P.ph_hi;
#define FRESH_IDS const int lane = (int)__builtin_amdgcn_mbcnt_hi(~0u, __builtin_amdgcn_mbcnt_lo(~0u, 0u)); const int tid = wave * 64 + lane; (void)tid; (void)lane
#ifndef PH_MASK
#define PH_MASK 0xfff
#endif
#define IN(k) (((PH_MASK >> (k)) & 1) && lo <= (k) && (k) < hi)
#define BOTH(k) (IN(k) && IN((k) + 1))
#ifndef DUP_MASK
#define DUP_MASK 0
#endif
#define NREP(k) (((DUP_MASK >> (k)) & 1) ? 2 : 1)
#define GRID_BAR() do { if (!MK_PER_PHASE) xcd_barrier(bar); } while (0)

    bf16* HN = (bf16*)(ws + WS_HN); bf16* WA = (bf16*)(ws + WS_WA); bf16* WV = (bf16*)(ws + WS_WV); bf16* WB = (bf16*)(ws + WS_WB); bf16* WO = (bf16*)(ws + WS_WO); bf16* WQ = (bf16*)(ws + WS_WQ);

    constexpr int NV_UNITS = (AW / 256) * (T_TOK / 256);
    const int tab_r1 = (G > NV_UNITS && (1024 % G) == 0) ? TAB_P0_ROWS : NEXP;
    if (IN(0)) { FRESH_IDS; for (int rep = 0; rep < NREP(0); ++rep) p0_prologue(P, lds, gw, NGW, wave, lane, tab_r1); if (BOTH(0)) GRID_BAR(); }

    if (IN(1)) { FRESH_IDS;
      _Pragma("unroll") for (int rep = 0; rep < NREP(1); ++rep) {
        { pg8::Gemm g{HN, WA, T_TOK, NWA, DM / 2, WV, HN, ws, (unsigned)WS_END}; pg8::StaticOrder2 S; S.init(T_TOK, NWA, AW, T_TOK, G, bx);
          pg8::EpiProj E{(bf16*)(ws + WS_Q), (bf16*)(ws + WS_K), (bf16*)(ws + WS_XR), (bf16*)(ws + WS_GY), (bf16*)(ws + WS_SG), (bf16*)(ws + WS_VT), rep == 0 ? (float*)(ws + WS_CTL) + CW_KM : nullptr, QSCALE, 1.f / W8SCALE};
          pg8::gemm_phase<pg8::EpiProj, pg8::StaticOrder2, true, true, true>(lds, g, S, E); }
        if (G > NV_UNITS && (1024 % G) == 0 && bx >= NV_UNITS) peer_tables(P, tab_r1, NEXP, (bx - NV_UNITS) * NWAVES + wave, (G - NV_UNITS) * NWAVES, lane);
      }
        if (BOTH(1)) GRID_BAR();
    }

    if (IN(2)) { FRESH_IDS;
        LAS int* tick = (LAS int*)(lds + MISC_OFF + 128);
#define NEXT_TICKET(dst, word) do { __syncthreads(); if (tid == 0) *tick = (int)__hip_atomic_fetch_add((unsigned*)(ctl + (word)), 1u, __ATOMIC_RELAXED, __HIP_MEMORY_SCOPE_AGENT); __syncthreads(); dst = *tick; } while (0)
#define TICKET_ISSUE(word) do { if (tid == 0) tk_next = (int)__hip_atomic_fetch_add((unsigned*)(ctl + (word)), 1u, __ATOMIC_RELAXED, __HIP_MEMORY_SCOPE_AGENT); } while (0)
#define TICKET_TAKE(dst) do { __syncthreads(); if (tid == 0) *tick = tk_next; __syncthreads(); dst = *tick; } while (0)
        int tk_next = 0;
#ifndef DUP_ATT
#define DUP_ATT 0
#endif
#ifndef DUP_LRU
#define DUP_LRU 0
#endif
#ifndef DUP_P2
#define DUP_P2 0
#endif
        _Pragma("unroll") for (int rp = 0; rp < 1 + DUP_P2; ++rp) {
        _Pragma("unroll") for (int rep = 0; rep < 1 + DUP_ATT; ++rep) {
            int tid2 = tid; asm volatile("" : "+v"(tid2));
            int it; NEXT_TICKET(it, CW_Q2 + 64 * (rep + 2 * rp));
            while (it < 256) { const int blk = 7 - (it >> 5), bh = it & 31; attn_unit(P, lds, bh >> 3, bh & 7, blk, tid2, wave, tid2 & 63); NEXT_TICKET(it, CW_Q2 + 64 * (rep + 2 * rp)); } }
        _Pragma("unroll") for (int rep = 0; rep < 1 + DUP_LRU; ++rep) {
            int tid2 = tid; asm volatile("" : "+v"(tid2));
            int it; NEXT_TICKET(it, CW_Q2 + 256 + 64 * (rep + 2 * rp));
            while (it < 512) { lru_pair(P, lds, it, tid2, wave, tid2 & 63, (unsigned*)(ctl + CW_Q2 + 256 + 64 * (rep + 2 * rp)), tk_next); TICKET_TAKE(it); } }
        if (DUP_P2 && rp == 0) GRID_BAR();
        }
#undef NEXT_TICKET
#undef TICKET_ISSUE
#undef TICKET_TAKE
        if (BOTH(2)) GRID_BAR();
    }

    if (IN(3)) { FRESH_IDS;
      _Pragma("unroll") for (int rep = 0; rep < NREP(3); ++rep) {
        const float* HL = (const float*)(ws + WS_HL); const float* AC = (const float*)(ws + WS_AC); const float* SUM = (const float*)(ws + WS_SUM);
        const bf16* GY = (const bf16*)(ws + WS_GY); unsigned char* OCAT = ws + WS_OCAT;
        for (int u = vcu; u < 256; u += G) { const int b = u >> 6, c = (u >> 1) & 31, C = (u & 1) * 512 + 4 * (tid & 127), tq = tid >> 7;
            f32x4 carry = (f32x4){0.f, 0.f, 0.f, 0.f};
            for (int cc = 0; cc < c; ++cc) { const float* sm = SUM + ((size_t)(b * 32 + cc) * 1024 + C) * 2; const f32x4 s0 = *(const f32x4*)sm, s1 = *(const f32x4*)(sm + 4);
                carry[0] = s0[0] * carry[0] + s0[1]; carry[1] = s0[2] * carry[1] + s0[3]; carry[2] = s1[0] * carry[2] + s1[1]; carry[3] = s1[2] * carry[3] + s1[3]; }
            const size_t R0 = (size_t)b * SEQ + c * 64 + tq * 16;
#pragma unroll 8
            for (int t = 0; t < 16; ++t) { const size_t o = (R0 + t) * AW + C; const f32x4 hv = *(const f32x4*)(HL + o) + *(const f32x4*)(AC + o) * carry;
                const unsigned long long gy = *(const unsigned long long*)(GY + o); const unsigned g0 = (unsigned)gy, g1 = (unsigned)(gy >> 32);
                int p = __builtin_amdgcn_cvt_pk_fp8_f32(clamp8(hv[0] * bf_lo(g0) * OC8SCALE), clamp8(hv[1] * bf_hi(g0) * OC8SCALE), 0, false); p = __builtin_amdgcn_cvt_pk_fp8_f32(clamp8(hv[2] * bf_lo(g1) * OC8SCALE), clamp8(hv[3] * bf_hi(g1) * OC8SCALE), p, true);
                *(unsigned*)(OCAT + (R0 + t) * DM + AW + C) = (unsigned)p; } }
      }
        if (BOTH(3)) GRID_BAR();
    }

    if (IN(4)) { FRESH_IDS;
      _Pragma("unroll") for (int rep = 0; rep < NREP(4); ++rep) {
        { pg8::Gemm g{(bf16*)(ws + WS_OCAT), WB, T_TOK, DM, DM / 2, nullptr, nullptr, ws, (unsigned)WS_END}; pg8::StaticOrder S; S.init(T_TOK, DM, G, bx);
          pg8::EpiMerge2 E{(const bf16*)(ws + WS_SG), (bf16*)(ws + WS_MG), MG8SCALE / (OC8SCALE * WB8SCALE)};
          pg8::gemm_phase<pg8::EpiMerge2, pg8::StaticOrder, true, true, true>(lds, g, S, E); }
      }
        if (BOTH(4)) GRID_BAR();
    }

    if (IN(5)) { FRESH_IDS;
      _Pragma("unroll") for (int rep = 0; rep < NREP(5); ++rep) {
        pg8::Gemm g{(bf16*)(ws + WS_MG), WO, T_TOK, DM, DM / 2, nullptr, nullptr, ws, (unsigned)WS_END}; pg8::StaticOrder S; S.init(T_TOK, DM, G, bx);
        pg8::EpiResid E{P.x, (bf16*)(ws + WS_X1B), (float*)(ws + WS_SSP), 1.f / (W8SCALE * MG8SCALE)};
        pg8::gemm_phase<pg8::EpiResid, pg8::StaticOrder, true, true, true>(lds, g, S, E);
      }
        if (BOTH(5)) GRID_BAR();
    }

    if (IN(6)) { FRESH_IDS;
      _Pragma("unroll") for (int rep = 0; rep < NREP(6); ++rep) {
        pg8::Gemm g{(bf16*)(ws + WS_X1B), WQ, T_TOK, DM, DM, nullptr, nullptr, ws, (unsigned)WS_END}; pg8::StaticOrder S; S.init(T_TOK, DM, G, bx);
        pg8::EpiRowScale E{(const float*)(ws + WS_SSP), (bf16*)(ws + WS_QP)};
        pg8::gemm_phase<pg8::EpiRowScale, pg8::StaticOrder, true, true>(lds, g, S, E);
        { pg8::Unit u; for (int i = 0; S.next(i, u); ++i) { peer_topk_unit(P, lds, u.pm * 256, u.pn, tid, wave, lane); peer_topk_unit(P, lds, u.pm * 256 + 128, u.pn, tid, wave, lane); } }
      }
        if (BOTH(6)) GRID_BAR();
    }

    int xg = bx & 7, nblk_g = (G - xg + 7) >> 3, rank_g = bx >> 3;
    if (!MK_PER_PHASE && lo == 0 && hi > 8) {
        unsigned cnt[8], sum = 0u; bool ok = my_xcc < 8u;
#pragma unroll
        for (int j = 0; j < 8; ++j) { cnt[j] = __hip_atomic_load((unsigned*)(ctl + CW_XC + 64 * j), __ATOMIC_RELAXED, __HIP_MEMORY_SCOPE_AGENT); sum += cnt[j]; ok = ok && cnt[j] > 0u; }
        if (ok && sum == (unsigned)G) { xg = (int)my_xcc; rank_g = (int)MISC[16];
            nblk_g = (int)(xg == 0 ? cnt[0] : xg == 1 ? cnt[1] : xg == 2 ? cnt[2] : xg == 3 ? cnt[3] : xg == 4 ? cnt[4] : xg == 5 ? cnt[5] : xg == 6 ? cnt[6] : cnt[7]); }
    }
    const int nslots = nblk_g * NWAVES, slot = rank_g * NWAVES + wave;
    if (IN(8)) { FRESH_IDS;
        _Pragma("unroll") for (int rep = 0; rep < NREP(8); ++rep)
        peer_u_phase(P, xg, slot, nslots, lane);
        if (BOTH(8)) GRID_BAR();
    }
#ifdef EXTRA_BARS
    for (int eb = 0; eb < EXTRA_BARS; ++eb) GRID_BAR();
#endif
    if (IN(9)) { FRESH_IDS;
        for (int t = gw; t < T_TOK; t += 2 * NGW) peer_act_tokens(P, t, t + NGW < T_TOK ? t + NGW : -1, lane);
        if (BOTH(9)) GRID_BAR();
    }
    if (IN(10)) { FRESH_IDS;
        _Pragma("unroll") for (int rep = 0; rep < NREP(10); ++rep)
        peer_v_phase(P, xg, slot, nslots, lane);
        if (BOTH(10)) GRID_BAR();
    }
    if (IN(11)) { FRESH_IDS;
        if (NREP(11) == 2) for (int t = gw; t < T_TOK; t += NGW) peer_final_token(P, t, lane, (float*)(ws + WS_MG));
        for (int t = gw; t < T_TOK; t += NGW) peer_final_token(P, t, lane, P.out);
    }
#undef IN
#undef BOTH
#undef GRID_BAR
}

extern "C" void kernel_launch(void* const* d_in, const int* in_sizes, int n_in, void* d_out, int out_size, void* d_ws, size_t ws_size, hipStream_t stream) {
    static int grid = 0;
    if (grid == 0) {
        if (n_in != 19 || out_size != T_TOK * DM || ws_size < WS_END) { fprintf(stderr, "kernel_launch: unexpected problem (n_in %d, out %d, ws %zu); nothing launched\n", n_in, out_size, ws_size); grid = -1; return; }
        int dev = 0, cus = 0, per_cu = 0;
        if (hipGetDevice(&dev) != hipSuccess || hipDeviceGetAttribute(&cus, hipDeviceAttributeMultiprocessorCount, dev) != hipSuccess) { grid = -1; return; }
        if (hipFuncSetAttribute((const void*)fwd_kernel, hipFuncAttributeMaxDynamicSharedMemorySize, LDS_BYTES) != hipSuccess) { fprintf(stderr, "kernel_launch: hipFuncSetAttribute failed\n"); grid = -1; return; }
        if (hipOccupancyMaxActiveBlocksPerMultiprocessor(&per_cu, (const void*)fwd_kernel, NWAVES * 64, LDS_BYTES) != hipSuccess || per_cu < 1) { fprintf(stderr, "kernel_launch: occupancy query says %d blocks per CU\n", per_cu); }
        (void)hipGetLastError();
        grid = cus;
    }
    if (grid < 0) return;
    if (hipMemsetAsync((char*)d_ws + WS_CTL, 0, CTL_ZERO_BYTES, stream) != hipSuccess) return;
    Params p{};
    const float** pp = (const float**)&p;
    for (int i = 0; i < 19; ++i) pp[i] = (const float*)d_in[i];
    p.out = (float*)d_out; p.ws = (unsigned char*)d_ws;
#if MK_PER_PHASE
    for (int ph = 0; ph < N_PHASES; ++ph) { p.ph_lo = ph; p.ph_hi = ph + 1; hipLaunchKernelGGL(fwd_kernel, dim3(grid), dim3(NWAVES * 64), LDS_BYTES, stream, p); }
#else
    p.ph_lo = 0; p.ph_hi = N_PHASES;
    hipLaunchKernelGGL(fwd_kernel, dim3(grid), dim3(NWAVES * 64), LDS_BYTES, stream, p);
#endif
}
```

```cpp
#include <hip/hip_runtime.h>
#include <cstdio>
#include <cstdint>
namespace pg8 {
#define PG8_LAS __attribute__((address_space(3)))
typedef unsigned short bf16_t;
typedef short bf16x8 __attribute__((ext_vector_type(8)));
typedef float f32x4 __attribute__((ext_vector_type(4)));
typedef unsigned u32x4 __attribute__((ext_vector_type(4)));
typedef int i32x4 __attribute__((ext_vector_type(4)));
typedef int i32x8 __attribute__((ext_vector_type(8)));
__device__ __forceinline__ i32x8 cat8(bf16x8 a, bf16x8 b) { return __builtin_shufflevector(__builtin_bit_cast(i32x4, a), __builtin_bit_cast(i32x4, b), 0, 1, 2, 3, 4, 5, 6, 7); }
constexpr int BM = 256, BK = 64, HALF = 128, HTB = HALF * BK * 2  , STAGE_BYTES = 8 * HTB, NXCD = 8, WGM = 8;

__host__ __device__ __forceinline__ int lds_byte(int r, int c) { const int st = (r >> 4) * 2 + (c >> 5), rr = r & 15, cc = c & 31, ob = rr * 64 + cc * 2; return st * 1024 + (ob ^ (((ob >> 9) & 1) << 5)); }
__host__ __device__ __forceinline__ void stage_rc(int b, int& R, int& C) { const int st = b / 1024, sb = b % 1024, swz = sb ^ (((sb >> 9) & 1) << 5); R = (st >> 1) * 16 + swz / 64; C = (st & 1) * 32 + (swz % 64) / 2; }
__host__ __device__ __forceinline__ int perm32(int rho) { const int n = rho >> 4, i = rho & 15; return 8 * (i >> 2) + 4 * n + (i & 3); }

struct Unit { int pm, pn, sel; };
struct Gemm { const bf16_t* A; const bf16_t* Bt; int M, N, K; const bf16_t* A2; const bf16_t* Bt2; const void* rbase; unsigned rbytes; };

struct StaticOrder {
    int nM, nN, nwg, G, c;
    __host__ __device__ __forceinline__ void init(int M, int N, int G_, int c_) { nM = M / BM; nN = N / BM; nwg = nM * nN; G = G_; c = c_; }
    __host__ __device__ __forceinline__ bool next(int i, Unit& u) const {
        const long L = (long)i * G + c; if (L >= nwg) return false;
        int wgid = (int)L; { const int q = nwg / NXCD, r = nwg % NXCD, xcd = wgid % NXCD, off = wgid / NXCD; wgid = (xcd < r ? xcd * (q + 1) : r * (q + 1) + (xcd - r) * q) + off; }
        const int nig = WGM * nN, gid = wgid / nig, fm = gid * WGM, gsz = (nM - fm) < WGM ? (nM - fm) : WGM;
        u.pm = fm + ((wgid % nig) % gsz); u.pn = (wgid % nig) / gsz; u.sel = 0; return true;
    }
    __device__ __forceinline__ void a_ready(const Unit&) const {}
    __device__ __forceinline__ void done(const Unit&) const {}
};

struct StaticOrder2 {
    StaticOrder s0, s1; int G, c;
    __host__ __device__ __forceinline__ void init(int M0, int N0, int M1, int N1, int G_, int c_) { s0.init(M0, N0, 1, 0); s1.init(M1, N1, 1, 0); G = G_; c = c_; }
    __host__ __device__ __forceinline__ bool next(int i, Unit& u) const {
        const long L = (long)i * G + c;
        if (L < s0.nwg) return s0.next((int)L, u);
        if (L < s0.nwg + s1.nwg) { const bool ok = s1.next((int)(L - s0.nwg), u); u.sel = 1; return ok; }
        return false;
    }
    __device__ __forceinline__ void a_ready(const Unit&) const {}
    __device__ __forceinline__ void done(const Unit&) const {}
};

__device__ __forceinline__ unsigned cvt_pk_bf16(float lo, float hi) { unsigned r; asm volatile("v_cvt_pk_bf16_f32 %0, %1, %2" : "=v"(r) : "v"(lo), "v"(hi)); return r; }
typedef float f32x2 __attribute__((ext_vector_type(2)));
__device__ __forceinline__ float c8(float v) { return __builtin_fminf(__builtin_fmaxf(v, -448.f), 448.f); }
__device__ __forceinline__ float sigmoid_f(float v) { return __builtin_amdgcn_rcpf(1.f + __builtin_amdgcn_exp2f(-1.4426950408889634f * v)); }
__device__ __forceinline__ float gelu_tanh_f(float v) { const float z = 1.5957691216057308f * (v + 0.044715f * v * v * v); return v * __builtin_amdgcn_rcpf(1.f + __builtin_amdgcn_exp2f(-1.4426950408889634f * z)); }
__device__ __forceinline__ u32x4 pack8(const f32x4& v0, const f32x4& v1) { u32x4 w; w.x = cvt_pk_bf16(v0[0], v0[1]); w.y = cvt_pk_bf16(v0[2], v0[3]); w.z = cvt_pk_bf16(v1[0], v1[1]); w.w = cvt_pk_bf16(v1[2], v1[3]); return w; }
__device__ __forceinline__ f32x4 bf4_lo(unsigned a, unsigned b) { f32x4 r; r[0] = __builtin_bit_cast(float, a << 16); r[1] = __builtin_bit_cast(float, a & 0xffff0000u); r[2] = __builtin_bit_cast(float, b << 16); r[3] = __builtin_bit_cast(float, b & 0xffff0000u); return r; }

struct EpiProj {
    static constexpr bool PERM = true, AFTER_DRAIN = false, MIDK = false;
    bf16_t *Q, *K, *XR, *GY, *SG, *VT; float* KM; float qscale, oscale;
    __device__ __forceinline__ void operator()(const f32x4 (&acc)[2][2][4][2], const Unit& u, int wr, int wc, int fr, int fq) const {
        { const int l_ = (int)__builtin_amdgcn_mbcnt_hi(~0u, __builtin_amdgcn_mbcnt_lo(~0u, 0u)); fr = l_ & 15; fq = l_ >> 4; }
        const int pn = u.pn; int kind, ldc, colt; bf16_t* base;
        if (u.sel) { kind = 2; base = VT; ldc = 8192; colt = pn * 256; }
        else if (pn < 4) { kind = 0; base = Q; ldc = 1024; colt = pn * 256; }
        else if (pn < 8) { kind = 1; base = K; ldc = 1024; colt = (pn - 4) * 256; }
        else if (pn < 12) { kind = 2; base = XR; ldc = 1024; colt = (pn - 8) * 256; }
        else if (pn < 16) { kind = 3; base = GY; ldc = 1024; colt = (pn - 12) * 256; }
        else { kind = 4; base = SG; ldc = 4096; colt = (pn - 16) * 256; }
        const int row0 = u.pm * BM + wr * 64 + fr, col0 = colt + wc * 32 + 8 * fq;
#pragma unroll
        for (int ai = 0; ai < 2; ++ai)
#pragma unroll
            for (int m = 0; m < 4; ++m) { bf16_t* rowp = base + (size_t)(row0 + ai * HALF + m * 16) * ldc + col0;
#pragma unroll
                for (int bj = 0; bj < 2; ++bj) { f32x4 v0 = acc[ai][bj][m][0] * oscale, v1 = acc[ai][bj][m][1] * oscale;
                    if (kind == 0) { v0 = v0 * qscale; v1 = v1 * qscale; }
                    else if (kind == 3) {
#pragma unroll
                        for (int e = 0; e < 4; ++e) { v0[e] = gelu_tanh_f(v0[e]); v1[e] = gelu_tanh_f(v1[e]); } }
                    else if (kind == 4) {
#pragma unroll
                        for (int e = 0; e < 4; ++e) { v0[e] = sigmoid_f(v0[e]); v1[e] = sigmoid_f(v1[e]); } }
                    *(u32x4*)(rowp + bj * HALF) = pack8(v0, v1); } }
        if (kind == 1 && KM != nullptr) {
            const int b = u.pm >> 3, blk = u.pm & 7;
#pragma unroll
            for (int bj = 0; bj < 2; ++bj)
#pragma unroll
                for (int n = 0; n < 2; ++n) { f32x4 s = (f32x4){0.f, 0.f, 0.f, 0.f};
#pragma unroll
                    for (int ai = 0; ai < 2; ++ai)
#pragma unroll
                        for (int m = 0; m < 4; ++m) s = s + acc[ai][bj][m][n];
#pragma unroll
                    for (int e = 0; e < 4; ++e) { float v = s[e]; v += __shfl_xor(v, 1); v += __shfl_xor(v, 2); v += __shfl_xor(v, 4); v += __shfl_xor(v, 8); s[e] = v; }
                    if (fr == 0) { const int c = colt + bj * HALF + wc * 32 + 8 * fq + 4 * n;
                        float* dst = KM + ((size_t)((b * 8 + (c >> 7)) * 8 + blk)) * 128 + (c & 127);
#pragma unroll
                        for (int e = 0; e < 4; ++e) atomicAdd(dst + e, s[e] * oscale); } }
        }
    }
};
struct EpiStore {
    static constexpr bool PERM = true, AFTER_DRAIN = false, MIDK = false;
    bf16_t* O; int ldc;
    __device__ __forceinline__ void operator()(const f32x4 (&acc)[2][2][4][2], const Unit& u, int wr, int wc, int fr, int fq) const {
        { const int l_ = (int)__builtin_amdgcn_mbcnt_hi(~0u, __builtin_amdgcn_mbcnt_lo(~0u, 0u)); fr = l_ & 15; fq = l_ >> 4; }
        const int row0 = u.pm * BM + wr * 64 + fr, col0 = u.pn * BM + wc * 32 + 8 * fq;
#pragma unroll
        for (int ai = 0; ai < 2; ++ai)
#pragma unroll
            for (int m = 0; m < 4; ++m) { bf16_t* rowp = O + (size_t)(row0 + ai * HALF + m * 16) * ldc + col0;
#pragma unroll
                for (int bj = 0; bj < 2; ++bj) *(u32x4*)(rowp + bj * HALF) = pack8(acc[ai][bj][m][0], acc[ai][bj][m][1]); }
    }
};
struct EpiMerge2 {
    static constexpr bool PERM = true, AFTER_DRAIN = false, MIDK = true;
    const bf16_t* SG; bf16_t* MG; float mgscale;
    __device__ __forceinline__ void midk(f32x4 (&acc)[2][2][4][2], const Unit& u, int wr, int wc, int fr, int fq) const {
        int row0 = u.pm * BM + wr * 64 + fr, col0 = u.pn * BM + wc * 32 + 8 * fq;
        asm volatile("" : "+v"(row0), "+v"(col0));
#pragma unroll
        for (int ai = 0; ai < 2; ++ai)
#pragma unroll
            for (int m = 0; m < 4; ++m) { const size_t row = (size_t)(row0 + ai * HALF + m * 16);
#pragma unroll
                for (int bj = 0; bj < 2; ++bj) { const int col = col0 + bj * HALF;
                    const u32x4 g0 = *(const u32x4*)(SG + row * 4096 + col), g1 = *(const u32x4*)(SG + row * 4096 + 2048 + col);
                    const f32x4 n0 = bf4_lo(g0.x, g0.y), n1 = bf4_lo(g0.z, g0.w), d0 = bf4_lo(g1.x, g1.y), d1 = bf4_lo(g1.z, g1.w);
#pragma unroll
                    for (int e2 = 0; e2 < 4; ++e2) { acc[ai][bj][m][0][e2] *= n0[e2] * __builtin_amdgcn_rcpf(fmaxf(d0[e2], 1e-18f)); acc[ai][bj][m][1][e2] *= n1[e2] * __builtin_amdgcn_rcpf(fmaxf(d1[e2], 1e-18f)); } } }
    }
    __device__ __forceinline__ void operator()(const f32x4 (&acc)[2][2][4][2], const Unit& u, int wr, int wc, int fr, int fq) const {
        { const int l_ = (int)__builtin_amdgcn_mbcnt_hi(~0u, __builtin_amdgcn_mbcnt_lo(~0u, 0u)); fr = l_ & 15; fq = l_ >> 4; }
        const int row0 = u.pm * BM + wr * 64 + fr, col0 = u.pn * BM + wc * 32 + 8 * fq;
#pragma unroll
        for (int ai = 0; ai < 2; ++ai)
#pragma unroll
            for (int m = 0; m < 4; ++m) { const size_t row = (size_t)(row0 + ai * HALF + m * 16);
#pragma unroll
                for (int bj = 0; bj < 2; ++bj) { const int col = col0 + bj * HALF;
                    const u32x4 g1 = *(const u32x4*)(SG + row * 4096 + 2048 + col);
                    const f32x4 v0 = acc[ai][bj][m][0] * bf4_lo(g1.x, g1.y) * mgscale, v1 = acc[ai][bj][m][1] * bf4_lo(g1.z, g1.w) * mgscale;
                    int p0 = __builtin_amdgcn_cvt_pk_fp8_f32(c8(v0[0]), c8(v0[1]), 0, false); p0 = __builtin_amdgcn_cvt_pk_fp8_f32(c8(v0[2]), c8(v0[3]), p0, true);
                    int p1 = __builtin_amdgcn_cvt_pk_fp8_f32(c8(v1[0]), c8(v1[1]), 0, false); p1 = __builtin_amdgcn_cvt_pk_fp8_f32(c8(v1[2]), c8(v1[3]), p1, true);
                    *(unsigned long long*)((unsigned char*)MG + row * 2048 + col) = (unsigned long long)(unsigned)p0 | ((unsigned long long)(unsigned)p1 << 32); } }
    }
};
struct EpiResid {
    static constexpr bool PERM = true, AFTER_DRAIN = false, MIDK = false;
    const float* X; bf16_t* X1B; float* SSP; float oscale;
    __device__ __forceinline__ void operator()(const f32x4 (&acc)[2][2][4][2], const Unit& u, int wr, int wc, int fr, int fq) const {
        { const int l_ = (int)__builtin_amdgcn_mbcnt_hi(~0u, __builtin_amdgcn_mbcnt_lo(~0u, 0u)); fr = l_ & 15; fq = l_ >> 4; }
        const int row0 = u.pm * BM + wr * 64 + fr, col0 = u.pn * BM + wc * 32 + 8 * fq;
#pragma unroll
        for (int ai = 0; ai < 2; ++ai)
#pragma unroll
            for (int m = 0; m < 4; ++m) { const size_t row = (size_t)(row0 + ai * HALF + m * 16); float ss = 0.f;
#pragma unroll
                for (int bj = 0; bj < 2; ++bj) { const int col = col0 + bj * HALF; const float* xp = X + row * 2048 + col;
                    f32x4 v0 = acc[ai][bj][m][0] * oscale + *(const f32x4*)xp, v1 = acc[ai][bj][m][1] * oscale + *(const f32x4*)(xp + 4);
                    *(u32x4*)(X1B + row * 2048 + col) = pack8(v0, v1);
                    ss += (v0[0] * v0[0] + v0[1] * v0[1]) + (v0[2] * v0[2] + v0[3] * v0[3]) + (v1[0] * v1[0] + v1[1] * v1[1]) + (v1[2] * v1[2] + v1[3] * v1[3]); }
                ss += __shfl_xor(ss, 16); ss += __shfl_xor(ss, 32);
                if (fq == 0) SSP[row * 32 + u.pn * 4 + wc] = ss; }
    }
};
struct EpiRowScale {
    static constexpr bool PERM = true, AFTER_DRAIN = false, MIDK = false;
    const float* SSP; bf16_t* O;
    __device__ __forceinline__ void operator()(const f32x4 (&acc)[2][2][4][2], const Unit& u, int wr, int wc, int fr, int fq) const {
        { const int l_ = (int)__builtin_amdgcn_mbcnt_hi(~0u, __builtin_amdgcn_mbcnt_lo(~0u, 0u)); fr = l_ & 15; fq = l_ >> 4; }
        const int row0 = u.pm * BM + wr * 64 + fr, col0 = u.pn * BM + wc * 32 + 8 * fq;
#pragma unroll
        for (int ai = 0; ai < 2; ++ai)
#pragma unroll
            for (int m = 0; m < 4; ++m) { const size_t row = (size_t)(row0 + ai * HALF + m * 16);
                const f32x4 a = *(const f32x4*)(SSP + row * 32 + 8 * fq), b = *(const f32x4*)(SSP + row * 32 + 8 * fq + 4);
                float ss = (a[0] + a[1]) + (a[2] + a[3]) + (b[0] + b[1]) + (b[2] + b[3]);
                ss += __shfl_xor(ss, 16); ss += __shfl_xor(ss, 32);
                const float rs = __builtin_amdgcn_rsqf(ss * (1.f / 2048.f) + 1e-6f);
#pragma unroll
                for (int bj = 0; bj < 2; ++bj) *(u32x4*)(O + row * 2048 + col0 + bj * HALF) = pack8(acc[ai][bj][m][0] * rs, acc[ai][bj][m][1] * rs); }
    }
};
template <class Epi, class Sched, bool ALIGN_EPI = false, bool SP2 = false, bool FP8 = false>
__device__ __forceinline__ void gemm_phase(PG8_LAS unsigned char* lds, const Gemm g, const Sched& S, const Epi& E) {
    const int tid = threadIdx.x, wid = __builtin_amdgcn_readfirstlane(tid >> 6), lane = tid & 63, wr = wid >> 2, wc = wid & 3, fr = lane & 15, fq = lane >> 4;
    const int K = g.K, nt = K / BK;
    const __amdgpu_buffer_rsrc_t rsrc = __builtin_amdgcn_make_buffer_rsrc((void*)g.rbase, 0, (int)g.rbytes, 0x00020000);
    unsigned voffA[2], voffB[2];
#pragma unroll
    for (int i = 0; i < 2; ++i) { int R, C; stage_rc(tid * 16 + i * 8192, R, C); const int Rb = Epi::PERM ? ((R & ~31) + perm32(R & 31)) : R;
        voffA[i] = (unsigned)(R * K + C) * 2u; voffB[i] = (unsigned)(Rb * K + C) * 2u; }
    const size_t kstep = (size_t)(BK * 2);
    const size_t hstep = (size_t)HALF * K * 2;
    const size_t tstep = 2 * hstep;
    const unsigned ldsw = (unsigned)wid * 1024u;
    const int aoff = lds_byte(wr * 64 + fr, fq * 8), boff = lds_byte(wc * 32 + fr, fq * 8);
#define PG8_SA(b, h) (((b) * 2 + (h)) * HTB)
#define PG8_SB(b, h) ((4 + (b) * 2 + (h)) * HTB)
#define PG8_STAGE(bufoff, gbase, voff) do { const unsigned so_ = (unsigned)((const char*)(gbase) - (const char*)g.rbase); _Pragma("unroll") for (int _i = 0; _i < 2; ++_i) \
        __builtin_amdgcn_raw_ptr_buffer_load_lds(rsrc, (PG8_LAS unsigned*)(lds + (bufoff) + ldsw + _i * 8192), 16, (voff)[_i], so_, 0, 0); } while (0)
#define PG8_LDA(dst, b, h) do { _Pragma("unroll") for (int m = 0; m < 4; ++m) { const PG8_LAS unsigned char* p_ = lds + PG8_SA(b, h) + aoff + m * 2048; \
        if constexpr (FP8) dst##8[m] = cat8(*(const PG8_LAS bf16x8*)p_, *(const PG8_LAS bf16x8*)(p_ + 1024)); else { dst[m][0] = *(const PG8_LAS bf16x8*)p_; dst[m][1] = *(const PG8_LAS bf16x8*)(p_ + 1024); } } } while (0)
#define PG8_LDB(dst, b, h) do { _Pragma("unroll") for (int n = 0; n < 2; ++n) { const PG8_LAS unsigned char* p_ = lds + PG8_SB(b, h) + boff + n * 2048; \
        if constexpr (FP8) dst##8[n] = cat8(*(const PG8_LAS bf16x8*)p_, *(const PG8_LAS bf16x8*)(p_ + 1024)); else { dst[n][0] = *(const PG8_LAS bf16x8*)p_; dst[n][1] = *(const PG8_LAS bf16x8*)(p_ + 1024); } } } while (0)
#define PG8_MMA(ai, bj, At, Bt) do { __builtin_amdgcn_s_setprio(1); _Pragma("unroll") for (int m = 0; m < 4; ++m) _Pragma("unroll") for (int n = 0; n < 2; ++n) { \
        if constexpr (FP8) acc[ai][bj][m][n] = __builtin_amdgcn_mfma_scale_f32_16x16x128_f8f6f4(Bt##8[n], At##8[m], acc[ai][bj][m][n], 0, 0, 0, 0x7f7f7f7f, 0, 0x7f7f7f7f); \
        else { _Pragma("unroll") for (int k = 0; k < 2; ++k) acc[ai][bj][m][n] = __builtin_amdgcn_mfma_f32_16x16x32_bf16(Bt[n][k], At[m][k], acc[ai][bj][m][n], 0, 0, 0); } } __builtin_amdgcn_s_setprio(0); } while (0)
#define PG8_WAIT_V(n) asm volatile("s_waitcnt vmcnt(" #n ")" ::: "memory")
#define PG8_WAIT_L(n) asm volatile("s_waitcnt lgkmcnt(" #n ")" ::: "memory")
#define PG8_BAR __builtin_amdgcn_s_barrier()
#define PG8_SCHED __builtin_amdgcn_sched_barrier(0)
    Unit cur, nxt; int ui = 0;
    if (!S.next(0, cur)) return;
    f32x4 acc[2][2][4][2];
#pragma unroll
    for (int a = 0; a < 2; ++a)
#pragma unroll
        for (int b = 0; b < 2; ++b)
#pragma unroll
            for (int m = 0; m < 4; ++m)
#pragma unroll
                for (int n = 0; n < 2; ++n) acc[a][b][m][n] = (f32x4){0.f, 0.f, 0.f, 0.f};
    bf16x8 At[4][2], B0[2][2], B1[2][2];
    i32x8 At8[4], B08[2], B18[2];
    const char* cA = (const char*)(cur.sel ? g.A2 : g.A) + (size_t)cur.pm * tstep; const char* cB = (const char*)(cur.sel ? g.Bt2 : g.Bt) + (size_t)cur.pn * tstep;
    S.a_ready(cur);
    if constexpr (SP2) {
        PG8_STAGE(PG8_SB(0, 0), cB, voffB); PG8_STAGE(PG8_SB(0, 1), cB + hstep, voffB); PG8_STAGE(PG8_SA(0, 0), cA, voffA); PG8_STAGE(PG8_SA(0, 1), cA + hstep, voffA);
        if (wr == 1) PG8_BAR;
        PG8_WAIT_V(2); PG8_BAR;
        PG8_STAGE(PG8_SB(1, 0), cB + kstep, voffB); PG8_STAGE(PG8_SA(1, 0), cA + kstep, voffA); PG8_STAGE(PG8_SB(1, 1), cB + hstep + kstep, voffB);
        PG8_WAIT_V(6); PG8_BAR;
    } else {
        PG8_STAGE(PG8_SB(0, 0), cB, voffB); PG8_STAGE(PG8_SA(0, 0), cA, voffA); PG8_STAGE(PG8_SB(0, 1), cB + hstep, voffB); PG8_STAGE(PG8_SA(0, 1), cA + hstep, voffA);
        if (wr == 1) PG8_BAR;
        PG8_WAIT_V(4); PG8_BAR;
        PG8_STAGE(PG8_SB(1, 0), cB + kstep, voffB); PG8_STAGE(PG8_SA(1, 0), cA + kstep, voffA); PG8_STAGE(PG8_SB(1, 1), cB + hstep + kstep, voffB);
        PG8_WAIT_V(6); PG8_BAR;
    }
    for (;;) {
        const bool has_next = S.next(ui + 1, nxt);
        const char* nA = has_next ? (const char*)(nxt.sel ? g.A2 : g.A) + (size_t)nxt.pm * tstep : cA; const char* nB = has_next ? (const char*)(nxt.sel ? g.Bt2 : g.Bt) + (size_t)nxt.pn * tstep : cB;
        for (int t = 0; t < nt; t += 2) {
            if constexpr (Epi::MIDK) { if (t == nt / 2) E.midk(acc, cur, wr, wc, fr, fq); }
            const bool last = (t == nt - 2);
            const char* a1 = cA + (size_t)(t + 1) * kstep;
            const char* a2 = last ? nA : cA + (size_t)(t + 2) * kstep; const char* b2 = last ? nB : cB + (size_t)(t + 2) * kstep;
            const char* a3 = a2 + kstep; const char* b3 = b2 + kstep;
            if (last && has_next) S.a_ready(nxt);
            if constexpr (SP2) {
            PG8_LDB(B0, 0, 0); PG8_LDB(B1, 0, 1); PG8_SCHED; PG8_LDA(At, 0, 0); PG8_STAGE(PG8_SA(1, 1), a1 + hstep, voffA);
            PG8_WAIT_V(8); PG8_WAIT_L(0); PG8_BAR; PG8_MMA(0, 0, At, B0); PG8_MMA(0, 1, At, B1); PG8_BAR; PG8_SCHED;
            PG8_LDA(At, 0, 1); PG8_STAGE(PG8_SB(0, 0), b2, voffB); PG8_STAGE(PG8_SB(0, 1), b2 + hstep, voffB); PG8_STAGE(PG8_SA(0, 0), a2, voffA);
            PG8_WAIT_V(8); PG8_WAIT_L(0); PG8_BAR; PG8_MMA(1, 0, At, B0); PG8_MMA(1, 1, At, B1); PG8_BAR; PG8_SCHED;
            PG8_LDB(B0, 1, 0); PG8_LDB(B1, 1, 1); PG8_SCHED; PG8_LDA(At, 1, 0); PG8_STAGE(PG8_SA(0, 1), a2 + hstep, voffA);
            PG8_WAIT_V(8); PG8_WAIT_L(0); PG8_BAR; PG8_MMA(0, 0, At, B0); PG8_MMA(0, 1, At, B1); PG8_BAR; PG8_SCHED;
            PG8_LDA(At, 1, 1); PG8_STAGE(PG8_SB(1, 0), b3, voffB); PG8_STAGE(PG8_SB(1, 1), b3 + hstep, voffB); PG8_STAGE(PG8_SA(1, 0), a3, voffA);
            PG8_WAIT_V(8); PG8_WAIT_L(0); PG8_BAR; PG8_MMA(1, 0, At, B0); PG8_MMA(1, 1, At, B1); PG8_BAR; PG8_SCHED;
            } else {
            PG8_LDB(B0, 0, 0); PG8_SCHED; PG8_LDA(At, 0, 0); PG8_STAGE(PG8_SA(1, 1), a1 + hstep, voffA);
            PG8_WAIT_L(8); PG8_BAR; PG8_WAIT_L(0); PG8_MMA(0, 0, At, B0); PG8_BAR; PG8_SCHED;
            PG8_LDB(B1, 0, 1); PG8_STAGE(PG8_SB(0, 0), b2, voffB);
            PG8_BAR; PG8_WAIT_L(0); PG8_MMA(0, 1, At, B1); PG8_BAR;
            PG8_LDA(At, 0, 1); PG8_STAGE(PG8_SA(0, 0), a2, voffA);
            PG8_BAR; PG8_WAIT_L(0); PG8_MMA(1, 0, At, B0); PG8_BAR; PG8_SCHED;
            PG8_STAGE(PG8_SB(0, 1), b2 + hstep, voffB);
            PG8_WAIT_V(6); PG8_BAR; PG8_MMA(1, 1, At, B1); PG8_BAR;
            PG8_LDB(B0, 1, 0); PG8_SCHED; PG8_LDA(At, 1, 0); PG8_STAGE(PG8_SA(0, 1), a2 + hstep, voffA);
            PG8_WAIT_L(8); PG8_BAR; PG8_WAIT_L(0); PG8_MMA(0, 0, At, B0); PG8_BAR; PG8_SCHED;
            PG8_LDB(B1, 1, 1); PG8_STAGE(PG8_SB(1, 0), b3, voffB);
            PG8_BAR; PG8_WAIT_L(0); PG8_MMA(0, 1, At, B1); PG8_BAR;
            PG8_LDA(At, 1, 1); PG8_STAGE(PG8_SA(1, 0), a3, voffA);
            PG8_BAR; PG8_WAIT_L(0); PG8_MMA(1, 0, At, B0); PG8_BAR; PG8_SCHED;
            PG8_STAGE(PG8_SB(1, 1), b3 + hstep, voffB);
            PG8_WAIT_V(6); PG8_BAR; PG8_MMA(1, 1, At, B1); PG8_BAR;
            }
        }
        if constexpr (ALIGN_EPI) { if (wr == 0) PG8_BAR; }
        if constexpr (!Epi::AFTER_DRAIN) { E(acc, cur, wr, wc, fr, fq); S.done(cur); }
        if (!has_next) break;
#pragma unroll
        for (int a = 0; a < 2; ++a)
#pragma unroll
            for (int b = 0; b < 2; ++b)
#pragma unroll
                for (int m = 0; m < 4; ++m)
#pragma unroll
                    for (int n = 0; n < 2; ++n) acc[a][b][m][n] = (f32x4){0.f, 0.f, 0.f, 0.f};
        cur = nxt; cA = nA; cB = nB; ++ui;
        if constexpr (ALIGN_EPI) { if (wr == 1) PG8_BAR; }
    }
    PG8_WAIT_V(0);
    if constexpr (!ALIGN_EPI) { if (wr == 0) PG8_BAR; }
    PG8_BAR;
    if constexpr (Epi::AFTER_DRAIN) { E.fused(acc, cur, wr, wc, fr, fq, lds, wid, lane); S.done(cur); }
#undef PG8_SA
#undef PG8_SB
#undef PG8_STAGE
#undef PG8_LDA
#undef PG8_LDB
#undef PG8_MMA
#undef PG8_WAIT_V
#undef PG8_WAIT_L
#undef PG8_BAR
#undef PG8_SCHED
}
}
#define GAS __attribute__((address_space(1)))
#define LAS __attribute__((address_space(3)))
typedef unsigned short bf16;
typedef unsigned v4u __attribute__((ext_vector_type(4)));
typedef float f32x4 __attribute__((ext_vector_type(4)));
typedef short bf16x8 __attribute__((ext_vector_type(8)));
typedef GAS unsigned gu32;
typedef GAS unsigned long long gu64;
#define RLX_AGENT __ATOMIC_RELAXED, __HIP_MEMORY_SCOPE_AGENT
#define LDS_WAIT() asm volatile("s_waitcnt lgkmcnt(0)" ::: "memory")
#define VM_WAIT() asm volatile("s_waitcnt vmcnt(0)" ::: "memory")
__device__ __forceinline__ unsigned long long rt() { return __builtin_amdgcn_s_memrealtime(); }
__device__ __forceinline__ unsigned f2bf(float f) { unsigned u = __builtin_bit_cast(unsigned, f); return (u + 0x7fffu + ((u >> 16) & 1u)) >> 16; }
__device__ __forceinline__ unsigned pk2(float lo, float hi) { return f2bf(lo) | (f2bf(hi) << 16); }

#define XB_TMO      128
#define XB_XCNT(j)  (256  + 64 * (j))
#define XB_XSUB(j)  (1280 + 64 * (j))
#define XB_XGEN(j)  (2304 + 64 * (j))
#define XB_TOP      3328
#define XB_TOPGEN   3392
#define XCD_BAR_WORDS 3456
#define XB_SPIN_CAP (1u << 18)

__device__ __forceinline__ unsigned xb_ld(unsigned* p)              { return __hip_atomic_load(p, __ATOMIC_RELAXED, __HIP_MEMORY_SCOPE_AGENT); }
__device__ __forceinline__ unsigned xb_add(unsigned* p, unsigned v) { return __hip_atomic_fetch_add(p, v, __ATOMIC_RELAXED, __HIP_MEMORY_SCOPE_AGENT); }
__device__ __forceinline__ unsigned xb_xcc_id() { return (unsigned)__builtin_amdgcn_s_getreg((3 << 11) | 20) & 0xFu; }
#define XB_SPIN(cond, bar) do { unsigned _sp = 0; while (cond) { __builtin_amdgcn_s_sleep(1); \
    if ((++_sp & 255u) == 0u) { if (xb_ld(&(bar)[XB_TMO])) break; if (_sp > XB_SPIN_CAP) { atomicAdd(&(bar)[XB_TMO], 1u); break; } } } } while (0)

struct XcdBarrier {
    unsigned* bar; unsigned x;
    volatile LAS unsigned* st;
};

__device__ __forceinline__ XcdBarrier xcd_barrier_post(unsigned* bar, volatile LAS unsigned* st) {
    XcdBarrier b; b.bar = bar; b.x = xb_xcc_id(); b.st = st;
    if (threadIdx.x == 0) (void)xb_add(&bar[XB_XCNT(b.x)], 1u);
    return b;
}
__device__ __forceinline__ void xcd_barrier_complete(unsigned* bar, unsigned x, unsigned& nloc, unsigned& nx) {
    const unsigned G = gridDim.x * gridDim.y * gridDim.z;
    unsigned sum, cnt, mine, sp = 0u;
    for (;;) {
        sum = 0u; cnt = 0u; mine = 0u;
#pragma unroll
        for (unsigned j = 0; j < 16; ++j) { const unsigned c = xb_ld(&bar[XB_XCNT(j)]); sum += c; cnt += (c > 0u) ? 1u : 0u; mine = (j == x) ? c : mine; }
        if (sum == G) break;
        __builtin_amdgcn_s_sleep(1);
        if ((++sp & 255u) == 0u) { if (xb_ld(&bar[XB_TMO])) break; if (sp > XB_SPIN_CAP) { atomicAdd(&bar[XB_TMO], 1u); break; } }
    }
    nloc = mine > 0u ? mine : 1u; nx = cnt > 0u ? cnt : 1u;
}

__device__ __forceinline__ void xcd_barrier(const XcdBarrier& b) {
    asm volatile("s_waitcnt vmcnt(0)" ::: "memory");
    __syncthreads();
    if (threadIdx.x == 0) {
        unsigned* bar = b.bar;
        __builtin_amdgcn_s_waitcnt(0);
        unsigned nloc = b.st[0], nx = b.st[1];
        if (nloc == 0u) { xcd_barrier_complete(bar, b.x, nloc, nx); b.st[0] = nloc; b.st[1] = nx; }
        const unsigned old = xb_add(&bar[XB_XSUB(b.x)], 1u);
        const unsigned gen = old / nloc;
        if (old + 1u == (gen + 1u) * nloc) {
            __builtin_amdgcn_fence(__ATOMIC_RELEASE, "agent");
            asm volatile("s_waitcnt vmcnt(0)" ::: "memory");
            const unsigned og = xb_add(&bar[XB_TOP], 1u);
            const unsigned tg = og / nx;
            if (og + 1u == (tg + 1u) * nx) xb_add(&bar[XB_TOPGEN], 1u);
            else XB_SPIN(xb_ld(&bar[XB_TOPGEN]) == tg, bar);
            __builtin_amdgcn_fence(__ATOMIC_ACQUIRE, "agent");
            xb_add(&bar[XB_XGEN(b.x)], 1u);
            asm volatile("s_waitcnt vmcnt(0)" ::: "memory");
        } else {
            XB_SPIN(xb_ld(&bar[XB_XGEN(b.x)]) == gen, bar);
            __builtin_amdgcn_fence(__ATOMIC_ACQUIRE, "agent");
            asm volatile("s_waitcnt vmcnt(0)" ::: "memory");
        }
    }
    __syncthreads();
}

constexpr int NWAVES = 8;
constexpr int T_TOK = 8192, DM = 2048, AW = 1024, SEQ = 2048, NHEAD = 8;
constexpr int NWA = 8192;
constexpr int NEXP = 16384;
constexpr float RMS_EPS = 1e-6f, LOG2E = 1.4426950408889634f;
constexpr float W8SCALE = 64.f;
constexpr float OC8SCALE = 8.f, WB8SCALE = 32.f;
constexpr float MG8SCALE = 16.f;
constexpr float QSCALE = 0.08838834764831845f * 1.4426950408889634f;

constexpr size_t MiB = 1u << 20;
constexpr size_t WS_CTL = 0, CTL_ZERO_BYTES = 1 * MiB;
constexpr size_t WS_WA = 2 * MiB;
constexpr size_t WS_WV = 34 * MiB;
constexpr size_t WS_WB = 38 * MiB;
constexpr size_t WS_WO = 46 * MiB;
constexpr size_t WS_WQ = 54 * MiB;
constexpr size_t WS_LWA = 62 * MiB;
constexpr size_t WS_LWX = 62 * MiB + 256 * 1024;
constexpr size_t WS_KEYS = 62 * MiB + 512 * 1024;
constexpr size_t WS_U8 = 64 * MiB;
constexpr size_t WS_V8 = 96 * MiB;
constexpr size_t WS_US = 128 * MiB;
constexpr size_t WS_VS = 128 * MiB + 65536;
constexpr size_t WS_HN = 192 * MiB;
constexpr size_t WS_X1B = WS_HN;
constexpr size_t WS_Q = 224 * MiB;
constexpr size_t WS_K = 240 * MiB;
constexpr size_t WS_VT = 256 * MiB;
constexpr size_t WS_XR = 272 * MiB;
constexpr size_t WS_GY = 288 * MiB;
constexpr size_t WS_SG = 304 * MiB;
constexpr size_t WS_QP = WS_SG;
constexpr size_t WS_OCAT = 368 * MiB;
constexpr size_t WS_HL = 400 * MiB;
constexpr size_t WS_AC = 432 * MiB;
constexpr size_t WS_TMP = WS_HL;
constexpr size_t WS_SUM = 464 * MiB;
constexpr size_t WS_MG = 466 * MiB;
constexpr size_t WS_SSP = 498 * MiB;
constexpr size_t WS_IDX = 500 * MiB;
constexpr size_t WS_G = 504 * MiB;
constexpr size_t WS_PD = WS_Q;
constexpr size_t WS_ACT = WS_VT;
constexpr size_t WS_OUTP = WS_HL;
constexpr size_t WS_END = 508 * MiB;
constexpr int CW_BAR = 4096;
constexpr int CW_XC = 12288;
constexpr int CW_Q2 = 8192;
constexpr int CW_KM = 65536;
static_assert((CW_KM + 32768) * 4 <= (int)CTL_ZERO_BYTES, "CTL");

constexpr int LDS_BYTES = 163840;
constexpr int MISC_OFF = 163840 - 256;
constexpr int SCR_BYTES = MISC_OFF;

typedef float f32x16 __attribute__((ext_vector_type(16)));
typedef float f32x2_t __attribute__((ext_vector_type(2)));
typedef __bf16 bf16x2_t __attribute__((ext_vector_type(2)));
typedef unsigned long long u64;
__device__ __forceinline__ float clamp8(float v) { return fminf(fmaxf(v, -448.f), 448.f); }
__device__ __forceinline__ unsigned cvtpk(float lo, float hi) { f32x2_t v = {lo, hi}; bf16x2_t b = __builtin_convertvector(v, bf16x2_t); return __builtin_bit_cast(unsigned, b); }
__device__ __forceinline__ float bf_lo(unsigned w) { return __builtin_bit_cast(float, w << 16); }
__device__ __forceinline__ float bf_hi(unsigned w) { return __builtin_bit_cast(float, w & 0xffff0000u); }
__device__ __forceinline__ f32x4 bf4_lo2(unsigned a, unsigned b) { f32x4 r; r[0] = bf_lo(a); r[1] = bf_hi(a); r[2] = bf_lo(b); r[3] = bf_hi(b); return r; }
__device__ __forceinline__ float wave_sum(float v) {
#pragma unroll
    for (int o = 1; o < 64; o <<= 1) v += __shfl_xor(v, o);
    return v;
}
__device__ __forceinline__ float dot2bf(unsigned a, unsigned b, float acc) { return __builtin_amdgcn_fdot2_f32_bf16(__builtin_bit_cast(bf16x2_t, a), __builtin_bit_cast(bf16x2_t, b), acc, false); }

struct Params {
    const float *x, *g_mix, *w_in, *conv_w, *conv_b, *lru_wa, *lru_ba, *lru_wx, *lru_bx, *lru_lam, *w_branch, *w_out, *rel_bias, *g_ffn, *peer_wq, *peer_keys, *peer_u, *peer_v, *g_fin;
    float* out; unsigned char* ws; int ph_lo, ph_hi;
};

template <bool F8 = false> __device__ __forceinline__ void tr_item(const float* W, int K, int N, bf16* dst_row0, int ldd, int k0, int n0, const float* kscale, LAS float* scr, int lane, float f8scale = 1.f) {
    f32x4 wv[8];
#pragma unroll
    for (int i = 0; i < 8; ++i) wv[i] = *(const f32x4*)(W + (size_t)(k0 + (lane >> 3) + 8 * i) * N + n0 + 4 * (lane & 7));
#pragma unroll
    for (int i = 0; i < 8; ++i) { const int kk = (lane >> 3) + 8 * i; f32x4 v = wv[i]; if (kscale) v = v * kscale[k0 + kk];
#pragma unroll
        for (int e = 0; e < 4; ++e) scr[kk * 33 + 4 * (lane & 7) + e] = v[e]; }
    LDS_WAIT(); asm volatile("" ::: "memory");
    const int c = lane & 7;
#pragma unroll
    for (int j = 0; j < 4; ++j) { const int n = (lane >> 3) + 8 * j; const LAS float* s = scr + (8 * c) * 33 + n;
        if (F8) {
            int p0 = __builtin_amdgcn_cvt_pk_fp8_f32(clamp8(s[0 * 33] * f8scale), clamp8(s[1 * 33] * f8scale), 0, false); p0 = __builtin_amdgcn_cvt_pk_fp8_f32(clamp8(s[2 * 33] * f8scale), clamp8(s[3 * 33] * f8scale), p0, true);
            int p1 = __builtin_amdgcn_cvt_pk_fp8_f32(clamp8(s[4 * 33] * f8scale), clamp8(s[5 * 33] * f8scale), 0, false); p1 = __builtin_amdgcn_cvt_pk_fp8_f32(clamp8(s[6 * 33] * f8scale), clamp8(s[7 * 33] * f8scale), p1, true);
            *(u64*)((unsigned char*)dst_row0 + (size_t)n * ldd + k0 + 8 * c) = (u64)(unsigned)p0 | ((u64)(unsigned)p1 << 32);
        } else {
        v4u o; o.x = cvtpk(s[0 * 33], s[1 * 33]); o.y = cvtpk(s[2 * 33], s[3 * 33]); o.z = cvtpk(s[4 * 33], s[5 * 33]); o.w = cvtpk(s[6 * 33], s[7 * 33]);
        *(v4u*)(dst_row0 + (size_t)n * ldd + k0 + 8 * c) = o; } }
    LDS_WAIT(); asm volatile("" ::: "memory");
}
template <int MODE> __device__ __forceinline__ void row_to_bf16(const float* src, bf16* dst, const float* colscale, int lane) {
    const f32x4* s = (const f32x4*)src + lane;
    f32x4 v[8]; float ss = 0.f;
#pragma unroll
    for (int j = 0; j < 8; ++j) { v[j] = s[64 * j]; ss += (v[j][0] * v[j][0] + v[j][1] * v[j][1]) + (v[j][2] * v[j][2] + v[j][3] * v[j][3]); }
    float rs = 1.f;
    if (MODE == 1) rs = __builtin_amdgcn_rsqf(wave_sum(ss) * (1.f / 2048.f) + RMS_EPS);
    u64* o8 = (u64*)dst + lane;
#pragma unroll
    for (int j = 0; j < 8; ++j) { f32x4 w = v[j] * rs; if (colscale) w = w * ((const f32x4*)colscale)[64 * j + lane];
        o8[64 * j] = (u64)cvtpk(w[0], w[1]) | ((u64)cvtpk(w[2], w[3]) << 32); }
}
template <bool I8> __device__ __forceinline__ void row_finish8(f32x4 (&v)[8], unsigned char* dst, float* scale_out, int lane) {
    float am = 0.f;
#pragma unroll
    for (int j = 0; j < 8; ++j) am = fmaxf(am, fmaxf(fmaxf(fabsf(v[j][0]), fabsf(v[j][1])), fmaxf(fabsf(v[j][2]), fabsf(v[j][3]))));
#pragma unroll
    for (int o = 1; o < 64; o <<= 1) am = fmaxf(am, __shfl_xor(am, o));
    const float qmax = I8 ? 127.f : 448.f;
    const float sc = am > 0.f ? am / qmax : 1.f, inv = 1.f / sc;
    unsigned* o4 = (unsigned*)(dst + (size_t)(lane >> 5) * NEXP * 128) + (lane & 31);
#pragma unroll
    for (int j = 0; j < 8; ++j) { unsigned w;
        if (I8) { const int q0 = (int)rintf(v[j][0] * inv), q1 = (int)rintf(v[j][1] * inv), q2 = (int)rintf(v[j][2] * inv), q3 = (int)rintf(v[j][3] * inv);
            w = (unsigned)(q0 & 255) | ((unsigned)(q1 & 255) << 8) | ((unsigned)(q2 & 255) << 16) | ((unsigned)q3 << 24); }
        else { int p = __builtin_amdgcn_cvt_pk_fp8_f32(v[j][0] * inv, v[j][1] * inv, 0, false); p = __builtin_amdgcn_cvt_pk_fp8_f32(v[j][2] * inv, v[j][3] * inv, p, true); w = (unsigned)p; }
        o4[(size_t)(2 * j) * NEXP * 32] = w; }
    if (lane == 0) *scale_out = sc;
}
template <bool I8> __device__ __forceinline__ void table_rows8(const float* src, unsigned char* dst, float* scales, const float* colscale, int r0, int r1, int wv, int nwv, int lane) {
    f32x4 cs[8];
#pragma unroll
    for (int j = 0; j < 8; ++j) cs[j] = colscale ? ((const f32x4*)colscale)[64 * j + lane] : (f32x4){1.f, 1.f, 1.f, 1.f};
    for (int m = r0 + wv; m < r1; m += 2 * nwv) {
        const int m2 = m + nwv; const bool two = m2 < r1;
        f32x4 va[8], vb[8];
#pragma unroll
        for (int j = 0; j < 8; ++j) va[j] = ((const f32x4*)(src + (size_t)m * DM))[64 * j + lane];
        if (two) {
#pragma unroll
            for (int j = 0; j < 8; ++j) vb[j] = ((const f32x4*)(src + (size_t)m2 * DM))[64 * j + lane]; }
#pragma unroll
        for (int j = 0; j < 8; ++j) va[j] = va[j] * cs[j];
        row_finish8<I8>(va, dst + (size_t)m * 128, scales + m, lane);
        if (two) {
#pragma unroll
            for (int j = 0; j < 8; ++j) vb[j] = vb[j] * cs[j];
            row_finish8<I8>(vb, dst + (size_t)m2 * 128, scales + m2, lane); }
    }
}
__device__ __forceinline__ void peer_tables(const Params& P, int r0, int r1, int wv, int nwv, int lane) {
    unsigned char* ws = P.ws; unsigned char* U8 = ws + WS_U8; unsigned char* V8 = ws + WS_V8; float* US = (float*)(ws + WS_US); float* VS = (float*)(ws + WS_VS);
    table_rows8<true>(P.peer_u, U8, US, P.g_ffn, r0, r1, wv, nwv, lane);
    table_rows8<false>(P.peer_v, V8, VS, nullptr, r0, r1, wv, nwv, lane);
}
__device__ __forceinline__ void p0_prologue(const Params& P, LAS unsigned char* lds, int gw, int NGW, int wave, int lane, int r1) {
    LAS float* scr = (LAS float*)(lds + wave * 16384);
    unsigned char* ws = P.ws;
    bf16* WA = (bf16*)(ws + WS_WA); bf16* WV = (bf16*)(ws + WS_WV); bf16* WB = (bf16*)(ws + WS_WB); bf16* WO = (bf16*)(ws + WS_WO); bf16* WQ = (bf16*)(ws + WS_WQ);
    bf16* LWA = (bf16*)(ws + WS_LWA); bf16* LWX = (bf16*)(ws + WS_LWX);
    constexpr int I_IN = 32 * 288, I_BR = 16 * 64, I_SQ = 32 * 64, I_L = 8 * 8;
    constexpr int NITEMS = I_IN + 2 * I_BR + 2 * I_SQ + 2 * I_L;
    for (int it = gw; it < NITEMS; it += NGW) {
        int r = it;
        if (r < I_IN) { const int kb = r / 288, nb = r % 288, n0 = 32 * nb;
            unsigned char* d = (n0 < 2048) ? (unsigned char*)WA + (size_t)n0 * 2048 : (n0 < 3072 ? (unsigned char*)WV + (size_t)(n0 - 2048) * 2048 : (unsigned char*)WA + (size_t)(n0 - 1024) * 2048);
            tr_item<true>(P.w_in, 2048, 9216, (bf16*)d, 2048, 64 * kb, n0, nullptr, scr, lane, W8SCALE); continue; } r -= I_IN;
        if (r < 2 * I_BR) { const int br = r / I_BR, q = r % I_BR, kb = q / 64, nb = q % 64;
            tr_item<true>(P.w_branch + (size_t)br * 1024 * 2048, 1024, 2048, (bf16*)((unsigned char*)WB + (size_t)(32 * nb) * 2048 + br * 1024), 2048, 64 * kb, 32 * nb, nullptr, scr, lane, WB8SCALE); continue; } r -= 2 * I_BR;
        if (r < I_SQ) { const int kb = r / 64, nb = r % 64; tr_item<true>(P.w_out, 2048, 2048, (bf16*)((unsigned char*)WO + (size_t)(32 * nb) * 2048), 2048, 64 * kb, 32 * nb, nullptr, scr, lane, W8SCALE); continue; } r -= I_SQ;
        if (r < I_SQ) { const int kb = r / 64, nb = r % 64; tr_item(P.peer_wq, 2048, 2048, WQ + (size_t)(32 * nb) * 2048, 2048, 64 * kb, 32 * nb, P.g_ffn, scr, lane); continue; } r -= I_SQ;
        { const int which = r / I_L, q = r % I_L, g = q / 8, kb = (q % 8) / 4, nb = q % 4;
          tr_item((which ? P.lru_wx : P.lru_wa) + (size_t)g * 16384, 128, 128, (which ? LWX : LWA) + (size_t)g * 16384 + (size_t)(32 * nb) * 128, 128, 64 * kb, 32 * nb, nullptr, scr, lane); }
    }
    { bf16* KB = (bf16*)(ws + WS_KEYS);
      for (int i = gw * 64 + lane; i < 262144 / 8; i += NGW * 64) { const f32x4 a = ((const f32x4*)P.peer_keys)[2 * i], b = ((const f32x4*)P.peer_keys)[2 * i + 1];
          v4u o; o.x = cvtpk(a[0], a[1]); o.y = cvtpk(a[2], a[3]); o.z = cvtpk(b[0], b[1]); o.w = cvtpk(b[2], b[3]); ((v4u*)KB)[i] = o; } }
    { bf16* HN = (bf16*)(ws + WS_HN);
      for (int m = gw; m < T_TOK; m += 2 * NGW) {
          const int m2 = m + NGW; const bool two = m2 < T_TOK;
          f32x4 va[8], vb[8]; float sa = 0.f, sb = 0.f;
#pragma unroll
          for (int j = 0; j < 8; ++j) va[j] = ((const f32x4*)(P.x + (size_t)m * DM))[64 * j + lane];
          if (two) {
#pragma unroll
              for (int j = 0; j < 8; ++j) vb[j] = ((const f32x4*)(P.x + (size_t)m2 * DM))[64 * j + lane]; }
#pragma unroll
          for (int j = 0; j < 8; ++j) sa += (va[j][0] * va[j][0] + va[j][1] * va[j][1]) + (va[j][2] * va[j][2] + va[j][3] * va[j][3]);
          const float ra = __builtin_amdgcn_rsqf(wave_sum(sa) * (1.f / 2048.f) + RMS_EPS);
          unsigned* oa = (unsigned*)((unsigned char*)HN + (size_t)m * DM) + lane;
#pragma unroll
          for (int j = 0; j < 8; ++j) { const f32x4 w = va[j] * ra * ((const f32x4*)P.g_mix)[64 * j + lane]; int p = __builtin_amdgcn_cvt_pk_fp8_f32(w[0], w[1], 0, false); p = __builtin_amdgcn_cvt_pk_fp8_f32(w[2], w[3], p, true); oa[64 * j] = (unsigned)p; }
          if (two) {
#pragma unroll
              for (int j = 0; j < 8; ++j) sb += (vb[j][0] * vb[j][0] + vb[j][1] * vb[j][1]) + (vb[j][2] * vb[j][2] + vb[j][3] * vb[j][3]);
              const float rb = __builtin_amdgcn_rsqf(wave_sum(sb) * (1.f / 2048.f) + RMS_EPS);
              unsigned* ob = (unsigned*)((unsigned char*)HN + (size_t)m2 * DM) + lane;
#pragma unroll
              for (int j = 0; j < 8; ++j) { const f32x4 w = vb[j] * rb * ((const f32x4*)P.g_mix)[64 * j + lane]; int p = __builtin_amdgcn_cvt_pk_fp8_f32(w[0], w[1], 0, false); p = __builtin_amdgcn_cvt_pk_fp8_f32(w[2], w[3], p, true); ob[64 * j] = (unsigned)p; } } } }
    peer_tables(P, 0, r1, gw, NGW, lane);
}

constexpr int AT_KT = 0, AT_VT = 2 * 17408, AT_KM = AT_VT + 2 * 18432, AT_B2 = AT_KM + 4096, AT_SEL = AT_B2 + 512, AT_ANY = AT_SEL + 1024;
#define MFMA32(a, b, c) __builtin_amdgcn_mfma_f32_32x32x16_bf16((a), (b), (c), 0, 0, 0)
__device__ __forceinline__ void attn_unit(const Params& P, LAS unsigned char* lds, int b, int h, int blk, int tid, int wave, int lane) {
    unsigned char* ws = P.ws;
    const bf16* Qb = (const bf16*)(ws + WS_Q); const bf16* Kb = (const bf16*)(ws + WS_K); const bf16* VTg = (const bf16*)(ws + WS_VT); bf16* OATT = (bf16*)(ws + WS_OCAT);
    const float* KMg = (const float*)(ws + WS_CTL) + CW_KM;
    LAS float* KMs = (LAS float*)(lds + AT_KM); LAS float* B2 = (LAS float*)(lds + AT_B2); LAS unsigned* SELM = (LAS unsigned*)(lds + AT_SEL); LAS unsigned* UANY = (LAS unsigned*)(lds + AT_ANY);
    const int row_blk0 = b * SEQ + blk * 256;
    __syncthreads();
    for (int i = tid; i < 1024; i += 512) KMs[i] = KMg[(size_t)(b * 8 + h) * 1024 + i] * (1.f / 256.f);
    if (tid < 128) { const int d = tid; int bucket = d;
        if (d >= 16) { bucket = 16 + (int)(__logf((float)d * (1.f / 16.f)) * (16.f / 2.0794415416798357f)); bucket = bucket > 31 ? 31 : bucket; }
        B2[d] = (P.rel_bias[bucket * 8 + h] - P.rel_bias[31 * 8 + h]) * LOG2E; }
    if (tid == 0) *UANY = 0u;
    __syncthreads();
    {
        const int qq = tid >> 1, q2 = tid & 1;
        unsigned mask = (1u << blk) - 1u;
        if (blk > 3) {
            const bf16* qrow = Qb + (size_t)(row_blk0 + qq) * AW + h * 128;
            v4u qv[8];
#pragma unroll
            for (int c8 = 0; c8 < 8; ++c8) qv[c8] = *(const v4u*)(qrow + 8 * (q2 + 2 * c8));
            float g0 = 0.f, g1 = 0.f, g2 = 0.f, g3 = 0.f, g4 = 0.f, g5 = 0.f, g6 = 0.f;
#pragma unroll
            for (int c8 = 0; c8 < 8; ++c8) { const float q[8] = {bf_lo(qv[c8].x), bf_hi(qv[c8].x), bf_lo(qv[c8].y), bf_hi(qv[c8].y), bf_lo(qv[c8].z), bf_hi(qv[c8].z), bf_lo(qv[c8].w), bf_hi(qv[c8].w)};
#pragma unroll
                for (int e = 0; e < 8; ++e) { const LAS float* km = KMs + 8 * (q2 + 2 * c8) + e;
                    g0 += q[e] * km[0]; g1 += q[e] * km[128]; g2 += q[e] * km[256]; g3 += q[e] * km[384]; g4 += q[e] * km[512]; g5 += q[e] * km[640]; g6 += q[e] * km[768]; } }
            g0 += __shfl_xor(g0, 1); g1 += __shfl_xor(g1, 1); g2 += __shfl_xor(g2, 1); g3 += __shfl_xor(g3, 1); g4 += __shfl_xor(g4, 1); g5 += __shfl_xor(g5, 1); g6 += __shfl_xor(g6, 1);
            const float NEGG = -3.0e38f;
            if (blk < 7) g6 = NEGG; if (blk < 6) g5 = NEGG; if (blk < 5) g4 = NEGG;
            mask = 0u;
#pragma unroll
            for (int s = 0; s < 3; ++s) { float best = g0; int bj = 0;
                if (g1 > best) { best = g1; bj = 1; } if (g2 > best) { best = g2; bj = 2; } if (g3 > best) { best = g3; bj = 3; }
                if (g4 > best) { best = g4; bj = 4; } if (g5 > best) { best = g5; bj = 5; } if (g6 > best) { best = g6; bj = 6; }
                mask |= 1u << bj;
                g0 = bj == 0 ? NEGG : g0; g1 = bj == 1 ? NEGG : g1; g2 = bj == 2 ? NEGG : g2; g3 = bj == 3 ? NEGG : g3; g4 = bj == 4 ? NEGG : g4; g5 = bj == 5 ? NEGG : g5; g6 = bj == 6 ? NEGG : g6; }
        }
        if (q2 == 0) { SELM[qq] = mask; __hip_atomic_fetch_or(UANY, mask, __ATOMIC_RELAXED, __HIP_MEMORY_SCOPE_WORKGROUP); }
    }
    __syncthreads();
    const unsigned uany = *UANY;
    unsigned blist = (unsigned)blk; int nb = 1;
    for (int j = blk - 1; j >= 0; --j) if ((uany >> j) & 1u) { blist |= (unsigned)j << (4 * nb); ++nb; }
    const int nsteps = 4 * nb;
    const int qi = 32 * wave + (lane & 31), hh = lane >> 5;
    const unsigned mymask = SELM[qi];
    bf16x8 Qf[8];
    { const bf16* qp = Qb + (size_t)(row_blk0 + qi) * AW + h * 128 + 8 * hh;
#pragma unroll
      for (int ks = 0; ks < 8; ++ks) Qf[ks] = *(const bf16x8*)(qp + 16 * ks); }
    float m_run = -1.0e30f, lsum = 0.f;
    f32x16 O[4];
#pragma unroll
    for (int dt = 0; dt < 4; ++dt)
#pragma unroll
        for (int r = 0; r < 16; ++r) O[dt][r] = 0.f;
    const int kkey0 = tid >> 4, kpart = tid & 15;
    const int vd0 = tid >> 3, vcc = tid & 7;
    const unsigned kl0 = kkey0 * 272 + kpart * 16, kl1 = kl0 + 32 * 272;
    const unsigned vl0 = vd0 * 144 + ((((vcc >> 2) * 2 + ((vcc & 3) >> 1)) * 2) * 16) + (vcc & 1) * 8, vl1 = vl0 + 64 * 144;
    v4u ka0, ka1, va0, va1, kb0, kb1, vb0, vb1;
#define AT_LOAD(s, k0, k1, v0, v1) do { const int j_ = (blist >> (4 * ((s) >> 2))) & 15, kt_ = (s) & 3; const size_t krow0 = (size_t)b * SEQ + j_ * 256 + kt_ * 64; \
        k0 = *(const v4u*)(Kb + (krow0 + kkey0) * AW + h * 128 + kpart * 8); k1 = *(const v4u*)(Kb + (krow0 + kkey0 + 32) * AW + h * 128 + kpart * 8); \
        v0 = *(const v4u*)(VTg + (size_t)(h * 128 + vd0) * T_TOK + krow0 + vcc * 8); v1 = *(const v4u*)(VTg + (size_t)(h * 128 + vd0 + 64) * T_TOK + krow0 + vcc * 8); } while (0)
#define AT_STORE(bufi, k0, k1, v0, v1) do { LAS unsigned char* KT_ = lds + AT_KT + (bufi) * 17408; LAS unsigned char* VT_ = lds + AT_VT + (bufi) * 18432; \
        *(LAS v4u*)(KT_ + kl0) = k0; *(LAS v4u*)(KT_ + kl1) = k1; \
        *(LAS u64*)(VT_ + vl0) = (u64)v0.x | ((u64)v0.y << 32); *(LAS u64*)(VT_ + vl0 + 16) = (u64)v0.z | ((u64)v0.w << 32); \
        *(LAS u64*)(VT_ + vl1) = (u64)v1.x | ((u64)v1.y << 32); *(LAS u64*)(VT_ + vl1 + 16) = (u64)v1.z | ((u64)v1.w << 32); } while (0)
    AT_LOAD(0, ka0, ka1, va0, va1); AT_STORE(0, ka0, ka1, va0, va1);
    if (1 < nsteps) AT_LOAD(1, ka0, ka1, va0, va1);
    if (2 < nsteps) AT_LOAD(2, kb0, kb1, vb0, vb1);
    for (int s = 0; s < nsteps; ++s) {
        const int j = (blist >> (4 * (s >> 2))) & 15, kt = s & 3;
        __syncthreads();
        if ((s & 1) == 0) { if (s + 1 < nsteps) AT_STORE((s + 1) & 1, ka0, ka1, va0, va1); if (s + 3 < nsteps) AT_LOAD(s + 3, ka0, ka1, va0, va1); }
        else              { if (s + 1 < nsteps) AT_STORE((s + 1) & 1, kb0, kb1, vb0, vb1); if (s + 3 < nsteps) AT_LOAD(s + 3, kb0, kb1, vb0, vb1); }
        const LAS unsigned char* KT = lds + AT_KT + (s & 1) * 17408; const LAS unsigned char* VTl = lds + AT_VT + (s & 1) * 18432;
        bool part;
        if (j == blk) part = (64 * kt <= 32 * wave + 31);
        else part = (__ballot((mymask >> j) & 1u) != 0ull);
        if (part) {
            f32x16 S0, S1;
#pragma unroll
            for (int r = 0; r < 16; ++r) { S0[r] = 0.f; S1[r] = 0.f; }
            const LAS unsigned char* kp = KT + (lane & 31) * 272 + hh * 16;
#pragma unroll
            for (int ks = 0; ks < 8; ++ks) { const bf16x8 a0 = *(const LAS bf16x8*)(kp + ks * 32), a1 = *(const LAS bf16x8*)(kp + 32 * 272 + ks * 32);
                S0 = MFMA32(a0, Qf[ks], S0); S1 = MFMA32(a1, Qf[ks], S1); }
            const bool sel = ((mymask >> j) & 1u) != 0u;
            float mx = -1.0e30f; bool ok_row = true;
            const int dmin = 32 * wave + 256 * (blk - j) - 64 * kt - 63;
            if (dmin < 113) {
                const int dbase = (j == blk) ? (qi - 64 * kt - 4 * hh) : (qi + 256 - 64 * kt - 4 * hh);
                const bool okrow = (j == blk) ? true : sel;
#pragma unroll
                for (int r = 0; r < 16; ++r) { const int kk = (r & 3) + 8 * (r >> 2);
                    { const int dist = dbase - kk; const int di = dist < 0 ? 0 : (dist > 127 ? 127 : dist); const float v = (okrow && dist >= 0) ? S0[r] + B2[di] : -1.0e30f; S0[r] = v; mx = fmaxf(mx, v); }
                    { const int dist = dbase - 32 - kk; const int di = dist < 0 ? 0 : (dist > 127 ? 127 : dist); const float v = (okrow && dist >= 0) ? S1[r] + B2[di] : -1.0e30f; S1[r] = v; mx = fmaxf(mx, v); } }
            } else {
                ok_row = sel || (j == blk);
#pragma unroll
                for (int r = 0; r < 16; ++r) mx = fmaxf(mx, fmaxf(S0[r], S1[r]));
                mx = ok_row ? mx : -1.0e30f;
            }
            mx = fmaxf(mx, __shfl_xor(mx, 32));
            const bool need = mx > m_run + 8.f;
            if (__any(need)) { const float m_new = need ? mx : m_run, alpha = __builtin_amdgcn_exp2f(m_run - m_new);
                m_run = m_new; lsum *= alpha;
#pragma unroll
                for (int dt = 0; dt < 4; ++dt)
#pragma unroll
                    for (int r = 0; r < 16; ++r) O[dt][r] *= alpha; }
            float ps = 0.f;
            const float m_eff = ok_row ? m_run : 1.0e30f;
#pragma unroll
            for (int r = 0; r < 16; ++r) { S0[r] = __builtin_amdgcn_exp2f(S0[r] - m_eff); S1[r] = __builtin_amdgcn_exp2f(S1[r] - m_eff); ps += S0[r] + S1[r]; }
            lsum += ps;
            bf16x8 Pf[2][2];
#pragma unroll
            for (int s2 = 0; s2 < 2; ++s2) {
                v4u p0, p1;
                p0.x = cvtpk(S0[8 * s2], S0[8 * s2 + 1]); p0.y = cvtpk(S0[8 * s2 + 2], S0[8 * s2 + 3]); p0.z = cvtpk(S0[8 * s2 + 4], S0[8 * s2 + 5]); p0.w = cvtpk(S0[8 * s2 + 6], S0[8 * s2 + 7]);
                p1.x = cvtpk(S1[8 * s2], S1[8 * s2 + 1]); p1.y = cvtpk(S1[8 * s2 + 2], S1[8 * s2 + 3]); p1.z = cvtpk(S1[8 * s2 + 4], S1[8 * s2 + 5]); p1.w = cvtpk(S1[8 * s2 + 6], S1[8 * s2 + 7]);
                Pf[0][s2] = __builtin_bit_cast(bf16x8, p0); Pf[1][s2] = __builtin_bit_cast(bf16x8, p1); }
            const LAS unsigned char* vp = VTl + (lane & 31) * 144 + hh * 16;
#pragma unroll
            for (int dt = 0; dt < 4; ++dt)
#pragma unroll
                for (int mt = 0; mt < 2; ++mt)
#pragma unroll
                    for (int s2 = 0; s2 < 2; ++s2) { const bf16x8 a = *(const LAS bf16x8*)(vp + dt * 32 * 144 + (mt * 2 + s2) * 32); O[dt] = MFMA32(a, Pf[mt][s2], O[dt]); }
        }
    }
#undef AT_LOAD
#undef AT_STORE
    const float ltot = lsum + __shfl_xor(lsum, 32), inv = 1.f / ltot;
    unsigned char* orow = (unsigned char*)OATT + (size_t)(row_blk0 + qi) * DM + h * 128 + 4 * hh;
    const float osc = inv * OC8SCALE;
#pragma unroll
    for (int dt = 0; dt < 4; ++dt)
#pragma unroll
        for (int g4 = 0; g4 < 4; ++g4) { int p = __builtin_amdgcn_cvt_pk_fp8_f32(clamp8(O[dt][4 * g4] * osc), clamp8(O[dt][4 * g4 + 1] * osc), 0, false); p = __builtin_amdgcn_cvt_pk_fp8_f32(clamp8(O[dt][4 * g4 + 2] * osc), clamp8(O[dt][4 * g4 + 3] * osc), p, true);
            *(unsigned*)(orow + 32 * dt + 8 * g4) = (unsigned)p; }
}
constexpr int LR_XC = 0, LR_SEG = 2 * 17408, LR_W = LR_SEG + 2 * 4096;
#define MFMA16(a, b, c) __builtin_amdgcn_mfma_f32_16x16x32_bf16((a), (b), (c), 0, 0, 0)
__device__ __forceinline__ void lru_pair(const Params& P, LAS unsigned char* lds, int pair, int tid, int wave, int lane, unsigned* tkword, int& tk_next) {
    unsigned char* ws = P.ws;
    const int grp = wave >> 2, wq = wave & 3, tg = tid & 255;
    const int unit = 2 * pair + grp, b = unit >> 8, g = (unit >> 5) & 7, c = unit & 31;
    const bf16* XR = (const bf16*)(ws + WS_XR); const bf16* LWA = (const bf16*)(ws + WS_LWA) + (size_t)g * 16384; const bf16* LWX = (const bf16*)(ws + WS_LWX) + (size_t)g * 16384;
    float* HL = (float*)(ws + WS_HL); float* AC = (float*)(ws + WS_AC); float* SUM = (float*)(ws + WS_SUM);
    LAS unsigned short* XC = (LAS unsigned short*)(lds + LR_XC + grp * 17408);
    LAS float* SEG = (LAS float*)(lds + LR_SEG + grp * 4096);
    LAS unsigned char* WL = lds + LR_W;
    const int t0 = c * 64; const size_t R0 = (size_t)b * SEQ + t0;
    __syncthreads();
    {
      v4u wv[8];
#pragma unroll
      for (int i = 0; i < 8; ++i) { const int q = tid + 512 * i, mat = q >> 11, row = (q >> 4) & 127, part = q & 15; wv[i] = *(const v4u*)((mat ? LWX : LWA) + row * 128 + part * 8); }
      const int cpart = tg & 15, C8 = g * 128 + 8 * cpart;
      f32x4 cw[4][2], cbv[2];
#pragma unroll
      for (int w = 0; w < 4; ++w) { cw[w][0] = *(const f32x4*)(P.conv_w + w * 1024 + C8); cw[w][1] = *(const f32x4*)(P.conv_w + w * 1024 + C8 + 4); }
      cbv[0] = *(const f32x4*)(P.conv_b + C8); cbv[1] = *(const f32x4*)(P.conv_b + C8 + 4);
#define LR_CONV_LOAD(xr, base) do { _Pragma("unroll") for (int i2 = 0; i2 < 2; ++i2) { const int tl = (tg >> 4) + 16 * ((base) + i2); \
          _Pragma("unroll") for (int w = 0; w < 4; ++w) { const int ts = t0 + tl - 3 + w; xr[i2][w] = (ts >= 0) ? *(const v4u*)(XR + ((size_t)b * SEQ + ts) * AW + C8) : (v4u){0u, 0u, 0u, 0u}; } } } while (0)
#define LR_CONV_DO(xr, base) do { _Pragma("unroll") for (int i2 = 0; i2 < 2; ++i2) { const int tl = (tg >> 4) + 16 * ((base) + i2); f32x4 y0 = cbv[0], y1 = cbv[1]; \
          _Pragma("unroll") for (int w = 0; w < 4; ++w) { y0 = y0 + bf4_lo2(xr[i2][w].x, xr[i2][w].y) * cw[w][0]; y1 = y1 + bf4_lo2(xr[i2][w].z, xr[i2][w].w) * cw[w][1]; } \
          v4u o; o.x = cvtpk(y0[0], y0[1]); o.y = cvtpk(y0[2], y0[3]); o.z = cvtpk(y1[0], y1[1]); o.w = cvtpk(y1[2], y1[3]); \
          *(LAS v4u*)((LAS unsigned char*)XC + tl * 272 + cpart * 16) = o; } } while (0)
      { v4u xr[2][4]; LR_CONV_LOAD(xr, 0);
#pragma unroll
        for (int i = 0; i < 8; ++i) { const int q = tid + 512 * i, mat = q >> 11, row = (q >> 4) & 127, part = q & 15; *(LAS v4u*)(WL + (mat * 128 + row) * 272 + part * 16) = wv[i]; }
        LR_CONV_DO(xr, 0); }
      { v4u xr[2][4]; LR_CONV_LOAD(xr, 2); LR_CONV_DO(xr, 2); }
#undef LR_CONV_LOAD
#undef LR_CONV_DO
    }
    __syncthreads();
    if (tid == 0) tk_next = (int)__hip_atomic_fetch_add(tkword, 1u, __ATOMIC_RELAXED, __HIP_MEMORY_SCOPE_AGENT);
    const int fr = lane & 15, fq = lane >> 4;
    float Ar[2][4][4], Hr[2][4][4], AE[2][4], HE[2][4];
#pragma unroll
    for (int nh = 0; nh < 2; ++nh) {
        f32x4 aA[4], aX[4];
#pragma unroll
        for (int nt = 0; nt < 4; ++nt) { aA[nt] = (f32x4){0.f, 0.f, 0.f, 0.f}; aX[nt] = (f32x4){0.f, 0.f, 0.f, 0.f}; }
#pragma unroll 1
        for (int ks = 0; ks < 4; ++ks) { const bf16x8 a = *(const LAS bf16x8*)((LAS unsigned char*)XC + (16 * wq + fr) * 272 + (32 * ks + 8 * fq) * 2);
#pragma unroll
            for (int nt = 0; nt < 4; ++nt) { const int wo = (64 * nh + 16 * nt + fr) * 272 + (32 * ks + 8 * fq) * 2;
                const bf16x8 ba = *(const LAS bf16x8*)(WL + wo), bx = *(const LAS bf16x8*)(WL + 128 * 272 + wo);
                aA[nt] = MFMA16(a, ba, aA[nt]); aX[nt] = MFMA16(a, bx, aX[nt]); } }
#pragma unroll
        for (int nt = 0; nt < 4; ++nt) { const int ch = 64 * nh + 16 * nt + fr, C = g * 128 + ch;
            const float ba = P.lru_ba[C], bx = P.lru_bx[C], lam = P.lru_lam[C];
            const float sp8 = 8.f * log1pf(__expf(-lam));
            float Ac = 1.f, Hc = 0.f;
#pragma unroll
            for (int r = 0; r < 4; ++r) { const int tok = 16 * wq + 4 * fq + r;
                const float rg = pg8::sigmoid_f(aA[nt][r] + ba), ig = pg8::sigmoid_f(aX[nt][r] + bx);
                const float log_a = -rg * sp8, a = __builtin_amdgcn_exp2f(log_a * 1.4426950408889634f);
                const float y = 2.f * log_a;
                const float em = (y > -0.25f) ? -y * (1.f + y * (0.5f + y * (0.16666667f + y * (0.041666668f + y * (0.0083333338f + y * 0.0013888889f))))) : 1.f - a * a;
                const float u = __builtin_amdgcn_sqrtf(em) * (ig * bf_lo((unsigned)XC[tok * 136 + ch]));
                Hc = a * Hc + u; Ac *= a; Ar[nh][nt][r] = Ac; Hr[nh][nt][r] = Hc; }
            float AI = Ac, HI = Hc;
            { const float Ap = __shfl_up(AI, 16), Hp = __shfl_up(HI, 16); if (fq >= 1) { HI = AI * Hp + HI; AI = AI * Ap; } }
            { const float Ap = __shfl_up(AI, 32), Hp = __shfl_up(HI, 32); if (fq >= 2) { HI = AI * Hp + HI; AI = AI * Ap; } }
            { const float Ap = __shfl_up(AI, 16), Hp = __shfl_up(HI, 16); AE[nh][nt] = fq >= 1 ? Ap : 1.f; HE[nh][nt] = fq >= 1 ? Hp : 0.f; }
            if (fq == 3) { SEG[(wq * 128 + ch) * 2] = AI; SEG[(wq * 128 + ch) * 2 + 1] = HI; } }
    }
    __syncthreads();
#pragma unroll
    for (int nh = 0; nh < 2; ++nh)
#pragma unroll
        for (int nt = 0; nt < 4; ++nt) { const int ch = 64 * nh + 16 * nt + fr, C = g * 128 + ch;
            float Aw = 1.f, Hw = 0.f;
#pragma unroll
            for (int w2 = 0; w2 < 3; ++w2) if (w2 < wq) { const float As = SEG[(w2 * 128 + ch) * 2], Hs = SEG[(w2 * 128 + ch) * 2 + 1]; Hw = As * Hw + Hs; Aw *= As; }
            const float hin = AE[nh][nt] * Hw + HE[nh][nt], ain = AE[nh][nt] * Aw;
            float* hl = HL + (R0 + 16 * wq + 4 * fq) * AW + C; float* ac = AC + (R0 + 16 * wq + 4 * fq) * AW + C;
#pragma unroll
            for (int r = 0; r < 4; ++r) { hl[(size_t)r * AW] = Ar[nh][nt][r] * hin + Hr[nh][nt][r]; ac[(size_t)r * AW] = Ar[nh][nt][r] * ain; }
            if (wq == 3 && fq == 3) { float* sm = SUM + ((size_t)(b * 32 + c) * 1024 + C) * 2; sm[0] = Ar[nh][nt][3] * ain; sm[1] = Ar[nh][nt][3] * hin + Hr[nh][nt][3]; } }
}

constexpr int SC_STR = 129, P7_SAB = 2 * 128 * SC_STR * 4, P7_IL = P7_SAB + 128 * 33 * 4, P7_CT = P7_IL + 128 * 34 * 2;
static_assert(P7_CT + 64 <= MISC_OFF, "P7 LDS map");
__device__ __forceinline__ unsigned ord_key(float v) { const unsigned u = __builtin_bit_cast(unsigned, v); return (u & 0x80000000u) ? ~u : (u | 0x80000000u); }
#define CE_DESC(x, y) do { const unsigned _x = (x), _y = (y); (x) = _x > _y ? _x : _y; (y) = _x > _y ? _y : _x; } while (0)
template <int B, int NA> __device__ __forceinline__ void sort16_desc(unsigned (&a)[NA]) {
#pragma unroll
    for (int k = 2; k <= 16; k <<= 1)
#pragma unroll
        for (int j = k >> 1; j > 0; j >>= 1)
#pragma unroll
            for (int i = 0; i < 16; ++i) { const int l = i ^ j; if (l > i) { if ((i & k) == 0) CE_DESC(a[B + i], a[B + l]); else CE_DESC(a[B + l], a[B + i]); } }
}
template <int A, int Bo, int NA, int NB> __device__ __forceinline__ void merge16_desc(unsigned (&a)[NA], const unsigned (&b)[NB]) {
#pragma unroll
    for (int i = 0; i < 16; ++i) a[A + i] = a[A + i] > b[Bo + 15 - i] ? a[A + i] : b[Bo + 15 - i];
#pragma unroll
    for (int j = 8; j > 0; j >>= 1)
#pragma unroll
        for (int i = 0; i < 16; ++i) { const int l = i ^ j; if (l > i) CE_DESC(a[A + i], a[A + l]); }
}
__device__ __forceinline__ void peer_topk_unit(const Params& P, LAS unsigned char* lds, int t0, int h, int tid, int wave, int lane) {
    unsigned char* ws = P.ws;
    const bf16* QP = (const bf16*)(ws + WS_QP); const bf16* KEYS = (const bf16*)(ws + WS_KEYS);
    int* IDX = (int*)(ws + WS_IDX); float* GW = (float*)(ws + WS_G);
    LAS float* SC = (LAS float*)lds; LAS float* SAB = (LAS float*)(lds + P7_SAB); LAS unsigned short* IL = (LAS unsigned short*)(lds + P7_IL); LAS unsigned char* CT = lds + P7_CT;
    __syncthreads();
    if (tid < 64) { int ia = 0, rem = tid; while (ia < 16 && rem >= 16 / (ia + 1)) { rem -= 16 / (ia + 1); ++ia; }
        CT[tid] = (unsigned char)(ia < 16 ? ia * 16 + rem : 255); }
    { const int mtile = wave & 3, c = wave >> 2, r31 = lane & 31, hh = lane >> 5;
      bf16x8 A[8];
      const bf16* qp = QP + (size_t)(t0 + 32 * mtile + r31) * DM + h * 256 + c * 128 + 8 * hh;
#pragma unroll
      for (int ks = 0; ks < 8; ++ks) A[ks] = *(const bf16x8*)(qp + 16 * ks);
#pragma unroll
      for (int nt = 0; nt < 4; ++nt) { f32x16 acc;
#pragma unroll
          for (int r = 0; r < 16; ++r) acc[r] = 0.f;
          const bf16* kp = KEYS + ((size_t)((h * 2 + c) * 128 + 32 * nt + r31)) * 128 + 8 * hh;
#pragma unroll
          for (int ks = 0; ks < 8; ++ks) { const bf16x8 bk = *(const bf16x8*)(kp + 16 * ks); acc = MFMA32(A[ks], bk, acc); }
#pragma unroll
          for (int r = 0; r < 16; ++r) { const int tok = 32 * mtile + (r & 3) + 8 * (r >> 2) + 4 * hh; SC[(c * 128 + tok) * SC_STR + 32 * nt + r31] = acc[r]; } } }
    __syncthreads();
    const int half = tid & 1, c = (tid >> 1) & 1, tok = tid >> 2;
    unsigned a[64];
    { const LAS float* sp = SC + (c * 128 + tok) * SC_STR + half * 64; const int rot = 8 * (2 * c + half);
#pragma unroll
      for (int i = 0; i < 64; ++i) { const int n = (i + rot) & 63; a[i] = (ord_key(sp[n]) & ~127u) | (unsigned)(127 - (half * 64 + n)); } }
    sort16_desc<0>(a); sort16_desc<16>(a); sort16_desc<32>(a); sort16_desc<48>(a);
    merge16_desc<0, 16>(a, a); merge16_desc<32, 48>(a, a); merge16_desc<0, 32>(a, a);
    { unsigned o[16];
#pragma unroll
      for (int j = 0; j < 16; ++j) o[j] = (unsigned)__shfl_xor((int)a[j], 1);
      merge16_desc<0, 0>(a, o); }
    if (half == 0) {
#pragma unroll
        for (int j = 0; j < 16; ++j) { const int n = 127 - (int)(a[j] & 127u); SAB[tok * 33 + c * 16 + j] = SC[(c * 128 + tok) * SC_STR + n]; IL[tok * 34 + c * 16 + j] = (unsigned short)n; } }
    __syncthreads();
    const int q = tid & 3;
    unsigned cd[16];
#pragma unroll
    for (int j = 0; j < 13; ++j) { const unsigned code = CT[q + 4 * j]; const float s = SAB[tok * 33 + ((code >> 4) & 15u)] + SAB[tok * 33 + 16 + (code & 15u)];
        cd[j] = code == 255u ? 0u : ((ord_key(s) & ~255u) | (255u - code)); }
    cd[13] = 0u; cd[14] = 0u; cd[15] = 0u;
    sort16_desc<0>(cd);
    { unsigned o[16];
#pragma unroll
      for (int j = 0; j < 16; ++j) o[j] = (unsigned)__shfl_xor((int)cd[j], 1);
      merge16_desc<0, 0>(cd, o);
#pragma unroll
      for (int j = 0; j < 16; ++j) o[j] = (unsigned)__shfl_xor((int)cd[j], 2);
      merge16_desc<0, 0>(cd, o); }
    if (q == 0) {
        float cv[16]; int id[16];
#pragma unroll
        for (int s = 0; s < 16; ++s) { const unsigned code = 255u - (cd[s] & 255u); const int ia = (int)(code >> 4), ib = (int)(code & 15u); const int na = IL[tok * 34 + ia], nb = IL[tok * 34 + 16 + ib];
            cv[s] = SAB[tok * 33 + ia] + SAB[tok * 33 + 16 + ib]; id[s] = na * 128 + nb; }
        float mx = cv[0];
#pragma unroll
        for (int s = 1; s < 16; ++s) mx = fmaxf(mx, cv[s]);
        float sum = 0.f;
#pragma unroll
        for (int s = 0; s < 16; ++s) { cv[s] = __builtin_amdgcn_exp2f((cv[s] - mx) * LOG2E); sum += cv[s]; }
        const float inv = 1.f / sum;
        int* ip = IDX + (size_t)(t0 + tok) * 128 + h * 16; float* gp = GW + (size_t)(t0 + tok) * 128 + h * 16;
#pragma unroll
        for (int s4 = 0; s4 < 4; ++s4) { *(int4*)(ip + 4 * s4) = make_int4(id[4 * s4], id[4 * s4 + 1], id[4 * s4 + 2], id[4 * s4 + 3]);
            *(f32x4*)(gp + 4 * s4) = (f32x4){cv[4 * s4] * inv, cv[4 * s4 + 1] * inv, cv[4 * s4 + 2] * inv, cv[4 * s4 + 3] * inv}; }
    }
}

__device__ __forceinline__ void fp8x16_to_f32(const v4u& w, float (&f)[16]) {
#pragma unroll
    for (int i = 0; i < 4; ++i) { const f32x2_t lo = __builtin_amdgcn_cvt_pk_f32_fp8((int)w[i], false), hi = __builtin_amdgcn_cvt_pk_f32_fp8((int)w[i], true);
        f[4 * i] = lo[0]; f[4 * i + 1] = lo[1]; f[4 * i + 2] = hi[0]; f[4 * i + 3] = hi[1]; }
}
#define LD16I(dst, p) do { _Pragma("unroll") for (int q_ = 0; q_ < 4; ++q_) { const int4 v_ = ((const int4*)(p))[q_]; dst[4 * q_] = v_.x; dst[4 * q_ + 1] = v_.y; dst[4 * q_ + 2] = v_.z; dst[4 * q_ + 3] = v_.w; } } while (0)
#define LD16F(dst, p) do { _Pragma("unroll") for (int q_ = 0; q_ < 4; ++q_) { const f32x4 v_ = ((const f32x4*)(p))[q_]; dst[4 * q_] = v_[0]; dst[4 * q_ + 1] = v_[1]; dst[4 * q_ + 2] = v_[2]; dst[4 * q_ + 3] = v_[3]; } } while (0)
__device__ __forceinline__ void peer_u_phase(const Params& P, int xg, int slot, int nslots, int lane) {
    unsigned char* ws = P.ws;
    const bf16* X1B = (const bf16*)(ws + WS_X1B); const unsigned char* U8 = ws + WS_U8; const int* IDX = (const int*)(ws + WS_IDX); float* PD = (float*)(ws + WS_PD) + (size_t)xg * T_TOK * 128;
    const int ntok = slot < T_TOK ? (T_TOK - slot + nslots - 1) / nslots : 0, N = 2 * ntok;
    if (N == 0) return;
    const int R = lane >> 3, p = lane & 7;
    const bool b2 = (lane & 4) != 0, b1 = (lane & 2) != 0, b0 = (lane & 1) != 0;
    int idn[16], idq[16]; v4u xc[2], xn[2]; v4u B0[8], B1[8], B2[8];
#define U_ITEM(n, t, s) const int n_##t = (n) < N ? (n) : N - 1; const int t = slot + (n_##t >= ntok ? n_##t - ntok : n_##t) * nslots, s = 2 * xg + (n_##t >= ntok ? 1 : 0)
#define U_ROWS(buf, ids, off, s) do { const unsigned char* ub_ = U8 + (size_t)(s) * NEXP * 128; _Pragma("unroll") for (int i = 0; i < 8; ++i) buf[i] = *(const v4u*)(ub_ + (unsigned)(((unsigned)ids[(off) + i] << 7) + 16u * p)); } while (0)
#define U_HALF(buf, off) do { _Pragma("unroll") for (int i = 0; i < 8; ++i) { int d = 0; _Pragma("unroll") for (int w = 0; w < 4; ++w) d = __builtin_amdgcn_sdot4((int)buf[i][w], xq[w], d, false); part[(off) + i] = d; } } while (0)
    { U_ITEM(0, t0, s0); U_ITEM(1, t1, s1);
      int id0[16];
#pragma unroll
      LD16I(id0, IDX + (size_t)t0 * 128 + 16 * R); LD16I(idn, IDX + (size_t)t1 * 128 + 16 * R);
      const bf16* xp = X1B + (size_t)t0 * DM + 128 * s0 + 16 * p; xc[0] = *(const v4u*)xp; xc[1] = *(const v4u*)(xp + 8);
      U_ROWS(B0, id0, 0, s0); U_ROWS(B1, id0, 8, s0); }
#define U_BODY(n, Ba, Bb, Bc) do { \
        U_ITEM(n, t, s); U_ITEM((n) + 1, t1, s1); U_ITEM((n) + 2, t2, s2); (void)s; (void)s2; \
        U_ROWS(Bc, idn, 0, s1); \
        LD16I(idq, IDX + (size_t)t2 * 128 + 16 * R); \
        { const bf16* xp = X1B + (size_t)t1 * DM + 128 * s1 + 16 * p; xn[0] = *(const v4u*)xp; xn[1] = *(const v4u*)(xp + 8); } \
        float x[16]; float am = 0.f; \
        _Pragma("unroll") for (int k = 0; k < 4; ++k) { x[2 * k] = bf_lo(xc[0][k]); x[2 * k + 1] = bf_hi(xc[0][k]); x[8 + 2 * k] = bf_lo(xc[1][k]); x[8 + 2 * k + 1] = bf_hi(xc[1][k]); } \
        _Pragma("unroll") for (int k = 0; k < 16; ++k) am = fmaxf(am, fabsf(x[k])); \
        am = fmaxf(am, __shfl_xor(am, 1)); am = fmaxf(am, __shfl_xor(am, 2)); am = fmaxf(am, __shfl_xor(am, 4)); \
        const float xs = am > 0.f ? am * (1.f / 127.f) : 1.f, xinv = 1.f / xs; \
        int xq[4]; \
        _Pragma("unroll") for (int w = 0; w < 4; ++w) { const int q0 = (int)rintf(x[4 * w] * xinv), q1 = (int)rintf(x[4 * w + 1] * xinv), q2 = (int)rintf(x[4 * w + 2] * xinv), q3 = (int)rintf(x[4 * w + 3] * xinv); \
            xq[w] = (int)((unsigned)(q0 & 255) | ((unsigned)(q1 & 255) << 8) | ((unsigned)(q2 & 255) << 16) | ((unsigned)q3 << 24)); } \
        int part[16]; \
        U_HALF(Ba, 0); \
        U_ROWS(Ba, idn, 8, s1); \
        U_HALF(Bb, 8); \
        if ((n) < N) { \
            int a8[8], a4[4], a2i[2]; \
            _Pragma("unroll") for (int k = 0; k < 8; ++k) { const int send = b2 ? part[k] : part[k + 8], keep = b2 ? part[k + 8] : part[k]; a8[k] = keep + __shfl_xor(send, 4); } \
            _Pragma("unroll") for (int k = 0; k < 4; ++k) { const int send = b1 ? a8[k] : a8[k + 4], keep = b1 ? a8[k + 4] : a8[k]; a4[k] = keep + __shfl_xor(send, 2); } \
            _Pragma("unroll") for (int k = 0; k < 2; ++k) { const int send = b0 ? a4[k] : a4[k + 2], keep = b0 ? a4[k + 2] : a4[k]; a2i[k] = keep + __shfl_xor(send, 1); } \
            const float a2[2] = {(float)a2i[0] * xs, (float)a2i[1] * xs}; \
            const int i0 = (b2 ? 8 : 0) + (b1 ? 4 : 0) + (b0 ? 2 : 0); \
            f32x2_t* pp = (f32x2_t*)(PD + (size_t)t * 128 + 16 * R + i0); \
            f32x2_t pv_ = (f32x2_t){a2[0], a2[1]}; if ((n) >= ntok) pv_ = pv_ + *pp; \
            *pp = pv_; } \
        _Pragma("unroll") for (int i = 0; i < 16; ++i) idn[i] = idq[i]; \
        xc[0] = xn[0]; xc[1] = xn[1]; } while (0)
    for (int n = 0; n < N; n += 3) { U_BODY(n, B0, B1, B2); U_BODY(n + 1, B2, B0, B1); U_BODY(n + 2, B1, B2, B0); }
#undef U_ITEM
#undef U_ROWS
#undef U_HALF
#undef U_BODY
}
__device__ __forceinline__ void peer_act_tokens(const Params& P, int t, int t2, int lane) {
    unsigned char* ws = P.ws;
    const float* PD = (const float*)(ws + WS_PD); const int* IDX = (const int*)(ws + WS_IDX); const float* GW = (const float*)(ws + WS_G); const float* SSP = (const float*)(ws + WS_SSP);
    const float* US = (const float*)(ws + WS_US); const float* VS = (const float*)(ws + WS_VS); float* ACT = (float*)(ws + WS_ACT);
    const bool two = t2 >= 0; const int tt[2] = {t, two ? t2 : t};
    float ss[2], d[2][2], gw[2][2], us[2][2], vs[2][2]; int id[2][2];
#pragma unroll
    for (int k = 0; k < 2; ++k) { ss[k] = lane < 32 ? SSP[(size_t)tt[k] * 32 + lane] : 0.f;
#pragma unroll
        for (int s = 0; s < 2; ++s) { const int slot = 64 * s + lane; id[k][s] = IDX[(size_t)tt[k] * 128 + slot]; gw[k][s] = GW[(size_t)tt[k] * 128 + slot]; float a = 0.f;
#pragma unroll
            for (int xg = 0; xg < 8; ++xg) a += PD[((size_t)xg * T_TOK + tt[k]) * 128 + slot];
            d[k][s] = a; } }
#pragma unroll
    for (int k = 0; k < 2; ++k)
#pragma unroll
        for (int s = 0; s < 2; ++s) { us[k][s] = US[id[k][s]]; vs[k][s] = VS[id[k][s]]; }
#pragma unroll
    for (int k = 0; k < 2; ++k) { const float rs = __builtin_amdgcn_rsqf(wave_sum(ss[k]) * (1.f / 2048.f) + RMS_EPS);
        if (k == 0 || two) {
#pragma unroll
            for (int s = 0; s < 2; ++s) ACT[(size_t)tt[k] * 128 + 64 * s + lane] = pg8::gelu_tanh_f(d[k][s] * us[k][s] * rs) * gw[k][s] * vs[k][s]; } }
}
#define PIN16(a) asm volatile("" : "+v"(a[0]), "+v"(a[1]), "+v"(a[2]), "+v"(a[3]), "+v"(a[4]), "+v"(a[5]), "+v"(a[6]), "+v"(a[7]), "+v"(a[8]), "+v"(a[9]), "+v"(a[10]), "+v"(a[11]), "+v"(a[12]), "+v"(a[13]), "+v"(a[14]), "+v"(a[15]))
__device__ __forceinline__ void peer_v_phase(const Params& P, int xg, int slot, int nslots, int lane) {
    unsigned char* ws = P.ws;
    const unsigned char* V8 = ws + WS_V8; const int* IDX = (const int*)(ws + WS_IDX); const float* ACT = (const float*)(ws + WS_ACT); bf16* OUTP = (bf16*)(ws + WS_OUTP);
    const int ntok = slot < T_TOK ? (T_TOK - slot + nslots - 1) / nslots : 0, N = 2 * ntok;
    if (N == 0) return;
    const int R = lane >> 3, p = lane & 7;
    const bool b5 = (lane & 32) != 0, b4 = (lane & 16) != 0, b3 = (lane & 8) != 0;
    int idn[16], idq[16]; float avc[16], avn[16]; v4u B0[8], B1[8], B2[8];
#define V_ITEM(n, t, s) const int n_##t = (n) < N ? (n) : N - 1; const int t = slot + (n_##t >= ntok ? n_##t - ntok : n_##t) * nslots, s = 2 * xg + (n_##t >= ntok ? 1 : 0)
#define V_ROWS(buf, ids, off, s) do { const unsigned char* vb_ = V8 + (size_t)(s) * NEXP * 128; _Pragma("unroll") for (int i = 0; i < 8; ++i) buf[i] = *(const v4u*)(vb_ + (unsigned)(((unsigned)ids[(off) + i] << 7) + 16u * p)); } while (0)
#define V_HALF(buf, off) do { _Pragma("unroll") for (int i = 0; i < 8; ++i) { asm volatile("" : "+v"(buf[i][0]), "+v"(buf[i][1]), "+v"(buf[i][2]), "+v"(buf[i][3])); \
            float f[16]; fp8x16_to_f32(buf[i], f); _Pragma("unroll") for (int k = 0; k < 16; ++k) acc[k] += avc[(off) + i] * f[k]; PIN16(acc); } } while (0)
    { V_ITEM(0, t0, s0); V_ITEM(1, t1, s1);
      int id0[16];
#pragma unroll
      for (int i = 0; i < 1; ++i) { LD16I(id0, IDX + (size_t)t0 * 128 + 16 * R); LD16I(idn, IDX + (size_t)t1 * 128 + 16 * R); LD16F(avc, ACT + (size_t)t0 * 128 + 16 * R); }
      V_ROWS(B0, id0, 0, s0); V_ROWS(B1, id0, 8, s0); }
#define V_BODY(n, Ba, Bb, Bc) do { \
        V_ITEM(n, t, s); V_ITEM((n) + 1, t1, s1); V_ITEM((n) + 2, t2, s2); (void)s2; \
        V_ROWS(Bc, idn, 0, s1); \
        LD16I(idq, IDX + (size_t)t2 * 128 + 16 * R); LD16F(avn, ACT + (size_t)t1 * 128 + 16 * R); \
        float acc[16]; \
        _Pragma("unroll") for (int k = 0; k < 16; ++k) acc[k] = 0.f; \
        V_HALF(Ba, 0); \
        V_ROWS(Ba, idn, 8, s1); \
        V_HALF(Bb, 8); \
        if ((n) < N) { \
            float a8[8], a4[4], a2[2]; \
            _Pragma("unroll") for (int k = 0; k < 8; ++k) { const float send = b5 ? acc[k] : acc[k + 8], keep = b5 ? acc[k + 8] : acc[k]; a8[k] = keep + __shfl_xor(send, 32); } \
            _Pragma("unroll") for (int k = 0; k < 4; ++k) { const float send = b4 ? a8[k] : a8[k + 4], keep = b4 ? a8[k + 4] : a8[k]; a4[k] = keep + __shfl_xor(send, 16); } \
            _Pragma("unroll") for (int k = 0; k < 2; ++k) { const float send = b3 ? a4[k] : a4[k + 2], keep = b3 ? a4[k + 2] : a4[k]; a2[k] = keep + __shfl_xor(send, 8); } \
            const int col = 128 * s + 16 * p + (b5 ? 8 : 0) + (b4 ? 4 : 0) + (b3 ? 2 : 0); \
            *(unsigned*)(OUTP + (size_t)t * DM + col) = cvtpk(a2[0], a2[1]); } \
        _Pragma("unroll") for (int i = 0; i < 16; ++i) { idn[i] = idq[i]; avc[i] = avn[i]; } } while (0)
    for (int n = 0; n < N; n += 3) { V_BODY(n, B0, B1, B2); V_BODY(n + 1, B2, B0, B1); V_BODY(n + 2, B1, B2, B0); }
#undef V_ITEM
#undef V_ROWS
#undef V_HALF
#undef V_BODY
}
__device__ __forceinline__ void peer_final_tokens(const Params& P, int t, int t2, int lane, float* outp) {
    const bool two = t2 >= 0; const int tt[2] = {t, two ? t2 : t};
    v4u a[2][4], b[2][4];
#pragma unroll
    for (int k = 0; k < 2; ++k) { const bf16* xrow = (const bf16*)(P.ws + WS_X1B) + (size_t)tt[k] * DM; const bf16* prow = (const bf16*)(P.ws + WS_OUTP) + (size_t)tt[k] * DM;
#pragma unroll
        for (int j = 0; j < 4; ++j) { a[k][j] = *(const v4u*)(xrow + 512 * j + 8 * lane); b[k][j] = *(const v4u*)(prow + 512 * j + 8 * lane); } }
#pragma unroll
    for (int k = 0; k < 2; ++k) { if (k == 1 && !two) break;
        float v[4][8]; float ss = 0.f;
#pragma unroll
        for (int j = 0; j < 4; ++j) {
#pragma unroll
            for (int i = 0; i < 4; ++i) { v[j][2 * i] = bf_lo(a[k][j][i]) + bf_lo(b[k][j][i]); v[j][2 * i + 1] = bf_hi(a[k][j][i]) + bf_hi(b[k][j][i]); }
#pragma unroll
            for (int i = 0; i < 8; ++i) ss += v[j][i] * v[j][i]; }
        const float rf = __builtin_amdgcn_rsqf(wave_sum(ss) * (1.f / 2048.f) + RMS_EPS);
        float* orow = outp + (size_t)tt[k] * DM;
#pragma unroll
        for (int j = 0; j < 4; ++j) { const f32x4 g0 = *(const f32x4*)(P.g_fin + 512 * j + 8 * lane), g1 = *(const f32x4*)(P.g_fin + 512 * j + 8 * lane + 4); f32x4 o0, o1;
#pragma unroll
            for (int i = 0; i < 4; ++i) { o0[i] = v[j][i] * rf * g0[i]; o1[i] = v[j][4 + i] * rf * g1[i]; }
            *(f32x4*)(orow + 512 * j + 8 * lane) = o0; *(f32x4*)(orow + 512 * j + 8 * lane + 4) = o1; } }
}

#ifndef MK_PER_PHASE
#define MK_PER_PHASE 0
#endif
constexpr int N_PHASES = 12;
#ifndef TAB_P0_ROWS
#define TAB_P0_ROWS 2048
#endif
__global__ void __launch_bounds__(NWAVES * 64, 2) fwd_kernel(Params P) {
    extern __shared__ __attribute__((aligned(16))) unsigned char lds_raw[];
    LAS unsigned char* lds = (LAS unsigned char*)lds_raw;
    volatile LAS unsigned* MISC = (volatile LAS unsigned*)(lds + MISC_OFF);
    const int tid = threadIdx.x, lane = tid & 63, wave = __builtin_amdgcn_readfirstlane(tid >> 6);
    const int G = gridDim.x; const int bx = blockIdx.x;
    const int vcu = (G % 8 == 0) ? (bx % 8) * (G / 8) + bx / 8 : bx;
    const int gw = vcu * NWAVES + wave, NGW = G * NWAVES;
    unsigned char* ws = P.ws;
    gu32* ctl = (gu32*)(ws + WS_CTL);
    for (int u = tid; u < 64; u += NWAVES * 64) MISC[u] = 0u;
    __syncthreads();
    XcdBarrier bar; bar.bar = (unsigned*)ctl + CW_BAR; bar.x = 0; bar.st = nullptr;
    if (!MK_PER_PHASE) bar = xcd_barrier_post((unsigned*)ctl + CW_BAR, MISC + 8);
    const unsigned my_xcc = xb_xcc_id();
    if (!MK_PER_PHASE) { if (tid == 0) MISC[16] = __hip_atomic_fetch_add((unsigned*)(ctl + CW_XC + 64 * (my_xcc & 7u)), 1u, __ATOMIC_RELAXED, __HIP_MEMORY_SCOPE_AGENT); }
    const int lo = P.ph_lo, hi = P.ph_hi;
#define FRESH_IDS const int lane = (int)__builtin_amdgcn_mbcnt_hi(~0u, __builtin_amdgcn_mbcnt_lo(~0u, 0u)); const int tid = wave * 64 + lane; (void)tid; (void)lane
#ifndef PH_MASK
#define PH_MASK 0xfff
#endif
#define IN(k) (((PH_MASK >> (k)) & 1) && lo <= (k) && (k) < hi)
#define BOTH(k) (IN(k) && IN((k) + 1))
#ifndef DUP_MASK
#define DUP_MASK 0
#endif
#define NREP(k) (((DUP_MASK >> (k)) & 1) ? 2 : 1)
#define GRID_BAR() do { if (!MK_PER_PHASE) xcd_barrier(bar); } while (0)

    bf16* HN = (bf16*)(ws + WS_HN); bf16* WA = (bf16*)(ws + WS_WA); bf16* WV = (bf16*)(ws + WS_WV); bf16* WB = (bf16*)(ws + WS_WB); bf16* WO = (bf16*)(ws + WS_WO); bf16* WQ = (bf16*)(ws + WS_WQ);

    constexpr int NV_UNITS = (AW / 256) * (T_TOK / 256);
    const int tab_r1 = (G > NV_UNITS && (1024 % G) == 0) ? TAB_P0_ROWS : NEXP;
    if (IN(0)) { FRESH_IDS; for (int rep = 0; rep < NREP(0); ++rep) p0_prologue(P, lds, gw, NGW, wave, lane, tab_r1); if (BOTH(0)) GRID_BAR(); }

    if (IN(1)) { FRESH_IDS;
      _Pragma("unroll") for (int rep = 0; rep < NREP(1); ++rep) {
        { pg8::Gemm g{HN, WA, T_TOK, NWA, DM / 2, WV, HN, ws, (unsigned)WS_END}; pg8::StaticOrder2 S; S.init(T_TOK, NWA, AW, T_TOK, G, bx);
          pg8::EpiProj E{(bf16*)(ws + WS_Q), (bf16*)(ws + WS_K), (bf16*)(ws + WS_XR), (bf16*)(ws + WS_GY), (bf16*)(ws + WS_SG), (bf16*)(ws + WS_VT), rep == 0 ? (float*)(ws + WS_CTL) + CW_KM : nullptr, QSCALE, 1.f / W8SCALE};
          pg8::gemm_phase<pg8::EpiProj, pg8::StaticOrder2, true, true, true>(lds, g, S, E); }
        if (G > NV_UNITS && (1024 % G) == 0 && bx >= NV_UNITS) peer_tables(P, tab_r1, NEXP, (bx - NV_UNITS) * NWAVES + wave, (G - NV_UNITS) * NWAVES, lane);
      }
        if (BOTH(1)) GRID_BAR();
    }

    if (IN(2)) { FRESH_IDS;
        LAS int* tick = (LAS int*)(lds + MISC_OFF + 128);
#define NEXT_TICKET(dst, word) do { __syncthreads(); if (tid == 0) *tick = (int)__hip_atomic_fetch_add((unsigned*)(ctl + (word)), 1u, __ATOMIC_RELAXED, __HIP_MEMORY_SCOPE_AGENT); __syncthreads(); dst = *tick; } while (0)
#define TICKET_ISSUE(word) do { if (tid == 0) tk_next = (int)__hip_atomic_fetch_add((unsigned*)(ctl + (word)), 1u, __ATOMIC_RELAXED, __HIP_MEMORY_SCOPE_AGENT); } while (0)
#define TICKET_TAKE(dst) do { __syncthreads(); if (tid == 0) *tick = tk_next; __syncthreads(); dst = *tick; } while (0)
        int tk_next = 0;
#ifndef DUP_ATT
#define DUP_ATT 0
#endif
#ifndef DUP_LRU
#define DUP_LRU 0
#endif
#ifndef DUP_P2
#define DUP_P2 0
#endif
        _Pragma("unroll") for (int rp = 0; rp < 1 + DUP_P2; ++rp) {
        _Pragma("unroll") for (int rep = 0; rep < 1 + DUP_ATT; ++rep) {
            int tid2 = tid; asm volatile("" : "+v"(tid2));
            int it; NEXT_TICKET(it, CW_Q2 + 64 * (rep + 2 * rp));
            while (it < 256) { const int blk = 7 - (it >> 5), bh = it & 31; attn_unit(P, lds, bh >> 3, bh & 7, blk, tid2, wave, tid2 & 63); NEXT_TICKET(it, CW_Q2 + 64 * (rep + 2 * rp)); } }
        _Pragma("unroll") for (int rep = 0; rep < 1 + DUP_LRU; ++rep) {
            int tid2 = tid; asm volatile("" : "+v"(tid2));
            int it; NEXT_TICKET(it, CW_Q2 + 256 + 64 * (rep + 2 * rp));
            while (it < 512) { lru_pair(P, lds, it, tid2, wave, tid2 & 63, (unsigned*)(ctl + CW_Q2 + 256 + 64 * (rep + 2 * rp)), tk_next); TICKET_TAKE(it); } }
        if (DUP_P2 && rp == 0) GRID_BAR();
        }
#undef NEXT_TICKET
#undef TICKET_ISSUE
#undef TICKET_TAKE
        if (BOTH(2)) GRID_BAR();
    }

    if (IN(3)) { FRESH_IDS;
      _Pragma("unroll") for (int rep = 0; rep < NREP(3); ++rep) {
        const float* HL = (const float*)(ws + WS_HL); const float* AC = (const float*)(ws + WS_AC); const float* SUM = (const float*)(ws + WS_SUM);
        const bf16* GY = (const bf16*)(ws + WS_GY); unsigned char* OCAT = ws + WS_OCAT;
        for (int u = vcu; u < 256; u += G) { const int b = u >> 6, c = (u >> 1) & 31, C = (u & 1) * 512 + 4 * (tid & 127), tq = tid >> 7;
            f32x4 carry = (f32x4){0.f, 0.f, 0.f, 0.f};
            for (int cc = 0; cc < c; ++cc) { const float* sm = SUM + ((size_t)(b * 32 + cc) * 1024 + C) * 2; const f32x4 s0 = *(const f32x4*)sm, s1 = *(const f32x4*)(sm + 4);
                carry[0] = s0[0] * carry[0] + s0[1]; carry[1] = s0[2] * carry[1] + s0[3]; carry[2] = s1[0] * carry[2] + s1[1]; carry[3] = s1[2] * carry[3] + s1[3]; }
            const size_t R0 = (size_t)b * SEQ + c * 64 + tq * 16;
#pragma unroll 8
            for (int t = 0; t < 16; ++t) { const size_t o = (R0 + t) * AW + C; const f32x4 hv = *(const f32x4*)(HL + o) + *(const f32x4*)(AC + o) * carry;
                const unsigned long long gy = *(const unsigned long long*)(GY + o); const unsigned g0 = (unsigned)gy, g1 = (unsigned)(gy >> 32);
                int p = __builtin_amdgcn_cvt_pk_fp8_f32(clamp8(hv[0] * bf_lo(g0) * OC8SCALE), clamp8(hv[1] * bf_hi(g0) * OC8SCALE), 0, false); p = __builtin_amdgcn_cvt_pk_fp8_f32(clamp8(hv[2] * bf_lo(g1) * OC8SCALE), clamp8(hv[3] * bf_hi(g1) * OC8SCALE), p, true);
                *(unsigned*)(OCAT + (R0 + t) * DM + AW + C) = (unsigned)p; } }
      }
        if (BOTH(3)) GRID_BAR();
    }

    if (IN(4)) { FRESH_IDS;
      _Pragma("unroll") for (int rep = 0; rep < NREP(4); ++rep) {
        { pg8::Gemm g{(bf16*)(ws + WS_OCAT), WB, T_TOK, DM, DM / 2, nullptr, nullptr, ws, (unsigned)WS_END}; pg8::StaticOrder S; S.init(T_TOK, DM, G, bx);
          pg8::EpiMerge2 E{(const bf16*)(ws + WS_SG), (bf16*)(ws + WS_MG), MG8SCALE / (OC8SCALE * WB8SCALE)};
          pg8::gemm_phase<pg8::EpiMerge2, pg8::StaticOrder, true, true, true>(lds, g, S, E); }
      }
        if (BOTH(4)) GRID_BAR();
    }

    if (IN(5)) { FRESH_IDS;
      _Pragma("unroll") for (int rep = 0; rep < NREP(5); ++rep) {
        pg8::Gemm g{(bf16*)(ws + WS_MG), WO, T_TOK, DM, DM / 2, nullptr, nullptr, ws, (unsigned)WS_END}; pg8::StaticOrder S; S.init(T_TOK, DM, G, bx);
        pg8::EpiResid E{P.x, (bf16*)(ws + WS_X1B), (float*)(ws + WS_SSP), 1.f / (W8SCALE * MG8SCALE)};
        pg8::gemm_phase<pg8::EpiResid, pg8::StaticOrder, true, true, true>(lds, g, S, E);
      }
        if (BOTH(5)) GRID_BAR();
    }

    if (IN(6)) { FRESH_IDS;
      _Pragma("unroll") for (int rep = 0; rep < NREP(6); ++rep) {
        pg8::Gemm g{(bf16*)(ws + WS_X1B), WQ, T_TOK, DM, DM, nullptr, nullptr, ws, (unsigned)WS_END}; pg8::StaticOrder S; S.init(T_TOK, DM, G, bx);
        pg8::EpiRowScale E{(const float*)(ws + WS_SSP), (bf16*)(ws + WS_QP)};
        pg8::gemm_phase<pg8::EpiRowScale, pg8::StaticOrder, true, true>(lds, g, S, E);
        { pg8::Unit u; for (int i = 0; S.next(i, u); ++i) { peer_topk_unit(P, lds, u.pm * 256, u.pn, tid, wave, lane); peer_topk_unit(P, lds, u.pm * 256 + 128, u.pn, tid, wave, lane); } }
      }
        if (BOTH(6)) GRID_BAR();
    }

    int xg = bx & 7, nblk_g = (G - xg + 7) >> 3, rank_g = bx >> 3;
    if (!MK_PER_PHASE && lo == 0 && hi > 8) {
        unsigned cnt[8], sum = 0u; bool ok = my_xcc < 8u;
#pragma unroll
        for (int j = 0; j < 8; ++j) { cnt[j] = __hip_atomic_load((unsigned*)(ctl + CW_XC + 64 * j), __ATOMIC_RELAXED, __HIP_MEMORY_SCOPE_AGENT); sum += cnt[j]; ok = ok && cnt[j] > 0u; }
        if (ok && sum == (unsigned)G) { xg = (int)my_xcc; rank_g = (int)MISC[16];
            nblk_g = (int)(xg == 0 ? cnt[0] : xg == 1 ? cnt[1] : xg == 2 ? cnt[2] : xg == 3 ? cnt[3] : xg == 4 ? cnt[4] : xg == 5 ? cnt[5] : xg == 6 ? cnt[6] : cnt[7]); }
    }
    const int nslots = nblk_g * NWAVES, slot = rank_g * NWAVES + wave;
    if (IN(8)) { FRESH_IDS;
        _Pragma("unroll") for (int rep = 0; rep < NREP(8); ++rep)
        peer_u_phase(P, xg, slot, nslots, lane);
        if (BOTH(8)) GRID_BAR();
    }
#ifdef EXTRA_BARS
    for (int eb = 0; eb < EXTRA_BARS; ++eb) GRID_BAR();
#endif
    if (IN(9)) { FRESH_IDS;
        for (int t = gw; t < T_TOK; t += 2 * NGW) peer_act_tokens(P, t, t + NGW < T_TOK ? t + NGW : -1, lane);
        if (BOTH(9)) GRID_BAR();
    }
    if (IN(10)) { FRESH_IDS;
        _Pragma("unroll") for (int rep = 0; rep < NREP(10); ++rep)
        peer_v_phase(P, xg, slot, nslots, lane);
        if (BOTH(10)) GRID_BAR();
    }
    if (IN(11)) { FRESH_IDS;
        if (NREP(11) == 2) for (int t = gw; t < T_TOK; t += 2 * NGW) peer_final_tokens(P, t, t + NGW < T_TOK ? t + NGW : -1, lane, (float*)(ws + WS_MG));
        for (int t = gw; t < T_TOK; t += 2 * NGW) peer_final_tokens(P, t, t + NGW < T_TOK ? t + NGW : -1, lane, P.out);
    }
#undef IN
#undef BOTH
#undef GRID_BAR
}

extern "C" void kernel_launch(void* const* d_in, const int* in_sizes, int n_in, void* d_out, int out_size, void* d_ws, size_t ws_size, hipStream_t stream) {
    static int grid = 0;
    if (grid == 0) {
        if (n_in != 19 || out_size != T_TOK * DM || ws_size < WS_END) { fprintf(stderr, "kernel_launch: unexpected problem (n_in %d, out %d, ws %zu); nothing launched\n", n_in, out_size, ws_size); grid = -1; return; }
        int dev = 0, cus = 0, per_cu = 0;
        if (hipGetDevice(&dev) != hipSuccess || hipDeviceGetAttribute(&cus, hipDeviceAttributeMultiprocessorCount, dev) != hipSuccess) { grid = -1; return; }
        if (hipFuncSetAttribute((const void*)fwd_kernel, hipFuncAttributeMaxDynamicSharedMemorySize, LDS_BYTES) != hipSuccess) { fprintf(stderr, "kernel_launch: hipFuncSetAttribute failed\n"); grid = -1; return; }
        if (hipOccupancyMaxActiveBlocksPerMultiprocessor(&per_cu, (const void*)fwd_kernel, NWAVES * 64, LDS_BYTES) != hipSuccess || per_cu < 1) { fprintf(stderr, "kernel_launch: occupancy query says %d blocks per CU\n", per_cu); }
        (void)hipGetLastError();
        grid = cus;
    }
    if (grid < 0) return;
    if (hipMemsetAsync((char*)d_ws + WS_CTL, 0, CTL_ZERO_BYTES, stream) != hipSuccess) return;
    Params p{};
    const float** pp = (const float**)&p;
    for (int i = 0; i < 19; ++i) pp[i] = (const float*)d_in[i];
    p.out = (float*)d_out; p.ws = (unsigned char*)d_ws;
#if MK_PER_PHASE
    for (int ph = 0; ph < N_PHASES; ++ph) { p.ph_lo = ph; p.ph_hi = ph + 1; hipLaunchKernelGGL(fwd_kernel, dim3(grid), dim3(NWAVES * 64), LDS_BYTES, stream, p); }
#else
    p.ph_lo = 0; p.ph_hi = N_PHASES;
    hipLaunchKernelGGL(fwd_kernel, dim3(grid), dim3(NWAVES * 64), LDS_BYTES, stream, p);
#endif
}
```

```cpp
#include <hip/hip_runtime.h>
#include <cstdio>
#include <cstdint>
namespace pg8 {
#define PG8_LAS __attribute__((address_space(3)))
typedef unsigned short bf16_t;
typedef short bf16x8 __attribute__((ext_vector_type(8)));
typedef float f32x4 __attribute__((ext_vector_type(4)));
typedef unsigned u32x4 __attribute__((ext_vector_type(4)));
typedef int i32x4 __attribute__((ext_vector_type(4)));
typedef int i32x8 __attribute__((ext_vector_type(8)));
__device__ __forceinline__ i32x8 cat8(bf16x8 a, bf16x8 b) { return __builtin_shufflevector(__builtin_bit_cast(i32x4, a), __builtin_bit_cast(i32x4, b), 0, 1, 2, 3, 4, 5, 6, 7); }
constexpr int BM = 256, BK = 64, HALF = 128, HTB = HALF * BK * 2  , STAGE_BYTES = 8 * HTB, NXCD = 8, WGM = 8;

__host__ __device__ __forceinline__ int lds_byte(int r, int c) { const int st = (r >> 4) * 2 + (c >> 5), rr = r & 15, cc = c & 31, ob = rr * 64 + cc * 2; return st * 1024 + (ob ^ (((ob >> 9) & 1) << 5)); }
__host__ __device__ __forceinline__ void stage_rc(int b, int& R, int& C) { const int st = b / 1024, sb = b % 1024, swz = sb ^ (((sb >> 9) & 1) << 5); R = (st >> 1) * 16 + swz / 64; C = (st & 1) * 32 + (swz % 64) / 2; }
__host__ __device__ __forceinline__ int perm32(int rho) { const int n = rho >> 4, i = rho & 15; return 8 * (i >> 2) + 4 * n + (i & 3); }

struct Unit { int pm, pn, sel; };
struct Gemm { const bf16_t* A; const bf16_t* Bt; int M, N, K; const bf16_t* A2; const bf16_t* Bt2; const void* rbase; unsigned rbytes; };

struct StaticOrder {
    int nM, nN, nwg, G, c;
    __host__ __device__ __forceinline__ void init(int M, int N, int G_, int c_) { nM = M / BM; nN = N / BM; nwg = nM * nN; G = G_; c = c_; }
    __host__ __device__ __forceinline__ bool next(int i, Unit& u) const {
        const long L = (long)i * G + c; if (L >= nwg) return false;
        int wgid = (int)L; { const int q = nwg / NXCD, r = nwg % NXCD, xcd = wgid % NXCD, off = wgid / NXCD; wgid = (xcd < r ? xcd * (q + 1) : r * (q + 1) + (xcd - r) * q) + off; }
        const int nig = WGM * nN, gid = wgid / nig, fm = gid * WGM, gsz = (nM - fm) < WGM ? (nM - fm) : WGM;
        u.pm = fm + ((wgid % nig) % gsz); u.pn = (wgid % nig) / gsz; u.sel = 0; return true;
    }
    __device__ __forceinline__ void a_ready(const Unit&) const {}
    __device__ __forceinline__ void done(const Unit&) const {}
};

struct StaticOrder2 {
    StaticOrder s0, s1; int G, c;
    __host__ __device__ __forceinline__ void init(int M0, int N0, int M1, int N1, int G_, int c_) { s0.init(M0, N0, 1, 0); s1.init(M1, N1, 1, 0); G = G_; c = c_; }
    __host__ __device__ __forceinline__ bool next(int i, Unit& u) const {
        const long L = (long)i * G + c;
        if (L < s0.nwg) return s0.next((int)L, u);
        if (L < s0.nwg + s1.nwg) { const bool ok = s1.next((int)(L - s0.nwg), u); u.sel = 1; return ok; }
        return false;
    }
    __device__ __forceinline__ void a_ready(const Unit&) const {}
    __device__ __forceinline__ void done(const Unit&) const {}
};

__device__ __forceinline__ unsigned cvt_pk_bf16(float lo, float hi) { unsigned r; asm volatile("v_cvt_pk_bf16_f32 %0, %1, %2" : "=v"(r) : "v"(lo), "v"(hi)); return r; }
typedef float f32x2 __attribute__((ext_vector_type(2)));
__device__ __forceinline__ float c8(float v) { return __builtin_fminf(__builtin_fmaxf(v, -448.f), 448.f); }
__device__ __forceinline__ float sigmoid_f(float v) { return __builtin_amdgcn_rcpf(1.f + __builtin_amdgcn_exp2f(-1.4426950408889634f * v)); }
__device__ __forceinline__ float gelu_tanh_f(float v) { const float z = 1.5957691216057308f * (v + 0.044715f * v * v * v); return v * __builtin_amdgcn_rcpf(1.f + __builtin_amdgcn_exp2f(-1.4426950408889634f * z)); }
__device__ __forceinline__ u32x4 pack8(const f32x4& v0, const f32x4& v1) { u32x4 w; w.x = cvt_pk_bf16(v0[0], v0[1]); w.y = cvt_pk_bf16(v0[2], v0[3]); w.z = cvt_pk_bf16(v1[0], v1[1]); w.w = cvt_pk_bf16(v1[2], v1[3]); return w; }
__device__ __forceinline__ f32x4 bf4_lo(unsigned a, unsigned b) { f32x4 r; r[0] = __builtin_bit_cast(float, a << 16); r[1] = __builtin_bit_cast(float, a & 0xffff0000u); r[2] = __builtin_bit_cast(float, b << 16); r[3] = __builtin_bit_cast(float, b & 0xffff0000u); return r; }

struct EpiProj {
    static constexpr bool PERM = true, AFTER_DRAIN = false, MIDK = false;
    bf16_t *Q, *K, *XR, *GY, *SG, *VT; float* KM; float qscale, oscale;
    __device__ __forceinline__ void operator()(const f32x4 (&acc)[2][2][4][2], const Unit& u, int wr, int wc, int fr, int fq) const {
        { const int l_ = (int)__builtin_amdgcn_mbcnt_hi(~0u, __builtin_amdgcn_mbcnt_lo(~0u, 0u)); fr = l_ & 15; fq = l_ >> 4; }
        const int pn = u.pn; int kind, ldc, colt; bf16_t* base;
        if (u.sel) { kind = 2; base = VT; ldc = 8192; colt = pn * 256; }
        else if (pn < 4) { kind = 0; base = Q; ldc = 1024; colt = pn * 256; }
        else if (pn < 8) { kind = 1; base = K; ldc = 1024; colt = (pn - 4) * 256; }
        else if (pn < 12) { kind = 2; base = XR; ldc = 1024; colt = (pn - 8) * 256; }
        else if (pn < 16) { kind = 3; base = GY; ldc = 1024; colt = (pn - 12) * 256; }
        else { kind = 4; base = SG; ldc = 4096; colt = (pn - 16) * 256; }
        const int row0 = u.pm * BM + wr * 64 + fr, col0 = colt + wc * 32 + 8 * fq;
#pragma unroll
        for (int ai = 0; ai < 2; ++ai)
#pragma unroll
            for (int m = 0; m < 4; ++m) { bf16_t* rowp = base + (size_t)(row0 + ai * HALF + m * 16) * ldc + col0;
#pragma unroll
                for (int bj = 0; bj < 2; ++bj) { f32x4 v0 = acc[ai][bj][m][0] * oscale, v1 = acc[ai][bj][m][1] * oscale;
                    if (kind == 0) { v0 = v0 * qscale; v1 = v1 * qscale; }
                    else if (kind == 3) {
#pragma unroll
                        for (int e = 0; e < 4; ++e) { v0[e] = gelu_tanh_f(v0[e]); v1[e] = gelu_tanh_f(v1[e]); } }
                    else if (kind == 4) {
#pragma unroll
                        for (int e = 0; e < 4; ++e) { v0[e] = sigmoid_f(v0[e]); v1[e] = sigmoid_f(v1[e]); } }
                    *(u32x4*)(rowp + bj * HALF) = pack8(v0, v1); } }
        if (kind == 1 && KM != nullptr) {
            const int b = u.pm >> 3, blk = u.pm & 7;
#pragma unroll
            for (int bj = 0; bj < 2; ++bj)
#pragma unroll
                for (int n = 0; n < 2; ++n) { f32x4 s = (f32x4){0.f, 0.f, 0.f, 0.f};
#pragma unroll
                    for (int ai = 0; ai < 2; ++ai)
#pragma unroll
                        for (int m = 0; m < 4; ++m) s = s + acc[ai][bj][m][n];
#pragma unroll
                    for (int e = 0; e < 4; ++e) { float v = s[e]; v += __shfl_xor(v, 1); v += __shfl_xor(v, 2); v += __shfl_xor(v, 4); v += __shfl_xor(v, 8); s[e] = v; }
                    if (fr == 0) { const int c = colt + bj * HALF + wc * 32 + 8 * fq + 4 * n;
                        float* dst = KM + ((size_t)((b * 8 + (c >> 7)) * 8 + blk)) * 128 + (c & 127);
#pragma unroll
                        for (int e = 0; e < 4; ++e) atomicAdd(dst + e, s[e] * oscale); } }
        }
    }
};
struct EpiStore {
    static constexpr bool PERM = true, AFTER_DRAIN = false, MIDK = false;
    bf16_t* O; int ldc;
    __device__ __forceinline__ void operator()(const f32x4 (&acc)[2][2][4][2], const Unit& u, int wr, int wc, int fr, int fq) const {
        { const int l_ = (int)__builtin_amdgcn_mbcnt_hi(~0u, __builtin_amdgcn_mbcnt_lo(~0u, 0u)); fr = l_ & 15; fq = l_ >> 4; }
        const int row0 = u.pm * BM + wr * 64 + fr, col0 = u.pn * BM + wc * 32 + 8 * fq;
#pragma unroll
        for (int ai = 0; ai < 2; ++ai)
#pragma unroll
            for (int m = 0; m < 4; ++m) { bf16_t* rowp = O + (size_t)(row0 + ai * HALF + m * 16) * ldc + col0;
#pragma unroll
                for (int bj = 0; bj < 2; ++bj) *(u32x4*)(rowp + bj * HALF) = pack8(acc[ai][bj][m][0], acc[ai][bj][m][1]); }
    }
};
struct EpiMerge2 {
    static constexpr bool PERM = true, AFTER_DRAIN = false, MIDK = true;
    const bf16_t* SG; bf16_t* MG; float mgscale;
    __device__ __forceinline__ void midk(f32x4 (&acc)[2][2][4][2], const Unit& u, int wr, int wc, int fr, int fq) const {
        int row0 = u.pm * BM + wr * 64 + fr, col0 = u.pn * BM + wc * 32 + 8 * fq;
        asm volatile("" : "+v"(row0), "+v"(col0));
#pragma unroll
        for (int ai = 0; ai < 2; ++ai)
#pragma unroll
            for (int m = 0; m < 4; ++m) { const size_t row = (size_t)(row0 + ai * HALF + m * 16);
#pragma unroll
                for (int bj = 0; bj < 2; ++bj) { const int col = col0 + bj * HALF;
                    const u32x4 g0 = *(const u32x4*)(SG + row * 4096 + col), g1 = *(const u32x4*)(SG + row * 4096 + 2048 + col);
                    const f32x4 n0 = bf4_lo(g0.x, g0.y), n1 = bf4_lo(g0.z, g0.w), d0 = bf4_lo(g1.x, g1.y), d1 = bf4_lo(g1.z, g1.w);
#pragma unroll
                    for (int e2 = 0; e2 < 4; ++e2) { acc[ai][bj][m][0][e2] *= n0[e2] * __builtin_amdgcn_rcpf(fmaxf(d0[e2], 1e-18f)); acc[ai][bj][m][1][e2] *= n1[e2] * __builtin_amdgcn_rcpf(fmaxf(d1[e2], 1e-18f)); } } }
    }
    __device__ __forceinline__ void operator()(const f32x4 (&acc)[2][2][4][2], const Unit& u, int wr, int wc, int fr, int fq) const {
        { const int l_ = (int)__builtin_amdgcn_mbcnt_hi(~0u, __builtin_amdgcn_mbcnt_lo(~0u, 0u)); fr = l_ & 15; fq = l_ >> 4; }
        const int row0 = u.pm * BM + wr * 64 + fr, col0 = u.pn * BM + wc * 32 + 8 * fq;
#pragma unroll
        for (int ai = 0; ai < 2; ++ai)
#pragma unroll
            for (int m = 0; m < 4; ++m) { const size_t row = (size_t)(row0 + ai * HALF + m * 16);
#pragma unroll
                for (int bj = 0; bj < 2; ++bj) { const int col = col0 + bj * HALF;
                    const u32x4 g1 = *(const u32x4*)(SG + row * 4096 + 2048 + col);
                    const f32x4 v0 = acc[ai][bj][m][0] * bf4_lo(g1.x, g1.y) * mgscale, v1 = acc[ai][bj][m][1] * bf4_lo(g1.z, g1.w) * mgscale;
                    int p0 = __builtin_amdgcn_cvt_pk_fp8_f32(c8(v0[0]), c8(v0[1]), 0, false); p0 = __builtin_amdgcn_cvt_pk_fp8_f32(c8(v0[2]), c8(v0[3]), p0, true);
                    int p1 = __builtin_amdgcn_cvt_pk_fp8_f32(c8(v1[0]), c8(v1[1]), 0, false); p1 = __builtin_amdgcn_cvt_pk_fp8_f32(c8(v1[2]), c8(v1[3]), p1, true);
                    *(unsigned long long*)((unsigned char*)MG + row * 2048 + col) = (unsigned long long)(unsigned)p0 | ((unsigned long long)(unsigned)p1 << 32); } }
    }
};
struct EpiResid {
    static constexpr bool PERM = true, AFTER_DRAIN = false, MIDK = false;
    const float* X; bf16_t* X1B; float* SSP; float oscale;
    __device__ __forceinline__ void operator()(const f32x4 (&acc)[2][2][4][2], const Unit& u, int wr, int wc, int fr, int fq) const {
        { const int l_ = (int)__builtin_amdgcn_mbcnt_hi(~0u, __builtin_amdgcn_mbcnt_lo(~0u, 0u)); fr = l_ & 15; fq = l_ >> 4; }
        const int row0 = u.pm * BM + wr * 64 + fr, col0 = u.pn * BM + wc * 32 + 8 * fq;
#pragma unroll
        for (int ai = 0; ai < 2; ++ai)
#pragma unroll
            for (int m = 0; m < 4; ++m) { const size_t row = (size_t)(row0 + ai * HALF + m * 16); float ss = 0.f;
#pragma unroll
                for (int bj = 0; bj < 2; ++bj) { const int col = col0 + bj * HALF; const float* xp = X + row * 2048 + col;
                    f32x4 v0 = acc[ai][bj][m][0] * oscale + *(const f32x4*)xp, v1 = acc[ai][bj][m][1] * oscale + *(const f32x4*)(xp + 4);
                    *(u32x4*)(X1B + row * 2048 + col) = pack8(v0, v1);
                    ss += (v0[0] * v0[0] + v0[1] * v0[1]) + (v0[2] * v0[2] + v0[3] * v0[3]) + (v1[0] * v1[0] + v1[1] * v1[1]) + (v1[2] * v1[2] + v1[3] * v1[3]); }
                ss += __shfl_xor(ss, 16); ss += __shfl_xor(ss, 32);
                if (fq == 0) SSP[row * 32 + u.pn * 4 + wc] = ss; }
    }
};
struct EpiRowScale {
    static constexpr bool PERM = true, AFTER_DRAIN = false, MIDK = false;
    const float* SSP; bf16_t* O;
    __device__ __forceinline__ void operator()(const f32x4 (&acc)[2][2][4][2], const Unit& u, int wr, int wc, int fr, int fq) const {
        { const int l_ = (int)__builtin_amdgcn_mbcnt_hi(~0u, __builtin_amdgcn_mbcnt_lo(~0u, 0u)); fr = l_ & 15; fq = l_ >> 4; }
        const int row0 = u.pm * BM + wr * 64 + fr, col0 = u.pn * BM + wc * 32 + 8 * fq;
#pragma unroll
        for (int ai = 0; ai < 2; ++ai)
#pragma unroll
            for (int m = 0; m < 4; ++m) { const size_t row = (size_t)(row0 + ai * HALF + m * 16);
                const f32x4 a = *(const f32x4*)(SSP + row * 32 + 8 * fq), b = *(const f32x4*)(SSP + row * 32 + 8 * fq + 4);
                float ss = (a[0] + a[1]) + (a[2] + a[3]) + (b[0] + b[1]) + (b[2] + b[3]);
                ss += __shfl_xor(ss, 16); ss += __shfl_xor(ss, 32);
                const float rs = __builtin_amdgcn_rsqf(ss * (1.f / 2048.f) + 1e-6f);
#pragma unroll
                for (int bj = 0; bj < 2; ++bj) *(u32x4*)(O + row * 2048 + col0 + bj * HALF) = pack8(acc[ai][bj][m][0] * rs, acc[ai][bj][m][1] * rs); }
    }
};
template <class Epi, class Sched, bool ALIGN_EPI = false, bool SP2 = false, bool FP8 = false>
__device__ __forceinline__ void gemm_phase(PG8_LAS unsigned char* lds, const Gemm g, const Sched& S, const Epi& E) {
    const int tid = threadIdx.x, wid = __builtin_amdgcn_readfirstlane(tid >> 6), lane = tid & 63, wr = wid >> 2, wc = wid & 3, fr = lane & 15, fq = lane >> 4;
    const int K = g.K, nt = K / BK;
    const __amdgpu_buffer_rsrc_t rsrc = __builtin_amdgcn_make_buffer_rsrc((void*)g.rbase, 0, (int)g.rbytes, 0x00020000);
    unsigned voffA[2], voffB[2];
#pragma unroll
    for (int i = 0; i < 2; ++i) { int R, C; stage_rc(tid * 16 + i * 8192, R, C); const int Rb = Epi::PERM ? ((R & ~31) + perm32(R & 31)) : R;
        voffA[i] = (unsigned)(R * K + C) * 2u; voffB[i] = (unsigned)(Rb * K + C) * 2u; }
    const size_t kstep = (size_t)(BK * 2);
    const size_t hstep = (size_t)HALF * K * 2;
    const size_t tstep = 2 * hstep;
    const unsigned ldsw = (unsigned)wid * 1024u;
    const int aoff = lds_byte(wr * 64 + fr, fq * 8), boff = lds_byte(wc * 32 + fr, fq * 8);
#define PG8_SA(b, h) (((b) * 2 + (h)) * HTB)
#define PG8_SB(b, h) ((4 + (b) * 2 + (h)) * HTB)
#define PG8_STAGE(bufoff, gbase, voff) do { const unsigned so_ = (unsigned)((const char*)(gbase) - (const char*)g.rbase); _Pragma("unroll") for (int _i = 0; _i < 2; ++_i) \
        __builtin_amdgcn_raw_ptr_buffer_load_lds(rsrc, (PG8_LAS unsigned*)(lds + (bufoff) + ldsw + _i * 8192), 16, (voff)[_i], so_, 0, 0); } while (0)
#define PG8_LDA(dst, b, h) do { _Pragma("unroll") for (int m = 0; m < 4; ++m) { const PG8_LAS unsigned char* p_ = lds + PG8_SA(b, h) + aoff + m * 2048; \
        if constexpr (FP8) dst##8[m] = cat8(*(const PG8_LAS bf16x8*)p_, *(const PG8_LAS bf16x8*)(p_ + 1024)); else { dst[m][0] = *(const PG8_LAS bf16x8*)p_; dst[m][1] = *(const PG8_LAS bf16x8*)(p_ + 1024); } } } while (0)
#define PG8_LDB(dst, b, h) do { _Pragma("unroll") for (int n = 0; n < 2; ++n) { const PG8_LAS unsigned char* p_ = lds + PG8_SB(b, h) + boff + n * 2048; \
        if constexpr (FP8) dst##8[n] = cat8(*(const PG8_LAS bf16x8*)p_, *(const PG8_LAS bf16x8*)(p_ + 1024)); else { dst[n][0] = *(const PG8_LAS bf16x8*)p_; dst[n][1] = *(const PG8_LAS bf16x8*)(p_ + 1024); } } } while (0)
#define PG8_MMA(ai, bj, At, Bt) do { __builtin_amdgcn_s_setprio(1); _Pragma("unroll") for (int m = 0; m < 4; ++m) _Pragma("unroll") for (int n = 0; n < 2; ++n) { \
        if constexpr (FP8) acc[ai][bj][m][n] = __builtin_amdgcn_mfma_scale_f32_16x16x128_f8f6f4(Bt##8[n], At##8[m], acc[ai][bj][m][n], 0, 0, 0, 0x7f7f7f7f, 0, 0x7f7f7f7f); \
        else { _Pragma("unroll") for (int k = 0; k < 2; ++k) acc[ai][bj][m][n] = __builtin_amdgcn_mfma_f32_16x16x32_bf16(Bt[n][k], At[m][k], acc[ai][bj][m][n], 0, 0, 0); } } __builtin_amdgcn_s_setprio(0); } while (0)
#define PG8_WAIT_V(n) asm volatile("s_waitcnt vmcnt(" #n ")" ::: "memory")
#define PG8_WAIT_L(n) asm volatile("s_waitcnt lgkmcnt(" #n ")" ::: "memory")
#define PG8_BAR __builtin_amdgcn_s_barrier()
#define PG8_SCHED __builtin_amdgcn_sched_barrier(0)
    Unit cur, nxt; int ui = 0;
    if (!S.next(0, cur)) return;
    f32x4 acc[2][2][4][2];
#pragma unroll
    for (int a = 0; a < 2; ++a)
#pragma unroll
        for (int b = 0; b < 2; ++b)
#pragma unroll
            for (int m = 0; m < 4; ++m)
#pragma unroll
                for (int n = 0; n < 2; ++n) acc[a][b][m][n] = (f32x4){0.f, 0.f, 0.f, 0.f};
    bf16x8 At[4][2], B0[2][2], B1[2][2];
    i32x8 At8[4], B08[2], B18[2];
    const char* cA = (const char*)(cur.sel ? g.A2 : g.A) + (size_t)cur.pm * tstep; const char* cB = (const char*)(cur.sel ? g.Bt2 : g.Bt) + (size_t)cur.pn * tstep;
    S.a_ready(cur);
    if constexpr (SP2) {
        PG8_STAGE(PG8_SB(0, 0), cB, voffB); PG8_STAGE(PG8_SB(0, 1), cB + hstep, voffB); PG8_STAGE(PG8_SA(0, 0), cA, voffA); PG8_STAGE(PG8_SA(0, 1), cA + hstep, voffA);
        if (wr == 1) PG8_BAR;
        PG8_WAIT_V(2); PG8_BAR;
        PG8_STAGE(PG8_SB(1, 0), cB + kstep, voffB); PG8_STAGE(PG8_SA(1, 0), cA + kstep, voffA); PG8_STAGE(PG8_SB(1, 1), cB + hstep + kstep, voffB);
        PG8_WAIT_V(6); PG8_BAR;
    } else {
        PG8_STAGE(PG8_SB(0, 0), cB, voffB); PG8_STAGE(PG8_SA(0, 0), cA, voffA); PG8_STAGE(PG8_SB(0, 1), cB + hstep, voffB); PG8_STAGE(PG8_SA(0, 1), cA + hstep, voffA);
        if (wr == 1) PG8_BAR;
        PG8_WAIT_V(4); PG8_BAR;
        PG8_STAGE(PG8_SB(1, 0), cB + kstep, voffB); PG8_STAGE(PG8_SA(1, 0), cA + kstep, voffA); PG8_STAGE(PG8_SB(1, 1), cB + hstep + kstep, voffB);
        PG8_WAIT_V(6); PG8_BAR;
    }
    for (;;) {
        const bool has_next = S.next(ui + 1, nxt);
        const char* nA = has_next ? (const char*)(nxt.sel ? g.A2 : g.A) + (size_t)nxt.pm * tstep : cA; const char* nB = has_next ? (const char*)(nxt.sel ? g.Bt2 : g.Bt) + (size_t)nxt.pn * tstep : cB;
        for (int t = 0; t < nt; t += 2) {
            if constexpr (Epi::MIDK) { if (t == nt / 2) E.midk(acc, cur, wr, wc, fr, fq); }
            const bool last = (t == nt - 2);
            const char* a1 = cA + (size_t)(t + 1) * kstep;
            const char* a2 = last ? nA : cA + (size_t)(t + 2) * kstep; const char* b2 = last ? nB : cB + (size_t)(t + 2) * kstep;
            const char* a3 = a2 + kstep; const char* b3 = b2 + kstep;
            if (last && has_next) S.a_ready(nxt);
            if constexpr (SP2) {
            PG8_LDB(B0, 0, 0); PG8_LDB(B1, 0, 1); PG8_SCHED; PG8_LDA(At, 0, 0); PG8_STAGE(PG8_SA(1, 1), a1 + hstep, voffA);
            PG8_WAIT_V(8); PG8_WAIT_L(0); PG8_BAR; PG8_MMA(0, 0, At, B0); PG8_MMA(0, 1, At, B1); PG8_BAR; PG8_SCHED;
            PG8_LDA(At, 0, 1); PG8_STAGE(PG8_SB(0, 0), b2, voffB); PG8_STAGE(PG8_SB(0, 1), b2 + hstep, voffB); PG8_STAGE(PG8_SA(0, 0), a2, voffA);
            PG8_WAIT_V(8); PG8_WAIT_L(0); PG8_BAR; PG8_MMA(1, 0, At, B0); PG8_MMA(1, 1, At, B1); PG8_BAR; PG8_SCHED;
            PG8_LDB(B0, 1, 0); PG8_LDB(B1, 1, 1); PG8_SCHED; PG8_LDA(At, 1, 0); PG8_STAGE(PG8_SA(0, 1), a2 + hstep, voffA);
            PG8_WAIT_V(8); PG8_WAIT_L(0); PG8_BAR; PG8_MMA(0, 0, At, B0); PG8_MMA(0, 1, At, B1); PG8_BAR; PG8_SCHED;
            PG8_LDA(At, 1, 1); PG8_STAGE(PG8_SB(1, 0), b3, voffB); PG8_STAGE(PG8_SB(1, 1), b3 + hstep, voffB); PG8_STAGE(PG8_SA(1, 0), a3, voffA);
            PG8_WAIT_V(8); PG8_WAIT_L(0); PG8_BAR; PG8_MMA(1, 0, At, B0); PG8_MMA(1, 1, At, B1); PG8_BAR; PG8_SCHED;
            } else {
            PG8_LDB(B0, 0, 0); PG8_SCHED; PG8_LDA(At, 0, 0); PG8_STAGE(PG8_SA(1, 1), a1 + hstep, voffA);
            PG8_WAIT_L(8); PG8_BAR; PG8_WAIT_L(0); PG8_MMA(0, 0, At, B0); PG8_BAR; PG8_SCHED;
            PG8_LDB(B1, 0, 1); PG8_STAGE(PG8_SB(0, 0), b2, voffB);
            PG8_BAR; PG8_WAIT_L(0); PG8_MMA(0, 1, At, B1); PG8_BAR;
            PG8_LDA(At, 0, 1); PG8_STAGE(PG8_SA(0, 0), a2, voffA);
            PG8_BAR; PG8_WAIT_L(0); PG8_MMA(1, 0, At, B0); PG8_BAR; PG8_SCHED;
            PG8_STAGE(PG8_SB(0, 1), b2 + hstep, voffB);
            PG8_WAIT_V(6); PG8_BAR; PG8_MMA(1, 1, At, B1); PG8_BAR;
            PG8_LDB(B0, 1, 0); PG8_SCHED; PG8_LDA(At, 1, 0); PG8_STAGE(PG8_SA(0, 1), a2 + hstep, voffA);
            PG8_WAIT_L(8); PG8_BAR; PG8_WAIT_L(0); PG8_MMA(0, 0, At, B0); PG8_BAR; PG8_SCHED;
            PG8_LDB(B1, 1, 1); PG8_STAGE(PG8_SB(1, 0), b3, voffB);
            PG8_BAR; PG8_WAIT_L(0); PG8_MMA(0, 1, At, B1); PG8_BAR;
            PG8_LDA(At, 1, 1); PG8_STAGE(PG8_SA(1, 0), a3, voffA);
            PG8_BAR; PG8_WAIT_L(0); PG8_MMA(1, 0, At, B0); PG8_BAR; PG8_SCHED;
            PG8_STAGE(PG8_SB(1, 1), b3 + hstep, voffB);
            PG8_WAIT_V(6); PG8_BAR; PG8_MMA(1, 1, At, B1); PG8_BAR;
            }
        }
        if constexpr (ALIGN_EPI) { if (wr == 0) PG8_BAR; }
        if constexpr (!Epi::AFTER_DRAIN) { E(acc, cur, wr, wc, fr, fq); S.done(cur); }
        if (!has_next) break;
#pragma unroll
        for (int a = 0; a < 2; ++a)
#pragma unroll
            for (int b = 0; b < 2; ++b)
#pragma unroll
                for (int m = 0; m < 4; ++m)
#pragma unroll
                    for (int n = 0; n < 2; ++n) acc[a][b][m][n] = (f32x4){0.f, 0.f, 0.f, 0.f};
        cur = nxt; cA = nA; cB = nB; ++ui;
        if constexpr (ALIGN_EPI) { if (wr == 1) PG8_BAR; }
    }
    PG8_WAIT_V(0);
    if constexpr (!ALIGN_EPI) { if (wr == 0) PG8_BAR; }
    PG8_BAR;
    if constexpr (Epi::AFTER_DRAIN) { E.fused(acc, cur, wr, wc, fr, fq, lds, wid, lane); S.done(cur); }
#undef PG8_SA
#undef PG8_SB
#undef PG8_STAGE
#undef PG8_LDA
#undef PG8_LDB
#undef PG8_MMA
#undef PG8_WAIT_V
#undef PG8_WAIT_L
#undef PG8_BAR
#undef PG8_SCHED
}
}
#define GAS __attribute__((address_space(1)))
#define LAS __attribute__((address_space(3)))
typedef unsigned short bf16;
typedef unsigned v4u __attribute__((ext_vector_type(4)));
typedef float f32x4 __attribute__((ext_vector_type(4)));
typedef short bf16x8 __attribute__((ext_vector_type(8)));
typedef GAS unsigned gu32;
typedef GAS unsigned long long gu64;
#define RLX_AGENT __ATOMIC_RELAXED, __HIP_MEMORY_SCOPE_AGENT
#define LDS_WAIT() asm volatile("s_waitcnt lgkmcnt(0)" ::: "memory")
#define VM_WAIT() asm volatile("s_waitcnt vmcnt(0)" ::: "memory")
__device__ __forceinline__ unsigned long long rt() { return __builtin_amdgcn_s_memrealtime(); }
__device__ __forceinline__ unsigned f2bf(float f) { unsigned u = __builtin_bit_cast(unsigned, f); return (u + 0x7fffu + ((u >> 16) & 1u)) >> 16; }
__device__ __forceinline__ unsigned pk2(float lo, float hi) { return f2bf(lo) | (f2bf(hi) << 16); }

#define XB_TMO      128
#define XB_XCNT(j)  (256  + 64 * (j))
#define XB_XSUB(j)  (1280 + 64 * (j))
#define XB_XGEN(j)  (2304 + 64 * (j))
#define XB_TOP      3328
#define XB_TOPGEN   3392
#define XCD_BAR_WORDS 3456
#define XB_SPIN_CAP (1u << 18)

__device__ __forceinline__ unsigned xb_ld(unsigned* p)              { return __hip_atomic_load(p, __ATOMIC_RELAXED, __HIP_MEMORY_SCOPE_AGENT); }
__device__ __forceinline__ unsigned xb_add(unsigned* p, unsigned v) { return __hip_atomic_fetch_add(p, v, __ATOMIC_RELAXED, __HIP_MEMORY_SCOPE_AGENT); }
__device__ __forceinline__ unsigned xb_xcc_id() { return (unsigned)__builtin_amdgcn_s_getreg((3 << 11) | 20) & 0xFu; }
#define XB_SPIN(cond, bar) do { unsigned _sp = 0; while (cond) { __builtin_amdgcn_s_sleep(1); \
    if ((++_sp & 255u) == 0u) { if (xb_ld(&(bar)[XB_TMO])) break; if (_sp > XB_SPIN_CAP) { atomicAdd(&(bar)[XB_TMO], 1u); break; } } } } while (0)

struct XcdBarrier {
    unsigned* bar; unsigned x;
    volatile LAS unsigned* st;
};

__device__ __forceinline__ XcdBarrier xcd_barrier_post(unsigned* bar, volatile LAS unsigned* st) {
    XcdBarrier b; b.bar = bar; b.x = xb_xcc_id(); b.st = st;
    if (threadIdx.x == 0) (void)xb_add(&bar[XB_XCNT(b.x)], 1u);
    return b;
}
__device__ __forceinline__ void xcd_barrier_complete(unsigned* bar, unsigned x, unsigned& nloc, unsigned& nx) {
    const unsigned G = gridDim.x * gridDim.y * gridDim.z;
    unsigned sum, cnt, mine, sp = 0u;
    for (;;) {
        sum = 0u; cnt = 0u; mine = 0u;
#pragma unroll
        for (unsigned j = 0; j < 16; ++j) { const unsigned c = xb_ld(&bar[XB_XCNT(j)]); sum += c; cnt += (c > 0u) ? 1u : 0u; mine = (j == x) ? c : mine; }
        if (sum == G) break;
        __builtin_amdgcn_s_sleep(1);
        if ((++sp & 255u) == 0u) { if (xb_ld(&bar[XB_TMO])) break; if (sp > XB_SPIN_CAP) { atomicAdd(&bar[XB_TMO], 1u); break; } }
    }
    nloc = mine > 0u ? mine : 1u; nx = cnt > 0u ? cnt : 1u;
}

__device__ __forceinline__ void xcd_barrier(const XcdBarrier& b) {
    asm volatile("s_waitcnt vmcnt(0)" ::: "memory");
    __syncthreads();
    if (threadIdx.x == 0) {
        unsigned* bar = b.bar;
        __builtin_amdgcn_s_waitcnt(0);
        unsigned nloc = b.st[0], nx = b.st[1];
        if (nloc == 0u) { xcd_barrier_complete(bar, b.x, nloc, nx); b.st[0] = nloc; b.st[1] = nx; }
        const unsigned old = xb_add(&bar[XB_XSUB(b.x)], 1u);
        const unsigned gen = old / nloc;
        if (old + 1u == (gen + 1u) * nloc) {
            __builtin_amdgcn_fence(__ATOMIC_RELEASE, "agent");
            asm volatile("s_waitcnt vmcnt(0)" ::: "memory");
            const unsigned og = xb_add(&bar[XB_TOP], 1u);
            const unsigned tg = og / nx;
            if (og + 1u == (tg + 1u) * nx) xb_add(&bar[XB_TOPGEN], 1u);
            else XB_SPIN(xb_ld(&bar[XB_TOPGEN]) == tg, bar);
            __builtin_amdgcn_fence(__ATOMIC_ACQUIRE, "agent");
            xb_add(&bar[XB_XGEN(b.x)], 1u);
            asm volatile("s_waitcnt vmcnt(0)" ::: "memory");
        } else {
            XB_SPIN(xb_ld(&bar[XB_XGEN(b.x)]) == gen, bar);
            __builtin_amdgcn_fence(__ATOMIC_ACQUIRE, "agent");
            asm volatile("s_waitcnt vmcnt(0)" ::: "memory");
        }
    }
    __syncthreads();
}

constexpr int NWAVES = 8;
constexpr int T_TOK = 8192, DM = 2048, AW = 1024, SEQ = 2048, NHEAD = 8;
constexpr int NWA = 8192;
constexpr int NEXP = 16384;
constexpr float RMS_EPS = 1e-6f, LOG2E = 1.4426950408889634f;
constexpr float W8SCALE = 64.f;
constexpr float OC8SCALE = 8.f, WB8SCALE = 32.f;
constexpr float MG8SCALE = 16.f;
constexpr float QSCALE = 0.08838834764831845f * 1.4426950408889634f;

constexpr size_t MiB = 1u << 20;
constexpr size_t WS_CTL = 0, CTL_ZERO_BYTES = 1 * MiB;
constexpr size_t WS_WA = 2 * MiB;
constexpr size_t WS_WV = 34 * MiB;
constexpr size_t WS_WB = 38 * MiB;
constexpr size_t WS_WO = 46 * MiB;
constexpr size_t WS_WQ = 54 * MiB;
constexpr size_t WS_LWA = 62 * MiB;
constexpr size_t WS_LWX = 62 * MiB + 256 * 1024;
constexpr size_t WS_KEYS = 62 * MiB + 512 * 1024;
constexpr size_t WS_U8 = 64 * MiB;
constexpr size_t WS_V8 = 96 * MiB;
constexpr size_t WS_US = 128 * MiB;
constexpr size_t WS_VS = 128 * MiB + 65536;
constexpr size_t WS_HN = 192 * MiB;
constexpr size_t WS_X1B = WS_HN;
constexpr size_t WS_Q = 224 * MiB;
constexpr size_t WS_K = 240 * MiB;
constexpr size_t WS_VT = 256 * MiB;
constexpr size_t WS_XR = 272 * MiB;
constexpr size_t WS_GY = 288 * MiB;
constexpr size_t WS_SG = 304 * MiB;
constexpr size_t WS_QP = WS_SG;
constexpr size_t WS_OCAT = 368 * MiB;
constexpr size_t WS_HL = 400 * MiB;
constexpr size_t WS_AC = 432 * MiB;
constexpr size_t WS_TMP = WS_HL;
constexpr size_t WS_SUM = 464 * MiB;
constexpr size_t WS_MG = 466 * MiB;
constexpr size_t WS_SSP = 498 * MiB;
constexpr size_t WS_IDX = 500 * MiB;
constexpr size_t WS_G = 504 * MiB;
constexpr size_t WS_PD = WS_Q;
constexpr size_t WS_ACT = WS_VT;
constexpr size_t WS_OUTP = WS_HL;
constexpr size_t WS_END = 508 * MiB;
constexpr int CW_BAR = 4096;
constexpr int CW_XC = 12288;
constexpr int CW_Q2 = 8192;
constexpr int CW_KM = 65536;
static_assert((CW_KM + 32768) * 4 <= (int)CTL_ZERO_BYTES, "CTL");

constexpr int LDS_BYTES = 163840;
constexpr int MISC_OFF = 163840 - 256;
constexpr int SCR_BYTES = MISC_OFF;

typedef float f32x16 __attribute__((ext_vector_type(16)));
typedef float f32x2_t __attribute__((ext_vector_type(2)));
typedef __bf16 bf16x2_t __attribute__((ext_vector_type(2)));
typedef unsigned long long u64;
__device__ __forceinline__ float clamp8(float v) { return fminf(fmaxf(v, -448.f), 448.f); }
__device__ __forceinline__ unsigned cvtpk(float lo, float hi) { f32x2_t v = {lo, hi}; bf16x2_t b = __builtin_convertvector(v, bf16x2_t); return __builtin_bit_cast(unsigned, b); }
__device__ __forceinline__ float bf_lo(unsigned w) { return __builtin_bit_cast(float, w << 16); }
__device__ __forceinline__ float bf_hi(unsigned w) { return __builtin_bit_cast(float, w & 0xffff0000u); }
__device__ __forceinline__ f32x4 bf4_lo2(unsigned a, unsigned b) { f32x4 r; r[0] = bf_lo(a); r[1] = bf_hi(a); r[2] = bf_lo(b); r[3] = bf_hi(b); return r; }
__device__ __forceinline__ float wave_sum(float v) {
#pragma unroll
    for (int o = 1; o < 64; o <<= 1) v += __shfl_xor(v, o);
    return v;
}
__device__ __forceinline__ float dot2bf(unsigned a, unsigned b, float acc) { return __builtin_amdgcn_fdot2_f32_bf16(__builtin_bit_cast(bf16x2_t, a), __builtin_bit_cast(bf16x2_t, b), acc, false); }

struct Params {
    const float *x, *g_mix, *w_in, *conv_w, *conv_b, *lru_wa, *lru_ba, *lru_wx, *lru_bx, *lru_lam, *w_branch, *w_out, *rel_bias, *g_ffn, *peer_wq, *peer_keys, *peer_u, *peer_v, *g_fin;
    float* out; unsigned char* ws; int ph_lo, ph_hi;
};

struct TrD { const float* W; const float* ks; unsigned char* d; int N, k0, n0, ldd; float sc; bool f8; };
__device__ __forceinline__ void tr_load(const TrD& t, int lane, f32x4 (&wv)[8]) {
#pragma unroll
    for (int i = 0; i < 8; ++i) wv[i] = *(const f32x4*)(t.W + (size_t)(t.k0 + (lane >> 3) + 8 * i) * t.N + t.n0 + 4 * (lane & 7));
}
__device__ __forceinline__ void tr_finish(const TrD& t, f32x4 (&wv)[8], LAS float* scr, int lane) {
#pragma unroll
    for (int i = 0; i < 8; ++i) { const int kk = (lane >> 3) + 8 * i; f32x4 v = wv[i]; if (t.ks) v = v * t.ks[t.k0 + kk];
#pragma unroll
        for (int e = 0; e < 4; ++e) scr[kk * 33 + 4 * (lane & 7) + e] = v[e]; }
    LDS_WAIT(); asm volatile("" ::: "memory");
    const int c = lane & 7; const float f8scale = t.sc;
#pragma unroll
    for (int j = 0; j < 4; ++j) { const int n = (lane >> 3) + 8 * j; const LAS float* s = scr + (8 * c) * 33 + n;
        if (t.f8) {
            int p0 = __builtin_amdgcn_cvt_pk_fp8_f32(clamp8(s[0 * 33] * f8scale), clamp8(s[1 * 33] * f8scale), 0, false); p0 = __builtin_amdgcn_cvt_pk_fp8_f32(clamp8(s[2 * 33] * f8scale), clamp8(s[3 * 33] * f8scale), p0, true);
            int p1 = __builtin_amdgcn_cvt_pk_fp8_f32(clamp8(s[4 * 33] * f8scale), clamp8(s[5 * 33] * f8scale), 0, false); p1 = __builtin_amdgcn_cvt_pk_fp8_f32(clamp8(s[6 * 33] * f8scale), clamp8(s[7 * 33] * f8scale), p1, true);
            *(u64*)(t.d + (size_t)n * t.ldd + t.k0 + 8 * c) = (u64)(unsigned)p0 | ((u64)(unsigned)p1 << 32);
        } else {
        v4u o; o.x = cvtpk(s[0 * 33], s[1 * 33]); o.y = cvtpk(s[2 * 33], s[3 * 33]); o.z = cvtpk(s[4 * 33], s[5 * 33]); o.w = cvtpk(s[6 * 33], s[7 * 33]);
        *(v4u*)(t.d + (size_t)n * t.ldd + 2 * (t.k0 + 8 * c)) = o; } }
    LDS_WAIT(); asm volatile("" ::: "memory");
}
template <int MODE> __device__ __forceinline__ void row_to_bf16(const float* src, bf16* dst, const float* colscale, int lane) {
    const f32x4* s = (const f32x4*)src + lane;
    f32x4 v[8]; float ss = 0.f;
#pragma unroll
    for (int j = 0; j < 8; ++j) { v[j] = s[64 * j]; ss += (v[j][0] * v[j][0] + v[j][1] * v[j][1]) + (v[j][2] * v[j][2] + v[j][3] * v[j][3]); }
    float rs = 1.f;
    if (MODE == 1) rs = __builtin_amdgcn_rsqf(wave_sum(ss) * (1.f / 2048.f) + RMS_EPS);
    u64* o8 = (u64*)dst + lane;
#pragma unroll
    for (int j = 0; j < 8; ++j) { f32x4 w = v[j] * rs; if (colscale) w = w * ((const f32x4*)colscale)[64 * j + lane];
        o8[64 * j] = (u64)cvtpk(w[0], w[1]) | ((u64)cvtpk(w[2], w[3]) << 32); }
}
template <bool I8> __device__ __forceinline__ void row_finish8(f32x4 (&v)[8], unsigned char* dst, float* scale_out, int lane) {
    float am = 0.f;
#pragma unroll
    for (int j = 0; j < 8; ++j) am = fmaxf(am, fmaxf(fmaxf(fabsf(v[j][0]), fabsf(v[j][1])), fmaxf(fabsf(v[j][2]), fabsf(v[j][3]))));
#pragma unroll
    for (int o = 1; o < 64; o <<= 1) am = fmaxf(am, __shfl_xor(am, o));
    const float qmax = I8 ? 127.f : 448.f;
    const float sc = am > 0.f ? am / qmax : 1.f, inv = 1.f / sc;
    unsigned* o4 = (unsigned*)(dst + (size_t)(lane >> 5) * NEXP * 128) + (lane & 31);
#pragma unroll
    for (int j = 0; j < 8; ++j) { unsigned w;
        if (I8) { const int q0 = (int)rintf(v[j][0] * inv), q1 = (int)rintf(v[j][1] * inv), q2 = (int)rintf(v[j][2] * inv), q3 = (int)rintf(v[j][3] * inv);
            w = (unsigned)(q0 & 255) | ((unsigned)(q1 & 255) << 8) | ((unsigned)(q2 & 255) << 16) | ((unsigned)q3 << 24); }
        else { int p = __builtin_amdgcn_cvt_pk_fp8_f32(v[j][0] * inv, v[j][1] * inv, 0, false); p = __builtin_amdgcn_cvt_pk_fp8_f32(v[j][2] * inv, v[j][3] * inv, p, true); w = (unsigned)p; }
        o4[(size_t)(2 * j) * NEXP * 32] = w; }
    if (lane == 0) *scale_out = sc;
}
template <bool I8, int NR = 2> __device__ __forceinline__ void table_rows8(const float* src, unsigned char* dst, float* scales, const float* colscale, int r0, int r1, int wv, int nwv, int lane) {
    f32x4 cs[8];
#pragma unroll
    for (int j = 0; j < 8; ++j) cs[j] = colscale ? ((const f32x4*)colscale)[64 * j + lane] : (f32x4){1.f, 1.f, 1.f, 1.f};
    for (int m = r0 + wv; m < r1; m += NR * nwv) {
        f32x4 v[NR][8];
#pragma unroll
        for (int q = 0; q < NR; ++q) { const int mq = m + q * nwv; if (mq < r1) {
#pragma unroll
            for (int j = 0; j < 8; ++j) v[q][j] = ((const f32x4*)(src + (size_t)mq * DM))[64 * j + lane]; } }
#pragma unroll
        for (int q = 0; q < NR; ++q) { const int mq = m + q * nwv; if (mq < r1) {
            if (colscale) {
#pragma unroll
                for (int j = 0; j < 8; ++j) v[q][j] = v[q][j] * cs[j]; }
            row_finish8<I8>(v[q], dst + (size_t)mq * 128, scales + mq, lane); } }
    }
}
template <int NR> __device__ __forceinline__ void peer_table_u(const Params& P, int r0, int r1, int wv, int nwv, int lane) { table_rows8<true, NR>(P.peer_u, P.ws + WS_U8, (float*)(P.ws + WS_US), P.g_ffn, r0, r1, wv, nwv, lane); }
template <int NR> __device__ __forceinline__ void peer_table_v(const Params& P, int r0, int r1, int wv, int nwv, int lane) { table_rows8<false, NR>(P.peer_v, P.ws + WS_V8, (float*)(P.ws + WS_VS), nullptr, r0, r1, wv, nwv, lane); }
__device__ __forceinline__ TrD tr_decode(const Params& P, int r) {
    unsigned char* ws = P.ws;
    constexpr int I_IN = 32 * 288, I_BR = 16 * 64, I_SQ = 32 * 64;
    TrD t; t.ks = nullptr; t.f8 = true; t.ldd = 2048; t.sc = W8SCALE;
    if (r < I_IN) { const int kb = r / 288, nb = r % 288, n0 = 32 * nb;
        t.W = P.w_in; t.N = 9216; t.k0 = 64 * kb; t.n0 = n0;
        t.d = (n0 < 2048) ? ws + WS_WA + (size_t)n0 * 2048 : (n0 < 3072 ? ws + WS_WV + (size_t)(n0 - 2048) * 2048 : ws + WS_WA + (size_t)(n0 - 1024) * 2048); return t; } r -= I_IN;
    if (r < 2 * I_BR) { const int br = r / I_BR, q = r % I_BR, kb = q / 64, nb = q % 64;
        t.W = P.w_branch + (size_t)br * 1024 * 2048; t.N = 2048; t.k0 = 64 * kb; t.n0 = 32 * nb; t.sc = WB8SCALE; t.d = ws + WS_WB + (size_t)(32 * nb) * 2048 + br * 1024; return t; } r -= 2 * I_BR;
    if (r < I_SQ) { const int kb = r / 64, nb = r % 64; t.W = P.w_out; t.N = 2048; t.k0 = 64 * kb; t.n0 = 32 * nb; t.d = ws + WS_WO + (size_t)(32 * nb) * 2048; return t; } r -= I_SQ;
    t.f8 = false; t.sc = 1.f;
    if (r < I_SQ) { const int kb = r / 64, nb = r % 64; t.W = P.peer_wq; t.N = 2048; t.k0 = 64 * kb; t.n0 = 32 * nb; t.ks = P.g_ffn; t.ldd = 4096; t.d = ws + WS_WQ + (size_t)(32 * nb) * 4096; return t; } r -= I_SQ;
    { const int which = r / 64, q = r % 64, g = q / 8, kb = (q % 8) / 4, nb = q % 4;
      t.W = (which ? P.lru_wx : P.lru_wa) + (size_t)g * 16384; t.N = 128; t.k0 = 64 * kb; t.n0 = 32 * nb; t.ldd = 256; t.d = ws + (which ? WS_LWX : WS_LWA) + ((size_t)g * 16384 + (size_t)(32 * nb) * 128) * 2; return t; }
}
__device__ __forceinline__ void p0_prologue(const Params& P, LAS unsigned char* lds, int gw, int NGW, int wave, int lane, int r1) {
    LAS float* scr = (LAS float*)(lds + wave * 16384);
    unsigned char* ws = P.ws;
    constexpr int NITEMS = 32 * 288 + 2 * 16 * 64 + 2 * 32 * 64 + 2 * 8 * 8;
    if (gw < NITEMS) {
        int ita = gw; TrD a = tr_decode(P, ita), b = a; f32x4 wa[8], wb[8]; tr_load(a, lane, wa);
        for (;;) {
            const int itb = ita + NGW; const bool hasb = itb < NITEMS; if (hasb) { b = tr_decode(P, itb); tr_load(b, lane, wb); }
            tr_finish(a, wa, scr, lane);
            if (!hasb) break;
            ita = itb + NGW; const bool hasa = ita < NITEMS; if (hasa) { a = tr_decode(P, ita); tr_load(a, lane, wa); }
            tr_finish(b, wb, scr, lane);
            if (!hasa) break;
        }
    }
    { bf16* KB = (bf16*)(ws + WS_KEYS);
      for (int i = gw * 64 + lane; i < 262144 / 8; i += NGW * 64) { const f32x4 a = ((const f32x4*)P.peer_keys)[2 * i], b = ((const f32x4*)P.peer_keys)[2 * i + 1];
          v4u o; o.x = cvtpk(a[0], a[1]); o.y = cvtpk(a[2], a[3]); o.z = cvtpk(b[0], b[1]); o.w = cvtpk(b[2], b[3]); ((v4u*)KB)[i] = o; } }
    { unsigned char* HN = ws + WS_HN;
      for (int m = gw; m < T_TOK; m += 4 * NGW) {
          f32x4 v[4][8];
#pragma unroll
          for (int q = 0; q < 4; ++q) { const int mq = m + q * NGW; if (mq < T_TOK) {
#pragma unroll
              for (int j = 0; j < 8; ++j) v[q][j] = ((const f32x4*)(P.x + (size_t)mq * DM))[64 * j + lane]; } }
#pragma unroll
          for (int q = 0; q < 4; ++q) { const int mq = m + q * NGW; if (mq < T_TOK) {
              float sa = 0.f;
#pragma unroll
              for (int j = 0; j < 8; ++j) sa += (v[q][j][0] * v[q][j][0] + v[q][j][1] * v[q][j][1]) + (v[q][j][2] * v[q][j][2] + v[q][j][3] * v[q][j][3]);
              const float ra = __builtin_amdgcn_rsqf(wave_sum(sa) * (1.f / 2048.f) + RMS_EPS);
              unsigned* oa = (unsigned*)(HN + (size_t)mq * DM) + lane;
#pragma unroll
              for (int j = 0; j < 8; ++j) { const f32x4 w = v[q][j] * ra * ((const f32x4*)P.g_mix)[64 * j + lane]; int p = __builtin_amdgcn_cvt_pk_fp8_f32(w[0], w[1], 0, false); p = __builtin_amdgcn_cvt_pk_fp8_f32(w[2], w[3], p, true); oa[64 * j] = (unsigned)p; } } } } }
    if (r1 > 0) { peer_table_u<2>(P, 0, r1, gw, NGW, lane); peer_table_v<2>(P, 0, r1, gw, NGW, lane); }
}

constexpr int AT_KT = 0, AT_VT = 2 * 17408, AT_KM = AT_VT + 2 * 18432, AT_B2 = AT_KM + 4096, AT_SEL = AT_B2 + 512, AT_ANY = AT_SEL + 1024;
#define MFMA32(a, b, c) __builtin_amdgcn_mfma_f32_32x32x16_bf16((a), (b), (c), 0, 0, 0)
__device__ __forceinline__ void attn_unit(const Params& P, LAS unsigned char* lds, int b, int h, int blk, int tid, int wave, int lane) {
    unsigned char* ws = P.ws;
    const bf16* Qb = (const bf16*)(ws + WS_Q); const bf16* Kb = (const bf16*)(ws + WS_K); const bf16* VTg = (const bf16*)(ws + WS_VT); bf16* OATT = (bf16*)(ws + WS_OCAT);
    const float* KMg = (const float*)(ws + WS_CTL) + CW_KM;
    LAS float* KMs = (LAS float*)(lds + AT_KM); LAS float* B2 = (LAS float*)(lds + AT_B2); LAS unsigned* SELM = (LAS unsigned*)(lds + AT_SEL); LAS unsigned* UANY = (LAS unsigned*)(lds + AT_ANY);
    const int row_blk0 = b * SEQ + blk * 256;
    __syncthreads();
    for (int i = tid; i < 1024; i += 512) KMs[i] = KMg[(size_t)(b * 8 + h) * 1024 + i] * (1.f / 256.f);
    if (tid < 128) { const int d = tid; int bucket = d;
        if (d >= 16) { bucket = 16 + (int)(__logf((float)d * (1.f / 16.f)) * (16.f / 2.0794415416798357f)); bucket = bucket > 31 ? 31 : bucket; }
        B2[d] = (P.rel_bias[bucket * 8 + h] - P.rel_bias[31 * 8 + h]) * LOG2E; }
    if (tid == 0) *UANY = 0u;
    __syncthreads();
    {
        const int qq = tid >> 1, q2 = tid & 1;
        unsigned mask = (1u << blk) - 1u;
        if (blk > 3) {
            const bf16* qrow = Qb + (size_t)(row_blk0 + qq) * AW + h * 128;
            v4u qv[8];
#pragma unroll
            for (int c8 = 0; c8 < 8; ++c8) qv[c8] = *(const v4u*)(qrow + 8 * (q2 + 2 * c8));
            float g0 = 0.f, g1 = 0.f, g2 = 0.f, g3 = 0.f, g4 = 0.f, g5 = 0.f, g6 = 0.f;
#pragma unroll
            for (int c8 = 0; c8 < 8; ++c8) { const float q[8] = {bf_lo(qv[c8].x), bf_hi(qv[c8].x), bf_lo(qv[c8].y), bf_hi(qv[c8].y), bf_lo(qv[c8].z), bf_hi(qv[c8].z), bf_lo(qv[c8].w), bf_hi(qv[c8].w)};
#pragma unroll
                for (int e = 0; e < 8; ++e) { const LAS float* km = KMs + 8 * (q2 + 2 * c8) + e;
                    g0 += q[e] * km[0]; g1 += q[e] * km[128]; g2 += q[e] * km[256]; g3 += q[e] * km[384]; g4 += q[e] * km[512]; g5 += q[e] * km[640]; g6 += q[e] * km[768]; } }
            g0 += __shfl_xor(g0, 1); g1 += __shfl_xor(g1, 1); g2 += __shfl_xor(g2, 1); g3 += __shfl_xor(g3, 1); g4 += __shfl_xor(g4, 1); g5 += __shfl_xor(g5, 1); g6 += __shfl_xor(g6, 1);
            const float NEGG = -3.0e38f;
            if (blk < 7) g6 = NEGG; if (blk < 6) g5 = NEGG; if (blk < 5) g4 = NEGG;
            mask = 0u;
#pragma unroll
            for (int s = 0; s < 3; ++s) { float best = g0; int bj = 0;
                if (g1 > best) { best = g1; bj = 1; } if (g2 > best) { best = g2; bj = 2; } if (g3 > best) { best = g3; bj = 3; }
                if (g4 > best) { best = g4; bj = 4; } if (g5 > best) { best = g5; bj = 5; } if (g6 > best) { best = g6; bj = 6; }
                mask |= 1u << bj;
                g0 = bj == 0 ? NEGG : g0; g1 = bj == 1 ? NEGG : g1; g2 = bj == 2 ? NEGG : g2; g3 = bj == 3 ? NEGG : g3; g4 = bj == 4 ? NEGG : g4; g5 = bj == 5 ? NEGG : g5; g6 = bj == 6 ? NEGG : g6; }
        }
        if (q2 == 0) { SELM[qq] = mask; __hip_atomic_fetch_or(UANY, mask, __ATOMIC_RELAXED, __HIP_MEMORY_SCOPE_WORKGROUP); }
    }
    __syncthreads();
    const unsigned uany = *UANY;
    unsigned blist = (unsigned)blk; int nb = 1;
    for (int j = blk - 1; j >= 0; --j) if ((uany >> j) & 1u) { blist |= (unsigned)j << (4 * nb); ++nb; }
    const int nsteps = 4 * nb;
    const int qi = 32 * wave + (lane & 31), hh = lane >> 5;
    const unsigned mymask = SELM[qi];
    bf16x8 Qf[8];
    { const bf16* qp = Qb + (size_t)(row_blk0 + qi) * AW + h * 128 + 8 * hh;
#pragma unroll
      for (int ks = 0; ks < 8; ++ks) Qf[ks] = *(const bf16x8*)(qp + 16 * ks); }
    float m_run = -1.0e30f, lsum = 0.f;
    f32x16 O[4];
#pragma unroll
    for (int dt = 0; dt < 4; ++dt)
#pragma unroll
        for (int r = 0; r < 16; ++r) O[dt][r] = 0.f;
    const int kkey0 = tid >> 4, kpart = tid & 15;
    const int vd0 = tid >> 3, vcc = tid & 7;
    const unsigned kl0 = kkey0 * 272 + kpart * 16, kl1 = kl0 + 32 * 272;
    const unsigned vl0 = vd0 * 144 + ((((vcc >> 2) * 2 + ((vcc & 3) >> 1)) * 2) * 16) + (vcc & 1) * 8, vl1 = vl0 + 64 * 144;
    v4u ka0, ka1, va0, va1, kb0, kb1, vb0, vb1;
#define AT_LOAD(s, k0, k1, v0, v1) do { const int j_ = (blist >> (4 * ((s) >> 2))) & 15, kt_ = (s) & 3; const size_t krow0 = (size_t)b * SEQ + j_ * 256 + kt_ * 64; \
        k0 = *(const v4u*)(Kb + (krow0 + kkey0) * AW + h * 128 + kpart * 8); k1 = *(const v4u*)(Kb + (krow0 + kkey0 + 32) * AW + h * 128 + kpart * 8); \
        v0 = *(const v4u*)(VTg + (size_t)(h * 128 + vd0) * T_TOK + krow0 + vcc * 8); v1 = *(const v4u*)(VTg + (size_t)(h * 128 + vd0 + 64) * T_TOK + krow0 + vcc * 8); } while (0)
#define AT_STORE(bufi, k0, k1, v0, v1) do { LAS unsigned char* KT_ = lds + AT_KT + (bufi) * 17408; LAS unsigned char* VT_ = lds + AT_VT + (bufi) * 18432; \
        *(LAS v4u*)(KT_ + kl0) = k0; *(LAS v4u*)(KT_ + kl1) = k1; \
        *(LAS u64*)(VT_ + vl0) = (u64)v0.x | ((u64)v0.y << 32); *(LAS u64*)(VT_ + vl0 + 16) = (u64)v0.z | ((u64)v0.w << 32); \
        *(LAS u64*)(VT_ + vl1) = (u64)v1.x | ((u64)v1.y << 32); *(LAS u64*)(VT_ + vl1 + 16) = (u64)v1.z | ((u64)v1.w << 32); } while (0)
    AT_LOAD(0, ka0, ka1, va0, va1); AT_STORE(0, ka0, ka1, va0, va1);
    if (1 < nsteps) AT_LOAD(1, ka0, ka1, va0, va1);
    if (2 < nsteps) AT_LOAD(2, kb0, kb1, vb0, vb1);
    for (int s = 0; s < nsteps; ++s) {
        const int j = (blist >> (4 * (s >> 2))) & 15, kt = s & 3;
        __syncthreads();
        if ((s & 1) == 0) { if (s + 1 < nsteps) AT_STORE((s + 1) & 1, ka0, ka1, va0, va1); if (s + 3 < nsteps) AT_LOAD(s + 3, ka0, ka1, va0, va1); }
        else              { if (s + 1 < nsteps) AT_STORE((s + 1) & 1, kb0, kb1, vb0, vb1); if (s + 3 < nsteps) AT_LOAD(s + 3, kb0, kb1, vb0, vb1); }
        const LAS unsigned char* KT = lds + AT_KT + (s & 1) * 17408; const LAS unsigned char* VTl = lds + AT_VT + (s & 1) * 18432;
        bool part;
        if (j == blk) part = (64 * kt <= 32 * wave + 31);
        else part = (__ballot((mymask >> j) & 1u) != 0ull);
        if (part) {
            f32x16 S0, S1;
#pragma unroll
            for (int r = 0; r < 16; ++r) { S0[r] = 0.f; S1[r] = 0.f; }
            const LAS unsigned char* kp = KT + (lane & 31) * 272 + hh * 16;
#pragma unroll
            for (int ks = 0; ks < 8; ++ks) { const bf16x8 a0 = *(const LAS bf16x8*)(kp + ks * 32), a1 = *(const LAS bf16x8*)(kp + 32 * 272 + ks * 32);
                S0 = MFMA32(a0, Qf[ks], S0); S1 = MFMA32(a1, Qf[ks], S1); }
            const bool sel = ((mymask >> j) & 1u) != 0u;
            float mx = -1.0e30f; bool ok_row = true;
            const int dmin = 32 * wave + 256 * (blk - j) - 64 * kt - 63;
            if (dmin < 113) {
                const int dbase = (j == blk) ? (qi - 64 * kt - 4 * hh) : (qi + 256 - 64 * kt - 4 * hh);
                const bool okrow = (j == blk) ? true : sel;
#pragma unroll
                for (int r = 0; r < 16; ++r) { const int kk = (r & 3) + 8 * (r >> 2);
                    { const int dist = dbase - kk; const int di = dist < 0 ? 0 : (dist > 127 ? 127 : dist); const float v = (okrow && dist >= 0) ? S0[r] + B2[di] : -1.0e30f; S0[r] = v; mx = fmaxf(mx, v); }
                    { const int dist = dbase - 32 - kk; const int di = dist < 0 ? 0 : (dist > 127 ? 127 : dist); const float v = (okrow && dist >= 0) ? S1[r] + B2[di] : -1.0e30f; S1[r] = v; mx = fmaxf(mx, v); } }
            } else {
                ok_row = sel || (j == blk);
#pragma unroll
                for (int r = 0; r < 16; ++r) mx = fmaxf(mx, fmaxf(S0[r], S1[r]));
                mx = ok_row ? mx : -1.0e30f;
            }
            mx = fmaxf(mx, __shfl_xor(mx, 32));
            const bool need = mx > m_run + 8.f;
            if (__any(need)) { const float m_new = need ? mx : m_run, alpha = __builtin_amdgcn_exp2f(m_run - m_new);
                m_run = m_new; lsum *= alpha;
#pragma unroll
                for (int dt = 0; dt < 4; ++dt)
#pragma unroll
                    for (int r = 0; r < 16; ++r) O[dt][r] *= alpha; }
            float ps = 0.f;
            const float m_eff = ok_row ? m_run : 1.0e30f;
#pragma unroll
            for (int r = 0; r < 16; ++r) { S0[r] = __builtin_amdgcn_exp2f(S0[r] - m_eff); S1[r] = __builtin_amdgcn_exp2f(S1[r] - m_eff); ps += S0[r] + S1[r]; }
            lsum += ps;
            bf16x8 Pf[2][2];
#pragma unroll
            for (int s2 = 0; s2 < 2; ++s2) {
                v4u p0, p1;
                p0.x = cvtpk(S0[8 * s2], S0[8 * s2 + 1]); p0.y = cvtpk(S0[8 * s2 + 2], S0[8 * s2 + 3]); p0.z = cvtpk(S0[8 * s2 + 4], S0[8 * s2 + 5]); p0.w = cvtpk(S0[8 * s2 + 6], S0[8 * s2 + 7]);
                p1.x = cvtpk(S1[8 * s2], S1[8 * s2 + 1]); p1.y = cvtpk(S1[8 * s2 + 2], S1[8 * s2 + 3]); p1.z = cvtpk(S1[8 * s2 + 4], S1[8 * s2 + 5]); p1.w = cvtpk(S1[8 * s2 + 6], S1[8 * s2 + 7]);
                Pf[0][s2] = __builtin_bit_cast(bf16x8, p0); Pf[1][s2] = __builtin_bit_cast(bf16x8, p1); }
            const LAS unsigned char* vp = VTl + (lane & 31) * 144 + hh * 16;
#pragma unroll
            for (int dt = 0; dt < 4; ++dt)
#pragma unroll
                for (int mt = 0; mt < 2; ++mt)
#pragma unroll
                    for (int s2 = 0; s2 < 2; ++s2) { const bf16x8 a = *(const LAS bf16x8*)(vp + dt * 32 * 144 + (mt * 2 + s2) * 32); O[dt] = MFMA32(a, Pf[mt][s2], O[dt]); }
        }
    }
#undef AT_LOAD
#undef AT_STORE
    const float ltot = lsum + __shfl_xor(lsum, 32), inv = 1.f / ltot;
    unsigned char* orow = (unsigned char*)OATT + (size_t)(row_blk0 + qi) * DM + h * 128 + 4 * hh;
    const float osc = inv * OC8SCALE;
#pragma unroll
    for (int dt = 0; dt < 4; ++dt)
#pragma unroll
        for (int g4 = 0; g4 < 4; ++g4) { int p = __builtin_amdgcn_cvt_pk_fp8_f32(clamp8(O[dt][4 * g4] * osc), clamp8(O[dt][4 * g4 + 1] * osc), 0, false); p = __builtin_amdgcn_cvt_pk_fp8_f32(clamp8(O[dt][4 * g4 + 2] * osc), clamp8(O[dt][4 * g4 + 3] * osc), p, true);
            *(unsigned*)(orow + 32 * dt + 8 * g4) = (unsigned)p; }
}
constexpr int LR_XC = 0, LR_SEG = 2 * 17408, LR_W = LR_SEG + 2 * 4096;
#define MFMA16(a, b, c) __builtin_amdgcn_mfma_f32_16x16x32_bf16((a), (b), (c), 0, 0, 0)
__device__ __forceinline__ void lru_pair(const Params& P, LAS unsigned char* lds, int pair, int tid, int wave, int lane, unsigned* tkword, int& tk_next) {
    unsigned char* ws = P.ws;
    const int grp = wave >> 2, wq = wave & 3, tg = tid & 255;
    const int unit = 2 * pair + grp, b = unit >> 8, g = (unit >> 5) & 7, c = unit & 31;
    const bf16* XR = (const bf16*)(ws + WS_XR); const bf16* LWA = (const bf16*)(ws + WS_LWA) + (size_t)g * 16384; const bf16* LWX = (const bf16*)(ws + WS_LWX) + (size_t)g * 16384;
    float* HL = (float*)(ws + WS_HL); float* AC = (float*)(ws + WS_AC); float* SUM = (float*)(ws + WS_SUM);
    LAS unsigned short* XC = (LAS unsigned short*)(lds + LR_XC + grp * 17408);
    LAS float* SEG = (LAS float*)(lds + LR_SEG + grp * 4096);
    LAS unsigned char* WL = lds + LR_W;
    const int t0 = c * 64; const size_t R0 = (size_t)b * SEQ + t0;
    __syncthreads();
    {
      v4u wv[8];
#pragma unroll
      for (int i = 0; i < 8; ++i) { const int q = tid + 512 * i, mat = q >> 11, row = (q >> 4) & 127, part = q & 15; wv[i] = *(const v4u*)((mat ? LWX : LWA) + row * 128 + part * 8); }
      const int cpart = tg & 15, C8 = g * 128 + 8 * cpart;
      f32x4 cw[4][2], cbv[2];
#pragma unroll
      for (int w = 0; w < 4; ++w) { cw[w][0] = *(const f32x4*)(P.conv_w + w * 1024 + C8); cw[w][1] = *(const f32x4*)(P.conv_w + w * 1024 + C8 + 4); }
      cbv[0] = *(const f32x4*)(P.conv_b + C8); cbv[1] = *(const f32x4*)(P.conv_b + C8 + 4);
#define LR_CONV_LOAD(xr, base) do { _Pragma("unroll") for (int i2 = 0; i2 < 2; ++i2) { const int tl = (tg >> 4) + 16 * ((base) + i2); \
          _Pragma("unroll") for (int w = 0; w < 4; ++w) { const int ts = t0 + tl - 3 + w; xr[i2][w] = (ts >= 0) ? *(const v4u*)(XR + ((size_t)b * SEQ + ts) * AW + C8) : (v4u){0u, 0u, 0u, 0u}; } } } while (0)
#define LR_CONV_DO(xr, base) do { _Pragma("unroll") for (int i2 = 0; i2 < 2; ++i2) { const int tl = (tg >> 4) + 16 * ((base) + i2); f32x4 y0 = cbv[0], y1 = cbv[1]; \
          _Pragma("unroll") for (int w = 0; w < 4; ++w) { y0 = y0 + bf4_lo2(xr[i2][w].x, xr[i2][w].y) * cw[w][0]; y1 = y1 + bf4_lo2(xr[i2][w].z, xr[i2][w].w) * cw[w][1]; } \
          v4u o; o.x = cvtpk(y0[0], y0[1]); o.y = cvtpk(y0[2], y0[3]); o.z = cvtpk(y1[0], y1[1]); o.w = cvtpk(y1[2], y1[3]); \
          *(LAS v4u*)((LAS unsigned char*)XC + tl * 272 + cpart * 16) = o; } } while (0)
      { v4u xr[2][4]; LR_CONV_LOAD(xr, 0);
#pragma unroll
        for (int i = 0; i < 8; ++i) { const int q = tid + 512 * i, mat = q >> 11, row = (q >> 4) & 127, part = q & 15; *(LAS v4u*)(WL + (mat * 128 + row) * 272 + part * 16) = wv[i]; }
        LR_CONV_DO(xr, 0); }
      { v4u xr[2][4]; LR_CONV_LOAD(xr, 2); LR_CONV_DO(xr, 2); }
#undef LR_CONV_LOAD
#undef LR_CONV_DO
    }
    __syncthreads();
    if (tid == 0) tk_next = (int)__hip_atomic_fetch_add(tkword, 1u, __ATOMIC_RELAXED, __HIP_MEMORY_SCOPE_AGENT);
    const int fr = lane & 15, fq = lane >> 4;
    float Ar[2][4][4], Hr[2][4][4], AE[2][4], HE[2][4];
#pragma unroll
    for (int nh = 0; nh < 2; ++nh) {
        f32x4 aA[4], aX[4];
#pragma unroll
        for (int nt = 0; nt < 4; ++nt) { aA[nt] = (f32x4){0.f, 0.f, 0.f, 0.f}; aX[nt] = (f32x4){0.f, 0.f, 0.f, 0.f}; }
#pragma unroll 1
        for (int ks = 0; ks < 4; ++ks) { const bf16x8 a = *(const LAS bf16x8*)((LAS unsigned char*)XC + (16 * wq + fr) * 272 + (32 * ks + 8 * fq) * 2);
#pragma unroll
            for (int nt = 0; nt < 4; ++nt) { const int wo = (64 * nh + 16 * nt + fr) * 272 + (32 * ks + 8 * fq) * 2;
                const bf16x8 ba = *(const LAS bf16x8*)(WL + wo), bx = *(const LAS bf16x8*)(WL + 128 * 272 + wo);
                aA[nt] = MFMA16(a, ba, aA[nt]); aX[nt] = MFMA16(a, bx, aX[nt]); } }
#pragma unroll
        for (int nt = 0; nt < 4; ++nt) { const int ch = 64 * nh + 16 * nt + fr, C = g * 128 + ch;
            const float ba = P.lru_ba[C], bx = P.lru_bx[C], lam = P.lru_lam[C];
            const float sp8 = 8.f * log1pf(__expf(-lam));
            float Ac = 1.f, Hc = 0.f;
#pragma unroll
            for (int r = 0; r < 4; ++r) { const int tok = 16 * wq + 4 * fq + r;
                const float rg = pg8::sigmoid_f(aA[nt][r] + ba), ig = pg8::sigmoid_f(aX[nt][r] + bx);
                const float log_a = -rg * sp8, a = __builtin_amdgcn_exp2f(log_a * 1.4426950408889634f);
                const float y = 2.f * log_a;
                const float em = (y > -0.25f) ? -y * (1.f + y * (0.5f + y * (0.16666667f + y * (0.041666668f + y * (0.0083333338f + y * 0.0013888889f))))) : 1.f - a * a;
                const float u = __builtin_amdgcn_sqrtf(em) * (ig * bf_lo((unsigned)XC[tok * 136 + ch]));
                Hc = a * Hc + u; Ac *= a; Ar[nh][nt][r] = Ac; Hr[nh][nt][r] = Hc; }
            float AI = Ac, HI = Hc;
            { const float Ap = __shfl_up(AI, 16), Hp = __shfl_up(HI, 16); if (fq >= 1) { HI = AI * Hp + HI; AI = AI * Ap; } }
            { const float Ap = __shfl_up(AI, 32), Hp = __shfl_up(HI, 32); if (fq >= 2) { HI = AI * Hp + HI; AI = AI * Ap; } }
            { const float Ap = __shfl_up(AI, 16), Hp = __shfl_up(HI, 16); AE[nh][nt] = fq >= 1 ? Ap : 1.f; HE[nh][nt] = fq >= 1 ? Hp : 0.f; }
            if (fq == 3) { SEG[(wq * 128 + ch) * 2] = AI; SEG[(wq * 128 + ch) * 2 + 1] = HI; } }
    }
    __syncthreads();
#pragma unroll
    for (int nh = 0; nh < 2; ++nh)
#pragma unroll
        for (int nt = 0; nt < 4; ++nt) { const int ch = 64 * nh + 16 * nt + fr, C = g * 128 + ch;
            float Aw = 1.f, Hw = 0.f;
#pragma unroll
            for (int w2 = 0; w2 < 3; ++w2) if (w2 < wq) { const float As = SEG[(w2 * 128 + ch) * 2], Hs = SEG[(w2 * 128 + ch) * 2 + 1]; Hw = As * Hw + Hs; Aw *= As; }
            const float hin = AE[nh][nt] * Hw + HE[nh][nt], ain = AE[nh][nt] * Aw;
            float* hl = HL + (R0 + 16 * wq + 4 * fq) * AW + C; float* ac = AC + (R0 + 16 * wq + 4 * fq) * AW + C;
#pragma unroll
            for (int r = 0; r < 4; ++r) { hl[(size_t)r * AW] = Ar[nh][nt][r] * hin + Hr[nh][nt][r]; ac[(size_t)r * AW] = Ar[nh][nt][r] * ain; }
            if (wq == 3 && fq == 3) { float* sm = SUM + ((size_t)(b * 32 + c) * 1024 + C) * 2; sm[0] = Ar[nh][nt][3] * ain; sm[1] = Ar[nh][nt][3] * hin + Hr[nh][nt][3]; } }
}

constexpr int SC_STR = 129, P7_SAB = 2 * 128 * SC_STR * 4, P7_IL = P7_SAB + 128 * 33 * 4, P7_CT = P7_IL + 128 * 34 * 2;
static_assert(P7_CT + 64 <= MISC_OFF, "P7 LDS map");
__device__ __forceinline__ unsigned ord_key(float v) { const unsigned u = __builtin_bit_cast(unsigned, v); return (u & 0x80000000u) ? ~u : (u | 0x80000000u); }
#define CE_DESC(x, y) do { const unsigned _x = (x), _y = (y); (x) = _x > _y ? _x : _y; (y) = _x > _y ? _y : _x; } while (0)
template <int B, int NA> __device__ __forceinline__ void sort16_desc(unsigned (&a)[NA]) {
#pragma unroll
    for (int k = 2; k <= 16; k <<= 1)
#pragma unroll
        for (int j = k >> 1; j > 0; j >>= 1)
#pragma unroll
            for (int i = 0; i < 16; ++i) { const int l = i ^ j; if (l > i) { if ((i & k) == 0) CE_DESC(a[B + i], a[B + l]); else CE_DESC(a[B + l], a[B + i]); } }
}
template <int A, int Bo, int NA, int NB> __device__ __forceinline__ void merge16_desc(unsigned (&a)[NA], const unsigned (&b)[NB]) {
#pragma unroll
    for (int i = 0; i < 16; ++i) a[A + i] = a[A + i] > b[Bo + 15 - i] ? a[A + i] : b[Bo + 15 - i];
#pragma unroll
    for (int j = 8; j > 0; j >>= 1)
#pragma unroll
        for (int i = 0; i < 16; ++i) { const int l = i ^ j; if (l > i) CE_DESC(a[A + i], a[A + l]); }
}
__device__ __forceinline__ void peer_topk_unit(const Params& P, LAS unsigned char* lds, int t0, int h, int tid, int wave, int lane) {
    unsigned char* ws = P.ws;
    const bf16* QP = (const bf16*)(ws + WS_QP); const bf16* KEYS = (const bf16*)(ws + WS_KEYS);
    int* IDX = (int*)(ws + WS_IDX); float* GW = (float*)(ws + WS_G);
    LAS float* SC = (LAS float*)lds; LAS float* SAB = (LAS float*)(lds + P7_SAB); LAS unsigned short* IL = (LAS unsigned short*)(lds + P7_IL); LAS unsigned char* CT = lds + P7_CT;
    __syncthreads();
    if (tid < 64) { int ia = 0, rem = tid; while (ia < 16 && rem >= 16 / (ia + 1)) { rem -= 16 / (ia + 1); ++ia; }
        CT[tid] = (unsigned char)(ia < 16 ? ia * 16 + rem : 255); }
    { const int mtile = wave & 3, c = wave >> 2, r31 = lane & 31, hh = lane >> 5;
      bf16x8 A[8];
      const bf16* qp = QP + (size_t)(t0 + 32 * mtile + r31) * DM + h * 256 + c * 128 + 8 * hh;
#pragma unroll
      for (int ks = 0; ks < 8; ++ks) A[ks] = *(const bf16x8*)(qp + 16 * ks);
#pragma unroll
      for (int nt = 0; nt < 4; ++nt) { f32x16 acc;
#pragma unroll
          for (int r = 0; r < 16; ++r) acc[r] = 0.f;
          const bf16* kp = KEYS + ((size_t)((h * 2 + c) * 128 + 32 * nt + r31)) * 128 + 8 * hh;
#pragma unroll
          for (int ks = 0; ks < 8; ++ks) { const bf16x8 bk = *(const bf16x8*)(kp + 16 * ks); acc = MFMA32(A[ks], bk, acc); }
#pragma unroll
          for (int r = 0; r < 16; ++r) { const int tok = 32 * mtile + (r & 3) + 8 * (r >> 2) + 4 * hh; SC[(c * 128 + tok) * SC_STR + 32 * nt + r31] = acc[r]; } } }
    __syncthreads();
    const int half = tid & 1, c = (tid >> 1) & 1, tok = tid >> 2;
    unsigned a[64];
    { const LAS float* sp = SC + (c * 128 + tok) * SC_STR + half * 64; const int rot = 8 * (2 * c + half);
#pragma unroll
      for (int i = 0; i < 64; ++i) { const int n = (i + rot) & 63; a[i] = (ord_key(sp[n]) & ~127u) | (unsigned)(127 - (half * 64 + n)); } }
    sort16_desc<0>(a); sort16_desc<16>(a); sort16_desc<32>(a); sort16_desc<48>(a);
    merge16_desc<0, 16>(a, a); merge16_desc<32, 48>(a, a); merge16_desc<0, 32>(a, a);
    { unsigned o[16];
#pragma unroll
      for (int j = 0; j < 16; ++j) o[j] = (unsigned)__shfl_xor((int)a[j], 1);
      merge16_desc<0, 0>(a, o); }
    if (half == 0) {
#pragma unroll
        for (int j = 0; j < 16; ++j) { const int n = 127 - (int)(a[j] & 127u); SAB[tok * 33 + c * 16 + j] = SC[(c * 128 + tok) * SC_STR + n]; IL[tok * 34 + c * 16 + j] = (unsigned short)n; } }
    __syncthreads();
    const int q = tid & 3;
    unsigned cd[16];
#pragma unroll
    for (int j = 0; j < 13; ++j) { const unsigned code = CT[q + 4 * j]; const float s = SAB[tok * 33 + ((code >> 4) & 15u)] + SAB[tok * 33 + 16 + (code & 15u)];
        cd[j] = code == 255u ? 0u : ((ord_key(s) & ~255u) | (255u - code)); }
    cd[13] = 0u; cd[14] = 0u; cd[15] = 0u;
    sort16_desc<0>(cd);
    { unsigned o[16];
#pragma unroll
      for (int j = 0; j < 16; ++j) o[j] = (unsigned)__shfl_xor((int)cd[j], 1);
      merge16_desc<0, 0>(cd, o);
#pragma unroll
      for (int j = 0; j < 16; ++j) o[j] = (unsigned)__shfl_xor((int)cd[j], 2);
      merge16_desc<0, 0>(cd, o); }
    if (q == 0) {
        float cv[16]; int id[16];
#pragma unroll
        for (int s = 0; s < 16; ++s) { const unsigned code = 255u - (cd[s] & 255u); const int ia = (int)(code >> 4), ib = (int)(code & 15u); const int na = IL[tok * 34 + ia], nb = IL[tok * 34 + 16 + ib];
            cv[s] = SAB[tok * 33 + ia] + SAB[tok * 33 + 16 + ib]; id[s] = na * 128 + nb; }
        float mx = cv[0];
#pragma unroll
        for (int s = 1; s < 16; ++s) mx = fmaxf(mx, cv[s]);
        float sum = 0.f;
#pragma unroll
        for (int s = 0; s < 16; ++s) { cv[s] = __builtin_amdgcn_exp2f((cv[s] - mx) * LOG2E); sum += cv[s]; }
        const float inv = 1.f / sum;
        int* ip = IDX + (size_t)(t0 + tok) * 128 + h * 16; float* gp = GW + (size_t)(t0 + tok) * 128 + h * 16;
#pragma unroll
        for (int s4 = 0; s4 < 4; ++s4) { *(int4*)(ip + 4 * s4) = make_int4(id[4 * s4], id[4 * s4 + 1], id[4 * s4 + 2], id[4 * s4 + 3]);
            *(f32x4*)(gp + 4 * s4) = (f32x4){cv[4 * s4] * inv, cv[4 * s4 + 1] * inv, cv[4 * s4 + 2] * inv, cv[4 * s4 + 3] * inv}; }
    }
}

__device__ __forceinline__ void fp8x16_to_f32(const v4u& w, float (&f)[16]) {
#pragma unroll
    for (int i = 0; i < 4; ++i) { const f32x2_t lo = __builtin_amdgcn_cvt_pk_f32_fp8((int)w[i], false), hi = __builtin_amdgcn_cvt_pk_f32_fp8((int)w[i], true);
        f[4 * i] = lo[0]; f[4 * i + 1] = lo[1]; f[4 * i + 2] = hi[0]; f[4 * i + 3] = hi[1]; }
}
#define LD16I(dst, p) do { _Pragma("unroll") for (int q_ = 0; q_ < 4; ++q_) { const int4 v_ = ((const int4*)(p))[q_]; dst[4 * q_] = v_.x; dst[4 * q_ + 1] = v_.y; dst[4 * q_ + 2] = v_.z; dst[4 * q_ + 3] = v_.w; } } while (0)
#define LD16F(dst, p) do { _Pragma("unroll") for (int q_ = 0; q_ < 4; ++q_) { const f32x4 v_ = ((const f32x4*)(p))[q_]; dst[4 * q_] = v_[0]; dst[4 * q_ + 1] = v_[1]; dst[4 * q_ + 2] = v_[2]; dst[4 * q_ + 3] = v_[3]; } } while (0)
__device__ __forceinline__ void peer_u_phase(const Params& P, int xg, int slot, int nslots, int lane) {
    unsigned char* ws = P.ws;
    const bf16* X1B = (const bf16*)(ws + WS_X1B); const unsigned char* U8 = ws + WS_U8; const int* IDX = (const int*)(ws + WS_IDX); float* PD = (float*)(ws + WS_PD) + (size_t)xg * T_TOK * 128;
    const int ntok = slot < T_TOK ? (T_TOK - slot + nslots - 1) / nslots : 0, N = 2 * ntok;
    if (N == 0) return;
    const int R = lane >> 3, p = lane & 7;
    const bool b2 = (lane & 4) != 0, b1 = (lane & 2) != 0, b0 = (lane & 1) != 0;
    int idn[16], idq[16]; v4u xc[2], xn[2]; v4u B0[8], B1[8], B2[8];
#define U_ITEM(n, t, s) const int n_##t = (n) < N ? (n) : N - 1; const int t = slot + (n_##t >= ntok ? n_##t - ntok : n_##t) * nslots, s = 2 * xg + (n_##t >= ntok ? 1 : 0)
#define U_ROWS(buf, ids, off, s) do { const unsigned char* ub_ = U8 + (size_t)(s) * NEXP * 128; _Pragma("unroll") for (int i = 0; i < 8; ++i) buf[i] = *(const v4u*)(ub_ + (unsigned)(((unsigned)ids[(off) + i] << 7) + 16u * p)); } while (0)
#define U_HALF(buf, off) do { _Pragma("unroll") for (int i = 0; i < 8; ++i) { int d = 0; _Pragma("unroll") for (int w = 0; w < 4; ++w) d = __builtin_amdgcn_sdot4((int)buf[i][w], xq[w], d, false); part[(off) + i] = d; } } while (0)
    { U_ITEM(0, t0, s0); U_ITEM(1, t1, s1);
      int id0[16];
#pragma unroll
      LD16I(id0, IDX + (size_t)t0 * 128 + 16 * R); LD16I(idn, IDX + (size_t)t1 * 128 + 16 * R);
      const bf16* xp = X1B + (size_t)t0 * DM + 128 * s0 + 16 * p; xc[0] = *(const v4u*)xp; xc[1] = *(const v4u*)(xp + 8);
      U_ROWS(B0, id0, 0, s0); U_ROWS(B1, id0, 8, s0); }
#define U_BODY(n, Ba, Bb, Bc) do { \
        U_ITEM(n, t, s); U_ITEM((n) + 1, t1, s1); U_ITEM((n) + 2, t2, s2); (void)s; (void)s2; \
        U_ROWS(Bc, idn, 0, s1); \
        LD16I(idq, IDX + (size_t)t2 * 128 + 16 * R); \
        { const bf16* xp = X1B + (size_t)t1 * DM + 128 * s1 + 16 * p; xn[0] = *(const v4u*)xp; xn[1] = *(const v4u*)(xp + 8); } \
        float x[16]; float am = 0.f; \
        _Pragma("unroll") for (int k = 0; k < 4; ++k) { x[2 * k] = bf_lo(xc[0][k]); x[2 * k + 1] = bf_hi(xc[0][k]); x[8 + 2 * k] = bf_lo(xc[1][k]); x[8 + 2 * k + 1] = bf_hi(xc[1][k]); } \
        _Pragma("unroll") for (int k = 0; k < 16; ++k) am = fmaxf(am, fabsf(x[k])); \
        am = fmaxf(am, __shfl_xor(am, 1)); am = fmaxf(am, __shfl_xor(am, 2)); am = fmaxf(am, __shfl_xor(am, 4)); \
        const float xs = am > 0.f ? am * (1.f / 127.f) : 1.f, xinv = 1.f / xs; \
        int xq[4]; \
        _Pragma("unroll") for (int w = 0; w < 4; ++w) { const int q0 = (int)rintf(x[4 * w] * xinv), q1 = (int)rintf(x[4 * w + 1] * xinv), q2 = (int)rintf(x[4 * w + 2] * xinv), q3 = (int)rintf(x[4 * w + 3] * xinv); \
            xq[w] = (int)((unsigned)(q0 & 255) | ((unsigned)(q1 & 255) << 8) | ((unsigned)(q2 & 255) << 16) | ((unsigned)q3 << 24)); } \
        int part[16]; \
        U_HALF(Ba, 0); \
        U_ROWS(Ba, idn, 8, s1); \
        U_HALF(Bb, 8); \
        if ((n) < N) { \
            int a8[8], a4[4], a2i[2]; \
            _Pragma("unroll") for (int k = 0; k < 8; ++k) { const int send = b2 ? part[k] : part[k + 8], keep = b2 ? part[k + 8] : part[k]; a8[k] = keep + __shfl_xor(send, 4); } \
            _Pragma("unroll") for (int k = 0; k < 4; ++k) { const int send = b1 ? a8[k] : a8[k + 4], keep = b1 ? a8[k + 4] : a8[k]; a4[k] = keep + __shfl_xor(send, 2); } \
            _Pragma("unroll") for (int k = 0; k < 2; ++k) { const int send = b0 ? a4[k] : a4[k + 2], keep = b0 ? a4[k + 2] : a4[k]; a2i[k] = keep + __shfl_xor(send, 1); } \
            const float a2[2] = {(float)a2i[0] * xs, (float)a2i[1] * xs}; \
            const int i0 = (b2 ? 8 : 0) + (b1 ? 4 : 0) + (b0 ? 2 : 0); \
            f32x2_t* pp = (f32x2_t*)(PD + (size_t)t * 128 + 16 * R + i0); \
            f32x2_t pv_ = (f32x2_t){a2[0], a2[1]}; if ((n) >= ntok) pv_ = pv_ + *pp; \
            *pp = pv_; } \
        _Pragma("unroll") for (int i = 0; i < 16; ++i) idn[i] = idq[i]; \
        xc[0] = xn[0]; xc[1] = xn[1]; } while (0)
    for (int n = 0; n < N; n += 3) { U_BODY(n, B0, B1, B2); U_BODY(n + 1, B2, B0, B1); U_BODY(n + 2, B1, B2, B0); }
#undef U_ITEM
#undef U_ROWS
#undef U_HALF
#undef U_BODY
}
__device__ __forceinline__ void peer_act_tokens(const Params& P, int t, int t2, int lane) {
    unsigned char* ws = P.ws;
    const float* PD = (const float*)(ws + WS_PD); const int* IDX = (const int*)(ws + WS_IDX); const float* GW = (const float*)(ws + WS_G); const float* SSP = (const float*)(ws + WS_SSP);
    const float* US = (const float*)(ws + WS_US); const float* VS = (const float*)(ws + WS_VS); float* ACT = (float*)(ws + WS_ACT);
    const bool two = t2 >= 0; const int tt[2] = {t, two ? t2 : t};
    float ss[2], d[2][2], gw[2][2], us[2][2], vs[2][2]; int id[2][2];
#pragma unroll
    for (int k = 0; k < 2; ++k) { ss[k] = lane < 32 ? SSP[(size_t)tt[k] * 32 + lane] : 0.f;
#pragma unroll
        for (int s = 0; s < 2; ++s) { const int slot = 64 * s + lane; id[k][s] = IDX[(size_t)tt[k] * 128 + slot]; gw[k][s] = GW[(size_t)tt[k] * 128 + slot]; float a = 0.f;
#pragma unroll
            for (int xg = 0; xg < 8; ++xg) a += PD[((size_t)xg * T_TOK + tt[k]) * 128 + slot];
            d[k][s] = a; } }
#pragma unroll
    for (int k = 0; k < 2; ++k)
#pragma unroll
        for (int s = 0; s < 2; ++s) { us[k][s] = US[id[k][s]]; vs[k][s] = VS[id[k][s]]; }
#pragma unroll
    for (int k = 0; k < 2; ++k) { const float rs = __builtin_amdgcn_rsqf(wave_sum(ss[k]) * (1.f / 2048.f) + RMS_EPS);
        if (k == 0 || two) {
#pragma unroll
            for (int s = 0; s < 2; ++s) ACT[(size_t)tt[k] * 128 + 64 * s + lane] = pg8::gelu_tanh_f(d[k][s] * us[k][s] * rs) * gw[k][s] * vs[k][s]; } }
}
#define PIN16(a) asm volatile("" : "+v"(a[0]), "+v"(a[1]), "+v"(a[2]), "+v"(a[3]), "+v"(a[4]), "+v"(a[5]), "+v"(a[6]), "+v"(a[7]), "+v"(a[8]), "+v"(a[9]), "+v"(a[10]), "+v"(a[11]), "+v"(a[12]), "+v"(a[13]), "+v"(a[14]), "+v"(a[15]))
__device__ __forceinline__ void peer_v_phase(const Params& P, int xg, int slot, int nslots, int lane) {
    unsigned char* ws = P.ws;
    const unsigned char* V8 = ws + WS_V8; const int* IDX = (const int*)(ws + WS_IDX); const float* ACT = (const float*)(ws + WS_ACT); bf16* OUTP = (bf16*)(ws + WS_OUTP);
    const int ntok = slot < T_TOK ? (T_TOK - slot + nslots - 1) / nslots : 0, N = 2 * ntok;
    if (N == 0) return;
    const int R = lane >> 3, p = lane & 7;
    const bool b5 = (lane & 32) != 0, b4 = (lane & 16) != 0, b3 = (lane & 8) != 0;
    int idn[16], idq[16]; float avc[16], avn[16]; v4u B0[8], B1[8], B2[8];
#define V_ITEM(n, t, s) const int n_##t = (n) < N ? (n) : N - 1; const int t = slot + (n_##t >= ntok ? n_##t - ntok : n_##t) * nslots, s = 2 * xg + (n_##t >= ntok ? 1 : 0)
#define V_ROWS(buf, ids, off, s) do { const unsigned char* vb_ = V8 + (size_t)(s) * NEXP * 128; _Pragma("unroll") for (int i = 0; i < 8; ++i) buf[i] = *(const v4u*)(vb_ + (unsigned)(((unsigned)ids[(off) + i] << 7) + 16u * p)); } while (0)
#define V_HALF(buf, off) do { _Pragma("unroll") for (int i = 0; i < 8; ++i) { asm volatile("" : "+v"(buf[i][0]), "+v"(buf[i][1]), "+v"(buf[i][2]), "+v"(buf[i][3])); \
            float f[16]; fp8x16_to_f32(buf[i], f); _Pragma("unroll") for (int k = 0; k < 16; ++k) acc[k] += avc[(off) + i] * f[k]; PIN16(acc); } } while (0)
    { V_ITEM(0, t0, s0); V_ITEM(1, t1, s1);
      int id0[16];
#pragma unroll
      for (int i = 0; i < 1; ++i) { LD16I(id0, IDX + (size_t)t0 * 128 + 16 * R); LD16I(idn, IDX + (size_t)t1 * 128 + 16 * R); LD16F(avc, ACT + (size_t)t0 * 128 + 16 * R); }
      V_ROWS(B0, id0, 0, s0); V_ROWS(B1, id0, 8, s0); }
#define V_BODY(n, Ba, Bb, Bc) do { \
        V_ITEM(n, t, s); V_ITEM((n) + 1, t1, s1); V_ITEM((n) + 2, t2, s2); (void)s2; \
        V_ROWS(Bc, idn, 0, s1); \
        LD16I(idq, IDX + (size_t)t2 * 128 + 16 * R); LD16F(avn, ACT + (size_t)t1 * 128 + 16 * R); \
        float acc[16]; \
        _Pragma("unroll") for (int k = 0; k < 16; ++k) acc[k] = 0.f; \
        V_HALF(Ba, 0); \
        V_ROWS(Ba, idn, 8, s1); \
        V_HALF(Bb, 8); \
        if ((n) < N) { \
            float a8[8], a4[4], a2[2]; \
            _Pragma("unroll") for (int k = 0; k < 8; ++k) { const float send = b5 ? acc[k] : acc[k + 8], keep = b5 ? acc[k + 8] : acc[k]; a8[k] = keep + __shfl_xor(send, 32); } \
            _Pragma("unroll") for (int k = 0; k < 4; ++k) { const float send = b4 ? a8[k] : a8[k + 4], keep = b4 ? a8[k + 4] : a8[k]; a4[k] = keep + __shfl_xor(send, 16); } \
            _Pragma("unroll") for (int k = 0; k < 2; ++k) { const float send = b3 ? a4[k] : a4[k + 2], keep = b3 ? a4[k + 2] : a4[k]; a2[k] = keep + __shfl_xor(send, 8); } \
            const int col = 128 * s + 16 * p + (b5 ? 8 : 0) + (b4 ? 4 : 0) + (b3 ? 2 : 0); \
            *(unsigned*)(OUTP + (size_t)t * DM + col) = cvtpk(a2[0], a2[1]); } \
        _Pragma("unroll") for (int i = 0; i < 16; ++i) { idn[i] = idq[i]; avc[i] = avn[i]; } } while (0)
    for (int n = 0; n < N; n += 3) { V_BODY(n, B0, B1, B2); V_BODY(n + 1, B2, B0, B1); V_BODY(n + 2, B1, B2, B0); }
#undef V_ITEM
#undef V_ROWS
#undef V_HALF
#undef V_BODY
}
__device__ __forceinline__ void peer_final_tokens(const Params& P, int t, int t2, int lane, float* outp) {
    const bool two = t2 >= 0; const int tt[2] = {t, two ? t2 : t};
    v4u a[2][4], b[2][4];
#pragma unroll
    for (int k = 0; k < 2; ++k) { const bf16* xrow = (const bf16*)(P.ws + WS_X1B) + (size_t)tt[k] * DM; const bf16* prow = (const bf16*)(P.ws + WS_OUTP) + (size_t)tt[k] * DM;
#pragma unroll
        for (int j = 0; j < 4; ++j) { a[k][j] = *(const v4u*)(xrow + 512 * j + 8 * lane); b[k][j] = *(const v4u*)(prow + 512 * j + 8 * lane); } }
#pragma unroll
    for (int k = 0; k < 2; ++k) { if (k == 1 && !two) break;
        float v[4][8]; float ss = 0.f;
#pragma unroll
        for (int j = 0; j < 4; ++j) {
#pragma unroll
            for (int i = 0; i < 4; ++i) { v[j][2 * i] = bf_lo(a[k][j][i]) + bf_lo(b[k][j][i]); v[j][2 * i + 1] = bf_hi(a[k][j][i]) + bf_hi(b[k][j][i]); }
#pragma unroll
            for (int i = 0; i < 8; ++i) ss += v[j][i] * v[j][i]; }
        const float rf = __builtin_amdgcn_rsqf(wave_sum(ss) * (1.f / 2048.f) + RMS_EPS);
        float* orow = outp + (size_t)tt[k] * DM;
#pragma unroll
        for (int j = 0; j < 4; ++j) { const f32x4 g0 = *(const f32x4*)(P.g_fin + 512 * j + 8 * lane), g1 = *(const f32x4*)(P.g_fin + 512 * j + 8 * lane + 4); f32x4 o0, o1;
#pragma unroll
            for (int i = 0; i < 4; ++i) { o0[i] = v[j][i] * rf * g0[i]; o1[i] = v[j][4 + i] * rf * g1[i]; }
            *(f32x4*)(orow + 512 * j + 8 * lane) = o0; *(f32x4*)(orow + 512 * j + 8 * lane + 4) = o1; } }
}

#ifndef MK_PER_PHASE
#define MK_PER_PHASE 0
#endif
constexpr int N_PHASES = 12;
__global__ void __launch_bounds__(NWAVES * 64, 2) fwd_kernel(Params P) {
    extern __shared__ __attribute__((aligned(16))) unsigned char lds_raw[];
    LAS unsigned char* lds = (LAS unsigned char*)lds_raw;
    volatile LAS unsigned* MISC = (volatile LAS unsigned*)(lds + MISC_OFF);
    const int tid = threadIdx.x, lane = tid & 63, wave = __builtin_amdgcn_readfirstlane(tid >> 6);
    const int G = gridDim.x; const int bx = blockIdx.x;
    const int vcu = (G % 8 == 0) ? (bx % 8) * (G / 8) + bx / 8 : bx;
    const int gw = vcu * NWAVES + wave, NGW = G * NWAVES;
    unsigned char* ws = P.ws;
    gu32* ctl = (gu32*)(ws + WS_CTL);
    for (int u = tid; u < 64; u += NWAVES * 64) MISC[u] = 0u;
    __syncthreads();
    XcdBarrier bar; bar.bar = (unsigned*)ctl + CW_BAR; bar.x = 0; bar.st = nullptr;
    if (!MK_PER_PHASE) bar = xcd_barrier_post((unsigned*)ctl + CW_BAR, MISC + 8);
    const unsigned my_xcc = xb_xcc_id();
    if (!MK_PER_PHASE) { if (tid == 0) MISC[16] = __hip_atomic_fetch_add((unsigned*)(ctl + CW_XC + 64 * (my_xcc & 7u)), 1u, __ATOMIC_RELAXED, __HIP_MEMORY_SCOPE_AGENT); }
    const int lo = P.ph_lo, hi = P.ph_hi;
#define FRESH_IDS const int lane = (int)__builtin_amdgcn_mbcnt_hi(~0u, __builtin_amdgcn_mbcnt_lo(~0u, 0u)); const int tid = wave * 64 + lane; (void)tid; (void)lane
#ifndef PH_MASK
#define PH_MASK 0xfff
#endif
#define IN(k) (((PH_MASK >> (k)) & 1) && lo <= (k) && (k) < hi)
#define BOTH(k) (IN(k) && IN((k) + 1))
#ifndef DUP_MASK
#define DUP_MASK 0
#endif
#define NREP(k) (((DUP_MASK >> (k)) & 1) ? 2 : 1)
#define GRID_BAR() do { if (!MK_PER_PHASE) xcd_barrier(bar); } while (0)
#ifdef TPROBE
#ifndef TPROBE_MODE
#define TPROBE_MODE 0
#endif
#define TP_T0 (wave == 0 && __builtin_amdgcn_mbcnt_hi(~0u, __builtin_amdgcn_mbcnt_lo(~0u, 0u)) == 0u)
#define TP_PREV (TPROBE == 8 ? 6 : TPROBE - 1)
    if (TP_T0) { MISC[20] = (unsigned)__builtin_amdgcn_s_memrealtime(); MISC[21] = 0u; }
#define TP_PRE(k) ((TPROBE_MODE == 1 && (k) == TPROBE) || TPROBE_MODE == 2)
#define TP_POST(k) ((TPROBE_MODE == 0 && ((k) == TPROBE || (k) == TP_PREV)) || TP_PRE(k))
#define GRID_BAR_K(k) do { if (TP_PRE(k)) { if (TP_T0) MISC[22] = (unsigned)__builtin_amdgcn_s_memrealtime(); } xcd_barrier(bar); \
        if (TP_POST(k)) { if (TP_T0) { const unsigned tq1 = (unsigned)__builtin_amdgcn_s_memrealtime(); \
            if (TPROBE_MODE == 0 && (k) == TPROBE) MISC[21] = tq1 - MISC[20]; if (TPROBE_MODE == 1 && (k) == TPROBE) MISC[21] = tq1 - MISC[22]; if (TPROBE_MODE == 2) MISC[21] = MISC[21] + (tq1 - MISC[22]); MISC[20] = tq1; } } } while (0)
#else
#define GRID_BAR_K(k) GRID_BAR()
#endif

    bf16* HN = (bf16*)(ws + WS_HN); bf16* WA = (bf16*)(ws + WS_WA); bf16* WV = (bf16*)(ws + WS_WV); bf16* WB = (bf16*)(ws + WS_WB); bf16* WO = (bf16*)(ws + WS_WO); bf16* WQ = (bf16*)(ws + WS_WQ);

    constexpr int NV_UNITS = (AW / 256) * (T_TOK / 256);
    const bool tab_fast = (G > NV_UNITS && (1024 % G) == 0);
    const int tab_r1 = tab_fast ? 0 : NEXP;
    if (IN(0)) { FRESH_IDS; for (int rep = 0; rep < NREP(0); ++rep) p0_prologue(P, lds, gw, NGW, wave, lane, tab_r1); if (BOTH(0)) GRID_BAR_K(0); }

    if (IN(1)) { FRESH_IDS;
      _Pragma("unroll") for (int rep = 0; rep < NREP(1); ++rep) {
        { pg8::Gemm g{HN, WA, T_TOK, NWA, DM / 2, WV, HN, ws, (unsigned)WS_END}; pg8::StaticOrder2 S; S.init(T_TOK, NWA, AW, T_TOK, G, bx);
          pg8::EpiProj E{(bf16*)(ws + WS_Q), (bf16*)(ws + WS_K), (bf16*)(ws + WS_XR), (bf16*)(ws + WS_GY), (bf16*)(ws + WS_SG), (bf16*)(ws + WS_VT), rep == 0 ? (float*)(ws + WS_CTL) + CW_KM : nullptr, QSCALE, 1.f / W8SCALE};
          pg8::gemm_phase<pg8::EpiProj, pg8::StaticOrder2, true, true, true>(lds, g, S, E); }
        if (tab_fast && bx >= NV_UNITS) peer_table_u<2>(P, 0, NEXP, (bx - NV_UNITS) * NWAVES + wave, (G - NV_UNITS) * NWAVES, lane);
      }
        if (BOTH(1)) GRID_BAR_K(1);
    }

    if (IN(2)) { FRESH_IDS;
        LAS int* tick = (LAS int*)(lds + MISC_OFF + 128);
#define NEXT_TICKET(dst, word) do { __syncthreads(); if (tid == 0) *tick = (int)__hip_atomic_fetch_add((unsigned*)(ctl + (word)), 1u, __ATOMIC_RELAXED, __HIP_MEMORY_SCOPE_AGENT); __syncthreads(); dst = *tick; } while (0)
#define TICKET_ISSUE(word) do { if (tid == 0) tk_next = (int)__hip_atomic_fetch_add((unsigned*)(ctl + (word)), 1u, __ATOMIC_RELAXED, __HIP_MEMORY_SCOPE_AGENT); } while (0)
#define TICKET_TAKE(dst) do { __syncthreads(); if (tid == 0) *tick = tk_next; __syncthreads(); dst = *tick; } while (0)
        int tk_next = 0;
#ifndef DUP_ATT
#define DUP_ATT 0
#endif
#ifndef DUP_LRU
#define DUP_LRU 0
#endif
#ifndef DUP_P2
#define DUP_P2 0
#endif
        _Pragma("unroll") for (int rp = 0; rp < 1 + DUP_P2; ++rp) {
        _Pragma("unroll") for (int rep = 0; rep < 1 + DUP_ATT; ++rep) {
            int tid2 = tid; asm volatile("" : "+v"(tid2));
            int it; NEXT_TICKET(it, CW_Q2 + 64 * (rep + 2 * rp));
            while (it < 256) { const int blk = 7 - (it >> 5), bh = it & 31; attn_unit(P, lds, bh >> 3, bh & 7, blk, tid2, wave, tid2 & 63); NEXT_TICKET(it, CW_Q2 + 64 * (rep + 2 * rp)); } }
        _Pragma("unroll") for (int rep = 0; rep < 1 + DUP_LRU; ++rep) {
            int tid2 = tid; asm volatile("" : "+v"(tid2));
            int it; NEXT_TICKET(it, CW_Q2 + 256 + 64 * (rep + 2 * rp));
            while (it < 512) { lru_pair(P, lds, it, tid2, wave, tid2 & 63, (unsigned*)(ctl + CW_Q2 + 256 + 64 * (rep + 2 * rp)), tk_next); TICKET_TAKE(it); } }
        if (DUP_P2 && rp == 0) GRID_BAR();
        }
#undef NEXT_TICKET
#undef TICKET_ISSUE
#undef TICKET_TAKE
        if (BOTH(2)) GRID_BAR_K(2);
    }

    if (IN(3)) { FRESH_IDS;
      _Pragma("unroll") for (int rep = 0; rep < NREP(3); ++rep) {
        const float* HL = (const float*)(ws + WS_HL); const float* AC = (const float*)(ws + WS_AC); const float* SUM = (const float*)(ws + WS_SUM);
        const bf16* GY = (const bf16*)(ws + WS_GY); unsigned char* OCAT = ws + WS_OCAT;
        for (int u = vcu; u < 256; u += G) { const int b = u >> 6, c = (u >> 1) & 31, C = (u & 1) * 512 + 4 * (tid & 127), tq = tid >> 7;
            f32x4 carry = (f32x4){0.f, 0.f, 0.f, 0.f};
            for (int cc = 0; cc < c; ++cc) { const float* sm = SUM + ((size_t)(b * 32 + cc) * 1024 + C) * 2; const f32x4 s0 = *(const f32x4*)sm, s1 = *(const f32x4*)(sm + 4);
                carry[0] = s0[0] * carry[0] + s0[1]; carry[1] = s0[2] * carry[1] + s0[3]; carry[2] = s1[0] * carry[2] + s1[1]; carry[3] = s1[2] * carry[3] + s1[3]; }
            const size_t R0 = (size_t)b * SEQ + c * 64 + tq * 16;
#pragma unroll 8
            for (int t = 0; t < 16; ++t) { const size_t o = (R0 + t) * AW + C; const f32x4 hv = *(const f32x4*)(HL + o) + *(const f32x4*)(AC + o) * carry;
                const unsigned long long gy = *(const unsigned long long*)(GY + o); const unsigned g0 = (unsigned)gy, g1 = (unsigned)(gy >> 32);
                int p = __builtin_amdgcn_cvt_pk_fp8_f32(clamp8(hv[0] * bf_lo(g0) * OC8SCALE), clamp8(hv[1] * bf_hi(g0) * OC8SCALE), 0, false); p = __builtin_amdgcn_cvt_pk_fp8_f32(clamp8(hv[2] * bf_lo(g1) * OC8SCALE), clamp8(hv[3] * bf_hi(g1) * OC8SCALE), p, true);
                *(unsigned*)(OCAT + (R0 + t) * DM + AW + C) = (unsigned)p; } }
      }
        if (BOTH(3)) GRID_BAR_K(3);
    }

    if (IN(4)) { FRESH_IDS;
      _Pragma("unroll") for (int rep = 0; rep < NREP(4); ++rep) {
        { pg8::Gemm g{(bf16*)(ws + WS_OCAT), WB, T_TOK, DM, DM / 2, nullptr, nullptr, ws, (unsigned)WS_END}; pg8::StaticOrder S; S.init(T_TOK, DM, G, bx);
          pg8::EpiMerge2 E{(const bf16*)(ws + WS_SG), (bf16*)(ws + WS_MG), MG8SCALE / (OC8SCALE * WB8SCALE)};
          pg8::gemm_phase<pg8::EpiMerge2, pg8::StaticOrder, true, true, true>(lds, g, S, E); }
      }
        if (BOTH(4)) GRID_BAR_K(4);
    }

    if (IN(5)) { FRESH_IDS;
      _Pragma("unroll") for (int rep = 0; rep < NREP(5); ++rep) {
        pg8::Gemm g{(bf16*)(ws + WS_MG), WO, T_TOK, DM, DM / 2, nullptr, nullptr, ws, (unsigned)WS_END}; pg8::StaticOrder S; S.init(T_TOK, DM, G, bx);
        pg8::EpiResid E{P.x, (bf16*)(ws + WS_X1B), (float*)(ws + WS_SSP), 1.f / (W8SCALE * MG8SCALE)};
        pg8::gemm_phase<pg8::EpiResid, pg8::StaticOrder, true, true, true>(lds, g, S, E);
      }
        if (BOTH(5)) GRID_BAR_K(5);
    }

    if (IN(6)) { FRESH_IDS;
      _Pragma("unroll") for (int rep = 0; rep < NREP(6); ++rep) {
        pg8::Gemm g{(bf16*)(ws + WS_X1B), WQ, T_TOK, DM, DM, nullptr, nullptr, ws, (unsigned)WS_END}; pg8::StaticOrder S; S.init(T_TOK, DM, G, bx);
        pg8::EpiRowScale E{(const float*)(ws + WS_SSP), (bf16*)(ws + WS_QP)};
        pg8::gemm_phase<pg8::EpiRowScale, pg8::StaticOrder, true, true>(lds, g, S, E);
        { pg8::Unit u; for (int i = 0; S.next(i, u); ++i) { peer_topk_unit(P, lds, u.pm * 256, u.pn, tid, wave, lane); peer_topk_unit(P, lds, u.pm * 256 + 128, u.pn, tid, wave, lane); } }
      }
        if (BOTH(6)) GRID_BAR_K(6);
    }

    int xg = bx & 7, nblk_g = (G - xg + 7) >> 3, rank_g = bx >> 3;
    if (!MK_PER_PHASE && lo == 0 && hi > 8) {
        unsigned cnt[8], sum = 0u; bool ok = my_xcc < 8u;
#pragma unroll
        for (int j = 0; j < 8; ++j) { cnt[j] = __hip_atomic_load((unsigned*)(ctl + CW_XC + 64 * j), __ATOMIC_RELAXED, __HIP_MEMORY_SCOPE_AGENT); sum += cnt[j]; ok = ok && cnt[j] > 0u; }
        if (ok && sum == (unsigned)G) { xg = (int)my_xcc; rank_g = (int)MISC[16];
            nblk_g = (int)(xg == 0 ? cnt[0] : xg == 1 ? cnt[1] : xg == 2 ? cnt[2] : xg == 3 ? cnt[3] : xg == 4 ? cnt[4] : xg == 5 ? cnt[5] : xg == 6 ? cnt[6] : cnt[7]); }
    }
    const int nslots = nblk_g * NWAVES, slot = rank_g * NWAVES + wave;
    if (IN(8)) { FRESH_IDS;
        _Pragma("unroll") for (int rep = 0; rep < NREP(8); ++rep) {
        if (tab_fast) { if (wave == NWAVES - 1) peer_table_v<4>(P, 0, NEXP, bx, G, lane); else peer_u_phase(P, xg, rank_g * (NWAVES - 1) + wave, nblk_g * (NWAVES - 1), lane); }
        else peer_u_phase(P, xg, slot, nslots, lane); }
        if (BOTH(8)) GRID_BAR_K(8);
    }
#ifdef EXTRA_BARS
    for (int eb = 0; eb < EXTRA_BARS; ++eb) GRID_BAR();
#endif
    if (IN(9)) { FRESH_IDS;
        for (int t = gw; t < T_TOK; t += 2 * NGW) peer_act_tokens(P, t, t + NGW < T_TOK ? t + NGW : -1, lane);
        if (BOTH(9)) GRID_BAR_K(9);
    }
    if (IN(10)) { FRESH_IDS;
        _Pragma("unroll") for (int rep = 0; rep < NREP(10); ++rep)
        peer_v_phase(P, xg, slot, nslots, lane);
        if (BOTH(10)) GRID_BAR_K(10);
    }
    if (IN(11)) { FRESH_IDS;
        if (NREP(11) == 2) for (int t = gw; t < T_TOK; t += 2 * NGW) peer_final_tokens(P, t, t + NGW < T_TOK ? t + NGW : -1, lane, (float*)(ws + WS_MG));
        for (int t = gw; t < T_TOK; t += 2 * NGW) peer_final_tokens(P, t, t + NGW < T_TOK ? t + NGW : -1, lane, P.out);
    }
#ifdef TPROBE
    { GRID_BAR_K(11);
      gu32* tpw = (gu32*)(P.ws + WS_CTL) + 16384;
      if (TP_T0) __hip_atomic_fetch_add((unsigned*)tpw, MISC[21], __ATOMIC_RELAXED, __HIP_MEMORY_SCOPE_AGENT);
      GRID_BAR();
      const unsigned tot = __hip_atomic_load((unsigned*)tpw, __ATOMIC_RELAXED, __HIP_MEMORY_SCOPE_AGENT), avg = (unsigned)__builtin_amdgcn_readfirstlane((int)(tot >> 8));
      const unsigned ts = (unsigned)__builtin_amdgcn_s_memrealtime();
      while ((unsigned)__builtin_amdgcn_s_memrealtime() - ts < avg) __builtin_amdgcn_s_sleep(1); }
#endif
#undef IN
#undef BOTH
#undef GRID_BAR
}

extern "C" void kernel_launch(void* const* d_in, const int* in_sizes, int n_in, void* d_out, int out_size, void* d_ws, size_t ws_size, hipStream_t stream) {
    static int grid = 0;
    if (grid == 0) {
        if (n_in != 19 || out_size != T_TOK * DM || ws_size < WS_END) { fprintf(stderr, "kernel_launch: unexpected problem (n_in %d, out %d, ws %zu); nothing launched\n", n_in, out_size, ws_size); grid = -1; return; }
        int dev = 0, cus = 0, per_cu = 0;
        if (hipGetDevice(&dev) != hipSuccess || hipDeviceGetAttribute(&cus, hipDeviceAttributeMultiprocessorCount, dev) != hipSuccess) { grid = -1; return; }
        if (hipFuncSetAttribute((const void*)fwd_kernel, hipFuncAttributeMaxDynamicSharedMemorySize, LDS_BYTES) != hipSuccess) { fprintf(stderr, "kernel_launch: hipFuncSetAttribute failed\n"); grid = -1; return; }
        if (hipOccupancyMaxActiveBlocksPerMultiprocessor(&per_cu, (const void*)fwd_kernel, NWAVES * 64, LDS_BYTES) != hipSuccess || per_cu < 1) { fprintf(stderr, "kernel_launch: occupancy query says %d blocks per CU\n", per_cu); }
        (void)hipGetLastError();
        grid = cus;
    }
    if (grid < 0) return;
    if (hipMemsetAsync((char*)d_ws + WS_CTL, 0, CTL_ZERO_BYTES, stream) != hipSuccess) return;
    Params p{};
    const float** pp = (const float**)&p;
    for (int i = 0; i < 19; ++i) pp[i] = (const float*)d_in[i];
    p.out = (float*)d_out; p.ws = (unsigned char*)d_ws;
#if MK_PER_PHASE
    for (int ph = 0; ph < N_PHASES; ++ph) { p.ph_lo = ph; p.ph_hi = ph + 1; hipLaunchKernelGGL(fwd_kernel, dim3(grid), dim3(NWAVES * 64), LDS_BYTES, stream, p); }
#else
    p.ph_lo = 0; p.ph_hi = N_PHASES;
    hipLaunchKernelGGL(fwd_kernel, dim3(grid), dim3(NWAVES * 64), LDS_BYTES, stream, p);
#endif
}
```

```cpp
#include <hip/hip_runtime.h>
#include <cstdio>
#include <cstdint>
namespace pg8 {
#define PG8_LAS __attribute__((address_space(3)))
typedef unsigned short bf16_t;
typedef short bf16x8 __attribute__((ext_vector_type(8)));
typedef float f32x4 __attribute__((ext_vector_type(4)));
typedef unsigned u32x4 __attribute__((ext_vector_type(4)));
typedef int i32x4 __attribute__((ext_vector_type(4)));
typedef int i32x8 __attribute__((ext_vector_type(8)));
__device__ __forceinline__ i32x8 cat8(bf16x8 a, bf16x8 b) { return __builtin_shufflevector(__builtin_bit_cast(i32x4, a), __builtin_bit_cast(i32x4, b), 0, 1, 2, 3, 4, 5, 6, 7); }
constexpr int BM = 256, BK = 64, HALF = 128, HTB = HALF * BK * 2  , STAGE_BYTES = 8 * HTB, NXCD = 8, WGM = 8;

__host__ __device__ __forceinline__ int lds_byte(int r, int c) { const int st = (r >> 4) * 2 + (c >> 5), rr = r & 15, cc = c & 31, ob = rr * 64 + cc * 2; return st * 1024 + (ob ^ (((ob >> 9) & 1) << 5)); }
__host__ __device__ __forceinline__ void stage_rc(int b, int& R, int& C) { const int st = b / 1024, sb = b % 1024, swz = sb ^ (((sb >> 9) & 1) << 5); R = (st >> 1) * 16 + swz / 64; C = (st & 1) * 32 + (swz % 64) / 2; }
__host__ __device__ __forceinline__ int perm32(int rho) { const int n = rho >> 4, i = rho & 15; return 8 * (i >> 2) + 4 * n + (i & 3); }

struct Unit { int pm, pn, sel; };
struct Gemm { const bf16_t* A; const bf16_t* Bt; int M, N, K; const bf16_t* A2; const bf16_t* Bt2; const void* rbase; unsigned rbytes; };

struct StaticOrder {
    int nM, nN, nwg, G, c;
    __host__ __device__ __forceinline__ void init(int M, int N, int G_, int c_) { nM = M / BM; nN = N / BM; nwg = nM * nN; G = G_; c = c_; }
    __host__ __device__ __forceinline__ bool next(int i, Unit& u) const {
        const long L = (long)i * G + c; if (L >= nwg) return false;
        int wgid = (int)L; { const int q = nwg / NXCD, r = nwg % NXCD, xcd = wgid % NXCD, off = wgid / NXCD; wgid = (xcd < r ? xcd * (q + 1) : r * (q + 1) + (xcd - r) * q) + off; }
        const int nig = WGM * nN, gid = wgid / nig, fm = gid * WGM, gsz = (nM - fm) < WGM ? (nM - fm) : WGM;
        u.pm = fm + ((wgid % nig) % gsz); u.pn = (wgid % nig) / gsz; u.sel = 0; return true;
    }
    __device__ __forceinline__ void a_ready(const Unit&) const {}
    __device__ __forceinline__ void done(const Unit&) const {}
};

struct StaticOrder2 {
    StaticOrder s0, s1; int G, c;
    __host__ __device__ __forceinline__ void init(int M0, int N0, int M1, int N1, int G_, int c_) { s0.init(M0, N0, 1, 0); s1.init(M1, N1, 1, 0); G = G_; c = c_; }
    __host__ __device__ __forceinline__ bool next(int i, Unit& u) const {
        const long L = (long)i * G + c;
        if (L < s0.nwg) return s0.next((int)L, u);
        if (L < s0.nwg + s1.nwg) { const bool ok = s1.next((int)(L - s0.nwg), u); u.sel = 1; return ok; }
        return false;
    }
    __device__ __forceinline__ void a_ready(const Unit&) const {}
    __device__ __forceinline__ void done(const Unit&) const {}
};

__device__ __forceinline__ unsigned cvt_pk_bf16(float lo, float hi) { unsigned r; asm volatile("v_cvt_pk_bf16_f32 %0, %1, %2" : "=v"(r) : "v"(lo), "v"(hi)); return r; }
typedef float f32x2 __attribute__((ext_vector_type(2)));
__device__ __forceinline__ float c8(float v) { return __builtin_fminf(__builtin_fmaxf(v, -448.f), 448.f); }
__device__ __forceinline__ float sigmoid_f(float v) { return __builtin_amdgcn_rcpf(1.f + __builtin_amdgcn_exp2f(-1.4426950408889634f * v)); }
__device__ __forceinline__ float gelu_tanh_f(float v) { const float z = 1.5957691216057308f * (v + 0.044715f * v * v * v); return v * __builtin_amdgcn_rcpf(1.f + __builtin_amdgcn_exp2f(-1.4426950408889634f * z)); }
__device__ __forceinline__ u32x4 pack8(const f32x4& v0, const f32x4& v1) { u32x4 w; w.x = cvt_pk_bf16(v0[0], v0[1]); w.y = cvt_pk_bf16(v0[2], v0[3]); w.z = cvt_pk_bf16(v1[0], v1[1]); w.w = cvt_pk_bf16(v1[2], v1[3]); return w; }
__device__ __forceinline__ f32x4 bf4_lo(unsigned a, unsigned b) { f32x4 r; r[0] = __builtin_bit_cast(float, a << 16); r[1] = __builtin_bit_cast(float, a & 0xffff0000u); r[2] = __builtin_bit_cast(float, b << 16); r[3] = __builtin_bit_cast(float, b & 0xffff0000u); return r; }

struct EpiProj {
    static constexpr bool PERM = true, AFTER_DRAIN = false, MIDK = false;
    bf16_t *Q, *K, *XR, *GY, *SG, *VT; float* KM; float qscale, oscale;
    __device__ __forceinline__ void operator()(const f32x4 (&acc)[2][2][4][2], const Unit& u, int wr, int wc, int fr, int fq) const {
        { const int l_ = (int)__builtin_amdgcn_mbcnt_hi(~0u, __builtin_amdgcn_mbcnt_lo(~0u, 0u)); fr = l_ & 15; fq = l_ >> 4; }
        const int pn = u.pn; int kind, ldc, colt; bf16_t* base;
        if (u.sel) { kind = 2; base = VT; ldc = 8192; colt = pn * 256; }
        else if (pn < 4) { kind = 0; base = Q; ldc = 1024; colt = pn * 256; }
        else if (pn < 8) { kind = 1; base = K; ldc = 1024; colt = (pn - 4) * 256; }
        else if (pn < 12) { kind = 2; base = XR; ldc = 1024; colt = (pn - 8) * 256; }
        else if (pn < 16) { kind = 3; base = GY; ldc = 1024; colt = (pn - 12) * 256; }
        else { kind = 4; base = SG; ldc = 4096; colt = (pn - 16) * 256; }
        const int row0 = u.pm * BM + wr * 64 + fr, col0 = colt + wc * 32 + 8 * fq;
#pragma unroll
        for (int ai = 0; ai < 2; ++ai)
#pragma unroll
            for (int m = 0; m < 4; ++m) { bf16_t* rowp = base + (size_t)(row0 + ai * HALF + m * 16) * ldc + col0;
#pragma unroll
                for (int bj = 0; bj < 2; ++bj) { f32x4 v0 = acc[ai][bj][m][0] * oscale, v1 = acc[ai][bj][m][1] * oscale;
                    if (kind == 0) { v0 = v0 * qscale; v1 = v1 * qscale; }
                    else if (kind == 3) {
#pragma unroll
                        for (int e = 0; e < 4; ++e) { v0[e] = gelu_tanh_f(v0[e]); v1[e] = gelu_tanh_f(v1[e]); } }
                    else if (kind == 4) {
#pragma unroll
                        for (int e = 0; e < 4; ++e) { v0[e] = sigmoid_f(v0[e]); v1[e] = sigmoid_f(v1[e]); } }
                    *(u32x4*)(rowp + bj * HALF) = pack8(v0, v1); } }
        if (kind == 1 && KM != nullptr) {
            const int b = u.pm >> 3, blk = u.pm & 7;
#pragma unroll
            for (int bj = 0; bj < 2; ++bj)
#pragma unroll
                for (int n = 0; n < 2; ++n) { f32x4 s = (f32x4){0.f, 0.f, 0.f, 0.f};
#pragma unroll
                    for (int ai = 0; ai < 2; ++ai)
#pragma unroll
                        for (int m = 0; m < 4; ++m) s = s + acc[ai][bj][m][n];
#pragma unroll
                    for (int e = 0; e < 4; ++e) { float v = s[e]; v += __shfl_xor(v, 1); v += __shfl_xor(v, 2); v += __shfl_xor(v, 4); v += __shfl_xor(v, 8); s[e] = v; }
                    if (fr == 0) { const int c = colt + bj * HALF + wc * 32 + 8 * fq + 4 * n;
                        float* dst = KM + ((size_t)((b * 8 + (c >> 7)) * 8 + blk)) * 128 + (c & 127);
#pragma unroll
                        for (int e = 0; e < 4; ++e) atomicAdd(dst + e, s[e] * oscale); } }
        }
    }
};
struct EpiStore {
    static constexpr bool PERM = true, AFTER_DRAIN = false, MIDK = false;
    bf16_t* O; int ldc;
    __device__ __forceinline__ void operator()(const f32x4 (&acc)[2][2][4][2], const Unit& u, int wr, int wc, int fr, int fq) const {
        { const int l_ = (int)__builtin_amdgcn_mbcnt_hi(~0u, __builtin_amdgcn_mbcnt_lo(~0u, 0u)); fr = l_ & 15; fq = l_ >> 4; }
        const int row0 = u.pm * BM + wr * 64 + fr, col0 = u.pn * BM + wc * 32 + 8 * fq;
#pragma unroll
        for (int ai = 0; ai < 2; ++ai)
#pragma unroll
            for (int m = 0; m < 4; ++m) { bf16_t* rowp = O + (size_t)(row0 + ai * HALF + m * 16) * ldc + col0;
#pragma unroll
                for (int bj = 0; bj < 2; ++bj) *(u32x4*)(rowp + bj * HALF) = pack8(acc[ai][bj][m][0], acc[ai][bj][m][1]); }
    }
};
struct EpiMerge2 {
    static constexpr bool PERM = true, AFTER_DRAIN = false, MIDK = true;
    const bf16_t* SG; bf16_t* MG; float mgscale;
    __device__ __forceinline__ void midk(f32x4 (&acc)[2][2][4][2], const Unit& u, int wr, int wc, int fr, int fq) const {
        int row0 = u.pm * BM + wr * 64 + fr, col0 = u.pn * BM + wc * 32 + 8 * fq;
        asm volatile("" : "+v"(row0), "+v"(col0));
#pragma unroll
        for (int ai = 0; ai < 2; ++ai)
#pragma unroll
            for (int m = 0; m < 4; ++m) { const size_t row = (size_t)(row0 + ai * HALF + m * 16);
#pragma unroll
                for (int bj = 0; bj < 2; ++bj) { const int col = col0 + bj * HALF;
                    const u32x4 g0 = *(const u32x4*)(SG + row * 4096 + col), g1 = *(const u32x4*)(SG + row * 4096 + 2048 + col);
                    const f32x4 n0 = bf4_lo(g0.x, g0.y), n1 = bf4_lo(g0.z, g0.w), d0 = bf4_lo(g1.x, g1.y), d1 = bf4_lo(g1.z, g1.w);
#pragma unroll
                    for (int e2 = 0; e2 < 4; ++e2) { acc[ai][bj][m][0][e2] *= n0[e2] * __builtin_amdgcn_rcpf(fmaxf(d0[e2], 1e-18f)); acc[ai][bj][m][1][e2] *= n1[e2] * __builtin_amdgcn_rcpf(fmaxf(d1[e2], 1e-18f)); } } }
    }
    __device__ __forceinline__ void operator()(const f32x4 (&acc)[2][2][4][2], const Unit& u, int wr, int wc, int fr, int fq) const {
        { const int l_ = (int)__builtin_amdgcn_mbcnt_hi(~0u, __builtin_amdgcn_mbcnt_lo(~0u, 0u)); fr = l_ & 15; fq = l_ >> 4; }
        const int row0 = u.pm * BM + wr * 64 + fr, col0 = u.pn * BM + wc * 32 + 8 * fq;
#pragma unroll
        for (int ai = 0; ai < 2; ++ai)
#pragma unroll
            for (int m = 0; m < 4; ++m) { const size_t row = (size_t)(row0 + ai * HALF + m * 16);
#pragma unroll
                for (int bj = 0; bj < 2; ++bj) { const int col = col0 + bj * HALF;
                    const u32x4 g1 = *(const u32x4*)(SG + row * 4096 + 2048 + col);
                    const f32x4 v0 = acc[ai][bj][m][0] * bf4_lo(g1.x, g1.y) * mgscale, v1 = acc[ai][bj][m][1] * bf4_lo(g1.z, g1.w) * mgscale;
                    int p0 = __builtin_amdgcn_cvt_pk_fp8_f32(c8(v0[0]), c8(v0[1]), 0, false); p0 = __builtin_amdgcn_cvt_pk_fp8_f32(c8(v0[2]), c8(v0[3]), p0, true);
                    int p1 = __builtin_amdgcn_cvt_pk_fp8_f32(c8(v1[0]), c8(v1[1]), 0, false); p1 = __builtin_amdgcn_cvt_pk_fp8_f32(c8(v1[2]), c8(v1[3]), p1, true);
                    *(unsigned long long*)((unsigned char*)MG + row * 2048 + col) = (unsigned long long)(unsigned)p0 | ((unsigned long long)(unsigned)p1 << 32); } }
    }
};
struct EpiResid {
    static constexpr bool PERM = true, AFTER_DRAIN = false, MIDK = false;
    const float* X; bf16_t* X1B; float* SSP; float oscale;
    __device__ __forceinline__ void operator()(const f32x4 (&acc)[2][2][4][2], const Unit& u, int wr, int wc, int fr, int fq) const {
        { const int l_ = (int)__builtin_amdgcn_mbcnt_hi(~0u, __builtin_amdgcn_mbcnt_lo(~0u, 0u)); fr = l_ & 15; fq = l_ >> 4; }
        const int row0 = u.pm * BM + wr * 64 + fr, col0 = u.pn * BM + wc * 32 + 8 * fq;
#pragma unroll
        for (int ai = 0; ai < 2; ++ai)
#pragma unroll
            for (int m = 0; m < 4; ++m) { const size_t row = (size_t)(row0 + ai * HALF + m * 16); float ss = 0.f;
#pragma unroll
                for (int bj = 0; bj < 2; ++bj) { const int col = col0 + bj * HALF; const float* xp = X + row * 2048 + col;
                    f32x4 v0 = acc[ai][bj][m][0] * oscale + *(const f32x4*)xp, v1 = acc[ai][bj][m][1] * oscale + *(const f32x4*)(xp + 4);
                    *(u32x4*)(X1B + row * 2048 + col) = pack8(v0, v1);
                    ss += (v0[0] * v0[0] + v0[1] * v0[1]) + (v0[2] * v0[2] + v0[3] * v0[3]) + (v1[0] * v1[0] + v1[1] * v1[1]) + (v1[2] * v1[2] + v1[3] * v1[3]); }
                ss += __shfl_xor(ss, 16); ss += __shfl_xor(ss, 32);
                if (fq == 0) SSP[row * 32 + u.pn * 4 + wc] = ss; }
    }
};
struct EpiRowScale {
    static constexpr bool PERM = true, AFTER_DRAIN = false, MIDK = false;
    const float* SSP; bf16_t* O;
    __device__ __forceinline__ void operator()(const f32x4 (&acc)[2][2][4][2], const Unit& u, int wr, int wc, int fr, int fq) const {
        { const int l_ = (int)__builtin_amdgcn_mbcnt_hi(~0u, __builtin_amdgcn_mbcnt_lo(~0u, 0u)); fr = l_ & 15; fq = l_ >> 4; }
        const int row0 = u.pm * BM + wr * 64 + fr, col0 = u.pn * BM + wc * 32 + 8 * fq;
#pragma unroll
        for (int ai = 0; ai < 2; ++ai)
#pragma unroll
            for (int m = 0; m < 4; ++m) { const size_t row = (size_t)(row0 + ai * HALF + m * 16);
                const f32x4 a = *(const f32x4*)(SSP + row * 32 + 8 * fq), b = *(const f32x4*)(SSP + row * 32 + 8 * fq + 4);
                float ss = (a[0] + a[1]) + (a[2] + a[3]) + (b[0] + b[1]) + (b[2] + b[3]);
                ss += __shfl_xor(ss, 16); ss += __shfl_xor(ss, 32);
                const float rs = __builtin_amdgcn_rsqf(ss * (1.f / 2048.f) + 1e-6f);
#pragma unroll
                for (int bj = 0; bj < 2; ++bj) *(u32x4*)(O + row * 2048 + col0 + bj * HALF) = pack8(acc[ai][bj][m][0] * rs, acc[ai][bj][m][1] * rs); }
    }
};
template <class Epi, class Sched, bool ALIGN_EPI = false, bool SP2 = false, bool FP8 = false>
__device__ __forceinline__ void gemm_phase(PG8_LAS unsigned char* lds, const Gemm g, const Sched& S, const Epi& E) {
    const int tid = threadIdx.x, wid = __builtin_amdgcn_readfirstlane(tid >> 6), lane = tid & 63, wr = wid >> 2, wc = wid & 3, fr = lane & 15, fq = lane >> 4;
    const int K = g.K, nt = K / BK;
    const __amdgpu_buffer_rsrc_t rsrc = __builtin_amdgcn_make_buffer_rsrc((void*)g.rbase, 0, (int)g.rbytes, 0x00020000);
    unsigned voffA[2], voffB[2];
#pragma unroll
    for (int i = 0; i < 2; ++i) { int R, C; stage_rc(tid * 16 + i * 8192, R, C); const int Rb = Epi::PERM ? ((R & ~31) + perm32(R & 31)) : R;
        voffA[i] = (unsigned)(R * K + C) * 2u; voffB[i] = (unsigned)(Rb * K + C) * 2u; }
    const size_t kstep = (size_t)(BK * 2);
    const size_t hstep = (size_t)HALF * K * 2;
    const size_t tstep = 2 * hstep;
    const unsigned ldsw = (unsigned)wid * 1024u;
    const int aoff = lds_byte(wr * 64 + fr, fq * 8), boff = lds_byte(wc * 32 + fr, fq * 8);
#define PG8_SA(b, h) (((b) * 2 + (h)) * HTB)
#define PG8_SB(b, h) ((4 + (b) * 2 + (h)) * HTB)
#define PG8_STAGE(bufoff, gbase, voff) do { const unsigned so_ = (unsigned)((const char*)(gbase) - (const char*)g.rbase); _Pragma("unroll") for (int _i = 0; _i < 2; ++_i) \
        __builtin_amdgcn_raw_ptr_buffer_load_lds(rsrc, (PG8_LAS unsigned*)(lds + (bufoff) + ldsw + _i * 8192), 16, (voff)[_i], so_, 0, 0); } while (0)
#define PG8_LDA(dst, b, h) do { _Pragma("unroll") for (int m = 0; m < 4; ++m) { const PG8_LAS unsigned char* p_ = lds + PG8_SA(b, h) + aoff + m * 2048; \
        if constexpr (FP8) dst##8[m] = cat8(*(const PG8_LAS bf16x8*)p_, *(const PG8_LAS bf16x8*)(p_ + 1024)); else { dst[m][0] = *(const PG8_LAS bf16x8*)p_; dst[m][1] = *(const PG8_LAS bf16x8*)(p_ + 1024); } } } while (0)
#define PG8_LDB(dst, b, h) do { _Pragma("unroll") for (int n = 0; n < 2; ++n) { const PG8_LAS unsigned char* p_ = lds + PG8_SB(b, h) + boff + n * 2048; \
        if constexpr (FP8) dst##8[n] = cat8(*(const PG8_LAS bf16x8*)p_, *(const PG8_LAS bf16x8*)(p_ + 1024)); else { dst[n][0] = *(const PG8_LAS bf16x8*)p_; dst[n][1] = *(const PG8_LAS bf16x8*)(p_ + 1024); } } } while (0)
#define PG8_MMA(ai, bj, At, Bt) do { __builtin_amdgcn_s_setprio(1); _Pragma("unroll") for (int m = 0; m < 4; ++m) _Pragma("unroll") for (int n = 0; n < 2; ++n) { \
        if constexpr (FP8) acc[ai][bj][m][n] = __builtin_amdgcn_mfma_scale_f32_16x16x128_f8f6f4(Bt##8[n], At##8[m], acc[ai][bj][m][n], 0, 0, 0, 0x7f7f7f7f, 0, 0x7f7f7f7f); \
        else { _Pragma("unroll") for (int k = 0; k < 2; ++k) acc[ai][bj][m][n] = __builtin_amdgcn_mfma_f32_16x16x32_bf16(Bt[n][k], At[m][k], acc[ai][bj][m][n], 0, 0, 0); } } __builtin_amdgcn_s_setprio(0); } while (0)
#define PG8_WAIT_V(n) asm volatile("s_waitcnt vmcnt(" #n ")" ::: "memory")
#define PG8_WAIT_L(n) asm volatile("s_waitcnt lgkmcnt(" #n ")" ::: "memory")
#define PG8_BAR __builtin_amdgcn_s_barrier()
#define PG8_SCHED __builtin_amdgcn_sched_barrier(0)
    Unit cur, nxt; int ui = 0;
    if (!S.next(0, cur)) return;
    f32x4 acc[2][2][4][2];
#pragma unroll
    for (int a = 0; a < 2; ++a)
#pragma unroll
        for (int b = 0; b < 2; ++b)
#pragma unroll
            for (int m = 0; m < 4; ++m)
#pragma unroll
                for (int n = 0; n < 2; ++n) acc[a][b][m][n] = (f32x4){0.f, 0.f, 0.f, 0.f};
    bf16x8 At[4][2], B0[2][2], B1[2][2];
    i32x8 At8[4], B08[2], B18[2];
    const char* cA = (const char*)(cur.sel ? g.A2 : g.A) + (size_t)cur.pm * tstep; const char* cB = (const char*)(cur.sel ? g.Bt2 : g.Bt) + (size_t)cur.pn * tstep;
    S.a_ready(cur);
    if constexpr (SP2) {
        PG8_STAGE(PG8_SB(0, 0), cB, voffB); PG8_STAGE(PG8_SB(0, 1), cB + hstep, voffB); PG8_STAGE(PG8_SA(0, 0), cA, voffA); PG8_STAGE(PG8_SA(0, 1), cA + hstep, voffA);
        if (wr == 1) PG8_BAR;
        PG8_WAIT_V(2); PG8_BAR;
        PG8_STAGE(PG8_SB(1, 0), cB + kstep, voffB); PG8_STAGE(PG8_SA(1, 0), cA + kstep, voffA); PG8_STAGE(PG8_SB(1, 1), cB + hstep + kstep, voffB);
        PG8_WAIT_V(6); PG8_BAR;
    } else {
        PG8_STAGE(PG8_SB(0, 0), cB, voffB); PG8_STAGE(PG8_SA(0, 0), cA, voffA); PG8_STAGE(PG8_SB(0, 1), cB + hstep, voffB); PG8_STAGE(PG8_SA(0, 1), cA + hstep, voffA);
        if (wr == 1) PG8_BAR;
        PG8_WAIT_V(4); PG8_BAR;
        PG8_STAGE(PG8_SB(1, 0), cB + kstep, voffB); PG8_STAGE(PG8_SA(1, 0), cA + kstep, voffA); PG8_STAGE(PG8_SB(1, 1), cB + hstep + kstep, voffB);
        PG8_WAIT_V(6); PG8_BAR;
    }
    for (;;) {
        const bool has_next = S.next(ui + 1, nxt);
        const char* nA = has_next ? (const char*)(nxt.sel ? g.A2 : g.A) + (size_t)nxt.pm * tstep : cA; const char* nB = has_next ? (const char*)(nxt.sel ? g.Bt2 : g.Bt) + (size_t)nxt.pn * tstep : cB;
        for (int t = 0; t < nt; t += 2) {
            if constexpr (Epi::MIDK) { if (t == nt / 2) E.midk(acc, cur, wr, wc, fr, fq); }
            const bool last = (t == nt - 2);
            const char* a1 = cA + (size_t)(t + 1) * kstep;
            const char* a2 = last ? nA : cA + (size_t)(t + 2) * kstep; const char* b2 = last ? nB : cB + (size_t)(t + 2) * kstep;
            const char* a3 = a2 + kstep; const char* b3 = b2 + kstep;
            if (last && has_next) S.a_ready(nxt);
            if constexpr (SP2) {
            PG8_LDB(B0, 0, 0); PG8_LDB(B1, 0, 1); PG8_SCHED; PG8_LDA(At, 0, 0); PG8_STAGE(PG8_SA(1, 1), a1 + hstep, voffA);
            PG8_WAIT_V(8); PG8_WAIT_L(0); PG8_BAR; PG8_MMA(0, 0, At, B0); PG8_MMA(0, 1, At, B1); PG8_BAR; PG8_SCHED;
            PG8_LDA(At, 0, 1); PG8_STAGE(PG8_SB(0, 0), b2, voffB); PG8_STAGE(PG8_SB(0, 1), b2 + hstep, voffB); PG8_STAGE(PG8_SA(0, 0), a2, voffA);
            PG8_WAIT_V(8); PG8_WAIT_L(0); PG8_BAR; PG8_MMA(1, 0, At, B0); PG8_MMA(1, 1, At, B1); PG8_BAR; PG8_SCHED;
            PG8_LDB(B0, 1, 0); PG8_LDB(B1, 1, 1); PG8_SCHED; PG8_LDA(At, 1, 0); PG8_STAGE(PG8_SA(0, 1), a2 + hstep, voffA);
            PG8_WAIT_V(8); PG8_WAIT_L(0); PG8_BAR; PG8_MMA(0, 0, At, B0); PG8_MMA(0, 1, At, B1); PG8_BAR; PG8_SCHED;
            PG8_LDA(At, 1, 1); PG8_STAGE(PG8_SB(1, 0), b3, voffB); PG8_STAGE(PG8_SB(1, 1), b3 + hstep, voffB); PG8_STAGE(PG8_SA(1, 0), a3, voffA);
            PG8_WAIT_V(8); PG8_WAIT_L(0); PG8_BAR; PG8_MMA(1, 0, At, B0); PG8_MMA(1, 1, At, B1); PG8_BAR; PG8_SCHED;
            } else {
            PG8_LDB(B0, 0, 0); PG8_SCHED; PG8_LDA(At, 0, 0); PG8_STAGE(PG8_SA(1, 1), a1 + hstep, voffA);
            PG8_WAIT_L(8); PG8_BAR; PG8_WAIT_L(0); PG8_MMA(0, 0, At, B0); PG8_BAR; PG8_SCHED;
            PG8_LDB(B1, 0, 1); PG8_STAGE(PG8_SB(0, 0), b2, voffB);
            PG8_BAR; PG8_WAIT_L(0); PG8_MMA(0, 1, At, B1); PG8_BAR;
            PG8_LDA(At, 0, 1); PG8_STAGE(PG8_SA(0, 0), a2, voffA);
            PG8_BAR; PG8_WAIT_L(0); PG8_MMA(1, 0, At, B0); PG8_BAR; PG8_SCHED;
            PG8_STAGE(PG8_SB(0, 1), b2 + hstep, voffB);
            PG8_WAIT_V(6); PG8_BAR; PG8_MMA(1, 1, At, B1); PG8_BAR;
            PG8_LDB(B0, 1, 0); PG8_SCHED; PG8_LDA(At, 1, 0); PG8_STAGE(PG8_SA(0, 1), a2 + hstep, voffA);
            PG8_WAIT_L(8); PG8_BAR; PG8_WAIT_L(0); PG8_MMA(0, 0, At, B0); PG8_BAR; PG8_SCHED;
            PG8_LDB(B1, 1, 1); PG8_STAGE(PG8_SB(1, 0), b3, voffB);
            PG8_BAR; PG8_WAIT_L(0); PG8_MMA(0, 1, At, B1); PG8_BAR;
            PG8_LDA(At, 1, 1); PG8_STAGE(PG8_SA(1, 0), a3, voffA);
            PG8_BAR; PG8_WAIT_L(0); PG8_MMA(1, 0, At, B0); PG8_BAR; PG8_SCHED;
            PG8_STAGE(PG8_SB(1, 1), b3 + hstep, voffB);
            PG8_WAIT_V(6); PG8_BAR; PG8_MMA(1, 1, At, B1); PG8_BAR;
            }
        }
        if constexpr (ALIGN_EPI) { if (wr == 0) PG8_BAR; }
        if constexpr (!Epi::AFTER_DRAIN) { E(acc, cur, wr, wc, fr, fq); S.done(cur); }
        if (!has_next) break;
#pragma unroll
        for (int a = 0; a < 2; ++a)
#pragma unroll
            for (int b = 0; b < 2; ++b)
#pragma unroll
                for (int m = 0; m < 4; ++m)
#pragma unroll
                    for (int n = 0; n < 2; ++n) acc[a][b][m][n] = (f32x4){0.f, 0.f, 0.f, 0.f};
        cur = nxt; cA = nA; cB = nB; ++ui;
        if constexpr (ALIGN_EPI) { if (wr == 1) PG8_BAR; }
    }
    PG8_WAIT_V(0);
    if constexpr (!ALIGN_EPI) { if (wr == 0) PG8_BAR; }
    PG8_BAR;
    if constexpr (Epi::AFTER_DRAIN) { E.fused(acc, cur, wr, wc, fr, fq, lds, wid, lane); S.done(cur); }
#undef PG8_SA
#undef PG8_SB
#undef PG8_STAGE
#undef PG8_LDA
#undef PG8_LDB
#undef PG8_MMA
#undef PG8_WAIT_V
#undef PG8_WAIT_L
#undef PG8_BAR
#undef PG8_SCHED
}
}
#define GAS __attribute__((address_space(1)))
#define LAS __attribute__((address_space(3)))
typedef unsigned short bf16;
typedef unsigned v4u __attribute__((ext_vector_type(4)));
typedef float f32x4 __attribute__((ext_vector_type(4)));
typedef short bf16x8 __attribute__((ext_vector_type(8)));
typedef GAS unsigned gu32;
typedef GAS unsigned long long gu64;
#define RLX_AGENT __ATOMIC_RELAXED, __HIP_MEMORY_SCOPE_AGENT
#define LDS_WAIT() asm volatile("s_waitcnt lgkmcnt(0)" ::: "memory")
#define VM_WAIT() asm volatile("s_waitcnt vmcnt(0)" ::: "memory")
__device__ __forceinline__ unsigned long long rt() { return __builtin_amdgcn_s_memrealtime(); }
__device__ __forceinline__ unsigned f2bf(float f) { unsigned u = __builtin_bit_cast(unsigned, f); return (u + 0x7fffu + ((u >> 16) & 1u)) >> 16; }
__device__ __forceinline__ unsigned pk2(float lo, float hi) { return f2bf(lo) | (f2bf(hi) << 16); }

#define XB_TMO      128
#define XB_XCNT(j)  (256  + 64 * (j))
#define XB_XSUB(j)  (1280 + 64 * (j))
#define XB_XGEN(j)  (2304 + 64 * (j))
#define XB_TOP      3328
#define XB_TOPGEN   3392
#define XCD_BAR_WORDS 3456
#define XB_SPIN_CAP (1u << 18)

__device__ __forceinline__ unsigned xb_ld(unsigned* p)              { return __hip_atomic_load(p, __ATOMIC_RELAXED, __HIP_MEMORY_SCOPE_AGENT); }
__device__ __forceinline__ unsigned xb_add(unsigned* p, unsigned v) { return __hip_atomic_fetch_add(p, v, __ATOMIC_RELAXED, __HIP_MEMORY_SCOPE_AGENT); }
__device__ __forceinline__ unsigned xb_xcc_id() { return (unsigned)__builtin_amdgcn_s_getreg((3 << 11) | 20) & 0xFu; }
#define XB_SPIN(cond, bar) do { unsigned _sp = 0; while (cond) { __builtin_amdgcn_s_sleep(1); \
    if ((++_sp & 255u) == 0u) { if (xb_ld(&(bar)[XB_TMO])) break; if (_sp > XB_SPIN_CAP) { atomicAdd(&(bar)[XB_TMO], 1u); break; } } } } while (0)

struct XcdBarrier {
    unsigned* bar; unsigned x;
    volatile LAS unsigned* st;
};

__device__ __forceinline__ XcdBarrier xcd_barrier_post(unsigned* bar, volatile LAS unsigned* st) {
    XcdBarrier b; b.bar = bar; b.x = xb_xcc_id(); b.st = st;
    if (threadIdx.x == 0) (void)xb_add(&bar[XB_XCNT(b.x)], 1u);
    return b;
}
__device__ __forceinline__ void xcd_barrier_complete(unsigned* bar, unsigned x, unsigned& nloc, unsigned& nx) {
    const unsigned G = gridDim.x * gridDim.y * gridDim.z;
    unsigned sum, cnt, mine, sp = 0u;
    for (;;) {
        sum = 0u; cnt = 0u; mine = 0u;
#pragma unroll
        for (unsigned j = 0; j < 16; ++j) { const unsigned c = xb_ld(&bar[XB_XCNT(j)]); sum += c; cnt += (c > 0u) ? 1u : 0u; mine = (j == x) ? c : mine; }
        if (sum == G) break;
        __builtin_amdgcn_s_sleep(1);
        if ((++sp & 255u) == 0u) { if (xb_ld(&bar[XB_TMO])) break; if (sp > XB_SPIN_CAP) { atomicAdd(&bar[XB_TMO], 1u); break; } }
    }
    nloc = mine > 0u ? mine : 1u; nx = cnt > 0u ? cnt : 1u;
}

__device__ __forceinline__ void xcd_barrier(const XcdBarrier& b) {
    asm volatile("s_waitcnt vmcnt(0)" ::: "memory");
    __syncthreads();
    if (threadIdx.x == 0) {
        unsigned* bar = b.bar;
        __builtin_amdgcn_s_waitcnt(0);
        unsigned nloc = b.st[0], nx = b.st[1];
        if (nloc == 0u) { xcd_barrier_complete(bar, b.x, nloc, nx); b.st[0] = nloc; b.st[1] = nx; }
        const unsigned old = xb_add(&bar[XB_XSUB(b.x)], 1u);
        const unsigned gen = old / nloc;
        if (old + 1u == (gen + 1u) * nloc) {
            __builtin_amdgcn_fence(__ATOMIC_RELEASE, "agent");
            asm volatile("s_waitcnt vmcnt(0)" ::: "memory");
            const unsigned og = xb_add(&bar[XB_TOP], 1u);
            const unsigned tg = og / nx;
            if (og + 1u == (tg + 1u) * nx) xb_add(&bar[XB_TOPGEN], 1u);
            else XB_SPIN(xb_ld(&bar[XB_TOPGEN]) == tg, bar);
            __builtin_amdgcn_fence(__ATOMIC_ACQUIRE, "agent");
            xb_add(&bar[XB_XGEN(b.x)], 1u);
            asm volatile("s_waitcnt vmcnt(0)" ::: "memory");
        } else {
            XB_SPIN(xb_ld(&bar[XB_XGEN(b.x)]) == gen, bar);
            __builtin_amdgcn_fence(__ATOMIC_ACQUIRE, "agent");
            asm volatile("s_waitcnt vmcnt(0)" ::: "memory");
        }
    }
    __syncthreads();
}

constexpr int NWAVES = 8;
constexpr int T_TOK = 8192, DM = 2048, AW = 1024, SEQ = 2048, NHEAD = 8;
constexpr int NWA = 8192;
constexpr int NEXP = 16384;
constexpr float RMS_EPS = 1e-6f, LOG2E = 1.4426950408889634f;
constexpr float W8SCALE = 64.f;
constexpr float OC8SCALE = 8.f, WB8SCALE = 32.f;
constexpr float MG8SCALE = 16.f;
constexpr float QSCALE = 0.08838834764831845f * 1.4426950408889634f;

constexpr size_t MiB = 1u << 20;
constexpr size_t WS_CTL = 0, CTL_ZERO_BYTES = 1 * MiB;
constexpr size_t WS_WA = 2 * MiB;
constexpr size_t WS_WV = 34 * MiB;
constexpr size_t WS_WB = 38 * MiB;
constexpr size_t WS_WO = 46 * MiB;
constexpr size_t WS_WQ = 54 * MiB;
constexpr size_t WS_LWA = 62 * MiB;
constexpr size_t WS_LWX = 62 * MiB + 256 * 1024;
constexpr size_t WS_KEYS = 62 * MiB + 512 * 1024;
constexpr size_t WS_U8 = 64 * MiB;
constexpr size_t WS_V8 = 96 * MiB;
constexpr size_t WS_US = 128 * MiB;
constexpr size_t WS_VS = 128 * MiB + 65536;
constexpr size_t WS_HN = 192 * MiB;
constexpr size_t WS_X1B = WS_HN;
constexpr size_t WS_Q = 224 * MiB;
constexpr size_t WS_K = 240 * MiB;
constexpr size_t WS_VT = 256 * MiB;
constexpr size_t WS_XR = 272 * MiB;
constexpr size_t WS_GY = 288 * MiB;
constexpr size_t WS_SG = 304 * MiB;
constexpr size_t WS_QP = WS_SG;
constexpr size_t WS_OCAT = 368 * MiB;
constexpr size_t WS_HL = 400 * MiB;
constexpr size_t WS_AC = 432 * MiB;
constexpr size_t WS_TMP = WS_HL;
constexpr size_t WS_SUM = 464 * MiB;
constexpr size_t WS_MG = 466 * MiB;
constexpr size_t WS_SSP = 498 * MiB;
constexpr size_t WS_IDX = 500 * MiB;
constexpr size_t WS_G = 504 * MiB;
constexpr size_t WS_PD = WS_Q;
constexpr size_t WS_ACT = WS_VT;
constexpr size_t WS_OUTP = WS_HL;
constexpr size_t WS_END = 508 * MiB;
constexpr int CW_BAR = 4096;
constexpr int CW_XC = 12288;
constexpr int CW_Q2 = 8192;
constexpr int CW_KM = 65536;
static_assert((CW_KM + 32768) * 4 <= (int)CTL_ZERO_BYTES, "CTL");

constexpr int LDS_BYTES = 163840;
constexpr int MISC_OFF = 163840 - 256;
constexpr int SCR_BYTES = MISC_OFF;

typedef float f32x16 __attribute__((ext_vector_type(16)));
typedef float f32x2_t __attribute__((ext_vector_type(2)));
typedef __bf16 bf16x2_t __attribute__((ext_vector_type(2)));
typedef unsigned long long u64;
__device__ __forceinline__ float clamp8(float v) { return fminf(fmaxf(v, -448.f), 448.f); }
__device__ __forceinline__ unsigned cvtpk(float lo, float hi) { f32x2_t v = {lo, hi}; bf16x2_t b = __builtin_convertvector(v, bf16x2_t); return __builtin_bit_cast(unsigned, b); }
__device__ __forceinline__ float bf_lo(unsigned w) { return __builtin_bit_cast(float, w << 16); }
__device__ __forceinline__ float bf_hi(unsigned w) { return __builtin_bit_cast(float, w & 0xffff0000u); }
__device__ __forceinline__ f32x4 bf4_lo2(unsigned a, unsigned b) { f32x4 r; r[0] = bf_lo(a); r[1] = bf_hi(a); r[2] = bf_lo(b); r[3] = bf_hi(b); return r; }
__device__ __forceinline__ float wave_sum(float v) {
#pragma unroll
    for (int o = 1; o < 64; o <<= 1) v += __shfl_xor(v, o);
    return v;
}
__device__ __forceinline__ float dot2bf(unsigned a, unsigned b, float acc) { return __builtin_amdgcn_fdot2_f32_bf16(__builtin_bit_cast(bf16x2_t, a), __builtin_bit_cast(bf16x2_t, b), acc, false); }

struct Params {
    const float *x, *g_mix, *w_in, *conv_w, *conv_b, *lru_wa, *lru_ba, *lru_wx, *lru_bx, *lru_lam, *w_branch, *w_out, *rel_bias, *g_ffn, *peer_wq, *peer_keys, *peer_u, *peer_v, *g_fin;
    float* out; unsigned char* ws; int ph_lo, ph_hi;
};

struct TrD { const float* W; const float* ks; unsigned char* d; int N, k0, n0, ldd; float sc; bool f8; };
__device__ __forceinline__ void tr_load(const TrD& t, int lane, f32x4 (&wv)[8]) {
#pragma unroll
    for (int i = 0; i < 8; ++i) wv[i] = *(const f32x4*)(t.W + (size_t)(t.k0 + (lane >> 3) + 8 * i) * t.N + t.n0 + 4 * (lane & 7));
}
__device__ __forceinline__ void tr_finish(const TrD& t, f32x4 (&wv)[8], LAS float* scr, int lane) {
#pragma unroll
    for (int i = 0; i < 8; ++i) { const int kk = (lane >> 3) + 8 * i; f32x4 v = wv[i]; if (t.ks) v = v * t.ks[t.k0 + kk];
#pragma unroll
        for (int e = 0; e < 4; ++e) scr[kk * 33 + 4 * (lane & 7) + e] = v[e]; }
    LDS_WAIT(); asm volatile("" ::: "memory");
    const int c = lane & 7; const float f8scale = t.sc;
#pragma unroll
    for (int j = 0; j < 4; ++j) { const int n = (lane >> 3) + 8 * j; const LAS float* s = scr + (8 * c) * 33 + n;
        if (t.f8) {
            int p0 = __builtin_amdgcn_cvt_pk_fp8_f32(clamp8(s[0 * 33] * f8scale), clamp8(s[1 * 33] * f8scale), 0, false); p0 = __builtin_amdgcn_cvt_pk_fp8_f32(clamp8(s[2 * 33] * f8scale), clamp8(s[3 * 33] * f8scale), p0, true);
            int p1 = __builtin_amdgcn_cvt_pk_fp8_f32(clamp8(s[4 * 33] * f8scale), clamp8(s[5 * 33] * f8scale), 0, false); p1 = __builtin_amdgcn_cvt_pk_fp8_f32(clamp8(s[6 * 33] * f8scale), clamp8(s[7 * 33] * f8scale), p1, true);
            *(u64*)(t.d + (size_t)n * t.ldd + t.k0 + 8 * c) = (u64)(unsigned)p0 | ((u64)(unsigned)p1 << 32);
        } else {
        v4u o; o.x = cvtpk(s[0 * 33], s[1 * 33]); o.y = cvtpk(s[2 * 33], s[3 * 33]); o.z = cvtpk(s[4 * 33], s[5 * 33]); o.w = cvtpk(s[6 * 33], s[7 * 33]);
        *(v4u*)(t.d + (size_t)n * t.ldd + 2 * (t.k0 + 8 * c)) = o; } }
    LDS_WAIT(); asm volatile("" ::: "memory");
}
template <int MODE> __device__ __forceinline__ void row_to_bf16(const float* src, bf16* dst, const float* colscale, int lane) {
    const f32x4* s = (const f32x4*)src + lane;
    f32x4 v[8]; float ss = 0.f;
#pragma unroll
    for (int j = 0; j < 8; ++j) { v[j] = s[64 * j]; ss += (v[j][0] * v[j][0] + v[j][1] * v[j][1]) + (v[j][2] * v[j][2] + v[j][3] * v[j][3]); }
    float rs = 1.f;
    if (MODE == 1) rs = __builtin_amdgcn_rsqf(wave_sum(ss) * (1.f / 2048.f) + RMS_EPS);
    u64* o8 = (u64*)dst + lane;
#pragma unroll
    for (int j = 0; j < 8; ++j) { f32x4 w = v[j] * rs; if (colscale) w = w * ((const f32x4*)colscale)[64 * j + lane];
        o8[64 * j] = (u64)cvtpk(w[0], w[1]) | ((u64)cvtpk(w[2], w[3]) << 32); }
}
template <bool I8> __device__ __forceinline__ void row_finish8(f32x4 (&v)[8], unsigned char* dst, float* scale_out, int lane) {
    float am = 0.f;
#pragma unroll
    for (int j = 0; j < 8; ++j) am = fmaxf(am, fmaxf(fmaxf(fabsf(v[j][0]), fabsf(v[j][1])), fmaxf(fabsf(v[j][2]), fabsf(v[j][3]))));
#pragma unroll
    for (int o = 1; o < 64; o <<= 1) am = fmaxf(am, __shfl_xor(am, o));
    const float qmax = I8 ? 127.f : 448.f;
    const float sc = am > 0.f ? am / qmax : 1.f, inv = 1.f / sc;
    unsigned* o4 = (unsigned*)(dst + (size_t)(lane >> 5) * NEXP * 128) + (lane & 31);
#pragma unroll
    for (int j = 0; j < 8; ++j) { unsigned w;
        if (I8) { const int q0 = (int)rintf(v[j][0] * inv), q1 = (int)rintf(v[j][1] * inv), q2 = (int)rintf(v[j][2] * inv), q3 = (int)rintf(v[j][3] * inv);
            w = (unsigned)(q0 & 255) | ((unsigned)(q1 & 255) << 8) | ((unsigned)(q2 & 255) << 16) | ((unsigned)q3 << 24); }
        else { int p = __builtin_amdgcn_cvt_pk_fp8_f32(v[j][0] * inv, v[j][1] * inv, 0, false); p = __builtin_amdgcn_cvt_pk_fp8_f32(v[j][2] * inv, v[j][3] * inv, p, true); w = (unsigned)p; }
        o4[(size_t)(2 * j) * NEXP * 32] = w; }
    if (lane == 0) *scale_out = sc;
}
template <bool I8, int NR = 2> __device__ __forceinline__ void table_rows8(const float* src, unsigned char* dst, float* scales, const float* colscale, int r0, int r1, int wv, int nwv, int lane) {
    f32x4 cs[8];
#pragma unroll
    for (int j = 0; j < 8; ++j) cs[j] = colscale ? ((const f32x4*)colscale)[64 * j + lane] : (f32x4){1.f, 1.f, 1.f, 1.f};
    for (int m = r0 + wv; m < r1; m += NR * nwv) {
        f32x4 v[NR][8];
#pragma unroll
        for (int q = 0; q < NR; ++q) { const int mq = m + q * nwv; if (mq < r1) {
#pragma unroll
            for (int j = 0; j < 8; ++j) v[q][j] = ((const f32x4*)(src + (size_t)mq * DM))[64 * j + lane]; } }
#pragma unroll
        for (int q = 0; q < NR; ++q) { const int mq = m + q * nwv; if (mq < r1) {
            if (colscale) {
#pragma unroll
                for (int j = 0; j < 8; ++j) v[q][j] = v[q][j] * cs[j]; }
            row_finish8<I8>(v[q], dst + (size_t)mq * 128, scales + mq, lane); } }
    }
}
template <int NR> __device__ __forceinline__ void peer_table_u(const Params& P, int r0, int r1, int wv, int nwv, int lane) { table_rows8<true, NR>(P.peer_u, P.ws + WS_U8, (float*)(P.ws + WS_US), P.g_ffn, r0, r1, wv, nwv, lane); }
template <int NR> __device__ __forceinline__ void peer_table_v(const Params& P, int r0, int r1, int wv, int nwv, int lane) { table_rows8<false, NR>(P.peer_v, P.ws + WS_V8, (float*)(P.ws + WS_VS), nullptr, r0, r1, wv, nwv, lane); }
__device__ __forceinline__ TrD tr_decode(const Params& P, int r) {
    unsigned char* ws = P.ws;
    constexpr int I_IN = 32 * 288, I_BR = 16 * 64, I_SQ = 32 * 64;
    TrD t; t.ks = nullptr; t.f8 = true; t.ldd = 2048; t.sc = W8SCALE;
    if (r < I_IN) { const int kb = r / 288, nb = r % 288, n0 = 32 * nb;
        t.W = P.w_in; t.N = 9216; t.k0 = 64 * kb; t.n0 = n0;
        t.d = (n0 < 2048) ? ws + WS_WA + (size_t)n0 * 2048 : (n0 < 3072 ? ws + WS_WV + (size_t)(n0 - 2048) * 2048 : ws + WS_WA + (size_t)(n0 - 1024) * 2048); return t; } r -= I_IN;
    if (r < 2 * I_BR) { const int br = r / I_BR, q = r % I_BR, kb = q / 64, nb = q % 64;
        t.W = P.w_branch + (size_t)br * 1024 * 2048; t.N = 2048; t.k0 = 64 * kb; t.n0 = 32 * nb; t.sc = WB8SCALE; t.d = ws + WS_WB + (size_t)(32 * nb) * 2048 + br * 1024; return t; } r -= 2 * I_BR;
    if (r < I_SQ) { const int kb = r / 64, nb = r % 64; t.W = P.w_out; t.N = 2048; t.k0 = 64 * kb; t.n0 = 32 * nb; t.d = ws + WS_WO + (size_t)(32 * nb) * 2048; return t; } r -= I_SQ;
    t.f8 = false; t.sc = 1.f;
    if (r < I_SQ) { const int kb = r / 64, nb = r % 64; t.W = P.peer_wq; t.N = 2048; t.k0 = 64 * kb; t.n0 = 32 * nb; t.ks = P.g_ffn; t.ldd = 4096; t.d = ws + WS_WQ + (size_t)(32 * nb) * 4096; return t; } r -= I_SQ;
    { const int which = r / 64, q = r % 64, g = q / 8, kb = (q % 8) / 4, nb = q % 4;
      t.W = (which ? P.lru_wx : P.lru_wa) + (size_t)g * 16384; t.N = 128; t.k0 = 64 * kb; t.n0 = 32 * nb; t.ldd = 256; t.d = ws + (which ? WS_LWX : WS_LWA) + ((size_t)g * 16384 + (size_t)(32 * nb) * 128) * 2; return t; }
}
__device__ __forceinline__ void p0_prologue(const Params& P, LAS unsigned char* lds, int gw, int NGW, int wave, int lane, int r1) {
    LAS float* scr = (LAS float*)(lds + wave * 16384);
    unsigned char* ws = P.ws;
    constexpr int NITEMS = 32 * 288 + 2 * 16 * 64 + 2 * 32 * 64 + 2 * 8 * 8;
    if (gw < NITEMS) {
        int ita = gw; TrD a = tr_decode(P, ita), b = a; f32x4 wa[8], wb[8]; tr_load(a, lane, wa);
        for (;;) {
            const int itb = ita + NGW; const bool hasb = itb < NITEMS; if (hasb) { b = tr_decode(P, itb); tr_load(b, lane, wb); }
            tr_finish(a, wa, scr, lane);
            if (!hasb) break;
            ita = itb + NGW; const bool hasa = ita < NITEMS; if (hasa) { a = tr_decode(P, ita); tr_load(a, lane, wa); }
            tr_finish(b, wb, scr, lane);
            if (!hasa) break;
        }
    }
    { bf16* KB = (bf16*)(ws + WS_KEYS);
      for (int i = gw * 64 + lane; i < 262144 / 8; i += NGW * 64) { const f32x4 a = ((const f32x4*)P.peer_keys)[2 * i], b = ((const f32x4*)P.peer_keys)[2 * i + 1];
          v4u o; o.x = cvtpk(a[0], a[1]); o.y = cvtpk(a[2], a[3]); o.z = cvtpk(b[0], b[1]); o.w = cvtpk(b[2], b[3]); ((v4u*)KB)[i] = o; } }
    { unsigned char* HN = ws + WS_HN;
      for (int m = gw; m < T_TOK; m += 4 * NGW) {
          f32x4 v[4][8];
#pragma unroll
          for (int q = 0; q < 4; ++q) { const int mq = m + q * NGW; if (mq < T_TOK) {
#pragma unroll
              for (int j = 0; j < 8; ++j) v[q][j] = ((const f32x4*)(P.x + (size_t)mq * DM))[64 * j + lane]; } }
#pragma unroll
          for (int q = 0; q < 4; ++q) { const int mq = m + q * NGW; if (mq < T_TOK) {
              float sa = 0.f;
#pragma unroll
              for (int j = 0; j < 8; ++j) sa += (v[q][j][0] * v[q][j][0] + v[q][j][1] * v[q][j][1]) + (v[q][j][2] * v[q][j][2] + v[q][j][3] * v[q][j][3]);
              const float ra = __builtin_amdgcn_rsqf(wave_sum(sa) * (1.f / 2048.f) + RMS_EPS);
              unsigned* oa = (unsigned*)(HN + (size_t)mq * DM) + lane;
#pragma unroll
              for (int j = 0; j < 8; ++j) { const f32x4 w = v[q][j] * ra * ((const f32x4*)P.g_mix)[64 * j + lane]; int p = __builtin_amdgcn_cvt_pk_fp8_f32(w[0], w[1], 0, false); p = __builtin_amdgcn_cvt_pk_fp8_f32(w[2], w[3], p, true); oa[64 * j] = (unsigned)p; } } } } }
    if (r1 > 0) { peer_table_u<2>(P, 0, r1, gw, NGW, lane); peer_table_v<2>(P, 0, r1, gw, NGW, lane); }
}

constexpr int AT_KT = 0, AT_VT = 2 * 17408, AT_KM = AT_VT + 2 * 18432, AT_B2 = AT_KM + 4096, AT_SEL = AT_B2 + 512, AT_ANY = AT_SEL + 1024;
#define MFMA32(a, b, c) __builtin_amdgcn_mfma_f32_32x32x16_bf16((a), (b), (c), 0, 0, 0)
__device__ __forceinline__ void attn_unit(const Params& P, LAS unsigned char* lds, int b, int h, int blk, int tid, int wave, int lane) {
    unsigned char* ws = P.ws;
    const bf16* Qb = (const bf16*)(ws + WS_Q); const bf16* Kb = (const bf16*)(ws + WS_K); const bf16* VTg = (const bf16*)(ws + WS_VT); bf16* OATT = (bf16*)(ws + WS_OCAT);
    const float* KMg = (const float*)(ws + WS_CTL) + CW_KM;
    LAS float* KMs = (LAS float*)(lds + AT_KM); LAS float* B2 = (LAS float*)(lds + AT_B2); LAS unsigned* SELM = (LAS unsigned*)(lds + AT_SEL); LAS unsigned* UANY = (LAS unsigned*)(lds + AT_ANY);
    const int row_blk0 = b * SEQ + blk * 256;
    __syncthreads();
    for (int i = tid; i < 1024; i += 512) KMs[i] = KMg[(size_t)(b * 8 + h) * 1024 + i] * (1.f / 256.f);
    if (tid < 128) { const int d = tid; int bucket = d;
        if (d >= 16) { bucket = 16 + (int)(__logf((float)d * (1.f / 16.f)) * (16.f / 2.0794415416798357f)); bucket = bucket > 31 ? 31 : bucket; }
        B2[d] = (P.rel_bias[bucket * 8 + h] - P.rel_bias[31 * 8 + h]) * LOG2E; }
    if (tid == 0) *UANY = 0u;
    __syncthreads();
    {
        const int qq = tid >> 1, q2 = tid & 1;
        unsigned mask = (1u << blk) - 1u;
        if (blk > 3) {
            const bf16* qrow = Qb + (size_t)(row_blk0 + qq) * AW + h * 128;
            v4u qv[8];
#pragma unroll
            for (int c8 = 0; c8 < 8; ++c8) qv[c8] = *(const v4u*)(qrow + 8 * (q2 + 2 * c8));
            float g0 = 0.f, g1 = 0.f, g2 = 0.f, g3 = 0.f, g4 = 0.f, g5 = 0.f, g6 = 0.f;
#pragma unroll
            for (int c8 = 0; c8 < 8; ++c8) { const float q[8] = {bf_lo(qv[c8].x), bf_hi(qv[c8].x), bf_lo(qv[c8].y), bf_hi(qv[c8].y), bf_lo(qv[c8].z), bf_hi(qv[c8].z), bf_lo(qv[c8].w), bf_hi(qv[c8].w)};
#pragma unroll
                for (int e = 0; e < 8; ++e) { const LAS float* km = KMs + 8 * (q2 + 2 * c8) + e;
                    g0 += q[e] * km[0]; g1 += q[e] * km[128]; g2 += q[e] * km[256]; g3 += q[e] * km[384]; g4 += q[e] * km[512]; g5 += q[e] * km[640]; g6 += q[e] * km[768]; } }
            g0 += __shfl_xor(g0, 1); g1 += __shfl_xor(g1, 1); g2 += __shfl_xor(g2, 1); g3 += __shfl_xor(g3, 1); g4 += __shfl_xor(g4, 1); g5 += __shfl_xor(g5, 1); g6 += __shfl_xor(g6, 1);
            const float NEGG = -3.0e38f;
            if (blk < 7) g6 = NEGG; if (blk < 6) g5 = NEGG; if (blk < 5) g4 = NEGG;
            mask = 0u;
#pragma unroll
            for (int s = 0; s < 3; ++s) { float best = g0; int bj = 0;
                if (g1 > best) { best = g1; bj = 1; } if (g2 > best) { best = g2; bj = 2; } if (g3 > best) { best = g3; bj = 3; }
                if (g4 > best) { best = g4; bj = 4; } if (g5 > best) { best = g5; bj = 5; } if (g6 > best) { best = g6; bj = 6; }
                mask |= 1u << bj;
                g0 = bj == 0 ? NEGG : g0; g1 = bj == 1 ? NEGG : g1; g2 = bj == 2 ? NEGG : g2; g3 = bj == 3 ? NEGG : g3; g4 = bj == 4 ? NEGG : g4; g5 = bj == 5 ? NEGG : g5; g6 = bj == 6 ? NEGG : g6; }
        }
        if (q2 == 0) { SELM[qq] = mask; __hip_atomic_fetch_or(UANY, mask, __ATOMIC_RELAXED, __HIP_MEMORY_SCOPE_WORKGROUP); }
    }
    __syncthreads();
    const unsigned uany = *UANY;
    unsigned blist = (unsigned)blk; int nb = 1;
    for (int j = blk - 1; j >= 0; --j) if ((uany >> j) & 1u) { blist |= (unsigned)j << (4 * nb); ++nb; }
    const int nsteps = 4 * nb;
    const int qi = 32 * wave + (lane & 31), hh = lane >> 5;
    const unsigned mymask = SELM[qi];
    bf16x8 Qf[8];
    { const bf16* qp = Qb + (size_t)(row_blk0 + qi) * AW + h * 128 + 8 * hh;
#pragma unroll
      for (int ks = 0; ks < 8; ++ks) Qf[ks] = *(const bf16x8*)(qp + 16 * ks); }
    float m_run = -1.0e30f, lsum = 0.f;
    f32x16 O[4];
#pragma unroll
    for (int dt = 0; dt < 4; ++dt)
#pragma unroll
        for (int r = 0; r < 16; ++r) O[dt][r] = 0.f;
    const int kkey0 = tid >> 4, kpart = tid & 15;
    const int vd0 = tid >> 3, vcc = tid & 7;
    const unsigned kl0 = kkey0 * 272 + kpart * 16, kl1 = kl0 + 32 * 272;
    const unsigned vl0 = vd0 * 144 + ((((vcc >> 2) * 2 + ((vcc & 3) >> 1)) * 2) * 16) + (vcc & 1) * 8, vl1 = vl0 + 64 * 144;
    v4u ka0, ka1, va0, va1, kb0, kb1, vb0, vb1;
#define AT_LOAD(s, k0, k1, v0, v1) do { const int j_ = (blist >> (4 * ((s) >> 2))) & 15, kt_ = (s) & 3; const size_t krow0 = (size_t)b * SEQ + j_ * 256 + kt_ * 64; \
        k0 = *(const v4u*)(Kb + (krow0 + kkey0) * AW + h * 128 + kpart * 8); k1 = *(const v4u*)(Kb + (krow0 + kkey0 + 32) * AW + h * 128 + kpart * 8); \
        v0 = *(const v4u*)(VTg + (size_t)(h * 128 + vd0) * T_TOK + krow0 + vcc * 8); v1 = *(const v4u*)(VTg + (size_t)(h * 128 + vd0 + 64) * T_TOK + krow0 + vcc * 8); } while (0)
#define AT_STORE(bufi, k0, k1, v0, v1) do { LAS unsigned char* KT_ = lds + AT_KT + (bufi) * 17408; LAS unsigned char* VT_ = lds + AT_VT + (bufi) * 18432; \
        *(LAS v4u*)(KT_ + kl0) = k0; *(LAS v4u*)(KT_ + kl1) = k1; \
        *(LAS u64*)(VT_ + vl0) = (u64)v0.x | ((u64)v0.y << 32); *(LAS u64*)(VT_ + vl0 + 16) = (u64)v0.z | ((u64)v0.w << 32); \
        *(LAS u64*)(VT_ + vl1) = (u64)v1.x | ((u64)v1.y << 32); *(LAS u64*)(VT_ + vl1 + 16) = (u64)v1.z | ((u64)v1.w << 32); } while (0)
    AT_LOAD(0, ka0, ka1, va0, va1); AT_STORE(0, ka0, ka1, va0, va1);
    if (1 < nsteps) AT_LOAD(1, ka0, ka1, va0, va1);
    if (2 < nsteps) AT_LOAD(2, kb0, kb1, vb0, vb1);
    for (int s = 0; s < nsteps; ++s) {
        const int j = (blist >> (4 * (s >> 2))) & 15, kt = s & 3;
        __syncthreads();
        if ((s & 1) == 0) { if (s + 1 < nsteps) AT_STORE((s + 1) & 1, ka0, ka1, va0, va1); if (s + 3 < nsteps) AT_LOAD(s + 3, ka0, ka1, va0, va1); }
        else              { if (s + 1 < nsteps) AT_STORE((s + 1) & 1, kb0, kb1, vb0, vb1); if (s + 3 < nsteps) AT_LOAD(s + 3, kb0, kb1, vb0, vb1); }
        const LAS unsigned char* KT = lds + AT_KT + (s & 1) * 17408; const LAS unsigned char* VTl = lds + AT_VT + (s & 1) * 18432;
        bool part;
        if (j == blk) part = (64 * kt <= 32 * wave + 31);
        else part = (__ballot((mymask >> j) & 1u) != 0ull);
        if (part) {
            f32x16 S0, S1;
#pragma unroll
            for (int r = 0; r < 16; ++r) { S0[r] = 0.f; S1[r] = 0.f; }
            const LAS unsigned char* kp = KT + (lane & 31) * 272 + hh * 16;
#pragma unroll
            for (int ks = 0; ks < 8; ++ks) { const bf16x8 a0 = *(const LAS bf16x8*)(kp + ks * 32), a1 = *(const LAS bf16x8*)(kp + 32 * 272 + ks * 32);
                S0 = MFMA32(a0, Qf[ks], S0); S1 = MFMA32(a1, Qf[ks], S1); }
            const bool sel = ((mymask >> j) & 1u) != 0u;
            float mx = -1.0e30f; bool ok_row = true;
            const int dmin = 32 * wave + 256 * (blk - j) - 64 * kt - 63;
            if (dmin < 113) {
                const int dbase = (j == blk) ? (qi - 64 * kt - 4 * hh) : (qi + 256 - 64 * kt - 4 * hh);
                const bool okrow = (j == blk) ? true : sel;
#pragma unroll
                for (int r = 0; r < 16; ++r) { const int kk = (r & 3) + 8 * (r >> 2);
                    { const int dist = dbase - kk; const int di = dist < 0 ? 0 : (dist > 127 ? 127 : dist); const float v = (okrow && dist >= 0) ? S0[r] + B2[di] : -1.0e30f; S0[r] = v; mx = fmaxf(mx, v); }
                    { const int dist = dbase - 32 - kk; const int di = dist < 0 ? 0 : (dist > 127 ? 127 : dist); const float v = (okrow && dist >= 0) ? S1[r] + B2[di] : -1.0e30f; S1[r] = v; mx = fmaxf(mx, v); } }
            } else {
                ok_row = sel || (j == blk);
#pragma unroll
                for (int r = 0; r < 16; ++r) mx = fmaxf(mx, fmaxf(S0[r], S1[r]));
                mx = ok_row ? mx : -1.0e30f;
            }
            mx = fmaxf(mx, __shfl_xor(mx, 32));
            const bool need = mx > m_run + 8.f;
            if (__any(need)) { const float m_new = need ? mx : m_run, alpha = __builtin_amdgcn_exp2f(m_run - m_new);
                m_run = m_new; lsum *= alpha;
#pragma unroll
                for (int dt = 0; dt < 4; ++dt)
#pragma unroll
                    for (int r = 0; r < 16; ++r) O[dt][r] *= alpha; }
            float ps = 0.f;
            const float m_eff = ok_row ? m_run : 1.0e30f;
#pragma unroll
            for (int r = 0; r < 16; ++r) { S0[r] = __builtin_amdgcn_exp2f(S0[r] - m_eff); S1[r] = __builtin_amdgcn_exp2f(S1[r] - m_eff); ps += S0[r] + S1[r]; }
            lsum += ps;
            bf16x8 Pf[2][2];
#pragma unroll
            for (int s2 = 0; s2 < 2; ++s2) {
                v4u p0, p1;
                p0.x = cvtpk(S0[8 * s2], S0[8 * s2 + 1]); p0.y = cvtpk(S0[8 * s2 + 2], S0[8 * s2 + 3]); p0.z = cvtpk(S0[8 * s2 + 4], S0[8 * s2 + 5]); p0.w = cvtpk(S0[8 * s2 + 6], S0[8 * s2 + 7]);
                p1.x = cvtpk(S1[8 * s2], S1[8 * s2 + 1]); p1.y = cvtpk(S1[8 * s2 + 2], S1[8 * s2 + 3]); p1.z = cvtpk(S1[8 * s2 + 4], S1[8 * s2 + 5]); p1.w = cvtpk(S1[8 * s2 + 6], S1[8 * s2 + 7]);
                Pf[0][s2] = __builtin_bit_cast(bf16x8, p0); Pf[1][s2] = __builtin_bit_cast(bf16x8, p1); }
            const LAS unsigned char* vp = VTl + (lane & 31) * 144 + hh * 16;
#pragma unroll
            for (int dt = 0; dt < 4; ++dt)
#pragma unroll
                for (int mt = 0; mt < 2; ++mt)
#pragma unroll
                    for (int s2 = 0; s2 < 2; ++s2) { const bf16x8 a = *(const LAS bf16x8*)(vp + dt * 32 * 144 + (mt * 2 + s2) * 32); O[dt] = MFMA32(a, Pf[mt][s2], O[dt]); }
        }
    }
#undef AT_LOAD
#undef AT_STORE
    const float ltot = lsum + __shfl_xor(lsum, 32), inv = 1.f / ltot;
    unsigned char* orow = (unsigned char*)OATT + (size_t)(row_blk0 + qi) * DM + h * 128 + 4 * hh;
    const float osc = inv * OC8SCALE;
#pragma unroll
    for (int dt = 0; dt < 4; ++dt)
#pragma unroll
        for (int g4 = 0; g4 < 4; ++g4) { int p = __builtin_amdgcn_cvt_pk_fp8_f32(clamp8(O[dt][4 * g4] * osc), clamp8(O[dt][4 * g4 + 1] * osc), 0, false); p = __builtin_amdgcn_cvt_pk_fp8_f32(clamp8(O[dt][4 * g4 + 2] * osc), clamp8(O[dt][4 * g4 + 3] * osc), p, true);
            *(unsigned*)(orow + 32 * dt + 8 * g4) = (unsigned)p; }
}
constexpr int LR_XC = 0, LR_SEG = 2 * 17408, LR_W = LR_SEG + 2 * 4096;
#define MFMA16(a, b, c) __builtin_amdgcn_mfma_f32_16x16x32_bf16((a), (b), (c), 0, 0, 0)
__device__ __forceinline__ void lru_pair(const Params& P, LAS unsigned char* lds, int pair, int tid, int wave, int lane, unsigned* tkword, int& tk_next) {
    unsigned char* ws = P.ws;
    const int grp = wave >> 2, wq = wave & 3, tg = tid & 255;
    const int unit = 2 * pair + grp, b = unit >> 8, g = (unit >> 5) & 7, c = unit & 31;
    const bf16* XR = (const bf16*)(ws + WS_XR); const bf16* LWA = (const bf16*)(ws + WS_LWA) + (size_t)g * 16384; const bf16* LWX = (const bf16*)(ws + WS_LWX) + (size_t)g * 16384;
    float* HL = (float*)(ws + WS_HL); float* AC = (float*)(ws + WS_AC); float* SUM = (float*)(ws + WS_SUM);
    LAS unsigned short* XC = (LAS unsigned short*)(lds + LR_XC + grp * 17408);
    LAS float* SEG = (LAS float*)(lds + LR_SEG + grp * 4096);
    LAS unsigned char* WL = lds + LR_W;
    const int t0 = c * 64; const size_t R0 = (size_t)b * SEQ + t0;
    __syncthreads();
    {
      v4u wv[8];
#pragma unroll
      for (int i = 0; i < 8; ++i) { const int q = tid + 512 * i, mat = q >> 11, row = (q >> 4) & 127, part = q & 15; wv[i] = *(const v4u*)((mat ? LWX : LWA) + row * 128 + part * 8); }
      const int cpart = tg & 15, C8 = g * 128 + 8 * cpart;
      f32x4 cw[4][2], cbv[2];
#pragma unroll
      for (int w = 0; w < 4; ++w) { cw[w][0] = *(const f32x4*)(P.conv_w + w * 1024 + C8); cw[w][1] = *(const f32x4*)(P.conv_w + w * 1024 + C8 + 4); }
      cbv[0] = *(const f32x4*)(P.conv_b + C8); cbv[1] = *(const f32x4*)(P.conv_b + C8 + 4);
#define LR_CONV_LOAD(xr, base) do { _Pragma("unroll") for (int i2 = 0; i2 < 2; ++i2) { const int tl = (tg >> 4) + 16 * ((base) + i2); \
          _Pragma("unroll") for (int w = 0; w < 4; ++w) { const int ts = t0 + tl - 3 + w; xr[i2][w] = (ts >= 0) ? *(const v4u*)(XR + ((size_t)b * SEQ + ts) * AW + C8) : (v4u){0u, 0u, 0u, 0u}; } } } while (0)
#define LR_CONV_DO(xr, base) do { _Pragma("unroll") for (int i2 = 0; i2 < 2; ++i2) { const int tl = (tg >> 4) + 16 * ((base) + i2); f32x4 y0 = cbv[0], y1 = cbv[1]; \
          _Pragma("unroll") for (int w = 0; w < 4; ++w) { y0 = y0 + bf4_lo2(xr[i2][w].x, xr[i2][w].y) * cw[w][0]; y1 = y1 + bf4_lo2(xr[i2][w].z, xr[i2][w].w) * cw[w][1]; } \
          v4u o; o.x = cvtpk(y0[0], y0[1]); o.y = cvtpk(y0[2], y0[3]); o.z = cvtpk(y1[0], y1[1]); o.w = cvtpk(y1[2], y1[3]); \
          *(LAS v4u*)((LAS unsigned char*)XC + tl * 272 + cpart * 16) = o; } } while (0)
      { v4u xr[2][4]; LR_CONV_LOAD(xr, 0);
#pragma unroll
        for (int i = 0; i < 8; ++i) { const int q = tid + 512 * i, mat = q >> 11, row = (q >> 4) & 127, part = q & 15; *(LAS v4u*)(WL + (mat * 128 + row) * 272 + part * 16) = wv[i]; }
        LR_CONV_DO(xr, 0); }
      { v4u xr[2][4]; LR_CONV_LOAD(xr, 2); LR_CONV_DO(xr, 2); }
#undef LR_CONV_LOAD
#undef LR_CONV_DO
    }
    __syncthreads();
    if (tid == 0) tk_next = (int)__hip_atomic_fetch_add(tkword, 1u, __ATOMIC_RELAXED, __HIP_MEMORY_SCOPE_AGENT);
    const int fr = lane & 15, fq = lane >> 4;
    float Ar[2][4][4], Hr[2][4][4], AE[2][4], HE[2][4];
#pragma unroll
    for (int nh = 0; nh < 2; ++nh) {
        f32x4 aA[4], aX[4];
#pragma unroll
        for (int nt = 0; nt < 4; ++nt) { aA[nt] = (f32x4){0.f, 0.f, 0.f, 0.f}; aX[nt] = (f32x4){0.f, 0.f, 0.f, 0.f}; }
#pragma unroll 1
        for (int ks = 0; ks < 4; ++ks) { const bf16x8 a = *(const LAS bf16x8*)((LAS unsigned char*)XC + (16 * wq + fr) * 272 + (32 * ks + 8 * fq) * 2);
#pragma unroll
            for (int nt = 0; nt < 4; ++nt) { const int wo = (64 * nh + 16 * nt + fr) * 272 + (32 * ks + 8 * fq) * 2;
                const bf16x8 ba = *(const LAS bf16x8*)(WL + wo), bx = *(const LAS bf16x8*)(WL + 128 * 272 + wo);
                aA[nt] = MFMA16(a, ba, aA[nt]); aX[nt] = MFMA16(a, bx, aX[nt]); } }
#pragma unroll
        for (int nt = 0; nt < 4; ++nt) { const int ch = 64 * nh + 16 * nt + fr, C = g * 128 + ch;
            const float ba = P.lru_ba[C], bx = P.lru_bx[C], lam = P.lru_lam[C];
            const float sp8 = 8.f * log1pf(__expf(-lam));
            float Ac = 1.f, Hc = 0.f;
#pragma unroll
            for (int r = 0; r < 4; ++r) { const int tok = 16 * wq + 4 * fq + r;
                const float rg = pg8::sigmoid_f(aA[nt][r] + ba), ig = pg8::sigmoid_f(aX[nt][r] + bx);
                const float log_a = -rg * sp8, a = __builtin_amdgcn_exp2f(log_a * 1.4426950408889634f);
                const float y = 2.f * log_a;
                const float em = (y > -0.25f) ? -y * (1.f + y * (0.5f + y * (0.16666667f + y * (0.041666668f + y * (0.0083333338f + y * 0.0013888889f))))) : 1.f - a * a;
                const float u = __builtin_amdgcn_sqrtf(em) * (ig * bf_lo((unsigned)XC[tok * 136 + ch]));
                Hc = a * Hc + u; Ac *= a; Ar[nh][nt][r] = Ac; Hr[nh][nt][r] = Hc; }
            float AI = Ac, HI = Hc;
            { const float Ap = __shfl_up(AI, 16), Hp = __shfl_up(HI, 16); if (fq >= 1) { HI = AI * Hp + HI; AI = AI * Ap; } }
            { const float Ap = __shfl_up(AI, 32), Hp = __shfl_up(HI, 32); if (fq >= 2) { HI = AI * Hp + HI; AI = AI * Ap; } }
            { const float Ap = __shfl_up(AI, 16), Hp = __shfl_up(HI, 16); AE[nh][nt] = fq >= 1 ? Ap : 1.f; HE[nh][nt] = fq >= 1 ? Hp : 0.f; }
            if (fq == 3) { SEG[(wq * 128 + ch) * 2] = AI; SEG[(wq * 128 + ch) * 2 + 1] = HI; } }
    }
    __syncthreads();
#pragma unroll
    for (int nh = 0; nh < 2; ++nh)
#pragma unroll
        for (int nt = 0; nt < 4; ++nt) { const int ch = 64 * nh + 16 * nt + fr, C = g * 128 + ch;
            float Aw = 1.f, Hw = 0.f;
#pragma unroll
            for (int w2 = 0; w2 < 3; ++w2) if (w2 < wq) { const float As = SEG[(w2 * 128 + ch) * 2], Hs = SEG[(w2 * 128 + ch) * 2 + 1]; Hw = As * Hw + Hs; Aw *= As; }
            const float hin = AE[nh][nt] * Hw + HE[nh][nt], ain = AE[nh][nt] * Aw;
            float* hl = HL + (R0 + 16 * wq + 4 * fq) * AW + C; float* ac = AC + (R0 + 16 * wq + 4 * fq) * AW + C;
#pragma unroll
            for (int r = 0; r < 4; ++r) { hl[(size_t)r * AW] = Ar[nh][nt][r] * hin + Hr[nh][nt][r]; ac[(size_t)r * AW] = Ar[nh][nt][r] * ain; }
            if (wq == 3 && fq == 3) { float* sm = SUM + ((size_t)(b * 32 + c) * 1024 + C) * 2; sm[0] = Ar[nh][nt][3] * ain; sm[1] = Ar[nh][nt][3] * hin + Hr[nh][nt][3]; } }
}

constexpr int SC_STR = 129, P7_SAB = 2 * 128 * SC_STR * 4, P7_IL = P7_SAB + 128 * 33 * 4, P7_CT = P7_IL + 128 * 34 * 2;
static_assert(P7_CT + 64 <= MISC_OFF, "P7 LDS map");
__device__ __forceinline__ unsigned ord_key(float v) { const unsigned u = __builtin_bit_cast(unsigned, v); return (u & 0x80000000u) ? ~u : (u | 0x80000000u); }
#define CE_DESC(x, y) do { const unsigned _x = (x), _y = (y); (x) = _x > _y ? _x : _y; (y) = _x > _y ? _y : _x; } while (0)
template <int B, int NA> __device__ __forceinline__ void sort16_desc(unsigned (&a)[NA]) {
#pragma unroll
    for (int k = 2; k <= 16; k <<= 1)
#pragma unroll
        for (int j = k >> 1; j > 0; j >>= 1)
#pragma unroll
            for (int i = 0; i < 16; ++i) { const int l = i ^ j; if (l > i) { if ((i & k) == 0) CE_DESC(a[B + i], a[B + l]); else CE_DESC(a[B + l], a[B + i]); } }
}
template <int A, int Bo, int NA, int NB> __device__ __forceinline__ void merge16_desc(unsigned (&a)[NA], const unsigned (&b)[NB]) {
#pragma unroll
    for (int i = 0; i < 16; ++i) a[A + i] = a[A + i] > b[Bo + 15 - i] ? a[A + i] : b[Bo + 15 - i];
#pragma unroll
    for (int j = 8; j > 0; j >>= 1)
#pragma unroll
        for (int i = 0; i < 16; ++i) { const int l = i ^ j; if (l > i) CE_DESC(a[A + i], a[A + l]); }
}
__device__ __forceinline__ void peer_topk_unit(const Params& P, LAS unsigned char* lds, int t0, int h, int tid, int wave, int lane) {
    unsigned char* ws = P.ws;
    const bf16* QP = (const bf16*)(ws + WS_QP); const bf16* KEYS = (const bf16*)(ws + WS_KEYS);
    int* IDX = (int*)(ws + WS_IDX); float* GW = (float*)(ws + WS_G);
    LAS float* SC = (LAS float*)lds; LAS float* SAB = (LAS float*)(lds + P7_SAB); LAS unsigned short* IL = (LAS unsigned short*)(lds + P7_IL); LAS unsigned char* CT = lds + P7_CT;
    __syncthreads();
    if (tid < 64) { int ia = 0, rem = tid; while (ia < 16 && rem >= 16 / (ia + 1)) { rem -= 16 / (ia + 1); ++ia; }
        CT[tid] = (unsigned char)(ia < 16 ? ia * 16 + rem : 255); }
    { const int mtile = wave & 3, c = wave >> 2, r31 = lane & 31, hh = lane >> 5;
      bf16x8 A[8];
      const bf16* qp = QP + (size_t)(t0 + 32 * mtile + r31) * DM + h * 256 + c * 128 + 8 * hh;
#pragma unroll
      for (int ks = 0; ks < 8; ++ks) A[ks] = *(const bf16x8*)(qp + 16 * ks);
#pragma unroll
      for (int nt = 0; nt < 4; ++nt) { f32x16 acc;
#pragma unroll
          for (int r = 0; r < 16; ++r) acc[r] = 0.f;
          const bf16* kp = KEYS + ((size_t)((h * 2 + c) * 128 + 32 * nt + r31)) * 128 + 8 * hh;
#pragma unroll
          for (int ks = 0; ks < 8; ++ks) { const bf16x8 bk = *(const bf16x8*)(kp + 16 * ks); acc = MFMA32(A[ks], bk, acc); }
#pragma unroll
          for (int r = 0; r < 16; ++r) { const int tok = 32 * mtile + (r & 3) + 8 * (r >> 2) + 4 * hh; SC[(c * 128 + tok) * SC_STR + 32 * nt + r31] = acc[r]; } } }
    __syncthreads();
    const int half = tid & 1, c = (tid >> 1) & 1, tok = tid >> 2;
    unsigned a[64];
    { const LAS float* sp = SC + (c * 128 + tok) * SC_STR + half * 64; const int rot = 8 * (2 * c + half);
#pragma unroll
      for (int i = 0; i < 64; ++i) { const int n = (i + rot) & 63; a[i] = (ord_key(sp[n]) & ~127u) | (unsigned)(127 - (half * 64 + n)); } }
    sort16_desc<0>(a); sort16_desc<16>(a); sort16_desc<32>(a); sort16_desc<48>(a);
    merge16_desc<0, 16>(a, a); merge16_desc<32, 48>(a, a); merge16_desc<0, 32>(a, a);
    { unsigned o[16];
#pragma unroll
      for (int j = 0; j < 16; ++j) o[j] = (unsigned)__shfl_xor((int)a[j], 1);
      merge16_desc<0, 0>(a, o); }
    if (half == 0) {
#pragma unroll
        for (int j = 0; j < 16; ++j) { const int n = 127 - (int)(a[j] & 127u); SAB[tok * 33 + c * 16 + j] = SC[(c * 128 + tok) * SC_STR + n]; IL[tok * 34 + c * 16 + j] = (unsigned short)n; } }
    __syncthreads();
    const int q = tid & 3;
    unsigned cd[16];
#pragma unroll
    for (int j = 0; j < 13; ++j) { const unsigned code = CT[q + 4 * j]; const float s = SAB[tok * 33 + ((code >> 4) & 15u)] + SAB[tok * 33 + 16 + (code & 15u)];
        cd[j] = code == 255u ? 0u : ((ord_key(s) & ~255u) | (255u - code)); }
    cd[13] = 0u; cd[14] = 0u; cd[15] = 0u;
    sort16_desc<0>(cd);
    { unsigned o[16];
#pragma unroll
      for (int j = 0; j < 16; ++j) o[j] = (unsigned)__shfl_xor((int)cd[j], 1);
      merge16_desc<0, 0>(cd, o);
#pragma unroll
      for (int j = 0; j < 16; ++j) o[j] = (unsigned)__shfl_xor((int)cd[j], 2);
      merge16_desc<0, 0>(cd, o); }
    if (q == 0) {
        float cv[16]; int id[16];
#pragma unroll
        for (int s = 0; s < 16; ++s) { const unsigned code = 255u - (cd[s] & 255u); const int ia = (int)(code >> 4), ib = (int)(code & 15u); const int na = IL[tok * 34 + ia], nb = IL[tok * 34 + 16 + ib];
            cv[s] = SAB[tok * 33 + ia] + SAB[tok * 33 + 16 + ib]; id[s] = na * 128 + nb; }
        float mx = cv[0];
#pragma unroll
        for (int s = 1; s < 16; ++s) mx = fmaxf(mx, cv[s]);
        float sum = 0.f;
#pragma unroll
        for (int s = 0; s < 16; ++s) { cv[s] = __builtin_amdgcn_exp2f((cv[s] - mx) * LOG2E); sum += cv[s]; }
        const float inv = 1.f / sum;
        int* ip = IDX + (size_t)(t0 + tok) * 128 + h * 16; float* gp = GW + (size_t)(t0 + tok) * 128 + h * 16;
#pragma unroll
        for (int s4 = 0; s4 < 4; ++s4) { *(int4*)(ip + 4 * s4) = make_int4(id[4 * s4], id[4 * s4 + 1], id[4 * s4 + 2], id[4 * s4 + 3]);
            *(f32x4*)(gp + 4 * s4) = (f32x4){cv[4 * s4] * inv, cv[4 * s4 + 1] * inv, cv[4 * s4 + 2] * inv, cv[4 * s4 + 3] * inv}; }
    }
}

__device__ __forceinline__ void fp8x16_to_f32(const v4u& w, float (&f)[16]) {
#pragma unroll
    for (int i = 0; i < 4; ++i) { const f32x2_t lo = __builtin_amdgcn_cvt_pk_f32_fp8((int)w[i], false), hi = __builtin_amdgcn_cvt_pk_f32_fp8((int)w[i], true);
        f[4 * i] = lo[0]; f[4 * i + 1] = lo[1]; f[4 * i + 2] = hi[0]; f[4 * i + 3] = hi[1]; }
}
#define LD16I(dst, p) do { _Pragma("unroll") for (int q_ = 0; q_ < 4; ++q_) { const int4 v_ = ((const int4*)(p))[q_]; dst[4 * q_] = v_.x; dst[4 * q_ + 1] = v_.y; dst[4 * q_ + 2] = v_.z; dst[4 * q_ + 3] = v_.w; } } while (0)
#define LD16F(dst, p) do { _Pragma("unroll") for (int q_ = 0; q_ < 4; ++q_) { const f32x4 v_ = ((const f32x4*)(p))[q_]; dst[4 * q_] = v_[0]; dst[4 * q_ + 1] = v_[1]; dst[4 * q_ + 2] = v_[2]; dst[4 * q_ + 3] = v_[3]; } } while (0)
__device__ __forceinline__ void peer_u_phase(const Params& P, int xg, int slot, int nslots, int lane) {
    unsigned char* ws = P.ws;
    const bf16* X1B = (const bf16*)(ws + WS_X1B); const unsigned char* U8 = ws + WS_U8; const int* IDX = (const int*)(ws + WS_IDX); float* PD = (float*)(ws + WS_PD) + (size_t)xg * T_TOK * 128;
    const int ntok = slot < T_TOK ? (T_TOK - slot + nslots - 1) / nslots : 0, N = 2 * ntok;
    if (N == 0) return;
    const int R = lane >> 3, p = lane & 7;
    const bool b2 = (lane & 4) != 0, b1 = (lane & 2) != 0, b0 = (lane & 1) != 0;
    int I0[16], I1[16], I2[16]; v4u X0[2], X1[2], X2[2]; v4u B0[8], B1[8], B2[8];
#define U_ITEM(n, t, s) const int n_##t = (n) < N ? (n) : N - 1; const int t = slot + (n_##t >= ntok ? n_##t - ntok : n_##t) * nslots, s = 2 * xg + (n_##t >= ntok ? 1 : 0)
#define U_ROWS(buf, ids, off, s) do { const unsigned char* ub_ = U8 + (size_t)(s) * NEXP * 128; _Pragma("unroll") for (int i = 0; i < 8; ++i) buf[i] = *(const v4u*)(ub_ + (unsigned)(((unsigned)ids[(off) + i] << 7) + 16u * p)); } while (0)
#define U_HALF(buf, off) do { _Pragma("unroll") for (int i = 0; i < 8; ++i) { int d = 0; _Pragma("unroll") for (int w = 0; w < 4; ++w) d = __builtin_amdgcn_sdot4((int)buf[i][w], xq[w], d, false); part[(off) + i] = d; } } while (0)
#define U_X(dst, t, s) do { const bf16* xp_ = X1B + (size_t)(t) * DM + 128 * (s) + 16 * p; dst[0] = *(const v4u*)xp_; dst[1] = *(const v4u*)(xp_ + 8); } while (0)
    const int i0 = ((lane & 4) ? 8 : 0) + ((lane & 2) ? 4 : 0) + ((lane & 1) ? 2 : 0);
    { U_ITEM(0, t0, s0); U_ITEM(1, t1, s1); U_ITEM(2, t2, s2);
      int id0[16];
      LD16I(id0, IDX + (size_t)t0 * 128 + 16 * R); LD16I(I0, IDX + (size_t)t1 * 128 + 16 * R); LD16I(I1, IDX + (size_t)t2 * 128 + 16 * R);
      U_X(X0, t0, s0); U_X(X1, t1, s1);
      U_ROWS(B0, id0, 0, s0); U_ROWS(B1, id0, 8, s0); }
#define U_BODY(n, Ba, Bb, Bc, Ia, Ib, Ic, Xa, Xb, Xc) do { \
        U_ITEM(n, t, s); U_ITEM((n) + 1, t1, s1); U_ITEM((n) + 2, t2, s2); U_ITEM((n) + 3, t3, s3); (void)s; (void)s3; \
        f32x2_t* pp = (f32x2_t*)(PD + (size_t)t * 128 + 16 * R + i0); \
        f32x2_t pold = (f32x2_t){0.f, 0.f}; if ((n) >= ntok) pold = *pp; \
        U_ROWS(Bc, Ia, 0, s1); \
        LD16I(Ic, IDX + (size_t)t3 * 128 + 16 * R); \
        U_X(Xc, t2, s2); \
        float x[16]; float am = 0.f; \
        _Pragma("unroll") for (int k = 0; k < 4; ++k) { x[2 * k] = bf_lo(Xa[0][k]); x[2 * k + 1] = bf_hi(Xa[0][k]); x[8 + 2 * k] = bf_lo(Xa[1][k]); x[8 + 2 * k + 1] = bf_hi(Xa[1][k]); } \
        _Pragma("unroll") for (int k = 0; k < 16; ++k) am = fmaxf(am, fabsf(x[k])); \
        am = fmaxf(am, __shfl_xor(am, 1)); am = fmaxf(am, __shfl_xor(am, 2)); am = fmaxf(am, __shfl_xor(am, 4)); \
        const float xs = am > 0.f ? am * (1.f / 127.f) : 1.f, xinv = 1.f / xs; \
        int xq[4]; \
        _Pragma("unroll") for (int w = 0; w < 4; ++w) { const int q0 = (int)rintf(x[4 * w] * xinv), q1 = (int)rintf(x[4 * w + 1] * xinv), q2 = (int)rintf(x[4 * w + 2] * xinv), q3 = (int)rintf(x[4 * w + 3] * xinv); \
            xq[w] = (int)((unsigned)(q0 & 255) | ((unsigned)(q1 & 255) << 8) | ((unsigned)(q2 & 255) << 16) | ((unsigned)q3 << 24)); } \
        int part[16]; \
        U_HALF(Ba, 0); \
        U_ROWS(Ba, Ia, 8, s1); \
        U_HALF(Bb, 8); \
        if ((n) < N) { \
            int a8[8], a4[4], a2i[2]; \
            _Pragma("unroll") for (int k = 0; k < 8; ++k) { const int send = b2 ? part[k] : part[k + 8], keep = b2 ? part[k + 8] : part[k]; a8[k] = keep + __shfl_xor(send, 4); } \
            _Pragma("unroll") for (int k = 0; k < 4; ++k) { const int send = b1 ? a8[k] : a8[k + 4], keep = b1 ? a8[k + 4] : a8[k]; a4[k] = keep + __shfl_xor(send, 2); } \
            _Pragma("unroll") for (int k = 0; k < 2; ++k) { const int send = b0 ? a4[k] : a4[k + 2], keep = b0 ? a4[k + 2] : a4[k]; a2i[k] = keep + __shfl_xor(send, 1); } \
            *pp = (f32x2_t){(float)a2i[0] * xs, (float)a2i[1] * xs} + pold; } } while (0)
    for (int n = 0; n < N; n += 3) { U_BODY(n, B0, B1, B2, I0, I1, I2, X0, X1, X2); U_BODY(n + 1, B2, B0, B1, I1, I2, I0, X1, X2, X0); U_BODY(n + 2, B1, B2, B0, I2, I0, I1, X2, X0, X1); }
#undef U_X
#undef U_ITEM
#undef U_ROWS
#undef U_HALF
#undef U_BODY
}
__device__ __forceinline__ void peer_act_tokens(const Params& P, int t, int t2, int lane) {
    unsigned char* ws = P.ws;
    const float* PD = (const float*)(ws + WS_PD); const int* IDX = (const int*)(ws + WS_IDX); const float* GW = (const float*)(ws + WS_G); const float* SSP = (const float*)(ws + WS_SSP);
    const float* US = (const float*)(ws + WS_US); const float* VS = (const float*)(ws + WS_VS); float* ACT = (float*)(ws + WS_ACT);
    const bool two = t2 >= 0; const int tt[2] = {t, two ? t2 : t};
    float ss[2], d[2][2], gw[2][2], us[2][2], vs[2][2]; int id[2][2];
#pragma unroll
    for (int k = 0; k < 2; ++k) { ss[k] = lane < 32 ? SSP[(size_t)tt[k] * 32 + lane] : 0.f;
#pragma unroll
        for (int s = 0; s < 2; ++s) { const int slot = 64 * s + lane; id[k][s] = IDX[(size_t)tt[k] * 128 + slot]; gw[k][s] = GW[(size_t)tt[k] * 128 + slot]; float a = 0.f;
#pragma unroll
            for (int xg = 0; xg < 8; ++xg) a += PD[((size_t)xg * T_TOK + tt[k]) * 128 + slot];
            d[k][s] = a; } }
#pragma unroll
    for (int k = 0; k < 2; ++k)
#pragma unroll
        for (int s = 0; s < 2; ++s) { us[k][s] = US[id[k][s]]; vs[k][s] = VS[id[k][s]]; }
#pragma unroll
    for (int k = 0; k < 2; ++k) { const float rs = __builtin_amdgcn_rsqf(wave_sum(ss[k]) * (1.f / 2048.f) + RMS_EPS);
        if (k == 0 || two) {
#pragma unroll
            for (int s = 0; s < 2; ++s) ACT[(size_t)tt[k] * 128 + 64 * s + lane] = pg8::gelu_tanh_f(d[k][s] * us[k][s] * rs) * gw[k][s] * vs[k][s]; } }
}
#define PIN16(a) asm volatile("" : "+v"(a[0]), "+v"(a[1]), "+v"(a[2]), "+v"(a[3]), "+v"(a[4]), "+v"(a[5]), "+v"(a[6]), "+v"(a[7]), "+v"(a[8]), "+v"(a[9]), "+v"(a[10]), "+v"(a[11]), "+v"(a[12]), "+v"(a[13]), "+v"(a[14]), "+v"(a[15]))
__device__ __forceinline__ void peer_v_phase(const Params& P, int xg, int slot, int nslots, int lane) {
    unsigned char* ws = P.ws;
    const unsigned char* V8 = ws + WS_V8; const int* IDX = (const int*)(ws + WS_IDX); const float* ACT = (const float*)(ws + WS_ACT); bf16* OUTP = (bf16*)(ws + WS_OUTP);
    const int ntok = slot < T_TOK ? (T_TOK - slot + nslots - 1) / nslots : 0, N = 2 * ntok;
    if (N == 0) return;
    const int R = lane >> 3, p = lane & 7;
    const bool b5 = (lane & 32) != 0, b4 = (lane & 16) != 0, b3 = (lane & 8) != 0;
    int I0[16], I1[16], I2[16]; float A0[16], A1[16], A2[16]; v4u B0[8], B1[8], B2[8];
#define V_ITEM(n, t, s) const int n_##t = (n) < N ? (n) : N - 1; const int t = slot + (n_##t >= ntok ? n_##t - ntok : n_##t) * nslots, s = 2 * xg + (n_##t >= ntok ? 1 : 0)
#define V_ROWS(buf, ids, off, s) do { const unsigned char* vb_ = V8 + (size_t)(s) * NEXP * 128; _Pragma("unroll") for (int i = 0; i < 8; ++i) buf[i] = *(const v4u*)(vb_ + (unsigned)(((unsigned)ids[(off) + i] << 7) + 16u * p)); } while (0)
#define V_HALF(buf, av, off) do { _Pragma("unroll") for (int i = 0; i < 8; ++i) { asm volatile("" : "+v"(buf[i][0]), "+v"(buf[i][1]), "+v"(buf[i][2]), "+v"(buf[i][3])); \
            float f[16]; fp8x16_to_f32(buf[i], f); _Pragma("unroll") for (int k = 0; k < 16; ++k) acc[k] += av[(off) + i] * f[k]; PIN16(acc); } } while (0)
    { V_ITEM(0, t0, s0); V_ITEM(1, t1, s1); V_ITEM(2, t2, s2); (void)s1; (void)s2;
      int id0[16];
      LD16I(id0, IDX + (size_t)t0 * 128 + 16 * R); LD16I(I0, IDX + (size_t)t1 * 128 + 16 * R); LD16I(I1, IDX + (size_t)t2 * 128 + 16 * R);
      LD16F(A0, ACT + (size_t)t0 * 128 + 16 * R); LD16F(A1, ACT + (size_t)t1 * 128 + 16 * R);
      V_ROWS(B0, id0, 0, s0); V_ROWS(B1, id0, 8, s0); }
#define V_BODY(n, Ba, Bb, Bc, Ia, Ib, Ic, Aa, Ab, Ac) do { \
        V_ITEM(n, t, s); V_ITEM((n) + 1, t1, s1); V_ITEM((n) + 2, t2, s2); V_ITEM((n) + 3, t3, s3); (void)s2; (void)s3; \
        V_ROWS(Bc, Ia, 0, s1); \
        LD16I(Ic, IDX + (size_t)t3 * 128 + 16 * R); LD16F(Ac, ACT + (size_t)t2 * 128 + 16 * R); \
        float acc[16]; \
        _Pragma("unroll") for (int k = 0; k < 16; ++k) acc[k] = 0.f; \
        V_HALF(Ba, Aa, 0); \
        V_ROWS(Ba, Ia, 8, s1); \
        V_HALF(Bb, Aa, 8); \
        if ((n) < N) { \
            float a8[8], a4[4], a2[2]; \
            _Pragma("unroll") for (int k = 0; k < 8; ++k) { const float send = b5 ? acc[k] : acc[k + 8], keep = b5 ? acc[k + 8] : acc[k]; a8[k] = keep + __shfl_xor(send, 32); } \
            _Pragma("unroll") for (int k = 0; k < 4; ++k) { const float send = b4 ? a8[k] : a8[k + 4], keep = b4 ? a8[k + 4] : a8[k]; a4[k] = keep + __shfl_xor(send, 16); } \
            _Pragma("unroll") for (int k = 0; k < 2; ++k) { const float send = b3 ? a4[k] : a4[k + 2], keep = b3 ? a4[k + 2] : a4[k]; a2[k] = keep + __shfl_xor(send, 8); } \
            const int col = 128 * s + 16 * p + (b5 ? 8 : 0) + (b4 ? 4 : 0) + (b3 ? 2 : 0); \
            *(unsigned*)(OUTP + (size_t)t * DM + col) = cvtpk(a2[0], a2[1]); } } while (0)
    for (int n = 0; n < N; n += 3) { V_BODY(n, B0, B1, B2, I0, I1, I2, A0, A1, A2); V_BODY(n + 1, B2, B0, B1, I1, I2, I0, A1, A2, A0); V_BODY(n + 2, B1, B2, B0, I2, I0, I1, A2, A0, A1); }
#undef V_ITEM
#undef V_ROWS
#undef V_HALF
#undef V_BODY
}
__device__ __forceinline__ void peer_final_tokens(const Params& P, int t, int t2, int lane, float* outp) {
    const bool two = t2 >= 0; const int tt[2] = {t, two ? t2 : t};
    v4u a[2][4], b[2][4];
#pragma unroll
    for (int k = 0; k < 2; ++k) { const bf16* xrow = (const bf16*)(P.ws + WS_X1B) + (size_t)tt[k] * DM; const bf16* prow = (const bf16*)(P.ws + WS_OUTP) + (size_t)tt[k] * DM;
#pragma unroll
        for (int j = 0; j < 4; ++j) { a[k][j] = *(const v4u*)(xrow + 512 * j + 8 * lane); b[k][j] = *(const v4u*)(prow + 512 * j + 8 * lane); } }
#pragma unroll
    for (int k = 0; k < 2; ++k) { if (k == 1 && !two) break;
        float v[4][8]; float ss = 0.f;
#pragma unroll
        for (int j = 0; j < 4; ++j) {
#pragma unroll
            for (int i = 0; i < 4; ++i) { v[j][2 * i] = bf_lo(a[k][j][i]) + bf_lo(b[k][j][i]); v[j][2 * i + 1] = bf_hi(a[k][j][i]) + bf_hi(b[k][j][i]); }
#pragma unroll
            for (int i = 0; i < 8; ++i) ss += v[j][i] * v[j][i]; }
        const float rf = __builtin_amdgcn_rsqf(wave_sum(ss) * (1.f / 2048.f) + RMS_EPS);
        float* orow = outp + (size_t)tt[k] * DM;
#pragma unroll
        for (int j = 0; j < 4; ++j) { const f32x4 g0 = *(const f32x4*)(P.g_fin + 512 * j + 8 * lane), g1 = *(const f32x4*)(P.g_fin + 512 * j + 8 * lane + 4); f32x4 o0, o1;
#pragma unroll
            for (int i = 0; i < 4; ++i) { o0[i] = v[j][i] * rf * g0[i]; o1[i] = v[j][4 + i] * rf * g1[i]; }
            *(f32x4*)(orow + 512 * j + 8 * lane) = o0; *(f32x4*)(orow + 512 * j + 8 * lane + 4) = o1; } }
}

#ifndef MK_PER_PHASE
#define MK_PER_PHASE 0
#endif
constexpr int N_PHASES = 12;
__global__ void __launch_bounds__(NWAVES * 64, 2) fwd_kernel(Params P) {
    extern __shared__ __attribute__((aligned(16))) unsigned char lds_raw[];
    LAS unsigned char* lds = (LAS unsigned char*)lds_raw;
    volatile LAS unsigned* MISC = (volatile LAS unsigned*)(lds + MISC_OFF);
    const int tid = threadIdx.x, lane = tid & 63, wave = __builtin_amdgcn_readfirstlane(tid >> 6);
    const int G = gridDim.x; const int bx = blockIdx.x;
    const int vcu = (G % 8 == 0) ? (bx % 8) * (G / 8) + bx / 8 : bx;
    const int gw = vcu * NWAVES + wave, NGW = G * NWAVES;
    unsigned char* ws = P.ws;
    gu32* ctl = (gu32*)(ws + WS_CTL);
    for (int u = tid; u < 64; u += NWAVES * 64) MISC[u] = 0u;
    __syncthreads();
    XcdBarrier bar; bar.bar = (unsigned*)ctl + CW_BAR; bar.x = 0; bar.st = nullptr;
    if (!MK_PER_PHASE) bar = xcd_barrier_post((unsigned*)ctl + CW_BAR, MISC + 8);
    const unsigned my_xcc = xb_xcc_id();
    if (!MK_PER_PHASE) { if (tid == 0) MISC[16] = __hip_atomic_fetch_add((unsigned*)(ctl + CW_XC + 64 * (my_xcc & 7u)), 1u, __ATOMIC_RELAXED, __HIP_MEMORY_SCOPE_AGENT); }
    const int lo = P.ph_lo, hi = P.ph_hi;
#define FRESH_IDS const int lane = (int)__builtin_amdgcn_mbcnt_hi(~0u, __builtin_amdgcn_mbcnt_lo(~0u, 0u)); const int tid = wave * 64 + lane; (void)tid; (void)lane
#ifndef PH_MASK
#define PH_MASK 0xfff
#endif
#define IN(k) (((PH_MASK >> (k)) & 1) && lo <= (k) && (k) < hi)
#define BOTH(k) (IN(k) && IN((k) + 1))
#ifndef DUP_MASK
#define DUP_MASK 0
#endif
#define NREP(k) (((DUP_MASK >> (k)) & 1) ? 2 : 1)
#define GRID_BAR() do { if (!MK_PER_PHASE) xcd_barrier(bar); } while (0)
#ifdef TPROBE
#ifndef TPROBE_MODE
#define TPROBE_MODE 0
#endif
#define TP_T0 (wave == 0 && __builtin_amdgcn_mbcnt_hi(~0u, __builtin_amdgcn_mbcnt_lo(~0u, 0u)) == 0u)
#define TP_PREV (TPROBE == 8 ? 6 : TPROBE - 1)
    if (TP_T0) { MISC[20] = (unsigned)__builtin_amdgcn_s_memrealtime(); MISC[21] = 0u; }
#define TP_PRE(k) ((TPROBE_MODE == 1 && (k) == TPROBE) || TPROBE_MODE == 2)
#define TP_POST(k) ((TPROBE_MODE == 0 && ((k) == TPROBE || (k) == TP_PREV)) || TP_PRE(k))
#define GRID_BAR_K(k) do { if (TP_PRE(k)) { if (TP_T0) MISC[22] = (unsigned)__builtin_amdgcn_s_memrealtime(); } xcd_barrier(bar); \
        if (TP_POST(k)) { if (TP_T0) { const unsigned tq1 = (unsigned)__builtin_amdgcn_s_memrealtime(); \
            if (TPROBE_MODE == 0 && (k) == TPROBE) MISC[21] = tq1 - MISC[20]; if (TPROBE_MODE == 1 && (k) == TPROBE) MISC[21] = tq1 - MISC[22]; if (TPROBE_MODE == 2) MISC[21] = MISC[21] + (tq1 - MISC[22]); MISC[20] = tq1; } } } while (0)
#else
#define GRID_BAR_K(k) GRID_BAR()
#endif

    bf16* HN = (bf16*)(ws + WS_HN); bf16* WA = (bf16*)(ws + WS_WA); bf16* WV = (bf16*)(ws + WS_WV); bf16* WB = (bf16*)(ws + WS_WB); bf16* WO = (bf16*)(ws + WS_WO); bf16* WQ = (bf16*)(ws + WS_WQ);

    constexpr int NV_UNITS = (AW / 256) * (T_TOK / 256);
    const bool tab_fast = (G > NV_UNITS && (1024 % G) == 0);
    const int tab_r1 = tab_fast ? 0 : NEXP;
    if (IN(0)) { FRESH_IDS; for (int rep = 0; rep < NREP(0); ++rep) p0_prologue(P, lds, gw, NGW, wave, lane, tab_r1); if (BOTH(0)) GRID_BAR_K(0); }

    if (IN(1)) { FRESH_IDS;
      _Pragma("unroll") for (int rep = 0; rep < NREP(1); ++rep) {
        { pg8::Gemm g{HN, WA, T_TOK, NWA, DM / 2, WV, HN, ws, (unsigned)WS_END}; pg8::StaticOrder2 S; S.init(T_TOK, NWA, AW, T_TOK, G, bx);
          pg8::EpiProj E{(bf16*)(ws + WS_Q), (bf16*)(ws + WS_K), (bf16*)(ws + WS_XR), (bf16*)(ws + WS_GY), (bf16*)(ws + WS_SG), (bf16*)(ws + WS_VT), rep == 0 ? (float*)(ws + WS_CTL) + CW_KM : nullptr, QSCALE, 1.f / W8SCALE};
          pg8::gemm_phase<pg8::EpiProj, pg8::StaticOrder2, true, true, true>(lds, g, S, E); }
        if (tab_fast && bx >= NV_UNITS) peer_table_u<2>(P, 0, NEXP, (bx - NV_UNITS) * NWAVES + wave, (G - NV_UNITS) * NWAVES, lane);
      }
        if (BOTH(1)) GRID_BAR_K(1);
    }

    if (IN(2)) { FRESH_IDS;
        LAS int* tick = (LAS int*)(lds + MISC_OFF + 128);
#define NEXT_TICKET(dst, word) do { __syncthreads(); if (tid == 0) *tick = (int)__hip_atomic_fetch_add((unsigned*)(ctl + (word)), 1u, __ATOMIC_RELAXED, __HIP_MEMORY_SCOPE_AGENT); __syncthreads(); dst = *tick; } while (0)
#define TICKET_ISSUE(word) do { if (tid == 0) tk_next = (int)__hip_atomic_fetch_add((unsigned*)(ctl + (word)), 1u, __ATOMIC_RELAXED, __HIP_MEMORY_SCOPE_AGENT); } while (0)
#define TICKET_TAKE(dst) do { __syncthreads(); if (tid == 0) *tick = tk_next; __syncthreads(); dst = *tick; } while (0)
        int tk_next = 0;
#ifndef DUP_ATT
#define DUP_ATT 0
#endif
#ifndef DUP_LRU
#define DUP_LRU 0
#endif
#ifndef DUP_P2
#define DUP_P2 0
#endif
        _Pragma("unroll") for (int rp = 0; rp < 1 + DUP_P2; ++rp) {
        _Pragma("unroll") for (int rep = 0; rep < 1 + DUP_ATT; ++rep) {
            int tid2 = tid; asm volatile("" : "+v"(tid2));
            int it; NEXT_TICKET(it, CW_Q2 + 64 * (rep + 2 * rp));
            while (it < 256) { const int blk = 7 - (it >> 5), bh = it & 31; attn_unit(P, lds, bh >> 3, bh & 7, blk, tid2, wave, tid2 & 63); NEXT_TICKET(it, CW_Q2 + 64 * (rep + 2 * rp)); } }
        _Pragma("unroll") for (int rep = 0; rep < 1 + DUP_LRU; ++rep) {
            int tid2 = tid; asm volatile("" : "+v"(tid2));
            int it; NEXT_TICKET(it, CW_Q2 + 256 + 64 * (rep + 2 * rp));
            while (it < 512) { lru_pair(P, lds, it, tid2, wave, tid2 & 63, (unsigned*)(ctl + CW_Q2 + 256 + 64 * (rep + 2 * rp)), tk_next); TICKET_TAKE(it); } }
        if (DUP_P2 && rp == 0) GRID_BAR();
        }
#undef NEXT_TICKET
#undef TICKET_ISSUE
#undef TICKET_TAKE
        if (BOTH(2)) GRID_BAR_K(2);
    }

    if (IN(3)) { FRESH_IDS;
      _Pragma("unroll") for (int rep = 0; rep < NREP(3); ++rep) {
        const float* HL = (const float*)(ws + WS_HL); const float* AC = (const float*)(ws + WS_AC); const float* SUM = (const float*)(ws + WS_SUM);
        const bf16* GY = (const bf16*)(ws + WS_GY); unsigned char* OCAT = ws + WS_OCAT;
        for (int u = vcu; u < 256; u += G) { const int b = u >> 6, c = (u >> 1) & 31, C = (u & 1) * 512 + 4 * (tid & 127), tq = tid >> 7;
            f32x4 carry = (f32x4){0.f, 0.f, 0.f, 0.f};
            for (int cc = 0; cc < c; ++cc) { const float* sm = SUM + ((size_t)(b * 32 + cc) * 1024 + C) * 2; const f32x4 s0 = *(const f32x4*)sm, s1 = *(const f32x4*)(sm + 4);
                carry[0] = s0[0] * carry[0] + s0[1]; carry[1] = s0[2] * carry[1] + s0[3]; carry[2] = s1[0] * carry[2] + s1[1]; carry[3] = s1[2] * carry[3] + s1[3]; }
            const size_t R0 = (size_t)b * SEQ + c * 64 + tq * 16;
#pragma unroll 8
            for (int t = 0; t < 16; ++t) { const size_t o = (R0 + t) * AW + C; const f32x4 hv = *(const f32x4*)(HL + o) + *(const f32x4*)(AC + o) * carry;
                const unsigned long long gy = *(const unsigned long long*)(GY + o); const unsigned g0 = (unsigned)gy, g1 = (unsigned)(gy >> 32);
                int p = __builtin_amdgcn_cvt_pk_fp8_f32(clamp8(hv[0] * bf_lo(g0) * OC8SCALE), clamp8(hv[1] * bf_hi(g0) * OC8SCALE), 0, false); p = __builtin_amdgcn_cvt_pk_fp8_f32(clamp8(hv[2] * bf_lo(g1) * OC8SCALE), clamp8(hv[3] * bf_hi(g1) * OC8SCALE), p, true);
                *(unsigned*)(OCAT + (R0 + t) * DM + AW + C) = (unsigned)p; } }
      }
        if (BOTH(3)) GRID_BAR_K(3);
    }

    if (IN(4)) { FRESH_IDS;
      _Pragma("unroll") for (int rep = 0; rep < NREP(4); ++rep) {
        { pg8::Gemm g{(bf16*)(ws + WS_OCAT), WB, T_TOK, DM, DM / 2, nullptr, nullptr, ws, (unsigned)WS_END}; pg8::StaticOrder S; S.init(T_TOK, DM, G, bx);
          pg8::EpiMerge2 E{(const bf16*)(ws + WS_SG), (bf16*)(ws + WS_MG), MG8SCALE / (OC8SCALE * WB8SCALE)};
          pg8::gemm_phase<pg8::EpiMerge2, pg8::StaticOrder, true, true, true>(lds, g, S, E); }
      }
        if (BOTH(4)) GRID_BAR_K(4);
    }

    if (IN(5)) { FRESH_IDS;
      _Pragma("unroll") for (int rep = 0; rep < NREP(5); ++rep) {
        pg8::Gemm g{(bf16*)(ws + WS_MG), WO, T_TOK, DM, DM / 2, nullptr, nullptr, ws, (unsigned)WS_END}; pg8::StaticOrder S; S.init(T_TOK, DM, G, bx);
        pg8::EpiResid E{P.x, (bf16*)(ws + WS_X1B), (float*)(ws + WS_SSP), 1.f / (W8SCALE * MG8SCALE)};
        pg8::gemm_phase<pg8::EpiResid, pg8::StaticOrder, true, true, true>(lds, g, S, E);
      }
        if (BOTH(5)) GRID_BAR_K(5);
    }

    if (IN(6)) { FRESH_IDS;
      _Pragma("unroll") for (int rep = 0; rep < NREP(6); ++rep) {
        pg8::Gemm g{(bf16*)(ws + WS_X1B), WQ, T_TOK, DM, DM, nullptr, nullptr, ws, (unsigned)WS_END}; pg8::StaticOrder S; S.init(T_TOK, DM, G, bx);
        pg8::EpiRowScale E{(const float*)(ws + WS_SSP), (bf16*)(ws + WS_QP)};
        pg8::gemm_phase<pg8::EpiRowScale, pg8::StaticOrder, true, true>(lds, g, S, E);
        { pg8::Unit u; for (int i = 0; S.next(i, u); ++i) { peer_topk_unit(P, lds, u.pm * 256, u.pn, tid, wave, lane); peer_topk_unit(P, lds, u.pm * 256 + 128, u.pn, tid, wave, lane); } }
      }
        if (BOTH(6)) GRID_BAR_K(6);
    }

    int xg = bx & 7, nblk_g = (G - xg + 7) >> 3, rank_g = bx >> 3;
    if (!MK_PER_PHASE && lo == 0 && hi > 8) {
        unsigned cnt[8], sum = 0u; bool ok = my_xcc < 8u;
#pragma unroll
        for (int j = 0; j < 8; ++j) { cnt[j] = __hip_atomic_load((unsigned*)(ctl + CW_XC + 64 * j), __ATOMIC_RELAXED, __HIP_MEMORY_SCOPE_AGENT); sum += cnt[j]; ok = ok && cnt[j] > 0u; }
        if (ok && sum == (unsigned)G) { xg = (int)my_xcc; rank_g = (int)MISC[16];
            nblk_g = (int)(xg == 0 ? cnt[0] : xg == 1 ? cnt[1] : xg == 2 ? cnt[2] : xg == 3 ? cnt[3] : xg == 4 ? cnt[4] : xg == 5 ? cnt[5] : xg == 6 ? cnt[6] : cnt[7]); }
    }
    const int nslots = nblk_g * NWAVES, slot = rank_g * NWAVES + wave;
    if (IN(8)) { FRESH_IDS;
        _Pragma("unroll") for (int rep = 0; rep < NREP(8); ++rep) {
        if (tab_fast) { if (wave == NWAVES - 1) peer_table_v<4>(P, 0, NEXP, bx, G, lane); else peer_u_phase(P, xg, rank_g * (NWAVES - 1) + wave, nblk_g * (NWAVES - 1), lane); }
        else peer_u_phase(P, xg, slot, nslots, lane); }
        if (BOTH(8)) GRID_BAR_K(8);
    }
#ifdef EXTRA_BARS
    for (int eb = 0; eb < EXTRA_BARS; ++eb) GRID_BAR();
#endif
    if (IN(9)) { FRESH_IDS;
        for (int t = gw; t < T_TOK; t += 2 * NGW) peer_act_tokens(P, t, t + NGW < T_TOK ? t + NGW : -1, lane);
        if (BOTH(9)) GRID_BAR_K(9);
    }
    if (IN(10)) { FRESH_IDS;
        _Pragma("unroll") for (int rep = 0; rep < NREP(10); ++rep)
        peer_v_phase(P, xg, slot, nslots, lane);
        if (BOTH(10)) GRID_BAR_K(10);
    }
    if (IN(11)) { FRESH_IDS;
        if (NREP(11) == 2) for (int t = gw; t < T_TOK; t += 2 * NGW) peer_final_tokens(P, t, t + NGW < T_TOK ? t + NGW : -1, lane, (float*)(ws + WS_MG));
        for (int t = gw; t < T_TOK; t += 2 * NGW) peer_final_tokens(P, t, t + NGW < T_TOK ? t + NGW : -1, lane, P.out);
    }
#ifdef TPROBE
    { GRID_BAR_K(11);
      gu32* tpw = (gu32*)(P.ws + WS_CTL) + 16384;
      if (TP_T0) __hip_atomic_fetch_add((unsigned*)tpw, MISC[21], __ATOMIC_RELAXED, __HIP_MEMORY_SCOPE_AGENT);
      GRID_BAR();
      const unsigned tot = __hip_atomic_load((unsigned*)tpw, __ATOMIC_RELAXED, __HIP_MEMORY_SCOPE_AGENT), avg = (unsigned)__builtin_amdgcn_readfirstlane((int)(tot >> 8));
      const unsigned ts = (unsigned)__builtin_amdgcn_s_memrealtime();
      while ((unsigned)__builtin_amdgcn_s_memrealtime() - ts < avg) __builtin_amdgcn_s_sleep(1); }
#endif
#undef IN
#undef BOTH
#undef GRID_BAR
}

extern "C" void kernel_launch(void* const* d_in, const int* in_sizes, int n_in, void* d_out, int out_size, void* d_ws, size_t ws_size, hipStream_t stream) {
    static int grid = 0;
    if (grid == 0) {
        if (n_in != 19 || out_size != T_TOK * DM || ws_size < WS_END) { fprintf(stderr, "kernel_launch: unexpected problem (n_in %d, out %d, ws %zu); nothing launched\n", n_in, out_size, ws_size); grid = -1; return; }
        int dev = 0, cus = 0, per_cu = 0;
        if (hipGetDevice(&dev) != hipSuccess || hipDeviceGetAttribute(&cus, hipDeviceAttributeMultiprocessorCount, dev) != hipSuccess) { grid = -1; return; }
        if (hipFuncSetAttribute((const void*)fwd_kernel, hipFuncAttributeMaxDynamicSharedMemorySize, LDS_BYTES) != hipSuccess) { fprintf(stderr, "kernel_launch: hipFuncSetAttribute failed\n"); grid = -1; return; }
        if (hipOccupancyMaxActiveBlocksPerMultiprocessor(&per_cu, (const void*)fwd_kernel, NWAVES * 64, LDS_BYTES) != hipSuccess || per_cu < 1) { fprintf(stderr, "kernel_launch: occupancy query says %d blocks per CU\n", per_cu); }
        (void)hipGetLastError();
        grid = cus;
    }
    if (grid < 0) return;
    if (hipMemsetAsync((char*)d_ws + WS_CTL, 0, CTL_ZERO_BYTES, stream) != hipSuccess) return;
    Params p{};
    const float** pp = (const float**)&p;
    for (int i = 0; i < 19; ++i) pp[i] = (const float*)d_in[i];
    p.out = (float*)d_out; p.ws = (unsigned char*)d_ws;
#if MK_PER_PHASE
    for (int ph = 0; ph < N_PHASES; ++ph) { p.ph_lo = ph; p.ph_hi = ph + 1; hipLaunchKernelGGL(fwd_kernel, dim3(grid), dim3(NWAVES * 64), LDS_BYTES, stream, p); }
#else
    p.ph_lo = 0; p.ph_hi = N_PHASES;
    hipLaunchKernelGGL(fwd_kernel, dim3(grid), dim3(NWAVES * 64), LDS_BYTES, stream, p);
#endif
}
```

```cpp
#include <hip/hip_runtime.h>
#include <cstdio>
#include <cstdint>
namespace pg8 {
#define PG8_LAS __attribute__((address_space(3)))
typedef unsigned short bf16_t;
typedef short bf16x8 __attribute__((ext_vector_type(8)));
typedef float f32x4 __attribute__((ext_vector_type(4)));
typedef unsigned u32x4 __attribute__((ext_vector_type(4)));
typedef int i32x4 __attribute__((ext_vector_type(4)));
typedef int i32x8 __attribute__((ext_vector_type(8)));
__device__ __forceinline__ i32x8 cat8(bf16x8 a, bf16x8 b) { return __builtin_shufflevector(__builtin_bit_cast(i32x4, a), __builtin_bit_cast(i32x4, b), 0, 1, 2, 3, 4, 5, 6, 7); }
constexpr int BM = 256, BK = 64, HALF = 128, HTB = HALF * BK * 2  , STAGE_BYTES = 8 * HTB, NXCD = 8, WGM = 8;

__host__ __device__ __forceinline__ int lds_byte(int r, int c) { const int st = (r >> 4) * 2 + (c >> 5), rr = r & 15, cc = c & 31, ob = rr * 64 + cc * 2; return st * 1024 + (ob ^ (((ob >> 9) & 1) << 5)); }
__host__ __device__ __forceinline__ void stage_rc(int b, int& R, int& C) { const int st = b / 1024, sb = b % 1024, swz = sb ^ (((sb >> 9) & 1) << 5); R = (st >> 1) * 16 + swz / 64; C = (st & 1) * 32 + (swz % 64) / 2; }
__host__ __device__ __forceinline__ int perm32(int rho) { const int n = rho >> 4, i = rho & 15; return 8 * (i >> 2) + 4 * n + (i & 3); }

struct Unit { int pm, pn, sel; };
struct Gemm { const bf16_t* A; const bf16_t* Bt; int M, N, K; const bf16_t* A2; const bf16_t* Bt2; const void* rbase; unsigned rbytes; };

struct StaticOrder {
    int nM, nN, nwg, G, c;
    __host__ __device__ __forceinline__ void init(int M, int N, int G_, int c_) { nM = M / BM; nN = N / BM; nwg = nM * nN; G = G_; c = c_; }
    __host__ __device__ __forceinline__ bool next(int i, Unit& u) const {
        const long L = (long)i * G + c; if (L >= nwg) return false;
        int wgid = (int)L; { const int q = nwg / NXCD, r = nwg % NXCD, xcd = wgid % NXCD, off = wgid / NXCD; wgid = (xcd < r ? xcd * (q + 1) : r * (q + 1) + (xcd - r) * q) + off; }
        const int nig = WGM * nN, gid = wgid / nig, fm = gid * WGM, gsz = (nM - fm) < WGM ? (nM - fm) : WGM;
        u.pm = fm + ((wgid % nig) % gsz); u.pn = (wgid % nig) / gsz; u.sel = 0; return true;
    }
    __device__ __forceinline__ void a_ready(const Unit&) const {}
    __device__ __forceinline__ void done(const Unit&) const {}
};

struct StaticOrder2 {
    StaticOrder s0, s1; int G, c;
    __host__ __device__ __forceinline__ void init(int M0, int N0, int M1, int N1, int G_, int c_) { s0.init(M0, N0, 1, 0); s1.init(M1, N1, 1, 0); G = G_; c = c_; }
    __host__ __device__ __forceinline__ bool next(int i, Unit& u) const {
        const long L = (long)i * G + c;
        if (L < s0.nwg) return s0.next((int)L, u);
        if (L < s0.nwg + s1.nwg) { const bool ok = s1.next((int)(L - s0.nwg), u); u.sel = 1; return ok; }
        return false;
    }
    __device__ __forceinline__ void a_ready(const Unit&) const {}
    __device__ __forceinline__ void done(const Unit&) const {}
};

__device__ __forceinline__ unsigned cvt_pk_bf16(float lo, float hi) { unsigned r; asm volatile("v_cvt_pk_bf16_f32 %0, %1, %2" : "=v"(r) : "v"(lo), "v"(hi)); return r; }
typedef float f32x2 __attribute__((ext_vector_type(2)));
__device__ __forceinline__ float c8(float v) { return __builtin_fminf(__builtin_fmaxf(v, -448.f), 448.f); }
__device__ __forceinline__ float sigmoid_f(float v) { return __builtin_amdgcn_rcpf(1.f + __builtin_amdgcn_exp2f(-1.4426950408889634f * v)); }
__device__ __forceinline__ float gelu_tanh_f(float v) { const float z = 1.5957691216057308f * (v + 0.044715f * v * v * v); return v * __builtin_amdgcn_rcpf(1.f + __builtin_amdgcn_exp2f(-1.4426950408889634f * z)); }
__device__ __forceinline__ u32x4 pack8(const f32x4& v0, const f32x4& v1) { u32x4 w; w.x = cvt_pk_bf16(v0[0], v0[1]); w.y = cvt_pk_bf16(v0[2], v0[3]); w.z = cvt_pk_bf16(v1[0], v1[1]); w.w = cvt_pk_bf16(v1[2], v1[3]); return w; }
__device__ __forceinline__ f32x4 bf4_lo(unsigned a, unsigned b) { f32x4 r; r[0] = __builtin_bit_cast(float, a << 16); r[1] = __builtin_bit_cast(float, a & 0xffff0000u); r[2] = __builtin_bit_cast(float, b << 16); r[3] = __builtin_bit_cast(float, b & 0xffff0000u); return r; }

struct EpiProj {
    static constexpr bool PERM = true, AFTER_DRAIN = false, MIDK = false;
    bf16_t *Q, *K, *XR, *GY, *SG, *VT; float* KM; float qscale, oscale;
    __device__ __forceinline__ void operator()(const f32x4 (&acc)[2][2][4][2], const Unit& u, int wr, int wc, int fr, int fq) const {
        { const int l_ = (int)__builtin_amdgcn_mbcnt_hi(~0u, __builtin_amdgcn_mbcnt_lo(~0u, 0u)); fr = l_ & 15; fq = l_ >> 4; }
        const int pn = u.pn; int kind, ldc, colt; bf16_t* base;
        if (u.sel) { kind = 2; base = VT; ldc = 8192; colt = pn * 256; }
        else if (pn < 4) { kind = 0; base = Q; ldc = 1024; colt = pn * 256; }
        else if (pn < 8) { kind = 1; base = K; ldc = 1024; colt = (pn - 4) * 256; }
        else if (pn < 12) { kind = 2; base = XR; ldc = 1024; colt = (pn - 8) * 256; }
        else if (pn < 16) { kind = 3; base = GY; ldc = 1024; colt = (pn - 12) * 256; }
        else { kind = 4; base = SG; ldc = 4096; colt = (pn - 16) * 256; }
        const int row0 = u.pm * BM + wr * 64 + fr, col0 = colt + wc * 32 + 8 * fq;
#pragma unroll
        for (int ai = 0; ai < 2; ++ai)
#pragma unroll
            for (int m = 0; m < 4; ++m) { bf16_t* rowp = base + (size_t)(row0 + ai * HALF + m * 16) * ldc + col0;
#pragma unroll
                for (int bj = 0; bj < 2; ++bj) { f32x4 v0 = acc[ai][bj][m][0] * oscale, v1 = acc[ai][bj][m][1] * oscale;
                    if (kind == 0) { v0 = v0 * qscale; v1 = v1 * qscale; }
                    else if (kind == 3) {
#pragma unroll
                        for (int e = 0; e < 4; ++e) { v0[e] = gelu_tanh_f(v0[e]); v1[e] = gelu_tanh_f(v1[e]); } }
                    else if (kind == 4) {
#pragma unroll
                        for (int e = 0; e < 4; ++e) { v0[e] = sigmoid_f(v0[e]); v1[e] = sigmoid_f(v1[e]); } }
                    *(u32x4*)(rowp + bj * HALF) = pack8(v0, v1); } }
        if (kind == 1 && KM != nullptr) {
            const int b = u.pm >> 3, blk = u.pm & 7;
#pragma unroll
            for (int bj = 0; bj < 2; ++bj)
#pragma unroll
                for (int n = 0; n < 2; ++n) { f32x4 s = (f32x4){0.f, 0.f, 0.f, 0.f};
#pragma unroll
                    for (int ai = 0; ai < 2; ++ai)
#pragma unroll
                        for (int m = 0; m < 4; ++m) s = s + acc[ai][bj][m][n];
#pragma unroll
                    for (int e = 0; e < 4; ++e) { float v = s[e]; v += __shfl_xor(v, 1); v += __shfl_xor(v, 2); v += __shfl_xor(v, 4); v += __shfl_xor(v, 8); s[e] = v; }
                    if (fr == 0) { const int c = colt + bj * HALF + wc * 32 + 8 * fq + 4 * n;
                        float* dst = KM + ((size_t)((b * 8 + (c >> 7)) * 8 + blk)) * 128 + (c & 127);
#pragma unroll
                        for (int e = 0; e < 4; ++e) atomicAdd(dst + e, s[e] * oscale); } }
        }
    }
};
struct EpiStore {
    static constexpr bool PERM = true, AFTER_DRAIN = false, MIDK = false;
    bf16_t* O; int ldc;
    __device__ __forceinline__ void operator()(const f32x4 (&acc)[2][2][4][2], const Unit& u, int wr, int wc, int fr, int fq) const {
        { const int l_ = (int)__builtin_amdgcn_mbcnt_hi(~0u, __builtin_amdgcn_mbcnt_lo(~0u, 0u)); fr = l_ & 15; fq = l_ >> 4; }
        const int row0 = u.pm * BM + wr * 64 + fr, col0 = u.pn * BM + wc * 32 + 8 * fq;
#pragma unroll
        for (int ai = 0; ai < 2; ++ai)
#pragma unroll
            for (int m = 0; m < 4; ++m) { bf16_t* rowp = O + (size_t)(row0 + ai * HALF + m * 16) * ldc + col0;
#pragma unroll
                for (int bj = 0; bj < 2; ++bj) *(u32x4*)(rowp + bj * HALF) = pack8(acc[ai][bj][m][0], acc[ai][bj][m][1]); }
    }
};
struct EpiMerge2 {
    static constexpr bool PERM = true, AFTER_DRAIN = false, MIDK = true;
    const bf16_t* SG; bf16_t* MG; float mgscale;
    __device__ __forceinline__ void midk(f32x4 (&acc)[2][2][4][2], const Unit& u, int wr, int wc, int fr, int fq) const {
        int row0 = u.pm * BM + wr * 64 + fr, col0 = u.pn * BM + wc * 32 + 8 * fq;
        asm volatile("" : "+v"(row0), "+v"(col0));
#pragma unroll
        for (int ai = 0; ai < 2; ++ai)
#pragma unroll
            for (int m = 0; m < 4; ++m) { const size_t row = (size_t)(row0 + ai * HALF + m * 16);
#pragma unroll
                for (int bj = 0; bj < 2; ++bj) { const int col = col0 + bj * HALF;
                    const u32x4 g0 = *(const u32x4*)(SG + row * 4096 + col), g1 = *(const u32x4*)(SG + row * 4096 + 2048 + col);
                    const f32x4 n0 = bf4_lo(g0.x, g0.y), n1 = bf4_lo(g0.z, g0.w), d0 = bf4_lo(g1.x, g1.y), d1 = bf4_lo(g1.z, g1.w);
#pragma unroll
                    for (int e2 = 0; e2 < 4; ++e2) { acc[ai][bj][m][0][e2] *= n0[e2] * __builtin_amdgcn_rcpf(fmaxf(d0[e2], 1e-18f)); acc[ai][bj][m][1][e2] *= n1[e2] * __builtin_amdgcn_rcpf(fmaxf(d1[e2], 1e-18f)); } } }
    }
    __device__ __forceinline__ void operator()(const f32x4 (&acc)[2][2][4][2], const Unit& u, int wr, int wc, int fr, int fq) const {
        { const int l_ = (int)__builtin_amdgcn_mbcnt_hi(~0u, __builtin_amdgcn_mbcnt_lo(~0u, 0u)); fr = l_ & 15; fq = l_ >> 4; }
        const int row0 = u.pm * BM + wr * 64 + fr, col0 = u.pn * BM + wc * 32 + 8 * fq;
#pragma unroll
        for (int ai = 0; ai < 2; ++ai)
#pragma unroll
            for (int m = 0; m < 4; ++m) { const size_t row = (size_t)(row0 + ai * HALF + m * 16);
#pragma unroll
                for (int bj = 0; bj < 2; ++bj) { const int col = col0 + bj * HALF;
                    const u32x4 g1 = *(const u32x4*)(SG + row * 4096 + 2048 + col);
                    const f32x4 v0 = acc[ai][bj][m][0] * bf4_lo(g1.x, g1.y) * mgscale, v1 = acc[ai][bj][m][1] * bf4_lo(g1.z, g1.w) * mgscale;
                    int p0 = __builtin_amdgcn_cvt_pk_fp8_f32(c8(v0[0]), c8(v0[1]), 0, false); p0 = __builtin_amdgcn_cvt_pk_fp8_f32(c8(v0[2]), c8(v0[3]), p0, true);
                    int p1 = __builtin_amdgcn_cvt_pk_fp8_f32(c8(v1[0]), c8(v1[1]), 0, false); p1 = __builtin_amdgcn_cvt_pk_fp8_f32(c8(v1[2]), c8(v1[3]), p1, true);
                    *(unsigned long long*)((unsigned char*)MG + row * 2048 + col) = (unsigned long long)(unsigned)p0 | ((unsigned long long)(unsigned)p1 << 32); } }
    }
};
struct EpiResid {
    static constexpr bool PERM = true, AFTER_DRAIN = false, MIDK = false;
    const float* X; bf16_t* X1B; float* SSP; float oscale;
    __device__ __forceinline__ void operator()(const f32x4 (&acc)[2][2][4][2], const Unit& u, int wr, int wc, int fr, int fq) const {
        { const int l_ = (int)__builtin_amdgcn_mbcnt_hi(~0u, __builtin_amdgcn_mbcnt_lo(~0u, 0u)); fr = l_ & 15; fq = l_ >> 4; }
        const int row0 = u.pm * BM + wr * 64 + fr, col0 = u.pn * BM + wc * 32 + 8 * fq;
#pragma unroll
        for (int ai = 0; ai < 2; ++ai)
#pragma unroll
            for (int m = 0; m < 4; ++m) { const size_t row = (size_t)(row0 + ai * HALF + m * 16); float ss = 0.f;
#pragma unroll
                for (int bj = 0; bj < 2; ++bj) { const int col = col0 + bj * HALF; const float* xp = X + row * 2048 + col;
                    f32x4 v0 = acc[ai][bj][m][0] * oscale + *(const f32x4*)xp, v1 = acc[ai][bj][m][1] * oscale + *(const f32x4*)(xp + 4);
                    *(u32x4*)(X1B + row * 2048 + col) = pack8(v0, v1);
                    ss += (v0[0] * v0[0] + v0[1] * v0[1]) + (v0[2] * v0[2] + v0[3] * v0[3]) + (v1[0] * v1[0] + v1[1] * v1[1]) + (v1[2] * v1[2] + v1[3] * v1[3]); }
                ss += __shfl_xor(ss, 16); ss += __shfl_xor(ss, 32);
                if (fq == 0) SSP[row * 32 + u.pn * 4 + wc] = ss; }
    }
};
struct EpiRowScale {
    static constexpr bool PERM = true, AFTER_DRAIN = false, MIDK = false;
    const float* SSP; bf16_t* O;
    __device__ __forceinline__ void operator()(const f32x4 (&acc)[2][2][4][2], const Unit& u, int wr, int wc, int fr, int fq) const {
        { const int l_ = (int)__builtin_amdgcn_mbcnt_hi(~0u, __builtin_amdgcn_mbcnt_lo(~0u, 0u)); fr = l_ & 15; fq = l_ >> 4; }
        const int row0 = u.pm * BM + wr * 64 + fr, col0 = u.pn * BM + wc * 32 + 8 * fq;
#pragma unroll
        for (int ai = 0; ai < 2; ++ai)
#pragma unroll
            for (int m = 0; m < 4; ++m) { const size_t row = (size_t)(row0 + ai * HALF + m * 16);
                const f32x4 a = *(const f32x4*)(SSP + row * 32 + 8 * fq), b = *(const f32x4*)(SSP + row * 32 + 8 * fq + 4);
                float ss = (a[0] + a[1]) + (a[2] + a[3]) + (b[0] + b[1]) + (b[2] + b[3]);
                ss += __shfl_xor(ss, 16); ss += __shfl_xor(ss, 32);
                const float rs = __builtin_amdgcn_rsqf(ss * (1.f / 2048.f) + 1e-6f);
#pragma unroll
                for (int bj = 0; bj < 2; ++bj) *(u32x4*)(O + row * 2048 + col0 + bj * HALF) = pack8(acc[ai][bj][m][0] * rs, acc[ai][bj][m][1] * rs); }
    }
};
template <class Epi, class Sched, bool ALIGN_EPI = false, bool SP2 = false, bool FP8 = false>
__device__ __forceinline__ void gemm_phase(PG8_LAS unsigned char* lds, const Gemm g, const Sched& S, const Epi& E) {
    const int tid = threadIdx.x, wid = __builtin_amdgcn_readfirstlane(tid >> 6), lane = tid & 63, wr = wid >> 2, wc = wid & 3, fr = lane & 15, fq = lane >> 4;
    const int K = g.K, nt = K / BK;
    const __amdgpu_buffer_rsrc_t rsrc = __builtin_amdgcn_make_buffer_rsrc((void*)g.rbase, 0, (int)g.rbytes, 0x00020000);
    unsigned voffA[2], voffB[2];
#pragma unroll
    for (int i = 0; i < 2; ++i) { int R, C; stage_rc(tid * 16 + i * 8192, R, C); const int Rb = Epi::PERM ? ((R & ~31) + perm32(R & 31)) : R;
        voffA[i] = (unsigned)(R * K + C) * 2u; voffB[i] = (unsigned)(Rb * K + C) * 2u; }
    const size_t kstep = (size_t)(BK * 2);
    const size_t hstep = (size_t)HALF * K * 2;
    const size_t tstep = 2 * hstep;
    const unsigned ldsw = (unsigned)wid * 1024u;
    const int aoff = lds_byte(wr * 64 + fr, fq * 8), boff = lds_byte(wc * 32 + fr, fq * 8);
#define PG8_SA(b, h) (((b) * 2 + (h)) * HTB)
#define PG8_SB(b, h) ((4 + (b) * 2 + (h)) * HTB)
#define PG8_STAGE(bufoff, gbase, voff) do { const unsigned so_ = (unsigned)((const char*)(gbase) - (const char*)g.rbase); _Pragma("unroll") for (int _i = 0; _i < 2; ++_i) \
        __builtin_amdgcn_raw_ptr_buffer_load_lds(rsrc, (PG8_LAS unsigned*)(lds + (bufoff) + ldsw + _i * 8192), 16, (voff)[_i], so_, 0, 0); } while (0)
#define PG8_LDA(dst, b, h) do { _Pragma("unroll") for (int m = 0; m < 4; ++m) { const PG8_LAS unsigned char* p_ = lds + PG8_SA(b, h) + aoff + m * 2048; \
        if constexpr (FP8) dst##8[m] = cat8(*(const PG8_LAS bf16x8*)p_, *(const PG8_LAS bf16x8*)(p_ + 1024)); else { dst[m][0] = *(const PG8_LAS bf16x8*)p_; dst[m][1] = *(const PG8_LAS bf16x8*)(p_ + 1024); } } } while (0)
#define PG8_LDB(dst, b, h) do { _Pragma("unroll") for (int n = 0; n < 2; ++n) { const PG8_LAS unsigned char* p_ = lds + PG8_SB(b, h) + boff + n * 2048; \
        if constexpr (FP8) dst##8[n] = cat8(*(const PG8_LAS bf16x8*)p_, *(const PG8_LAS bf16x8*)(p_ + 1024)); else { dst[n][0] = *(const PG8_LAS bf16x8*)p_; dst[n][1] = *(const PG8_LAS bf16x8*)(p_ + 1024); } } } while (0)
#define PG8_MMA(ai, bj, At, Bt) do { __builtin_amdgcn_s_setprio(1); _Pragma("unroll") for (int m = 0; m < 4; ++m) _Pragma("unroll") for (int n = 0; n < 2; ++n) { \
        if constexpr (FP8) acc[ai][bj][m][n] = __builtin_amdgcn_mfma_scale_f32_16x16x128_f8f6f4(Bt##8[n], At##8[m], acc[ai][bj][m][n], 0, 0, 0, 0x7f7f7f7f, 0, 0x7f7f7f7f); \
        else { _Pragma("unroll") for (int k = 0; k < 2; ++k) acc[ai][bj][m][n] = __builtin_amdgcn_mfma_f32_16x16x32_bf16(Bt[n][k], At[m][k], acc[ai][bj][m][n], 0, 0, 0); } } __builtin_amdgcn_s_setprio(0); } while (0)
#define PG8_WAIT_V(n) asm volatile("s_waitcnt vmcnt(" #n ")" ::: "memory")
#define PG8_WAIT_L(n) asm volatile("s_waitcnt lgkmcnt(" #n ")" ::: "memory")
#define PG8_BAR __builtin_amdgcn_s_barrier()
#define PG8_SCHED __builtin_amdgcn_sched_barrier(0)
    Unit cur, nxt; int ui = 0;
    if (!S.next(0, cur)) return;
    f32x4 acc[2][2][4][2];
#pragma unroll
    for (int a = 0; a < 2; ++a)
#pragma unroll
        for (int b = 0; b < 2; ++b)
#pragma unroll
            for (int m = 0; m < 4; ++m)
#pragma unroll
                for (int n = 0; n < 2; ++n) acc[a][b][m][n] = (f32x4){0.f, 0.f, 0.f, 0.f};
    bf16x8 At[4][2], B0[2][2], B1[2][2];
    i32x8 At8[4], B08[2], B18[2];
    const char* cA = (const char*)(cur.sel ? g.A2 : g.A) + (size_t)cur.pm * tstep; const char* cB = (const char*)(cur.sel ? g.Bt2 : g.Bt) + (size_t)cur.pn * tstep;
    S.a_ready(cur);
    if constexpr (SP2) {
        PG8_STAGE(PG8_SB(0, 0), cB, voffB); PG8_STAGE(PG8_SB(0, 1), cB + hstep, voffB); PG8_STAGE(PG8_SA(0, 0), cA, voffA); PG8_STAGE(PG8_SA(0, 1), cA + hstep, voffA);
        if (wr == 1) PG8_BAR;
        PG8_WAIT_V(2); PG8_BAR;
        PG8_STAGE(PG8_SB(1, 0), cB + kstep, voffB); PG8_STAGE(PG8_SA(1, 0), cA + kstep, voffA); PG8_STAGE(PG8_SB(1, 1), cB + hstep + kstep, voffB);
        PG8_WAIT_V(6); PG8_BAR;
    } else {
        PG8_STAGE(PG8_SB(0, 0), cB, voffB); PG8_STAGE(PG8_SA(0, 0), cA, voffA); PG8_STAGE(PG8_SB(0, 1), cB + hstep, voffB); PG8_STAGE(PG8_SA(0, 1), cA + hstep, voffA);
        if (wr == 1) PG8_BAR;
        PG8_WAIT_V(4); PG8_BAR;
        PG8_STAGE(PG8_SB(1, 0), cB + kstep, voffB); PG8_STAGE(PG8_SA(1, 0), cA + kstep, voffA); PG8_STAGE(PG8_SB(1, 1), cB + hstep + kstep, voffB);
        PG8_WAIT_V(6); PG8_BAR;
    }
    for (;;) {
        const bool has_next = S.next(ui + 1, nxt);
        const char* nA = has_next ? (const char*)(nxt.sel ? g.A2 : g.A) + (size_t)nxt.pm * tstep : cA; const char* nB = has_next ? (const char*)(nxt.sel ? g.Bt2 : g.Bt) + (size_t)nxt.pn * tstep : cB;
        for (int t = 0; t < nt; t += 2) {
            if constexpr (Epi::MIDK) { if (t == nt / 2) E.midk(acc, cur, wr, wc, fr, fq); }
            const bool last = (t == nt - 2);
            const char* a1 = cA + (size_t)(t + 1) * kstep;
            const char* a2 = last ? nA : cA + (size_t)(t + 2) * kstep; const char* b2 = last ? nB : cB + (size_t)(t + 2) * kstep;
            const char* a3 = a2 + kstep; const char* b3 = b2 + kstep;
            if (last && has_next) S.a_ready(nxt);
            if constexpr (SP2) {
            PG8_LDB(B0, 0, 0); PG8_LDB(B1, 0, 1); PG8_SCHED; PG8_LDA(At, 0, 0); PG8_STAGE(PG8_SA(1, 1), a1 + hstep, voffA);
            PG8_WAIT_V(8); PG8_WAIT_L(0); PG8_BAR; PG8_MMA(0, 0, At, B0); PG8_MMA(0, 1, At, B1); PG8_BAR; PG8_SCHED;
            PG8_LDA(At, 0, 1); PG8_STAGE(PG8_SB(0, 0), b2, voffB); PG8_STAGE(PG8_SB(0, 1), b2 + hstep, voffB); PG8_STAGE(PG8_SA(0, 0), a2, voffA);
            PG8_WAIT_V(8); PG8_WAIT_L(0); PG8_BAR; PG8_MMA(1, 0, At, B0); PG8_MMA(1, 1, At, B1); PG8_BAR; PG8_SCHED;
            PG8_LDB(B0, 1, 0); PG8_LDB(B1, 1, 1); PG8_SCHED; PG8_LDA(At, 1, 0); PG8_STAGE(PG8_SA(0, 1), a2 + hstep, voffA);
            PG8_WAIT_V(8); PG8_WAIT_L(0); PG8_BAR; PG8_MMA(0, 0, At, B0); PG8_MMA(0, 1, At, B1); PG8_BAR; PG8_SCHED;
            PG8_LDA(At, 1, 1); PG8_STAGE(PG8_SB(1, 0), b3, voffB); PG8_STAGE(PG8_SB(1, 1), b3 + hstep, voffB); PG8_STAGE(PG8_SA(1, 0), a3, voffA);
            PG8_WAIT_V(8); PG8_WAIT_L(0); PG8_BAR; PG8_MMA(1, 0, At, B0); PG8_MMA(1, 1, At, B1); PG8_BAR; PG8_SCHED;
            } else {
            PG8_LDB(B0, 0, 0); PG8_SCHED; PG8_LDA(At, 0, 0); PG8_STAGE(PG8_SA(1, 1), a1 + hstep, voffA);
            PG8_WAIT_L(8); PG8_BAR; PG8_WAIT_L(0); PG8_MMA(0, 0, At, B0); PG8_BAR; PG8_SCHED;
            PG8_LDB(B1, 0, 1); PG8_STAGE(PG8_SB(0, 0), b2, voffB);
            PG8_BAR; PG8_WAIT_L(0); PG8_MMA(0, 1, At, B1); PG8_BAR;
            PG8_LDA(At, 0, 1); PG8_STAGE(PG8_SA(0, 0), a2, voffA);
            PG8_BAR; PG8_WAIT_L(0); PG8_MMA(1, 0, At, B0); PG8_BAR; PG8_SCHED;
            PG8_STAGE(PG8_SB(0, 1), b2 + hstep, voffB);
            PG8_WAIT_V(6); PG8_BAR; PG8_MMA(1, 1, At, B1); PG8_BAR;
            PG8_LDB(B0, 1, 0); PG8_SCHED; PG8_LDA(At, 1, 0); PG8_STAGE(PG8_SA(0, 1), a2 + hstep, voffA);
            PG8_WAIT_L(8); PG8_BAR; PG8_WAIT_L(0); PG8_MMA(0, 0, At, B0); PG8_BAR; PG8_SCHED;
            PG8_LDB(B1, 1, 1); PG8_STAGE(PG8_SB(1, 0), b3, voffB);
            PG8_BAR; PG8_WAIT_L(0); PG8_MMA(0, 1, At, B1); PG8_BAR;
            PG8_LDA(At, 1, 1); PG8_STAGE(PG8_SA(1, 0), a3, voffA);
            PG8_BAR; PG8_WAIT_L(0); PG8_MMA(1, 0, At, B0); PG8_BAR; PG8_SCHED;
            PG8_STAGE(PG8_SB(1, 1), b3 + hstep, voffB);
            PG8_WAIT_V(6); PG8_BAR; PG8_MMA(1, 1, At, B1); PG8_BAR;
            }
        }
        if constexpr (ALIGN_EPI) { if (wr == 0) PG8_BAR; }
        if constexpr (!Epi::AFTER_DRAIN) { E(acc, cur, wr, wc, fr, fq); S.done(cur); }
        if (!has_next) break;
#pragma unroll
        for (int a = 0; a < 2; ++a)
#pragma unroll
            for (int b = 0; b < 2; ++b)
#pragma unroll
                for (int m = 0; m < 4; ++m)
#pragma unroll
                    for (int n = 0; n < 2; ++n) acc[a][b][m][n] = (f32x4){0.f, 0.f, 0.f, 0.f};
        cur = nxt; cA = nA; cB = nB; ++ui;
        if constexpr (ALIGN_EPI) { if (wr == 1) PG8_BAR; }
    }
    PG8_WAIT_V(0);
    if constexpr (!ALIGN_EPI) { if (wr == 0) PG8_BAR; }
    PG8_BAR;
    if constexpr (Epi::AFTER_DRAIN) { E.fused(acc, cur, wr, wc, fr, fq, lds, wid, lane); S.done(cur); }
#undef PG8_SA
#undef PG8_SB
#undef PG8_STAGE
#undef PG8_LDA
#undef PG8_LDB
#undef PG8_MMA
#undef PG8_WAIT_V
#undef PG8_WAIT_L
#undef PG8_BAR
#undef PG8_SCHED
}
}
#define GAS __attribute__((address_space(1)))
#define LAS __attribute__((address_space(3)))
typedef unsigned short bf16;
typedef unsigned v4u __attribute__((ext_vector_type(4)));
typedef float f32x4 __attribute__((ext_vector_type(4)));
typedef short bf16x8 __attribute__((ext_vector_type(8)));
typedef GAS unsigned gu32;
typedef GAS unsigned long long gu64;
#define RLX_AGENT __ATOMIC_RELAXED, __HIP_MEMORY_SCOPE_AGENT
#define LDS_WAIT() asm volatile("s_waitcnt lgkmcnt(0)" ::: "memory")
#define VM_WAIT() asm volatile("s_waitcnt vmcnt(0)" ::: "memory")
__device__ __forceinline__ unsigned long long rt() { return __builtin_amdgcn_s_memrealtime(); }
__device__ __forceinline__ unsigned f2bf(float f) { unsigned u = __builtin_bit_cast(unsigned, f); return (u + 0x7fffu + ((u >> 16) & 1u)) >> 16; }
__device__ __forceinline__ unsigned pk2(float lo, float hi) { return f2bf(lo) | (f2bf(hi) << 16); }

#define XB_TMO      128
#define XB_XCNT(j)  (256  + 64 * (j))
#define XB_XSUB(j)  (1280 + 64 * (j))
#define XB_XGEN(j)  (2304 + 64 * (j))
#define XB_TOP      3328
#define XB_TOPGEN   3392
#define XCD_BAR_WORDS 3456
#define XB_SPIN_CAP (1u << 18)

__device__ __forceinline__ unsigned xb_ld(unsigned* p)              { return __hip_atomic_load(p, __ATOMIC_RELAXED, __HIP_MEMORY_SCOPE_AGENT); }
__device__ __forceinline__ unsigned xb_add(unsigned* p, unsigned v) { return __hip_atomic_fetch_add(p, v, __ATOMIC_RELAXED, __HIP_MEMORY_SCOPE_AGENT); }
__device__ __forceinline__ unsigned xb_xcc_id() { return (unsigned)__builtin_amdgcn_s_getreg((3 << 11) | 20) & 0xFu; }
#define XB_SPIN(cond, bar) do { unsigned _sp = 0; while (cond) { __builtin_amdgcn_s_sleep(1); \
    if ((++_sp & 255u) == 0u) { if (xb_ld(&(bar)[XB_TMO])) break; if (_sp > XB_SPIN_CAP) { atomicAdd(&(bar)[XB_TMO], 1u); break; } } } } while (0)

struct XcdBarrier {
    unsigned* bar; unsigned x;
    volatile LAS unsigned* st;
};

__device__ __forceinline__ XcdBarrier xcd_barrier_post(unsigned* bar, volatile LAS unsigned* st) {
    XcdBarrier b; b.bar = bar; b.x = xb_xcc_id(); b.st = st;
    if (threadIdx.x == 0) (void)xb_add(&bar[XB_XCNT(b.x)], 1u);
    return b;
}
__device__ __forceinline__ void xcd_barrier_complete(unsigned* bar, unsigned x, unsigned& nloc, unsigned& nx) {
    const unsigned G = gridDim.x * gridDim.y * gridDim.z;
    unsigned sum, cnt, mine, sp = 0u;
    for (;;) {
        sum = 0u; cnt = 0u; mine = 0u;
#pragma unroll
        for (unsigned j = 0; j < 16; ++j) { const unsigned c = xb_ld(&bar[XB_XCNT(j)]); sum += c; cnt += (c > 0u) ? 1u : 0u; mine = (j == x) ? c : mine; }
        if (sum == G) break;
        __builtin_amdgcn_s_sleep(1);
        if ((++sp & 255u) == 0u) { if (xb_ld(&bar[XB_TMO])) break; if (sp > XB_SPIN_CAP) { atomicAdd(&bar[XB_TMO], 1u); break; } }
    }
    nloc = mine > 0u ? mine : 1u; nx = cnt > 0u ? cnt : 1u;
}

__device__ __forceinline__ void xcd_barrier(const XcdBarrier& b) {
    asm volatile("s_waitcnt vmcnt(0)" ::: "memory");
    __syncthreads();
    if (threadIdx.x == 0) {
        unsigned* bar = b.bar;
        __builtin_amdgcn_s_waitcnt(0);
        unsigned nloc = b.st[0], nx = b.st[1];
        if (nloc == 0u) { xcd_barrier_complete(bar, b.x, nloc, nx); b.st[0] = nloc; b.st[1] = nx; }
        const unsigned old = xb_add(&bar[XB_XSUB(b.x)], 1u);
        const unsigned gen = old / nloc;
        if (old + 1u == (gen + 1u) * nloc) {
            __builtin_amdgcn_fence(__ATOMIC_RELEASE, "agent");
            asm volatile("s_waitcnt vmcnt(0)" ::: "memory");
            const unsigned og = xb_add(&bar[XB_TOP], 1u);
            const unsigned tg = og / nx;
            if (og + 1u == (tg + 1u) * nx) xb_add(&bar[XB_TOPGEN], 1u);
            else XB_SPIN(xb_ld(&bar[XB_TOPGEN]) == tg, bar);
            __builtin_amdgcn_fence(__ATOMIC_ACQUIRE, "agent");
            xb_add(&bar[XB_XGEN(b.x)], 1u);
            asm volatile("s_waitcnt vmcnt(0)" ::: "memory");
        } else {
            XB_SPIN(xb_ld(&bar[XB_XGEN(b.x)]) == gen, bar);
            __builtin_amdgcn_fence(__ATOMIC_ACQUIRE, "agent");
            asm volatile("s_waitcnt vmcnt(0)" ::: "memory");
        }
    }
    __syncthreads();
}

constexpr int NWAVES = 8;
constexpr int T_TOK = 8192, DM = 2048, AW = 1024, SEQ = 2048, NHEAD = 8;
constexpr int NWA = 8192;
constexpr int NEXP = 16384;
constexpr float RMS_EPS = 1e-6f, LOG2E = 1.4426950408889634f;
constexpr float W8SCALE = 64.f;
constexpr float OC8SCALE = 8.f, WB8SCALE = 32.f;
constexpr float MG8SCALE = 16.f;
constexpr float QSCALE = 0.08838834764831845f * 1.4426950408889634f;

constexpr size_t MiB = 1u << 20;
constexpr size_t WS_CTL = 0, CTL_ZERO_BYTES = 1 * MiB;
constexpr size_t WS_WA = 2 * MiB;
constexpr size_t WS_WV = 34 * MiB;
constexpr size_t WS_WB = 38 * MiB;
constexpr size_t WS_WO = 46 * MiB;
constexpr size_t WS_WQ = 54 * MiB;
constexpr size_t WS_LWA = 62 * MiB;
constexpr size_t WS_LWX = 62 * MiB + 256 * 1024;
constexpr size_t WS_KEYS = 62 * MiB + 512 * 1024;
constexpr size_t WS_U8 = 64 * MiB;
constexpr size_t WS_V8 = 96 * MiB;
constexpr size_t WS_US = 128 * MiB;
constexpr size_t WS_VS = 128 * MiB + 65536;
constexpr size_t WS_HN = 192 * MiB;
constexpr size_t WS_X1B = WS_HN;
constexpr size_t WS_Q = 224 * MiB;
constexpr size_t WS_K = 240 * MiB;
constexpr size_t WS_VT = 256 * MiB;
constexpr size_t WS_XR = 272 * MiB;
constexpr size_t WS_GY = 288 * MiB;
constexpr size_t WS_SG = 304 * MiB;
constexpr size_t WS_QP = WS_SG;
constexpr size_t WS_OCAT = 368 * MiB;
constexpr size_t WS_HL = 400 * MiB;
constexpr size_t WS_AC = 432 * MiB;
constexpr size_t WS_TMP = WS_HL;
constexpr size_t WS_SUM = 464 * MiB;
constexpr size_t WS_MG = 466 * MiB;
constexpr size_t WS_SSP = 498 * MiB;
constexpr size_t WS_IDX = 500 * MiB;
constexpr size_t WS_G = 504 * MiB;
constexpr size_t WS_PD = WS_Q;
constexpr size_t WS_ACT = WS_VT;
constexpr size_t WS_OUTP = WS_HL;
constexpr size_t WS_END = 508 * MiB;
constexpr int CW_BAR = 4096;
constexpr int CW_XC = 12288;
constexpr int CW_Q2 = 8192;
constexpr int CW_KM = 65536;
static_assert((CW_KM + 32768) * 4 <= (int)CTL_ZERO_BYTES, "CTL");

constexpr int LDS_BYTES = 163840;
constexpr int MISC_OFF = 163840 - 256;
constexpr int SCR_BYTES = MISC_OFF;

typedef float f32x16 __attribute__((ext_vector_type(16)));
typedef float f32x2_t __attribute__((ext_vector_type(2)));
typedef __bf16 bf16x2_t __attribute__((ext_vector_type(2)));
typedef unsigned long long u64;
__device__ __forceinline__ float clamp8(float v) { return fminf(fmaxf(v, -448.f), 448.f); }
__device__ __forceinline__ unsigned cvtpk(float lo, float hi) { f32x2_t v = {lo, hi}; bf16x2_t b = __builtin_convertvector(v, bf16x2_t); return __builtin_bit_cast(unsigned, b); }
__device__ __forceinline__ float bf_lo(unsigned w) { return __builtin_bit_cast(float, w << 16); }
__device__ __forceinline__ float bf_hi(unsigned w) { return __builtin_bit_cast(float, w & 0xffff0000u); }
__device__ __forceinline__ f32x4 bf4_lo2(unsigned a, unsigned b) { f32x4 r; r[0] = bf_lo(a); r[1] = bf_hi(a); r[2] = bf_lo(b); r[3] = bf_hi(b); return r; }
__device__ __forceinline__ float wave_sum(float v) {
#pragma unroll
    for (int o = 1; o < 64; o <<= 1) v += __shfl_xor(v, o);
    return v;
}
__device__ __forceinline__ float dot2bf(unsigned a, unsigned b, float acc) { return __builtin_amdgcn_fdot2_f32_bf16(__builtin_bit_cast(bf16x2_t, a), __builtin_bit_cast(bf16x2_t, b), acc, false); }

struct Params {
    const float *x, *g_mix, *w_in, *conv_w, *conv_b, *lru_wa, *lru_ba, *lru_wx, *lru_bx, *lru_lam, *w_branch, *w_out, *rel_bias, *g_ffn, *peer_wq, *peer_keys, *peer_u, *peer_v, *g_fin;
    float* out; unsigned char* ws; int ph_lo, ph_hi;
};

struct TrD { const float* W; const float* ks; unsigned char* d; int N, k0, n0, ldd; float sc; bool f8; };
__device__ __forceinline__ void tr_load(const TrD& t, int lane, f32x4 (&wv)[8]) {
#pragma unroll
    for (int i = 0; i < 8; ++i) wv[i] = *(const f32x4*)(t.W + (size_t)(t.k0 + (lane >> 3) + 8 * i) * t.N + t.n0 + 4 * (lane & 7));
}
__device__ __forceinline__ void tr_finish(const TrD& t, f32x4 (&wv)[8], LAS float* scr, int lane) {
#pragma unroll
    for (int i = 0; i < 8; ++i) { const int kk = (lane >> 3) + 8 * i; f32x4 v = wv[i]; if (t.ks) v = v * t.ks[t.k0 + kk];
#pragma unroll
        for (int e = 0; e < 4; ++e) scr[kk * 33 + 4 * (lane & 7) + e] = v[e]; }
    LDS_WAIT(); asm volatile("" ::: "memory");
    const int c = lane & 7; const float f8scale = t.sc;
#pragma unroll
    for (int j = 0; j < 4; ++j) { const int n = (lane >> 3) + 8 * j; const LAS float* s = scr + (8 * c) * 33 + n;
        if (t.f8) {
            int p0 = __builtin_amdgcn_cvt_pk_fp8_f32(clamp8(s[0 * 33] * f8scale), clamp8(s[1 * 33] * f8scale), 0, false); p0 = __builtin_amdgcn_cvt_pk_fp8_f32(clamp8(s[2 * 33] * f8scale), clamp8(s[3 * 33] * f8scale), p0, true);
            int p1 = __builtin_amdgcn_cvt_pk_fp8_f32(clamp8(s[4 * 33] * f8scale), clamp8(s[5 * 33] * f8scale), 0, false); p1 = __builtin_amdgcn_cvt_pk_fp8_f32(clamp8(s[6 * 33] * f8scale), clamp8(s[7 * 33] * f8scale), p1, true);
            *(u64*)(t.d + (size_t)n * t.ldd + t.k0 + 8 * c) = (u64)(unsigned)p0 | ((u64)(unsigned)p1 << 32);
        } else {
        v4u o; o.x = cvtpk(s[0 * 33], s[1 * 33]); o.y = cvtpk(s[2 * 33], s[3 * 33]); o.z = cvtpk(s[4 * 33], s[5 * 33]); o.w = cvtpk(s[6 * 33], s[7 * 33]);
        *(v4u*)(t.d + (size_t)n * t.ldd + 2 * (t.k0 + 8 * c)) = o; } }
    LDS_WAIT(); asm volatile("" ::: "memory");
}
template <int MODE> __device__ __forceinline__ void row_to_bf16(const float* src, bf16* dst, const float* colscale, int lane) {
    const f32x4* s = (const f32x4*)src + lane;
    f32x4 v[8]; float ss = 0.f;
#pragma unroll
    for (int j = 0; j < 8; ++j) { v[j] = s[64 * j]; ss += (v[j][0] * v[j][0] + v[j][1] * v[j][1]) + (v[j][2] * v[j][2] + v[j][3] * v[j][3]); }
    float rs = 1.f;
    if (MODE == 1) rs = __builtin_amdgcn_rsqf(wave_sum(ss) * (1.f / 2048.f) + RMS_EPS);
    u64* o8 = (u64*)dst + lane;
#pragma unroll
    for (int j = 0; j < 8; ++j) { f32x4 w = v[j] * rs; if (colscale) w = w * ((const f32x4*)colscale)[64 * j + lane];
        o8[64 * j] = (u64)cvtpk(w[0], w[1]) | ((u64)cvtpk(w[2], w[3]) << 32); }
}
template <bool I8> __device__ __forceinline__ void row_finish8(f32x4 (&v)[8], unsigned char* dst, float* scale_out, int lane) {
    float am = 0.f;
#pragma unroll
    for (int j = 0; j < 8; ++j) am = fmaxf(am, fmaxf(fmaxf(fabsf(v[j][0]), fabsf(v[j][1])), fmaxf(fabsf(v[j][2]), fabsf(v[j][3]))));
#pragma unroll
    for (int o = 1; o < 64; o <<= 1) am = fmaxf(am, __shfl_xor(am, o));
    const float qmax = I8 ? 127.f : 448.f;
    const float sc = am > 0.f ? am / qmax : 1.f, inv = 1.f / sc;
    unsigned* o4 = (unsigned*)(dst + (size_t)(lane >> 5) * NEXP * 128) + (lane & 31);
#pragma unroll
    for (int j = 0; j < 8; ++j) { unsigned w;
        if (I8) { const int q0 = (int)rintf(v[j][0] * inv), q1 = (int)rintf(v[j][1] * inv), q2 = (int)rintf(v[j][2] * inv), q3 = (int)rintf(v[j][3] * inv);
            w = (unsigned)(q0 & 255) | ((unsigned)(q1 & 255) << 8) | ((unsigned)(q2 & 255) << 16) | ((unsigned)q3 << 24); }
        else { int p = __builtin_amdgcn_cvt_pk_fp8_f32(v[j][0] * inv, v[j][1] * inv, 0, false); p = __builtin_amdgcn_cvt_pk_fp8_f32(v[j][2] * inv, v[j][3] * inv, p, true); w = (unsigned)p; }
        o4[(size_t)(2 * j) * NEXP * 32] = w; }
    if (lane == 0) *scale_out = sc;
}
template <bool I8, int NR = 2> __device__ __forceinline__ void table_rows8(const float* src, unsigned char* dst, float* scales, const float* colscale, int r0, int r1, int wv, int nwv, int lane) {
    f32x4 cs[8];
#pragma unroll
    for (int j = 0; j < 8; ++j) cs[j] = colscale ? ((const f32x4*)colscale)[64 * j + lane] : (f32x4){1.f, 1.f, 1.f, 1.f};
    for (int m = r0 + wv; m < r1; m += NR * nwv) {
        f32x4 v[NR][8];
#pragma unroll
        for (int q = 0; q < NR; ++q) { const int mq = m + q * nwv; if (mq < r1) {
#pragma unroll
            for (int j = 0; j < 8; ++j) v[q][j] = ((const f32x4*)(src + (size_t)mq * DM))[64 * j + lane]; } }
#pragma unroll
        for (int q = 0; q < NR; ++q) { const int mq = m + q * nwv; if (mq < r1) {
            if (colscale) {
#pragma unroll
                for (int j = 0; j < 8; ++j) v[q][j] = v[q][j] * cs[j]; }
            row_finish8<I8>(v[q], dst + (size_t)mq * 128, scales + mq, lane); } }
    }
}
template <int NR> __device__ __forceinline__ void peer_table_u(const Params& P, int r0, int r1, int wv, int nwv, int lane) { table_rows8<true, NR>(P.peer_u, P.ws + WS_U8, (float*)(P.ws + WS_US), P.g_ffn, r0, r1, wv, nwv, lane); }
template <int NR> __device__ __forceinline__ void peer_table_v(const Params& P, int r0, int r1, int wv, int nwv, int lane) { table_rows8<false, NR>(P.peer_v, P.ws + WS_V8, (float*)(P.ws + WS_VS), nullptr, r0, r1, wv, nwv, lane); }
constexpr int TT_PITCH = 260;
constexpr int TT_IN = 16 * 36, TT_BR = 2 * 8 * 8, TT_SQ = 16 * 8, TT_N = TT_IN + TT_BR + 2 * TT_SQ;
static_assert(128 * TT_PITCH * 4 <= MISC_OFF, "transpose tile");
__device__ __forceinline__ TrD tt_decode(const Params& P, int T) {
    unsigned char* ws = P.ws;
    TrD t; t.ks = nullptr; t.f8 = true; t.ldd = 2048; t.sc = W8SCALE;
    if (T < TT_IN) { const int kt = T / 36, nt = T % 36, n0 = 256 * nt; t.W = P.w_in; t.N = 9216; t.k0 = 128 * kt; t.n0 = n0;
        t.d = (n0 < 2048) ? ws + WS_WA + (size_t)n0 * 2048 : (n0 < 3072 ? ws + WS_WV + (size_t)(n0 - 2048) * 2048 : ws + WS_WA + (size_t)(n0 - 1024) * 2048); return t; } T -= TT_IN;
    if (T < TT_BR) { const int br = T / 64, q = T % 64, kt = q / 8, nt = q % 8; t.W = P.w_branch + (size_t)br * 1024 * 2048; t.N = 2048; t.k0 = 128 * kt; t.n0 = 256 * nt; t.sc = WB8SCALE;
        t.d = ws + WS_WB + (size_t)(256 * nt) * 2048 + br * 1024; return t; } T -= TT_BR;
    if (T < TT_SQ) { const int kt = T / 8, nt = T % 8; t.W = P.w_out; t.N = 2048; t.k0 = 128 * kt; t.n0 = 256 * nt; t.d = ws + WS_WO + (size_t)(256 * nt) * 2048; return t; } T -= TT_SQ;
    { const int kt = T / 8, nt = T % 8; t.f8 = false; t.sc = 1.f; t.W = P.peer_wq; t.N = 2048; t.k0 = 128 * kt; t.n0 = 256 * nt; t.ks = P.g_ffn; t.ldd = 4096; t.d = ws + WS_WQ + (size_t)(256 * nt) * 4096; return t; }
}
__device__ __forceinline__ void tt_load(const TrD& t, int wave, int lane, f32x4 (&v)[16]) {
#pragma unroll
    for (int i = 0; i < 16; ++i) v[i] = *(const f32x4*)(t.W + (size_t)(t.k0 + 16 * wave + i) * t.N + t.n0 + 4 * lane);
}
__device__ __forceinline__ void tt_to_lds(const TrD& t, LAS float* tile, int wave, int lane, f32x4 (&v)[16]) {
#pragma unroll
    for (int i = 0; i < 16; ++i) { f32x4 w = v[i] * t.sc; if (t.ks) w = w * t.ks[t.k0 + 16 * wave + i]; *(LAS f32x4*)(tile + (16 * wave + i) * TT_PITCH + 4 * lane) = w; }
}
__device__ __forceinline__ void tt_emit(const TrD& t, const LAS float* tile, int tid) {
    const int n = tid & 255, kh = tid >> 8; const LAS float* s = tile + (64 * kh) * TT_PITCH + n;
    if (t.f8) { unsigned char* o = t.d + (size_t)n * t.ldd + t.k0 + 64 * kh;
#pragma unroll
        for (int q = 0; q < 4; ++q) { v4u w;
#pragma unroll
            for (int e = 0; e < 4; ++e) { const LAS float* z = s + (16 * q + 4 * e) * TT_PITCH;
                int pk = __builtin_amdgcn_cvt_pk_fp8_f32(clamp8(z[0]), clamp8(z[TT_PITCH]), 0, false); pk = __builtin_amdgcn_cvt_pk_fp8_f32(clamp8(z[2 * TT_PITCH]), clamp8(z[3 * TT_PITCH]), pk, true); w[e] = (unsigned)pk; }
            *(v4u*)(o + 16 * q) = w; }
    } else { unsigned char* o = t.d + (size_t)n * t.ldd + 2 * (t.k0 + 64 * kh);
#pragma unroll
        for (int q = 0; q < 8; ++q) { v4u w;
#pragma unroll
            for (int e = 0; e < 4; ++e) { const LAS float* z = s + (8 * q + 2 * e) * TT_PITCH; w[e] = cvtpk(z[0], z[TT_PITCH]); }
            *(v4u*)(o + 16 * q) = w; } }
}
__device__ __forceinline__ TrD tr_decode_lru(const Params& P, int r) {
    TrD t; t.ks = nullptr; t.f8 = false; t.sc = 1.f;
    const int which = r / 64, q = r % 64, g = q / 8, kb = (q % 8) / 4, nb = q % 4;
    t.W = (which ? P.lru_wx : P.lru_wa) + (size_t)g * 16384; t.N = 128; t.k0 = 64 * kb; t.n0 = 32 * nb; t.ldd = 256; t.d = P.ws + (which ? WS_LWX : WS_LWA) + ((size_t)g * 16384 + (size_t)(32 * nb) * 128) * 2; return t;
}
__device__ __forceinline__ void p0_prologue(const Params& P, LAS unsigned char* lds, int gw, int NGW, int wave, int lane, int r1) {
    unsigned char* ws = P.ws;
    const int vcu = gw / NWAVES, G = NGW / NWAVES, tid = wave * 64 + lane;
    { LAS float* tile = (LAS float*)lds; f32x4 v[16];
      int T = vcu; TrD a = tt_decode(P, T < TT_N ? T : 0);
      if (T < TT_N) tt_load(a, wave, lane, v);
      while (T < TT_N) {
          tt_to_lds(a, tile, wave, lane, v);
          __syncthreads();
          const TrD cur = a; const int Tn = T + G;
          if (Tn < TT_N) { a = tt_decode(P, Tn); tt_load(a, wave, lane, v); }
          tt_emit(cur, tile, tid);
          __syncthreads();
          T = Tn; } }
    if (gw < 128) { LAS float* scr = (LAS float*)(lds + wave * 16384); TrD a = tr_decode_lru(P, gw); f32x4 wa[8]; tr_load(a, lane, wa); tr_finish(a, wa, scr, lane); }
#ifdef TPROBE
    *(volatile LAS unsigned*)(lds + MISC_OFF + 4 * 52) = (unsigned)__builtin_amdgcn_s_memrealtime();
#endif
    { bf16* KB = (bf16*)(ws + WS_KEYS);
      for (int i = gw * 64 + lane; i < 262144 / 8; i += NGW * 64) { const f32x4 a = ((const f32x4*)P.peer_keys)[2 * i], b = ((const f32x4*)P.peer_keys)[2 * i + 1];
          v4u o; o.x = cvtpk(a[0], a[1]); o.y = cvtpk(a[2], a[3]); o.z = cvtpk(b[0], b[1]); o.w = cvtpk(b[2], b[3]); ((v4u*)KB)[i] = o; } }
    { unsigned char* HN = ws + WS_HN;
      const int tq = TT_N / G, n_hi = TT_N - tq * G, W = (T_TOK + 16 * TT_N + G - 1) / G, r_hi = W - 16 * (tq + 1), r_lo = W - 16 * tq;
      int r0, cnt;
      if (r_hi >= 0 && n_hi * r_hi + (G - n_hi) * r_lo >= T_TOK) { r0 = vcu < n_hi ? vcu * r_hi : n_hi * r_hi + (vcu - n_hi) * r_lo; cnt = vcu < n_hi ? r_hi : r_lo; }
      else { const int per = (T_TOK + G - 1) / G; r0 = vcu * per; cnt = per; }
      const int rend = (r0 + cnt < T_TOK) ? r0 + cnt : T_TOK;
      for (int m = r0 + wave; m < rend; m += 4 * NWAVES) {
          f32x4 v[4][8];
#pragma unroll
          for (int q = 0; q < 4; ++q) { const int mq = m + q * NWAVES; if (mq < rend) {
#pragma unroll
              for (int j = 0; j < 8; ++j) v[q][j] = ((const f32x4*)(P.x + (size_t)mq * DM))[64 * j + lane]; } }
#pragma unroll
          for (int q = 0; q < 4; ++q) { const int mq = m + q * NWAVES; if (mq < rend) {
              float sa = 0.f;
#pragma unroll
              for (int j = 0; j < 8; ++j) sa += (v[q][j][0] * v[q][j][0] + v[q][j][1] * v[q][j][1]) + (v[q][j][2] * v[q][j][2] + v[q][j][3] * v[q][j][3]);
              const float ra = __builtin_amdgcn_rsqf(wave_sum(sa) * (1.f / 2048.f) + RMS_EPS);
              unsigned* oa = (unsigned*)(HN + (size_t)mq * DM) + lane;
#pragma unroll
              for (int j = 0; j < 8; ++j) { const f32x4 w = v[q][j] * ra * ((const f32x4*)P.g_mix)[64 * j + lane]; int p = __builtin_amdgcn_cvt_pk_fp8_f32(w[0], w[1], 0, false); p = __builtin_amdgcn_cvt_pk_fp8_f32(w[2], w[3], p, true); oa[64 * j] = (unsigned)p; } } } } }
    if (r1 > 0) { peer_table_u<2>(P, 0, r1, gw, NGW, lane); peer_table_v<2>(P, 0, r1, gw, NGW, lane); }
}

constexpr int AT_KT = 0, AT_VT = 2 * 17408, AT_KM = AT_VT + 2 * 18432, AT_B2 = AT_KM + 4096, AT_SEL = AT_B2 + 512, AT_ANY = AT_SEL + 1024;
#define MFMA32(a, b, c) __builtin_amdgcn_mfma_f32_32x32x16_bf16((a), (b), (c), 0, 0, 0)
__device__ __forceinline__ void attn_unit(const Params& P, LAS unsigned char* lds, int b, int h, int blk, int tid, int wave, int lane) {
    unsigned char* ws = P.ws;
    const bf16* Qb = (const bf16*)(ws + WS_Q); const bf16* Kb = (const bf16*)(ws + WS_K); const bf16* VTg = (const bf16*)(ws + WS_VT); bf16* OATT = (bf16*)(ws + WS_OCAT);
    const float* KMg = (const float*)(ws + WS_CTL) + CW_KM;
    LAS float* KMs = (LAS float*)(lds + AT_KM); LAS float* B2 = (LAS float*)(lds + AT_B2); LAS unsigned* SELM = (LAS unsigned*)(lds + AT_SEL); LAS unsigned* UANY = (LAS unsigned*)(lds + AT_ANY);
    const int row_blk0 = b * SEQ + blk * 256;
    __syncthreads();
    for (int i = tid; i < 1024; i += 512) KMs[i] = KMg[(size_t)(b * 8 + h) * 1024 + i] * (1.f / 256.f);
    if (tid < 128) { const int d = tid; int bucket = d;
        if (d >= 16) { bucket = 16 + (int)(__logf((float)d * (1.f / 16.f)) * (16.f / 2.0794415416798357f)); bucket = bucket > 31 ? 31 : bucket; }
        B2[d] = (P.rel_bias[bucket * 8 + h] - P.rel_bias[31 * 8 + h]) * LOG2E; }
    if (tid == 0) *UANY = 0u;
    __syncthreads();
    {
        const int qq = tid >> 1, q2 = tid & 1;
        unsigned mask = (1u << blk) - 1u;
        if (blk > 3) {
            const bf16* qrow = Qb + (size_t)(row_blk0 + qq) * AW + h * 128;
            v4u qv[8];
#pragma unroll
            for (int c8 = 0; c8 < 8; ++c8) qv[c8] = *(const v4u*)(qrow + 8 * (q2 + 2 * c8));
            float g0 = 0.f, g1 = 0.f, g2 = 0.f, g3 = 0.f, g4 = 0.f, g5 = 0.f, g6 = 0.f;
#pragma unroll
            for (int c8 = 0; c8 < 8; ++c8) { const float q[8] = {bf_lo(qv[c8].x), bf_hi(qv[c8].x), bf_lo(qv[c8].y), bf_hi(qv[c8].y), bf_lo(qv[c8].z), bf_hi(qv[c8].z), bf_lo(qv[c8].w), bf_hi(qv[c8].w)};
#pragma unroll
                for (int e = 0; e < 8; ++e) { const LAS float* km = KMs + 8 * (q2 + 2 * c8) + e;
                    g0 += q[e] * km[0]; g1 += q[e] * km[128]; g2 += q[e] * km[256]; g3 += q[e] * km[384]; g4 += q[e] * km[512]; g5 += q[e] * km[640]; g6 += q[e] * km[768]; } }
            g0 += __shfl_xor(g0, 1); g1 += __shfl_xor(g1, 1); g2 += __shfl_xor(g2, 1); g3 += __shfl_xor(g3, 1); g4 += __shfl_xor(g4, 1); g5 += __shfl_xor(g5, 1); g6 += __shfl_xor(g6, 1);
            const float NEGG = -3.0e38f;
            if (blk < 7) g6 = NEGG; if (blk < 6) g5 = NEGG; if (blk < 5) g4 = NEGG;
            mask = 0u;
#pragma unroll
            for (int s = 0; s < 3; ++s) { float best = g0; int bj = 0;
                if (g1 > best) { best = g1; bj = 1; } if (g2 > best) { best = g2; bj = 2; } if (g3 > best) { best = g3; bj = 3; }
                if (g4 > best) { best = g4; bj = 4; } if (g5 > best) { best = g5; bj = 5; } if (g6 > best) { best = g6; bj = 6; }
                mask |= 1u << bj;
                g0 = bj == 0 ? NEGG : g0; g1 = bj == 1 ? NEGG : g1; g2 = bj == 2 ? NEGG : g2; g3 = bj == 3 ? NEGG : g3; g4 = bj == 4 ? NEGG : g4; g5 = bj == 5 ? NEGG : g5; g6 = bj == 6 ? NEGG : g6; }
        }
        if (q2 == 0) { SELM[qq] = mask; __hip_atomic_fetch_or(UANY, mask, __ATOMIC_RELAXED, __HIP_MEMORY_SCOPE_WORKGROUP); }
    }
    __syncthreads();
    const unsigned uany = *UANY;
    unsigned blist = (unsigned)blk; int nb = 1;
    for (int j = blk - 1; j >= 0; --j) if ((uany >> j) & 1u) { blist |= (unsigned)j << (4 * nb); ++nb; }
    const int nsteps = 4 * nb;
    const int qi = 32 * wave + (lane & 31), hh = lane >> 5;
    const unsigned mymask = SELM[qi];
    bf16x8 Qf[8];
    { const bf16* qp = Qb + (size_t)(row_blk0 + qi) * AW + h * 128 + 8 * hh;
#pragma unroll
      for (int ks = 0; ks < 8; ++ks) Qf[ks] = *(const bf16x8*)(qp + 16 * ks); }
    float m_run = -1.0e30f, lsum = 0.f;
    f32x16 O[4];
#pragma unroll
    for (int dt = 0; dt < 4; ++dt)
#pragma unroll
        for (int r = 0; r < 16; ++r) O[dt][r] = 0.f;
    const int kkey0 = tid >> 4, kpart = tid & 15;
    const int vd0 = tid >> 3, vcc = tid & 7;
    const unsigned kl0 = kkey0 * 272 + kpart * 16, kl1 = kl0 + 32 * 272;
    const unsigned vl0 = vd0 * 144 + ((((vcc >> 2) * 2 + ((vcc & 3) >> 1)) * 2) * 16) + (vcc & 1) * 8, vl1 = vl0 + 64 * 144;
    v4u ka0, ka1, va0, va1, kb0, kb1, vb0, vb1;
#define AT_LOAD(s, k0, k1, v0, v1) do { const int j_ = (blist >> (4 * ((s) >> 2))) & 15, kt_ = (s) & 3; const size_t krow0 = (size_t)b * SEQ + j_ * 256 + kt_ * 64; \
        k0 = *(const v4u*)(Kb + (krow0 + kkey0) * AW + h * 128 + kpart * 8); k1 = *(const v4u*)(Kb + (krow0 + kkey0 + 32) * AW + h * 128 + kpart * 8); \
        v0 = *(const v4u*)(VTg + (size_t)(h * 128 + vd0) * T_TOK + krow0 + vcc * 8); v1 = *(const v4u*)(VTg + (size_t)(h * 128 + vd0 + 64) * T_TOK + krow0 + vcc * 8); } while (0)
#define AT_STORE(bufi, k0, k1, v0, v1) do { LAS unsigned char* KT_ = lds + AT_KT + (bufi) * 17408; LAS unsigned char* VT_ = lds + AT_VT + (bufi) * 18432; \
        *(LAS v4u*)(KT_ + kl0) = k0; *(LAS v4u*)(KT_ + kl1) = k1; \
        *(LAS u64*)(VT_ + vl0) = (u64)v0.x | ((u64)v0.y << 32); *(LAS u64*)(VT_ + vl0 + 16) = (u64)v0.z | ((u64)v0.w << 32); \
        *(LAS u64*)(VT_ + vl1) = (u64)v1.x | ((u64)v1.y << 32); *(LAS u64*)(VT_ + vl1 + 16) = (u64)v1.z | ((u64)v1.w << 32); } while (0)
    AT_LOAD(0, ka0, ka1, va0, va1); AT_STORE(0, ka0, ka1, va0, va1);
    if (1 < nsteps) AT_LOAD(1, ka0, ka1, va0, va1);
    if (2 < nsteps) AT_LOAD(2, kb0, kb1, vb0, vb1);
    for (int s = 0; s < nsteps; ++s) {
        const int j = (blist >> (4 * (s >> 2))) & 15, kt = s & 3;
        __syncthreads();
        if ((s & 1) == 0) { if (s + 1 < nsteps) AT_STORE((s + 1) & 1, ka0, ka1, va0, va1); if (s + 3 < nsteps) AT_LOAD(s + 3, ka0, ka1, va0, va1); }
        else              { if (s + 1 < nsteps) AT_STORE((s + 1) & 1, kb0, kb1, vb0, vb1); if (s + 3 < nsteps) AT_LOAD(s + 3, kb0, kb1, vb0, vb1); }
        const LAS unsigned char* KT = lds + AT_KT + (s & 1) * 17408; const LAS unsigned char* VTl = lds + AT_VT + (s & 1) * 18432;
        bool part;
        if (j == blk) part = (64 * kt <= 32 * wave + 31);
        else part = (__ballot((mymask >> j) & 1u) != 0ull);
        if (part) {
            f32x16 S0, S1;
#pragma unroll
            for (int r = 0; r < 16; ++r) { S0[r] = 0.f; S1[r] = 0.f; }
            const LAS unsigned char* kp = KT + (lane & 31) * 272 + hh * 16;
#pragma unroll
            for (int ks = 0; ks < 8; ++ks) { const bf16x8 a0 = *(const LAS bf16x8*)(kp + ks * 32), a1 = *(const LAS bf16x8*)(kp + 32 * 272 + ks * 32);
                S0 = MFMA32(a0, Qf[ks], S0); S1 = MFMA32(a1, Qf[ks], S1); }
            const bool sel = ((mymask >> j) & 1u) != 0u;
            float mx = -1.0e30f; bool ok_row = true;
            const int dmin = 32 * wave + 256 * (blk - j) - 64 * kt - 63;
            if (dmin < 113) {
                const int dbase = (j == blk) ? (qi - 64 * kt - 4 * hh) : (qi + 256 - 64 * kt - 4 * hh);
                const bool okrow = (j == blk) ? true : sel;
#pragma unroll
                for (int r = 0; r < 16; ++r) { const int kk = (r & 3) + 8 * (r >> 2);
                    { const int dist = dbase - kk; const int di = dist < 0 ? 0 : (dist > 127 ? 127 : dist); const float v = (okrow && dist >= 0) ? S0[r] + B2[di] : -1.0e30f; S0[r] = v; mx = fmaxf(mx, v); }
                    { const int dist = dbase - 32 - kk; const int di = dist < 0 ? 0 : (dist > 127 ? 127 : dist); const float v = (okrow && dist >= 0) ? S1[r] + B2[di] : -1.0e30f; S1[r] = v; mx = fmaxf(mx, v); } }
            } else {
                ok_row = sel || (j == blk);
#pragma unroll
                for (int r = 0; r < 16; ++r) mx = fmaxf(mx, fmaxf(S0[r], S1[r]));
                mx = ok_row ? mx : -1.0e30f;
            }
            mx = fmaxf(mx, __shfl_xor(mx, 32));
            const bool need = mx > m_run + 8.f;
            if (__any(need)) { const float m_new = need ? mx : m_run, alpha = __builtin_amdgcn_exp2f(m_run - m_new);
                m_run = m_new; lsum *= alpha;
#pragma unroll
                for (int dt = 0; dt < 4; ++dt)
#pragma unroll
                    for (int r = 0; r < 16; ++r) O[dt][r] *= alpha; }
            float ps = 0.f;
            const float m_eff = ok_row ? m_run : 1.0e30f;
#pragma unroll
            for (int r = 0; r < 16; ++r) { S0[r] = __builtin_amdgcn_exp2f(S0[r] - m_eff); S1[r] = __builtin_amdgcn_exp2f(S1[r] - m_eff); ps += S0[r] + S1[r]; }
            lsum += ps;
            bf16x8 Pf[2][2];
#pragma unroll
            for (int s2 = 0; s2 < 2; ++s2) {
                v4u p0, p1;
                p0.x = cvtpk(S0[8 * s2], S0[8 * s2 + 1]); p0.y = cvtpk(S0[8 * s2 + 2], S0[8 * s2 + 3]); p0.z = cvtpk(S0[8 * s2 + 4], S0[8 * s2 + 5]); p0.w = cvtpk(S0[8 * s2 + 6], S0[8 * s2 + 7]);
                p1.x = cvtpk(S1[8 * s2], S1[8 * s2 + 1]); p1.y = cvtpk(S1[8 * s2 + 2], S1[8 * s2 + 3]); p1.z = cvtpk(S1[8 * s2 + 4], S1[8 * s2 + 5]); p1.w = cvtpk(S1[8 * s2 + 6], S1[8 * s2 + 7]);
                Pf[0][s2] = __builtin_bit_cast(bf16x8, p0); Pf[1][s2] = __builtin_bit_cast(bf16x8, p1); }
            const LAS unsigned char* vp = VTl + (lane & 31) * 144 + hh * 16;
#pragma unroll
            for (int dt = 0; dt < 4; ++dt)
#pragma unroll
                for (int mt = 0; mt < 2; ++mt)
#pragma unroll
                    for (int s2 = 0; s2 < 2; ++s2) { const bf16x8 a = *(const LAS bf16x8*)(vp + dt * 32 * 144 + (mt * 2 + s2) * 32); O[dt] = MFMA32(a, Pf[mt][s2], O[dt]); }
        }
    }
#undef AT_LOAD
#undef AT_STORE
    const float ltot = lsum + __shfl_xor(lsum, 32), inv = 1.f / ltot;
    unsigned char* orow = (unsigned char*)OATT + (size_t)(row_blk0 + qi) * DM + h * 128 + 4 * hh;
    const float osc = inv * OC8SCALE;
#pragma unroll
    for (int dt = 0; dt < 4; ++dt)
#pragma unroll
        for (int g4 = 0; g4 < 4; ++g4) { int p = __builtin_amdgcn_cvt_pk_fp8_f32(clamp8(O[dt][4 * g4] * osc), clamp8(O[dt][4 * g4 + 1] * osc), 0, false); p = __builtin_amdgcn_cvt_pk_fp8_f32(clamp8(O[dt][4 * g4 + 2] * osc), clamp8(O[dt][4 * g4 + 3] * osc), p, true);
            *(unsigned*)(orow + 32 * dt + 8 * g4) = (unsigned)p; }
}
constexpr int LR_XC = 0, LR_SEG = 2 * 17408, LR_W = LR_SEG + 2 * 4096;
#define MFMA16(a, b, c) __builtin_amdgcn_mfma_f32_16x16x32_bf16((a), (b), (c), 0, 0, 0)
__device__ __forceinline__ void lru_pair(const Params& P, LAS unsigned char* lds, int pair, int tid, int wave, int lane, unsigned* tkword, int& tk_next) {
    unsigned char* ws = P.ws;
    const int grp = wave >> 2, wq = wave & 3, tg = tid & 255;
    const int unit = 2 * pair + grp, b = unit >> 8, g = (unit >> 5) & 7, c = unit & 31;
    const bf16* XR = (const bf16*)(ws + WS_XR); const bf16* LWA = (const bf16*)(ws + WS_LWA) + (size_t)g * 16384; const bf16* LWX = (const bf16*)(ws + WS_LWX) + (size_t)g * 16384;
    float* HL = (float*)(ws + WS_HL); float* AC = (float*)(ws + WS_AC); float* SUM = (float*)(ws + WS_SUM);
    LAS unsigned short* XC = (LAS unsigned short*)(lds + LR_XC + grp * 17408);
    LAS float* SEG = (LAS float*)(lds + LR_SEG + grp * 4096);
    LAS unsigned char* WL = lds + LR_W;
    const int t0 = c * 64; const size_t R0 = (size_t)b * SEQ + t0;
    __syncthreads();
    {
      v4u wv[8];
#pragma unroll
      for (int i = 0; i < 8; ++i) { const int q = tid + 512 * i, mat = q >> 11, row = (q >> 4) & 127, part = q & 15; wv[i] = *(const v4u*)((mat ? LWX : LWA) + row * 128 + part * 8); }
      const int cpart = tg & 15, C8 = g * 128 + 8 * cpart;
      f32x4 cw[4][2], cbv[2];
#pragma unroll
      for (int w = 0; w < 4; ++w) { cw[w][0] = *(const f32x4*)(P.conv_w + w * 1024 + C8); cw[w][1] = *(const f32x4*)(P.conv_w + w * 1024 + C8 + 4); }
      cbv[0] = *(const f32x4*)(P.conv_b + C8); cbv[1] = *(const f32x4*)(P.conv_b + C8 + 4);
#define LR_CONV_LOAD(xr, base) do { _Pragma("unroll") for (int i2 = 0; i2 < 2; ++i2) { const int tl = (tg >> 4) + 16 * ((base) + i2); \
          _Pragma("unroll") for (int w = 0; w < 4; ++w) { const int ts = t0 + tl - 3 + w; xr[i2][w] = (ts >= 0) ? *(const v4u*)(XR + ((size_t)b * SEQ + ts) * AW + C8) : (v4u){0u, 0u, 0u, 0u}; } } } while (0)
#define LR_CONV_DO(xr, base) do { _Pragma("unroll") for (int i2 = 0; i2 < 2; ++i2) { const int tl = (tg >> 4) + 16 * ((base) + i2); f32x4 y0 = cbv[0], y1 = cbv[1]; \
          _Pragma("unroll") for (int w = 0; w < 4; ++w) { y0 = y0 + bf4_lo2(xr[i2][w].x, xr[i2][w].y) * cw[w][0]; y1 = y1 + bf4_lo2(xr[i2][w].z, xr[i2][w].w) * cw[w][1]; } \
          v4u o; o.x = cvtpk(y0[0], y0[1]); o.y = cvtpk(y0[2], y0[3]); o.z = cvtpk(y1[0], y1[1]); o.w = cvtpk(y1[2], y1[3]); \
          *(LAS v4u*)((LAS unsigned char*)XC + tl * 272 + cpart * 16) = o; } } while (0)
      { v4u xr[2][4]; LR_CONV_LOAD(xr, 0);
#pragma unroll
        for (int i = 0; i < 8; ++i) { const int q = tid + 512 * i, mat = q >> 11, row = (q >> 4) & 127, part = q & 15; *(LAS v4u*)(WL + (mat * 128 + row) * 272 + part * 16) = wv[i]; }
        LR_CONV_DO(xr, 0); }
      { v4u xr[2][4]; LR_CONV_LOAD(xr, 2); LR_CONV_DO(xr, 2); }
#undef LR_CONV_LOAD
#undef LR_CONV_DO
    }
    __syncthreads();
    if (tid == 0) tk_next = (int)__hip_atomic_fetch_add(tkword, 1u, __ATOMIC_RELAXED, __HIP_MEMORY_SCOPE_AGENT);
    const int fr = lane & 15, fq = lane >> 4;
    float Ar[2][4][4], Hr[2][4][4], AE[2][4], HE[2][4];
#pragma unroll
    for (int nh = 0; nh < 2; ++nh) {
        f32x4 aA[4], aX[4];
#pragma unroll
        for (int nt = 0; nt < 4; ++nt) { aA[nt] = (f32x4){0.f, 0.f, 0.f, 0.f}; aX[nt] = (f32x4){0.f, 0.f, 0.f, 0.f}; }
#pragma unroll 1
        for (int ks = 0; ks < 4; ++ks) { const bf16x8 a = *(const LAS bf16x8*)((LAS unsigned char*)XC + (16 * wq + fr) * 272 + (32 * ks + 8 * fq) * 2);
#pragma unroll
            for (int nt = 0; nt < 4; ++nt) { const int wo = (64 * nh + 16 * nt + fr) * 272 + (32 * ks + 8 * fq) * 2;
                const bf16x8 ba = *(const LAS bf16x8*)(WL + wo), bx = *(const LAS bf16x8*)(WL + 128 * 272 + wo);
                aA[nt] = MFMA16(a, ba, aA[nt]); aX[nt] = MFMA16(a, bx, aX[nt]); } }
#pragma unroll
        for (int nt = 0; nt < 4; ++nt) { const int ch = 64 * nh + 16 * nt + fr, C = g * 128 + ch;
            const float ba = P.lru_ba[C], bx = P.lru_bx[C], lam = P.lru_lam[C];
            const float sp8 = 8.f * log1pf(__expf(-lam));
            float Ac = 1.f, Hc = 0.f;
#pragma unroll
            for (int r = 0; r < 4; ++r) { const int tok = 16 * wq + 4 * fq + r;
                const float rg = pg8::sigmoid_f(aA[nt][r] + ba), ig = pg8::sigmoid_f(aX[nt][r] + bx);
                const float log_a = -rg * sp8, a = __builtin_amdgcn_exp2f(log_a * 1.4426950408889634f);
                const float y = 2.f * log_a;
                const float em = (y > -0.25f) ? -y * (1.f + y * (0.5f + y * (0.16666667f + y * (0.041666668f + y * (0.0083333338f + y * 0.0013888889f))))) : 1.f - a * a;
                const float u = __builtin_amdgcn_sqrtf(em) * (ig * bf_lo((unsigned)XC[tok * 136 + ch]));
                Hc = a * Hc + u; Ac *= a; Ar[nh][nt][r] = Ac; Hr[nh][nt][r] = Hc; }
            float AI = Ac, HI = Hc;
            { const float Ap = __shfl_up(AI, 16), Hp = __shfl_up(HI, 16); if (fq >= 1) { HI = AI * Hp + HI; AI = AI * Ap; } }
            { const float Ap = __shfl_up(AI, 32), Hp = __shfl_up(HI, 32); if (fq >= 2) { HI = AI * Hp + HI; AI = AI * Ap; } }
            { const float Ap = __shfl_up(AI, 16), Hp = __shfl_up(HI, 16); AE[nh][nt] = fq >= 1 ? Ap : 1.f; HE[nh][nt] = fq >= 1 ? Hp : 0.f; }
            if (fq == 3) { SEG[(wq * 128 + ch) * 2] = AI; SEG[(wq * 128 + ch) * 2 + 1] = HI; } }
    }
    __syncthreads();
#pragma unroll
    for (int nh = 0; nh < 2; ++nh)
#pragma unroll
        for (int nt = 0; nt < 4; ++nt) { const int ch = 64 * nh + 16 * nt + fr, C = g * 128 + ch;
            float Aw = 1.f, Hw = 0.f;
#pragma unroll
            for (int w2 = 0; w2 < 3; ++w2) if (w2 < wq) { const float As = SEG[(w2 * 128 + ch) * 2], Hs = SEG[(w2 * 128 + ch) * 2 + 1]; Hw = As * Hw + Hs; Aw *= As; }
            const float hin = AE[nh][nt] * Hw + HE[nh][nt], ain = AE[nh][nt] * Aw;
            float* hl = HL + (R0 + 16 * wq + 4 * fq) * AW + C; float* ac = AC + (R0 + 16 * wq + 4 * fq) * AW + C;
#pragma unroll
            for (int r = 0; r < 4; ++r) { hl[(size_t)r * AW] = Ar[nh][nt][r] * hin + Hr[nh][nt][r]; ac[(size_t)r * AW] = Ar[nh][nt][r] * ain; }
            if (wq == 3 && fq == 3) { float* sm = SUM + ((size_t)(b * 32 + c) * 1024 + C) * 2; sm[0] = Ar[nh][nt][3] * ain; sm[1] = Ar[nh][nt][3] * hin + Hr[nh][nt][3]; } }
}

constexpr int SC_STR = 129, P7_SAB = 2 * 128 * SC_STR * 4, P7_IL = P7_SAB + 128 * 33 * 4, P7_CT = P7_IL + 128 * 34 * 2;
static_assert(P7_CT + 64 <= MISC_OFF, "P7 LDS map");
__device__ __forceinline__ unsigned ord_key(float v) { const unsigned u = __builtin_bit_cast(unsigned, v); return (u & 0x80000000u) ? ~u : (u | 0x80000000u); }
#define CE_DESC(x, y) do { const unsigned _x = (x), _y = (y); (x) = _x > _y ? _x : _y; (y) = _x > _y ? _y : _x; } while (0)
template <int B, int NA> __device__ __forceinline__ void sort16_desc(unsigned (&a)[NA]) {
#pragma unroll
    for (int k = 2; k <= 16; k <<= 1)
#pragma unroll
        for (int j = k >> 1; j > 0; j >>= 1)
#pragma unroll
            for (int i = 0; i < 16; ++i) { const int l = i ^ j; if (l > i) { if ((i & k) == 0) CE_DESC(a[B + i], a[B + l]); else CE_DESC(a[B + l], a[B + i]); } }
}
template <int A, int Bo, int NA, int NB> __device__ __forceinline__ void merge16_desc(unsigned (&a)[NA], const unsigned (&b)[NB]) {
#pragma unroll
    for (int i = 0; i < 16; ++i) a[A + i] = a[A + i] > b[Bo + 15 - i] ? a[A + i] : b[Bo + 15 - i];
#pragma unroll
    for (int j = 8; j > 0; j >>= 1)
#pragma unroll
        for (int i = 0; i < 16; ++i) { const int l = i ^ j; if (l > i) CE_DESC(a[A + i], a[A + l]); }
}
__device__ __forceinline__ void peer_topk_unit(const Params& P, LAS unsigned char* lds, int t0, int h, int tid, int wave, int lane) {
    unsigned char* ws = P.ws;
    const bf16* QP = (const bf16*)(ws + WS_QP); const bf16* KEYS = (const bf16*)(ws + WS_KEYS);
    int* IDX = (int*)(ws + WS_IDX); float* GW = (float*)(ws + WS_G);
    LAS float* SC = (LAS float*)lds; LAS float* SAB = (LAS float*)(lds + P7_SAB); LAS unsigned short* IL = (LAS unsigned short*)(lds + P7_IL); LAS unsigned char* CT = lds + P7_CT;
    __syncthreads();
    if (tid < 64) { int ia = 0, rem = tid; while (ia < 16 && rem >= 16 / (ia + 1)) { rem -= 16 / (ia + 1); ++ia; }
        CT[tid] = (unsigned char)(ia < 16 ? ia * 16 + rem : 255); }
    { const int mtile = wave & 3, c = wave >> 2, r31 = lane & 31, hh = lane >> 5;
      bf16x8 A[8];
      const bf16* qp = QP + (size_t)(t0 + 32 * mtile + r31) * DM + h * 256 + c * 128 + 8 * hh;
#pragma unroll
      for (int ks = 0; ks < 8; ++ks) A[ks] = *(const bf16x8*)(qp + 16 * ks);
#pragma unroll
      for (int nt = 0; nt < 4; ++nt) { f32x16 acc;
#pragma unroll
          for (int r = 0; r < 16; ++r) acc[r] = 0.f;
          const bf16* kp = KEYS + ((size_t)((h * 2 + c) * 128 + 32 * nt + r31)) * 128 + 8 * hh;
#pragma unroll
          for (int ks = 0; ks < 8; ++ks) { const bf16x8 bk = *(const bf16x8*)(kp + 16 * ks); acc = MFMA32(A[ks], bk, acc); }
#pragma unroll
          for (int r = 0; r < 16; ++r) { const int tok = 32 * mtile + (r & 3) + 8 * (r >> 2) + 4 * hh; SC[(c * 128 + tok) * SC_STR + 32 * nt + r31] = acc[r]; } } }
    __syncthreads();
    const int half = tid & 1, c = (tid >> 1) & 1, tok = tid >> 2;
    unsigned a[64];
    { const LAS float* sp = SC + (c * 128 + tok) * SC_STR + half * 64; const int rot = 8 * (2 * c + half);
#pragma unroll
      for (int i = 0; i < 64; ++i) { const int n = (i + rot) & 63; a[i] = (ord_key(sp[n]) & ~127u) | (unsigned)(127 - (half * 64 + n)); } }
    sort16_desc<0>(a); sort16_desc<16>(a); sort16_desc<32>(a); sort16_desc<48>(a);
    merge16_desc<0, 16>(a, a); merge16_desc<32, 48>(a, a); merge16_desc<0, 32>(a, a);
    { unsigned o[16];
#pragma unroll
      for (int j = 0; j < 16; ++j) o[j] = (unsigned)__shfl_xor((int)a[j], 1);
      merge16_desc<0, 0>(a, o); }
    if (half == 0) {
#pragma unroll
        for (int j = 0; j < 16; ++j) { const int n = 127 - (int)(a[j] & 127u); SAB[tok * 33 + c * 16 + j] = SC[(c * 128 + tok) * SC_STR + n]; IL[tok * 34 + c * 16 + j] = (unsigned short)n; } }
    __syncthreads();
    const int q = tid & 3;
    unsigned cd[16];
#pragma unroll
    for (int j = 0; j < 13; ++j) { const unsigned code = CT[q + 4 * j]; const float s = SAB[tok * 33 + ((code >> 4) & 15u)] + SAB[tok * 33 + 16 + (code & 15u)];
        cd[j] = code == 255u ? 0u : ((ord_key(s) & ~255u) | (255u - code)); }
    cd[13] = 0u; cd[14] = 0u; cd[15] = 0u;
    sort16_desc<0>(cd);
    { unsigned o[16];
#pragma unroll
      for (int j = 0; j < 16; ++j) o[j] = (unsigned)__shfl_xor((int)cd[j], 1);
      merge16_desc<0, 0>(cd, o);
#pragma unroll
      for (int j = 0; j < 16; ++j) o[j] = (unsigned)__shfl_xor((int)cd[j], 2);
      merge16_desc<0, 0>(cd, o); }
    if (q == 0) {
        float cv[16]; int id[16];
#pragma unroll
        for (int s = 0; s < 16; ++s) { const unsigned code = 255u - (cd[s] & 255u); const int ia = (int)(code >> 4), ib = (int)(code & 15u); const int na = IL[tok * 34 + ia], nb = IL[tok * 34 + 16 + ib];
            cv[s] = SAB[tok * 33 + ia] + SAB[tok * 33 + 16 + ib]; id[s] = na * 128 + nb; }
        float mx = cv[0];
#pragma unroll
        for (int s = 1; s < 16; ++s) mx = fmaxf(mx, cv[s]);
        float sum = 0.f;
#pragma unroll
        for (int s = 0; s < 16; ++s) { cv[s] = __builtin_amdgcn_exp2f((cv[s] - mx) * LOG2E); sum += cv[s]; }
        const float inv = 1.f / sum;
        int* ip = IDX + (size_t)(t0 + tok) * 128 + h * 16; float* gp = GW + (size_t)(t0 + tok) * 128 + h * 16;
#pragma unroll
        for (int s4 = 0; s4 < 4; ++s4) { *(int4*)(ip + 4 * s4) = make_int4(id[4 * s4], id[4 * s4 + 1], id[4 * s4 + 2], id[4 * s4 + 3]);
            *(f32x4*)(gp + 4 * s4) = (f32x4){cv[4 * s4] * inv, cv[4 * s4 + 1] * inv, cv[4 * s4 + 2] * inv, cv[4 * s4 + 3] * inv}; }
    }
}

__device__ __forceinline__ void fp8x16_to_f32(const v4u& w, float (&f)[16]) {
#pragma unroll
    for (int i = 0; i < 4; ++i) { const f32x2_t lo = __builtin_amdgcn_cvt_pk_f32_fp8((int)w[i], false), hi = __builtin_amdgcn_cvt_pk_f32_fp8((int)w[i], true);
        f[4 * i] = lo[0]; f[4 * i + 1] = lo[1]; f[4 * i + 2] = hi[0]; f[4 * i + 3] = hi[1]; }
}
#define LD16I(dst, p) do { _Pragma("unroll") for (int q_ = 0; q_ < 4; ++q_) { const int4 v_ = ((const int4*)(p))[q_]; dst[4 * q_] = v_.x; dst[4 * q_ + 1] = v_.y; dst[4 * q_ + 2] = v_.z; dst[4 * q_ + 3] = v_.w; } } while (0)
#define LD16F(dst, p) do { _Pragma("unroll") for (int q_ = 0; q_ < 4; ++q_) { const f32x4 v_ = ((const f32x4*)(p))[q_]; dst[4 * q_] = v_[0]; dst[4 * q_ + 1] = v_[1]; dst[4 * q_ + 2] = v_[2]; dst[4 * q_ + 3] = v_[3]; } } while (0)
__device__ __forceinline__ void peer_u_phase(const Params& P, int xg, int slot, int nslots, int lane) {
    unsigned char* ws = P.ws;
    const bf16* X1B = (const bf16*)(ws + WS_X1B); const unsigned char* U8 = ws + WS_U8; const int* IDX = (const int*)(ws + WS_IDX); float* PD = (float*)(ws + WS_PD) + (size_t)xg * T_TOK * 128;
    const int ntok = slot < T_TOK ? (T_TOK - slot + nslots - 1) / nslots : 0, N = 2 * ntok;
    if (N == 0) return;
    const int R = lane >> 3, p = lane & 7;
    const bool b2 = (lane & 4) != 0, b1 = (lane & 2) != 0, b0 = (lane & 1) != 0;
    int I0[16], I1[16], I2[16]; v4u X0[2], X1[2], X2[2]; v4u B0[8], B1[8], B2[8];
#define U_ITEM(n, t, s) const int n_##t = (n) < N ? (n) : N - 1; const int t = slot + (n_##t >= ntok ? n_##t - ntok : n_##t) * nslots, s = 2 * xg + (n_##t >= ntok ? 1 : 0)
#define U_ROWS(buf, ids, off, s) do { const unsigned char* ub_ = U8 + (size_t)(s) * NEXP * 128; _Pragma("unroll") for (int i = 0; i < 8; ++i) buf[i] = *(const v4u*)(ub_ + (unsigned)(((unsigned)ids[(off) + i] << 7) + 16u * p)); } while (0)
#define U_HALF(buf, off) do { _Pragma("unroll") for (int i = 0; i < 8; ++i) { int d = 0; _Pragma("unroll") for (int w = 0; w < 4; ++w) d = __builtin_amdgcn_sdot4((int)buf[i][w], xq[w], d, false); part[(off) + i] = d; } } while (0)
#define U_X(dst, t, s) do { const bf16* xp_ = X1B + (size_t)(t) * DM + 128 * (s) + 16 * p; dst[0] = *(const v4u*)xp_; dst[1] = *(const v4u*)(xp_ + 8); } while (0)
    const int i0 = ((lane & 4) ? 8 : 0) + ((lane & 2) ? 4 : 0) + ((lane & 1) ? 2 : 0);
    { U_ITEM(0, t0, s0); U_ITEM(1, t1, s1); U_ITEM(2, t2, s2);
      int id0[16];
      LD16I(id0, IDX + (size_t)t0 * 128 + 16 * R); LD16I(I0, IDX + (size_t)t1 * 128 + 16 * R); LD16I(I1, IDX + (size_t)t2 * 128 + 16 * R);
      U_X(X0, t0, s0); U_X(X1, t1, s1);
      U_ROWS(B0, id0, 0, s0); U_ROWS(B1, id0, 8, s0); }
#define U_BODY(n, Ba, Bb, Bc, Ia, Ib, Ic, Xa, Xb, Xc) do { \
        U_ITEM(n, t, s); U_ITEM((n) + 1, t1, s1); U_ITEM((n) + 2, t2, s2); U_ITEM((n) + 3, t3, s3); (void)s; (void)s3; \
        f32x2_t* pp = (f32x2_t*)(PD + (size_t)t * 128 + 16 * R + i0); \
        f32x2_t pold = (f32x2_t){0.f, 0.f}; if ((n) >= ntok) pold = *pp; \
        U_ROWS(Bc, Ia, 0, s1); \
        LD16I(Ic, IDX + (size_t)t3 * 128 + 16 * R); \
        U_X(Xc, t2, s2); \
        float x[16]; float am = 0.f; \
        _Pragma("unroll") for (int k = 0; k < 4; ++k) { x[2 * k] = bf_lo(Xa[0][k]); x[2 * k + 1] = bf_hi(Xa[0][k]); x[8 + 2 * k] = bf_lo(Xa[1][k]); x[8 + 2 * k + 1] = bf_hi(Xa[1][k]); } \
        _Pragma("unroll") for (int k = 0; k < 16; ++k) am = fmaxf(am, fabsf(x[k])); \
        am = fmaxf(am, __shfl_xor(am, 1)); am = fmaxf(am, __shfl_xor(am, 2)); am = fmaxf(am, __shfl_xor(am, 4)); \
        const float xs = am > 0.f ? am * (1.f / 127.f) : 1.f, xinv = 1.f / xs; \
        int xq[4]; \
        _Pragma("unroll") for (int w = 0; w < 4; ++w) { const int q0 = (int)rintf(x[4 * w] * xinv), q1 = (int)rintf(x[4 * w + 1] * xinv), q2 = (int)rintf(x[4 * w + 2] * xinv), q3 = (int)rintf(x[4 * w + 3] * xinv); \
            xq[w] = (int)((unsigned)(q0 & 255) | ((unsigned)(q1 & 255) << 8) | ((unsigned)(q2 & 255) << 16) | ((unsigned)q3 << 24)); } \
        int part[16]; \
        U_HALF(Ba, 0); \
        U_ROWS(Ba, Ia, 8, s1); \
        U_HALF(Bb, 8); \
        if ((n) < N) { \
            int a8[8], a4[4], a2i[2]; \
            _Pragma("unroll") for (int k = 0; k < 8; ++k) { const int send = b2 ? part[k] : part[k + 8], keep = b2 ? part[k + 8] : part[k]; a8[k] = keep + __shfl_xor(send, 4); } \
            _Pragma("unroll") for (int k = 0; k < 4; ++k) { const int send = b1 ? a8[k] : a8[k + 4], keep = b1 ? a8[k + 4] : a8[k]; a4[k] = keep + __shfl_xor(send, 2); } \
            _Pragma("unroll") for (int k = 0; k < 2; ++k) { const int send = b0 ? a4[k] : a4[k + 2], keep = b0 ? a4[k + 2] : a4[k]; a2i[k] = keep + __shfl_xor(send, 1); } \
            *pp = (f32x2_t){(float)a2i[0] * xs, (float)a2i[1] * xs} + pold; } } while (0)
    for (int n = 0; n < N; n += 3) { U_BODY(n, B0, B1, B2, I0, I1, I2, X0, X1, X2); U_BODY(n + 1, B2, B0, B1, I1, I2, I0, X1, X2, X0); U_BODY(n + 2, B1, B2, B0, I2, I0, I1, X2, X0, X1); }
#undef U_X
#undef U_ITEM
#undef U_ROWS
#undef U_HALF
#undef U_BODY
}
__device__ __forceinline__ void peer_act_tokens(const Params& P, int t, int t2, int lane) {
    unsigned char* ws = P.ws;
    const float* PD = (const float*)(ws + WS_PD); const int* IDX = (const int*)(ws + WS_IDX); const float* GW = (const float*)(ws + WS_G); const float* SSP = (const float*)(ws + WS_SSP);
    const float* US = (const float*)(ws + WS_US); const float* VS = (const float*)(ws + WS_VS); float* ACT = (float*)(ws + WS_ACT);
    const bool two = t2 >= 0; const int tt[2] = {t, two ? t2 : t};
    float ss[2], d[2][2], gw[2][2], us[2][2], vs[2][2]; int id[2][2];
#pragma unroll
    for (int k = 0; k < 2; ++k) { ss[k] = lane < 32 ? SSP[(size_t)tt[k] * 32 + lane] : 0.f;
#pragma unroll
        for (int s = 0; s < 2; ++s) { const int slot = 64 * s + lane; id[k][s] = IDX[(size_t)tt[k] * 128 + slot]; gw[k][s] = GW[(size_t)tt[k] * 128 + slot]; float a = 0.f;
#pragma unroll
            for (int xg = 0; xg < 8; ++xg) a += PD[((size_t)xg * T_TOK + tt[k]) * 128 + slot];
            d[k][s] = a; } }
#pragma unroll
    for (int k = 0; k < 2; ++k)
#pragma unroll
        for (int s = 0; s < 2; ++s) { us[k][s] = US[id[k][s]]; vs[k][s] = VS[id[k][s]]; }
#pragma unroll
    for (int k = 0; k < 2; ++k) { const float rs = __builtin_amdgcn_rsqf(wave_sum(ss[k]) * (1.f / 2048.f) + RMS_EPS);
        if (k == 0 || two) {
#pragma unroll
            for (int s = 0; s < 2; ++s) ACT[(size_t)tt[k] * 128 + 64 * s + lane] = pg8::gelu_tanh_f(d[k][s] * us[k][s] * rs) * gw[k][s] * vs[k][s]; } }
}
#define PIN16(a) asm volatile("" : "+v"(a[0]), "+v"(a[1]), "+v"(a[2]), "+v"(a[3]), "+v"(a[4]), "+v"(a[5]), "+v"(a[6]), "+v"(a[7]), "+v"(a[8]), "+v"(a[9]), "+v"(a[10]), "+v"(a[11]), "+v"(a[12]), "+v"(a[13]), "+v"(a[14]), "+v"(a[15]))
__device__ __forceinline__ void peer_v_phase(const Params& P, int xg, int slot, int nslots, int lane) {
    unsigned char* ws = P.ws;
    const unsigned char* V8 = ws + WS_V8; const int* IDX = (const int*)(ws + WS_IDX); const float* ACT = (const float*)(ws + WS_ACT); bf16* OUTP = (bf16*)(ws + WS_OUTP);
    const int ntok = slot < T_TOK ? (T_TOK - slot + nslots - 1) / nslots : 0, N = 2 * ntok;
    if (N == 0) return;
    const int R = lane >> 3, p = lane & 7;
    const bool b5 = (lane & 32) != 0, b4 = (lane & 16) != 0, b3 = (lane & 8) != 0;
    int I0[16], I1[16], I2[16]; float A0[16], A1[16], A2[16]; v4u B0[8], B1[8], B2[8];
#define V_ITEM(n, t, s) const int n_##t = (n) < N ? (n) : N - 1; const int t = slot + (n_##t >= ntok ? n_##t - ntok : n_##t) * nslots, s = 2 * xg + (n_##t >= ntok ? 1 : 0)
#define V_ROWS(buf, ids, off, s) do { const unsigned char* vb_ = V8 + (size_t)(s) * NEXP * 128; _Pragma("unroll") for (int i = 0; i < 8; ++i) buf[i] = *(const v4u*)(vb_ + (unsigned)(((unsigned)ids[(off) + i] << 7) + 16u * p)); } while (0)
#define V_HALF(buf, av, off) do { _Pragma("unroll") for (int i = 0; i < 8; ++i) { asm volatile("" : "+v"(buf[i][0]), "+v"(buf[i][1]), "+v"(buf[i][2]), "+v"(buf[i][3])); \
            float f[16]; fp8x16_to_f32(buf[i], f); _Pragma("unroll") for (int k = 0; k < 16; ++k) acc[k] += av[(off) + i] * f[k]; PIN16(acc); } } while (0)
    { V_ITEM(0, t0, s0); V_ITEM(1, t1, s1); V_ITEM(2, t2, s2); (void)s1; (void)s2;
      int id0[16];
      LD16I(id0, IDX + (size_t)t0 * 128 + 16 * R); LD16I(I0, IDX + (size_t)t1 * 128 + 16 * R); LD16I(I1, IDX + (size_t)t2 * 128 + 16 * R);
      LD16F(A0, ACT + (size_t)t0 * 128 + 16 * R); LD16F(A1, ACT + (size_t)t1 * 128 + 16 * R);
      V_ROWS(B0, id0, 0, s0); V_ROWS(B1, id0, 8, s0); }
#define V_BODY(n, Ba, Bb, Bc, Ia, Ib, Ic, Aa, Ab, Ac) do { \
        V_ITEM(n, t, s); V_ITEM((n) + 1, t1, s1); V_ITEM((n) + 2, t2, s2); V_ITEM((n) + 3, t3, s3); (void)s2; (void)s3; \
        V_ROWS(Bc, Ia, 0, s1); \
        LD16I(Ic, IDX + (size_t)t3 * 128 + 16 * R); LD16F(Ac, ACT + (size_t)t2 * 128 + 16 * R); \
        float acc[16]; \
        _Pragma("unroll") for (int k = 0; k < 16; ++k) acc[k] = 0.f; \
        V_HALF(Ba, Aa, 0); \
        V_ROWS(Ba, Ia, 8, s1); \
        V_HALF(Bb, Aa, 8); \
        if ((n) < N) { \
            float a8[8], a4[4], a2[2]; \
            _Pragma("unroll") for (int k = 0; k < 8; ++k) { const float send = b5 ? acc[k] : acc[k + 8], keep = b5 ? acc[k + 8] : acc[k]; a8[k] = keep + __shfl_xor(send, 32); } \
            _Pragma("unroll") for (int k = 0; k < 4; ++k) { const float send = b4 ? a8[k] : a8[k + 4], keep = b4 ? a8[k + 4] : a8[k]; a4[k] = keep + __shfl_xor(send, 16); } \
            _Pragma("unroll") for (int k = 0; k < 2; ++k) { const float send = b3 ? a4[k] : a4[k + 2], keep = b3 ? a4[k + 2] : a4[k]; a2[k] = keep + __shfl_xor(send, 8); } \
            const int col = 128 * s + 16 * p + (b5 ? 8 : 0) + (b4 ? 4 : 0) + (b3 ? 2 : 0); \
            *(unsigned*)(OUTP + (size_t)t * DM + col) = cvtpk(a2[0], a2[1]); } } while (0)
    for (int n = 0; n < N; n += 3) { V_BODY(n, B0, B1, B2, I0, I1, I2, A0, A1, A2); V_BODY(n + 1, B2, B0, B1, I1, I2, I0, A1, A2, A0); V_BODY(n + 2, B1, B2, B0, I2, I0, I1, A2, A0, A1); }
#undef V_ITEM
#undef V_ROWS
#undef V_HALF
#undef V_BODY
}
__device__ __forceinline__ void peer_final_tokens(const Params& P, int t, int t2, int lane, float* outp) {
    const bool two = t2 >= 0; const int tt[2] = {t, two ? t2 : t};
    v4u a[2][4], b[2][4];
#pragma unroll
    for (int k = 0; k < 2; ++k) { const bf16* xrow = (const bf16*)(P.ws + WS_X1B) + (size_t)tt[k] * DM; const bf16* prow = (const bf16*)(P.ws + WS_OUTP) + (size_t)tt[k] * DM;
#pragma unroll
        for (int j = 0; j < 4; ++j) { a[k][j] = *(const v4u*)(xrow + 512 * j + 8 * lane); b[k][j] = *(const v4u*)(prow + 512 * j + 8 * lane); } }
#pragma unroll
    for (int k = 0; k < 2; ++k) { if (k == 1 && !two) break;
        float v[4][8]; float ss = 0.f;
#pragma unroll
        for (int j = 0; j < 4; ++j) {
#pragma unroll
            for (int i = 0; i < 4; ++i) { v[j][2 * i] = bf_lo(a[k][j][i]) + bf_lo(b[k][j][i]); v[j][2 * i + 1] = bf_hi(a[k][j][i]) + bf_hi(b[k][j][i]); }
#pragma unroll
            for (int i = 0; i < 8; ++i) ss += v[j][i] * v[j][i]; }
        const float rf = __builtin_amdgcn_rsqf(wave_sum(ss) * (1.f / 2048.f) + RMS_EPS);
        float* orow = outp + (size_t)tt[k] * DM;
#pragma unroll
        for (int j = 0; j < 4; ++j) { const f32x4 g0 = *(const f32x4*)(P.g_fin + 512 * j + 8 * lane), g1 = *(const f32x4*)(P.g_fin + 512 * j + 8 * lane + 4); f32x4 o0, o1;
#pragma unroll
            for (int i = 0; i < 4; ++i) { o0[i] = v[j][i] * rf * g0[i]; o1[i] = v[j][4 + i] * rf * g1[i]; }
            *(f32x4*)(orow + 512 * j + 8 * lane) = o0; *(f32x4*)(orow + 512 * j + 8 * lane + 4) = o1; } }
}

#ifndef MK_PER_PHASE
#define MK_PER_PHASE 0
#endif
constexpr int N_PHASES = 12;
__global__ void __launch_bounds__(NWAVES * 64, 2) fwd_kernel(Params P) {
    extern __shared__ __attribute__((aligned(16))) unsigned char lds_raw[];
    LAS unsigned char* lds = (LAS unsigned char*)lds_raw;
    volatile LAS unsigned* MISC = (volatile LAS unsigned*)(lds + MISC_OFF);
    const int tid = threadIdx.x, lane = tid & 63, wave = __builtin_amdgcn_readfirstlane(tid >> 6);
    const int G = gridDim.x; const int bx = blockIdx.x;
    const int vcu = (G % 8 == 0) ? (bx % 8) * (G / 8) + bx / 8 : bx;
    const int gw = vcu * NWAVES + wave, NGW = G * NWAVES;
    unsigned char* ws = P.ws;
    gu32* ctl = (gu32*)(ws + WS_CTL);
    for (int u = tid; u < 64; u += NWAVES * 64) MISC[u] = 0u;
    __syncthreads();
    XcdBarrier bar; bar.bar = (unsigned*)ctl + CW_BAR; bar.x = 0; bar.st = nullptr;
    if (!MK_PER_PHASE) bar = xcd_barrier_post((unsigned*)ctl + CW_BAR, MISC + 8);
    const unsigned my_xcc = xb_xcc_id();
    if (!MK_PER_PHASE) { if (tid == 0) MISC[16] = __hip_atomic_fetch_add((unsigned*)(ctl + CW_XC + 64 * (my_xcc & 7u)), 1u, __ATOMIC_RELAXED, __HIP_MEMORY_SCOPE_AGENT); }
    const int lo = P.ph_lo, hi = P.ph_hi;
#define FRESH_IDS const int lane = (int)__builtin_amdgcn_mbcnt_hi(~0u, __builtin_amdgcn_mbcnt_lo(~0u, 0u)); const int tid = wave * 64 + lane; (void)tid; (void)lane
#ifndef PH_MASK
#define PH_MASK 0xfff
#endif
#define IN(k) (((PH_MASK >> (k)) & 1) && lo <= (k) && (k) < hi)
#define BOTH(k) (IN(k) && IN((k) + 1))
#ifndef DUP_MASK
#define DUP_MASK 0
#endif
#define NREP(k) (((DUP_MASK >> (k)) & 1) ? 2 : 1)
#define GRID_BAR() do { if (!MK_PER_PHASE) xcd_barrier(bar); } while (0)
#ifdef TPROBE
#define TP_T0 (wave == 0 && __builtin_amdgcn_mbcnt_hi(~0u, __builtin_amdgcn_mbcnt_lo(~0u, 0u)) == 0u)
#define TP_ORD(k) ((k) < 7 ? (k) : (k) - 1)
    if (TP_T0) MISC[40] = (unsigned)__builtin_amdgcn_s_memrealtime();
#define TP_STAMP(w) do { MISC[(w)] = (unsigned)__builtin_amdgcn_s_memrealtime(); } while (0)
#define GRID_BAR_K(k) do { xcd_barrier(bar); MISC[41 + TP_ORD(k)] = (unsigned)__builtin_amdgcn_s_memrealtime(); } while (0)
#else
#define TP_STAMP(w) do { } while (0)
#define GRID_BAR_K(k) GRID_BAR()
#endif

    bf16* HN = (bf16*)(ws + WS_HN); bf16* WA = (bf16*)(ws + WS_WA); bf16* WV = (bf16*)(ws + WS_WV); bf16* WB = (bf16*)(ws + WS_WB); bf16* WO = (bf16*)(ws + WS_WO); bf16* WQ = (bf16*)(ws + WS_WQ);

    constexpr int NV_UNITS = (AW / 256) * (T_TOK / 256);
    const bool tab_fast = (G > NV_UNITS && (1024 % G) == 0);
    const int tab_r1 = tab_fast ? 0 : NEXP;
    if (IN(0)) { FRESH_IDS; for (int rep = 0; rep < NREP(0); ++rep) p0_prologue(P, lds, gw, NGW, wave, lane, tab_r1); TP_STAMP(53); if (BOTH(0)) GRID_BAR_K(0); }

    if (IN(1)) { FRESH_IDS;
      _Pragma("unroll") for (int rep = 0; rep < NREP(1); ++rep) {
        { pg8::Gemm g{HN, WA, T_TOK, NWA, DM / 2, WV, HN, ws, (unsigned)WS_END}; pg8::StaticOrder2 S; S.init(T_TOK, NWA, AW, T_TOK, G, bx);
          pg8::EpiProj E{(bf16*)(ws + WS_Q), (bf16*)(ws + WS_K), (bf16*)(ws + WS_XR), (bf16*)(ws + WS_GY), (bf16*)(ws + WS_SG), (bf16*)(ws + WS_VT), rep == 0 ? (float*)(ws + WS_CTL) + CW_KM : nullptr, QSCALE, 1.f / W8SCALE};
          pg8::gemm_phase<pg8::EpiProj, pg8::StaticOrder2, true, true, true>(lds, g, S, E); }
        TP_STAMP(54);
        if (tab_fast && bx >= NV_UNITS) peer_table_u<2>(P, 0, NEXP, (bx - NV_UNITS) * NWAVES + wave, (G - NV_UNITS) * NWAVES, lane);
      }
        TP_STAMP(55); if (BOTH(1)) GRID_BAR_K(1);
    }

    if (IN(2)) { FRESH_IDS;
        LAS int* tick = (LAS int*)(lds + MISC_OFF + 128);
#define NEXT_TICKET(dst, word) do { __syncthreads(); if (tid == 0) *tick = (int)__hip_atomic_fetch_add((unsigned*)(ctl + (word)), 1u, __ATOMIC_RELAXED, __HIP_MEMORY_SCOPE_AGENT); __syncthreads(); dst = *tick; } while (0)
#define TICKET_ISSUE(word) do { if (tid == 0) tk_next = (int)__hip_atomic_fetch_add((unsigned*)(ctl + (word)), 1u, __ATOMIC_RELAXED, __HIP_MEMORY_SCOPE_AGENT); } while (0)
#define TICKET_TAKE(dst) do { __syncthreads(); if (tid == 0) *tick = tk_next; __syncthreads(); dst = *tick; } while (0)
        int tk_next = 0;
#ifndef DUP_ATT
#define DUP_ATT 0
#endif
#ifndef DUP_LRU
#define DUP_LRU 0
#endif
#ifndef DUP_P2
#define DUP_P2 0
#endif
        _Pragma("unroll") for (int rp = 0; rp < 1 + DUP_P2; ++rp) {
        _Pragma("unroll") for (int rep = 0; rep < 1 + DUP_ATT; ++rep) {
            int tid2 = tid; asm volatile("" : "+v"(tid2));
            int it; NEXT_TICKET(it, CW_Q2 + 64 * (rep + 2 * rp));
            while (it < 256) { const int blk = 7 - (it >> 5), bh = it & 31; attn_unit(P, lds, bh >> 3, bh & 7, blk, tid2, wave, tid2 & 63); NEXT_TICKET(it, CW_Q2 + 64 * (rep + 2 * rp)); } }
        TP_STAMP(56);
        _Pragma("unroll") for (int rep = 0; rep < 1 + DUP_LRU; ++rep) {
            int tid2 = tid; asm volatile("" : "+v"(tid2));
            int it; NEXT_TICKET(it, CW_Q2 + 256 + 64 * (rep + 2 * rp));
            while (it < 512) { lru_pair(P, lds, it, tid2, wave, tid2 & 63, (unsigned*)(ctl + CW_Q2 + 256 + 64 * (rep + 2 * rp)), tk_next); TICKET_TAKE(it); } }
        if (DUP_P2 && rp == 0) GRID_BAR();
        }
#undef NEXT_TICKET
#undef TICKET_ISSUE
#undef TICKET_TAKE
        TP_STAMP(57); if (BOTH(2)) GRID_BAR_K(2);
    }

    if (IN(3)) { FRESH_IDS;
      _Pragma("unroll") for (int rep = 0; rep < NREP(3); ++rep) {
        const float* HL = (const float*)(ws + WS_HL); const float* AC = (const float*)(ws + WS_AC); const float* SUM = (const float*)(ws + WS_SUM);
        const bf16* GY = (const bf16*)(ws + WS_GY); unsigned char* OCAT = ws + WS_OCAT;
        for (int u = vcu; u < 256; u += G) { const int b = u >> 6, c = (u >> 1) & 31, C = (u & 1) * 512 + 4 * (tid & 127), tq = tid >> 7;
            f32x4 carry = (f32x4){0.f, 0.f, 0.f, 0.f};
            for (int cc = 0; cc < c; ++cc) { const float* sm = SUM + ((size_t)(b * 32 + cc) * 1024 + C) * 2; const f32x4 s0 = *(const f32x4*)sm, s1 = *(const f32x4*)(sm + 4);
                carry[0] = s0[0] * carry[0] + s0[1]; carry[1] = s0[2] * carry[1] + s0[3]; carry[2] = s1[0] * carry[2] + s1[1]; carry[3] = s1[2] * carry[3] + s1[3]; }
            const size_t R0 = (size_t)b * SEQ + c * 64 + tq * 16;
#pragma unroll 8
            for (int t = 0; t < 16; ++t) { const size_t o = (R0 + t) * AW + C; const f32x4 hv = *(const f32x4*)(HL + o) + *(const f32x4*)(AC + o) * carry;
                const unsigned long long gy = *(const unsigned long long*)(GY + o); const unsigned g0 = (unsigned)gy, g1 = (unsigned)(gy >> 32);
                int p = __builtin_amdgcn_cvt_pk_fp8_f32(clamp8(hv[0] * bf_lo(g0) * OC8SCALE), clamp8(hv[1] * bf_hi(g0) * OC8SCALE), 0, false); p = __builtin_amdgcn_cvt_pk_fp8_f32(clamp8(hv[2] * bf_lo(g1) * OC8SCALE), clamp8(hv[3] * bf_hi(g1) * OC8SCALE), p, true);
                *(unsigned*)(OCAT + (R0 + t) * DM + AW + C) = (unsigned)p; } }
      }
        TP_STAMP(58); if (BOTH(3)) GRID_BAR_K(3);
    }

    if (IN(4)) { FRESH_IDS;
      _Pragma("unroll") for (int rep = 0; rep < NREP(4); ++rep) {
        { pg8::Gemm g{(bf16*)(ws + WS_OCAT), WB, T_TOK, DM, DM / 2, nullptr, nullptr, ws, (unsigned)WS_END}; pg8::StaticOrder S; S.init(T_TOK, DM, G, bx);
          pg8::EpiMerge2 E{(const bf16*)(ws + WS_SG), (bf16*)(ws + WS_MG), MG8SCALE / (OC8SCALE * WB8SCALE)};
          pg8::gemm_phase<pg8::EpiMerge2, pg8::StaticOrder, true, true, true>(lds, g, S, E); }
      }
        if (BOTH(4)) GRID_BAR_K(4);
    }

    if (IN(5)) { FRESH_IDS;
      _Pragma("unroll") for (int rep = 0; rep < NREP(5); ++rep) {
        pg8::Gemm g{(bf16*)(ws + WS_MG), WO, T_TOK, DM, DM / 2, nullptr, nullptr, ws, (unsigned)WS_END}; pg8::StaticOrder S; S.init(T_TOK, DM, G, bx);
        pg8::EpiResid E{P.x, (bf16*)(ws + WS_X1B), (float*)(ws + WS_SSP), 1.f / (W8SCALE * MG8SCALE)};
        pg8::gemm_phase<pg8::EpiResid, pg8::StaticOrder, true, true, true>(lds, g, S, E);
      }
        if (BOTH(5)) GRID_BAR_K(5);
    }

    if (IN(6)) { FRESH_IDS;
      _Pragma("unroll") for (int rep = 0; rep < NREP(6); ++rep) {
        pg8::Gemm g{(bf16*)(ws + WS_X1B), WQ, T_TOK, DM, DM, nullptr, nullptr, ws, (unsigned)WS_END}; pg8::StaticOrder S; S.init(T_TOK, DM, G, bx);
        pg8::EpiRowScale E{(const float*)(ws + WS_SSP), (bf16*)(ws + WS_QP)};
        pg8::gemm_phase<pg8::EpiRowScale, pg8::StaticOrder, true, true>(lds, g, S, E);
        TP_STAMP(59);
        { pg8::Unit u; for (int i = 0; S.next(i, u); ++i) { peer_topk_unit(P, lds, u.pm * 256, u.pn, tid, wave, lane); peer_topk_unit(P, lds, u.pm * 256 + 128, u.pn, tid, wave, lane); } }
      }
        TP_STAMP(60); if (BOTH(6)) GRID_BAR_K(6);
    }

    int xg = bx & 7, nblk_g = (G - xg + 7) >> 3, rank_g = bx >> 3;
    if (!MK_PER_PHASE && lo == 0 && hi > 8) {
        unsigned cnt[8], sum = 0u; bool ok = my_xcc < 8u;
#pragma unroll
        for (int j = 0; j < 8; ++j) { cnt[j] = __hip_atomic_load((unsigned*)(ctl + CW_XC + 64 * j), __ATOMIC_RELAXED, __HIP_MEMORY_SCOPE_AGENT); sum += cnt[j]; ok = ok && cnt[j] > 0u; }
        if (ok && sum == (unsigned)G) { xg = (int)my_xcc; rank_g = (int)MISC[16];
            nblk_g = (int)(xg == 0 ? cnt[0] : xg == 1 ? cnt[1] : xg == 2 ? cnt[2] : xg == 3 ? cnt[3] : xg == 4 ? cnt[4] : xg == 5 ? cnt[5] : xg == 6 ? cnt[6] : cnt[7]); }
    }
    const int nslots = nblk_g * NWAVES, slot = rank_g * NWAVES + wave;
    if (IN(8)) { FRESH_IDS;
        _Pragma("unroll") for (int rep = 0; rep < NREP(8); ++rep) {
        if (tab_fast) { if (wave == NWAVES - 1) peer_table_v<4>(P, 0, NEXP, bx, G, lane); else peer_u_phase(P, xg, rank_g * (NWAVES - 1) + wave, nblk_g * (NWAVES - 1), lane); }
        else peer_u_phase(P, xg, slot, nslots, lane); }
        TP_STAMP(61); if (BOTH(8)) GRID_BAR_K(8);
    }
#ifdef EXTRA_BARS
    for (int eb = 0; eb < EXTRA_BARS; ++eb) GRID_BAR();
#endif
    if (IN(9)) { FRESH_IDS;
        for (int t = gw; t < T_TOK; t += 2 * NGW) peer_act_tokens(P, t, t + NGW < T_TOK ? t + NGW : -1, lane);
        if (BOTH(9)) GRID_BAR_K(9);
    }
    if (IN(10)) { FRESH_IDS;
        _Pragma("unroll") for (int rep = 0; rep < NREP(10); ++rep)
        peer_v_phase(P, xg, slot, nslots, lane);
        TP_STAMP(62); if (BOTH(10)) GRID_BAR_K(10);
    }
    if (IN(11)) { FRESH_IDS;
        if (NREP(11) == 2) for (int t = gw; t < T_TOK; t += 2 * NGW) peer_final_tokens(P, t, t + NGW < T_TOK ? t + NGW : -1, lane, (float*)(ws + WS_MG));
        for (int t = gw; t < T_TOK; t += 2 * NGW) peer_final_tokens(P, t, t + NGW < T_TOK ? t + NGW : -1, lane, P.out);
    }
#ifdef TPROBE
    { GRID_BAR_K(11);
      gu32* tpw = (gu32*)(P.ws + WS_CTL) + 16384;
      if (TP_T0) { const int j = (int)__hip_atomic_load((unsigned*)tpw + 64, __ATOMIC_RELAXED, __HIP_MEMORY_SCOPE_AGENT); const unsigned val = j < 11 ? MISC[41 + j] - MISC[40 + j] : (j >= 4096 ? MISC[(j >> 6) & 63] - MISC[j & 63] : 0u);
          __hip_atomic_fetch_add((unsigned*)tpw, val, __ATOMIC_RELAXED, __HIP_MEMORY_SCOPE_AGENT); }
      GRID_BAR();
      const unsigned tot = __hip_atomic_load((unsigned*)tpw, __ATOMIC_RELAXED, __HIP_MEMORY_SCOPE_AGENT), avg = (unsigned)__builtin_amdgcn_readfirstlane((int)(tot >> 8));
      const unsigned ts = (unsigned)__builtin_amdgcn_s_memrealtime();
      while ((unsigned)__builtin_amdgcn_s_memrealtime() - ts < avg) __builtin_amdgcn_s_sleep(1); }
#endif
#undef IN
#undef BOTH
#undef GRID_BAR
}

extern "C" void kernel_launch(void* const* d_in, const int* in_sizes, int n_in, void* d_out, int out_size, void* d_ws, size_t ws_size, hipStream_t stream) {
    static int grid = 0;
    if (grid == 0) {
        if (n_in != 19 || out_size != T_TOK * DM || ws_size < WS_END) { fprintf(stderr, "kernel_launch: unexpected problem (n_in %d, out %d, ws %zu); nothing launched\n", n_in, out_size, ws_size); grid = -1; return; }
        int dev = 0, cus = 0, per_cu = 0;
        if (hipGetDevice(&dev) != hipSuccess || hipDeviceGetAttribute(&cus, hipDeviceAttributeMultiprocessorCount, dev) != hipSuccess) { grid = -1; return; }
        if (hipFuncSetAttribute((const void*)fwd_kernel, hipFuncAttributeMaxDynamicSharedMemorySize, LDS_BYTES) != hipSuccess) { fprintf(stderr, "kernel_launch: hipFuncSetAttribute failed\n"); grid = -1; return; }
        if (hipOccupancyMaxActiveBlocksPerMultiprocessor(&per_cu, (const void*)fwd_kernel, NWAVES * 64, LDS_BYTES) != hipSuccess || per_cu < 1) { fprintf(stderr, "kernel_launch: occupancy query says %d blocks per CU\n", per_cu); }
        (void)hipGetLastError();
        grid = cus;
    }
    if (grid < 0) return;
    if (hipMemsetAsync((char*)d_ws + WS_CTL, 0, CTL_ZERO_BYTES, stream) != hipSuccess) return;
#ifdef TPROBE
    if (hipMemsetD32Async((hipDeviceptr_t)((char*)d_ws + WS_CTL + 4 * (16384 + 64)), TPROBE, 1, stream) != hipSuccess) return;
#endif
    Params p{};
    const float** pp = (const float**)&p;
    for (int i = 0; i < 19; ++i) pp[i] = (const float*)d_in[i];
    p.out = (float*)d_out; p.ws = (unsigned char*)d_ws;
#if MK_PER_PHASE
    for (int ph = 0; ph < N_PHASES; ++ph) { p.ph_lo = ph; p.ph_hi = ph + 1; hipLaunchKernelGGL(fwd_kernel, dim3(grid), dim3(NWAVES * 64), LDS_BYTES, stream, p); }
#else
    p.ph_lo = 0; p.ph_hi = N_PHASES;
    hipLaunchKernelGGL(fwd_kernel, dim3(grid), dim3(NWAVES * 64), LDS_BYTES, stream, p);
#endif
}
```

```cpp
#include <hip/hip_runtime.h>
#include <cstdio>
#include <cstdint>
namespace pg8 {
#define PG8_LAS __attribute__((address_space(3)))
typedef unsigned short bf16_t;
typedef short bf16x8 __attribute__((ext_vector_type(8)));
typedef float f32x4 __attribute__((ext_vector_type(4)));
typedef unsigned u32x4 __attribute__((ext_vector_type(4)));
typedef int i32x4 __attribute__((ext_vector_type(4)));
typedef int i32x8 __attribute__((ext_vector_type(8)));
__device__ __forceinline__ i32x8 cat8(bf16x8 a, bf16x8 b) { return __builtin_shufflevector(__builtin_bit_cast(i32x4, a), __builtin_bit_cast(i32x4, b), 0, 1, 2, 3, 4, 5, 6, 7); }
constexpr int BM = 256, BK = 64, HALF = 128, HTB = HALF * BK * 2  , STAGE_BYTES = 8 * HTB, NXCD = 8, WGM = 8;

__host__ __device__ __forceinline__ int lds_byte(int r, int c) { const int st = (r >> 4) * 2 + (c >> 5), rr = r & 15, cc = c & 31, ob = rr * 64 + cc * 2; return st * 1024 + (ob ^ (((ob >> 9) & 1) << 5)); }
__host__ __device__ __forceinline__ void stage_rc(int b, int& R, int& C) { const int st = b / 1024, sb = b % 1024, swz = sb ^ (((sb >> 9) & 1) << 5); R = (st >> 1) * 16 + swz / 64; C = (st & 1) * 32 + (swz % 64) / 2; }
__host__ __device__ __forceinline__ int perm32(int rho) { const int n = rho >> 4, i = rho & 15; return 8 * (i >> 2) + 4 * n + (i & 3); }

struct Unit { int pm, pn, sel; };
struct Gemm { const bf16_t* A; const bf16_t* Bt; int M, N, K; const bf16_t* A2; const bf16_t* Bt2; const void* rbase; unsigned rbytes; };

struct StaticOrder {
    int nM, nN, nwg, G, c;
    __host__ __device__ __forceinline__ void init(int M, int N, int G_, int c_) { nM = M / BM; nN = N / BM; nwg = nM * nN; G = G_; c = c_; }
    __host__ __device__ __forceinline__ bool next(int i, Unit& u) const {
        const long L = (long)i * G + c; if (L >= nwg) return false;
        int wgid = (int)L; { const int q = nwg / NXCD, r = nwg % NXCD, xcd = wgid % NXCD, off = wgid / NXCD; wgid = (xcd < r ? xcd * (q + 1) : r * (q + 1) + (xcd - r) * q) + off; }
        const int nig = WGM * nN, gid = wgid / nig, fm = gid * WGM, gsz = (nM - fm) < WGM ? (nM - fm) : WGM;
        u.pm = fm + ((wgid % nig) % gsz); u.pn = (wgid % nig) / gsz; u.sel = 0; return true;
    }
    __device__ __forceinline__ void a_ready(const Unit&) const {}
    __device__ __forceinline__ void done(const Unit&) const {}
};

struct StaticOrder2 {
    StaticOrder s0, s1; int G, c;
    __host__ __device__ __forceinline__ void init(int M0, int N0, int M1, int N1, int G_, int c_) { s0.init(M0, N0, 1, 0); s1.init(M1, N1, 1, 0); G = G_; c = c_; }
    __host__ __device__ __forceinline__ bool next(int i, Unit& u) const {
        const long L = (long)i * G + c;
        if (L < s0.nwg) return s0.next((int)L, u);
        if (L < s0.nwg + s1.nwg) { const bool ok = s1.next((int)(L - s0.nwg), u); u.sel = 1; return ok; }
        return false;
    }
    __device__ __forceinline__ void a_ready(const Unit&) const {}
    __device__ __forceinline__ void done(const Unit&) const {}
};

__device__ __forceinline__ unsigned cvt_pk_bf16(float lo, float hi) { unsigned r; asm volatile("v_cvt_pk_bf16_f32 %0, %1, %2" : "=v"(r) : "v"(lo), "v"(hi)); return r; }
typedef float f32x2 __attribute__((ext_vector_type(2)));
__device__ __forceinline__ float c8(float v) { return __builtin_fminf(__builtin_fmaxf(v, -448.f), 448.f); }
__device__ __forceinline__ float sigmoid_f(float v) { return __builtin_amdgcn_rcpf(1.f + __builtin_amdgcn_exp2f(-1.4426950408889634f * v)); }
__device__ __forceinline__ float gelu_tanh_f(float v) { const float z = 1.5957691216057308f * (v + 0.044715f * v * v * v); return v * __builtin_amdgcn_rcpf(1.f + __builtin_amdgcn_exp2f(-1.4426950408889634f * z)); }
__device__ __forceinline__ u32x4 pack8(const f32x4& v0, const f32x4& v1) { u32x4 w; w.x = cvt_pk_bf16(v0[0], v0[1]); w.y = cvt_pk_bf16(v0[2], v0[3]); w.z = cvt_pk_bf16(v1[0], v1[1]); w.w = cvt_pk_bf16(v1[2], v1[3]); return w; }
__device__ __forceinline__ f32x4 bf4_lo(unsigned a, unsigned b) { f32x4 r; r[0] = __builtin_bit_cast(float, a << 16); r[1] = __builtin_bit_cast(float, a & 0xffff0000u); r[2] = __builtin_bit_cast(float, b << 16); r[3] = __builtin_bit_cast(float, b & 0xffff0000u); return r; }

struct EpiProj {
    static constexpr bool PERM = true, AFTER_DRAIN = false, MIDK = false;
    bf16_t *Q, *K, *XR, *GY, *SG, *VT; float* KM; float qscale, oscale;
    __device__ __forceinline__ void operator()(const f32x4 (&acc)[2][2][4][2], const Unit& u, int wr, int wc, int fr, int fq) const {
        { const int l_ = (int)__builtin_amdgcn_mbcnt_hi(~0u, __builtin_amdgcn_mbcnt_lo(~0u, 0u)); fr = l_ & 15; fq = l_ >> 4; }
        const int pn = u.pn; int kind, ldc, colt; bf16_t* base;
        if (u.sel) { kind = 2; base = VT; ldc = 8192; colt = pn * 256; }
        else if (pn < 4) { kind = 0; base = Q; ldc = 1024; colt = pn * 256; }
        else if (pn < 8) { kind = 1; base = K; ldc = 1024; colt = (pn - 4) * 256; }
        else if (pn < 12) { kind = 2; base = XR; ldc = 1024; colt = (pn - 8) * 256; }
        else if (pn < 16) { kind = 3; base = GY; ldc = 1024; colt = (pn - 12) * 256; }
        else { kind = 4; base = SG; ldc = 4096; colt = (pn - 16) * 256; }
        const int row0 = u.pm * BM + wr * 64 + fr, col0 = colt + wc * 32 + 8 * fq;
#pragma unroll
        for (int ai = 0; ai < 2; ++ai)
#pragma unroll
            for (int m = 0; m < 4; ++m) { bf16_t* rowp = base + (size_t)(row0 + ai * HALF + m * 16) * ldc + col0;
#pragma unroll
                for (int bj = 0; bj < 2; ++bj) { f32x4 v0 = acc[ai][bj][m][0] * oscale, v1 = acc[ai][bj][m][1] * oscale;
                    if (kind == 0) { v0 = v0 * qscale; v1 = v1 * qscale; }
                    else if (kind == 3) {
#pragma unroll
                        for (int e = 0; e < 4; ++e) { v0[e] = gelu_tanh_f(v0[e]); v1[e] = gelu_tanh_f(v1[e]); } }
                    else if (kind == 4) {
#pragma unroll
                        for (int e = 0; e < 4; ++e) { v0[e] = sigmoid_f(v0[e]); v1[e] = sigmoid_f(v1[e]); } }
                    *(u32x4*)(rowp + bj * HALF) = pack8(v0, v1); } }
        if (kind == 1 && KM != nullptr) {
            const int b = u.pm >> 3, blk = u.pm & 7;
#pragma unroll
            for (int bj = 0; bj < 2; ++bj)
#pragma unroll
                for (int n = 0; n < 2; ++n) { f32x4 s = (f32x4){0.f, 0.f, 0.f, 0.f};
#pragma unroll
                    for (int ai = 0; ai < 2; ++ai)
#pragma unroll
                        for (int m = 0; m < 4; ++m) s = s + acc[ai][bj][m][n];
#pragma unroll
                    for (int e = 0; e < 4; ++e) { float v = s[e]; v += __shfl_xor(v, 1); v += __shfl_xor(v, 2); v += __shfl_xor(v, 4); v += __shfl_xor(v, 8); s[e] = v; }
                    if (fr == 0) { const int c = colt + bj * HALF + wc * 32 + 8 * fq + 4 * n;
                        float* dst = KM + ((size_t)((b * 8 + (c >> 7)) * 8 + blk)) * 128 + (c & 127);
#pragma unroll
                        for (int e = 0; e < 4; ++e) atomicAdd(dst + e, s[e] * oscale); } }
        }
    }
};
struct EpiStore {
    static constexpr bool PERM = true, AFTER_DRAIN = false, MIDK = false;
    bf16_t* O; int ldc;
    __device__ __forceinline__ void operator()(const f32x4 (&acc)[2][2][4][2], const Unit& u, int wr, int wc, int fr, int fq) const {
        { const int l_ = (int)__builtin_amdgcn_mbcnt_hi(~0u, __builtin_amdgcn_mbcnt_lo(~0u, 0u)); fr = l_ & 15; fq = l_ >> 4; }
        const int row0 = u.pm * BM + wr * 64 + fr, col0 = u.pn * BM + wc * 32 + 8 * fq;
#pragma unroll
        for (int ai = 0; ai < 2; ++ai)
#pragma unroll
            for (int m = 0; m < 4; ++m) { bf16_t* rowp = O + (size_t)(row0 + ai * HALF + m * 16) * ldc + col0;
#pragma unroll
                for (int bj = 0; bj < 2; ++bj) *(u32x4*)(rowp + bj * HALF) = pack8(acc[ai][bj][m][0], acc[ai][bj][m][1]); }
    }
};
struct EpiMerge2 {
    static constexpr bool PERM = true, AFTER_DRAIN = false, MIDK = true;
    const bf16_t* SG; bf16_t* MG; float mgscale;
    __device__ __forceinline__ void midk(f32x4 (&acc)[2][2][4][2], const Unit& u, int wr, int wc, int fr, int fq) const {
        int row0 = u.pm * BM + wr * 64 + fr, col0 = u.pn * BM + wc * 32 + 8 * fq;
        asm volatile("" : "+v"(row0), "+v"(col0));
#pragma unroll
        for (int ai = 0; ai < 2; ++ai)
#pragma unroll
            for (int m = 0; m < 4; ++m) { const size_t row = (size_t)(row0 + ai * HALF + m * 16);
#pragma unroll
                for (int bj = 0; bj < 2; ++bj) { const int col = col0 + bj * HALF;
                    const u32x4 g0 = *(const u32x4*)(SG + row * 4096 + col), g1 = *(const u32x4*)(SG + row * 4096 + 2048 + col);
                    const f32x4 n0 = bf4_lo(g0.x, g0.y), n1 = bf4_lo(g0.z, g0.w), d0 = bf4_lo(g1.x, g1.y), d1 = bf4_lo(g1.z, g1.w);
#pragma unroll
                    for (int e2 = 0; e2 < 4; ++e2) { acc[ai][bj][m][0][e2] *= n0[e2] * __builtin_amdgcn_rcpf(fmaxf(d0[e2], 1e-18f)); acc[ai][bj][m][1][e2] *= n1[e2] * __builtin_amdgcn_rcpf(fmaxf(d1[e2], 1e-18f)); } } }
    }
    __device__ __forceinline__ void operator()(const f32x4 (&acc)[2][2][4][2], const Unit& u, int wr, int wc, int fr, int fq) const {
        { const int l_ = (int)__builtin_amdgcn_mbcnt_hi(~0u, __builtin_amdgcn_mbcnt_lo(~0u, 0u)); fr = l_ & 15; fq = l_ >> 4; }
        const int row0 = u.pm * BM + wr * 64 + fr, col0 = u.pn * BM + wc * 32 + 8 * fq;
#pragma unroll
        for (int ai = 0; ai < 2; ++ai)
#pragma unroll
            for (int m = 0; m < 4; ++m) { const size_t row = (size_t)(row0 + ai * HALF + m * 16);
#pragma unroll
                for (int bj = 0; bj < 2; ++bj) { const int col = col0 + bj * HALF;
                    const u32x4 g1 = *(const u32x4*)(SG + row * 4096 + 2048 + col);
                    const f32x4 v0 = acc[ai][bj][m][0] * bf4_lo(g1.x, g1.y) * mgscale, v1 = acc[ai][bj][m][1] * bf4_lo(g1.z, g1.w) * mgscale;
                    int p0 = __builtin_amdgcn_cvt_pk_fp8_f32(c8(v0[0]), c8(v0[1]), 0, false); p0 = __builtin_amdgcn_cvt_pk_fp8_f32(c8(v0[2]), c8(v0[3]), p0, true);
                    int p1 = __builtin_amdgcn_cvt_pk_fp8_f32(c8(v1[0]), c8(v1[1]), 0, false); p1 = __builtin_amdgcn_cvt_pk_fp8_f32(c8(v1[2]), c8(v1[3]), p1, true);
                    *(unsigned long long*)((unsigned char*)MG + row * 2048 + col) = (unsigned long long)(unsigned)p0 | ((unsigned long long)(unsigned)p1 << 32); } }
    }
};
struct EpiResid {
    static constexpr bool PERM = true, AFTER_DRAIN = false, MIDK = false;
    const float* X; bf16_t* X1B; float* SSP; float oscale;
    __device__ __forceinline__ void operator()(const f32x4 (&acc)[2][2][4][2], const Unit& u, int wr, int wc, int fr, int fq) const {
        { const int l_ = (int)__builtin_amdgcn_mbcnt_hi(~0u, __builtin_amdgcn_mbcnt_lo(~0u, 0u)); fr = l_ & 15; fq = l_ >> 4; }
        const int row0 = u.pm * BM + wr * 64 + fr, col0 = u.pn * BM + wc * 32 + 8 * fq;
#pragma unroll
        for (int ai = 0; ai < 2; ++ai)
#pragma unroll
            for (int m = 0; m < 4; ++m) { const size_t row = (size_t)(row0 + ai * HALF + m * 16); float ss = 0.f;
#pragma unroll
                for (int bj = 0; bj < 2; ++bj) { const int col = col0 + bj * HALF; const float* xp = X + row * 2048 + col;
                    f32x4 v0 = acc[ai][bj][m][0] * oscale + *(const f32x4*)xp, v1 = acc[ai][bj][m][1] * oscale + *(const f32x4*)(xp + 4);
                    *(u32x4*)(X1B + row * 2048 + col) = pack8(v0, v1);
                    ss += (v0[0] * v0[0] + v0[1] * v0[1]) + (v0[2] * v0[2] + v0[3] * v0[3]) + (v1[0] * v1[0] + v1[1] * v1[1]) + (v1[2] * v1[2] + v1[3] * v1[3]); }
                ss += __shfl_xor(ss, 16); ss += __shfl_xor(ss, 32);
                if (fq == 0) SSP[row * 32 + u.pn * 4 + wc] = ss; }
    }
};
struct EpiRowScale {
    static constexpr bool PERM = true, AFTER_DRAIN = false, MIDK = false;
    const float* SSP; bf16_t* O;
    __device__ __forceinline__ void operator()(const f32x4 (&acc)[2][2][4][2], const Unit& u, int wr, int wc, int fr, int fq) const {
        { const int l_ = (int)__builtin_amdgcn_mbcnt_hi(~0u, __builtin_amdgcn_mbcnt_lo(~0u, 0u)); fr = l_ & 15; fq = l_ >> 4; }
        const int row0 = u.pm * BM + wr * 64 + fr, col0 = u.pn * BM + wc * 32 + 8 * fq;
#pragma unroll
        for (int ai = 0; ai < 2; ++ai)
#pragma unroll
            for (int m = 0; m < 4; ++m) { const size_t row = (size_t)(row0 + ai * HALF + m * 16);
                const f32x4 a = *(const f32x4*)(SSP + row * 32 + 8 * fq), b = *(const f32x4*)(SSP + row * 32 + 8 * fq + 4);
                float ss = (a[0] + a[1]) + (a[2] + a[3]) + (b[0] + b[1]) + (b[2] + b[3]);
                ss += __shfl_xor(ss, 16); ss += __shfl_xor(ss, 32);
                const float rs = __builtin_amdgcn_rsqf(ss * (1.f / 2048.f) + 1e-6f);
#pragma unroll
                for (int bj = 0; bj < 2; ++bj) *(u32x4*)(O + row * 2048 + col0 + bj * HALF) = pack8(acc[ai][bj][m][0] * rs, acc[ai][bj][m][1] * rs); }
    }
};
template <class Epi, class Sched, bool ALIGN_EPI = false, bool SP2 = false, bool FP8 = false>
__device__ __forceinline__ void gemm_phase(PG8_LAS unsigned char* lds, const Gemm g, const Sched& S, const Epi& E) {
    const int tid = threadIdx.x, wid = __builtin_amdgcn_readfirstlane(tid >> 6), lane = tid & 63, wr = wid >> 2, wc = wid & 3, fr = lane & 15, fq = lane >> 4;
    const int K = g.K, nt = K / BK;
    const __amdgpu_buffer_rsrc_t rsrc = __builtin_amdgcn_make_buffer_rsrc((void*)g.rbase, 0, (int)g.rbytes, 0x00020000);
    unsigned voffA[2], voffB[2];
#pragma unroll
    for (int i = 0; i < 2; ++i) { int R, C; stage_rc(tid * 16 + i * 8192, R, C); const int Rb = Epi::PERM ? ((R & ~31) + perm32(R & 31)) : R;
        voffA[i] = (unsigned)(R * K + C) * 2u; voffB[i] = (unsigned)(Rb * K + C) * 2u; }
    const size_t kstep = (size_t)(BK * 2);
    const size_t hstep = (size_t)HALF * K * 2;
    const size_t tstep = 2 * hstep;
    const unsigned ldsw = (unsigned)wid * 1024u;
    const int aoff = lds_byte(wr * 64 + fr, fq * 8), boff = lds_byte(wc * 32 + fr, fq * 8);
#define PG8_SA(b, h) (((b) * 2 + (h)) * HTB)
#define PG8_SB(b, h) ((4 + (b) * 2 + (h)) * HTB)
#define PG8_STAGE(bufoff, gbase, voff) do { const unsigned so_ = (unsigned)((const char*)(gbase) - (const char*)g.rbase); _Pragma("unroll") for (int _i = 0; _i < 2; ++_i) \
        __builtin_amdgcn_raw_ptr_buffer_load_lds(rsrc, (PG8_LAS unsigned*)(lds + (bufoff) + ldsw + _i * 8192), 16, (voff)[_i], so_, 0, 0); } while (0)
#define PG8_LDA(dst, b, h) do { _Pragma("unroll") for (int m = 0; m < 4; ++m) { const PG8_LAS unsigned char* p_ = lds + PG8_SA(b, h) + aoff + m * 2048; \
        if constexpr (FP8) dst##8[m] = cat8(*(const PG8_LAS bf16x8*)p_, *(const PG8_LAS bf16x8*)(p_ + 1024)); else { dst[m][0] = *(const PG8_LAS bf16x8*)p_; dst[m][1] = *(const PG8_LAS bf16x8*)(p_ + 1024); } } } while (0)
#define PG8_LDB(dst, b, h) do { _Pragma("unroll") for (int n = 0; n < 2; ++n) { const PG8_LAS unsigned char* p_ = lds + PG8_SB(b, h) + boff + n * 2048; \
        if constexpr (FP8) dst##8[n] = cat8(*(const PG8_LAS bf16x8*)p_, *(const PG8_LAS bf16x8*)(p_ + 1024)); else { dst[n][0] = *(const PG8_LAS bf16x8*)p_; dst[n][1] = *(const PG8_LAS bf16x8*)(p_ + 1024); } } } while (0)
#define PG8_MMA(ai, bj, At, Bt) do { __builtin_amdgcn_s_setprio(1); _Pragma("unroll") for (int m = 0; m < 4; ++m) _Pragma("unroll") for (int n = 0; n < 2; ++n) { \
        if constexpr (FP8) acc[ai][bj][m][n] = __builtin_amdgcn_mfma_scale_f32_16x16x128_f8f6f4(Bt##8[n], At##8[m], acc[ai][bj][m][n], 0, 0, 0, 0x7f7f7f7f, 0, 0x7f7f7f7f); \
        else { _Pragma("unroll") for (int k = 0; k < 2; ++k) acc[ai][bj][m][n] = __builtin_amdgcn_mfma_f32_16x16x32_bf16(Bt[n][k], At[m][k], acc[ai][bj][m][n], 0, 0, 0); } } __builtin_amdgcn_s_setprio(0); } while (0)
#define PG8_WAIT_V(n) asm volatile("s_waitcnt vmcnt(" #n ")" ::: "memory")
#define PG8_WAIT_L(n) asm volatile("s_waitcnt lgkmcnt(" #n ")" ::: "memory")
#define PG8_BAR __builtin_amdgcn_s_barrier()
#define PG8_SCHED __builtin_amdgcn_sched_barrier(0)
    Unit cur, nxt; int ui = 0;
    if (!S.next(0, cur)) return;
    f32x4 acc[2][2][4][2];
#pragma unroll
    for (int a = 0; a < 2; ++a)
#pragma unroll
        for (int b = 0; b < 2; ++b)
#pragma unroll
            for (int m = 0; m < 4; ++m)
#pragma unroll
                for (int n = 0; n < 2; ++n) acc[a][b][m][n] = (f32x4){0.f, 0.f, 0.f, 0.f};
    bf16x8 At[4][2], B0[2][2], B1[2][2];
    i32x8 At8[4], B08[2], B18[2];
    const char* cA = (const char*)(cur.sel ? g.A2 : g.A) + (size_t)cur.pm * tstep; const char* cB = (const char*)(cur.sel ? g.Bt2 : g.Bt) + (size_t)cur.pn * tstep;
    S.a_ready(cur);
    if constexpr (SP2) {
        PG8_STAGE(PG8_SB(0, 0), cB, voffB); PG8_STAGE(PG8_SB(0, 1), cB + hstep, voffB); PG8_STAGE(PG8_SA(0, 0), cA, voffA); PG8_STAGE(PG8_SA(0, 1), cA + hstep, voffA);
        if (wr == 1) PG8_BAR;
        PG8_WAIT_V(2); PG8_BAR;
        PG8_STAGE(PG8_SB(1, 0), cB + kstep, voffB); PG8_STAGE(PG8_SA(1, 0), cA + kstep, voffA); PG8_STAGE(PG8_SB(1, 1), cB + hstep + kstep, voffB);
        PG8_WAIT_V(6); PG8_BAR;
    } else {
        PG8_STAGE(PG8_SB(0, 0), cB, voffB); PG8_STAGE(PG8_SA(0, 0), cA, voffA); PG8_STAGE(PG8_SB(0, 1), cB + hstep, voffB); PG8_STAGE(PG8_SA(0, 1), cA + hstep, voffA);
        if (wr == 1) PG8_BAR;
        PG8_WAIT_V(4); PG8_BAR;
        PG8_STAGE(PG8_SB(1, 0), cB + kstep, voffB); PG8_STAGE(PG8_SA(1, 0), cA + kstep, voffA); PG8_STAGE(PG8_SB(1, 1), cB + hstep + kstep, voffB);
        PG8_WAIT_V(6); PG8_BAR;
    }
    for (;;) {
        const bool has_next = S.next(ui + 1, nxt);
        const char* nA = has_next ? (const char*)(nxt.sel ? g.A2 : g.A) + (size_t)nxt.pm * tstep : cA; const char* nB = has_next ? (const char*)(nxt.sel ? g.Bt2 : g.Bt) + (size_t)nxt.pn * tstep : cB;
        for (int t = 0; t < nt; t += 2) {
            if constexpr (Epi::MIDK) { if (t == nt / 2) E.midk(acc, cur, wr, wc, fr, fq); }
            const bool last = (t == nt - 2);
            const char* a1 = cA + (size_t)(t + 1) * kstep;
            const char* a2 = last ? nA : cA + (size_t)(t + 2) * kstep; const char* b2 = last ? nB : cB + (size_t)(t + 2) * kstep;
            const char* a3 = a2 + kstep; const char* b3 = b2 + kstep;
            if (last && has_next) S.a_ready(nxt);
            if constexpr (SP2) {
            PG8_LDB(B0, 0, 0); PG8_LDB(B1, 0, 1); PG8_SCHED; PG8_LDA(At, 0, 0); PG8_STAGE(PG8_SA(1, 1), a1 + hstep, voffA);
            PG8_WAIT_V(8); PG8_WAIT_L(0); PG8_BAR; PG8_MMA(0, 0, At, B0); PG8_MMA(0, 1, At, B1); PG8_BAR; PG8_SCHED;
            PG8_LDA(At, 0, 1); PG8_STAGE(PG8_SB(0, 0), b2, voffB); PG8_STAGE(PG8_SB(0, 1), b2 + hstep, voffB); PG8_STAGE(PG8_SA(0, 0), a2, voffA);
            PG8_WAIT_V(8); PG8_WAIT_L(0); PG8_BAR; PG8_MMA(1, 0, At, B0); PG8_MMA(1, 1, At, B1); PG8_BAR; PG8_SCHED;
            PG8_LDB(B0, 1, 0); PG8_LDB(B1, 1, 1); PG8_SCHED; PG8_LDA(At, 1, 0); PG8_STAGE(PG8_SA(0, 1), a2 + hstep, voffA);
            PG8_WAIT_V(8); PG8_WAIT_L(0); PG8_BAR; PG8_MMA(0, 0, At, B0); PG8_MMA(0, 1, At, B1); PG8_BAR; PG8_SCHED;
            PG8_LDA(At, 1, 1); PG8_STAGE(PG8_SB(1, 0), b3, voffB); PG8_STAGE(PG8_SB(1, 1), b3 + hstep, voffB); PG8_STAGE(PG8_SA(1, 0), a3, voffA);
            PG8_WAIT_V(8); PG8_WAIT_L(0); PG8_BAR; PG8_MMA(1, 0, At, B0); PG8_MMA(1, 1, At, B1); PG8_BAR; PG8_SCHED;
            } else {
            PG8_LDB(B0, 0, 0); PG8_SCHED; PG8_LDA(At, 0, 0); PG8_STAGE(PG8_SA(1, 1), a1 + hstep, voffA);
            PG8_WAIT_L(8); PG8_BAR; PG8_WAIT_L(0); PG8_MMA(0, 0, At, B0); PG8_BAR; PG8_SCHED;
            PG8_LDB(B1, 0, 1); PG8_STAGE(PG8_SB(0, 0), b2, voffB);
            PG8_BAR; PG8_WAIT_L(0); PG8_MMA(0, 1, At, B1); PG8_BAR;
            PG8_LDA(At, 0, 1); PG8_STAGE(PG8_SA(0, 0), a2, voffA);
            PG8_BAR; PG8_WAIT_L(0); PG8_MMA(1, 0, At, B0); PG8_BAR; PG8_SCHED;
            PG8_STAGE(PG8_SB(0, 1), b2 + hstep, voffB);
            PG8_WAIT_V(6); PG8_BAR; PG8_MMA(1, 1, At, B1); PG8_BAR;
            PG8_LDB(B0, 1, 0); PG8_SCHED; PG8_LDA(At, 1, 0); PG8_STAGE(PG8_SA(0, 1), a2 + hstep, voffA);
            PG8_WAIT_L(8); PG8_BAR; PG8_WAIT_L(0); PG8_MMA(0, 0, At, B0); PG8_BAR; PG8_SCHED;
            PG8_LDB(B1, 1, 1); PG8_STAGE(PG8_SB(1, 0), b3, voffB);
            PG8_BAR; PG8_WAIT_L(0); PG8_MMA(0, 1, At, B1); PG8_BAR;
            PG8_LDA(At, 1, 1); PG8_STAGE(PG8_SA(1, 0), a3, voffA);
            PG8_BAR; PG8_WAIT_L(0); PG8_MMA(1, 0, At, B0); PG8_BAR; PG8_SCHED;
            PG8_STAGE(PG8_SB(1, 1), b3 + hstep, voffB);
            PG8_WAIT_V(6); PG8_BAR; PG8_MMA(1, 1, At, B1); PG8_BAR;
            }
        }
        if constexpr (ALIGN_EPI) { if (wr == 0) PG8_BAR; }
        if constexpr (!Epi::AFTER_DRAIN) { E(acc, cur, wr, wc, fr, fq); S.done(cur); }
        if (!has_next) break;
#pragma unroll
        for (int a = 0; a < 2; ++a)
#pragma unroll
            for (int b = 0; b < 2; ++b)
#pragma unroll
                for (int m = 0; m < 4; ++m)
#pragma unroll
                    for (int n = 0; n < 2; ++n) acc[a][b][m][n] = (f32x4){0.f, 0.f, 0.f, 0.f};
        cur = nxt; cA = nA; cB = nB; ++ui;
        if constexpr (ALIGN_EPI) { if (wr == 1) PG8_BAR; }
    }
    PG8_WAIT_V(0);
    if constexpr (!ALIGN_EPI) { if (wr == 0) PG8_BAR; }
    PG8_BAR;
    if constexpr (Epi::AFTER_DRAIN) { E.fused(acc, cur, wr, wc, fr, fq, lds, wid, lane); S.done(cur); }
#undef PG8_SA
#undef PG8_SB
#undef PG8_STAGE
#undef PG8_LDA
#undef PG8_LDB
#undef PG8_MMA
#undef PG8_WAIT_V
#undef PG8_WAIT_L
#undef PG8_BAR
#undef PG8_SCHED
}
}
#define GAS __attribute__((address_space(1)))
#define LAS __attribute__((address_space(3)))
typedef unsigned short bf16;
typedef unsigned v4u __attribute__((ext_vector_type(4)));
typedef float f32x4 __attribute__((ext_vector_type(4)));
typedef short bf16x8 __attribute__((ext_vector_type(8)));
typedef GAS unsigned gu32;
typedef GAS unsigned long long gu64;
#define RLX_AGENT __ATOMIC_RELAXED, __HIP_MEMORY_SCOPE_AGENT
#define LDS_WAIT() asm volatile("s_waitcnt lgkmcnt(0)" ::: "memory")
#define VM_WAIT() asm volatile("s_waitcnt vmcnt(0)" ::: "memory")
__device__ __forceinline__ unsigned long long rt() { return __builtin_amdgcn_s_memrealtime(); }
__device__ __forceinline__ unsigned f2bf(float f) { unsigned u = __builtin_bit_cast(unsigned, f); return (u + 0x7fffu + ((u >> 16) & 1u)) >> 16; }
__device__ __forceinline__ unsigned pk2(float lo, float hi) { return f2bf(lo) | (f2bf(hi) << 16); }

#define XB_TMO      128
#define XB_XCNT(j)  (256  + 64 * (j))
#define XB_XSUB(j)  (1280 + 64 * (j))
#define XB_XGEN(j)  (2304 + 64 * (j))
#define XB_TOP      3328
#define XB_TOPGEN   3392
#define XCD_BAR_WORDS 3456
#define XB_SPIN_CAP (1u << 18)

__device__ __forceinline__ unsigned xb_ld(unsigned* p)              { return __hip_atomic_load(p, __ATOMIC_RELAXED, __HIP_MEMORY_SCOPE_AGENT); }
__device__ __forceinline__ unsigned xb_add(unsigned* p, unsigned v) { return __hip_atomic_fetch_add(p, v, __ATOMIC_RELAXED, __HIP_MEMORY_SCOPE_AGENT); }
__device__ __forceinline__ unsigned xb_xcc_id() { return (unsigned)__builtin_amdgcn_s_getreg((3 << 11) | 20) & 0xFu; }
#define XB_SPIN(cond, bar) do { unsigned _sp = 0; while (cond) { __builtin_amdgcn_s_sleep(1); \
    if ((++_sp & 255u) == 0u) { if (xb_ld(&(bar)[XB_TMO])) break; if (_sp > XB_SPIN_CAP) { atomicAdd(&(bar)[XB_TMO], 1u); break; } } } } while (0)

struct XcdBarrier {
    unsigned* bar; unsigned x;
    volatile LAS unsigned* st;
};

__device__ __forceinline__ XcdBarrier xcd_barrier_post(unsigned* bar, volatile LAS unsigned* st) {
    XcdBarrier b; b.bar = bar; b.x = xb_xcc_id(); b.st = st;
    if (threadIdx.x == 0) (void)xb_add(&bar[XB_XCNT(b.x)], 1u);
    return b;
}
__device__ __forceinline__ void xcd_barrier_complete(unsigned* bar, unsigned x, unsigned& nloc, unsigned& nx) {
    const unsigned G = gridDim.x * gridDim.y * gridDim.z;
    unsigned sum, cnt, mine, sp = 0u;
    for (;;) {
        sum = 0u; cnt = 0u; mine = 0u;
#pragma unroll
        for (unsigned j = 0; j < 16; ++j) { const unsigned c = xb_ld(&bar[XB_XCNT(j)]); sum += c; cnt += (c > 0u) ? 1u : 0u; mine = (j == x) ? c : mine; }
        if (sum == G) break;
        __builtin_amdgcn_s_sleep(1);
        if ((++sp & 255u) == 0u) { if (xb_ld(&bar[XB_TMO])) break; if (sp > XB_SPIN_CAP) { atomicAdd(&bar[XB_TMO], 1u); break; } }
    }
    nloc = mine > 0u ? mine : 1u; nx = cnt > 0u ? cnt : 1u;
}

__device__ __forceinline__ void xcd_barrier(const XcdBarrier& b) {
    asm volatile("s_waitcnt vmcnt(0)" ::: "memory");
    __syncthreads();
    if (threadIdx.x == 0) {
        unsigned* bar = b.bar;
        __builtin_amdgcn_s_waitcnt(0);
        unsigned nloc = b.st[0], nx = b.st[1];
        if (nloc == 0u) { xcd_barrier_complete(bar, b.x, nloc, nx); b.st[0] = nloc; b.st[1] = nx; }
        const unsigned old = xb_add(&bar[XB_XSUB(b.x)], 1u);
        const unsigned gen = old / nloc;
        if (old + 1u == (gen + 1u) * nloc) {
            __builtin_amdgcn_fence(__ATOMIC_RELEASE, "agent");
            asm volatile("s_waitcnt vmcnt(0)" ::: "memory");
            const unsigned og = xb_add(&bar[XB_TOP], 1u);
            const unsigned tg = og / nx;
            if (og + 1u == (tg + 1u) * nx) xb_add(&bar[XB_TOPGEN], 1u);
            else XB_SPIN(xb_ld(&bar[XB_TOPGEN]) == tg, bar);
            __builtin_amdgcn_fence(__ATOMIC_ACQUIRE, "agent");
            xb_add(&bar[XB_XGEN(b.x)], 1u);
            asm volatile("s_waitcnt vmcnt(0)" ::: "memory");
        } else {
            XB_SPIN(xb_ld(&bar[XB_XGEN(b.x)]) == gen, bar);
            __builtin_amdgcn_fence(__ATOMIC_ACQUIRE, "agent");
            asm volatile("s_waitcnt vmcnt(0)" ::: "memory");
        }
    }
    __syncthreads();
}

constexpr int NWAVES = 8;
constexpr int T_TOK = 8192, DM = 2048, AW = 1024, SEQ = 2048, NHEAD = 8;
constexpr int NWA = 8192;
constexpr int NEXP = 16384;
constexpr float RMS_EPS = 1e-6f, LOG2E = 1.4426950408889634f;
constexpr float W8SCALE = 64.f;
constexpr float OC8SCALE = 8.f, WB8SCALE = 32.f;
constexpr float MG8SCALE = 16.f;
constexpr float QSCALE = 0.08838834764831845f * 1.4426950408889634f;

constexpr size_t MiB = 1u << 20;
constexpr size_t WS_CTL = 0, CTL_ZERO_BYTES = 1 * MiB;
constexpr size_t WS_WA = 2 * MiB;
constexpr size_t WS_WV = 34 * MiB;
constexpr size_t WS_WB = 38 * MiB;
constexpr size_t WS_WO = 46 * MiB;
constexpr size_t WS_WQ = 54 * MiB;
constexpr size_t WS_LWA = 62 * MiB;
constexpr size_t WS_LWX = 62 * MiB + 256 * 1024;
constexpr size_t WS_KEYS = 62 * MiB + 512 * 1024;
constexpr size_t WS_U8 = 64 * MiB;
constexpr size_t WS_V8 = 96 * MiB;
constexpr size_t WS_US = 128 * MiB;
constexpr size_t WS_VS = 128 * MiB + 65536;
constexpr size_t WS_HN = 192 * MiB;
constexpr size_t WS_X1B = WS_HN;
constexpr size_t WS_Q = 224 * MiB;
constexpr size_t WS_K = 240 * MiB;
constexpr size_t WS_VT = 256 * MiB;
constexpr size_t WS_XR = 272 * MiB;
constexpr size_t WS_GY = 288 * MiB;
constexpr size_t WS_SG = 304 * MiB;
constexpr size_t WS_QP = WS_SG;
constexpr size_t WS_OCAT = 368 * MiB;
constexpr size_t WS_HL = 400 * MiB;
constexpr size_t WS_AC = 432 * MiB;
constexpr size_t WS_TMP = WS_HL;
constexpr size_t WS_SUM = 464 * MiB;
constexpr size_t WS_MG = 466 * MiB;
constexpr size_t WS_SSP = 498 * MiB;
constexpr size_t WS_IDX = 500 * MiB;
constexpr size_t WS_G = 504 * MiB;
constexpr size_t WS_PD = WS_Q;
constexpr size_t WS_ACT = WS_VT;
constexpr size_t WS_OUTP = WS_HL;
constexpr size_t WS_END = 508 * MiB;
constexpr int CW_BAR = 4096;
constexpr int CW_XC = 12288;
constexpr int CW_Q2 = 8192;
constexpr int CW_KM = 65536;
static_assert((CW_KM + 32768) * 4 <= (int)CTL_ZERO_BYTES, "CTL");

constexpr int LDS_BYTES = 163840;
constexpr int MISC_OFF = 163840 - 256;
constexpr int SCR_BYTES = MISC_OFF;

typedef float f32x16 __attribute__((ext_vector_type(16)));
typedef float f32x2_t __attribute__((ext_vector_type(2)));
typedef __bf16 bf16x2_t __attribute__((ext_vector_type(2)));
typedef unsigned long long u64;
__device__ __forceinline__ float clamp8(float v) { return fminf(fmaxf(v, -448.f), 448.f); }
__device__ __forceinline__ unsigned cvtpk(float lo, float hi) { f32x2_t v = {lo, hi}; bf16x2_t b = __builtin_convertvector(v, bf16x2_t); return __builtin_bit_cast(unsigned, b); }
__device__ __forceinline__ float bf_lo(unsigned w) { return __builtin_bit_cast(float, w << 16); }
__device__ __forceinline__ float bf_hi(unsigned w) { return __builtin_bit_cast(float, w & 0xffff0000u); }
__device__ __forceinline__ f32x4 bf4_lo2(unsigned a, unsigned b) { f32x4 r; r[0] = bf_lo(a); r[1] = bf_hi(a); r[2] = bf_lo(b); r[3] = bf_hi(b); return r; }
__device__ __forceinline__ float wave_sum(float v) {
#pragma unroll
    for (int o = 1; o < 64; o <<= 1) v += __shfl_xor(v, o);
    return v;
}
__device__ __forceinline__ float dot2bf(unsigned a, unsigned b, float acc) { return __builtin_amdgcn_fdot2_f32_bf16(__builtin_bit_cast(bf16x2_t, a), __builtin_bit_cast(bf16x2_t, b), acc, false); }

struct Params {
    const float *x, *g_mix, *w_in, *conv_w, *conv_b, *lru_wa, *lru_ba, *lru_wx, *lru_bx, *lru_lam, *w_branch, *w_out, *rel_bias, *g_ffn, *peer_wq, *peer_keys, *peer_u, *peer_v, *g_fin;
    float* out; unsigned char* ws; int ph_lo, ph_hi;
};

struct TrD { const float* W; const float* ks; unsigned char* d; int N, k0, n0, ldd; float sc; bool f8; };
__device__ __forceinline__ void tr_load(const TrD& t, int lane, f32x4 (&wv)[8]) {
#pragma unroll
    for (int i = 0; i < 8; ++i) wv[i] = *(const f32x4*)(t.W + (size_t)(t.k0 + (lane >> 3) + 8 * i) * t.N + t.n0 + 4 * (lane & 7));
}
__device__ __forceinline__ void tr_finish(const TrD& t, f32x4 (&wv)[8], LAS float* scr, int lane) {
#pragma unroll
    for (int i = 0; i < 8; ++i) { const int kk = (lane >> 3) + 8 * i; f32x4 v = wv[i]; if (t.ks) v = v * t.ks[t.k0 + kk];
#pragma unroll
        for (int e = 0; e < 4; ++e) scr[kk * 33 + 4 * (lane & 7) + e] = v[e]; }
    LDS_WAIT(); asm volatile("" ::: "memory");
    const int c = lane & 7; const float f8scale = t.sc;
#pragma unroll
    for (int j = 0; j < 4; ++j) { const int n = (lane >> 3) + 8 * j; const LAS float* s = scr + (8 * c) * 33 + n;
        if (t.f8) {
            int p0 = __builtin_amdgcn_cvt_pk_fp8_f32(clamp8(s[0 * 33] * f8scale), clamp8(s[1 * 33] * f8scale), 0, false); p0 = __builtin_amdgcn_cvt_pk_fp8_f32(clamp8(s[2 * 33] * f8scale), clamp8(s[3 * 33] * f8scale), p0, true);
            int p1 = __builtin_amdgcn_cvt_pk_fp8_f32(clamp8(s[4 * 33] * f8scale), clamp8(s[5 * 33] * f8scale), 0, false); p1 = __builtin_amdgcn_cvt_pk_fp8_f32(clamp8(s[6 * 33] * f8scale), clamp8(s[7 * 33] * f8scale), p1, true);
            *(u64*)(t.d + (size_t)n * t.ldd + t.k0 + 8 * c) = (u64)(unsigned)p0 | ((u64)(unsigned)p1 << 32);
        } else {
        v4u o; o.x = cvtpk(s[0 * 33], s[1 * 33]); o.y = cvtpk(s[2 * 33], s[3 * 33]); o.z = cvtpk(s[4 * 33], s[5 * 33]); o.w = cvtpk(s[6 * 33], s[7 * 33]);
        *(v4u*)(t.d + (size_t)n * t.ldd + 2 * (t.k0 + 8 * c)) = o; } }
    LDS_WAIT(); asm volatile("" ::: "memory");
}
template <int MODE> __device__ __forceinline__ void row_to_bf16(const float* src, bf16* dst, const float* colscale, int lane) {
    const f32x4* s = (const f32x4*)src + lane;
    f32x4 v[8]; float ss = 0.f;
#pragma unroll
    for (int j = 0; j < 8; ++j) { v[j] = s[64 * j]; ss += (v[j][0] * v[j][0] + v[j][1] * v[j][1]) + (v[j][2] * v[j][2] + v[j][3] * v[j][3]); }
    float rs = 1.f;
    if (MODE == 1) rs = __builtin_amdgcn_rsqf(wave_sum(ss) * (1.f / 2048.f) + RMS_EPS);
    u64* o8 = (u64*)dst + lane;
#pragma unroll
    for (int j = 0; j < 8; ++j) { f32x4 w = v[j] * rs; if (colscale) w = w * ((const f32x4*)colscale)[64 * j + lane];
        o8[64 * j] = (u64)cvtpk(w[0], w[1]) | ((u64)cvtpk(w[2], w[3]) << 32); }
}
template <bool I8, bool NT = false> __device__ __forceinline__ void row_finish8(f32x4 (&v)[8], unsigned char* dst, float* scale_out, int lane) {
    float am = 0.f;
#pragma unroll
    for (int j = 0; j < 8; ++j) am = fmaxf(am, fmaxf(fmaxf(fabsf(v[j][0]), fabsf(v[j][1])), fmaxf(fabsf(v[j][2]), fabsf(v[j][3]))));
#pragma unroll
    for (int o = 1; o < 64; o <<= 1) am = fmaxf(am, __shfl_xor(am, o));
    const float qmax = I8 ? 127.f : 448.f;
    const float sc = am > 0.f ? am / qmax : 1.f, inv = 1.f / sc;
    unsigned* o4 = (unsigned*)(dst + (size_t)(lane >> 5) * NEXP * 128) + (lane & 31);
#pragma unroll
    for (int j = 0; j < 8; ++j) { unsigned w;
        if (I8) { const int q0 = (int)rintf(v[j][0] * inv), q1 = (int)rintf(v[j][1] * inv), q2 = (int)rintf(v[j][2] * inv), q3 = (int)rintf(v[j][3] * inv);
            w = (unsigned)(q0 & 255) | ((unsigned)(q1 & 255) << 8) | ((unsigned)(q2 & 255) << 16) | ((unsigned)q3 << 24); }
        else { int p = __builtin_amdgcn_cvt_pk_fp8_f32(v[j][0] * inv, v[j][1] * inv, 0, false); p = __builtin_amdgcn_cvt_pk_fp8_f32(v[j][2] * inv, v[j][3] * inv, p, true); w = (unsigned)p; }
        if (NT) __builtin_nontemporal_store(w, o4 + (size_t)(2 * j) * NEXP * 32); else o4[(size_t)(2 * j) * NEXP * 32] = w; }
    if (lane == 0) *scale_out = sc;
}
template <bool I8, int NR = 2, bool NT = false> __device__ __forceinline__ void table_rows8(const float* src, unsigned char* dst, float* scales, const float* colscale, int r0, int r1, int wv, int nwv, int lane) {
    f32x4 cs[8];
#pragma unroll
    for (int j = 0; j < 8; ++j) cs[j] = colscale ? ((const f32x4*)colscale)[64 * j + lane] : (f32x4){1.f, 1.f, 1.f, 1.f};
    for (int m = r0 + wv; m < r1; m += NR * nwv) {
        f32x4 v[NR][8];
#pragma unroll
        for (int q = 0; q < NR; ++q) { const int mq = m + q * nwv; if (mq < r1) {
#pragma unroll
            for (int j = 0; j < 8; ++j) v[q][j] = NT ? __builtin_nontemporal_load((const f32x4*)(src + (size_t)mq * DM) + 64 * j + lane) : ((const f32x4*)(src + (size_t)mq * DM))[64 * j + lane]; } }
#pragma unroll
        for (int q = 0; q < NR; ++q) { const int mq = m + q * nwv; if (mq < r1) {
            if (colscale) {
#pragma unroll
                for (int j = 0; j < 8; ++j) v[q][j] = v[q][j] * cs[j]; }
            row_finish8<I8, NT>(v[q], dst + (size_t)mq * 128, scales + mq, lane); } }
    }
}
template <int NR> __device__ __forceinline__ void peer_table_u(const Params& P, int r0, int r1, int wv, int nwv, int lane) { table_rows8<true, NR>(P.peer_u, P.ws + WS_U8, (float*)(P.ws + WS_US), P.g_ffn, r0, r1, wv, nwv, lane); }
template <int NR, bool NT = false> __device__ __forceinline__ void peer_table_v(const Params& P, int r0, int r1, int wv, int nwv, int lane) { table_rows8<false, NR, NT>(P.peer_v, P.ws + WS_V8, (float*)(P.ws + WS_VS), nullptr, r0, r1, wv, nwv, lane); }
constexpr int TT_PITCH = 260;
constexpr int TT_IN = 16 * 36, TT_BR = 2 * 8 * 8, TT_SQ = 16 * 8, TT_N = TT_IN + TT_BR + 2 * TT_SQ;
static_assert(128 * TT_PITCH * 4 <= MISC_OFF, "transpose tile");
__device__ __forceinline__ TrD tt_decode(const Params& P, int T) {
    unsigned char* ws = P.ws;
    TrD t; t.ks = nullptr; t.f8 = true; t.ldd = 2048; t.sc = W8SCALE;
    if (T < TT_IN) { const int kt = T / 36, nt = T % 36, n0 = 256 * nt; t.W = P.w_in; t.N = 9216; t.k0 = 128 * kt; t.n0 = n0;
        t.d = (n0 < 2048) ? ws + WS_WA + (size_t)n0 * 2048 : (n0 < 3072 ? ws + WS_WV + (size_t)(n0 - 2048) * 2048 : ws + WS_WA + (size_t)(n0 - 1024) * 2048); return t; } T -= TT_IN;
    if (T < TT_BR) { const int br = T / 64, q = T % 64, kt = q / 8, nt = q % 8; t.W = P.w_branch + (size_t)br * 1024 * 2048; t.N = 2048; t.k0 = 128 * kt; t.n0 = 256 * nt; t.sc = WB8SCALE;
        t.d = ws + WS_WB + (size_t)(256 * nt) * 2048 + br * 1024; return t; } T -= TT_BR;
    if (T < TT_SQ) { const int kt = T / 8, nt = T % 8; t.W = P.w_out; t.N = 2048; t.k0 = 128 * kt; t.n0 = 256 * nt; t.d = ws + WS_WO + (size_t)(256 * nt) * 2048; return t; } T -= TT_SQ;
    { const int kt = T / 8, nt = T % 8; t.f8 = false; t.sc = 1.f; t.W = P.peer_wq; t.N = 2048; t.k0 = 128 * kt; t.n0 = 256 * nt; t.ks = P.g_ffn; t.ldd = 4096; t.d = ws + WS_WQ + (size_t)(256 * nt) * 4096; return t; }
}
__device__ __forceinline__ void tt_load(const TrD& t, int wave, int lane, f32x4 (&v)[16]) {
#pragma unroll
    for (int i = 0; i < 16; ++i) v[i] = *(const f32x4*)(t.W + (size_t)(t.k0 + 16 * wave + i) * t.N + t.n0 + 4 * lane);
}
__device__ __forceinline__ void tt_to_lds(const TrD& t, LAS float* tile, int wave, int lane, f32x4 (&v)[16]) {
#pragma unroll
    for (int i = 0; i < 16; ++i) { f32x4 w = v[i] * t.sc; if (t.ks) w = w * t.ks[t.k0 + 16 * wave + i]; *(LAS f32x4*)(tile + (16 * wave + i) * TT_PITCH + 4 * lane) = w; }
}
__device__ __forceinline__ void tt_emit(const TrD& t, const LAS float* tile, int tid) {
    const int n = tid & 255, kh = tid >> 8; const LAS float* s = tile + (64 * kh) * TT_PITCH + n;
    if (t.f8) { unsigned char* o = t.d + (size_t)n * t.ldd + t.k0 + 64 * kh;
#pragma unroll
        for (int q = 0; q < 4; ++q) { v4u w;
#pragma unroll
            for (int e = 0; e < 4; ++e) { const LAS float* z = s + (16 * q + 4 * e) * TT_PITCH;
                int pk = __builtin_amdgcn_cvt_pk_fp8_f32(clamp8(z[0]), clamp8(z[TT_PITCH]), 0, false); pk = __builtin_amdgcn_cvt_pk_fp8_f32(clamp8(z[2 * TT_PITCH]), clamp8(z[3 * TT_PITCH]), pk, true); w[e] = (unsigned)pk; }
            *(v4u*)(o + 16 * q) = w; }
    } else { unsigned char* o = t.d + (size_t)n * t.ldd + 2 * (t.k0 + 64 * kh);
#pragma unroll
        for (int q = 0; q < 8; ++q) { v4u w;
#pragma unroll
            for (int e = 0; e < 4; ++e) { const LAS float* z = s + (8 * q + 2 * e) * TT_PITCH; w[e] = cvtpk(z[0], z[TT_PITCH]); }
            *(v4u*)(o + 16 * q) = w; } }
}
__device__ __forceinline__ TrD tr_decode_lru(const Params& P, int r) {
    TrD t; t.ks = nullptr; t.f8 = false; t.sc = 1.f;
    const int which = r / 64, q = r % 64, g = q / 8, kb = (q % 8) / 4, nb = q % 4;
    t.W = (which ? P.lru_wx : P.lru_wa) + (size_t)g * 16384; t.N = 128; t.k0 = 64 * kb; t.n0 = 32 * nb; t.ldd = 256; t.d = P.ws + (which ? WS_LWX : WS_LWA) + ((size_t)g * 16384 + (size_t)(32 * nb) * 128) * 2; return t;
}
__device__ __forceinline__ void p0_prologue(const Params& P, LAS unsigned char* lds, int gw, int NGW, int wave, int lane, int r1) {
    unsigned char* ws = P.ws;
    const int vcu = gw / NWAVES, G = NGW / NWAVES, tid = wave * 64 + lane;
    { LAS float* tile = (LAS float*)lds; f32x4 v[16];
      int T = vcu; TrD a = tt_decode(P, T < TT_N ? T : 0);
      if (T < TT_N) tt_load(a, wave, lane, v);
      while (T < TT_N) {
          tt_to_lds(a, tile, wave, lane, v);
          __syncthreads();
          const TrD cur = a; const int Tn = T + G;
          if (Tn < TT_N) { a = tt_decode(P, Tn); tt_load(a, wave, lane, v); }
          tt_emit(cur, tile, tid);
          __syncthreads();
          T = Tn; } }
    if (gw < 128) { LAS float* scr = (LAS float*)(lds + wave * 16384); TrD a = tr_decode_lru(P, gw); f32x4 wa[8]; tr_load(a, lane, wa); tr_finish(a, wa, scr, lane); }
#ifdef TPROBE
    *(volatile LAS unsigned*)(lds + MISC_OFF + 4 * 52) = (unsigned)__builtin_amdgcn_s_memrealtime();
#endif
    { bf16* KB = (bf16*)(ws + WS_KEYS);
      for (int i = gw * 64 + lane; i < 262144 / 8; i += NGW * 64) { const f32x4 a = ((const f32x4*)P.peer_keys)[2 * i], b = ((const f32x4*)P.peer_keys)[2 * i + 1];
          v4u o; o.x = cvtpk(a[0], a[1]); o.y = cvtpk(a[2], a[3]); o.z = cvtpk(b[0], b[1]); o.w = cvtpk(b[2], b[3]); ((v4u*)KB)[i] = o; } }
    { unsigned char* HN = ws + WS_HN;
      const int tq = TT_N / G, n_hi = TT_N - tq * G, W = (T_TOK + 16 * TT_N + G - 1) / G, r_hi = W - 16 * (tq + 1), r_lo = W - 16 * tq;
      int r0, cnt;
      if (r_hi >= 0 && n_hi * r_hi + (G - n_hi) * r_lo >= T_TOK) { r0 = vcu < n_hi ? vcu * r_hi : n_hi * r_hi + (vcu - n_hi) * r_lo; cnt = vcu < n_hi ? r_hi : r_lo; }
      else { const int per = (T_TOK + G - 1) / G; r0 = vcu * per; cnt = per; }
      const int rend = (r0 + cnt < T_TOK) ? r0 + cnt : T_TOK;
      for (int m = r0 + wave; m < rend; m += 4 * NWAVES) {
          f32x4 v[4][8];
#pragma unroll
          for (int q = 0; q < 4; ++q) { const int mq = m + q * NWAVES; if (mq < rend) {
#pragma unroll
              for (int j = 0; j < 8; ++j) v[q][j] = ((const f32x4*)(P.x + (size_t)mq * DM))[64 * j + lane]; } }
#pragma unroll
          for (int q = 0; q < 4; ++q) { const int mq = m + q * NWAVES; if (mq < rend) {
              float sa = 0.f;
#pragma unroll
              for (int j = 0; j < 8; ++j) sa += (v[q][j][0] * v[q][j][0] + v[q][j][1] * v[q][j][1]) + (v[q][j][2] * v[q][j][2] + v[q][j][3] * v[q][j][3]);
              const float ra = __builtin_amdgcn_rsqf(wave_sum(sa) * (1.f / 2048.f) + RMS_EPS);
              unsigned* oa = (unsigned*)(HN + (size_t)mq * DM) + lane;
#pragma unroll
              for (int j = 0; j < 8; ++j) { const f32x4 w = v[q][j] * ra * ((const f32x4*)P.g_mix)[64 * j + lane]; int p = __builtin_amdgcn_cvt_pk_fp8_f32(w[0], w[1], 0, false); p = __builtin_amdgcn_cvt_pk_fp8_f32(w[2], w[3], p, true); oa[64 * j] = (unsigned)p; } } } } }
    if (r1 > 0) { peer_table_u<2>(P, 0, r1, gw, NGW, lane); peer_table_v<2>(P, 0, r1, gw, NGW, lane); }
}

constexpr int AT_KT = 0, AT_VT = 2 * 17408, AT_KM = AT_VT + 2 * 18432, AT_B2 = AT_KM + 4096, AT_SEL = AT_B2 + 512, AT_ANY = AT_SEL + 1024;
#define MFMA32(a, b, c) __builtin_amdgcn_mfma_f32_32x32x16_bf16((a), (b), (c), 0, 0, 0)
__device__ __forceinline__ void attn_unit(const Params& P, LAS unsigned char* lds, int b, int h, int blk, int tid, int wave, int lane) {
    unsigned char* ws = P.ws;
    const bf16* Qb = (const bf16*)(ws + WS_Q); const bf16* Kb = (const bf16*)(ws + WS_K); const bf16* VTg = (const bf16*)(ws + WS_VT); bf16* OATT = (bf16*)(ws + WS_OCAT);
    const float* KMg = (const float*)(ws + WS_CTL) + CW_KM;
    LAS float* KMs = (LAS float*)(lds + AT_KM); LAS float* B2 = (LAS float*)(lds + AT_B2); LAS unsigned* SELM = (LAS unsigned*)(lds + AT_SEL); LAS unsigned* UANY = (LAS unsigned*)(lds + AT_ANY);
    const int row_blk0 = b * SEQ + blk * 256;
    __syncthreads();
    for (int i = tid; i < 1024; i += 512) KMs[i] = KMg[(size_t)(b * 8 + h) * 1024 + i] * (1.f / 256.f);
    if (tid < 128) { const int d = tid; int bucket = d;
        if (d >= 16) { bucket = 16 + (int)(__logf((float)d * (1.f / 16.f)) * (16.f / 2.0794415416798357f)); bucket = bucket > 31 ? 31 : bucket; }
        B2[d] = (P.rel_bias[bucket * 8 + h] - P.rel_bias[31 * 8 + h]) * LOG2E; }
    if (tid == 0) *UANY = 0u;
    __syncthreads();
    {
        const int qq = tid >> 1, q2 = tid & 1;
        unsigned mask = (1u << blk) - 1u;
        if (blk > 3) {
            const bf16* qrow = Qb + (size_t)(row_blk0 + qq) * AW + h * 128;
            v4u qv[8];
#pragma unroll
            for (int c8 = 0; c8 < 8; ++c8) qv[c8] = *(const v4u*)(qrow + 8 * (q2 + 2 * c8));
            float g0 = 0.f, g1 = 0.f, g2 = 0.f, g3 = 0.f, g4 = 0.f, g5 = 0.f, g6 = 0.f;
#pragma unroll
            for (int c8 = 0; c8 < 8; ++c8) { const float q[8] = {bf_lo(qv[c8].x), bf_hi(qv[c8].x), bf_lo(qv[c8].y), bf_hi(qv[c8].y), bf_lo(qv[c8].z), bf_hi(qv[c8].z), bf_lo(qv[c8].w), bf_hi(qv[c8].w)};
#pragma unroll
                for (int e = 0; e < 8; ++e) { const LAS float* km = KMs + 8 * (q2 + 2 * c8) + e;
                    g0 += q[e] * km[0]; g1 += q[e] * km[128]; g2 += q[e] * km[256]; g3 += q[e] * km[384]; g4 += q[e] * km[512]; g5 += q[e] * km[640]; g6 += q[e] * km[768]; } }
            g0 += __shfl_xor(g0, 1); g1 += __shfl_xor(g1, 1); g2 += __shfl_xor(g2, 1); g3 += __shfl_xor(g3, 1); g4 += __shfl_xor(g4, 1); g5 += __shfl_xor(g5, 1); g6 += __shfl_xor(g6, 1);
            const float NEGG = -3.0e38f;
            if (blk < 7) g6 = NEGG; if (blk < 6) g5 = NEGG; if (blk < 5) g4 = NEGG;
            mask = 0u;
#pragma unroll
            for (int s = 0; s < 3; ++s) { float best = g0; int bj = 0;
                if (g1 > best) { best = g1; bj = 1; } if (g2 > best) { best = g2; bj = 2; } if (g3 > best) { best = g3; bj = 3; }
                if (g4 > best) { best = g4; bj = 4; } if (g5 > best) { best = g5; bj = 5; } if (g6 > best) { best = g6; bj = 6; }
                mask |= 1u << bj;
                g0 = bj == 0 ? NEGG : g0; g1 = bj == 1 ? NEGG : g1; g2 = bj == 2 ? NEGG : g2; g3 = bj == 3 ? NEGG : g3; g4 = bj == 4 ? NEGG : g4; g5 = bj == 5 ? NEGG : g5; g6 = bj == 6 ? NEGG : g6; }
        }
        if (q2 == 0) { SELM[qq] = mask; __hip_atomic_fetch_or(UANY, mask, __ATOMIC_RELAXED, __HIP_MEMORY_SCOPE_WORKGROUP); }
    }
    __syncthreads();
    const unsigned uany = *UANY;
    unsigned blist = (unsigned)blk; int nb = 1;
    for (int j = blk - 1; j >= 0; --j) if ((uany >> j) & 1u) { blist |= (unsigned)j << (4 * nb); ++nb; }
    const int nsteps = 4 * nb;
    const int qi = 32 * wave + (lane & 31), hh = lane >> 5;
    const unsigned mymask = SELM[qi];
    bf16x8 Qf[8];
    { const bf16* qp = Qb + (size_t)(row_blk0 + qi) * AW + h * 128 + 8 * hh;
#pragma unroll
      for (int ks = 0; ks < 8; ++ks) Qf[ks] = *(const bf16x8*)(qp + 16 * ks); }
    float m_run = -1.0e30f, lsum = 0.f;
    f32x16 O[4];
#pragma unroll
    for (int dt = 0; dt < 4; ++dt)
#pragma unroll
        for (int r = 0; r < 16; ++r) O[dt][r] = 0.f;
    const int kkey0 = tid >> 4, kpart = tid & 15;
    const int vd0 = tid >> 3, vcc = tid & 7;
    const unsigned kl0 = kkey0 * 272 + kpart * 16, kl1 = kl0 + 32 * 272;
    const unsigned vl0 = vd0 * 144 + ((((vcc >> 2) * 2 + ((vcc & 3) >> 1)) * 2) * 16) + (vcc & 1) * 8, vl1 = vl0 + 64 * 144;
    v4u ka0, ka1, va0, va1, kb0, kb1, vb0, vb1;
#define AT_LOAD(s, k0, k1, v0, v1) do { const int j_ = (blist >> (4 * ((s) >> 2))) & 15, kt_ = (s) & 3; const size_t krow0 = (size_t)b * SEQ + j_ * 256 + kt_ * 64; \
        k0 = *(const v4u*)(Kb + (krow0 + kkey0) * AW + h * 128 + kpart * 8); k1 = *(const v4u*)(Kb + (krow0 + kkey0 + 32) * AW + h * 128 + kpart * 8); \
        v0 = *(const v4u*)(VTg + (size_t)(h * 128 + vd0) * T_TOK + krow0 + vcc * 8); v1 = *(const v4u*)(VTg + (size_t)(h * 128 + vd0 + 64) * T_TOK + krow0 + vcc * 8); } while (0)
#define AT_STORE(bufi, k0, k1, v0, v1) do { LAS unsigned char* KT_ = lds + AT_KT + (bufi) * 17408; LAS unsigned char* VT_ = lds + AT_VT + (bufi) * 18432; \
        *(LAS v4u*)(KT_ + kl0) = k0; *(LAS v4u*)(KT_ + kl1) = k1; \
        *(LAS u64*)(VT_ + vl0) = (u64)v0.x | ((u64)v0.y << 32); *(LAS u64*)(VT_ + vl0 + 16) = (u64)v0.z | ((u64)v0.w << 32); \
        *(LAS u64*)(VT_ + vl1) = (u64)v1.x | ((u64)v1.y << 32); *(LAS u64*)(VT_ + vl1 + 16) = (u64)v1.z | ((u64)v1.w << 32); } while (0)
    AT_LOAD(0, ka0, ka1, va0, va1); AT_STORE(0, ka0, ka1, va0, va1);
    if (1 < nsteps) AT_LOAD(1, ka0, ka1, va0, va1);
    if (2 < nsteps) AT_LOAD(2, kb0, kb1, vb0, vb1);
    for (int s = 0; s < nsteps; ++s) {
        const int j = (blist >> (4 * (s >> 2))) & 15, kt = s & 3;
        __syncthreads();
        if ((s & 1) == 0) { if (s + 1 < nsteps) AT_STORE((s + 1) & 1, ka0, ka1, va0, va1); if (s + 3 < nsteps) AT_LOAD(s + 3, ka0, ka1, va0, va1); }
        else              { if (s + 1 < nsteps) AT_STORE((s + 1) & 1, kb0, kb1, vb0, vb1); if (s + 3 < nsteps) AT_LOAD(s + 3, kb0, kb1, vb0, vb1); }
        const LAS unsigned char* KT = lds + AT_KT + (s & 1) * 17408; const LAS unsigned char* VTl = lds + AT_VT + (s & 1) * 18432;
        bool part;
        if (j == blk) part = (64 * kt <= 32 * wave + 31);
        else part = (__ballot((mymask >> j) & 1u) != 0ull);
        if (part) {
            f32x16 S0, S1;
#pragma unroll
            for (int r = 0; r < 16; ++r) { S0[r] = 0.f; S1[r] = 0.f; }
            const LAS unsigned char* kp = KT + (lane & 31) * 272 + hh * 16;
#pragma unroll
            for (int ks = 0; ks < 8; ++ks) { const bf16x8 a0 = *(const LAS bf16x8*)(kp + ks * 32), a1 = *(const LAS bf16x8*)(kp + 32 * 272 + ks * 32);
                S0 = MFMA32(a0, Qf[ks], S0); S1 = MFMA32(a1, Qf[ks], S1); }
            const bool sel = ((mymask >> j) & 1u) != 0u;
            float mx = -1.0e30f; bool ok_row = true;
            const int dmin = 32 * wave + 256 * (blk - j) - 64 * kt - 63;
            if (dmin < 113) {
                const int dbase = (j == blk) ? (qi - 64 * kt - 4 * hh) : (qi + 256 - 64 * kt - 4 * hh);
                const bool okrow = (j == blk) ? true : sel;
#pragma unroll
                for (int r = 0; r < 16; ++r) { const int kk = (r & 3) + 8 * (r >> 2);
                    { const int dist = dbase - kk; const int di = dist < 0 ? 0 : (dist > 127 ? 127 : dist); const float v = (okrow && dist >= 0) ? S0[r] + B2[di] : -1.0e30f; S0[r] = v; mx = fmaxf(mx, v); }
                    { const int dist = dbase - 32 - kk; const int di = dist < 0 ? 0 : (dist > 127 ? 127 : dist); const float v = (okrow && dist >= 0) ? S1[r] + B2[di] : -1.0e30f; S1[r] = v; mx = fmaxf(mx, v); } }
            } else {
                ok_row = sel || (j == blk);
#pragma unroll
                for (int r = 0; r < 16; ++r) mx = fmaxf(mx, fmaxf(S0[r], S1[r]));
                mx = ok_row ? mx : -1.0e30f;
            }
            mx = fmaxf(mx, __shfl_xor(mx, 32));
            const bool need = mx > m_run + 8.f;
            if (__any(need)) { const float m_new = need ? mx : m_run, alpha = __builtin_amdgcn_exp2f(m_run - m_new);
                m_run = m_new; lsum *= alpha;
#pragma unroll
                for (int dt = 0; dt < 4; ++dt)
#pragma unroll
                    for (int r = 0; r < 16; ++r) O[dt][r] *= alpha; }
            float ps = 0.f;
            const float m_eff = ok_row ? m_run : 1.0e30f;
#pragma unroll
            for (int r = 0; r < 16; ++r) { S0[r] = __builtin_amdgcn_exp2f(S0[r] - m_eff); S1[r] = __builtin_amdgcn_exp2f(S1[r] - m_eff); ps += S0[r] + S1[r]; }
            lsum += ps;
            bf16x8 Pf[2][2];
#pragma unroll
            for (int s2 = 0; s2 < 2; ++s2) {
                v4u p0, p1;
                p0.x = cvtpk(S0[8 * s2], S0[8 * s2 + 1]); p0.y = cvtpk(S0[8 * s2 + 2], S0[8 * s2 + 3]); p0.z = cvtpk(S0[8 * s2 + 4], S0[8 * s2 + 5]); p0.w = cvtpk(S0[8 * s2 + 6], S0[8 * s2 + 7]);
                p1.x = cvtpk(S1[8 * s2], S1[8 * s2 + 1]); p1.y = cvtpk(S1[8 * s2 + 2], S1[8 * s2 + 3]); p1.z = cvtpk(S1[8 * s2 + 4], S1[8 * s2 + 5]); p1.w = cvtpk(S1[8 * s2 + 6], S1[8 * s2 + 7]);
                Pf[0][s2] = __builtin_bit_cast(bf16x8, p0); Pf[1][s2] = __builtin_bit_cast(bf16x8, p1); }
            const LAS unsigned char* vp = VTl + (lane & 31) * 144 + hh * 16;
#pragma unroll
            for (int dt = 0; dt < 4; ++dt)
#pragma unroll
                for (int mt = 0; mt < 2; ++mt)
#pragma unroll
                    for (int s2 = 0; s2 < 2; ++s2) { const bf16x8 a = *(const LAS bf16x8*)(vp + dt * 32 * 144 + (mt * 2 + s2) * 32); O[dt] = MFMA32(a, Pf[mt][s2], O[dt]); }
        }
    }
#undef AT_LOAD
#undef AT_STORE
    const float ltot = lsum + __shfl_xor(lsum, 32), inv = 1.f / ltot;
    unsigned char* orow = (unsigned char*)OATT + (size_t)(row_blk0 + qi) * DM + h * 128 + 4 * hh;
    const float osc = inv * OC8SCALE;
#pragma unroll
    for (int dt = 0; dt < 4; ++dt)
#pragma unroll
        for (int g4 = 0; g4 < 4; ++g4) { int p = __builtin_amdgcn_cvt_pk_fp8_f32(clamp8(O[dt][4 * g4] * osc), clamp8(O[dt][4 * g4 + 1] * osc), 0, false); p = __builtin_amdgcn_cvt_pk_fp8_f32(clamp8(O[dt][4 * g4 + 2] * osc), clamp8(O[dt][4 * g4 + 3] * osc), p, true);
            *(unsigned*)(orow + 32 * dt + 8 * g4) = (unsigned)p; }
}
constexpr int LR_XC = 0, LR_SEG = 2 * 17408, LR_W = LR_SEG + 2 * 4096;
#define MFMA16(a, b, c) __builtin_amdgcn_mfma_f32_16x16x32_bf16((a), (b), (c), 0, 0, 0)
__device__ __forceinline__ void lru_pair(const Params& P, LAS unsigned char* lds, int pair, int tid, int wave, int lane, unsigned* tkword, int& tk_next) {
    unsigned char* ws = P.ws;
    const int grp = wave >> 2, wq = wave & 3, tg = tid & 255;
    const int unit = 2 * pair + grp, b = unit >> 8, g = (unit >> 5) & 7, c = unit & 31;
    const bf16* XR = (const bf16*)(ws + WS_XR); const bf16* LWA = (const bf16*)(ws + WS_LWA) + (size_t)g * 16384; const bf16* LWX = (const bf16*)(ws + WS_LWX) + (size_t)g * 16384;
    float* HL = (float*)(ws + WS_HL); float* SUM = (float*)(ws + WS_SUM);
    LAS unsigned short* XC = (LAS unsigned short*)(lds + LR_XC + grp * 17408);
    LAS float* SEG = (LAS float*)(lds + LR_SEG + grp * 4096);
    LAS unsigned char* WL = lds + LR_W;
    const int t0 = c * 64; const size_t R0 = (size_t)b * SEQ + t0;
    __syncthreads();
    {
      v4u wv[8];
#pragma unroll
      for (int i = 0; i < 8; ++i) { const int q = tid + 512 * i, mat = q >> 11, row = (q >> 4) & 127, part = q & 15; wv[i] = *(const v4u*)((mat ? LWX : LWA) + row * 128 + part * 8); }
      const int cpart = tg & 15, C8 = g * 128 + 8 * cpart;
      f32x4 cw[4][2], cbv[2];
#pragma unroll
      for (int w = 0; w < 4; ++w) { cw[w][0] = *(const f32x4*)(P.conv_w + w * 1024 + C8); cw[w][1] = *(const f32x4*)(P.conv_w + w * 1024 + C8 + 4); }
      cbv[0] = *(const f32x4*)(P.conv_b + C8); cbv[1] = *(const f32x4*)(P.conv_b + C8 + 4);
#define LR_CONV_LOAD(xr, base) do { _Pragma("unroll") for (int i2 = 0; i2 < 2; ++i2) { const int tl = (tg >> 4) + 16 * ((base) + i2); \
          _Pragma("unroll") for (int w = 0; w < 4; ++w) { const int ts = t0 + tl - 3 + w; xr[i2][w] = (ts >= 0) ? *(const v4u*)(XR + ((size_t)b * SEQ + ts) * AW + C8) : (v4u){0u, 0u, 0u, 0u}; } } } while (0)
#define LR_CONV_DO(xr, base) do { _Pragma("unroll") for (int i2 = 0; i2 < 2; ++i2) { const int tl = (tg >> 4) + 16 * ((base) + i2); f32x4 y0 = cbv[0], y1 = cbv[1]; \
          _Pragma("unroll") for (int w = 0; w < 4; ++w) { y0 = y0 + bf4_lo2(xr[i2][w].x, xr[i2][w].y) * cw[w][0]; y1 = y1 + bf4_lo2(xr[i2][w].z, xr[i2][w].w) * cw[w][1]; } \
          v4u o; o.x = cvtpk(y0[0], y0[1]); o.y = cvtpk(y0[2], y0[3]); o.z = cvtpk(y1[0], y1[1]); o.w = cvtpk(y1[2], y1[3]); \
          *(LAS v4u*)((LAS unsigned char*)XC + tl * 272 + cpart * 16) = o; } } while (0)
      { v4u xr[2][4]; LR_CONV_LOAD(xr, 0);
#pragma unroll
        for (int i = 0; i < 8; ++i) { const int q = tid + 512 * i, mat = q >> 11, row = (q >> 4) & 127, part = q & 15; *(LAS v4u*)(WL + (mat * 128 + row) * 272 + part * 16) = wv[i]; }
        LR_CONV_DO(xr, 0); }
      { v4u xr[2][4]; LR_CONV_LOAD(xr, 2); LR_CONV_DO(xr, 2); }
#undef LR_CONV_LOAD
#undef LR_CONV_DO
    }
    __syncthreads();
    if (tid == 0) tk_next = (int)__hip_atomic_fetch_add(tkword, 1u, __ATOMIC_RELAXED, __HIP_MEMORY_SCOPE_AGENT);
    const int fr = lane & 15, fq = lane >> 4;
    float Ar[2][4][4], Hr[2][4][4], AE[2][4], HE[2][4];
#pragma unroll
    for (int nh = 0; nh < 2; ++nh) {
        f32x4 aA[4], aX[4];
#pragma unroll
        for (int nt = 0; nt < 4; ++nt) { aA[nt] = (f32x4){0.f, 0.f, 0.f, 0.f}; aX[nt] = (f32x4){0.f, 0.f, 0.f, 0.f}; }
#pragma unroll 1
        for (int ks = 0; ks < 4; ++ks) { const bf16x8 a = *(const LAS bf16x8*)((LAS unsigned char*)XC + (16 * wq + fr) * 272 + (32 * ks + 8 * fq) * 2);
#pragma unroll
            for (int nt = 0; nt < 4; ++nt) { const int wo = (64 * nh + 16 * nt + fr) * 272 + (32 * ks + 8 * fq) * 2;
                const bf16x8 ba = *(const LAS bf16x8*)(WL + wo), bx = *(const LAS bf16x8*)(WL + 128 * 272 + wo);
                aA[nt] = MFMA16(a, ba, aA[nt]); aX[nt] = MFMA16(a, bx, aX[nt]); } }
#pragma unroll
        for (int nt = 0; nt < 4; ++nt) { const int ch = 64 * nh + 16 * nt + fr, C = g * 128 + ch;
            const float ba = P.lru_ba[C], bx = P.lru_bx[C], lam = P.lru_lam[C];
            const float sp8 = 8.f * log1pf(__expf(-lam));
            float Ac = 1.f, Hc = 0.f;
#pragma unroll
            for (int r = 0; r < 4; ++r) { const int tok = 16 * wq + 4 * fq + r;
                const float rg = pg8::sigmoid_f(aA[nt][r] + ba), ig = pg8::sigmoid_f(aX[nt][r] + bx);
                const float log_a = -rg * sp8, a = __builtin_amdgcn_exp2f(log_a * 1.4426950408889634f);
                const float y = 2.f * log_a;
                const float em = (y > -0.25f) ? -y * (1.f + y * (0.5f + y * (0.16666667f + y * (0.041666668f + y * (0.0083333338f + y * 0.0013888889f))))) : 1.f - a * a;
                const float u = __builtin_amdgcn_sqrtf(em) * (ig * bf_lo((unsigned)XC[tok * 136 + ch]));
                Hc = a * Hc + u; Ac *= a; Ar[nh][nt][r] = Ac; Hr[nh][nt][r] = Hc; }
            float AI = Ac, HI = Hc;
            { const float Ap = __shfl_up(AI, 16), Hp = __shfl_up(HI, 16); if (fq >= 1) { HI = AI * Hp + HI; AI = AI * Ap; } }
            { const float Ap = __shfl_up(AI, 32), Hp = __shfl_up(HI, 32); if (fq >= 2) { HI = AI * Hp + HI; AI = AI * Ap; } }
            { const float Ap = __shfl_up(AI, 16), Hp = __shfl_up(HI, 16); AE[nh][nt] = fq >= 1 ? Ap : 1.f; HE[nh][nt] = fq >= 1 ? Hp : 0.f; }
            if (fq == 3) { SEG[(wq * 128 + ch) * 2] = AI; SEG[(wq * 128 + ch) * 2 + 1] = HI; } }
    }
    __syncthreads();
#pragma unroll
    for (int nh = 0; nh < 2; ++nh)
#pragma unroll
        for (int nt = 0; nt < 4; ++nt) { const int ch = 64 * nh + 16 * nt + fr, C = g * 128 + ch;
            float Aw = 1.f, Hw = 0.f;
#pragma unroll
            for (int w2 = 0; w2 < 3; ++w2) if (w2 < wq) { const float As = SEG[(w2 * 128 + ch) * 2], Hs = SEG[(w2 * 128 + ch) * 2 + 1]; Hw = As * Hw + Hs; Aw *= As; }
            const float hin = AE[nh][nt] * Hw + HE[nh][nt], ain = AE[nh][nt] * Aw;
            unsigned* ha = (unsigned*)HL + (R0 + 16 * wq + 4 * fq) * AW + C;
#pragma unroll
            for (int r = 0; r < 4; ++r) ha[(size_t)r * AW] = cvtpk(Ar[nh][nt][r] * hin + Hr[nh][nt][r], Ar[nh][nt][r] * ain);
            if (wq == 3 && fq == 3) { float* sm = SUM + ((size_t)(b * 32 + c) * 1024 + C) * 2; sm[0] = Ar[nh][nt][3] * ain; sm[1] = Ar[nh][nt][3] * hin + Hr[nh][nt][3]; } }
}

constexpr int SC_STR = 129, P7_SAB = 2 * 128 * SC_STR * 4, P7_IL = P7_SAB + 128 * 33 * 4, P7_CT = P7_IL + 128 * 34 * 2;
static_assert(P7_CT + 64 <= MISC_OFF, "P7 LDS map");
__device__ __forceinline__ unsigned ord_key(float v) { const unsigned u = __builtin_bit_cast(unsigned, v); return (u & 0x80000000u) ? ~u : (u | 0x80000000u); }
#define CE_DESC(x, y) do { const unsigned _x = (x), _y = (y); (x) = _x > _y ? _x : _y; (y) = _x > _y ? _y : _x; } while (0)
template <int B, int NA> __device__ __forceinline__ void sort16_desc(unsigned (&a)[NA]) {
#pragma unroll
    for (int k = 2; k <= 16; k <<= 1)
#pragma unroll
        for (int j = k >> 1; j > 0; j >>= 1)
#pragma unroll
            for (int i = 0; i < 16; ++i) { const int l = i ^ j; if (l > i) { if ((i & k) == 0) CE_DESC(a[B + i], a[B + l]); else CE_DESC(a[B + l], a[B + i]); } }
}
template <int A, int Bo, int NA, int NB> __device__ __forceinline__ void merge16_desc(unsigned (&a)[NA], const unsigned (&b)[NB]) {
#pragma unroll
    for (int i = 0; i < 16; ++i) a[A + i] = a[A + i] > b[Bo + 15 - i] ? a[A + i] : b[Bo + 15 - i];
#pragma unroll
    for (int j = 8; j > 0; j >>= 1)
#pragma unroll
        for (int i = 0; i < 16; ++i) { const int l = i ^ j; if (l > i) CE_DESC(a[A + i], a[A + l]); }
}
__device__ __forceinline__ void peer_topk_unit(const Params& P, LAS unsigned char* lds, int t0, int h, int tid, int wave, int lane) {
    unsigned char* ws = P.ws;
    const bf16* QP = (const bf16*)(ws + WS_QP); const bf16* KEYS = (const bf16*)(ws + WS_KEYS);
    int* IDX = (int*)(ws + WS_IDX); float* GW = (float*)(ws + WS_G);
    LAS float* SC = (LAS float*)lds; LAS float* SAB = (LAS float*)(lds + P7_SAB); LAS unsigned short* IL = (LAS unsigned short*)(lds + P7_IL); LAS unsigned char* CT = lds + P7_CT;
    __syncthreads();
    if (tid < 64) { int ia = 0, rem = tid; while (ia < 16 && rem >= 16 / (ia + 1)) { rem -= 16 / (ia + 1); ++ia; }
        CT[tid] = (unsigned char)(ia < 16 ? ia * 16 + rem : 255); }
    { const int mtile = wave & 3, c = wave >> 2, r31 = lane & 31, hh = lane >> 5;
      bf16x8 A[8];
      const bf16* qp = QP + (size_t)(t0 + 32 * mtile + r31) * DM + h * 256 + c * 128 + 8 * hh;
#pragma unroll
      for (int ks = 0; ks < 8; ++ks) A[ks] = *(const bf16x8*)(qp + 16 * ks);
#pragma unroll
      for (int nt = 0; nt < 4; ++nt) { f32x16 acc;
#pragma unroll
          for (int r = 0; r < 16; ++r) acc[r] = 0.f;
          const bf16* kp = KEYS + ((size_t)((h * 2 + c) * 128 + 32 * nt + r31)) * 128 + 8 * hh;
#pragma unroll
          for (int ks = 0; ks < 8; ++ks) { const bf16x8 bk = *(const bf16x8*)(kp + 16 * ks); acc = MFMA32(A[ks], bk, acc); }
#pragma unroll
          for (int r = 0; r < 16; ++r) { const int tok = 32 * mtile + (r & 3) + 8 * (r >> 2) + 4 * hh; SC[(c * 128 + tok) * SC_STR + 32 * nt + r31] = acc[r]; } } }
    __syncthreads();
    const int half = tid & 1, c = (tid >> 1) & 1, tok = tid >> 2;
    unsigned a[64];
    { const LAS float* sp = SC + (c * 128 + tok) * SC_STR + half * 64; const int rot = 8 * (2 * c + half);
#pragma unroll
      for (int i = 0; i < 64; ++i) { const int n = (i + rot) & 63; a[i] = (ord_key(sp[n]) & ~127u) | (unsigned)(127 - (half * 64 + n)); } }
    sort16_desc<0>(a); sort16_desc<16>(a); sort16_desc<32>(a); sort16_desc<48>(a);
    merge16_desc<0, 16>(a, a); merge16_desc<32, 48>(a, a); merge16_desc<0, 32>(a, a);
    { unsigned o[16];
#pragma unroll
      for (int j = 0; j < 16; ++j) o[j] = (unsigned)__shfl_xor((int)a[j], 1);
      merge16_desc<0, 0>(a, o); }
    if (half == 0) {
#pragma unroll
        for (int j = 0; j < 16; ++j) { const int n = 127 - (int)(a[j] & 127u); SAB[tok * 33 + c * 16 + j] = SC[(c * 128 + tok) * SC_STR + n]; IL[tok * 34 + c * 16 + j] = (unsigned short)n; } }
    __syncthreads();
    const int q = tid & 3;
    unsigned cd[16];
#pragma unroll
    for (int j = 0; j < 13; ++j) { const unsigned code = CT[q + 4 * j]; const float s = SAB[tok * 33 + ((code >> 4) & 15u)] + SAB[tok * 33 + 16 + (code & 15u)];
        cd[j] = code == 255u ? 0u : ((ord_key(s) & ~255u) | (255u - code)); }
    cd[13] = 0u; cd[14] = 0u; cd[15] = 0u;
    sort16_desc<0>(cd);
    { unsigned o[16];
#pragma unroll
      for (int j = 0; j < 16; ++j) o[j] = (unsigned)__shfl_xor((int)cd[j], 1);
      merge16_desc<0, 0>(cd, o);
#pragma unroll
      for (int j = 0; j < 16; ++j) o[j] = (unsigned)__shfl_xor((int)cd[j], 2);
      merge16_desc<0, 0>(cd, o); }
    if (q == 0) {
        float cv[16]; int id[16];
#pragma unroll
        for (int s = 0; s < 16; ++s) { const unsigned code = 255u - (cd[s] & 255u); const int ia = (int)(code >> 4), ib = (int)(code & 15u); const int na = IL[tok * 34 + ia], nb = IL[tok * 34 + 16 + ib];
            cv[s] = SAB[tok * 33 + ia] + SAB[tok * 33 + 16 + ib]; id[s] = na * 128 + nb; }
        float mx = cv[0];
#pragma unroll
        for (int s = 1; s < 16; ++s) mx = fmaxf(mx, cv[s]);
        float sum = 0.f;
#pragma unroll
        for (int s = 0; s < 16; ++s) { cv[s] = __builtin_amdgcn_exp2f((cv[s] - mx) * LOG2E); sum += cv[s]; }
        const float inv = 1.f / sum;
        int* ip = IDX + (size_t)(t0 + tok) * 128 + h * 16; float* gp = GW + (size_t)(t0 + tok) * 128 + h * 16;
#pragma unroll
        for (int s4 = 0; s4 < 4; ++s4) { *(int4*)(ip + 4 * s4) = make_int4(id[4 * s4], id[4 * s4 + 1], id[4 * s4 + 2], id[4 * s4 + 3]);
            *(f32x4*)(gp + 4 * s4) = (f32x4){cv[4 * s4] * inv, cv[4 * s4 + 1] * inv, cv[4 * s4 + 2] * inv, cv[4 * s4 + 3] * inv}; }
    }
}

__device__ __forceinline__ void fp8x16_to_f32(const v4u& w, float (&f)[16]) {
#pragma unroll
    for (int i = 0; i < 4; ++i) { const f32x2_t lo = __builtin_amdgcn_cvt_pk_f32_fp8((int)w[i], false), hi = __builtin_amdgcn_cvt_pk_f32_fp8((int)w[i], true);
        f[4 * i] = lo[0]; f[4 * i + 1] = lo[1]; f[4 * i + 2] = hi[0]; f[4 * i + 3] = hi[1]; }
}
#define LD16I(dst, p) do { _Pragma("unroll") for (int q_ = 0; q_ < 4; ++q_) { const int4 v_ = ((const int4*)(p))[q_]; dst[4 * q_] = v_.x; dst[4 * q_ + 1] = v_.y; dst[4 * q_ + 2] = v_.z; dst[4 * q_ + 3] = v_.w; } } while (0)
#define LD16F(dst, p) do { _Pragma("unroll") for (int q_ = 0; q_ < 4; ++q_) { const f32x4 v_ = ((const f32x4*)(p))[q_]; dst[4 * q_] = v_[0]; dst[4 * q_ + 1] = v_[1]; dst[4 * q_ + 2] = v_[2]; dst[4 * q_ + 3] = v_[3]; } } while (0)
__device__ __forceinline__ void peer_u_phase(const Params& P, int xg, int slot, int nslots, int lane) {
    unsigned char* ws = P.ws;
    const bf16* X1B = (const bf16*)(ws + WS_X1B); const unsigned char* U8 = ws + WS_U8; const int* IDX = (const int*)(ws + WS_IDX); float* PD = (float*)(ws + WS_PD) + (size_t)xg * T_TOK * 128;
    const int ntok = slot < T_TOK ? (T_TOK - slot + nslots - 1) / nslots : 0, N = 2 * ntok;
    if (N == 0) return;
    const int R = lane >> 3, p = lane & 7;
    const bool b2 = (lane & 4) != 0, b1 = (lane & 2) != 0, b0 = (lane & 1) != 0;
    int I0[16], I1[16], I2[16]; v4u X0[2], X1[2], X2[2]; v4u B0[8], B1[8], B2[8];
#define U_ITEM(n, t, s) const int n_##t = (n) < N ? (n) : N - 1; const int t = slot + (n_##t >= ntok ? n_##t - ntok : n_##t) * nslots, s = 2 * xg + (n_##t >= ntok ? 1 : 0)
#define U_ROWS(buf, ids, off, s) do { const unsigned char* ub_ = U8 + (size_t)(s) * NEXP * 128; _Pragma("unroll") for (int i = 0; i < 8; ++i) buf[i] = *(const v4u*)(ub_ + (unsigned)(((unsigned)ids[(off) + i] << 7) + 16u * p)); } while (0)
#define U_HALF(buf, off) do { _Pragma("unroll") for (int i = 0; i < 8; ++i) { int d = 0; _Pragma("unroll") for (int w = 0; w < 4; ++w) d = __builtin_amdgcn_sdot4((int)buf[i][w], xq[w], d, false); part[(off) + i] = d; } } while (0)
#define U_X(dst, t, s) do { const bf16* xp_ = X1B + (size_t)(t) * DM + 128 * (s) + 16 * p; dst[0] = *(const v4u*)xp_; dst[1] = *(const v4u*)(xp_ + 8); } while (0)
    const int i0 = ((lane & 4) ? 8 : 0) + ((lane & 2) ? 4 : 0) + ((lane & 1) ? 2 : 0);
    { U_ITEM(0, t0, s0); U_ITEM(1, t1, s1); U_ITEM(2, t2, s2);
      int id0[16];
      LD16I(id0, IDX + (size_t)t0 * 128 + 16 * R); LD16I(I0, IDX + (size_t)t1 * 128 + 16 * R); LD16I(I1, IDX + (size_t)t2 * 128 + 16 * R);
      U_X(X0, t0, s0); U_X(X1, t1, s1);
      U_ROWS(B0, id0, 0, s0); U_ROWS(B1, id0, 8, s0); }
#define U_BODY(n, Ba, Bb, Bc, Ia, Ib, Ic, Xa, Xb, Xc) do { \
        U_ITEM(n, t, s); U_ITEM((n) + 1, t1, s1); U_ITEM((n) + 2, t2, s2); U_ITEM((n) + 3, t3, s3); (void)s; (void)s3; \
        f32x2_t* pp = (f32x2_t*)(PD + (size_t)t * 128 + 16 * R + i0); \
        f32x2_t pold = (f32x2_t){0.f, 0.f}; if ((n) >= ntok) pold = *pp; \
        U_ROWS(Bc, Ia, 0, s1); \
        LD16I(Ic, IDX + (size_t)t3 * 128 + 16 * R); \
        U_X(Xc, t2, s2); \
        float x[16]; float am = 0.f; \
        _Pragma("unroll") for (int k = 0; k < 4; ++k) { x[2 * k] = bf_lo(Xa[0][k]); x[2 * k + 1] = bf_hi(Xa[0][k]); x[8 + 2 * k] = bf_lo(Xa[1][k]); x[8 + 2 * k + 1] = bf_hi(Xa[1][k]); } \
        _Pragma("unroll") for (int k = 0; k < 16; ++k) am = fmaxf(am, fabsf(x[k])); \
        am = fmaxf(am, __shfl_xor(am, 1)); am = fmaxf(am, __shfl_xor(am, 2)); am = fmaxf(am, __shfl_xor(am, 4)); \
        const float xs = am > 0.f ? am * (1.f / 127.f) : 1.f, xinv = 1.f / xs; \
        int xq[4]; \
        _Pragma("unroll") for (int w = 0; w < 4; ++w) { const int q0 = (int)rintf(x[4 * w] * xinv), q1 = (int)rintf(x[4 * w + 1] * xinv), q2 = (int)rintf(x[4 * w + 2] * xinv), q3 = (int)rintf(x[4 * w + 3] * xinv); \
            xq[w] = (int)((unsigned)(q0 & 255) | ((unsigned)(q1 & 255) << 8) | ((unsigned)(q2 & 255) << 16) | ((unsigned)q3 << 24)); } \
        int part[16]; \
        U_HALF(Ba, 0); \
        U_ROWS(Ba, Ia, 8, s1); \
        U_HALF(Bb, 8); \
        if ((n) < N) { \
            int a8[8], a4[4], a2i[2]; \
            _Pragma("unroll") for (int k = 0; k < 8; ++k) { const int send = b2 ? part[k] : part[k + 8], keep = b2 ? part[k + 8] : part[k]; a8[k] = keep + __shfl_xor(send, 4); } \
            _Pragma("unroll") for (int k = 0; k < 4; ++k) { const int send = b1 ? a8[k] : a8[k + 4], keep = b1 ? a8[k + 4] : a8[k]; a4[k] = keep + __shfl_xor(send, 2); } \
            _Pragma("unroll") for (int k = 0; k < 2; ++k) { const int send = b0 ? a4[k] : a4[k + 2], keep = b0 ? a4[k + 2] : a4[k]; a2i[k] = keep + __shfl_xor(send, 1); } \
            *pp = (f32x2_t){(float)a2i[0] * xs, (float)a2i[1] * xs} + pold; } } while (0)
    for (int n = 0; n < N; n += 3) { U_BODY(n, B0, B1, B2, I0, I1, I2, X0, X1, X2); U_BODY(n + 1, B2, B0, B1, I1, I2, I0, X1, X2, X0); U_BODY(n + 2, B1, B2, B0, I2, I0, I1, X2, X0, X1); }
#undef U_X
#undef U_ITEM
#undef U_ROWS
#undef U_HALF
#undef U_BODY
}
__device__ __forceinline__ void peer_act_tokens(const Params& P, int t, int t2, int lane) {
    unsigned char* ws = P.ws;
    const float* PD = (const float*)(ws + WS_PD); const int* IDX = (const int*)(ws + WS_IDX); const float* GW = (const float*)(ws + WS_G); const float* SSP = (const float*)(ws + WS_SSP);
    const float* US = (const float*)(ws + WS_US); const float* VS = (const float*)(ws + WS_VS); float* ACT = (float*)(ws + WS_ACT);
    const bool two = t2 >= 0; const int tt[2] = {t, two ? t2 : t};
    float ss[2], d[2][2], gw[2][2], us[2][2], vs[2][2]; int id[2][2];
#pragma unroll
    for (int k = 0; k < 2; ++k) { ss[k] = lane < 32 ? SSP[(size_t)tt[k] * 32 + lane] : 0.f;
#pragma unroll
        for (int s = 0; s < 2; ++s) { const int slot = 64 * s + lane; id[k][s] = IDX[(size_t)tt[k] * 128 + slot]; gw[k][s] = GW[(size_t)tt[k] * 128 + slot]; float a = 0.f;
#pragma unroll
            for (int xg = 0; xg < 8; ++xg) a += PD[((size_t)xg * T_TOK + tt[k]) * 128 + slot];
            d[k][s] = a; } }
#pragma unroll
    for (int k = 0; k < 2; ++k)
#pragma unroll
        for (int s = 0; s < 2; ++s) { us[k][s] = US[id[k][s]]; vs[k][s] = VS[id[k][s]]; }
#pragma unroll
    for (int k = 0; k < 2; ++k) { const float rs = __builtin_amdgcn_rsqf(wave_sum(ss[k]) * (1.f / 2048.f) + RMS_EPS);
        if (k == 0 || two) {
#pragma unroll
            for (int s = 0; s < 2; ++s) ACT[(size_t)tt[k] * 128 + 64 * s + lane] = pg8::gelu_tanh_f(d[k][s] * us[k][s] * rs) * gw[k][s] * vs[k][s]; } }
}
#define PIN16(a) asm volatile("" : "+v"(a[0]), "+v"(a[1]), "+v"(a[2]), "+v"(a[3]), "+v"(a[4]), "+v"(a[5]), "+v"(a[6]), "+v"(a[7]), "+v"(a[8]), "+v"(a[9]), "+v"(a[10]), "+v"(a[11]), "+v"(a[12]), "+v"(a[13]), "+v"(a[14]), "+v"(a[15]))
__device__ __forceinline__ void peer_v_phase(const Params& P, int xg, int slot, int nslots, int lane) {
    unsigned char* ws = P.ws;
    const unsigned char* V8 = ws + WS_V8; const int* IDX = (const int*)(ws + WS_IDX); const float* ACT = (const float*)(ws + WS_ACT); bf16* OUTP = (bf16*)(ws + WS_OUTP);
    const int ntok = slot < T_TOK ? (T_TOK - slot + nslots - 1) / nslots : 0, N = 2 * ntok;
    if (N == 0) return;
    const int R = lane >> 3, p = lane & 7;
    const bool b5 = (lane & 32) != 0, b4 = (lane & 16) != 0, b3 = (lane & 8) != 0;
    int I0[16], I1[16], I2[16]; float A0[16], A1[16], A2[16]; v4u B0[8], B1[8], B2[8];
#define V_ITEM(n, t, s) const int n_##t = (n) < N ? (n) : N - 1; const int t = slot + (n_##t >= ntok ? n_##t - ntok : n_##t) * nslots, s = 2 * xg + (n_##t >= ntok ? 1 : 0)
#define V_ROWS(buf, ids, off, s) do { const unsigned char* vb_ = V8 + (size_t)(s) * NEXP * 128; _Pragma("unroll") for (int i = 0; i < 8; ++i) buf[i] = *(const v4u*)(vb_ + (unsigned)(((unsigned)ids[(off) + i] << 7) + 16u * p)); } while (0)
#define V_HALF(buf, av, off) do { _Pragma("unroll") for (int i = 0; i < 8; ++i) { asm volatile("" : "+v"(buf[i][0]), "+v"(buf[i][1]), "+v"(buf[i][2]), "+v"(buf[i][3])); \
            float f[16]; fp8x16_to_f32(buf[i], f); _Pragma("unroll") for (int k = 0; k < 16; ++k) acc[k] += av[(off) + i] * f[k]; PIN16(acc); } } while (0)
    { V_ITEM(0, t0, s0); V_ITEM(1, t1, s1); V_ITEM(2, t2, s2); (void)s1; (void)s2;
      int id0[16];
      LD16I(id0, IDX + (size_t)t0 * 128 + 16 * R); LD16I(I0, IDX + (size_t)t1 * 128 + 16 * R); LD16I(I1, IDX + (size_t)t2 * 128 + 16 * R);
      LD16F(A0, ACT + (size_t)t0 * 128 + 16 * R); LD16F(A1, ACT + (size_t)t1 * 128 + 16 * R);
      V_ROWS(B0, id0, 0, s0); V_ROWS(B1, id0, 8, s0); }
#define V_BODY(n, Ba, Bb, Bc, Ia, Ib, Ic, Aa, Ab, Ac) do { \
        V_ITEM(n, t, s); V_ITEM((n) + 1, t1, s1); V_ITEM((n) + 2, t2, s2); V_ITEM((n) + 3, t3, s3); (void)s2; (void)s3; \
        V_ROWS(Bc, Ia, 0, s1); \
        LD16I(Ic, IDX + (size_t)t3 * 128 + 16 * R); LD16F(Ac, ACT + (size_t)t2 * 128 + 16 * R); \
        float acc[16]; \
        _Pragma("unroll") for (int k = 0; k < 16; ++k) acc[k] = 0.f; \
        V_HALF(Ba, Aa, 0); \
        V_ROWS(Ba, Ia, 8, s1); \
        V_HALF(Bb, Aa, 8); \
        if ((n) < N) { \
            float a8[8], a4[4], a2[2]; \
            _Pragma("unroll") for (int k = 0; k < 8; ++k) { const float send = b5 ? acc[k] : acc[k + 8], keep = b5 ? acc[k + 8] : acc[k]; a8[k] = keep + __shfl_xor(send, 32); } \
            _Pragma("unroll") for (int k = 0; k < 4; ++k) { const float send = b4 ? a8[k] : a8[k + 4], keep = b4 ? a8[k + 4] : a8[k]; a4[k] = keep + __shfl_xor(send, 16); } \
            _Pragma("unroll") for (int k = 0; k < 2; ++k) { const float send = b3 ? a4[k] : a4[k + 2], keep = b3 ? a4[k + 2] : a4[k]; a2[k] = keep + __shfl_xor(send, 8); } \
            const int col = 128 * s + 16 * p + (b5 ? 8 : 0) + (b4 ? 4 : 0) + (b3 ? 2 : 0); \
            *(unsigned*)(OUTP + (size_t)t * DM + col) = cvtpk(a2[0], a2[1]); } } while (0)
    for (int n = 0; n < N; n += 3) { V_BODY(n, B0, B1, B2, I0, I1, I2, A0, A1, A2); V_BODY(n + 1, B2, B0, B1, I1, I2, I0, A1, A2, A0); V_BODY(n + 2, B1, B2, B0, I2, I0, I1, A2, A0, A1); }
#undef V_ITEM
#undef V_ROWS
#undef V_HALF
#undef V_BODY
}
__device__ __forceinline__ void peer_final_tokens(const Params& P, int t, int t2, int lane, float* outp) {
    const bool two = t2 >= 0; const int tt[2] = {t, two ? t2 : t};
    v4u a[2][4], b[2][4];
#pragma unroll
    for (int k = 0; k < 2; ++k) { const bf16* xrow = (const bf16*)(P.ws + WS_X1B) + (size_t)tt[k] * DM; const bf16* prow = (const bf16*)(P.ws + WS_OUTP) + (size_t)tt[k] * DM;
#pragma unroll
        for (int j = 0; j < 4; ++j) { a[k][j] = *(const v4u*)(xrow + 512 * j + 8 * lane); b[k][j] = *(const v4u*)(prow + 512 * j + 8 * lane); } }
#pragma unroll
    for (int k = 0; k < 2; ++k) { if (k == 1 && !two) break;
        float v[4][8]; float ss = 0.f;
#pragma unroll
        for (int j = 0; j < 4; ++j) {
#pragma unroll
            for (int i = 0; i < 4; ++i) { v[j][2 * i] = bf_lo(a[k][j][i]) + bf_lo(b[k][j][i]); v[j][2 * i + 1] = bf_hi(a[k][j][i]) + bf_hi(b[k][j][i]); }
#pragma unroll
            for (int i = 0; i < 8; ++i) ss += v[j][i] * v[j][i]; }
        const float rf = __builtin_amdgcn_rsqf(wave_sum(ss) * (1.f / 2048.f) + RMS_EPS);
        float* orow = outp + (size_t)tt[k] * DM;
#pragma unroll
        for (int j = 0; j < 4; ++j) { const f32x4 g0 = *(const f32x4*)(P.g_fin + 512 * j + 8 * lane), g1 = *(const f32x4*)(P.g_fin + 512 * j + 8 * lane + 4); f32x4 o0, o1;
#pragma unroll
            for (int i = 0; i < 4; ++i) { o0[i] = v[j][i] * rf * g0[i]; o1[i] = v[j][4 + i] * rf * g1[i]; }
            *(f32x4*)(orow + 512 * j + 8 * lane) = o0; *(f32x4*)(orow + 512 * j + 8 * lane + 4) = o1; } }
}

#ifndef MK_PER_PHASE
#define MK_PER_PHASE 0
#endif
constexpr int N_PHASES = 12;
__global__ void __launch_bounds__(NWAVES * 64, 2) fwd_kernel(Params P) {
    extern __shared__ __attribute__((aligned(16))) unsigned char lds_raw[];
    LAS unsigned char* lds = (LAS unsigned char*)lds_raw;
    volatile LAS unsigned* MISC = (volatile LAS unsigned*)(lds + MISC_OFF);
    const int tid = threadIdx.x, lane = tid & 63, wave = __builtin_amdgcn_readfirstlane(tid >> 6);
    const int G = gridDim.x; const int bx = blockIdx.x;
    const int vcu = (G % 8 == 0) ? (bx % 8) * (G / 8) + bx / 8 : bx;
    const int gw = vcu * NWAVES + wave, NGW = G * NWAVES;
    unsigned char* ws = P.ws;
    gu32* ctl = (gu32*)(ws + WS_CTL);
    for (int u = tid; u < 64; u += NWAVES * 64) MISC[u] = 0u;
    __syncthreads();
    XcdBarrier bar; bar.bar = (unsigned*)ctl + CW_BAR; bar.x = 0; bar.st = nullptr;
    if (!MK_PER_PHASE) bar = xcd_barrier_post((unsigned*)ctl + CW_BAR, MISC + 8);
    const unsigned my_xcc = xb_xcc_id();
    if (!MK_PER_PHASE) { if (tid == 0) MISC[16] = __hip_atomic_fetch_add((unsigned*)(ctl + CW_XC + 64 * (my_xcc & 7u)), 1u, __ATOMIC_RELAXED, __HIP_MEMORY_SCOPE_AGENT); }
    const int lo = P.ph_lo, hi = P.ph_hi;
#define FRESH_IDS const int lane = (int)__builtin_amdgcn_mbcnt_hi(~0u, __builtin_amdgcn_mbcnt_lo(~0u, 0u)); const int tid = wave * 64 + lane; (void)tid; (void)lane
#ifndef PH_MASK
#define PH_MASK 0xfff
#endif
#define IN(k) (((PH_MASK >> (k)) & 1) && lo <= (k) && (k) < hi)
#define BOTH(k) (IN(k) && IN((k) + 1))
#ifndef DUP_MASK
#define DUP_MASK 0
#endif
#define NREP(k) (((DUP_MASK >> (k)) & 1) ? 2 : 1)
#define GRID_BAR() do { if (!MK_PER_PHASE) xcd_barrier(bar); } while (0)
#ifdef TPROBE
#define TP_T0 (wave == 0 && __builtin_amdgcn_mbcnt_hi(~0u, __builtin_amdgcn_mbcnt_lo(~0u, 0u)) == 0u)
#define TP_ORD(k) ((k) < 7 ? (k) : (k) - 1)
    if (TP_T0) MISC[40] = (unsigned)__builtin_amdgcn_s_memrealtime();
#define TP_STAMP(w) do { MISC[(w)] = (unsigned)__builtin_amdgcn_s_memrealtime(); } while (0)
#define GRID_BAR_K(k) do { xcd_barrier(bar); MISC[41 + TP_ORD(k)] = (unsigned)__builtin_amdgcn_s_memrealtime(); } while (0)
#else
#define TP_STAMP(w) do { } while (0)
#define GRID_BAR_K(k) GRID_BAR()
#endif

    bf16* HN = (bf16*)(ws + WS_HN); bf16* WA = (bf16*)(ws + WS_WA); bf16* WV = (bf16*)(ws + WS_WV); bf16* WB = (bf16*)(ws + WS_WB); bf16* WO = (bf16*)(ws + WS_WO); bf16* WQ = (bf16*)(ws + WS_WQ);

    constexpr int NV_UNITS = (AW / 256) * (T_TOK / 256);
    const bool tab_fast = (G > NV_UNITS && (1024 % G) == 0);
    const int tab_r1 = tab_fast ? 0 : NEXP;
    if (IN(0)) { FRESH_IDS; for (int rep = 0; rep < NREP(0); ++rep) p0_prologue(P, lds, gw, NGW, wave, lane, tab_r1); TP_STAMP(53); if (BOTH(0)) GRID_BAR_K(0); }

    if (IN(1)) { FRESH_IDS;
      _Pragma("unroll") for (int rep = 0; rep < NREP(1); ++rep) {
        { pg8::Gemm g{HN, WA, T_TOK, NWA, DM / 2, WV, HN, ws, (unsigned)WS_END}; pg8::StaticOrder2 S; S.init(T_TOK, NWA, AW, T_TOK, G, bx);
          pg8::EpiProj E{(bf16*)(ws + WS_Q), (bf16*)(ws + WS_K), (bf16*)(ws + WS_XR), (bf16*)(ws + WS_GY), (bf16*)(ws + WS_SG), (bf16*)(ws + WS_VT), rep == 0 ? (float*)(ws + WS_CTL) + CW_KM : nullptr, QSCALE, 1.f / W8SCALE};
          pg8::gemm_phase<pg8::EpiProj, pg8::StaticOrder2, true, true, true>(lds, g, S, E); }
        TP_STAMP(54);
        if (tab_fast && bx >= NV_UNITS) peer_table_u<2>(P, 0, NEXP, (bx - NV_UNITS) * NWAVES + wave, (G - NV_UNITS) * NWAVES, lane);
      }
        TP_STAMP(55); if (BOTH(1)) GRID_BAR_K(1);
    }

    if (IN(2)) { FRESH_IDS;
        LAS int* tick = (LAS int*)(lds + MISC_OFF + 128);
#define NEXT_TICKET(dst, word) do { __syncthreads(); if (tid == 0) *tick = (int)__hip_atomic_fetch_add((unsigned*)(ctl + (word)), 1u, __ATOMIC_RELAXED, __HIP_MEMORY_SCOPE_AGENT); __syncthreads(); dst = *tick; } while (0)
#define TICKET_ISSUE(word) do { if (tid == 0) tk_next = (int)__hip_atomic_fetch_add((unsigned*)(ctl + (word)), 1u, __ATOMIC_RELAXED, __HIP_MEMORY_SCOPE_AGENT); } while (0)
#define TICKET_TAKE(dst) do { __syncthreads(); if (tid == 0) *tick = tk_next; __syncthreads(); dst = *tick; } while (0)
        int tk_next = 0;
#ifndef DUP_ATT
#define DUP_ATT 0
#endif
#ifndef DUP_LRU
#define DUP_LRU 0
#endif
#ifndef DUP_P2
#define DUP_P2 0
#endif
        _Pragma("unroll") for (int rp = 0; rp < 1 + DUP_P2; ++rp) {
        _Pragma("unroll") for (int rep = 0; rep < 1 + DUP_ATT; ++rep) {
            int tid2 = tid; asm volatile("" : "+v"(tid2));
            int it; NEXT_TICKET(it, CW_Q2 + 64 * (rep + 2 * rp));
            while (it < 256) { const int blk = 7 - (it >> 5), bh = it & 31; attn_unit(P, lds, bh >> 3, bh & 7, blk, tid2, wave, tid2 & 63); NEXT_TICKET(it, CW_Q2 + 64 * (rep + 2 * rp)); } }
        TP_STAMP(56);
        _Pragma("unroll") for (int rep = 0; rep < 1 + DUP_LRU; ++rep) {
            int tid2 = tid; asm volatile("" : "+v"(tid2));
            int it; NEXT_TICKET(it, CW_Q2 + 256 + 64 * (rep + 2 * rp));
            while (it < 512) { lru_pair(P, lds, it, tid2, wave, tid2 & 63, (unsigned*)(ctl + CW_Q2 + 256 + 64 * (rep + 2 * rp)), tk_next); TICKET_TAKE(it); } }
        if (DUP_P2 && rp == 0) GRID_BAR();
        }
#undef NEXT_TICKET
#undef TICKET_ISSUE
#undef TICKET_TAKE
        TP_STAMP(57); if (BOTH(2)) GRID_BAR_K(2);
    }

    if (IN(3)) { FRESH_IDS;
      _Pragma("unroll") for (int rep = 0; rep < NREP(3); ++rep) {
        const unsigned* HLAC = (const unsigned*)(ws + WS_HL); const float* SUM = (const float*)(ws + WS_SUM);
        const bf16* GY = (const bf16*)(ws + WS_GY); unsigned char* OCAT = ws + WS_OCAT;
        for (int u = vcu; u < 256; u += G) { const int b = u >> 6, c = (u >> 1) & 31, C = (u & 1) * 512 + 4 * (tid & 127), tq = tid >> 7;
            f32x4 carry = (f32x4){0.f, 0.f, 0.f, 0.f};
            for (int c0 = 0; c0 < c; c0 += 8) {
                f32x4 s0[8], s1[8];
#pragma unroll
                for (int j = 0; j < 8; ++j) { const int cc = c0 + j < c ? c0 + j : c - 1; const float* sm = SUM + ((size_t)(b * 32 + cc) * 1024 + C) * 2; s0[j] = *(const f32x4*)sm; s1[j] = *(const f32x4*)(sm + 4); }
#pragma unroll
                for (int j = 0; j < 8; ++j) if (c0 + j < c) { carry[0] = s0[j][0] * carry[0] + s0[j][1]; carry[1] = s0[j][2] * carry[1] + s0[j][3]; carry[2] = s1[j][0] * carry[2] + s1[j][1]; carry[3] = s1[j][2] * carry[3] + s1[j][3]; } }
            const size_t R0 = (size_t)b * SEQ + c * 64 + tq * 16;
#pragma unroll 8
            for (int t = 0; t < 16; ++t) { const size_t o = (R0 + t) * AW + C; const v4u ha = *(const v4u*)(HLAC + o);
                const f32x4 hv = (f32x4){bf_lo(ha.x) + bf_hi(ha.x) * carry[0], bf_lo(ha.y) + bf_hi(ha.y) * carry[1], bf_lo(ha.z) + bf_hi(ha.z) * carry[2], bf_lo(ha.w) + bf_hi(ha.w) * carry[3]};
                const unsigned long long gy = *(const unsigned long long*)(GY + o); const unsigned g0 = (unsigned)gy, g1 = (unsigned)(gy >> 32);
                int p = __builtin_amdgcn_cvt_pk_fp8_f32(clamp8(hv[0] * bf_lo(g0) * OC8SCALE), clamp8(hv[1] * bf_hi(g0) * OC8SCALE), 0, false); p = __builtin_amdgcn_cvt_pk_fp8_f32(clamp8(hv[2] * bf_lo(g1) * OC8SCALE), clamp8(hv[3] * bf_hi(g1) * OC8SCALE), p, true);
                *(unsigned*)(OCAT + (R0 + t) * DM + AW + C) = (unsigned)p; } }
      }
        TP_STAMP(58); if (BOTH(3)) GRID_BAR_K(3);
    }

    if (IN(4)) { FRESH_IDS;
      _Pragma("unroll") for (int rep = 0; rep < NREP(4); ++rep) {
        { pg8::Gemm g{(bf16*)(ws + WS_OCAT), WB, T_TOK, DM, DM / 2, nullptr, nullptr, ws, (unsigned)WS_END}; pg8::StaticOrder S; S.init(T_TOK, DM, G, bx);
          pg8::EpiMerge2 E{(const bf16*)(ws + WS_SG), (bf16*)(ws + WS_MG), MG8SCALE / (OC8SCALE * WB8SCALE)};
          pg8::gemm_phase<pg8::EpiMerge2, pg8::StaticOrder, true, true, true>(lds, g, S, E); }
      }
        if (BOTH(4)) GRID_BAR_K(4);
    }

    if (IN(5)) { FRESH_IDS;
      _Pragma("unroll") for (int rep = 0; rep < NREP(5); ++rep) {
        pg8::Gemm g{(bf16*)(ws + WS_MG), WO, T_TOK, DM, DM / 2, nullptr, nullptr, ws, (unsigned)WS_END}; pg8::StaticOrder S; S.init(T_TOK, DM, G, bx);
        pg8::EpiResid E{P.x, (bf16*)(ws + WS_X1B), (float*)(ws + WS_SSP), 1.f / (W8SCALE * MG8SCALE)};
        pg8::gemm_phase<pg8::EpiResid, pg8::StaticOrder, true, true, true>(lds, g, S, E);
      }
        if (BOTH(5)) GRID_BAR_K(5);
    }

    if (IN(6)) { FRESH_IDS;
      _Pragma("unroll") for (int rep = 0; rep < NREP(6); ++rep) {
        pg8::Gemm g{(bf16*)(ws + WS_X1B), WQ, T_TOK, DM, DM, nullptr, nullptr, ws, (unsigned)WS_END}; pg8::StaticOrder S; S.init(T_TOK, DM, G, bx);
        pg8::EpiRowScale E{(const float*)(ws + WS_SSP), (bf16*)(ws + WS_QP)};
        pg8::gemm_phase<pg8::EpiRowScale, pg8::StaticOrder, true, true>(lds, g, S, E);
        TP_STAMP(59);
        { pg8::Unit u; for (int i = 0; S.next(i, u); ++i) { peer_topk_unit(P, lds, u.pm * 256, u.pn, tid, wave, lane); peer_topk_unit(P, lds, u.pm * 256 + 128, u.pn, tid, wave, lane); } }
      }
        TP_STAMP(60); if (BOTH(6)) GRID_BAR_K(6);
    }

    int xg = bx & 7, nblk_g = (G - xg + 7) >> 3, rank_g = bx >> 3;
    if (!MK_PER_PHASE && lo == 0 && hi > 8) {
        unsigned cnt[8], sum = 0u; bool ok = my_xcc < 8u;
#pragma unroll
        for (int j = 0; j < 8; ++j) { cnt[j] = __hip_atomic_load((unsigned*)(ctl + CW_XC + 64 * j), __ATOMIC_RELAXED, __HIP_MEMORY_SCOPE_AGENT); sum += cnt[j]; ok = ok && cnt[j] > 0u; }
        if (ok && sum == (unsigned)G) { xg = (int)my_xcc; rank_g = (int)MISC[16];
            nblk_g = (int)(xg == 0 ? cnt[0] : xg == 1 ? cnt[1] : xg == 2 ? cnt[2] : xg == 3 ? cnt[3] : xg == 4 ? cnt[4] : xg == 5 ? cnt[5] : xg == 6 ? cnt[6] : cnt[7]); }
    }
    const int nslots = nblk_g * NWAVES, slot = rank_g * NWAVES + wave;
    if (IN(8)) { FRESH_IDS;
        _Pragma("unroll") for (int rep = 0; rep < NREP(8); ++rep) {
        if (tab_fast) { if (wave == NWAVES - 1) peer_table_v<4, true>(P, 0, NEXP, bx, G, lane); else peer_u_phase(P, xg, rank_g * (NWAVES - 1) + wave, nblk_g * (NWAVES - 1), lane); }
        else peer_u_phase(P, xg, slot, nslots, lane); }
        TP_STAMP(61); if (BOTH(8)) GRID_BAR_K(8);
    }
#ifdef EXTRA_BARS
    for (int eb = 0; eb < EXTRA_BARS; ++eb) GRID_BAR();
#endif
    if (IN(9)) { FRESH_IDS;
        for (int t = gw; t < T_TOK; t += 2 * NGW) peer_act_tokens(P, t, t + NGW < T_TOK ? t + NGW : -1, lane);
        if (BOTH(9)) GRID_BAR_K(9);
    }
    if (IN(10)) { FRESH_IDS;
        _Pragma("unroll") for (int rep = 0; rep < NREP(10); ++rep)
        peer_v_phase(P, xg, slot, nslots, lane);
        TP_STAMP(62); if (BOTH(10)) GRID_BAR_K(10);
    }
    if (IN(11)) { FRESH_IDS;
        if (NREP(11) == 2) for (int t = gw; t < T_TOK; t += 2 * NGW) peer_final_tokens(P, t, t + NGW < T_TOK ? t + NGW : -1, lane, (float*)(ws + WS_MG));
        for (int t = gw; t < T_TOK; t += 2 * NGW) peer_final_tokens(P, t, t + NGW < T_TOK ? t + NGW : -1, lane, P.out);
    }
#ifdef TPROBE
    { GRID_BAR_K(11);
      gu32* tpw = (gu32*)(P.ws + WS_CTL) + 16384;
      if (TP_T0) { const int j = (int)__hip_atomic_load((unsigned*)tpw + 64, __ATOMIC_RELAXED, __HIP_MEMORY_SCOPE_AGENT); const unsigned val = j < 11 ? MISC[41 + j] - MISC[40 + j] : (j >= 4096 ? MISC[(j >> 6) & 63] - MISC[j & 63] : 0u);
          __hip_atomic_fetch_add((unsigned*)tpw, val, __ATOMIC_RELAXED, __HIP_MEMORY_SCOPE_AGENT); }
      GRID_BAR();
      const unsigned tot = __hip_atomic_load((unsigned*)tpw, __ATOMIC_RELAXED, __HIP_MEMORY_SCOPE_AGENT), avg = (unsigned)__builtin_amdgcn_readfirstlane((int)(tot >> 8));
      const unsigned ts = (unsigned)__builtin_amdgcn_s_memrealtime();
      while ((unsigned)__builtin_amdgcn_s_memrealtime() - ts < avg) __builtin_amdgcn_s_sleep(1); }
#endif
#undef IN
#undef BOTH
#undef GRID_BAR
}

extern "C" void kernel_launch(void* const* d_in, const int* in_sizes, int n_in, void* d_out, int out_size, void* d_ws, size_t ws_size, hipStream_t stream) {
    static int grid = 0;
    if (grid == 0) {
        if (n_in != 19 || out_size != T_TOK * DM || ws_size < WS_END) { fprintf(stderr, "kernel_launch: unexpected problem (n_in %d, out %d, ws %zu); nothing launched\n", n_in, out_size, ws_size); grid = -1; return; }
        int dev = 0, cus = 0, per_cu = 0;
        if (hipGetDevice(&dev) != hipSuccess || hipDeviceGetAttribute(&cus, hipDeviceAttributeMultiprocessorCount, dev) != hipSuccess) { grid = -1; return; }
        if (hipFuncSetAttribute((const void*)fwd_kernel, hipFuncAttributeMaxDynamicSharedMemorySize, LDS_BYTES) != hipSuccess) { fprintf(stderr, "kernel_launch: hipFuncSetAttribute failed\n"); grid = -1; return; }
        if (hipOccupancyMaxActiveBlocksPerMultiprocessor(&per_cu, (const void*)fwd_kernel, NWAVES * 64, LDS_BYTES) != hipSuccess || per_cu < 1) { fprintf(stderr, "kernel_launch: occupancy query says %d blocks per CU\n", per_cu); }
        (void)hipGetLastError();
        grid = cus;
    }
    if (grid < 0) return;
    if (hipMemsetAsync((char*)d_ws + WS_CTL, 0, CTL_ZERO_BYTES, stream) != hipSuccess) return;
#ifdef TPROBE
    if (hipMemsetD32Async((hipDeviceptr_t)((char*)d_ws + WS_CTL + 4 * (16384 + 64)), TPROBE, 1, stream) != hipSuccess) return;
#endif
    Params p{};
    const float** pp = (const float**)&p;
    for (int i = 0; i < 19; ++i) pp[i] = (const float*)d_in[i];
    p.out = (float*)d_out; p.ws = (unsigned char*)d_ws;
#if MK_PER_PHASE
    for (int ph = 0; ph < N_PHASES; ++ph) { p.ph_lo = ph; p.ph_hi = ph + 1; hipLaunchKernelGGL(fwd_kernel, dim3(grid), dim3(NWAVES * 64), LDS_BYTES, stream, p); }
#else
    p.ph_lo = 0; p.ph_hi = N_PHASES;
    hipLaunchKernelGGL(fwd_kernel, dim3(grid), dim3(NWAVES * 64), LDS_BYTES, stream, p);
#endif
}
```

```cpp
#include <hip/hip_runtime.h>
#include <cstdio>
#include <cstdint>
namespace pg8 {
#define PG8_LAS __attribute__((address_space(3)))
typedef unsigned short bf16_t;
typedef short bf16x8 __attribute__((ext_vector_type(8)));
typedef float f32x4 __attribute__((ext_vector_type(4)));
typedef unsigned u32x4 __attribute__((ext_vector_type(4)));
typedef int i32x4 __attribute__((ext_vector_type(4)));
typedef int i32x8 __attribute__((ext_vector_type(8)));
__device__ __forceinline__ i32x8 cat8(bf16x8 a, bf16x8 b) { return __builtin_shufflevector(__builtin_bit_cast(i32x4, a), __builtin_bit_cast(i32x4, b), 0, 1, 2, 3, 4, 5, 6, 7); }
constexpr int BM = 256, BK = 64, HALF = 128, HTB = HALF * BK * 2  , STAGE_BYTES = 8 * HTB, NXCD = 8, WGM = 8;

__host__ __device__ __forceinline__ int lds_byte(int r, int c) { const int st = (r >> 4) * 2 + (c >> 5), rr = r & 15, cc = c & 31, ob = rr * 64 + cc * 2; return st * 1024 + (ob ^ (((ob >> 9) & 1) << 5)); }
__host__ __device__ __forceinline__ void stage_rc(int b, int& R, int& C) { const int st = b / 1024, sb = b % 1024, swz = sb ^ (((sb >> 9) & 1) << 5); R = (st >> 1) * 16 + swz / 64; C = (st & 1) * 32 + (swz % 64) / 2; }
__host__ __device__ __forceinline__ int perm32(int rho) { const int n = rho >> 4, i = rho & 15; return 8 * (i >> 2) + 4 * n + (i & 3); }

struct Unit { int pm, pn, sel; };
struct Gemm { const bf16_t* A; const bf16_t* Bt; int M, N, K; const bf16_t* A2; const bf16_t* Bt2; const void* rbase; unsigned rbytes; };

struct StaticOrder {
    int nM, nN, nwg, G, c;
    __host__ __device__ __forceinline__ void init(int M, int N, int G_, int c_) { nM = M / BM; nN = N / BM; nwg = nM * nN; G = G_; c = c_; }
    __host__ __device__ __forceinline__ bool next(int i, Unit& u) const {
        const long L = (long)i * G + c; if (L >= nwg) return false;
        int wgid = (int)L; { const int q = nwg / NXCD, r = nwg % NXCD, xcd = wgid % NXCD, off = wgid / NXCD; wgid = (xcd < r ? xcd * (q + 1) : r * (q + 1) + (xcd - r) * q) + off; }
        const int nig = WGM * nN, gid = wgid / nig, fm = gid * WGM, gsz = (nM - fm) < WGM ? (nM - fm) : WGM;
        u.pm = fm + ((wgid % nig) % gsz); u.pn = (wgid % nig) / gsz; u.sel = 0; return true;
    }
    __device__ __forceinline__ void a_ready(const Unit&) const {}
    __device__ __forceinline__ void done(const Unit&) const {}
};

struct StaticOrder2 {
    StaticOrder s0, s1; int G, c;
    __host__ __device__ __forceinline__ void init(int M0, int N0, int M1, int N1, int G_, int c_) { s0.init(M0, N0, 1, 0); s1.init(M1, N1, 1, 0); G = G_; c = c_; }
    __host__ __device__ __forceinline__ bool next(int i, Unit& u) const {
        const long L = (long)i * G + c;
        if (L < s0.nwg) return s0.next((int)L, u);
        if (L < s0.nwg + s1.nwg) { const bool ok = s1.next((int)(L - s0.nwg), u); u.sel = 1; return ok; }
        return false;
    }
    __device__ __forceinline__ void a_ready(const Unit&) const {}
    __device__ __forceinline__ void done(const Unit&) const {}
};

__device__ __forceinline__ unsigned cvt_pk_bf16(float lo, float hi) { unsigned r; asm volatile("v_cvt_pk_bf16_f32 %0, %1, %2" : "=v"(r) : "v"(lo), "v"(hi)); return r; }
typedef float f32x2 __attribute__((ext_vector_type(2)));
__device__ __forceinline__ float c8(float v) { return __builtin_fminf(__builtin_fmaxf(v, -448.f), 448.f); }
__device__ __forceinline__ float sigmoid_f(float v) { return __builtin_amdgcn_rcpf(1.f + __builtin_amdgcn_exp2f(-1.4426950408889634f * v)); }
__device__ __forceinline__ float gelu_tanh_f(float v) { const float z = 1.5957691216057308f * (v + 0.044715f * v * v * v); return v * __builtin_amdgcn_rcpf(1.f + __builtin_amdgcn_exp2f(-1.4426950408889634f * z)); }
__device__ __forceinline__ u32x4 pack8(const f32x4& v0, const f32x4& v1) { u32x4 w; w.x = cvt_pk_bf16(v0[0], v0[1]); w.y = cvt_pk_bf16(v0[2], v0[3]); w.z = cvt_pk_bf16(v1[0], v1[1]); w.w = cvt_pk_bf16(v1[2], v1[3]); return w; }
__device__ __forceinline__ f32x4 bf4_lo(unsigned a, unsigned b) { f32x4 r; r[0] = __builtin_bit_cast(float, a << 16); r[1] = __builtin_bit_cast(float, a & 0xffff0000u); r[2] = __builtin_bit_cast(float, b << 16); r[3] = __builtin_bit_cast(float, b & 0xffff0000u); return r; }

struct EpiProj {
    static constexpr bool PERM = true, AFTER_DRAIN = false, MIDK = false;
    bf16_t *Q, *K, *XR, *GY, *SG, *VT; float* KM; float qscale, oscale;
    __device__ __forceinline__ void operator()(const f32x4 (&acc)[2][2][4][2], const Unit& u, int wr, int wc, int fr, int fq) const {
        { const int l_ = (int)__builtin_amdgcn_mbcnt_hi(~0u, __builtin_amdgcn_mbcnt_lo(~0u, 0u)); fr = l_ & 15; fq = l_ >> 4; }
        const int pn = u.pn; int kind, ldc, colt; bf16_t* base;
        if (u.sel) { kind = 2; base = VT; ldc = 8192; colt = pn * 256; }
        else if (pn < 4) { kind = 0; base = Q; ldc = 1024; colt = pn * 256; }
        else if (pn < 8) { kind = 1; base = K; ldc = 1024; colt = (pn - 4) * 256; }
        else if (pn < 12) { kind = 2; base = XR; ldc = 1024; colt = (pn - 8) * 256; }
        else if (pn < 16) { kind = 3; base = GY; ldc = 1024; colt = (pn - 12) * 256; }
        else { kind = 4; base = SG; ldc = 4096; colt = (pn - 16) * 256; }
        const int row0 = u.pm * BM + wr * 64 + fr, col0 = colt + wc * 32 + 8 * fq;
#pragma unroll
        for (int ai = 0; ai < 2; ++ai)
#pragma unroll
            for (int m = 0; m < 4; ++m) { bf16_t* rowp = base + (size_t)(row0 + ai * HALF + m * 16) * ldc + col0;
#pragma unroll
                for (int bj = 0; bj < 2; ++bj) { f32x4 v0 = acc[ai][bj][m][0] * oscale, v1 = acc[ai][bj][m][1] * oscale;
                    if (kind == 0) { v0 = v0 * qscale; v1 = v1 * qscale; }
                    else if (kind == 3) {
#pragma unroll
                        for (int e = 0; e < 4; ++e) { v0[e] = gelu_tanh_f(v0[e]); v1[e] = gelu_tanh_f(v1[e]); } }
                    else if (kind == 4) {
                        unsigned w0 = 0u, w1 = 0u;
#pragma unroll
                        for (int e = 0; e < 4; ++e) { const unsigned q0 = (unsigned)fmaxf(sigmoid_f(v0[e]) * 255.f + 0.5f, 1.f), q1 = (unsigned)fmaxf(sigmoid_f(v1[e]) * 255.f + 0.5f, 1.f); w0 |= q0 << (8 * e); w1 |= q1 << (8 * e); }
                        *(unsigned long long*)((unsigned char*)SG + (size_t)(row0 + ai * HALF + m * 16) * 4096 + col0 + bj * HALF) = (unsigned long long)w0 | ((unsigned long long)w1 << 32);
                        continue; }
                    *(u32x4*)(rowp + bj * HALF) = pack8(v0, v1); } }
        if (kind == 1 && KM != nullptr) {
            const int b = u.pm >> 3, blk = u.pm & 7;
#pragma unroll
            for (int bj = 0; bj < 2; ++bj)
#pragma unroll
                for (int n = 0; n < 2; ++n) { f32x4 s = (f32x4){0.f, 0.f, 0.f, 0.f};
#pragma unroll
                    for (int ai = 0; ai < 2; ++ai)
#pragma unroll
                        for (int m = 0; m < 4; ++m) s = s + acc[ai][bj][m][n];
#pragma unroll
                    for (int e = 0; e < 4; ++e) { float v = s[e]; v += __shfl_xor(v, 1); v += __shfl_xor(v, 2); v += __shfl_xor(v, 4); v += __shfl_xor(v, 8); s[e] = v; }
                    if (fr == 0) { const int c = colt + bj * HALF + wc * 32 + 8 * fq + 4 * n;
                        float* dst = KM + ((size_t)((b * 8 + (c >> 7)) * 8 + blk)) * 128 + (c & 127);
#pragma unroll
                        for (int e = 0; e < 4; ++e) atomicAdd(dst + e, s[e] * oscale); } }
        }
    }
};
struct EpiStore {
    static constexpr bool PERM = true, AFTER_DRAIN = false, MIDK = false;
    bf16_t* O; int ldc;
    __device__ __forceinline__ void operator()(const f32x4 (&acc)[2][2][4][2], const Unit& u, int wr, int wc, int fr, int fq) const {
        { const int l_ = (int)__builtin_amdgcn_mbcnt_hi(~0u, __builtin_amdgcn_mbcnt_lo(~0u, 0u)); fr = l_ & 15; fq = l_ >> 4; }
        const int row0 = u.pm * BM + wr * 64 + fr, col0 = u.pn * BM + wc * 32 + 8 * fq;
#pragma unroll
        for (int ai = 0; ai < 2; ++ai)
#pragma unroll
            for (int m = 0; m < 4; ++m) { bf16_t* rowp = O + (size_t)(row0 + ai * HALF + m * 16) * ldc + col0;
#pragma unroll
                for (int bj = 0; bj < 2; ++bj) *(u32x4*)(rowp + bj * HALF) = pack8(acc[ai][bj][m][0], acc[ai][bj][m][1]); }
    }
};
struct EpiMerge2 {
    static constexpr bool PERM = true, AFTER_DRAIN = false, MIDK = true;
    const bf16_t* SG; bf16_t* MG; float mgscale;
    __device__ __forceinline__ void midk(f32x4 (&acc)[2][2][4][2], const Unit& u, int wr, int wc, int fr, int fq) const {
        int row0 = u.pm * BM + wr * 64 + fr, col0 = u.pn * BM + wc * 32 + 8 * fq;
        asm volatile("" : "+v"(row0), "+v"(col0));
#pragma unroll
        for (int ai = 0; ai < 2; ++ai)
#pragma unroll
            for (int m = 0; m < 4; ++m) { const size_t row = (size_t)(row0 + ai * HALF + m * 16);
#pragma unroll
                for (int bj = 0; bj < 2; ++bj) { const int col = col0 + bj * HALF;
                    const unsigned long long g0 = *(const unsigned long long*)((const unsigned char*)SG + row * 4096 + col), g1 = *(const unsigned long long*)((const unsigned char*)SG + row * 4096 + 2048 + col);
                    const unsigned g0l = (unsigned)g0, g0h = (unsigned)(g0 >> 32), g1l = (unsigned)g1, g1h = (unsigned)(g1 >> 32);
#pragma unroll
                    for (int e2 = 0; e2 < 4; ++e2) { acc[ai][bj][m][0][e2] *= (float)((g0l >> (8 * e2)) & 255u) * __builtin_amdgcn_rcpf((float)((g1l >> (8 * e2)) & 255u));
                        acc[ai][bj][m][1][e2] *= (float)((g0h >> (8 * e2)) & 255u) * __builtin_amdgcn_rcpf((float)((g1h >> (8 * e2)) & 255u)); } } }
    }
    __device__ __forceinline__ void operator()(const f32x4 (&acc)[2][2][4][2], const Unit& u, int wr, int wc, int fr, int fq) const {
        { const int l_ = (int)__builtin_amdgcn_mbcnt_hi(~0u, __builtin_amdgcn_mbcnt_lo(~0u, 0u)); fr = l_ & 15; fq = l_ >> 4; }
        const int row0 = u.pm * BM + wr * 64 + fr, col0 = u.pn * BM + wc * 32 + 8 * fq;
#pragma unroll
        for (int ai = 0; ai < 2; ++ai)
#pragma unroll
            for (int m = 0; m < 4; ++m) { const size_t row = (size_t)(row0 + ai * HALF + m * 16);
#pragma unroll
                for (int bj = 0; bj < 2; ++bj) { const int col = col0 + bj * HALF;
                    const unsigned long long g1 = *(const unsigned long long*)((const unsigned char*)SG + row * 4096 + 2048 + col); const unsigned g1l = (unsigned)g1, g1h = (unsigned)(g1 >> 32);
                    const float ms = mgscale * (1.f / 255.f);
                    const f32x4 s0 = (f32x4){(float)(g1l & 255u), (float)((g1l >> 8) & 255u), (float)((g1l >> 16) & 255u), (float)(g1l >> 24)}, s1 = (f32x4){(float)(g1h & 255u), (float)((g1h >> 8) & 255u), (float)((g1h >> 16) & 255u), (float)(g1h >> 24)};
                    const f32x4 v0 = acc[ai][bj][m][0] * s0 * ms, v1 = acc[ai][bj][m][1] * s1 * ms;
                    int p0 = __builtin_amdgcn_cvt_pk_fp8_f32(c8(v0[0]), c8(v0[1]), 0, false); p0 = __builtin_amdgcn_cvt_pk_fp8_f32(c8(v0[2]), c8(v0[3]), p0, true);
                    int p1 = __builtin_amdgcn_cvt_pk_fp8_f32(c8(v1[0]), c8(v1[1]), 0, false); p1 = __builtin_amdgcn_cvt_pk_fp8_f32(c8(v1[2]), c8(v1[3]), p1, true);
                    *(unsigned long long*)((unsigned char*)MG + row * 2048 + col) = (unsigned long long)(unsigned)p0 | ((unsigned long long)(unsigned)p1 << 32); } }
    }
};
struct EpiResid {
    static constexpr bool PERM = true, AFTER_DRAIN = false, MIDK = false;
    const float* X; bf16_t* X1B; float* SSP; float oscale;
    __device__ __forceinline__ void operator()(const f32x4 (&acc)[2][2][4][2], const Unit& u, int wr, int wc, int fr, int fq) const {
        { const int l_ = (int)__builtin_amdgcn_mbcnt_hi(~0u, __builtin_amdgcn_mbcnt_lo(~0u, 0u)); fr = l_ & 15; fq = l_ >> 4; }
        const int row0 = u.pm * BM + wr * 64 + fr, col0 = u.pn * BM + wc * 32 + 8 * fq;
#pragma unroll
        for (int ai = 0; ai < 2; ++ai)
#pragma unroll
            for (int m = 0; m < 4; ++m) { const size_t row = (size_t)(row0 + ai * HALF + m * 16); float ss = 0.f;
#pragma unroll
                for (int bj = 0; bj < 2; ++bj) { const int col = col0 + bj * HALF; const float* xp = X + row * 2048 + col;
                    f32x4 v0 = acc[ai][bj][m][0] * oscale + *(const f32x4*)xp, v1 = acc[ai][bj][m][1] * oscale + *(const f32x4*)(xp + 4);
                    *(u32x4*)(X1B + row * 2048 + col) = pack8(v0, v1);
                    ss += (v0[0] * v0[0] + v0[1] * v0[1]) + (v0[2] * v0[2] + v0[3] * v0[3]) + (v1[0] * v1[0] + v1[1] * v1[1]) + (v1[2] * v1[2] + v1[3] * v1[3]); }
                ss += __shfl_xor(ss, 16); ss += __shfl_xor(ss, 32);
                if (fq == 0) SSP[row * 32 + u.pn * 4 + wc] = ss; }
    }
};
struct EpiRowScale {
    static constexpr bool PERM = true, AFTER_DRAIN = false, MIDK = false;
    const float* SSP; bf16_t* O;
    __device__ __forceinline__ void operator()(const f32x4 (&acc)[2][2][4][2], const Unit& u, int wr, int wc, int fr, int fq) const {
        { const int l_ = (int)__builtin_amdgcn_mbcnt_hi(~0u, __builtin_amdgcn_mbcnt_lo(~0u, 0u)); fr = l_ & 15; fq = l_ >> 4; }
        const int row0 = u.pm * BM + wr * 64 + fr, col0 = u.pn * BM + wc * 32 + 8 * fq;
#pragma unroll
        for (int ai = 0; ai < 2; ++ai)
#pragma unroll
            for (int m = 0; m < 4; ++m) { const size_t row = (size_t)(row0 + ai * HALF + m * 16);
                const f32x4 a = *(const f32x4*)(SSP + row * 32 + 8 * fq), b = *(const f32x4*)(SSP + row * 32 + 8 * fq + 4);
                float ss = (a[0] + a[1]) + (a[2] + a[3]) + (b[0] + b[1]) + (b[2] + b[3]);
                ss += __shfl_xor(ss, 16); ss += __shfl_xor(ss, 32);
                const float rs = __builtin_amdgcn_rsqf(ss * (1.f / 2048.f) + 1e-6f);
#pragma unroll
                for (int bj = 0; bj < 2; ++bj) *(u32x4*)(O + row * 2048 + col0 + bj * HALF) = pack8(acc[ai][bj][m][0] * rs, acc[ai][bj][m][1] * rs); }
    }
};
template <class Epi, class Sched, bool ALIGN_EPI = false, bool SP2 = false, bool FP8 = false>
__device__ __forceinline__ void gemm_phase(PG8_LAS unsigned char* lds, const Gemm g, const Sched& S, const Epi& E) {
    const int tid = threadIdx.x, wid = __builtin_amdgcn_readfirstlane(tid >> 6), lane = tid & 63, wr = wid >> 2, wc = wid & 3, fr = lane & 15, fq = lane >> 4;
    const int K = g.K, nt = K / BK;
    const __amdgpu_buffer_rsrc_t rsrc = __builtin_amdgcn_make_buffer_rsrc((void*)g.rbase, 0, (int)g.rbytes, 0x00020000);
    unsigned voffA[2], voffB[2];
#pragma unroll
    for (int i = 0; i < 2; ++i) { int R, C; stage_rc(tid * 16 + i * 8192, R, C); const int Rb = Epi::PERM ? ((R & ~31) + perm32(R & 31)) : R;
        voffA[i] = (unsigned)(R * K + C) * 2u; voffB[i] = (unsigned)(Rb * K + C) * 2u; }
    const size_t kstep = (size_t)(BK * 2);
    const size_t hstep = (size_t)HALF * K * 2;
    const size_t tstep = 2 * hstep;
    const unsigned ldsw = (unsigned)wid * 1024u;
    const int aoff = lds_byte(wr * 64 + fr, fq * 8), boff = lds_byte(wc * 32 + fr, fq * 8);
#define PG8_SA(b, h) (((b) * 2 + (h)) * HTB)
#define PG8_SB(b, h) ((4 + (b) * 2 + (h)) * HTB)
#define PG8_STAGE(bufoff, gbase, voff) do { const unsigned so_ = (unsigned)((const char*)(gbase) - (const char*)g.rbase); _Pragma("unroll") for (int _i = 0; _i < 2; ++_i) \
        __builtin_amdgcn_raw_ptr_buffer_load_lds(rsrc, (PG8_LAS unsigned*)(lds + (bufoff) + ldsw + _i * 8192), 16, (voff)[_i], so_, 0, 0); } while (0)
#define PG8_LDA(dst, b, h) do { _Pragma("unroll") for (int m = 0; m < 4; ++m) { const PG8_LAS unsigned char* p_ = lds + PG8_SA(b, h) + aoff + m * 2048; \
        if constexpr (FP8) dst##8[m] = cat8(*(const PG8_LAS bf16x8*)p_, *(const PG8_LAS bf16x8*)(p_ + 1024)); else { dst[m][0] = *(const PG8_LAS bf16x8*)p_; dst[m][1] = *(const PG8_LAS bf16x8*)(p_ + 1024); } } } while (0)
#define PG8_LDB(dst, b, h) do { _Pragma("unroll") for (int n = 0; n < 2; ++n) { const PG8_LAS unsigned char* p_ = lds + PG8_SB(b, h) + boff + n * 2048; \
        if constexpr (FP8) dst##8[n] = cat8(*(const PG8_LAS bf16x8*)p_, *(const PG8_LAS bf16x8*)(p_ + 1024)); else { dst[n][0] = *(const PG8_LAS bf16x8*)p_; dst[n][1] = *(const PG8_LAS bf16x8*)(p_ + 1024); } } } while (0)
#define PG8_MMA(ai, bj, At, Bt) do { __builtin_amdgcn_s_setprio(1); _Pragma("unroll") for (int m = 0; m < 4; ++m) _Pragma("unroll") for (int n = 0; n < 2; ++n) { \
        if constexpr (FP8) acc[ai][bj][m][n] = __builtin_amdgcn_mfma_scale_f32_16x16x128_f8f6f4(Bt##8[n], At##8[m], acc[ai][bj][m][n], 0, 0, 0, 0x7f7f7f7f, 0, 0x7f7f7f7f); \
        else { _Pragma("unroll") for (int k = 0; k < 2; ++k) acc[ai][bj][m][n] = __builtin_amdgcn_mfma_f32_16x16x32_bf16(Bt[n][k], At[m][k], acc[ai][bj][m][n], 0, 0, 0); } } __builtin_amdgcn_s_setprio(0); } while (0)
#define PG8_WAIT_V(n) asm volatile("s_waitcnt vmcnt(" #n ")" ::: "memory")
#define PG8_WAIT_L(n) asm volatile("s_waitcnt lgkmcnt(" #n ")" ::: "memory")
#define PG8_BAR __builtin_amdgcn_s_barrier()
#define PG8_SCHED __builtin_amdgcn_sched_barrier(0)
    Unit cur, nxt; int ui = 0;
    if (!S.next(0, cur)) return;
    f32x4 acc[2][2][4][2];
#pragma unroll
    for (int a = 0; a < 2; ++a)
#pragma unroll
        for (int b = 0; b < 2; ++b)
#pragma unroll
            for (int m = 0; m < 4; ++m)
#pragma unroll
                for (int n = 0; n < 2; ++n) acc[a][b][m][n] = (f32x4){0.f, 0.f, 0.f, 0.f};
    bf16x8 At[4][2], B0[2][2], B1[2][2];
    i32x8 At8[4], B08[2], B18[2];
    const char* cA = (const char*)(cur.sel ? g.A2 : g.A) + (size_t)cur.pm * tstep; const char* cB = (const char*)(cur.sel ? g.Bt2 : g.Bt) + (size_t)cur.pn * tstep;
    S.a_ready(cur);
    if constexpr (SP2) {
        PG8_STAGE(PG8_SB(0, 0), cB, voffB); PG8_STAGE(PG8_SB(0, 1), cB + hstep, voffB); PG8_STAGE(PG8_SA(0, 0), cA, voffA); PG8_STAGE(PG8_SA(0, 1), cA + hstep, voffA);
        if (wr == 1) PG8_BAR;
        PG8_WAIT_V(2); PG8_BAR;
        PG8_STAGE(PG8_SB(1, 0), cB + kstep, voffB); PG8_STAGE(PG8_SA(1, 0), cA + kstep, voffA); PG8_STAGE(PG8_SB(1, 1), cB + hstep + kstep, voffB);
        PG8_WAIT_V(6); PG8_BAR;
    } else {
        PG8_STAGE(PG8_SB(0, 0), cB, voffB); PG8_STAGE(PG8_SA(0, 0), cA, voffA); PG8_STAGE(PG8_SB(0, 1), cB + hstep, voffB); PG8_STAGE(PG8_SA(0, 1), cA + hstep, voffA);
        if (wr == 1) PG8_BAR;
        PG8_WAIT_V(4); PG8_BAR;
        PG8_STAGE(PG8_SB(1, 0), cB + kstep, voffB); PG8_STAGE(PG8_SA(1, 0), cA + kstep, voffA); PG8_STAGE(PG8_SB(1, 1), cB + hstep + kstep, voffB);
        PG8_WAIT_V(6); PG8_BAR;
    }
    for (;;) {
        const bool has_next = S.next(ui + 1, nxt);
        const char* nA = has_next ? (const char*)(nxt.sel ? g.A2 : g.A) + (size_t)nxt.pm * tstep : cA; const char* nB = has_next ? (const char*)(nxt.sel ? g.Bt2 : g.Bt) + (size_t)nxt.pn * tstep : cB;
        for (int t = 0; t < nt; t += 2) {
            if constexpr (Epi::MIDK) { if (t == nt / 2) E.midk(acc, cur, wr, wc, fr, fq); }
            const bool last = (t == nt - 2);
            const char* a1 = cA + (size_t)(t + 1) * kstep;
            const char* a2 = last ? nA : cA + (size_t)(t + 2) * kstep; const char* b2 = last ? nB : cB + (size_t)(t + 2) * kstep;
            const char* a3 = a2 + kstep; const char* b3 = b2 + kstep;
            if (last && has_next) S.a_ready(nxt);
            if constexpr (SP2) {
            PG8_LDB(B0, 0, 0); PG8_LDB(B1, 0, 1); PG8_SCHED; PG8_LDA(At, 0, 0); PG8_STAGE(PG8_SA(1, 1), a1 + hstep, voffA);
            PG8_WAIT_V(8); PG8_WAIT_L(0); PG8_BAR; PG8_MMA(0, 0, At, B0); PG8_MMA(0, 1, At, B1); PG8_BAR; PG8_SCHED;
            PG8_LDA(At, 0, 1); PG8_STAGE(PG8_SB(0, 0), b2, voffB); PG8_STAGE(PG8_SB(0, 1), b2 + hstep, voffB); PG8_STAGE(PG8_SA(0, 0), a2, voffA);
            PG8_WAIT_V(8); PG8_WAIT_L(0); PG8_BAR; PG8_MMA(1, 0, At, B0); PG8_MMA(1, 1, At, B1); PG8_BAR; PG8_SCHED;
            PG8_LDB(B0, 1, 0); PG8_LDB(B1, 1, 1); PG8_SCHED; PG8_LDA(At, 1, 0); PG8_STAGE(PG8_SA(0, 1), a2 + hstep, voffA);
            PG8_WAIT_V(8); PG8_WAIT_L(0); PG8_BAR; PG8_MMA(0, 0, At, B0); PG8_MMA(0, 1, At, B1); PG8_BAR; PG8_SCHED;
            PG8_LDA(At, 1, 1); PG8_STAGE(PG8_SB(1, 0), b3, voffB); PG8_STAGE(PG8_SB(1, 1), b3 + hstep, voffB); PG8_STAGE(PG8_SA(1, 0), a3, voffA);
            PG8_WAIT_V(8); PG8_WAIT_L(0); PG8_BAR; PG8_MMA(1, 0, At, B0); PG8_MMA(1, 1, At, B1); PG8_BAR; PG8_SCHED;
            } else {
            PG8_LDB(B0, 0, 0); PG8_SCHED; PG8_LDA(At, 0, 0); PG8_STAGE(PG8_SA(1, 1), a1 + hstep, voffA);
            PG8_WAIT_L(8); PG8_BAR; PG8_WAIT_L(0); PG8_MMA(0, 0, At, B0); PG8_BAR; PG8_SCHED;
            PG8_LDB(B1, 0, 1); PG8_STAGE(PG8_SB(0, 0), b2, voffB);
            PG8_BAR; PG8_WAIT_L(0); PG8_MMA(0, 1, At, B1); PG8_BAR;
            PG8_LDA(At, 0, 1); PG8_STAGE(PG8_SA(0, 0), a2, voffA);
            PG8_BAR; PG8_WAIT_L(0); PG8_MMA(1, 0, At, B0); PG8_BAR; PG8_SCHED;
            PG8_STAGE(PG8_SB(0, 1), b2 + hstep, voffB);
            PG8_WAIT_V(6); PG8_BAR; PG8_MMA(1, 1, At, B1); PG8_BAR;
            PG8_LDB(B0, 1, 0); PG8_SCHED; PG8_LDA(At, 1, 0); PG8_STAGE(PG8_SA(0, 1), a2 + hstep, voffA);
            PG8_WAIT_L(8); PG8_BAR; PG8_WAIT_L(0); PG8_MMA(0, 0, At, B0); PG8_BAR; PG8_SCHED;
            PG8_LDB(B1, 1, 1); PG8_STAGE(PG8_SB(1, 0), b3, voffB);
            PG8_BAR; PG8_WAIT_L(0); PG8_MMA(0, 1, At, B1); PG8_BAR;
            PG8_LDA(At, 1, 1); PG8_STAGE(PG8_SA(1, 0), a3, voffA);
            PG8_BAR; PG8_WAIT_L(0); PG8_MMA(1, 0, At, B0); PG8_BAR; PG8_SCHED;
            PG8_STAGE(PG8_SB(1, 1), b3 + hstep, voffB);
            PG8_WAIT_V(6); PG8_BAR; PG8_MMA(1, 1, At, B1); PG8_BAR;
            }
        }
        if constexpr (ALIGN_EPI) { if (wr == 0) PG8_BAR; }
        if constexpr (!Epi::AFTER_DRAIN) { E(acc, cur, wr, wc, fr, fq); S.done(cur); }
        if (!has_next) break;
#pragma unroll
        for (int a = 0; a < 2; ++a)
#pragma unroll
            for (int b = 0; b < 2; ++b)
#pragma unroll
                for (int m = 0; m < 4; ++m)
#pragma unroll
                    for (int n = 0; n < 2; ++n) acc[a][b][m][n] = (f32x4){0.f, 0.f, 0.f, 0.f};
        cur = nxt; cA = nA; cB = nB; ++ui;
        if constexpr (ALIGN_EPI) { if (wr == 1) PG8_BAR; }
    }
    PG8_WAIT_V(0);
    if constexpr (!ALIGN_EPI) { if (wr == 0) PG8_BAR; }
    PG8_BAR;
    if constexpr (Epi::AFTER_DRAIN) { E.fused(acc, cur, wr, wc, fr, fq, lds, wid, lane); S.done(cur); }
#undef PG8_SA
#undef PG8_SB
#undef PG8_STAGE
#undef PG8_LDA
#undef PG8_LDB
#undef PG8_MMA
#undef PG8_WAIT_V
#undef PG8_WAIT_L
#undef PG8_BAR
#undef PG8_SCHED
}
}
#define GAS __attribute__((address_space(1)))
#define LAS __attribute__((address_space(3)))
typedef unsigned short bf16;
typedef unsigned v4u __attribute__((ext_vector_type(4)));
typedef float f32x4 __attribute__((ext_vector_type(4)));
typedef short bf16x8 __attribute__((ext_vector_type(8)));
typedef GAS unsigned gu32;
typedef GAS unsigned long long gu64;
#define RLX_AGENT __ATOMIC_RELAXED, __HIP_MEMORY_SCOPE_AGENT
#define LDS_WAIT() asm volatile("s_waitcnt lgkmcnt(0)" ::: "memory")
#define VM_WAIT() asm volatile("s_waitcnt vmcnt(0)" ::: "memory")
__device__ __forceinline__ unsigned long long rt() { return __builtin_amdgcn_s_memrealtime(); }
__device__ __forceinline__ unsigned f2bf(float f) { unsigned u = __builtin_bit_cast(unsigned, f); return (u + 0x7fffu + ((u >> 16) & 1u)) >> 16; }
__device__ __forceinline__ unsigned pk2(float lo, float hi) { return f2bf(lo) | (f2bf(hi) << 16); }

#define XB_TMO      128
#define XB_XCNT(j)  (256  + 64 * (j))
#define XB_XSUB(j)  (1280 + 64 * (j))
#define XB_XGEN(j)  (2304 + 64 * (j))
#define XB_TOP      3328
#define XB_TOPGEN   3392
#define XCD_BAR_WORDS 3456
#define XB_SPIN_CAP (1u << 18)

__device__ __forceinline__ unsigned xb_ld(unsigned* p)              { return __hip_atomic_load(p, __ATOMIC_RELAXED, __HIP_MEMORY_SCOPE_AGENT); }
__device__ __forceinline__ unsigned xb_add(unsigned* p, unsigned v) { return __hip_atomic_fetch_add(p, v, __ATOMIC_RELAXED, __HIP_MEMORY_SCOPE_AGENT); }
__device__ __forceinline__ unsigned xb_xcc_id() { return (unsigned)__builtin_amdgcn_s_getreg((3 << 11) | 20) & 0xFu; }
#define XB_SPIN(cond, bar) do { unsigned _sp = 0; while (cond) { __builtin_amdgcn_s_sleep(1); \
    if ((++_sp & 255u) == 0u) { if (xb_ld(&(bar)[XB_TMO])) break; if (_sp > XB_SPIN_CAP) { atomicAdd(&(bar)[XB_TMO], 1u); break; } } } } while (0)

struct XcdBarrier {
    unsigned* bar; unsigned x;
    volatile LAS unsigned* st;
};

__device__ __forceinline__ XcdBarrier xcd_barrier_post(unsigned* bar, volatile LAS unsigned* st) {
    XcdBarrier b; b.bar = bar; b.x = xb_xcc_id(); b.st = st;
    if (threadIdx.x == 0) (void)xb_add(&bar[XB_XCNT(b.x)], 1u);
    return b;
}
__device__ __forceinline__ void xcd_barrier_complete(unsigned* bar, unsigned x, unsigned& nloc, unsigned& nx) {
    const unsigned G = gridDim.x * gridDim.y * gridDim.z;
    unsigned sum, cnt, mine, sp = 0u;
    for (;;) {
        sum = 0u; cnt = 0u; mine = 0u;
#pragma unroll
        for (unsigned j = 0; j < 16; ++j) { const unsigned c = xb_ld(&bar[XB_XCNT(j)]); sum += c; cnt += (c > 0u) ? 1u : 0u; mine = (j == x) ? c : mine; }
        if (sum == G) break;
        __builtin_amdgcn_s_sleep(1);
        if ((++sp & 255u) == 0u) { if (xb_ld(&bar[XB_TMO])) break; if (sp > XB_SPIN_CAP) { atomicAdd(&bar[XB_TMO], 1u); break; } }
    }
    nloc = mine > 0u ? mine : 1u; nx = cnt > 0u ? cnt : 1u;
}

__device__ __forceinline__ void xcd_barrier(const XcdBarrier& b) {
    asm volatile("s_waitcnt vmcnt(0)" ::: "memory");
    __syncthreads();
    if (threadIdx.x == 0) {
        unsigned* bar = b.bar;
        __builtin_amdgcn_s_waitcnt(0);
        unsigned nloc = b.st[0], nx = b.st[1];
        if (nloc == 0u) { xcd_barrier_complete(bar, b.x, nloc, nx); b.st[0] = nloc; b.st[1] = nx; }
        const unsigned old = xb_add(&bar[XB_XSUB(b.x)], 1u);
        const unsigned gen = old / nloc;
        if (old + 1u == (gen + 1u) * nloc) {
            __builtin_amdgcn_fence(__ATOMIC_RELEASE, "agent");
            asm volatile("s_waitcnt vmcnt(0)" ::: "memory");
            const unsigned og = xb_add(&bar[XB_TOP], 1u);
            const unsigned tg = og / nx;
            if (og + 1u == (tg + 1u) * nx) xb_add(&bar[XB_TOPGEN], 1u);
            else XB_SPIN(xb_ld(&bar[XB_TOPGEN]) == tg, bar);
            __builtin_amdgcn_fence(__ATOMIC_ACQUIRE, "agent");
            xb_add(&bar[XB_XGEN(b.x)], 1u);
            asm volatile("s_waitcnt vmcnt(0)" ::: "memory");
        } else {
            XB_SPIN(xb_ld(&bar[XB_XGEN(b.x)]) == gen, bar);
            __builtin_amdgcn_fence(__ATOMIC_ACQUIRE, "agent");
            asm volatile("s_waitcnt vmcnt(0)" ::: "memory");
        }
    }
    __syncthreads();
}

constexpr int NWAVES = 8;
constexpr int T_TOK = 8192, DM = 2048, AW = 1024, SEQ = 2048, NHEAD = 8;
constexpr int NWA = 8192;
constexpr int NEXP = 16384;
constexpr float RMS_EPS = 1e-6f, LOG2E = 1.4426950408889634f;
constexpr float W8SCALE = 64.f;
constexpr float OC8SCALE = 8.f, WB8SCALE = 32.f;
constexpr float MG8SCALE = 16.f;
constexpr float QSCALE = 0.08838834764831845f * 1.4426950408889634f;

constexpr size_t MiB = 1u << 20;
constexpr size_t WS_CTL = 0, CTL_ZERO_BYTES = 1 * MiB;
constexpr size_t WS_WA = 2 * MiB;
constexpr size_t WS_WV = 34 * MiB;
constexpr size_t WS_WB = 38 * MiB;
constexpr size_t WS_WO = 46 * MiB;
constexpr size_t WS_WQ = 54 * MiB;
constexpr size_t WS_LWA = 62 * MiB;
constexpr size_t WS_LWX = 62 * MiB + 256 * 1024;
constexpr size_t WS_KEYS = 62 * MiB + 512 * 1024;
constexpr size_t WS_U8 = 64 * MiB;
constexpr size_t WS_V8 = 96 * MiB;
constexpr size_t WS_US = 128 * MiB;
constexpr size_t WS_VS = 128 * MiB + 65536;
constexpr size_t WS_HN = 192 * MiB;
constexpr size_t WS_X1B = WS_HN;
constexpr size_t WS_Q = 224 * MiB;
constexpr size_t WS_K = 240 * MiB;
constexpr size_t WS_VT = 256 * MiB;
constexpr size_t WS_XR = 272 * MiB;
constexpr size_t WS_GY = 288 * MiB;
constexpr size_t WS_SG = 304 * MiB;
constexpr size_t WS_QP = WS_SG;
constexpr size_t WS_OCAT = 368 * MiB;
constexpr size_t WS_HL = 400 * MiB;
constexpr size_t WS_AC = 432 * MiB;
constexpr size_t WS_TMP = WS_HL;
constexpr size_t WS_SUM = 464 * MiB;
constexpr size_t WS_MG = 466 * MiB;
constexpr size_t WS_SSP = 498 * MiB;
constexpr size_t WS_IDX = 500 * MiB;
constexpr size_t WS_G = 504 * MiB;
constexpr size_t WS_PD = WS_Q;
constexpr size_t WS_ACT = WS_VT;
constexpr size_t WS_OUTP = WS_HL;
constexpr size_t WS_END = 508 * MiB;
constexpr int CW_BAR = 4096;
constexpr int CW_XC = 12288;
constexpr int CW_Q2 = 8192;
constexpr int CW_KM = 65536;
static_assert((CW_KM + 32768) * 4 <= (int)CTL_ZERO_BYTES, "CTL");

constexpr int LDS_BYTES = 163840;
constexpr int MISC_OFF = 163840 - 256;
constexpr int SCR_BYTES = MISC_OFF;

typedef float f32x16 __attribute__((ext_vector_type(16)));
typedef float f32x2_t __attribute__((ext_vector_type(2)));
typedef __bf16 bf16x2_t __attribute__((ext_vector_type(2)));
typedef unsigned long long u64;
__device__ __forceinline__ float clamp8(float v) { return fminf(fmaxf(v, -448.f), 448.f); }
__device__ __forceinline__ unsigned cvtpk(float lo, float hi) { f32x2_t v = {lo, hi}; bf16x2_t b = __builtin_convertvector(v, bf16x2_t); return __builtin_bit_cast(unsigned, b); }
__device__ __forceinline__ float bf_lo(unsigned w) { return __builtin_bit_cast(float, w << 16); }
__device__ __forceinline__ float bf_hi(unsigned w) { return __builtin_bit_cast(float, w & 0xffff0000u); }
__device__ __forceinline__ f32x4 bf4_lo2(unsigned a, unsigned b) { f32x4 r; r[0] = bf_lo(a); r[1] = bf_hi(a); r[2] = bf_lo(b); r[3] = bf_hi(b); return r; }
__device__ __forceinline__ float wave_sum(float v) {
#pragma unroll
    for (int o = 1; o < 64; o <<= 1) v += __shfl_xor(v, o);
    return v;
}
__device__ __forceinline__ float dot2bf(unsigned a, unsigned b, float acc) { return __builtin_amdgcn_fdot2_f32_bf16(__builtin_bit_cast(bf16x2_t, a), __builtin_bit_cast(bf16x2_t, b), acc, false); }

struct Params {
    const float *x, *g_mix, *w_in, *conv_w, *conv_b, *lru_wa, *lru_ba, *lru_wx, *lru_bx, *lru_lam, *w_branch, *w_out, *rel_bias, *g_ffn, *peer_wq, *peer_keys, *peer_u, *peer_v, *g_fin;
    float* out; unsigned char* ws; int ph_lo, ph_hi;
};

struct TrD { const float* W; const float* ks; unsigned char* d; int N, k0, n0, ldd; float sc; bool f8; };
__device__ __forceinline__ void tr_load(const TrD& t, int lane, f32x4 (&wv)[8]) {
#pragma unroll
    for (int i = 0; i < 8; ++i) wv[i] = *(const f32x4*)(t.W + (size_t)(t.k0 + (lane >> 3) + 8 * i) * t.N + t.n0 + 4 * (lane & 7));
}
__device__ __forceinline__ void tr_finish(const TrD& t, f32x4 (&wv)[8], LAS float* scr, int lane) {
#pragma unroll
    for (int i = 0; i < 8; ++i) { const int kk = (lane >> 3) + 8 * i; f32x4 v = wv[i]; if (t.ks) v = v * t.ks[t.k0 + kk];
#pragma unroll
        for (int e = 0; e < 4; ++e) scr[kk * 33 + 4 * (lane & 7) + e] = v[e]; }
    LDS_WAIT(); asm volatile("" ::: "memory");
    const int c = lane & 7; const float f8scale = t.sc;
#pragma unroll
    for (int j = 0; j < 4; ++j) { const int n = (lane >> 3) + 8 * j; const LAS float* s = scr + (8 * c) * 33 + n;
        if (t.f8) {
            int p0 = __builtin_amdgcn_cvt_pk_fp8_f32(clamp8(s[0 * 33] * f8scale), clamp8(s[1 * 33] * f8scale), 0, false); p0 = __builtin_amdgcn_cvt_pk_fp8_f32(clamp8(s[2 * 33] * f8scale), clamp8(s[3 * 33] * f8scale), p0, true);
            int p1 = __builtin_amdgcn_cvt_pk_fp8_f32(clamp8(s[4 * 33] * f8scale), clamp8(s[5 * 33] * f8scale), 0, false); p1 = __builtin_amdgcn_cvt_pk_fp8_f32(clamp8(s[6 * 33] * f8scale), clamp8(s[7 * 33] * f8scale), p1, true);
            *(u64*)(t.d + (size_t)n * t.ldd + t.k0 + 8 * c) = (u64)(unsigned)p0 | ((u64)(unsigned)p1 << 32);
        } else {
        v4u o; o.x = cvtpk(s[0 * 33], s[1 * 33]); o.y = cvtpk(s[2 * 33], s[3 * 33]); o.z = cvtpk(s[4 * 33], s[5 * 33]); o.w = cvtpk(s[6 * 33], s[7 * 33]);
        *(v4u*)(t.d + (size_t)n * t.ldd + 2 * (t.k0 + 8 * c)) = o; } }
    LDS_WAIT(); asm volatile("" ::: "memory");
}
template <int MODE> __device__ __forceinline__ void row_to_bf16(const float* src, bf16* dst, const float* colscale, int lane) {
    const f32x4* s = (const f32x4*)src + lane;
    f32x4 v[8]; float ss = 0.f;
#pragma unroll
    for (int j = 0; j < 8; ++j) { v[j] = s[64 * j]; ss += (v[j][0] * v[j][0] + v[j][1] * v[j][1]) + (v[j][2] * v[j][2] + v[j][3] * v[j][3]); }
    float rs = 1.f;
    if (MODE == 1) rs = __builtin_amdgcn_rsqf(wave_sum(ss) * (1.f / 2048.f) + RMS_EPS);
    u64* o8 = (u64*)dst + lane;
#pragma unroll
    for (int j = 0; j < 8; ++j) { f32x4 w = v[j] * rs; if (colscale) w = w * ((const f32x4*)colscale)[64 * j + lane];
        o8[64 * j] = (u64)cvtpk(w[0], w[1]) | ((u64)cvtpk(w[2], w[3]) << 32); }
}
template <bool I8, bool NT = false> __device__ __forceinline__ void row_finish8(f32x4 (&v)[8], unsigned char* dst, float* scale_out, int lane) {
    float am = 0.f;
#pragma unroll
    for (int j = 0; j < 8; ++j) am = fmaxf(am, fmaxf(fmaxf(fabsf(v[j][0]), fabsf(v[j][1])), fmaxf(fabsf(v[j][2]), fabsf(v[j][3]))));
#pragma unroll
    for (int o = 1; o < 64; o <<= 1) am = fmaxf(am, __shfl_xor(am, o));
    const float qmax = I8 ? 127.f : 448.f;
    const float sc = am > 0.f ? am / qmax : 1.f, inv = 1.f / sc;
    unsigned* o4 = (unsigned*)(dst + (size_t)(lane >> 5) * NEXP * 128) + (lane & 31);
#pragma unroll
    for (int j = 0; j < 8; ++j) { unsigned w;
        if (I8) { const int q0 = (int)rintf(v[j][0] * inv), q1 = (int)rintf(v[j][1] * inv), q2 = (int)rintf(v[j][2] * inv), q3 = (int)rintf(v[j][3] * inv);
            w = (unsigned)(q0 & 255) | ((unsigned)(q1 & 255) << 8) | ((unsigned)(q2 & 255) << 16) | ((unsigned)q3 << 24); }
        else { int p = __builtin_amdgcn_cvt_pk_fp8_f32(v[j][0] * inv, v[j][1] * inv, 0, false); p = __builtin_amdgcn_cvt_pk_fp8_f32(v[j][2] * inv, v[j][3] * inv, p, true); w = (unsigned)p; }
        if (NT) __builtin_nontemporal_store(w, o4 + (size_t)(2 * j) * NEXP * 32); else o4[(size_t)(2 * j) * NEXP * 32] = w; }
    if (lane == 0) *scale_out = sc;
}
template <bool I8, int NR = 2, bool NT = false> __device__ __forceinline__ void table_rows8(const float* src, unsigned char* dst, float* scales, const float* colscale, int r0, int r1, int wv, int nwv, int lane) {
    f32x4 cs[8];
#pragma unroll
    for (int j = 0; j < 8; ++j) cs[j] = colscale ? ((const f32x4*)colscale)[64 * j + lane] : (f32x4){1.f, 1.f, 1.f, 1.f};
    for (int m = r0 + wv; m < r1; m += NR * nwv) {
        f32x4 v[NR][8];
#pragma unroll
        for (int q = 0; q < NR; ++q) { const int mq = m + q * nwv; if (mq < r1) {
#pragma unroll
            for (int j = 0; j < 8; ++j) v[q][j] = NT ? __builtin_nontemporal_load((const f32x4*)(src + (size_t)mq * DM) + 64 * j + lane) : ((const f32x4*)(src + (size_t)mq * DM))[64 * j + lane]; } }
#pragma unroll
        for (int q = 0; q < NR; ++q) { const int mq = m + q * nwv; if (mq < r1) {
            if (colscale) {
#pragma unroll
                for (int j = 0; j < 8; ++j) v[q][j] = v[q][j] * cs[j]; }
            row_finish8<I8, NT>(v[q], dst + (size_t)mq * 128, scales + mq, lane); } }
    }
}
template <int NR> __device__ __forceinline__ void peer_table_u(const Params& P, int r0, int r1, int wv, int nwv, int lane) { table_rows8<true, NR>(P.peer_u, P.ws + WS_U8, (float*)(P.ws + WS_US), P.g_ffn, r0, r1, wv, nwv, lane); }
template <int NR, bool NT = false> __device__ __forceinline__ void peer_table_v(const Params& P, int r0, int r1, int wv, int nwv, int lane) { table_rows8<false, NR, NT>(P.peer_v, P.ws + WS_V8, (float*)(P.ws + WS_VS), nullptr, r0, r1, wv, nwv, lane); }
constexpr int TT_PITCH = 260;
constexpr int TT_IN = 16 * 36, TT_BR = 2 * 8 * 8, TT_SQ = 16 * 8, TT_N = TT_IN + TT_BR + 2 * TT_SQ;
static_assert(128 * TT_PITCH * 4 <= MISC_OFF, "transpose tile");
__device__ __forceinline__ TrD tt_decode(const Params& P, int T) {
    unsigned char* ws = P.ws;
    TrD t; t.ks = nullptr; t.f8 = true; t.ldd = 2048; t.sc = W8SCALE;
    if (T < TT_IN) { const int kt = T / 36, nt = T % 36, n0 = 256 * nt; t.W = P.w_in; t.N = 9216; t.k0 = 128 * kt; t.n0 = n0;
        t.d = (n0 < 2048) ? ws + WS_WA + (size_t)n0 * 2048 : (n0 < 3072 ? ws + WS_WV + (size_t)(n0 - 2048) * 2048 : ws + WS_WA + (size_t)(n0 - 1024) * 2048); return t; } T -= TT_IN;
    if (T < TT_BR) { const int br = T / 64, q = T % 64, kt = q / 8, nt = q % 8; t.W = P.w_branch + (size_t)br * 1024 * 2048; t.N = 2048; t.k0 = 128 * kt; t.n0 = 256 * nt; t.sc = WB8SCALE;
        t.d = ws + WS_WB + (size_t)(256 * nt) * 2048 + br * 1024; return t; } T -= TT_BR;
    if (T < TT_SQ) { const int kt = T / 8, nt = T % 8; t.W = P.w_out; t.N = 2048; t.k0 = 128 * kt; t.n0 = 256 * nt; t.d = ws + WS_WO + (size_t)(256 * nt) * 2048; return t; } T -= TT_SQ;
    { const int kt = T / 8, nt = T % 8; t.f8 = false; t.sc = 1.f; t.W = P.peer_wq; t.N = 2048; t.k0 = 128 * kt; t.n0 = 256 * nt; t.ks = P.g_ffn; t.ldd = 4096; t.d = ws + WS_WQ + (size_t)(256 * nt) * 4096; return t; }
}
__device__ __forceinline__ void tt_load(const TrD& t, int wave, int lane, f32x4 (&v)[16]) {
#pragma unroll
    for (int i = 0; i < 16; ++i) v[i] = *(const f32x4*)(t.W + (size_t)(t.k0 + 16 * wave + i) * t.N + t.n0 + 4 * lane);
}
__device__ __forceinline__ void tt_to_lds(const TrD& t, LAS float* tile, int wave, int lane, f32x4 (&v)[16]) {
#pragma unroll
    for (int i = 0; i < 16; ++i) { f32x4 w = v[i] * t.sc; if (t.ks) w = w * t.ks[t.k0 + 16 * wave + i]; *(LAS f32x4*)(tile + (16 * wave + i) * TT_PITCH + 4 * lane) = w; }
}
__device__ __forceinline__ void tt_emit(const TrD& t, const LAS float* tile, int tid) {
    const int n = tid & 255, kh = tid >> 8; const LAS float* s = tile + (64 * kh) * TT_PITCH + n;
    if (t.f8) { unsigned char* o = t.d + (size_t)n * t.ldd + t.k0 + 64 * kh;
#pragma unroll
        for (int q = 0; q < 4; ++q) { v4u w;
#pragma unroll
            for (int e = 0; e < 4; ++e) { const LAS float* z = s + (16 * q + 4 * e) * TT_PITCH;
                int pk = __builtin_amdgcn_cvt_pk_fp8_f32(clamp8(z[0]), clamp8(z[TT_PITCH]), 0, false); pk = __builtin_amdgcn_cvt_pk_fp8_f32(clamp8(z[2 * TT_PITCH]), clamp8(z[3 * TT_PITCH]), pk, true); w[e] = (unsigned)pk; }
            *(v4u*)(o + 16 * q) = w; }
    } else { unsigned char* o = t.d + (size_t)n * t.ldd + 2 * (t.k0 + 64 * kh);
#pragma unroll
        for (int q = 0; q < 8; ++q) { v4u w;
#pragma unroll
            for (int e = 0; e < 4; ++e) { const LAS float* z = s + (8 * q + 2 * e) * TT_PITCH; w[e] = cvtpk(z[0], z[TT_PITCH]); }
            *(v4u*)(o + 16 * q) = w; } }
}
__device__ __forceinline__ TrD tr_decode_lru(const Params& P, int r) {
    TrD t; t.ks = nullptr; t.f8 = false; t.sc = 1.f;
    const int which = r / 64, q = r % 64, g = q / 8, kb = (q % 8) / 4, nb = q % 4;
    t.W = (which ? P.lru_wx : P.lru_wa) + (size_t)g * 16384; t.N = 128; t.k0 = 64 * kb; t.n0 = 32 * nb; t.ldd = 256; t.d = P.ws + (which ? WS_LWX : WS_LWA) + ((size_t)g * 16384 + (size_t)(32 * nb) * 128) * 2; return t;
}
__device__ __forceinline__ void p0_prologue(const Params& P, LAS unsigned char* lds, int gw, int NGW, int wave, int lane, int r1) {
    unsigned char* ws = P.ws;
    const int vcu = gw / NWAVES, G = NGW / NWAVES, tid = wave * 64 + lane;
    { LAS float* tile = (LAS float*)lds; f32x4 v[16];
      int T = vcu; TrD a = tt_decode(P, T < TT_N ? T : 0);
      if (T < TT_N) tt_load(a, wave, lane, v);
      while (T < TT_N) {
          tt_to_lds(a, tile, wave, lane, v);
          __syncthreads();
          const TrD cur = a; const int Tn = T + G;
          if (Tn < TT_N) { a = tt_decode(P, Tn); tt_load(a, wave, lane, v); }
          tt_emit(cur, tile, tid);
          __syncthreads();
          T = Tn; } }
    if (gw < 128) { LAS float* scr = (LAS float*)(lds + wave * 16384); TrD a = tr_decode_lru(P, gw); f32x4 wa[8]; tr_load(a, lane, wa); tr_finish(a, wa, scr, lane); }
#ifdef TPROBE
    *(volatile LAS unsigned*)(lds + MISC_OFF + 4 * 52) = (unsigned)__builtin_amdgcn_s_memrealtime();
#endif
    { bf16* KB = (bf16*)(ws + WS_KEYS);
      for (int i = gw * 64 + lane; i < 262144 / 8; i += NGW * 64) { const f32x4 a = ((const f32x4*)P.peer_keys)[2 * i], b = ((const f32x4*)P.peer_keys)[2 * i + 1];
          v4u o; o.x = cvtpk(a[0], a[1]); o.y = cvtpk(a[2], a[3]); o.z = cvtpk(b[0], b[1]); o.w = cvtpk(b[2], b[3]); ((v4u*)KB)[i] = o; } }
    { unsigned char* HN = ws + WS_HN;
      const int tq = TT_N / G, n_hi = TT_N - tq * G, W = (T_TOK + 16 * TT_N + G - 1) / G, r_hi = W - 16 * (tq + 1), r_lo = W - 16 * tq;
      int r0, cnt;
      if (r_hi >= 0 && n_hi * r_hi + (G - n_hi) * r_lo >= T_TOK) { r0 = vcu < n_hi ? vcu * r_hi : n_hi * r_hi + (vcu - n_hi) * r_lo; cnt = vcu < n_hi ? r_hi : r_lo; }
      else { const int per = (T_TOK + G - 1) / G; r0 = vcu * per; cnt = per; }
      const int rend = (r0 + cnt < T_TOK) ? r0 + cnt : T_TOK;
      for (int m = r0 + wave; m < rend; m += 4 * NWAVES) {
          f32x4 v[4][8];
#pragma unroll
          for (int q = 0; q < 4; ++q) { const int mq = m + q * NWAVES; if (mq < rend) {
#pragma unroll
              for (int j = 0; j < 8; ++j) v[q][j] = ((const f32x4*)(P.x + (size_t)mq * DM))[64 * j + lane]; } }
#pragma unroll
          for (int q = 0; q < 4; ++q) { const int mq = m + q * NWAVES; if (mq < rend) {
              float sa = 0.f;
#pragma unroll
              for (int j = 0; j < 8; ++j) sa += (v[q][j][0] * v[q][j][0] + v[q][j][1] * v[q][j][1]) + (v[q][j][2] * v[q][j][2] + v[q][j][3] * v[q][j][3]);
              const float ra = __builtin_amdgcn_rsqf(wave_sum(sa) * (1.f / 2048.f) + RMS_EPS);
              unsigned* oa = (unsigned*)(HN + (size_t)mq * DM) + lane;
#pragma unroll
              for (int j = 0; j < 8; ++j) { const f32x4 w = v[q][j] * ra * ((const f32x4*)P.g_mix)[64 * j + lane]; int p = __builtin_amdgcn_cvt_pk_fp8_f32(w[0], w[1], 0, false); p = __builtin_amdgcn_cvt_pk_fp8_f32(w[2], w[3], p, true); oa[64 * j] = (unsigned)p; } } } } }
    if (r1 > 0) { peer_table_u<2>(P, 0, r1, gw, NGW, lane); peer_table_v<2>(P, 0, r1, gw, NGW, lane); }
}

constexpr int AT_KT = 0, AT_VT = 2 * 17408, AT_KM = AT_VT + 2 * 18432, AT_B2 = AT_KM + 4096, AT_SEL = AT_B2 + 512, AT_ANY = AT_SEL + 1024;
#define MFMA32(a, b, c) __builtin_amdgcn_mfma_f32_32x32x16_bf16((a), (b), (c), 0, 0, 0)
__device__ __forceinline__ void attn_unit(const Params& P, LAS unsigned char* lds, int b, int h, int blk, int tid, int wave, int lane) {
    unsigned char* ws = P.ws;
    const bf16* Qb = (const bf16*)(ws + WS_Q); const bf16* Kb = (const bf16*)(ws + WS_K); const bf16* VTg = (const bf16*)(ws + WS_VT); bf16* OATT = (bf16*)(ws + WS_OCAT);
    const float* KMg = (const float*)(ws + WS_CTL) + CW_KM;
    LAS float* KMs = (LAS float*)(lds + AT_KM); LAS float* B2 = (LAS float*)(lds + AT_B2); LAS unsigned* SELM = (LAS unsigned*)(lds + AT_SEL); LAS unsigned* UANY = (LAS unsigned*)(lds + AT_ANY);
    const int row_blk0 = b * SEQ + blk * 256;
    __syncthreads();
    for (int i = tid; i < 1024; i += 512) KMs[i] = KMg[(size_t)(b * 8 + h) * 1024 + i] * (1.f / 256.f);
    if (tid < 128) { const int d = tid; int bucket = d;
        if (d >= 16) { bucket = 16 + (int)(__logf((float)d * (1.f / 16.f)) * (16.f / 2.0794415416798357f)); bucket = bucket > 31 ? 31 : bucket; }
        B2[d] = (P.rel_bias[bucket * 8 + h] - P.rel_bias[31 * 8 + h]) * LOG2E; }
    if (tid == 0) *UANY = 0u;
    __syncthreads();
    {
        const int qq = tid >> 1, q2 = tid & 1;
        unsigned mask = (1u << blk) - 1u;
        if (blk > 3) {
            const bf16* qrow = Qb + (size_t)(row_blk0 + qq) * AW + h * 128;
            v4u qv[8];
#pragma unroll
            for (int c8 = 0; c8 < 8; ++c8) qv[c8] = *(const v4u*)(qrow + 8 * (q2 + 2 * c8));
            float g0 = 0.f, g1 = 0.f, g2 = 0.f, g3 = 0.f, g4 = 0.f, g5 = 0.f, g6 = 0.f;
#pragma unroll
            for (int c8 = 0; c8 < 8; ++c8) { const float q[8] = {bf_lo(qv[c8].x), bf_hi(qv[c8].x), bf_lo(qv[c8].y), bf_hi(qv[c8].y), bf_lo(qv[c8].z), bf_hi(qv[c8].z), bf_lo(qv[c8].w), bf_hi(qv[c8].w)};
#pragma unroll
                for (int e = 0; e < 8; ++e) { const LAS float* km = KMs + 8 * (q2 + 2 * c8) + e;
                    g0 += q[e] * km[0]; g1 += q[e] * km[128]; g2 += q[e] * km[256]; g3 += q[e] * km[384]; g4 += q[e] * km[512]; g5 += q[e] * km[640]; g6 += q[e] * km[768]; } }
            g0 += __shfl_xor(g0, 1); g1 += __shfl_xor(g1, 1); g2 += __shfl_xor(g2, 1); g3 += __shfl_xor(g3, 1); g4 += __shfl_xor(g4, 1); g5 += __shfl_xor(g5, 1); g6 += __shfl_xor(g6, 1);
            const float NEGG = -3.0e38f;
            if (blk < 7) g6 = NEGG; if (blk < 6) g5 = NEGG; if (blk < 5) g4 = NEGG;
            mask = 0u;
#pragma unroll
            for (int s = 0; s < 3; ++s) { float best = g0; int bj = 0;
                if (g1 > best) { best = g1; bj = 1; } if (g2 > best) { best = g2; bj = 2; } if (g3 > best) { best = g3; bj = 3; }
                if (g4 > best) { best = g4; bj = 4; } if (g5 > best) { best = g5; bj = 5; } if (g6 > best) { best = g6; bj = 6; }
                mask |= 1u << bj;
                g0 = bj == 0 ? NEGG : g0; g1 = bj == 1 ? NEGG : g1; g2 = bj == 2 ? NEGG : g2; g3 = bj == 3 ? NEGG : g3; g4 = bj == 4 ? NEGG : g4; g5 = bj == 5 ? NEGG : g5; g6 = bj == 6 ? NEGG : g6; }
        }
        if (q2 == 0) { SELM[qq] = mask; __hip_atomic_fetch_or(UANY, mask, __ATOMIC_RELAXED, __HIP_MEMORY_SCOPE_WORKGROUP); }
    }
    __syncthreads();
    const unsigned uany = *UANY;
    unsigned blist = (unsigned)blk; int nb = 1;
    for (int j = blk - 1; j >= 0; --j) if ((uany >> j) & 1u) { blist |= (unsigned)j << (4 * nb); ++nb; }
    const int nsteps = 4 * nb;
    const int qi = 32 * wave + (lane & 31), hh = lane >> 5;
    const unsigned mymask = SELM[qi];
    bf16x8 Qf[8];
    { const bf16* qp = Qb + (size_t)(row_blk0 + qi) * AW + h * 128 + 8 * hh;
#pragma unroll
      for (int ks = 0; ks < 8; ++ks) Qf[ks] = *(const bf16x8*)(qp + 16 * ks); }
    float m_run = -1.0e30f, lsum = 0.f;
    f32x16 O[4];
#pragma unroll
    for (int dt = 0; dt < 4; ++dt)
#pragma unroll
        for (int r = 0; r < 16; ++r) O[dt][r] = 0.f;
    const int kkey0 = tid >> 4, kpart = tid & 15;
    const int vd0 = tid >> 3, vcc = tid & 7;
    const unsigned kl0 = kkey0 * 272 + kpart * 16, kl1 = kl0 + 32 * 272;
    const unsigned vl0 = vd0 * 144 + ((((vcc >> 2) * 2 + ((vcc & 3) >> 1)) * 2) * 16) + (vcc & 1) * 8, vl1 = vl0 + 64 * 144;
    v4u ka0, ka1, va0, va1, kb0, kb1, vb0, vb1;
#define AT_LOAD(s, k0, k1, v0, v1) do { const int j_ = (blist >> (4 * ((s) >> 2))) & 15, kt_ = (s) & 3; const size_t krow0 = (size_t)b * SEQ + j_ * 256 + kt_ * 64; \
        k0 = *(const v4u*)(Kb + (krow0 + kkey0) * AW + h * 128 + kpart * 8); k1 = *(const v4u*)(Kb + (krow0 + kkey0 + 32) * AW + h * 128 + kpart * 8); \
        v0 = *(const v4u*)(VTg + (size_t)(h * 128 + vd0) * T_TOK + krow0 + vcc * 8); v1 = *(const v4u*)(VTg + (size_t)(h * 128 + vd0 + 64) * T_TOK + krow0 + vcc * 8); } while (0)
#define AT_STORE(bufi, k0, k1, v0, v1) do { LAS unsigned char* KT_ = lds + AT_KT + (bufi) * 17408; LAS unsigned char* VT_ = lds + AT_VT + (bufi) * 18432; \
        *(LAS v4u*)(KT_ + kl0) = k0; *(LAS v4u*)(KT_ + kl1) = k1; \
        *(LAS u64*)(VT_ + vl0) = (u64)v0.x | ((u64)v0.y << 32); *(LAS u64*)(VT_ + vl0 + 16) = (u64)v0.z | ((u64)v0.w << 32); \
        *(LAS u64*)(VT_ + vl1) = (u64)v1.x | ((u64)v1.y << 32); *(LAS u64*)(VT_ + vl1 + 16) = (u64)v1.z | ((u64)v1.w << 32); } while (0)
    AT_LOAD(0, ka0, ka1, va0, va1); AT_STORE(0, ka0, ka1, va0, va1);
    if (1 < nsteps) AT_LOAD(1, ka0, ka1, va0, va1);
    if (2 < nsteps) AT_LOAD(2, kb0, kb1, vb0, vb1);
    for (int s = 0; s < nsteps; ++s) {
        const int j = (blist >> (4 * (s >> 2))) & 15, kt = s & 3;
        __syncthreads();
        if ((s & 1) == 0) { if (s + 1 < nsteps) AT_STORE((s + 1) & 1, ka0, ka1, va0, va1); if (s + 3 < nsteps) AT_LOAD(s + 3, ka0, ka1, va0, va1); }
        else              { if (s + 1 < nsteps) AT_STORE((s + 1) & 1, kb0, kb1, vb0, vb1); if (s + 3 < nsteps) AT_LOAD(s + 3, kb0, kb1, vb0, vb1); }
        const LAS unsigned char* KT = lds + AT_KT + (s & 1) * 17408; const LAS unsigned char* VTl = lds + AT_VT + (s & 1) * 18432;
        bool part;
        if (j == blk) part = (64 * kt <= 32 * wave + 31);
        else part = (__ballot((mymask >> j) & 1u) != 0ull);
        if (part) {
            f32x16 S0, S1;
#pragma unroll
            for (int r = 0; r < 16; ++r) { S0[r] = 0.f; S1[r] = 0.f; }
            const LAS unsigned char* kp = KT + (lane & 31) * 272 + hh * 16;
#pragma unroll
            for (int ks = 0; ks < 8; ++ks) { const bf16x8 a0 = *(const LAS bf16x8*)(kp + ks * 32), a1 = *(const LAS bf16x8*)(kp + 32 * 272 + ks * 32);
                S0 = MFMA32(a0, Qf[ks], S0); S1 = MFMA32(a1, Qf[ks], S1); }
            const bool sel = ((mymask >> j) & 1u) != 0u;
            float mx = -1.0e30f; bool ok_row = true;
            const int dmin = 32 * wave + 256 * (blk - j) - 64 * kt - 63;
            if (dmin < 113) {
                const int dbase = (j == blk) ? (qi - 64 * kt - 4 * hh) : (qi + 256 - 64 * kt - 4 * hh);
                const bool okrow = (j == blk) ? true : sel;
#pragma unroll
                for (int r = 0; r < 16; ++r) { const int kk = (r & 3) + 8 * (r >> 2);
                    { const int dist = dbase - kk; const int di = dist < 0 ? 0 : (dist > 127 ? 127 : dist); const float v = (okrow && dist >= 0) ? S0[r] + B2[di] : -1.0e30f; S0[r] = v; mx = fmaxf(mx, v); }
                    { const int dist = dbase - 32 - kk; const int di = dist < 0 ? 0 : (dist > 127 ? 127 : dist); const float v = (okrow && dist >= 0) ? S1[r] + B2[di] : -1.0e30f; S1[r] = v; mx = fmaxf(mx, v); } }
            } else {
                ok_row = sel || (j == blk);
#pragma unroll
                for (int r = 0; r < 16; ++r) mx = fmaxf(mx, fmaxf(S0[r], S1[r]));
                mx = ok_row ? mx : -1.0e30f;
            }
            mx = fmaxf(mx, __shfl_xor(mx, 32));
            const bool need = mx > m_run + 8.f;
            if (__any(need)) { const float m_new = need ? mx : m_run, alpha = __builtin_amdgcn_exp2f(m_run - m_new);
                m_run = m_new; lsum *= alpha;
#pragma unroll
                for (int dt = 0; dt < 4; ++dt)
#pragma unroll
                    for (int r = 0; r < 16; ++r) O[dt][r] *= alpha; }
            float ps = 0.f;
            const float m_eff = ok_row ? m_run : 1.0e30f;
#pragma unroll
            for (int r = 0; r < 16; ++r) { S0[r] = __builtin_amdgcn_exp2f(S0[r] - m_eff); S1[r] = __builtin_amdgcn_exp2f(S1[r] - m_eff); ps += S0[r] + S1[r]; }
            lsum += ps;
            bf16x8 Pf[2][2];
#pragma unroll
            for (int s2 = 0; s2 < 2; ++s2) {
                v4u p0, p1;
                p0.x = cvtpk(S0[8 * s2], S0[8 * s2 + 1]); p0.y = cvtpk(S0[8 * s2 + 2], S0[8 * s2 + 3]); p0.z = cvtpk(S0[8 * s2 + 4], S0[8 * s2 + 5]); p0.w = cvtpk(S0[8 * s2 + 6], S0[8 * s2 + 7]);
                p1.x = cvtpk(S1[8 * s2], S1[8 * s2 + 1]); p1.y = cvtpk(S1[8 * s2 + 2], S1[8 * s2 + 3]); p1.z = cvtpk(S1[8 * s2 + 4], S1[8 * s2 + 5]); p1.w = cvtpk(S1[8 * s2 + 6], S1[8 * s2 + 7]);
                Pf[0][s2] = __builtin_bit_cast(bf16x8, p0); Pf[1][s2] = __builtin_bit_cast(bf16x8, p1); }
            const LAS unsigned char* vp = VTl + (lane & 31) * 144 + hh * 16;
#pragma unroll
            for (int dt = 0; dt < 4; ++dt)
#pragma unroll
                for (int mt = 0; mt < 2; ++mt)
#pragma unroll
                    for (int s2 = 0; s2 < 2; ++s2) { const bf16x8 a = *(const LAS bf16x8*)(vp + dt * 32 * 144 + (mt * 2 + s2) * 32); O[dt] = MFMA32(a, Pf[mt][s2], O[dt]); }
        }
    }
#undef AT_LOAD
#undef AT_STORE
    const float ltot = lsum + __shfl_xor(lsum, 32), inv = 1.f / ltot;
    unsigned char* orow = (unsigned char*)OATT + (size_t)(row_blk0 + qi) * DM + h * 128 + 4 * hh;
    const float osc = inv * OC8SCALE;
#pragma unroll
    for (int dt = 0; dt < 4; ++dt)
#pragma unroll
        for (int g4 = 0; g4 < 4; ++g4) { int p = __builtin_amdgcn_cvt_pk_fp8_f32(clamp8(O[dt][4 * g4] * osc), clamp8(O[dt][4 * g4 + 1] * osc), 0, false); p = __builtin_amdgcn_cvt_pk_fp8_f32(clamp8(O[dt][4 * g4 + 2] * osc), clamp8(O[dt][4 * g4 + 3] * osc), p, true);
            *(unsigned*)(orow + 32 * dt + 8 * g4) = (unsigned)p; }
}
constexpr int LR_XC = 0, LR_SEG = 2 * 17408, LR_W = LR_SEG + 2 * 4096;
#define MFMA16(a, b, c) __builtin_amdgcn_mfma_f32_16x16x32_bf16((a), (b), (c), 0, 0, 0)
__device__ __forceinline__ void lru_pair(const Params& P, LAS unsigned char* lds, int pair, int tid, int wave, int lane, unsigned* tkword, int& tk_next) {
    unsigned char* ws = P.ws;
    const int grp = wave >> 2, wq = wave & 3, tg = tid & 255;
    const int unit = 2 * pair + grp, b = unit >> 8, g = (unit >> 5) & 7, c = unit & 31;
    const bf16* XR = (const bf16*)(ws + WS_XR); const bf16* LWA = (const bf16*)(ws + WS_LWA) + (size_t)g * 16384; const bf16* LWX = (const bf16*)(ws + WS_LWX) + (size_t)g * 16384;
    float* HL = (float*)(ws + WS_HL); float* SUM = (float*)(ws + WS_SUM);
    LAS unsigned short* XC = (LAS unsigned short*)(lds + LR_XC + grp * 17408);
    LAS float* SEG = (LAS float*)(lds + LR_SEG + grp * 4096);
    LAS unsigned char* WL = lds + LR_W;
    const int t0 = c * 64; const size_t R0 = (size_t)b * SEQ + t0;
    __syncthreads();
    {
      v4u wv[8];
#pragma unroll
      for (int i = 0; i < 8; ++i) { const int q = tid + 512 * i, mat = q >> 11, row = (q >> 4) & 127, part = q & 15; wv[i] = *(const v4u*)((mat ? LWX : LWA) + row * 128 + part * 8); }
      const int cpart = tg & 15, C8 = g * 128 + 8 * cpart;
      f32x4 cw[4][2], cbv[2];
#pragma unroll
      for (int w = 0; w < 4; ++w) { cw[w][0] = *(const f32x4*)(P.conv_w + w * 1024 + C8); cw[w][1] = *(const f32x4*)(P.conv_w + w * 1024 + C8 + 4); }
      cbv[0] = *(const f32x4*)(P.conv_b + C8); cbv[1] = *(const f32x4*)(P.conv_b + C8 + 4);
#define LR_CONV_LOAD(xr, base) do { _Pragma("unroll") for (int i2 = 0; i2 < 2; ++i2) { const int tl = (tg >> 4) + 16 * ((base) + i2); \
          _Pragma("unroll") for (int w = 0; w < 4; ++w) { const int ts = t0 + tl - 3 + w; xr[i2][w] = (ts >= 0) ? *(const v4u*)(XR + ((size_t)b * SEQ + ts) * AW + C8) : (v4u){0u, 0u, 0u, 0u}; } } } while (0)
#define LR_CONV_DO(xr, base) do { _Pragma("unroll") for (int i2 = 0; i2 < 2; ++i2) { const int tl = (tg >> 4) + 16 * ((base) + i2); f32x4 y0 = cbv[0], y1 = cbv[1]; \
          _Pragma("unroll") for (int w = 0; w < 4; ++w) { y0 = y0 + bf4_lo2(xr[i2][w].x, xr[i2][w].y) * cw[w][0]; y1 = y1 + bf4_lo2(xr[i2][w].z, xr[i2][w].w) * cw[w][1]; } \
          v4u o; o.x = cvtpk(y0[0], y0[1]); o.y = cvtpk(y0[2], y0[3]); o.z = cvtpk(y1[0], y1[1]); o.w = cvtpk(y1[2], y1[3]); \
          *(LAS v4u*)((LAS unsigned char*)XC + tl * 272 + cpart * 16) = o; } } while (0)
      { v4u xr[2][4]; LR_CONV_LOAD(xr, 0);
#pragma unroll
        for (int i = 0; i < 8; ++i) { const int q = tid + 512 * i, mat = q >> 11, row = (q >> 4) & 127, part = q & 15; *(LAS v4u*)(WL + (mat * 128 + row) * 272 + part * 16) = wv[i]; }
        LR_CONV_DO(xr, 0); }
      { v4u xr[2][4]; LR_CONV_LOAD(xr, 2); LR_CONV_DO(xr, 2); }
#undef LR_CONV_LOAD
#undef LR_CONV_DO
    }
    __syncthreads();
    if (tid == 0) tk_next = (int)__hip_atomic_fetch_add(tkword, 1u, __ATOMIC_RELAXED, __HIP_MEMORY_SCOPE_AGENT);
    const int fr = lane & 15, fq = lane >> 4;
    float Ar[2][4][4], Hr[2][4][4], AE[2][4], HE[2][4];
#pragma unroll
    for (int nh = 0; nh < 2; ++nh) {
        f32x4 aA[4], aX[4];
#pragma unroll
        for (int nt = 0; nt < 4; ++nt) { aA[nt] = (f32x4){0.f, 0.f, 0.f, 0.f}; aX[nt] = (f32x4){0.f, 0.f, 0.f, 0.f}; }
#pragma unroll 1
        for (int ks = 0; ks < 4; ++ks) { const bf16x8 a = *(const LAS bf16x8*)((LAS unsigned char*)XC + (16 * wq + fr) * 272 + (32 * ks + 8 * fq) * 2);
#pragma unroll
            for (int nt = 0; nt < 4; ++nt) { const int wo = (64 * nh + 16 * nt + fr) * 272 + (32 * ks + 8 * fq) * 2;
                const bf16x8 ba = *(const LAS bf16x8*)(WL + wo), bx = *(const LAS bf16x8*)(WL + 128 * 272 + wo);
                aA[nt] = MFMA16(a, ba, aA[nt]); aX[nt] = MFMA16(a, bx, aX[nt]); } }
#pragma unroll
        for (int nt = 0; nt < 4; ++nt) { const int ch = 64 * nh + 16 * nt + fr, C = g * 128 + ch;
            const float ba = P.lru_ba[C], bx = P.lru_bx[C], lam = P.lru_lam[C];
            const float sp8 = 8.f * log1pf(__expf(-lam));
            float Ac = 1.f, Hc = 0.f;
#pragma unroll
            for (int r = 0; r < 4; ++r) { const int tok = 16 * wq + 4 * fq + r;
                const float rg = pg8::sigmoid_f(aA[nt][r] + ba), ig = pg8::sigmoid_f(aX[nt][r] + bx);
                const float log_a = -rg * sp8, a = __builtin_amdgcn_exp2f(log_a * 1.4426950408889634f);
                const float y = 2.f * log_a;
                const float em = (y > -0.25f) ? -y * (1.f + y * (0.5f + y * (0.16666667f + y * (0.041666668f + y * (0.0083333338f + y * 0.0013888889f))))) : 1.f - a * a;
                const float u = __builtin_amdgcn_sqrtf(em) * (ig * bf_lo((unsigned)XC[tok * 136 + ch]));
                Hc = a * Hc + u; Ac *= a; Ar[nh][nt][r] = Ac; Hr[nh][nt][r] = Hc; }
            float AI = Ac, HI = Hc;
            { const float Ap = __shfl_up(AI, 16), Hp = __shfl_up(HI, 16); if (fq >= 1) { HI = AI * Hp + HI; AI = AI * Ap; } }
            { const float Ap = __shfl_up(AI, 32), Hp = __shfl_up(HI, 32); if (fq >= 2) { HI = AI * Hp + HI; AI = AI * Ap; } }
            { const float Ap = __shfl_up(AI, 16), Hp = __shfl_up(HI, 16); AE[nh][nt] = fq >= 1 ? Ap : 1.f; HE[nh][nt] = fq >= 1 ? Hp : 0.f; }
            if (fq == 3) { SEG[(wq * 128 + ch) * 2] = AI; SEG[(wq * 128 + ch) * 2 + 1] = HI; } }
    }
    __syncthreads();
#pragma unroll
    for (int nh = 0; nh < 2; ++nh)
#pragma unroll
        for (int nt = 0; nt < 4; ++nt) { const int ch = 64 * nh + 16 * nt + fr, C = g * 128 + ch;
            float Aw = 1.f, Hw = 0.f;
#pragma unroll
            for (int w2 = 0; w2 < 3; ++w2) if (w2 < wq) { const float As = SEG[(w2 * 128 + ch) * 2], Hs = SEG[(w2 * 128 + ch) * 2 + 1]; Hw = As * Hw + Hs; Aw *= As; }
            const float hin = AE[nh][nt] * Hw + HE[nh][nt], ain = AE[nh][nt] * Aw;
            unsigned* ha = (unsigned*)HL + (R0 + 16 * wq + 4 * fq) * AW + C;
#pragma unroll
            for (int r = 0; r < 4; ++r) ha[(size_t)r * AW] = cvtpk(Ar[nh][nt][r] * hin + Hr[nh][nt][r], Ar[nh][nt][r] * ain);
            if (wq == 3 && fq == 3) { float* sm = SUM + ((size_t)(b * 32 + c) * 1024 + C) * 2; sm[0] = Ar[nh][nt][3] * ain; sm[1] = Ar[nh][nt][3] * hin + Hr[nh][nt][3]; } }
}

constexpr int SC_STR = 129, P7_SAB = 2 * 128 * SC_STR * 4, P7_IL = P7_SAB + 128 * 33 * 4, P7_CT = P7_IL + 128 * 34 * 2;
static_assert(P7_CT + 64 <= MISC_OFF, "P7 LDS map");
__device__ __forceinline__ unsigned ord_key(float v) { const unsigned u = __builtin_bit_cast(unsigned, v); return (u & 0x80000000u) ? ~u : (u | 0x80000000u); }
#define CE_DESC(x, y) do { const unsigned _x = (x), _y = (y); (x) = _x > _y ? _x : _y; (y) = _x > _y ? _y : _x; } while (0)
template <int B, int NA> __device__ __forceinline__ void sort16_desc(unsigned (&a)[NA]) {
#pragma unroll
    for (int k = 2; k <= 16; k <<= 1)
#pragma unroll
        for (int j = k >> 1; j > 0; j >>= 1)
#pragma unroll
            for (int i = 0; i < 16; ++i) { const int l = i ^ j; if (l > i) { if ((i & k) == 0) CE_DESC(a[B + i], a[B + l]); else CE_DESC(a[B + l], a[B + i]); } }
}
template <int A, int Bo, int NA, int NB> __device__ __forceinline__ void merge16_desc(unsigned (&a)[NA], const unsigned (&b)[NB]) {
#pragma unroll
    for (int i = 0; i < 16; ++i) a[A + i] = a[A + i] > b[Bo + 15 - i] ? a[A + i] : b[Bo + 15 - i];
#pragma unroll
    for (int j = 8; j > 0; j >>= 1)
#pragma unroll
        for (int i = 0; i < 16; ++i) { const int l = i ^ j; if (l > i) CE_DESC(a[A + i], a[A + l]); }
}
__device__ __forceinline__ void peer_topk_unit(const Params& P, LAS unsigned char* lds, int t0, int h, int tid, int wave, int lane) {
    unsigned char* ws = P.ws;
    const bf16* QP = (const bf16*)(ws + WS_QP); const bf16* KEYS = (const bf16*)(ws + WS_KEYS);
    int* IDX = (int*)(ws + WS_IDX); float* GW = (float*)(ws + WS_G);
    LAS float* SC = (LAS float*)lds; LAS float* SAB = (LAS float*)(lds + P7_SAB); LAS unsigned short* IL = (LAS unsigned short*)(lds + P7_IL); LAS unsigned char* CT = lds + P7_CT;
    __syncthreads();
    if (tid < 64) { int ia = 0, rem = tid; while (ia < 16 && rem >= 16 / (ia + 1)) { rem -= 16 / (ia + 1); ++ia; }
        CT[tid] = (unsigned char)(ia < 16 ? ia * 16 + rem : 255); }
    { const int mtile = wave & 3, c = wave >> 2, r31 = lane & 31, hh = lane >> 5;
      bf16x8 A[8];
      const bf16* qp = QP + (size_t)(t0 + 32 * mtile + r31) * DM + h * 256 + c * 128 + 8 * hh;
#pragma unroll
      for (int ks = 0; ks < 8; ++ks) A[ks] = *(const bf16x8*)(qp + 16 * ks);
#pragma unroll
      for (int nt = 0; nt < 4; ++nt) { f32x16 acc;
#pragma unroll
          for (int r = 0; r < 16; ++r) acc[r] = 0.f;
          const bf16* kp = KEYS + ((size_t)((h * 2 + c) * 128 + 32 * nt + r31)) * 128 + 8 * hh;
#pragma unroll
          for (int ks = 0; ks < 8; ++ks) { const bf16x8 bk = *(const bf16x8*)(kp + 16 * ks); acc = MFMA32(A[ks], bk, acc); }
#pragma unroll
          for (int r = 0; r < 16; ++r) { const int tok = 32 * mtile + (r & 3) + 8 * (r >> 2) + 4 * hh; SC[(c * 128 + tok) * SC_STR + 32 * nt + r31] = acc[r]; } } }
    __syncthreads();
    const int half = tid & 1, c = (tid >> 1) & 1, tok = tid >> 2;
    unsigned a[64];
    { const LAS float* sp = SC + (c * 128 + tok) * SC_STR + half * 64; const int rot = 8 * (2 * c + half);
#pragma unroll
      for (int i = 0; i < 64; ++i) { const int n = (i + rot) & 63; a[i] = (ord_key(sp[n]) & ~127u) | (unsigned)(127 - (half * 64 + n)); } }
    sort16_desc<0>(a); sort16_desc<16>(a); sort16_desc<32>(a); sort16_desc<48>(a);
    merge16_desc<0, 16>(a, a); merge16_desc<32, 48>(a, a); merge16_desc<0, 32>(a, a);
    { unsigned o[16];
#pragma unroll
      for (int j = 0; j < 16; ++j) o[j] = (unsigned)__shfl_xor((int)a[j], 1);
      merge16_desc<0, 0>(a, o); }
    if (half == 0) {
#pragma unroll
        for (int j = 0; j < 16; ++j) { const int n = 127 - (int)(a[j] & 127u); SAB[tok * 33 + c * 16 + j] = SC[(c * 128 + tok) * SC_STR + n]; IL[tok * 34 + c * 16 + j] = (unsigned short)n; } }
    __syncthreads();
    const int q = tid & 3;
    unsigned cd[16];
#pragma unroll
    for (int j = 0; j < 13; ++j) { const unsigned code = CT[q + 4 * j]; const float s = SAB[tok * 33 + ((code >> 4) & 15u)] + SAB[tok * 33 + 16 + (code & 15u)];
        cd[j] = code == 255u ? 0u : ((ord_key(s) & ~255u) | (255u - code)); }
    cd[13] = 0u; cd[14] = 0u; cd[15] = 0u;
    sort16_desc<0>(cd);
    { unsigned o[16];
#pragma unroll
      for (int j = 0; j < 16; ++j) o[j] = (unsigned)__shfl_xor((int)cd[j], 1);
      merge16_desc<0, 0>(cd, o);
#pragma unroll
      for (int j = 0; j < 16; ++j) o[j] = (unsigned)__shfl_xor((int)cd[j], 2);
      merge16_desc<0, 0>(cd, o); }
    if (q == 0) {
        float cv[16]; int id[16];
#pragma unroll
        for (int s = 0; s < 16; ++s) { const unsigned code = 255u - (cd[s] & 255u); const int ia = (int)(code >> 4), ib = (int)(code & 15u); const int na = IL[tok * 34 + ia], nb = IL[tok * 34 + 16 + ib];
            cv[s] = SAB[tok * 33 + ia] + SAB[tok * 33 + 16 + ib]; id[s] = na * 128 + nb; }
        float mx = cv[0];
#pragma unroll
        for (int s = 1; s < 16; ++s) mx = fmaxf(mx, cv[s]);
        float sum = 0.f;
#pragma unroll
        for (int s = 0; s < 16; ++s) { cv[s] = __builtin_amdgcn_exp2f((cv[s] - mx) * LOG2E); sum += cv[s]; }
        const float inv = 1.f / sum;
        int* ip = IDX + (size_t)(t0 + tok) * 128 + h * 16; float* gp = GW + (size_t)(t0 + tok) * 128 + h * 16;
#pragma unroll
        for (int s4 = 0; s4 < 4; ++s4) { *(int4*)(ip + 4 * s4) = make_int4(id[4 * s4], id[4 * s4 + 1], id[4 * s4 + 2], id[4 * s4 + 3]);
            *(f32x4*)(gp + 4 * s4) = (f32x4){cv[4 * s4] * inv, cv[4 * s4 + 1] * inv, cv[4 * s4 + 2] * inv, cv[4 * s4 + 3] * inv}; }
    }
}

__device__ __forceinline__ void fp8x16_to_f32(const v4u& w, float (&f)[16]) {
#pragma unroll
    for (int i = 0; i < 4; ++i) { const f32x2_t lo = __builtin_amdgcn_cvt_pk_f32_fp8((int)w[i], false), hi = __builtin_amdgcn_cvt_pk_f32_fp8((int)w[i], true);
        f[4 * i] = lo[0]; f[4 * i + 1] = lo[1]; f[4 * i + 2] = hi[0]; f[4 * i + 3] = hi[1]; }
}
#define LD16I(dst, p) do { _Pragma("unroll") for (int q_ = 0; q_ < 4; ++q_) { const int4 v_ = ((const int4*)(p))[q_]; dst[4 * q_] = v_.x; dst[4 * q_ + 1] = v_.y; dst[4 * q_ + 2] = v_.z; dst[4 * q_ + 3] = v_.w; } } while (0)
#define LD16F(dst, p) do { _Pragma("unroll") for (int q_ = 0; q_ < 4; ++q_) { const f32x4 v_ = ((const f32x4*)(p))[q_]; dst[4 * q_] = v_[0]; dst[4 * q_ + 1] = v_[1]; dst[4 * q_ + 2] = v_[2]; dst[4 * q_ + 3] = v_[3]; } } while (0)
__device__ __forceinline__ void peer_u_phase(const Params& P, int xg, int slot, int nslots, int lane) {
    unsigned char* ws = P.ws;
    const bf16* X1B = (const bf16*)(ws + WS_X1B); const unsigned char* U8 = ws + WS_U8; const int* IDX = (const int*)(ws + WS_IDX); float* PD = (float*)(ws + WS_PD) + (size_t)xg * T_TOK * 128;
    const int ntok = slot < T_TOK ? (T_TOK - slot + nslots - 1) / nslots : 0, N = 2 * ntok;
    if (N == 0) return;
    const int R = lane >> 3, p = lane & 7;
    const bool b2 = (lane & 4) != 0, b1 = (lane & 2) != 0, b0 = (lane & 1) != 0;
    int I0[16], I1[16], I2[16]; v4u X0[2], X1[2], X2[2]; v4u B0[8], B1[8], B2[8];
#define U_ITEM(n, t, s) const int n_##t = (n) < N ? (n) : N - 1; const int t = slot + (n_##t >= ntok ? n_##t - ntok : n_##t) * nslots, s = 2 * xg + (n_##t >= ntok ? 1 : 0)
#define U_ROWS(buf, ids, off, s) do { const unsigned char* ub_ = U8 + (size_t)(s) * NEXP * 128; _Pragma("unroll") for (int i = 0; i < 8; ++i) buf[i] = *(const v4u*)(ub_ + (unsigned)(((unsigned)ids[(off) + i] << 7) + 16u * p)); } while (0)
#define U_HALF(buf, off) do { _Pragma("unroll") for (int i = 0; i < 8; ++i) { int d = 0; _Pragma("unroll") for (int w = 0; w < 4; ++w) d = __builtin_amdgcn_sdot4((int)buf[i][w], xq[w], d, false); part[(off) + i] = d; } } while (0)
#define U_X(dst, t, s) do { const bf16* xp_ = X1B + (size_t)(t) * DM + 128 * (s) + 16 * p; dst[0] = *(const v4u*)xp_; dst[1] = *(const v4u*)(xp_ + 8); } while (0)
    const int i0 = ((lane & 4) ? 8 : 0) + ((lane & 2) ? 4 : 0) + ((lane & 1) ? 2 : 0);
    { U_ITEM(0, t0, s0); U_ITEM(1, t1, s1); U_ITEM(2, t2, s2);
      int id0[16];
      LD16I(id0, IDX + (size_t)t0 * 128 + 16 * R); LD16I(I0, IDX + (size_t)t1 * 128 + 16 * R); LD16I(I1, IDX + (size_t)t2 * 128 + 16 * R);
      U_X(X0, t0, s0); U_X(X1, t1, s1);
      U_ROWS(B0, id0, 0, s0); U_ROWS(B1, id0, 8, s0); }
#define U_BODY(n, Ba, Bb, Bc, Ia, Ib, Ic, Xa, Xb, Xc) do { \
        U_ITEM(n, t, s); U_ITEM((n) + 1, t1, s1); U_ITEM((n) + 2, t2, s2); U_ITEM((n) + 3, t3, s3); (void)s; (void)s3; \
        f32x2_t* pp = (f32x2_t*)(PD + (size_t)t * 128 + 16 * R + i0); \
        f32x2_t pold = (f32x2_t){0.f, 0.f}; if ((n) >= ntok) pold = *pp; \
        U_ROWS(Bc, Ia, 0, s1); \
        LD16I(Ic, IDX + (size_t)t3 * 128 + 16 * R); \
        U_X(Xc, t2, s2); \
        float x[16]; float am = 0.f; \
        _Pragma("unroll") for (int k = 0; k < 4; ++k) { x[2 * k] = bf_lo(Xa[0][k]); x[2 * k + 1] = bf_hi(Xa[0][k]); x[8 + 2 * k] = bf_lo(Xa[1][k]); x[8 + 2 * k + 1] = bf_hi(Xa[1][k]); } \
        _Pragma("unroll") for (int k = 0; k < 16; ++k) am = fmaxf(am, fabsf(x[k])); \
        am = fmaxf(am, __shfl_xor(am, 1)); am = fmaxf(am, __shfl_xor(am, 2)); am = fmaxf(am, __shfl_xor(am, 4)); \
        const float xs = am > 0.f ? am * (1.f / 127.f) : 1.f, xinv = 1.f / xs; \
        int xq[4]; \
        _Pragma("unroll") for (int w = 0; w < 4; ++w) { const int q0 = (int)rintf(x[4 * w] * xinv), q1 = (int)rintf(x[4 * w + 1] * xinv), q2 = (int)rintf(x[4 * w + 2] * xinv), q3 = (int)rintf(x[4 * w + 3] * xinv); \
            xq[w] = (int)((unsigned)(q0 & 255) | ((unsigned)(q1 & 255) << 8) | ((unsigned)(q2 & 255) << 16) | ((unsigned)q3 << 24)); } \
        int part[16]; \
        U_HALF(Ba, 0); \
        U_ROWS(Ba, Ia, 8, s1); \
        U_HALF(Bb, 8); \
        if ((n) < N) { \
            int a8[8], a4[4], a2i[2]; \
            _Pragma("unroll") for (int k = 0; k < 8; ++k) { const int send = b2 ? part[k] : part[k + 8], keep = b2 ? part[k + 8] : part[k]; a8[k] = keep + __shfl_xor(send, 4); } \
            _Pragma("unroll") for (int k = 0; k < 4; ++k) { const int send = b1 ? a8[k] : a8[k + 4], keep = b1 ? a8[k + 4] : a8[k]; a4[k] = keep + __shfl_xor(send, 2); } \
            _Pragma("unroll") for (int k = 0; k < 2; ++k) { const int send = b0 ? a4[k] : a4[k + 2], keep = b0 ? a4[k + 2] : a4[k]; a2i[k] = keep + __shfl_xor(send, 1); } \
            *pp = (f32x2_t){(float)a2i[0] * xs, (float)a2i[1] * xs} + pold; } } while (0)
    for (int n = 0; n < N; n += 3) { U_BODY(n, B0, B1, B2, I0, I1, I2, X0, X1, X2); U_BODY(n + 1, B2, B0, B1, I1, I2, I0, X1, X2, X0); U_BODY(n + 2, B1, B2, B0, I2, I0, I1, X2, X0, X1); }
#undef U_X
#undef U_ITEM
#undef U_ROWS
#undef U_HALF
#undef U_BODY
}
__device__ __forceinline__ void peer_act_tokens(const Params& P, int t, int t2, int lane) {
    unsigned char* ws = P.ws;
    const float* PD = (const float*)(ws + WS_PD); const int* IDX = (const int*)(ws + WS_IDX); const float* GW = (const float*)(ws + WS_G); const float* SSP = (const float*)(ws + WS_SSP);
    const float* US = (const float*)(ws + WS_US); const float* VS = (const float*)(ws + WS_VS); float* ACT = (float*)(ws + WS_ACT);
    const bool two = t2 >= 0; const int tt[2] = {t, two ? t2 : t};
    float ss[2], d[2][2], gw[2][2], us[2][2], vs[2][2]; int id[2][2];
#pragma unroll
    for (int k = 0; k < 2; ++k) { ss[k] = lane < 32 ? SSP[(size_t)tt[k] * 32 + lane] : 0.f;
#pragma unroll
        for (int s = 0; s < 2; ++s) { const int slot = 64 * s + lane; id[k][s] = IDX[(size_t)tt[k] * 128 + slot]; gw[k][s] = GW[(size_t)tt[k] * 128 + slot]; float a = 0.f;
#pragma unroll
            for (int xg = 0; xg < 8; ++xg) a += PD[((size_t)xg * T_TOK + tt[k]) * 128 + slot];
            d[k][s] = a; } }
#pragma unroll
    for (int k = 0; k < 2; ++k)
#pragma unroll
        for (int s = 0; s < 2; ++s) { us[k][s] = US[id[k][s]]; vs[k][s] = VS[id[k][s]]; }
#pragma unroll
    for (int k = 0; k < 2; ++k) { const float rs = __builtin_amdgcn_rsqf(wave_sum(ss[k]) * (1.f / 2048.f) + RMS_EPS);
        if (k == 0 || two) {
#pragma unroll
            for (int s = 0; s < 2; ++s) ACT[(size_t)tt[k] * 128 + 64 * s + lane] = pg8::gelu_tanh_f(d[k][s] * us[k][s] * rs) * gw[k][s] * vs[k][s]; } }
}
#define PIN16(a) asm volatile("" : "+v"(a[0]), "+v"(a[1]), "+v"(a[2]), "+v"(a[3]), "+v"(a[4]), "+v"(a[5]), "+v"(a[6]), "+v"(a[7]), "+v"(a[8]), "+v"(a[9]), "+v"(a[10]), "+v"(a[11]), "+v"(a[12]), "+v"(a[13]), "+v"(a[14]), "+v"(a[15]))
__device__ __forceinline__ void peer_v_phase(const Params& P, int xg, int slot, int nslots, int lane) {
    unsigned char* ws = P.ws;
    const unsigned char* V8 = ws + WS_V8; const int* IDX = (const int*)(ws + WS_IDX); const float* ACT = (const float*)(ws + WS_ACT); bf16* OUTP = (bf16*)(ws + WS_OUTP);
    const int ntok = slot < T_TOK ? (T_TOK - slot + nslots - 1) / nslots : 0, N = 2 * ntok;
    if (N == 0) return;
    const int R = lane >> 3, p = lane & 7;
    const bool b5 = (lane & 32) != 0, b4 = (lane & 16) != 0, b3 = (lane & 8) != 0;
    int I0[16], I1[16], I2[16]; float A0[16], A1[16], A2[16]; v4u B0[8], B1[8], B2[8];
#define V_ITEM(n, t, s) const int n_##t = (n) < N ? (n) : N - 1; const int t = slot + (n_##t >= ntok ? n_##t - ntok : n_##t) * nslots, s = 2 * xg + (n_##t >= ntok ? 1 : 0)
#define V_ROWS(buf, ids, off, s) do { const unsigned char* vb_ = V8 + (size_t)(s) * NEXP * 128; _Pragma("unroll") for (int i = 0; i < 8; ++i) buf[i] = *(const v4u*)(vb_ + (unsigned)(((unsigned)ids[(off) + i] << 7) + 16u * p)); } while (0)
#define V_HALF(buf, av, off) do { _Pragma("unroll") for (int i = 0; i < 8; ++i) { asm volatile("" : "+v"(buf[i][0]), "+v"(buf[i][1]), "+v"(buf[i][2]), "+v"(buf[i][3])); \
            float f[16]; fp8x16_to_f32(buf[i], f); _Pragma("unroll") for (int k = 0; k < 16; ++k) acc[k] += av[(off) + i] * f[k]; PIN16(acc); } } while (0)
    { V_ITEM(0, t0, s0); V_ITEM(1, t1, s1); V_ITEM(2, t2, s2); (void)s1; (void)s2;
      int id0[16];
      LD16I(id0, IDX + (size_t)t0 * 128 + 16 * R); LD16I(I0, IDX + (size_t)t1 * 128 + 16 * R); LD16I(I1, IDX + (size_t)t2 * 128 + 16 * R);
      LD16F(A0, ACT + (size_t)t0 * 128 + 16 * R); LD16F(A1, ACT + (size_t)t1 * 128 + 16 * R);
      V_ROWS(B0, id0, 0, s0); V_ROWS(B1, id0, 8, s0); }
#define V_BODY(n, Ba, Bb, Bc, Ia, Ib, Ic, Aa, Ab, Ac) do { \
        V_ITEM(n, t, s); V_ITEM((n) + 1, t1, s1); V_ITEM((n) + 2, t2, s2); V_ITEM((n) + 3, t3, s3); (void)s2; (void)s3; \
        V_ROWS(Bc, Ia, 0, s1); \
        LD16I(Ic, IDX + (size_t)t3 * 128 + 16 * R); LD16F(Ac, ACT + (size_t)t2 * 128 + 16 * R); \
        float acc[16]; \
        _Pragma("unroll") for (int k = 0; k < 16; ++k) acc[k] = 0.f; \
        V_HALF(Ba, Aa, 0); \
        V_ROWS(Ba, Ia, 8, s1); \
        V_HALF(Bb, Aa, 8); \
        if ((n) < N) { \
            float a8[8], a4[4], a2[2]; \
            _Pragma("unroll") for (int k = 0; k < 8; ++k) { const float send = b5 ? acc[k] : acc[k + 8], keep = b5 ? acc[k + 8] : acc[k]; a8[k] = keep + __shfl_xor(send, 32); } \
            _Pragma("unroll") for (int k = 0; k < 4; ++k) { const float send = b4 ? a8[k] : a8[k + 4], keep = b4 ? a8[k + 4] : a8[k]; a4[k] = keep + __shfl_xor(send, 16); } \
            _Pragma("unroll") for (int k = 0; k < 2; ++k) { const float send = b3 ? a4[k] : a4[k + 2], keep = b3 ? a4[k + 2] : a4[k]; a2[k] = keep + __shfl_xor(send, 8); } \
            const int col = 128 * s + 16 * p + (b5 ? 8 : 0) + (b4 ? 4 : 0) + (b3 ? 2 : 0); \
            *(unsigned*)(OUTP + (size_t)t * DM + col) = cvtpk(a2[0], a2[1]); } } while (0)
    for (int n = 0; n < N; n += 3) { V_BODY(n, B0, B1, B2, I0, I1, I2, A0, A1, A2); V_BODY(n + 1, B2, B0, B1, I1, I2, I0, A1, A2, A0); V_BODY(n + 2, B1, B2, B0, I2, I0, I1, A2, A0, A1); }
#undef V_ITEM
#undef V_ROWS
#undef V_HALF
#undef V_BODY
}
__device__ __forceinline__ void peer_final_tokens(const Params& P, int t, int t2, int lane, float* outp) {
    const bool two = t2 >= 0; const int tt[2] = {t, two ? t2 : t};
    v4u a[2][4], b[2][4];
#pragma unroll
    for (int k = 0; k < 2; ++k) { const bf16* xrow = (const bf16*)(P.ws + WS_X1B) + (size_t)tt[k] * DM; const bf16* prow = (const bf16*)(P.ws + WS_OUTP) + (size_t)tt[k] * DM;
#pragma unroll
        for (int j = 0; j < 4; ++j) { a[k][j] = *(const v4u*)(xrow + 512 * j + 8 * lane); b[k][j] = *(const v4u*)(prow + 512 * j + 8 * lane); } }
#pragma unroll
    for (int k = 0; k < 2; ++k) { if (k == 1 && !two) break;
        float v[4][8]; float ss = 0.f;
#pragma unroll
        for (int j = 0; j < 4; ++j) {
#pragma unroll
            for (int i = 0; i < 4; ++i) { v[j][2 * i] = bf_lo(a[k][j][i]) + bf_lo(b[k][j][i]); v[j][2 * i + 1] = bf_hi(a[k][j][i]) + bf_hi(b[k][j][i]); }
#pragma unroll
            for (int i = 0; i < 8; ++i) ss += v[j][i] * v[j][i]; }
        const float rf = __builtin_amdgcn_rsqf(wave_sum(ss) * (1.f / 2048.f) + RMS_EPS);
        float* orow = outp + (size_t)tt[k] * DM;
#pragma unroll
        for (int j = 0; j < 4; ++j) { const f32x4 g0 = *(const f32x4*)(P.g_fin + 512 * j + 8 * lane), g1 = *(const f32x4*)(P.g_fin + 512 * j + 8 * lane + 4); f32x4 o0, o1;
#pragma unroll
            for (int i = 0; i < 4; ++i) { o0[i] = v[j][i] * rf * g0[i]; o1[i] = v[j][4 + i] * rf * g1[i]; }
            *(f32x4*)(orow + 512 * j + 8 * lane) = o0; *(f32x4*)(orow + 512 * j + 8 * lane + 4) = o1; } }
}

#ifndef MK_PER_PHASE
#define MK_PER_PHASE 0
#endif
constexpr int N_PHASES = 12;
__global__ void __launch_bounds__(NWAVES * 64, 2) fwd_kernel(Params P) {
    extern __shared__ __attribute__((aligned(16))) unsigned char lds_raw[];
    LAS unsigned char* lds = (LAS unsigned char*)lds_raw;
    volatile LAS unsigned* MISC = (volatile LAS unsigned*)(lds + MISC_OFF);
    const int tid = threadIdx.x, lane = tid & 63, wave = __builtin_amdgcn_readfirstlane(tid >> 6);
    const int G = gridDim.x; const int bx = blockIdx.x;
    const int vcu = (G % 8 == 0) ? (bx % 8) * (G / 8) + bx / 8 : bx;
    const int gw = vcu * NWAVES + wave, NGW = G * NWAVES;
    unsigned char* ws = P.ws;
    gu32* ctl = (gu32*)(ws + WS_CTL);
    for (int u = tid; u < 64; u += NWAVES * 64) MISC[u] = 0u;
    __syncthreads();
    XcdBarrier bar; bar.bar = (unsigned*)ctl + CW_BAR; bar.x = 0; bar.st = nullptr;
    if (!MK_PER_PHASE) bar = xcd_barrier_post((unsigned*)ctl + CW_BAR, MISC + 8);
    const unsigned my_xcc = xb_xcc_id();
    if (!MK_PER_PHASE) { if (tid == 0) MISC[16] = __hip_atomic_fetch_add((unsigned*)(ctl + CW_XC + 64 * (my_xcc & 7u)), 1u, __ATOMIC_RELAXED, __HIP_MEMORY_SCOPE_AGENT); }
    const int lo = P.ph_lo, hi = P.ph_hi;
#define FRESH_IDS const int lane = (int)__builtin_amdgcn_mbcnt_hi(~0u, __builtin_amdgcn_mbcnt_lo(~0u, 0u)); const int tid = wave * 64 + lane; (void)tid; (void)lane
#ifndef PH_MASK
#define PH_MASK 0xfff
#endif
#define IN(k) (((PH_MASK >> (k)) & 1) && lo <= (k) && (k) < hi)
#define BOTH(k) (IN(k) && IN((k) + 1))
#ifndef DUP_MASK
#define DUP_MASK 0
#endif
#define NREP(k) (((DUP_MASK >> (k)) & 1) ? 2 : 1)
#define GRID_BAR() do { if (!MK_PER_PHASE) xcd_barrier(bar); } while (0)
#ifdef TPROBE
#define TP_T0 (wave == 0 && __builtin_amdgcn_mbcnt_hi(~0u, __builtin_amdgcn_mbcnt_lo(~0u, 0u)) == 0u)
#define TP_ORD(k) ((k) < 7 ? (k) : (k) - 1)
    if (TP_T0) MISC[40] = (unsigned)__builtin_amdgcn_s_memrealtime();
#define TP_STAMP(w) do { MISC[(w)] = (unsigned)__builtin_amdgcn_s_memrealtime(); } while (0)
#define GRID_BAR_K(k) do { xcd_barrier(bar); MISC[41 + TP_ORD(k)] = (unsigned)__builtin_amdgcn_s_memrealtime(); } while (0)
#else
#define TP_STAMP(w) do { } while (0)
#define GRID_BAR_K(k) GRID_BAR()
#endif

    bf16* HN = (bf16*)(ws + WS_HN); bf16* WA = (bf16*)(ws + WS_WA); bf16* WV = (bf16*)(ws + WS_WV); bf16* WB = (bf16*)(ws + WS_WB); bf16* WO = (bf16*)(ws + WS_WO); bf16* WQ = (bf16*)(ws + WS_WQ);

    constexpr int NV_UNITS = (AW / 256) * (T_TOK / 256);
    const bool tab_fast = (G > NV_UNITS && (1024 % G) == 0);
    const int tab_r1 = tab_fast ? 0 : NEXP;
    if (IN(0)) { FRESH_IDS; for (int rep = 0; rep < NREP(0); ++rep) p0_prologue(P, lds, gw, NGW, wave, lane, tab_r1); TP_STAMP(53); if (BOTH(0)) GRID_BAR_K(0); }

    if (IN(1)) { FRESH_IDS;
      _Pragma("unroll") for (int rep = 0; rep < NREP(1); ++rep) {
        { pg8::Gemm g{HN, WA, T_TOK, NWA, DM / 2, WV, HN, ws, (unsigned)WS_END}; pg8::StaticOrder2 S; S.init(T_TOK, NWA, AW, T_TOK, G, bx);
          pg8::EpiProj E{(bf16*)(ws + WS_Q), (bf16*)(ws + WS_K), (bf16*)(ws + WS_XR), (bf16*)(ws + WS_GY), (bf16*)(ws + WS_SG), (bf16*)(ws + WS_VT), rep == 0 ? (float*)(ws + WS_CTL) + CW_KM : nullptr, QSCALE, 1.f / W8SCALE};
          pg8::gemm_phase<pg8::EpiProj, pg8::StaticOrder2, true, true, true>(lds, g, S, E); }
        TP_STAMP(54);
        if (tab_fast && bx >= NV_UNITS) peer_table_u<2>(P, 0, NEXP, (bx - NV_UNITS) * NWAVES + wave, (G - NV_UNITS) * NWAVES, lane);
      }
        TP_STAMP(55); if (BOTH(1)) GRID_BAR_K(1);
    }

    if (IN(2)) { FRESH_IDS;
        LAS int* tick = (LAS int*)(lds + MISC_OFF + 128);
#define NEXT_TICKET(dst, word) do { __syncthreads(); if (tid == 0) *tick = (int)__hip_atomic_fetch_add((unsigned*)(ctl + (word)), 1u, __ATOMIC_RELAXED, __HIP_MEMORY_SCOPE_AGENT); __syncthreads(); dst = *tick; } while (0)
#define TICKET_ISSUE(word) do { if (tid == 0) tk_next = (int)__hip_atomic_fetch_add((unsigned*)(ctl + (word)), 1u, __ATOMIC_RELAXED, __HIP_MEMORY_SCOPE_AGENT); } while (0)
#define TICKET_TAKE(dst) do { __syncthreads(); if (tid == 0) *tick = tk_next; __syncthreads(); dst = *tick; } while (0)
        int tk_next = 0;
#ifndef DUP_ATT
#define DUP_ATT 0
#endif
#ifndef DUP_LRU
#define DUP_LRU 0
#endif
#ifndef DUP_P2
#define DUP_P2 0
#endif
        _Pragma("unroll") for (int rp = 0; rp < 1 + DUP_P2; ++rp) {
        _Pragma("unroll") for (int rep = 0; rep < 1 + DUP_ATT; ++rep) {
            int tid2 = tid; asm volatile("" : "+v"(tid2));
            int it; NEXT_TICKET(it, CW_Q2 + 64 * (rep + 2 * rp));
            while (it < 256) { const int blk = 7 - (it >> 5), bh = it & 31; attn_unit(P, lds, bh >> 3, bh & 7, blk, tid2, wave, tid2 & 63); NEXT_TICKET(it, CW_Q2 + 64 * (rep + 2 * rp)); } }
        TP_STAMP(56);
        _Pragma("unroll") for (int rep = 0; rep < 1 + DUP_LRU; ++rep) {
            int tid2 = tid; asm volatile("" : "+v"(tid2));
            int it; NEXT_TICKET(it, CW_Q2 + 256 + 64 * (rep + 2 * rp));
            while (it < 512) { lru_pair(P, lds, it, tid2, wave, tid2 & 63, (unsigned*)(ctl + CW_Q2 + 256 + 64 * (rep + 2 * rp)), tk_next); TICKET_TAKE(it); } }
        if (DUP_P2 && rp == 0) GRID_BAR();
        }
#undef NEXT_TICKET
#undef TICKET_ISSUE
#undef TICKET_TAKE
        TP_STAMP(57); if (BOTH(2)) GRID_BAR_K(2);
    }

    if (IN(3)) { FRESH_IDS;
      _Pragma("unroll") for (int rep = 0; rep < NREP(3); ++rep) {
        const unsigned* HLAC = (const unsigned*)(ws + WS_HL); const float* SUM = (const float*)(ws + WS_SUM);
        const bf16* GY = (const bf16*)(ws + WS_GY); unsigned char* OCAT = ws + WS_OCAT;
        for (int u = vcu; u < 256; u += G) { const int b = u >> 6, c = (u >> 1) & 31, C = (u & 1) * 512 + 4 * (tid & 127), tq = tid >> 7;
            f32x4 carry = (f32x4){0.f, 0.f, 0.f, 0.f};
            for (int c0 = 0; c0 < c; c0 += 8) {
                f32x4 s0[8], s1[8];
#pragma unroll
                for (int j = 0; j < 8; ++j) { const int cc = c0 + j < c ? c0 + j : c - 1; const float* sm = SUM + ((size_t)(b * 32 + cc) * 1024 + C) * 2; s0[j] = *(const f32x4*)sm; s1[j] = *(const f32x4*)(sm + 4); }
#pragma unroll
                for (int j = 0; j < 8; ++j) if (c0 + j < c) { carry[0] = s0[j][0] * carry[0] + s0[j][1]; carry[1] = s0[j][2] * carry[1] + s0[j][3]; carry[2] = s1[j][0] * carry[2] + s1[j][1]; carry[3] = s1[j][2] * carry[3] + s1[j][3]; } }
            const size_t R0 = (size_t)b * SEQ + c * 64 + tq * 16;
#pragma unroll 8
            for (int t = 0; t < 16; ++t) { const size_t o = (R0 + t) * AW + C; const v4u ha = *(const v4u*)(HLAC + o);
                const f32x4 hv = (f32x4){bf_lo(ha.x) + bf_hi(ha.x) * carry[0], bf_lo(ha.y) + bf_hi(ha.y) * carry[1], bf_lo(ha.z) + bf_hi(ha.z) * carry[2], bf_lo(ha.w) + bf_hi(ha.w) * carry[3]};
                const unsigned long long gy = *(const unsigned long long*)(GY + o); const unsigned g0 = (unsigned)gy, g1 = (unsigned)(gy >> 32);
                int p = __builtin_amdgcn_cvt_pk_fp8_f32(clamp8(hv[0] * bf_lo(g0) * OC8SCALE), clamp8(hv[1] * bf_hi(g0) * OC8SCALE), 0, false); p = __builtin_amdgcn_cvt_pk_fp8_f32(clamp8(hv[2] * bf_lo(g1) * OC8SCALE), clamp8(hv[3] * bf_hi(g1) * OC8SCALE), p, true);
                *(unsigned*)(OCAT + (R0 + t) * DM + AW + C) = (unsigned)p; } }
      }
        TP_STAMP(58); if (BOTH(3)) GRID_BAR_K(3);
    }

    if (IN(4)) { FRESH_IDS;
      _Pragma("unroll") for (int rep = 0; rep < NREP(4); ++rep) {
        { pg8::Gemm g{(bf16*)(ws + WS_OCAT), WB, T_TOK, DM, DM / 2, nullptr, nullptr, ws, (unsigned)WS_END}; pg8::StaticOrder S; S.init(T_TOK, DM, G, bx);
          pg8::EpiMerge2 E{(const bf16*)(ws + WS_SG), (bf16*)(ws + WS_MG), MG8SCALE / (OC8SCALE * WB8SCALE)};
          pg8::gemm_phase<pg8::EpiMerge2, pg8::StaticOrder, true, true, true>(lds, g, S, E); }
      }
        if (BOTH(4)) GRID_BAR_K(4);
    }

    if (IN(5)) { FRESH_IDS;
      _Pragma("unroll") for (int rep = 0; rep < NREP(5); ++rep) {
        pg8::Gemm g{(bf16*)(ws + WS_MG), WO, T_TOK, DM, DM / 2, nullptr, nullptr, ws, (unsigned)WS_END}; pg8::StaticOrder S; S.init(T_TOK, DM, G, bx);
        pg8::EpiResid E{P.x, (bf16*)(ws + WS_X1B), (float*)(ws + WS_SSP), 1.f / (W8SCALE * MG8SCALE)};
        pg8::gemm_phase<pg8::EpiResid, pg8::StaticOrder, true, true, true>(lds, g, S, E);
      }
        if (BOTH(5)) GRID_BAR_K(5);
    }

    if (IN(6)) { FRESH_IDS;
      _Pragma("unroll") for (int rep = 0; rep < NREP(6); ++rep) {
        pg8::Gemm g{(bf16*)(ws + WS_X1B), WQ, T_TOK, DM, DM, nullptr, nullptr, ws, (unsigned)WS_END}; pg8::StaticOrder S; S.init(T_TOK, DM, G, bx);
        pg8::EpiRowScale E{(const float*)(ws + WS_SSP), (bf16*)(ws + WS_QP)};
        pg8::gemm_phase<pg8::EpiRowScale, pg8::StaticOrder, true, true>(lds, g, S, E);
        TP_STAMP(59);
        { pg8::Unit u; for (int i = 0; S.next(i, u); ++i) { peer_topk_unit(P, lds, u.pm * 256, u.pn, tid, wave, lane); peer_topk_unit(P, lds, u.pm * 256 + 128, u.pn, tid, wave, lane); } }
      }
        TP_STAMP(60); if (BOTH(6)) GRID_BAR_K(6);
    }

    int xg = bx & 7, nblk_g = (G - xg + 7) >> 3, rank_g = bx >> 3;
    if (!MK_PER_PHASE && lo == 0 && hi > 8) {
        unsigned cnt[8], sum = 0u; bool ok = my_xcc < 8u;
#pragma unroll
        for (int j = 0; j < 8; ++j) { cnt[j] = __hip_atomic_load((unsigned*)(ctl + CW_XC + 64 * j), __ATOMIC_RELAXED, __HIP_MEMORY_SCOPE_AGENT); sum += cnt[j]; ok = ok && cnt[j] > 0u; }
        if (ok && sum == (unsigned)G) { xg = (int)my_xcc; rank_g = (int)MISC[16];
            nblk_g = (int)(xg == 0 ? cnt[0] : xg == 1 ? cnt[1] : xg == 2 ? cnt[2] : xg == 3 ? cnt[3] : xg == 4 ? cnt[4] : xg == 5 ? cnt[5] : xg == 6 ? cnt[6] : cnt[7]); }
    }
    const int nslots = nblk_g * NWAVES, slot = rank_g * NWAVES + wave;
    if (IN(8)) { FRESH_IDS;
        _Pragma("unroll") for (int rep = 0; rep < NREP(8); ++rep) {
        if (tab_fast) { if (wave == NWAVES - 1) peer_table_v<4, true>(P, 0, NEXP, bx, G, lane); else peer_u_phase(P, xg, rank_g * (NWAVES - 1) + wave, nblk_g * (NWAVES - 1), lane); }
        else peer_u_phase(P, xg, slot, nslots, lane); }
        TP_STAMP(61); if (BOTH(8)) GRID_BAR_K(8);
    }
#ifdef EXTRA_BARS
    for (int eb = 0; eb < EXTRA_BARS; ++eb) GRID_BAR();
#endif
    if (IN(9)) { FRESH_IDS;
        for (int t = gw; t < T_TOK; t += 2 * NGW) peer_act_tokens(P, t, t + NGW < T_TOK ? t + NGW : -1, lane);
        if (BOTH(9)) GRID_BAR_K(9);
    }
    if (IN(10)) { FRESH_IDS;
        _Pragma("unroll") for (int rep = 0; rep < NREP(10); ++rep)
        peer_v_phase(P, xg, slot, nslots, lane);
        TP_STAMP(62); if (BOTH(10)) GRID_BAR_K(10);
    }
    if (IN(11)) { FRESH_IDS;
        if (NREP(11) == 2) for (int t = gw; t < T_TOK; t += 2 * NGW) peer_final_tokens(P, t, t + NGW < T_TOK ? t + NGW : -1, lane, (float*)(ws + WS_MG));
        for (int t = gw; t < T_TOK; t += 2 * NGW) peer_final_tokens(P, t, t + NGW < T_TOK ? t + NGW : -1, lane, P.out);
    }
#ifdef TPROBE
    { GRID_BAR_K(11);
      gu32* tpw = (gu32*)(P.ws + WS_CTL) + 16384;
      if (TP_T0) { const int j = (int)__hip_atomic_load((unsigned*)tpw + 64, __ATOMIC_RELAXED, __HIP_MEMORY_SCOPE_AGENT); const unsigned val = j < 11 ? MISC[41 + j] - MISC[40 + j] : (j >= 4096 ? MISC[(j >> 6) & 63] - MISC[j & 63] : 0u);
          __hip_atomic_fetch_add((unsigned*)tpw, val, __ATOMIC_RELAXED, __HIP_MEMORY_SCOPE_AGENT); }
      GRID_BAR();
      const unsigned tot = __hip_atomic_load((unsigned*)tpw, __ATOMIC_RELAXED, __HIP_MEMORY_SCOPE_AGENT), avg = (unsigned)__builtin_amdgcn_readfirstlane((int)(tot >> 8));
      const unsigned ts = (unsigned)__builtin_amdgcn_s_memrealtime();
      while ((unsigned)__builtin_amdgcn_s_memrealtime() - ts < avg) __builtin_amdgcn_s_sleep(1); }
#endif
#undef IN
#undef BOTH
#undef GRID_BAR
}

extern "C" void kernel_launch(void* const* d_in, const int* in_sizes, int n_in, void* d_out, int out_size, void* d_ws, size_t ws_size, hipStream_t stream) {
    static int grid = 0;
    if (grid == 0) {
        if (n_in != 19 || out_size != T_TOK * DM || ws_size < WS_END) { fprintf(stderr, "kernel_launch: unexpected problem (n_in %d, out %d, ws %zu); nothing launched\n", n_in, out_size, ws_size); grid = -1; return; }
        int dev = 0, cus = 0, per_cu = 0;
        if (hipGetDevice(&dev) != hipSuccess || hipDeviceGetAttribute(&cus, hipDeviceAttributeMultiprocessorCount, dev) != hipSuccess) { grid = -1; return; }
        if (hipFuncSetAttribute((const void*)fwd_kernel, hipFuncAttributeMaxDynamicSharedMemorySize, LDS_BYTES) != hipSuccess) { fprintf(stderr, "kernel_launch: hipFuncSetAttribute failed\n"); grid = -1; return; }
        if (hipOccupancyMaxActiveBlocksPerMultiprocessor(&per_cu, (const void*)fwd_kernel, NWAVES * 64, LDS_BYTES) != hipSuccess || per_cu < 1) { fprintf(stderr, "kernel_launch: occupancy query says %d blocks per CU\n", per_cu); }
        (void)hipGetLastError();
        grid = cus;
    }
    if (grid < 0) return;
    if (hipMemsetAsync((char*)d_ws + WS_CTL, 0, CTL_ZERO_BYTES, stream) != hipSuccess) return;
#ifdef TPROBE
    if (hipMemsetD32Async((hipDeviceptr_t)((char*)d_ws + WS_CTL + 4 * (16384 + 64)), TPROBE, 1, stream) != hipSuccess) return;
#endif
    Params p{};
    const float** pp = (const float**)&p;
    for (int i = 0; i < 19; ++i) pp[i] = (const float*)d_in[i];
    p.out = (float*)d_out; p.ws = (unsigned char*)d_ws;
#if MK_PER_PHASE
    for (int ph = 0; ph < N_PHASES; ++ph) { p.ph_lo = ph; p.ph_hi = ph + 1; hipLaunchKernelGGL(fwd_kernel, dim3(grid), dim3(NWAVES * 64), LDS_BYTES, stream, p); }
#else
    p.ph_lo = 0; p.ph_hi = N_PHASES;
    hipLaunchKernelGGL(fwd_kernel, dim3(grid), dim3(NWAVES * 64), LDS_BYTES, stream, p);
#endif
}
```

```cpp
#include <hip/hip_runtime.h>
#include <cstdio>
#include <cstdint>
namespace pg8 {
#define PG8_LAS __attribute__((address_space(3)))
typedef unsigned short bf16_t;
typedef short bf16x8 __attribute__((ext_vector_type(8)));
typedef float f32x4 __attribute__((ext_vector_type(4)));
typedef unsigned u32x4 __attribute__((ext_vector_type(4)));
typedef int i32x4 __attribute__((ext_vector_type(4)));
typedef int i32x8 __attribute__((ext_vector_type(8)));
__device__ __forceinline__ i32x8 cat8(bf16x8 a, bf16x8 b) { return __builtin_shufflevector(__builtin_bit_cast(i32x4, a), __builtin_bit_cast(i32x4, b), 0, 1, 2, 3, 4, 5, 6, 7); }
constexpr int BM = 256, BK = 64, HALF = 128, HTB = HALF * BK * 2  , STAGE_BYTES = 8 * HTB, NXCD = 8, WGM = 8;

__host__ __device__ __forceinline__ int lds_byte(int r, int c) { const int st = (r >> 4) * 2 + (c >> 5), rr = r & 15, cc = c & 31, ob = rr * 64 + cc * 2; return st * 1024 + (ob ^ (((ob >> 9) & 1) << 5)); }
__host__ __device__ __forceinline__ void stage_rc(int b, int& R, int& C) { const int st = b / 1024, sb = b % 1024, swz = sb ^ (((sb >> 9) & 1) << 5); R = (st >> 1) * 16 + swz / 64; C = (st & 1) * 32 + (swz % 64) / 2; }
__host__ __device__ __forceinline__ int perm32(int rho) { const int n = rho >> 4, i = rho & 15; return 8 * (i >> 2) + 4 * n + (i & 3); }

struct Unit { int pm, pn, sel; };
struct Gemm { const bf16_t* A; const bf16_t* Bt; int M, N, K; const bf16_t* A2; const bf16_t* Bt2; const void* rbase; unsigned rbytes; };

struct StaticOrder {
    int nM, nN, nwg, G, c;
    __host__ __device__ __forceinline__ void init(int M, int N, int G_, int c_) { nM = M / BM; nN = N / BM; nwg = nM * nN; G = G_; c = c_; }
    __host__ __device__ __forceinline__ bool next(int i, Unit& u) const {
        const long L = (long)i * G + c; if (L >= nwg) return false;
        int wgid = (int)L; { const int q = nwg / NXCD, r = nwg % NXCD, xcd = wgid % NXCD, off = wgid / NXCD; wgid = (xcd < r ? xcd * (q + 1) : r * (q + 1) + (xcd - r) * q) + off; }
        const int nig = WGM * nN, gid = wgid / nig, fm = gid * WGM, gsz = (nM - fm) < WGM ? (nM - fm) : WGM;
        u.pm = fm + ((wgid % nig) % gsz); u.pn = (wgid % nig) / gsz; u.sel = 0; return true;
    }
    __device__ __forceinline__ void a_ready(const Unit&) const {}
    __device__ __forceinline__ void done(const Unit&) const {}
};

struct StaticOrder2 {
    StaticOrder s0, s1; int G, c;
    __host__ __device__ __forceinline__ void init(int M0, int N0, int M1, int N1, int G_, int c_) { s0.init(M0, N0, 1, 0); s1.init(M1, N1, 1, 0); G = G_; c = c_; }
    __host__ __device__ __forceinline__ bool next(int i, Unit& u) const {
        const long L = (long)i * G + c;
        if (L < s0.nwg) return s0.next((int)L, u);
        if (L < s0.nwg + s1.nwg) { const bool ok = s1.next((int)(L - s0.nwg), u); u.sel = 1; return ok; }
        return false;
    }
    __device__ __forceinline__ void a_ready(const Unit&) const {}
    __device__ __forceinline__ void done(const Unit&) const {}
};

__device__ __forceinline__ unsigned cvt_pk_bf16(float lo, float hi) { unsigned r; asm volatile("v_cvt_pk_bf16_f32 %0, %1, %2" : "=v"(r) : "v"(lo), "v"(hi)); return r; }
typedef float f32x2 __attribute__((ext_vector_type(2)));
__device__ __forceinline__ float c8(float v) { return __builtin_fminf(__builtin_fmaxf(v, -448.f), 448.f); }
__device__ __forceinline__ float sigmoid_f(float v) { return __builtin_amdgcn_rcpf(1.f + __builtin_amdgcn_exp2f(-1.4426950408889634f * v)); }
__device__ __forceinline__ float gelu_tanh_f(float v) { const float z = 1.5957691216057308f * (v + 0.044715f * v * v * v); return v * __builtin_amdgcn_rcpf(1.f + __builtin_amdgcn_exp2f(-1.4426950408889634f * z)); }
__device__ __forceinline__ u32x4 pack8(const f32x4& v0, const f32x4& v1) { u32x4 w; w.x = cvt_pk_bf16(v0[0], v0[1]); w.y = cvt_pk_bf16(v0[2], v0[3]); w.z = cvt_pk_bf16(v1[0], v1[1]); w.w = cvt_pk_bf16(v1[2], v1[3]); return w; }
__device__ __forceinline__ f32x4 bf4_lo(unsigned a, unsigned b) { f32x4 r; r[0] = __builtin_bit_cast(float, a << 16); r[1] = __builtin_bit_cast(float, a & 0xffff0000u); r[2] = __builtin_bit_cast(float, b << 16); r[3] = __builtin_bit_cast(float, b & 0xffff0000u); return r; }

struct EpiProj {
    static constexpr bool PERM = true, AFTER_DRAIN = false, MIDK = false;
    bf16_t *Q, *K, *XR, *GY, *SG, *VT; float* KM; float qscale, oscale;
    __device__ __forceinline__ void operator()(const f32x4 (&acc)[2][2][4][2], const Unit& u, int wr, int wc, int fr, int fq) const {
        { const int l_ = (int)__builtin_amdgcn_mbcnt_hi(~0u, __builtin_amdgcn_mbcnt_lo(~0u, 0u)); fr = l_ & 15; fq = l_ >> 4; }
        const int pn = u.pn; int kind, ldc, colt; bf16_t* base;
        if (u.sel) { kind = 2; base = VT; ldc = 8192; colt = pn * 256; }
        else if (pn < 4) { kind = 0; base = Q; ldc = 1024; colt = pn * 256; }
        else if (pn < 8) { kind = 1; base = K; ldc = 1024; colt = (pn - 4) * 256; }
        else if (pn < 12) { kind = 2; base = XR; ldc = 1024; colt = (pn - 8) * 256; }
        else if (pn < 16) { kind = 3; base = GY; ldc = 1024; colt = (pn - 12) * 256; }
        else { kind = 4; base = SG; ldc = 4096; colt = (pn - 16) * 256; }
        const int row0 = u.pm * BM + wr * 64 + fr, col0 = colt + wc * 32 + 8 * fq;
#pragma unroll
        for (int ai = 0; ai < 2; ++ai)
#pragma unroll
            for (int m = 0; m < 4; ++m) { bf16_t* rowp = base + (size_t)(row0 + ai * HALF + m * 16) * ldc + col0;
#pragma unroll
                for (int bj = 0; bj < 2; ++bj) { f32x4 v0 = acc[ai][bj][m][0] * oscale, v1 = acc[ai][bj][m][1] * oscale;
                    if (kind == 0) { v0 = v0 * qscale; v1 = v1 * qscale; }
                    else if (kind == 3) {
#pragma unroll
                        for (int e = 0; e < 4; ++e) { v0[e] = gelu_tanh_f(v0[e]); v1[e] = gelu_tanh_f(v1[e]); } }
                    else if (kind == 4) {
                        unsigned w0 = 0u, w1 = 0u;
#pragma unroll
                        for (int e = 0; e < 4; ++e) { const unsigned q0 = (unsigned)fmaxf(sigmoid_f(v0[e]) * 255.f + 0.5f, 1.f), q1 = (unsigned)fmaxf(sigmoid_f(v1[e]) * 255.f + 0.5f, 1.f); w0 |= q0 << (8 * e); w1 |= q1 << (8 * e); }
                        *(unsigned long long*)((unsigned char*)SG + (size_t)(row0 + ai * HALF + m * 16) * 4096 + col0 + bj * HALF) = (unsigned long long)w0 | ((unsigned long long)w1 << 32);
                        continue; }
                    *(u32x4*)(rowp + bj * HALF) = pack8(v0, v1); } }
        if (kind == 1 && KM != nullptr) {
            const int b = u.pm >> 3, blk = u.pm & 7;
#pragma unroll
            for (int bj = 0; bj < 2; ++bj)
#pragma unroll
                for (int n = 0; n < 2; ++n) { f32x4 s = (f32x4){0.f, 0.f, 0.f, 0.f};
#pragma unroll
                    for (int ai = 0; ai < 2; ++ai)
#pragma unroll
                        for (int m = 0; m < 4; ++m) s = s + acc[ai][bj][m][n];
#pragma unroll
                    for (int e = 0; e < 4; ++e) { float v = s[e]; v += __shfl_xor(v, 1); v += __shfl_xor(v, 2); v += __shfl_xor(v, 4); v += __shfl_xor(v, 8); s[e] = v; }
                    if (fr == 0) { const int c = colt + bj * HALF + wc * 32 + 8 * fq + 4 * n;
                        float* dst = KM + ((size_t)((b * 8 + (c >> 7)) * 8 + blk)) * 128 + (c & 127);
#pragma unroll
                        for (int e = 0; e < 4; ++e) atomicAdd(dst + e, s[e] * oscale); } }
        }
    }
};
struct EpiStore {
    static constexpr bool PERM = true, AFTER_DRAIN = false, MIDK = false;
    bf16_t* O; int ldc;
    __device__ __forceinline__ void operator()(const f32x4 (&acc)[2][2][4][2], const Unit& u, int wr, int wc, int fr, int fq) const {
        { const int l_ = (int)__builtin_amdgcn_mbcnt_hi(~0u, __builtin_amdgcn_mbcnt_lo(~0u, 0u)); fr = l_ & 15; fq = l_ >> 4; }
        const int row0 = u.pm * BM + wr * 64 + fr, col0 = u.pn * BM + wc * 32 + 8 * fq;
#pragma unroll
        for (int ai = 0; ai < 2; ++ai)
#pragma unroll
            for (int m = 0; m < 4; ++m) { bf16_t* rowp = O + (size_t)(row0 + ai * HALF + m * 16) * ldc + col0;
#pragma unroll
                for (int bj = 0; bj < 2; ++bj) *(u32x4*)(rowp + bj * HALF) = pack8(acc[ai][bj][m][0], acc[ai][bj][m][1]); }
    }
};
struct EpiMerge2 {
    static constexpr bool PERM = true, AFTER_DRAIN = false, MIDK = true;
    const bf16_t* SG; bf16_t* MG; float mgscale;
    __device__ __forceinline__ void midk(f32x4 (&acc)[2][2][4][2], const Unit& u, int wr, int wc, int fr, int fq) const {
        int row0 = u.pm * BM + wr * 64 + fr, col0 = u.pn * BM + wc * 32 + 8 * fq;
        asm volatile("" : "+v"(row0), "+v"(col0));
#pragma unroll
        for (int ai = 0; ai < 2; ++ai)
#pragma unroll
            for (int m = 0; m < 4; ++m) { const size_t row = (size_t)(row0 + ai * HALF + m * 16);
#pragma unroll
                for (int bj = 0; bj < 2; ++bj) { const int col = col0 + bj * HALF;
                    const unsigned long long g0 = *(const unsigned long long*)((const unsigned char*)SG + row * 4096 + col), g1 = *(const unsigned long long*)((const unsigned char*)SG + row * 4096 + 2048 + col);
                    const unsigned g0l = (unsigned)g0, g0h = (unsigned)(g0 >> 32), g1l = (unsigned)g1, g1h = (unsigned)(g1 >> 32);
#pragma unroll
                    for (int e2 = 0; e2 < 4; ++e2) { acc[ai][bj][m][0][e2] *= (float)((g0l >> (8 * e2)) & 255u) * __builtin_amdgcn_rcpf((float)((g1l >> (8 * e2)) & 255u));
                        acc[ai][bj][m][1][e2] *= (float)((g0h >> (8 * e2)) & 255u) * __builtin_amdgcn_rcpf((float)((g1h >> (8 * e2)) & 255u)); } } }
    }
    __device__ __forceinline__ void operator()(const f32x4 (&acc)[2][2][4][2], const Unit& u, int wr, int wc, int fr, int fq) const {
        { const int l_ = (int)__builtin_amdgcn_mbcnt_hi(~0u, __builtin_amdgcn_mbcnt_lo(~0u, 0u)); fr = l_ & 15; fq = l_ >> 4; }
        const int row0 = u.pm * BM + wr * 64 + fr, col0 = u.pn * BM + wc * 32 + 8 * fq;
#pragma unroll
        for (int ai = 0; ai < 2; ++ai)
#pragma unroll
            for (int m = 0; m < 4; ++m) { const size_t row = (size_t)(row0 + ai * HALF + m * 16);
#pragma unroll
                for (int bj = 0; bj < 2; ++bj) { const int col = col0 + bj * HALF;
                    const unsigned long long g1 = *(const unsigned long long*)((const unsigned char*)SG + row * 4096 + 2048 + col); const unsigned g1l = (unsigned)g1, g1h = (unsigned)(g1 >> 32);
                    const float ms = mgscale * (1.f / 255.f);
                    const f32x4 s0 = (f32x4){(float)(g1l & 255u), (float)((g1l >> 8) & 255u), (float)((g1l >> 16) & 255u), (float)(g1l >> 24)}, s1 = (f32x4){(float)(g1h & 255u), (float)((g1h >> 8) & 255u), (float)((g1h >> 16) & 255u), (float)(g1h >> 24)};
                    const f32x4 v0 = acc[ai][bj][m][0] * s0 * ms, v1 = acc[ai][bj][m][1] * s1 * ms;
                    int p0 = __builtin_amdgcn_cvt_pk_fp8_f32(c8(v0[0]), c8(v0[1]), 0, false); p0 = __builtin_amdgcn_cvt_pk_fp8_f32(c8(v0[2]), c8(v0[3]), p0, true);
                    int p1 = __builtin_amdgcn_cvt_pk_fp8_f32(c8(v1[0]), c8(v1[1]), 0, false); p1 = __builtin_amdgcn_cvt_pk_fp8_f32(c8(v1[2]), c8(v1[3]), p1, true);
                    *(unsigned long long*)((unsigned char*)MG + row * 2048 + col) = (unsigned long long)(unsigned)p0 | ((unsigned long long)(unsigned)p1 << 32); } }
    }
};
struct EpiResid {
    static constexpr bool PERM = true, AFTER_DRAIN = false, MIDK = false;
    const float* X; bf16_t* X1B; float* SSP; float oscale;
    __device__ __forceinline__ void operator()(const f32x4 (&acc)[2][2][4][2], const Unit& u, int wr, int wc, int fr, int fq) const {
        { const int l_ = (int)__builtin_amdgcn_mbcnt_hi(~0u, __builtin_amdgcn_mbcnt_lo(~0u, 0u)); fr = l_ & 15; fq = l_ >> 4; }
        const int row0 = u.pm * BM + wr * 64 + fr, col0 = u.pn * BM + wc * 32 + 8 * fq;
#pragma unroll
        for (int ai = 0; ai < 2; ++ai)
#pragma unroll
            for (int m = 0; m < 4; ++m) { const size_t row = (size_t)(row0 + ai * HALF + m * 16); float ss = 0.f;
#pragma unroll
                for (int bj = 0; bj < 2; ++bj) { const int col = col0 + bj * HALF; const float* xp = X + row * 2048 + col;
                    f32x4 v0 = acc[ai][bj][m][0] * oscale + *(const f32x4*)xp, v1 = acc[ai][bj][m][1] * oscale + *(const f32x4*)(xp + 4);
                    *(u32x4*)(X1B + row * 2048 + col) = pack8(v0, v1);
                    ss += (v0[0] * v0[0] + v0[1] * v0[1]) + (v0[2] * v0[2] + v0[3] * v0[3]) + (v1[0] * v1[0] + v1[1] * v1[1]) + (v1[2] * v1[2] + v1[3] * v1[3]); }
                ss += __shfl_xor(ss, 16); ss += __shfl_xor(ss, 32);
                if (fq == 0) SSP[row * 32 + u.pn * 4 + wc] = ss; }
    }
};
struct EpiRowScale {
    static constexpr bool PERM = true, AFTER_DRAIN = false, MIDK = false;
    const float* SSP; bf16_t* O;
    __device__ __forceinline__ void operator()(const f32x4 (&acc)[2][2][4][2], const Unit& u, int wr, int wc, int fr, int fq) const {
        { const int l_ = (int)__builtin_amdgcn_mbcnt_hi(~0u, __builtin_amdgcn_mbcnt_lo(~0u, 0u)); fr = l_ & 15; fq = l_ >> 4; }
        const int row0 = u.pm * BM + wr * 64 + fr, col0 = u.pn * BM + wc * 32 + 8 * fq;
#pragma unroll
        for (int ai = 0; ai < 2; ++ai)
#pragma unroll
            for (int m = 0; m < 4; ++m) { const size_t row = (size_t)(row0 + ai * HALF + m * 16);
                const f32x4 a = *(const f32x4*)(SSP + row * 32 + 8 * fq), b = *(const f32x4*)(SSP + row * 32 + 8 * fq + 4);
                float ss = (a[0] + a[1]) + (a[2] + a[3]) + (b[0] + b[1]) + (b[2] + b[3]);
                ss += __shfl_xor(ss, 16); ss += __shfl_xor(ss, 32);
                const float rs = __builtin_amdgcn_rsqf(ss * (1.f / 2048.f) + 1e-6f);
#pragma unroll
                for (int bj = 0; bj < 2; ++bj) *(u32x4*)(O + row * 2048 + col0 + bj * HALF) = pack8(acc[ai][bj][m][0] * rs, acc[ai][bj][m][1] * rs); }
    }
};
template <class Epi, class Sched, bool ALIGN_EPI = false, bool SP2 = false, bool FP8 = false>
__device__ __forceinline__ void gemm_phase(PG8_LAS unsigned char* lds, const Gemm g, const Sched& S, const Epi& E) {
    const int tid = threadIdx.x, wid = __builtin_amdgcn_readfirstlane(tid >> 6), lane = tid & 63, wr = wid >> 2, wc = wid & 3, fr = lane & 15, fq = lane >> 4;
    const int K = g.K, nt = K / BK;
    const __amdgpu_buffer_rsrc_t rsrc = __builtin_amdgcn_make_buffer_rsrc((void*)g.rbase, 0, (int)g.rbytes, 0x00020000);
    unsigned voffA[2], voffB[2];
#pragma unroll
    for (int i = 0; i < 2; ++i) { int R, C; stage_rc(tid * 16 + i * 8192, R, C); const int Rb = Epi::PERM ? ((R & ~31) + perm32(R & 31)) : R;
        voffA[i] = (unsigned)(R * K + C) * 2u; voffB[i] = (unsigned)(Rb * K + C) * 2u; }
    const size_t kstep = (size_t)(BK * 2);
    const size_t hstep = (size_t)HALF * K * 2;
    const size_t tstep = 2 * hstep;
    const unsigned ldsw = (unsigned)wid * 1024u;
    const int aoff = lds_byte(wr * 64 + fr, fq * 8), boff = lds_byte(wc * 32 + fr, fq * 8);
#define PG8_SA(b, h) (((b) * 2 + (h)) * HTB)
#define PG8_SB(b, h) ((4 + (b) * 2 + (h)) * HTB)
#define PG8_STAGE(bufoff, gbase, voff) do { const unsigned so_ = (unsigned)((const char*)(gbase) - (const char*)g.rbase); _Pragma("unroll") for (int _i = 0; _i < 2; ++_i) \
        __builtin_amdgcn_raw_ptr_buffer_load_lds(rsrc, (PG8_LAS unsigned*)(lds + (bufoff) + ldsw + _i * 8192), 16, (voff)[_i], so_, 0, 0); } while (0)
#define PG8_LDA(dst, b, h) do { _Pragma("unroll") for (int m = 0; m < 4; ++m) { const PG8_LAS unsigned char* p_ = lds + PG8_SA(b, h) + aoff + m * 2048; \
        if constexpr (FP8) dst##8[m] = cat8(*(const PG8_LAS bf16x8*)p_, *(const PG8_LAS bf16x8*)(p_ + 1024)); else { dst[m][0] = *(const PG8_LAS bf16x8*)p_; dst[m][1] = *(const PG8_LAS bf16x8*)(p_ + 1024); } } } while (0)
#define PG8_LDB(dst, b, h) do { _Pragma("unroll") for (int n = 0; n < 2; ++n) { const PG8_LAS unsigned char* p_ = lds + PG8_SB(b, h) + boff + n * 2048; \
        if constexpr (FP8) dst##8[n] = cat8(*(const PG8_LAS bf16x8*)p_, *(const PG8_LAS bf16x8*)(p_ + 1024)); else { dst[n][0] = *(const PG8_LAS bf16x8*)p_; dst[n][1] = *(const PG8_LAS bf16x8*)(p_ + 1024); } } } while (0)
#define PG8_MMA(ai, bj, At, Bt) do { __builtin_amdgcn_s_setprio(1); _Pragma("unroll") for (int m = 0; m < 4; ++m) _Pragma("unroll") for (int n = 0; n < 2; ++n) { \
        if constexpr (FP8) acc[ai][bj][m][n] = __builtin_amdgcn_mfma_scale_f32_16x16x128_f8f6f4(Bt##8[n], At##8[m], acc[ai][bj][m][n], 0, 0, 0, 0x7f7f7f7f, 0, 0x7f7f7f7f); \
        else { _Pragma("unroll") for (int k = 0; k < 2; ++k) acc[ai][bj][m][n] = __builtin_amdgcn_mfma_f32_16x16x32_bf16(Bt[n][k], At[m][k], acc[ai][bj][m][n], 0, 0, 0); } } __builtin_amdgcn_s_setprio(0); } while (0)
#define PG8_WAIT_V(n) asm volatile("s_waitcnt vmcnt(" #n ")" ::: "memory")
#define PG8_WAIT_L(n) asm volatile("s_waitcnt lgkmcnt(" #n ")" ::: "memory")
#define PG8_BAR __builtin_amdgcn_s_barrier()
#define PG8_SCHED __builtin_amdgcn_sched_barrier(0)
    Unit cur, nxt; int ui = 0;
    if (!S.next(0, cur)) return;
    f32x4 acc[2][2][4][2];
#pragma unroll
    for (int a = 0; a < 2; ++a)
#pragma unroll
        for (int b = 0; b < 2; ++b)
#pragma unroll
            for (int m = 0; m < 4; ++m)
#pragma unroll
                for (int n = 0; n < 2; ++n) acc[a][b][m][n] = (f32x4){0.f, 0.f, 0.f, 0.f};
    bf16x8 At[4][2], B0[2][2], B1[2][2];
    i32x8 At8[4], B08[2], B18[2];
    const char* cA = (const char*)(cur.sel ? g.A2 : g.A) + (size_t)cur.pm * tstep; const char* cB = (const char*)(cur.sel ? g.Bt2 : g.Bt) + (size_t)cur.pn * tstep;
    S.a_ready(cur);
    if constexpr (SP2) {
        PG8_STAGE(PG8_SB(0, 0), cB, voffB); PG8_STAGE(PG8_SB(0, 1), cB + hstep, voffB); PG8_STAGE(PG8_SA(0, 0), cA, voffA); PG8_STAGE(PG8_SA(0, 1), cA + hstep, voffA);
        if (wr == 1) PG8_BAR;
        PG8_WAIT_V(2); PG8_BAR;
        PG8_STAGE(PG8_SB(1, 0), cB + kstep, voffB); PG8_STAGE(PG8_SA(1, 0), cA + kstep, voffA); PG8_STAGE(PG8_SB(1, 1), cB + hstep + kstep, voffB);
        PG8_WAIT_V(6); PG8_BAR;
    } else {
        PG8_STAGE(PG8_SB(0, 0), cB, voffB); PG8_STAGE(PG8_SA(0, 0), cA, voffA); PG8_STAGE(PG8_SB(0, 1), cB + hstep, voffB); PG8_STAGE(PG8_SA(0, 1), cA + hstep, voffA);
        if (wr == 1) PG8_BAR;
        PG8_WAIT_V(4); PG8_BAR;
        PG8_STAGE(PG8_SB(1, 0), cB + kstep, voffB); PG8_STAGE(PG8_SA(1, 0), cA + kstep, voffA); PG8_STAGE(PG8_SB(1, 1), cB + hstep + kstep, voffB);
        PG8_WAIT_V(6); PG8_BAR;
    }
    for (;;) {
        const bool has_next = S.next(ui + 1, nxt);
        const char* nA = has_next ? (const char*)(nxt.sel ? g.A2 : g.A) + (size_t)nxt.pm * tstep : cA; const char* nB = has_next ? (const char*)(nxt.sel ? g.Bt2 : g.Bt) + (size_t)nxt.pn * tstep : cB;
        for (int t = 0; t < nt; t += 2) {
            if constexpr (Epi::MIDK) { if (t == nt / 2) E.midk(acc, cur, wr, wc, fr, fq); }
            const bool last = (t == nt - 2);
            const char* a1 = cA + (size_t)(t + 1) * kstep;
            const char* a2 = last ? nA : cA + (size_t)(t + 2) * kstep; const char* b2 = last ? nB : cB + (size_t)(t + 2) * kstep;
            const char* a3 = a2 + kstep; const char* b3 = b2 + kstep;
            if (last && has_next) S.a_ready(nxt);
            if constexpr (SP2) {
            PG8_LDB(B0, 0, 0); PG8_LDB(B1, 0, 1); PG8_SCHED; PG8_LDA(At, 0, 0); PG8_STAGE(PG8_SA(1, 1), a1 + hstep, voffA);
            PG8_WAIT_V(8); PG8_WAIT_L(0); PG8_BAR; PG8_MMA(0, 0, At, B0); PG8_MMA(0, 1, At, B1); PG8_BAR; PG8_SCHED;
            PG8_LDA(At, 0, 1); PG8_STAGE(PG8_SB(0, 0), b2, voffB); PG8_STAGE(PG8_SB(0, 1), b2 + hstep, voffB); PG8_STAGE(PG8_SA(0, 0), a2, voffA);
            PG8_WAIT_V(8); PG8_WAIT_L(0); PG8_BAR; PG8_MMA(1, 0, At, B0); PG8_MMA(1, 1, At, B1); PG8_BAR; PG8_SCHED;
            PG8_LDB(B0, 1, 0); PG8_LDB(B1, 1, 1); PG8_SCHED; PG8_LDA(At, 1, 0); PG8_STAGE(PG8_SA(0, 1), a2 + hstep, voffA);
            PG8_WAIT_V(8); PG8_WAIT_L(0); PG8_BAR; PG8_MMA(0, 0, At, B0); PG8_MMA(0, 1, At, B1); PG8_BAR; PG8_SCHED;
            PG8_LDA(At, 1, 1); PG8_STAGE(PG8_SB(1, 0), b3, voffB); PG8_STAGE(PG8_SB(1, 1), b3 + hstep, voffB); PG8_STAGE(PG8_SA(1, 0), a3, voffA);
            PG8_WAIT_V(8); PG8_WAIT_L(0); PG8_BAR; PG8_MMA(1, 0, At, B0); PG8_MMA(1, 1, At, B1); PG8_BAR; PG8_SCHED;
            } else {
            PG8_LDB(B0, 0, 0); PG8_SCHED; PG8_LDA(At, 0, 0); PG8_STAGE(PG8_SA(1, 1), a1 + hstep, voffA);
            PG8_WAIT_L(8); PG8_BAR; PG8_WAIT_L(0); PG8_MMA(0, 0, At, B0); PG8_BAR; PG8_SCHED;
            PG8_LDB(B1, 0, 1); PG8_STAGE(PG8_SB(0, 0), b2, voffB);
            PG8_BAR; PG8_WAIT_L(0); PG8_MMA(0, 1, At, B1); PG8_BAR;
            PG8_LDA(At, 0, 1); PG8_STAGE(PG8_SA(0, 0), a2, voffA);
            PG8_BAR; PG8_WAIT_L(0); PG8_MMA(1, 0, At, B0); PG8_BAR; PG8_SCHED;
            PG8_STAGE(PG8_SB(0, 1), b2 + hstep, voffB);
            PG8_WAIT_V(6); PG8_BAR; PG8_MMA(1, 1, At, B1); PG8_BAR;
            PG8_LDB(B0, 1, 0); PG8_SCHED; PG8_LDA(At, 1, 0); PG8_STAGE(PG8_SA(0, 1), a2 + hstep, voffA);
            PG8_WAIT_L(8); PG8_BAR; PG8_WAIT_L(0); PG8_MMA(0, 0, At, B0); PG8_BAR; PG8_SCHED;
            PG8_LDB(B1, 1, 1); PG8_STAGE(PG8_SB(1, 0), b3, voffB);
            PG8_BAR; PG8_WAIT_L(0); PG8_MMA(0, 1, At, B1); PG8_BAR;
            PG8_LDA(At, 1, 1); PG8_STAGE(PG8_SA(1, 0), a3, voffA);
            PG8_BAR; PG8_WAIT_L(0); PG8_MMA(1, 0, At, B0); PG8_BAR; PG8_SCHED;
            PG8_STAGE(PG8_SB(1, 1), b3 + hstep, voffB);
            PG8_WAIT_V(6); PG8_BAR; PG8_MMA(1, 1, At, B1); PG8_BAR;
            }
        }
        if constexpr (ALIGN_EPI) { if (wr == 0) PG8_BAR; }
        if constexpr (!Epi::AFTER_DRAIN) { E(acc, cur, wr, wc, fr, fq); S.done(cur); }
        if (!has_next) break;
#pragma unroll
        for (int a = 0; a < 2; ++a)
#pragma unroll
            for (int b = 0; b < 2; ++b)
#pragma unroll
                for (int m = 0; m < 4; ++m)
#pragma unroll
                    for (int n = 0; n < 2; ++n) acc[a][b][m][n] = (f32x4){0.f, 0.f, 0.f, 0.f};
        cur = nxt; cA = nA; cB = nB; ++ui;
        if constexpr (ALIGN_EPI) { if (wr == 1) PG8_BAR; }
    }
    PG8_WAIT_V(0);
    if constexpr (!ALIGN_EPI) { if (wr == 0) PG8_BAR; }
    PG8_BAR;
    if constexpr (Epi::AFTER_DRAIN) { E.fused(acc, cur, wr, wc, fr, fq, lds, wid, lane); S.done(cur); }
#undef PG8_SA
#undef PG8_SB
#undef PG8_STAGE
#undef PG8_LDA
#undef PG8_LDB
#undef PG8_MMA
#undef PG8_WAIT_V
#undef PG8_WAIT_L
#undef PG8_BAR
#undef PG8_SCHED
}
}
#define GAS __attribute__((address_space(1)))
#define LAS __attribute__((address_space(3)))
typedef unsigned short bf16;
typedef unsigned v4u __attribute__((ext_vector_type(4)));
typedef float f32x4 __attribute__((ext_vector_type(4)));
typedef short bf16x8 __attribute__((ext_vector_type(8)));
typedef GAS unsigned gu32;
typedef GAS unsigned long long gu64;
#define RLX_AGENT __ATOMIC_RELAXED, __HIP_MEMORY_SCOPE_AGENT
#define LDS_WAIT() asm volatile("s_waitcnt lgkmcnt(0)" ::: "memory")
#define VM_WAIT() asm volatile("s_waitcnt vmcnt(0)" ::: "memory")
__device__ __forceinline__ unsigned long long rt() { return __builtin_amdgcn_s_memrealtime(); }
__device__ __forceinline__ unsigned f2bf(float f) { unsigned u = __builtin_bit_cast(unsigned, f); return (u + 0x7fffu + ((u >> 16) & 1u)) >> 16; }
__device__ __forceinline__ unsigned pk2(float lo, float hi) { return f2bf(lo) | (f2bf(hi) << 16); }

#define XB_TMO      128
#define XB_XCNT(j)  (256  + 64 * (j))
#define XB_XSUB(j)  (1280 + 64 * (j))
#define XB_XGEN(j)  (2304 + 64 * (j))
#define XB_TOP      3328
#define XB_TOPGEN   3392
#define XCD_BAR_WORDS 3456
#define XB_SPIN_CAP (1u << 18)

__device__ __forceinline__ unsigned xb_ld(unsigned* p)              { return __hip_atomic_load(p, __ATOMIC_RELAXED, __HIP_MEMORY_SCOPE_AGENT); }
__device__ __forceinline__ unsigned xb_add(unsigned* p, unsigned v) { return __hip_atomic_fetch_add(p, v, __ATOMIC_RELAXED, __HIP_MEMORY_SCOPE_AGENT); }
__device__ __forceinline__ unsigned xb_xcc_id() { return (unsigned)__builtin_amdgcn_s_getreg((3 << 11) | 20) & 0xFu; }
#define XB_SPIN(cond, bar) do { unsigned _sp = 0; while (cond) { __builtin_amdgcn_s_sleep(1); \
    if ((++_sp & 255u) == 0u) { if (xb_ld(&(bar)[XB_TMO])) break; if (_sp > XB_SPIN_CAP) { atomicAdd(&(bar)[XB_TMO], 1u); break; } } } } while (0)

struct XcdBarrier {
    unsigned* bar; unsigned x;
    volatile LAS unsigned* st;
};

__device__ __forceinline__ XcdBarrier xcd_barrier_post(unsigned* bar, volatile LAS unsigned* st) {
    XcdBarrier b; b.bar = bar; b.x = xb_xcc_id(); b.st = st;
    if (threadIdx.x == 0) (void)xb_add(&bar[XB_XCNT(b.x)], 1u);
    return b;
}
__device__ __forceinline__ void xcd_barrier_complete(unsigned* bar, unsigned x, unsigned& nloc, unsigned& nx) {
    const unsigned G = gridDim.x * gridDim.y * gridDim.z;
    unsigned sum, cnt, mine, sp = 0u;
    for (;;) {
        sum = 0u; cnt = 0u; mine = 0u;
#pragma unroll
        for (unsigned j = 0; j < 16; ++j) { const unsigned c = xb_ld(&bar[XB_XCNT(j)]); sum += c; cnt += (c > 0u) ? 1u : 0u; mine = (j == x) ? c : mine; }
        if (sum == G) break;
        __builtin_amdgcn_s_sleep(1);
        if ((++sp & 255u) == 0u) { if (xb_ld(&bar[XB_TMO])) break; if (sp > XB_SPIN_CAP) { atomicAdd(&bar[XB_TMO], 1u); break; } }
    }
    nloc = mine > 0u ? mine : 1u; nx = cnt > 0u ? cnt : 1u;
}

__device__ __forceinline__ void xcd_barrier(const XcdBarrier& b) {
    asm volatile("s_waitcnt vmcnt(0)" ::: "memory");
    __syncthreads();
    if (threadIdx.x == 0) {
        unsigned* bar = b.bar;
        __builtin_amdgcn_s_waitcnt(0);
        unsigned nloc = b.st[0], nx = b.st[1];
        if (nloc == 0u) { xcd_barrier_complete(bar, b.x, nloc, nx); b.st[0] = nloc; b.st[1] = nx; }
        const unsigned old = xb_add(&bar[XB_XSUB(b.x)], 1u);
        const unsigned gen = old / nloc;
        if (old + 1u == (gen + 1u) * nloc) {
            __builtin_amdgcn_fence(__ATOMIC_RELEASE, "agent");
            asm volatile("s_waitcnt vmcnt(0)" ::: "memory");
            const unsigned og = xb_add(&bar[XB_TOP], 1u);
            const unsigned tg = og / nx;
            if (og + 1u == (tg + 1u) * nx) xb_add(&bar[XB_TOPGEN], 1u);
            else XB_SPIN(xb_ld(&bar[XB_TOPGEN]) == tg, bar);
            __builtin_amdgcn_fence(__ATOMIC_ACQUIRE, "agent");
            xb_add(&bar[XB_XGEN(b.x)], 1u);
            asm volatile("s_waitcnt vmcnt(0)" ::: "memory");
        } else {
            XB_SPIN(xb_ld(&bar[XB_XGEN(b.x)]) == gen, bar);
            __builtin_amdgcn_fence(__ATOMIC_ACQUIRE, "agent");
            asm volatile("s_waitcnt vmcnt(0)" ::: "memory");
        }
    }
    __syncthreads();
}

constexpr int NWAVES = 8;
constexpr int T_TOK = 8192, DM = 2048, AW = 1024, SEQ = 2048, NHEAD = 8;
constexpr int NWA = 8192;
constexpr int NEXP = 16384;
constexpr float RMS_EPS = 1e-6f, LOG2E = 1.4426950408889634f;
constexpr float W8SCALE = 64.f;
constexpr float OC8SCALE = 8.f, WB8SCALE = 32.f;
constexpr float MG8SCALE = 16.f;
constexpr float QSCALE = 0.08838834764831845f * 1.4426950408889634f;

constexpr size_t MiB = 1u << 20;
constexpr size_t WS_CTL = 0, CTL_ZERO_BYTES = 1 * MiB;
constexpr size_t WS_WA = 2 * MiB;
constexpr size_t WS_WV = 34 * MiB;
constexpr size_t WS_WB = 38 * MiB;
constexpr size_t WS_WO = 46 * MiB;
constexpr size_t WS_WQ = 54 * MiB;
constexpr size_t WS_LWA = 62 * MiB;
constexpr size_t WS_LWX = 62 * MiB + 256 * 1024;
constexpr size_t WS_KEYS = 62 * MiB + 512 * 1024;
constexpr size_t WS_U8 = 64 * MiB;
constexpr size_t WS_V8 = 96 * MiB;
constexpr size_t WS_US = 128 * MiB;
constexpr size_t WS_VS = 128 * MiB + 65536;
constexpr size_t WS_HN = 192 * MiB;
constexpr size_t WS_X1B = WS_HN;
constexpr size_t WS_Q = 224 * MiB;
constexpr size_t WS_K = 240 * MiB;
constexpr size_t WS_VT = 256 * MiB;
constexpr size_t WS_XR = 272 * MiB;
constexpr size_t WS_GY = 288 * MiB;
constexpr size_t WS_SG = 304 * MiB;
constexpr size_t WS_QP = WS_SG;
constexpr size_t WS_OCAT = 368 * MiB;
constexpr size_t WS_HL = 400 * MiB;
constexpr size_t WS_AC = 432 * MiB;
constexpr size_t WS_TMP = WS_HL;
constexpr size_t WS_SUM = 464 * MiB;
constexpr size_t WS_MG = 466 * MiB;
constexpr size_t WS_SSP = 498 * MiB;
constexpr size_t WS_IDX = 500 * MiB;
constexpr size_t WS_G = 504 * MiB;
constexpr size_t WS_PD = WS_Q;
constexpr size_t WS_ACT = WS_VT;
constexpr size_t WS_OUTP = WS_HL;
constexpr size_t WS_END = 508 * MiB;
constexpr int CW_BAR = 4096;
constexpr int CW_XC = 12288;
constexpr int CW_Q2 = 8192;
constexpr int CW_KM = 65536;
static_assert((CW_KM + 32768) * 4 <= (int)CTL_ZERO_BYTES, "CTL");

constexpr int LDS_BYTES = 163840;
constexpr int MISC_OFF = 163840 - 256;
constexpr int SCR_BYTES = MISC_OFF;

typedef float f32x16 __attribute__((ext_vector_type(16)));
typedef float f32x2_t __attribute__((ext_vector_type(2)));
typedef __bf16 bf16x2_t __attribute__((ext_vector_type(2)));
typedef unsigned long long u64;
__device__ __forceinline__ float clamp8(float v) { return fminf(fmaxf(v, -448.f), 448.f); }
__device__ __forceinline__ unsigned cvtpk(float lo, float hi) { f32x2_t v = {lo, hi}; bf16x2_t b = __builtin_convertvector(v, bf16x2_t); return __builtin_bit_cast(unsigned, b); }
__device__ __forceinline__ float bf_lo(unsigned w) { return __builtin_bit_cast(float, w << 16); }
__device__ __forceinline__ float bf_hi(unsigned w) { return __builtin_bit_cast(float, w & 0xffff0000u); }
__device__ __forceinline__ f32x4 bf4_lo2(unsigned a, unsigned b) { f32x4 r; r[0] = bf_lo(a); r[1] = bf_hi(a); r[2] = bf_lo(b); r[3] = bf_hi(b); return r; }
__device__ __forceinline__ float wave_sum(float v) {
#pragma unroll
    for (int o = 1; o < 64; o <<= 1) v += __shfl_xor(v, o);
    return v;
}
__device__ __forceinline__ float dot2bf(unsigned a, unsigned b, float acc) { return __builtin_amdgcn_fdot2_f32_bf16(__builtin_bit_cast(bf16x2_t, a), __builtin_bit_cast(bf16x2_t, b), acc, false); }

struct Params {
    const float *x, *g_mix, *w_in, *conv_w, *conv_b, *lru_wa, *lru_ba, *lru_wx, *lru_bx, *lru_lam, *w_branch, *w_out, *rel_bias, *g_ffn, *peer_wq, *peer_keys, *peer_u, *peer_v, *g_fin;
    float* out; unsigned char* ws; int ph_lo, ph_hi;
};

struct TrD { const float* W; const float* ks; unsigned char* d; int N, k0, n0, ldd; float sc; bool f8; };
__device__ __forceinline__ void tr_load(const TrD& t, int lane, f32x4 (&wv)[8]) {
#pragma unroll
    for (int i = 0; i < 8; ++i) wv[i] = *(const f32x4*)(t.W + (size_t)(t.k0 + (lane >> 3) + 8 * i) * t.N + t.n0 + 4 * (lane & 7));
}
__device__ __forceinline__ void tr_finish(const TrD& t, f32x4 (&wv)[8], LAS float* scr, int lane) {
#pragma unroll
    for (int i = 0; i < 8; ++i) { const int kk = (lane >> 3) + 8 * i; f32x4 v = wv[i]; if (t.ks) v = v * t.ks[t.k0 + kk];
#pragma unroll
        for (int e = 0; e < 4; ++e) scr[kk * 33 + 4 * (lane & 7) + e] = v[e]; }
    LDS_WAIT(); asm volatile("" ::: "memory");
    const int c = lane & 7; const float f8scale = t.sc;
#pragma unroll
    for (int j = 0; j < 4; ++j) { const int n = (lane >> 3) + 8 * j; const LAS float* s = scr + (8 * c) * 33 + n;
        if (t.f8) {
            int p0 = __builtin_amdgcn_cvt_pk_fp8_f32(clamp8(s[0 * 33] * f8scale), clamp8(s[1 * 33] * f8scale), 0, false); p0 = __builtin_amdgcn_cvt_pk_fp8_f32(clamp8(s[2 * 33] * f8scale), clamp8(s[3 * 33] * f8scale), p0, true);
            int p1 = __builtin_amdgcn_cvt_pk_fp8_f32(clamp8(s[4 * 33] * f8scale), clamp8(s[5 * 33] * f8scale), 0, false); p1 = __builtin_amdgcn_cvt_pk_fp8_f32(clamp8(s[6 * 33] * f8scale), clamp8(s[7 * 33] * f8scale), p1, true);
            *(u64*)(t.d + (size_t)n * t.ldd + t.k0 + 8 * c) = (u64)(unsigned)p0 | ((u64)(unsigned)p1 << 32);
        } else {
        v4u o; o.x = cvtpk(s[0 * 33], s[1 * 33]); o.y = cvtpk(s[2 * 33], s[3 * 33]); o.z = cvtpk(s[4 * 33], s[5 * 33]); o.w = cvtpk(s[6 * 33], s[7 * 33]);
        *(v4u*)(t.d + (size_t)n * t.ldd + 2 * (t.k0 + 8 * c)) = o; } }
    LDS_WAIT(); asm volatile("" ::: "memory");
}
template <int MODE> __device__ __forceinline__ void row_to_bf16(const float* src, bf16* dst, const float* colscale, int lane) {
    const f32x4* s = (const f32x4*)src + lane;
    f32x4 v[8]; float ss = 0.f;
#pragma unroll
    for (int j = 0; j < 8; ++j) { v[j] = s[64 * j]; ss += (v[j][0] * v[j][0] + v[j][1] * v[j][1]) + (v[j][2] * v[j][2] + v[j][3] * v[j][3]); }
    float rs = 1.f;
    if (MODE == 1) rs = __builtin_amdgcn_rsqf(wave_sum(ss) * (1.f / 2048.f) + RMS_EPS);
    u64* o8 = (u64*)dst + lane;
#pragma unroll
    for (int j = 0; j < 8; ++j) { f32x4 w = v[j] * rs; if (colscale) w = w * ((const f32x4*)colscale)[64 * j + lane];
        o8[64 * j] = (u64)cvtpk(w[0], w[1]) | ((u64)cvtpk(w[2], w[3]) << 32); }
}
template <bool I8, bool NT = false> __device__ __forceinline__ void row_finish8(f32x4 (&v)[8], unsigned char* dst, float* scale_out, int lane) {
    float am = 0.f;
#pragma unroll
    for (int j = 0; j < 8; ++j) am = fmaxf(am, fmaxf(fmaxf(fabsf(v[j][0]), fabsf(v[j][1])), fmaxf(fabsf(v[j][2]), fabsf(v[j][3]))));
#pragma unroll
    for (int o = 1; o < 64; o <<= 1) am = fmaxf(am, __shfl_xor(am, o));
    const float qmax = I8 ? 127.f : 448.f;
    const float sc = am > 0.f ? am / qmax : 1.f, inv = 1.f / sc;
    unsigned* o4 = (unsigned*)(dst + (size_t)(lane >> 5) * NEXP * 128) + (lane & 31);
#pragma unroll
    for (int j = 0; j < 8; ++j) { unsigned w;
        if (I8) { const int q0 = (int)rintf(v[j][0] * inv), q1 = (int)rintf(v[j][1] * inv), q2 = (int)rintf(v[j][2] * inv), q3 = (int)rintf(v[j][3] * inv);
            w = (unsigned)(q0 & 255) | ((unsigned)(q1 & 255) << 8) | ((unsigned)(q2 & 255) << 16) | ((unsigned)q3 << 24); }
        else { int p = __builtin_amdgcn_cvt_pk_fp8_f32(v[j][0] * inv, v[j][1] * inv, 0, false); p = __builtin_amdgcn_cvt_pk_fp8_f32(v[j][2] * inv, v[j][3] * inv, p, true); w = (unsigned)p; }
        if (NT) __builtin_nontemporal_store(w, o4 + (size_t)(2 * j) * NEXP * 32); else o4[(size_t)(2 * j) * NEXP * 32] = w; }
    if (lane == 0) *scale_out = sc;
}
template <bool I8, int NR = 2, bool NT = false> __device__ __forceinline__ void table_rows8(const float* src, unsigned char* dst, float* scales, const float* colscale, int r0, int r1, int wv, int nwv, int lane) {
    f32x4 cs[8];
#pragma unroll
    for (int j = 0; j < 8; ++j) cs[j] = colscale ? ((const f32x4*)colscale)[64 * j + lane] : (f32x4){1.f, 1.f, 1.f, 1.f};
    for (int m = r0 + wv; m < r1; m += NR * nwv) {
        f32x4 v[NR][8];
#pragma unroll
        for (int q = 0; q < NR; ++q) { const int mq = m + q * nwv; if (mq < r1) {
#pragma unroll
            for (int j = 0; j < 8; ++j) v[q][j] = NT ? __builtin_nontemporal_load((const f32x4*)(src + (size_t)mq * DM) + 64 * j + lane) : ((const f32x4*)(src + (size_t)mq * DM))[64 * j + lane]; } }
#pragma unroll
        for (int q = 0; q < NR; ++q) { const int mq = m + q * nwv; if (mq < r1) {
            if (colscale) {
#pragma unroll
                for (int j = 0; j < 8; ++j) v[q][j] = v[q][j] * cs[j]; }
            row_finish8<I8, NT>(v[q], dst + (size_t)mq * 128, scales + mq, lane); } }
    }
}
template <int NR> __device__ __forceinline__ void peer_table_u(const Params& P, int r0, int r1, int wv, int nwv, int lane) { table_rows8<true, NR>(P.peer_u, P.ws + WS_U8, (float*)(P.ws + WS_US), P.g_ffn, r0, r1, wv, nwv, lane); }
template <int NR, bool NT = false> __device__ __forceinline__ void peer_table_v(const Params& P, int r0, int r1, int wv, int nwv, int lane) { table_rows8<false, NR, NT>(P.peer_v, P.ws + WS_V8, (float*)(P.ws + WS_VS), nullptr, r0, r1, wv, nwv, lane); }
constexpr int TT_PITCH = 260;
constexpr int TT_IN = 16 * 36, TT_BR = 2 * 8 * 8, TT_SQ = 16 * 8, TT_N = TT_IN + TT_BR + 2 * TT_SQ;
static_assert(128 * TT_PITCH * 4 <= MISC_OFF, "transpose tile");
__device__ __forceinline__ TrD tt_decode(const Params& P, int T) {
    unsigned char* ws = P.ws;
    TrD t; t.ks = nullptr; t.f8 = true; t.ldd = 2048; t.sc = W8SCALE;
    if (T < TT_IN) { const int kt = T / 36, nt = T % 36, n0 = 256 * nt; t.W = P.w_in; t.N = 9216; t.k0 = 128 * kt; t.n0 = n0;
        t.d = (n0 < 2048) ? ws + WS_WA + (size_t)n0 * 2048 : (n0 < 3072 ? ws + WS_WV + (size_t)(n0 - 2048) * 2048 : ws + WS_WA + (size_t)(n0 - 1024) * 2048); return t; } T -= TT_IN;
    if (T < TT_BR) { const int br = T / 64, q = T % 64, kt = q / 8, nt = q % 8; t.W = P.w_branch + (size_t)br * 1024 * 2048; t.N = 2048; t.k0 = 128 * kt; t.n0 = 256 * nt; t.sc = WB8SCALE;
        t.d = ws + WS_WB + (size_t)(256 * nt) * 2048 + br * 1024; return t; } T -= TT_BR;
    if (T < TT_SQ) { const int kt = T / 8, nt = T % 8; t.W = P.w_out; t.N = 2048; t.k0 = 128 * kt; t.n0 = 256 * nt; t.d = ws + WS_WO + (size_t)(256 * nt) * 2048; return t; } T -= TT_SQ;
    { const int kt = T / 8, nt = T % 8; t.f8 = false; t.sc = 1.f; t.W = P.peer_wq; t.N = 2048; t.k0 = 128 * kt; t.n0 = 256 * nt; t.ks = P.g_ffn; t.ldd = 4096; t.d = ws + WS_WQ + (size_t)(256 * nt) * 4096; return t; }
}
__device__ __forceinline__ void tt_load(const TrD& t, int wave, int lane, f32x4 (&v)[16]) {
#pragma unroll
    for (int i = 0; i < 16; ++i) v[i] = *(const f32x4*)(t.W + (size_t)(t.k0 + 16 * wave + i) * t.N + t.n0 + 4 * lane);
}
__device__ __forceinline__ void tt_to_lds(const TrD& t, LAS float* tile, int wave, int lane, f32x4 (&v)[16]) {
#pragma unroll
    for (int i = 0; i < 16; ++i) { f32x4 w = v[i] * t.sc; if (t.ks) w = w * t.ks[t.k0 + 16 * wave + i]; *(LAS f32x4*)(tile + (16 * wave + i) * TT_PITCH + 4 * lane) = w; }
}
__device__ __forceinline__ void tt_emit(const TrD& t, const LAS float* tile, int tid) {
    const int n = tid & 255, kh = tid >> 8; const LAS float* s = tile + (64 * kh) * TT_PITCH + n;
    if (t.f8) { unsigned char* o = t.d + (size_t)n * t.ldd + t.k0 + 64 * kh;
#pragma unroll
        for (int q = 0; q < 4; ++q) { v4u w;
#pragma unroll
            for (int e = 0; e < 4; ++e) { const LAS float* z = s + (16 * q + 4 * e) * TT_PITCH;
                int pk = __builtin_amdgcn_cvt_pk_fp8_f32(clamp8(z[0]), clamp8(z[TT_PITCH]), 0, false); pk = __builtin_amdgcn_cvt_pk_fp8_f32(clamp8(z[2 * TT_PITCH]), clamp8(z[3 * TT_PITCH]), pk, true); w[e] = (unsigned)pk; }
            *(v4u*)(o + 16 * q) = w; }
    } else { unsigned char* o = t.d + (size_t)n * t.ldd + 2 * (t.k0 + 64 * kh);
#pragma unroll
        for (int q = 0; q < 8; ++q) { v4u w;
#pragma unroll
            for (int e = 0; e < 4; ++e) { const LAS float* z = s + (8 * q + 2 * e) * TT_PITCH; w[e] = cvtpk(z[0], z[TT_PITCH]); }
            *(v4u*)(o + 16 * q) = w; } }
}
__device__ __forceinline__ TrD tr_decode_lru(const Params& P, int r) {
    TrD t; t.ks = nullptr; t.f8 = false; t.sc = 1.f;
    const int which = r / 64, q = r % 64, g = q / 8, kb = (q % 8) / 4, nb = q % 4;
    t.W = (which ? P.lru_wx : P.lru_wa) + (size_t)g * 16384; t.N = 128; t.k0 = 64 * kb; t.n0 = 32 * nb; t.ldd = 256; t.d = P.ws + (which ? WS_LWX : WS_LWA) + ((size_t)g * 16384 + (size_t)(32 * nb) * 128) * 2; return t;
}
__device__ __forceinline__ void p0_prologue(const Params& P, LAS unsigned char* lds, int gw, int NGW, int wave, int lane, int r1) {
    unsigned char* ws = P.ws;
    const int vcu = gw / NWAVES, G = NGW / NWAVES, tid = wave * 64 + lane;
    { LAS float* tile = (LAS float*)lds; f32x4 v[16];
      int T = vcu; TrD a = tt_decode(P, T < TT_N ? T : 0);
      if (T < TT_N) tt_load(a, wave, lane, v);
      while (T < TT_N) {
          tt_to_lds(a, tile, wave, lane, v);
          __syncthreads();
          const TrD cur = a; const int Tn = T + G;
          if (Tn < TT_N) { a = tt_decode(P, Tn); tt_load(a, wave, lane, v); }
          tt_emit(cur, tile, tid);
          __syncthreads();
          T = Tn; } }
    if (gw < 128) { LAS float* scr = (LAS float*)(lds + wave * 16384); TrD a = tr_decode_lru(P, gw); f32x4 wa[8]; tr_load(a, lane, wa); tr_finish(a, wa, scr, lane); }
#ifdef TPROBE
    *(volatile LAS unsigned*)(lds + MISC_OFF + 4 * 52) = (unsigned)__builtin_amdgcn_s_memrealtime();
#endif
    { bf16* KB = (bf16*)(ws + WS_KEYS);
      for (int i = gw * 64 + lane; i < 262144 / 8; i += NGW * 64) { const f32x4 a = ((const f32x4*)P.peer_keys)[2 * i], b = ((const f32x4*)P.peer_keys)[2 * i + 1];
          v4u o; o.x = cvtpk(a[0], a[1]); o.y = cvtpk(a[2], a[3]); o.z = cvtpk(b[0], b[1]); o.w = cvtpk(b[2], b[3]); ((v4u*)KB)[i] = o; } }
    { unsigned char* HN = ws + WS_HN;
      const int tq = TT_N / G, n_hi = TT_N - tq * G, W = (T_TOK + 16 * TT_N + G - 1) / G, r_hi = W - 16 * (tq + 1), r_lo = W - 16 * tq;
      int r0, cnt;
      if (r_hi >= 0 && n_hi * r_hi + (G - n_hi) * r_lo >= T_TOK) { r0 = vcu < n_hi ? vcu * r_hi : n_hi * r_hi + (vcu - n_hi) * r_lo; cnt = vcu < n_hi ? r_hi : r_lo; }
      else { const int per = (T_TOK + G - 1) / G; r0 = vcu * per; cnt = per; }
      const int rend = (r0 + cnt < T_TOK) ? r0 + cnt : T_TOK;
      for (int m = r0 + wave; m < rend; m += 4 * NWAVES) {
          f32x4 v[4][8];
#pragma unroll
          for (int q = 0; q < 4; ++q) { const int mq = m + q * NWAVES; if (mq < rend) {
#pragma unroll
              for (int j = 0; j < 8; ++j) v[q][j] = ((const f32x4*)(P.x + (size_t)mq * DM))[64 * j + lane]; } }
#pragma unroll
          for (int q = 0; q < 4; ++q) { const int mq = m + q * NWAVES; if (mq < rend) {
              float sa = 0.f;
#pragma unroll
              for (int j = 0; j < 8; ++j) sa += (v[q][j][0] * v[q][j][0] + v[q][j][1] * v[q][j][1]) + (v[q][j][2] * v[q][j][2] + v[q][j][3] * v[q][j][3]);
              const float ra = __builtin_amdgcn_rsqf(wave_sum(sa) * (1.f / 2048.f) + RMS_EPS);
              unsigned* oa = (unsigned*)(HN + (size_t)mq * DM) + lane;
#pragma unroll
              for (int j = 0; j < 8; ++j) { const f32x4 w = v[q][j] * ra * ((const f32x4*)P.g_mix)[64 * j + lane]; int p = __builtin_amdgcn_cvt_pk_fp8_f32(w[0], w[1], 0, false); p = __builtin_amdgcn_cvt_pk_fp8_f32(w[2], w[3], p, true); oa[64 * j] = (unsigned)p; } } } } }
    if (r1 > 0) { peer_table_u<2>(P, 0, r1, gw, NGW, lane); peer_table_v<2>(P, 0, r1, gw, NGW, lane); }
}

constexpr int AT_KT = 0, AT_VT = 2 * 17408, AT_KM = AT_VT + 2 * 18432, AT_B2 = AT_KM + 4096, AT_SEL = AT_B2 + 512, AT_ANY = AT_SEL + 1024;
#define MFMA32(a, b, c) __builtin_amdgcn_mfma_f32_32x32x16_bf16((a), (b), (c), 0, 0, 0)
__device__ __forceinline__ void attn_unit(const Params& P, LAS unsigned char* lds, int b, int h, int blk, int tid, int wave, int lane) {
    unsigned char* ws = P.ws;
    const bf16* Qb = (const bf16*)(ws + WS_Q); const bf16* Kb = (const bf16*)(ws + WS_K); const bf16* VTg = (const bf16*)(ws + WS_VT); bf16* OATT = (bf16*)(ws + WS_OCAT);
    const float* KMg = (const float*)(ws + WS_CTL) + CW_KM;
    LAS float* KMs = (LAS float*)(lds + AT_KM); LAS float* B2 = (LAS float*)(lds + AT_B2); LAS unsigned* SELM = (LAS unsigned*)(lds + AT_SEL); LAS unsigned* UANY = (LAS unsigned*)(lds + AT_ANY);
    const int row_blk0 = b * SEQ + blk * 256;
    __syncthreads();
    for (int i = tid; i < 1024; i += 512) KMs[i] = KMg[(size_t)(b * 8 + h) * 1024 + i] * (1.f / 256.f);
    if (tid < 128) { const int d = tid; int bucket = d;
        if (d >= 16) { bucket = 16 + (int)(__logf((float)d * (1.f / 16.f)) * (16.f / 2.0794415416798357f)); bucket = bucket > 31 ? 31 : bucket; }
        B2[d] = (P.rel_bias[bucket * 8 + h] - P.rel_bias[31 * 8 + h]) * LOG2E; }
    if (tid == 0) *UANY = 0u;
    __syncthreads();
    {
        const int qq = tid >> 1, q2 = tid & 1;
        unsigned mask = (1u << blk) - 1u;
        if (blk > 3) {
            const bf16* qrow = Qb + (size_t)(row_blk0 + qq) * AW + h * 128;
            v4u qv[8];
#pragma unroll
            for (int c8 = 0; c8 < 8; ++c8) qv[c8] = *(const v4u*)(qrow + 8 * (q2 + 2 * c8));
            float g0 = 0.f, g1 = 0.f, g2 = 0.f, g3 = 0.f, g4 = 0.f, g5 = 0.f, g6 = 0.f;
#pragma unroll
            for (int c8 = 0; c8 < 8; ++c8) { const float q[8] = {bf_lo(qv[c8].x), bf_hi(qv[c8].x), bf_lo(qv[c8].y), bf_hi(qv[c8].y), bf_lo(qv[c8].z), bf_hi(qv[c8].z), bf_lo(qv[c8].w), bf_hi(qv[c8].w)};
#pragma unroll
                for (int e = 0; e < 8; ++e) { const LAS float* km = KMs + 8 * (q2 + 2 * c8) + e;
                    g0 += q[e] * km[0]; g1 += q[e] * km[128]; g2 += q[e] * km[256]; g3 += q[e] * km[384]; g4 += q[e] * km[512]; g5 += q[e] * km[640]; g6 += q[e] * km[768]; } }
            g0 += __shfl_xor(g0, 1); g1 += __shfl_xor(g1, 1); g2 += __shfl_xor(g2, 1); g3 += __shfl_xor(g3, 1); g4 += __shfl_xor(g4, 1); g5 += __shfl_xor(g5, 1); g6 += __shfl_xor(g6, 1);
            const float NEGG = -3.0e38f;
            if (blk < 7) g6 = NEGG; if (blk < 6) g5 = NEGG; if (blk < 5) g4 = NEGG;
            mask = 0u;
#pragma unroll
            for (int s = 0; s < 3; ++s) { float best = g0; int bj = 0;
                if (g1 > best) { best = g1; bj = 1; } if (g2 > best) { best = g2; bj = 2; } if (g3 > best) { best = g3; bj = 3; }
                if (g4 > best) { best = g4; bj = 4; } if (g5 > best) { best = g5; bj = 5; } if (g6 > best) { best = g6; bj = 6; }
                mask |= 1u << bj;
                g0 = bj == 0 ? NEGG : g0; g1 = bj == 1 ? NEGG : g1; g2 = bj == 2 ? NEGG : g2; g3 = bj == 3 ? NEGG : g3; g4 = bj == 4 ? NEGG : g4; g5 = bj == 5 ? NEGG : g5; g6 = bj == 6 ? NEGG : g6; }
        }
        if (q2 == 0) { SELM[qq] = mask; __hip_atomic_fetch_or(UANY, mask, __ATOMIC_RELAXED, __HIP_MEMORY_SCOPE_WORKGROUP); }
    }
    __syncthreads();
    const unsigned uany = *UANY;
    unsigned blist = (unsigned)blk; int nb = 1;
    for (int j = blk - 1; j >= 0; --j) if ((uany >> j) & 1u) { blist |= (unsigned)j << (4 * nb); ++nb; }
    const int nsteps = 4 * nb;
    const int qi = 32 * wave + (lane & 31), hh = lane >> 5;
    const unsigned mymask = SELM[qi];
    bf16x8 Qf[8];
    { const bf16* qp = Qb + (size_t)(row_blk0 + qi) * AW + h * 128 + 8 * hh;
#pragma unroll
      for (int ks = 0; ks < 8; ++ks) Qf[ks] = *(const bf16x8*)(qp + 16 * ks); }
    float m_run = -1.0e30f, lsum = 0.f;
    f32x16 O[4];
#pragma unroll
    for (int dt = 0; dt < 4; ++dt)
#pragma unroll
        for (int r = 0; r < 16; ++r) O[dt][r] = 0.f;
    const int kkey0 = tid >> 4, kpart = tid & 15;
    const int vd0 = tid >> 3, vcc = tid & 7;
    const unsigned kl0 = kkey0 * 272 + kpart * 16, kl1 = kl0 + 32 * 272;
    const unsigned vl0 = vd0 * 144 + ((((vcc >> 2) * 2 + ((vcc & 3) >> 1)) * 2) * 16) + (vcc & 1) * 8, vl1 = vl0 + 64 * 144;
    v4u ka0, ka1, va0, va1, kb0, kb1, vb0, vb1;
#define AT_LOAD(s, k0, k1, v0, v1) do { const int j_ = (blist >> (4 * ((s) >> 2))) & 15, kt_ = (s) & 3; const size_t krow0 = (size_t)b * SEQ + j_ * 256 + kt_ * 64; \
        k0 = *(const v4u*)(Kb + (krow0 + kkey0) * AW + h * 128 + kpart * 8); k1 = *(const v4u*)(Kb + (krow0 + kkey0 + 32) * AW + h * 128 + kpart * 8); \
        v0 = *(const v4u*)(VTg + (size_t)(h * 128 + vd0) * T_TOK + krow0 + vcc * 8); v1 = *(const v4u*)(VTg + (size_t)(h * 128 + vd0 + 64) * T_TOK + krow0 + vcc * 8); } while (0)
#define AT_STORE(bufi, k0, k1, v0, v1) do { LAS unsigned char* KT_ = lds + AT_KT + (bufi) * 17408; LAS unsigned char* VT_ = lds + AT_VT + (bufi) * 18432; \
        *(LAS v4u*)(KT_ + kl0) = k0; *(LAS v4u*)(KT_ + kl1) = k1; \
        *(LAS u64*)(VT_ + vl0) = (u64)v0.x | ((u64)v0.y << 32); *(LAS u64*)(VT_ + vl0 + 16) = (u64)v0.z | ((u64)v0.w << 32); \
        *(LAS u64*)(VT_ + vl1) = (u64)v1.x | ((u64)v1.y << 32); *(LAS u64*)(VT_ + vl1 + 16) = (u64)v1.z | ((u64)v1.w << 32); } while (0)
    AT_LOAD(0, ka0, ka1, va0, va1); AT_STORE(0, ka0, ka1, va0, va1);
    if (1 < nsteps) AT_LOAD(1, ka0, ka1, va0, va1);
    if (2 < nsteps) AT_LOAD(2, kb0, kb1, vb0, vb1);
    for (int s = 0; s < nsteps; ++s) {
        const int j = (blist >> (4 * (s >> 2))) & 15, kt = s & 3;
        __syncthreads();
        if ((s & 1) == 0) { if (s + 1 < nsteps) AT_STORE((s + 1) & 1, ka0, ka1, va0, va1); if (s + 3 < nsteps) AT_LOAD(s + 3, ka0, ka1, va0, va1); }
        else              { if (s + 1 < nsteps) AT_STORE((s + 1) & 1, kb0, kb1, vb0, vb1); if (s + 3 < nsteps) AT_LOAD(s + 3, kb0, kb1, vb0, vb1); }
        const LAS unsigned char* KT = lds + AT_KT + (s & 1) * 17408; const LAS unsigned char* VTl = lds + AT_VT + (s & 1) * 18432;
        bool part;
        if (j == blk) part = (64 * kt <= 32 * wave + 31);
        else part = (__ballot((mymask >> j) & 1u) != 0ull);
        if (part) {
            f32x16 S0, S1;
#pragma unroll
            for (int r = 0; r < 16; ++r) { S0[r] = 0.f; S1[r] = 0.f; }
            const LAS unsigned char* kp = KT + (lane & 31) * 272 + hh * 16;
#pragma unroll
            for (int ks = 0; ks < 8; ++ks) { const bf16x8 a0 = *(const LAS bf16x8*)(kp + ks * 32), a1 = *(const LAS bf16x8*)(kp + 32 * 272 + ks * 32);
                S0 = MFMA32(a0, Qf[ks], S0); S1 = MFMA32(a1, Qf[ks], S1); }
            const bool sel = ((mymask >> j) & 1u) != 0u;
            float mx = -1.0e30f; bool ok_row = true;
            const int dmin = 32 * wave + 256 * (blk - j) - 64 * kt - 63;
            if (dmin < 113) {
                const int dbase = (j == blk) ? (qi - 64 * kt - 4 * hh) : (qi + 256 - 64 * kt - 4 * hh);
                const bool okrow = (j == blk) ? true : sel;
#pragma unroll
                for (int r = 0; r < 16; ++r) { const int kk = (r & 3) + 8 * (r >> 2);
                    { const int dist = dbase - kk; const int di = dist < 0 ? 0 : (dist > 127 ? 127 : dist); const float v = (okrow && dist >= 0) ? S0[r] + B2[di] : -1.0e30f; S0[r] = v; mx = fmaxf(mx, v); }
                    { const int dist = dbase - 32 - kk; const int di = dist < 0 ? 0 : (dist > 127 ? 127 : dist); const float v = (okrow && dist >= 0) ? S1[r] + B2[di] : -1.0e30f; S1[r] = v; mx = fmaxf(mx, v); } }
            } else {
                ok_row = sel || (j == blk);
#pragma unroll
                for (int r = 0; r < 16; ++r) mx = fmaxf(mx, fmaxf(S0[r], S1[r]));
                mx = ok_row ? mx : -1.0e30f;
            }
            mx = fmaxf(mx, __shfl_xor(mx, 32));
            const bool need = mx > m_run + 8.f;
            if (__any(need)) { const float m_new = need ? mx : m_run, alpha = __builtin_amdgcn_exp2f(m_run - m_new);
                m_run = m_new; lsum *= alpha;
#pragma unroll
                for (int dt = 0; dt < 4; ++dt)
#pragma unroll
                    for (int r = 0; r < 16; ++r) O[dt][r] *= alpha; }
            float ps = 0.f;
            const float m_eff = ok_row ? m_run : 1.0e30f;
#pragma unroll
            for (int r = 0; r < 16; ++r) { S0[r] = __builtin_amdgcn_exp2f(S0[r] - m_eff); S1[r] = __builtin_amdgcn_exp2f(S1[r] - m_eff); ps += S0[r] + S1[r]; }
            lsum += ps;
            bf16x8 Pf[2][2];
#pragma unroll
            for (int s2 = 0; s2 < 2; ++s2) {
                v4u p0, p1;
                p0.x = cvtpk(S0[8 * s2], S0[8 * s2 + 1]); p0.y = cvtpk(S0[8 * s2 + 2], S0[8 * s2 + 3]); p0.z = cvtpk(S0[8 * s2 + 4], S0[8 * s2 + 5]); p0.w = cvtpk(S0[8 * s2 + 6], S0[8 * s2 + 7]);
                p1.x = cvtpk(S1[8 * s2], S1[8 * s2 + 1]); p1.y = cvtpk(S1[8 * s2 + 2], S1[8 * s2 + 3]); p1.z = cvtpk(S1[8 * s2 + 4], S1[8 * s2 + 5]); p1.w = cvtpk(S1[8 * s2 + 6], S1[8 * s2 + 7]);
                Pf[0][s2] = __builtin_bit_cast(bf16x8, p0); Pf[1][s2] = __builtin_bit_cast(bf16x8, p1); }
            const LAS unsigned char* vp = VTl + (lane & 31) * 144 + hh * 16;
#pragma unroll
            for (int dt = 0; dt < 4; ++dt)
#pragma unroll
                for (int mt = 0; mt < 2; ++mt)
#pragma unroll
                    for (int s2 = 0; s2 < 2; ++s2) { const bf16x8 a = *(const LAS bf16x8*)(vp + dt * 32 * 144 + (mt * 2 + s2) * 32); O[dt] = MFMA32(a, Pf[mt][s2], O[dt]); }
        }
    }
#undef AT_LOAD
#undef AT_STORE
    const float ltot = lsum + __shfl_xor(lsum, 32), inv = 1.f / ltot;
    unsigned char* orow = (unsigned char*)OATT + (size_t)(row_blk0 + qi) * DM + h * 128 + 4 * hh;
    const float osc = inv * OC8SCALE;
#pragma unroll
    for (int dt = 0; dt < 4; ++dt)
#pragma unroll
        for (int g4 = 0; g4 < 4; ++g4) { int p = __builtin_amdgcn_cvt_pk_fp8_f32(clamp8(O[dt][4 * g4] * osc), clamp8(O[dt][4 * g4 + 1] * osc), 0, false); p = __builtin_amdgcn_cvt_pk_fp8_f32(clamp8(O[dt][4 * g4 + 2] * osc), clamp8(O[dt][4 * g4 + 3] * osc), p, true);
            *(unsigned*)(orow + 32 * dt + 8 * g4) = (unsigned)p; }
}
constexpr int LR_XC = 0, LR_SEG = 2 * 17408, LR_W = LR_SEG + 2 * 4096;
#define MFMA16(a, b, c) __builtin_amdgcn_mfma_f32_16x16x32_bf16((a), (b), (c), 0, 0, 0)
__device__ __forceinline__ void lru_pair(const Params& P, LAS unsigned char* lds, int pair, int tid, int wave, int lane, unsigned* tkword, int& tk_next) {
    unsigned char* ws = P.ws;
    const int grp = wave >> 2, wq = wave & 3, tg = tid & 255;
    const int unit = 2 * pair + grp, b = unit >> 8, g = (unit >> 5) & 7, c = unit & 31;
    const bf16* XR = (const bf16*)(ws + WS_XR); const bf16* LWA = (const bf16*)(ws + WS_LWA) + (size_t)g * 16384; const bf16* LWX = (const bf16*)(ws + WS_LWX) + (size_t)g * 16384;
    float* HL = (float*)(ws + WS_HL); float* SUM = (float*)(ws + WS_SUM);
    LAS unsigned short* XC = (LAS unsigned short*)(lds + LR_XC + grp * 17408);
    LAS float* SEG = (LAS float*)(lds + LR_SEG + grp * 4096);
    LAS unsigned char* WL = lds + LR_W;
    const int t0 = c * 64; const size_t R0 = (size_t)b * SEQ + t0;
    __syncthreads();
    {
      v4u wv[8];
#pragma unroll
      for (int i = 0; i < 8; ++i) { const int q = tid + 512 * i, mat = q >> 11, row = (q >> 4) & 127, part = q & 15; wv[i] = *(const v4u*)((mat ? LWX : LWA) + row * 128 + part * 8); }
      const int cpart = tg & 15, C8 = g * 128 + 8 * cpart;
      f32x4 cw[4][2], cbv[2];
#pragma unroll
      for (int w = 0; w < 4; ++w) { cw[w][0] = *(const f32x4*)(P.conv_w + w * 1024 + C8); cw[w][1] = *(const f32x4*)(P.conv_w + w * 1024 + C8 + 4); }
      cbv[0] = *(const f32x4*)(P.conv_b + C8); cbv[1] = *(const f32x4*)(P.conv_b + C8 + 4);
#define LR_CONV_LOAD(xr, base) do { _Pragma("unroll") for (int i2 = 0; i2 < 2; ++i2) { const int tl = (tg >> 4) + 16 * ((base) + i2); \
          _Pragma("unroll") for (int w = 0; w < 4; ++w) { const int ts = t0 + tl - 3 + w; xr[i2][w] = (ts >= 0) ? *(const v4u*)(XR + ((size_t)b * SEQ + ts) * AW + C8) : (v4u){0u, 0u, 0u, 0u}; } } } while (0)
#define LR_CONV_DO(xr, base) do { _Pragma("unroll") for (int i2 = 0; i2 < 2; ++i2) { const int tl = (tg >> 4) + 16 * ((base) + i2); f32x4 y0 = cbv[0], y1 = cbv[1]; \
          _Pragma("unroll") for (int w = 0; w < 4; ++w) { y0 = y0 + bf4_lo2(xr[i2][w].x, xr[i2][w].y) * cw[w][0]; y1 = y1 + bf4_lo2(xr[i2][w].z, xr[i2][w].w) * cw[w][1]; } \
          v4u o; o.x = cvtpk(y0[0], y0[1]); o.y = cvtpk(y0[2], y0[3]); o.z = cvtpk(y1[0], y1[1]); o.w = cvtpk(y1[2], y1[3]); \
          *(LAS v4u*)((LAS unsigned char*)XC + tl * 272 + cpart * 16) = o; } } while (0)
      { v4u xr[2][4]; LR_CONV_LOAD(xr, 0);
#pragma unroll
        for (int i = 0; i < 8; ++i) { const int q = tid + 512 * i, mat = q >> 11, row = (q >> 4) & 127, part = q & 15; *(LAS v4u*)(WL + (mat * 128 + row) * 272 + part * 16) = wv[i]; }
        LR_CONV_DO(xr, 0); }
      { v4u xr[2][4]; LR_CONV_LOAD(xr, 2); LR_CONV_DO(xr, 2); }
#undef LR_CONV_LOAD
#undef LR_CONV_DO
    }
    __syncthreads();
    if (tid == 0) tk_next = (int)__hip_atomic_fetch_add(tkword, 1u, __ATOMIC_RELAXED, __HIP_MEMORY_SCOPE_AGENT);
    const int fr = lane & 15, fq = lane >> 4;
    float Ar[2][4][4], Hr[2][4][4], AE[2][4], HE[2][4];
#pragma unroll
    for (int nh = 0; nh < 2; ++nh) {
        f32x4 aA[4], aX[4];
#pragma unroll
        for (int nt = 0; nt < 4; ++nt) { aA[nt] = (f32x4){0.f, 0.f, 0.f, 0.f}; aX[nt] = (f32x4){0.f, 0.f, 0.f, 0.f}; }
#pragma unroll 1
        for (int ks = 0; ks < 4; ++ks) { const bf16x8 a = *(const LAS bf16x8*)((LAS unsigned char*)XC + (16 * wq + fr) * 272 + (32 * ks + 8 * fq) * 2);
#pragma unroll
            for (int nt = 0; nt < 4; ++nt) { const int wo = (64 * nh + 16 * nt + fr) * 272 + (32 * ks + 8 * fq) * 2;
                const bf16x8 ba = *(const LAS bf16x8*)(WL + wo), bx = *(const LAS bf16x8*)(WL + 128 * 272 + wo);
                aA[nt] = MFMA16(a, ba, aA[nt]); aX[nt] = MFMA16(a, bx, aX[nt]); } }
#pragma unroll
        for (int nt = 0; nt < 4; ++nt) { const int ch = 64 * nh + 16 * nt + fr, C = g * 128 + ch;
            const float ba = P.lru_ba[C], bx = P.lru_bx[C], lam = P.lru_lam[C];
            const float sp8 = 8.f * log1pf(__expf(-lam));
            float Ac = 1.f, Hc = 0.f;
#pragma unroll
            for (int r = 0; r < 4; ++r) { const int tok = 16 * wq + 4 * fq + r;
                const float rg = pg8::sigmoid_f(aA[nt][r] + ba), ig = pg8::sigmoid_f(aX[nt][r] + bx);
                const float log_a = -rg * sp8, a = __builtin_amdgcn_exp2f(log_a * 1.4426950408889634f);
                const float y = 2.f * log_a;
                const float em = (y > -0.25f) ? -y * (1.f + y * (0.5f + y * (0.16666667f + y * (0.041666668f + y * (0.0083333338f + y * 0.0013888889f))))) : 1.f - a * a;
                const float u = __builtin_amdgcn_sqrtf(em) * (ig * bf_lo((unsigned)XC[tok * 136 + ch]));
                Hc = a * Hc + u; Ac *= a; Ar[nh][nt][r] = Ac; Hr[nh][nt][r] = Hc; }
            float AI = Ac, HI = Hc;
            { const float Ap = __shfl_up(AI, 16), Hp = __shfl_up(HI, 16); if (fq >= 1) { HI = AI * Hp + HI; AI = AI * Ap; } }
            { const float Ap = __shfl_up(AI, 32), Hp = __shfl_up(HI, 32); if (fq >= 2) { HI = AI * Hp + HI; AI = AI * Ap; } }
            { const float Ap = __shfl_up(AI, 16), Hp = __shfl_up(HI, 16); AE[nh][nt] = fq >= 1 ? Ap : 1.f; HE[nh][nt] = fq >= 1 ? Hp : 0.f; }
            if (fq == 3) { SEG[(wq * 128 + ch) * 2] = AI; SEG[(wq * 128 + ch) * 2 + 1] = HI; } }
    }
    __syncthreads();
#pragma unroll
    for (int nh = 0; nh < 2; ++nh)
#pragma unroll
        for (int nt = 0; nt < 4; ++nt) { const int ch = 64 * nh + 16 * nt + fr, C = g * 128 + ch;
            float Aw = 1.f, Hw = 0.f;
#pragma unroll
            for (int w2 = 0; w2 < 3; ++w2) if (w2 < wq) { const float As = SEG[(w2 * 128 + ch) * 2], Hs = SEG[(w2 * 128 + ch) * 2 + 1]; Hw = As * Hw + Hs; Aw *= As; }
            const float hin = AE[nh][nt] * Hw + HE[nh][nt], ain = AE[nh][nt] * Aw;
            unsigned* ha = (unsigned*)HL + (R0 + 16 * wq + 4 * fq) * AW + C;
#pragma unroll
            for (int r = 0; r < 4; ++r) ha[(size_t)r * AW] = cvtpk(Ar[nh][nt][r] * hin + Hr[nh][nt][r], Ar[nh][nt][r] * ain);
            if (wq == 3 && fq == 3) { float* sm = SUM + ((size_t)(b * 32 + c) * 1024 + C) * 2; sm[0] = Ar[nh][nt][3] * ain; sm[1] = Ar[nh][nt][3] * hin + Hr[nh][nt][3]; } }
}

constexpr int SC_STR = 129, P7_SAB = 2 * 128 * SC_STR * 4, P7_IL = P7_SAB + 128 * 33 * 4, P7_CT = P7_IL + 128 * 34 * 2;
static_assert(P7_CT + 64 <= MISC_OFF, "P7 LDS map");
__device__ __forceinline__ unsigned ord_key(float v) { const unsigned u = __builtin_bit_cast(unsigned, v); return (u & 0x80000000u) ? ~u : (u | 0x80000000u); }
#define CE_DESC(x, y) do { const unsigned _x = (x), _y = (y); (x) = _x > _y ? _x : _y; (y) = _x > _y ? _y : _x; } while (0)
template <int B, int NA> __device__ __forceinline__ void sort16_desc(unsigned (&a)[NA]) {
#pragma unroll
    for (int k = 2; k <= 16; k <<= 1)
#pragma unroll
        for (int j = k >> 1; j > 0; j >>= 1)
#pragma unroll
            for (int i = 0; i < 16; ++i) { const int l = i ^ j; if (l > i) { if ((i & k) == 0) CE_DESC(a[B + i], a[B + l]); else CE_DESC(a[B + l], a[B + i]); } }
}
template <int A, int Bo, int NA, int NB> __device__ __forceinline__ void merge16_desc(unsigned (&a)[NA], const unsigned (&b)[NB]) {
#pragma unroll
    for (int i = 0; i < 16; ++i) a[A + i] = a[A + i] > b[Bo + 15 - i] ? a[A + i] : b[Bo + 15 - i];
#pragma unroll
    for (int j = 8; j > 0; j >>= 1)
#pragma unroll
        for (int i = 0; i < 16; ++i) { const int l = i ^ j; if (l > i) CE_DESC(a[A + i], a[A + l]); }
}
__device__ __forceinline__ void peer_topk_unit(const Params& P, LAS unsigned char* lds, int t0, int h, int tid, int wave, int lane) {
    unsigned char* ws = P.ws;
    const bf16* QP = (const bf16*)(ws + WS_QP); const bf16* KEYS = (const bf16*)(ws + WS_KEYS);
    int* IDX = (int*)(ws + WS_IDX); float* GW = (float*)(ws + WS_G);
    LAS float* SC = (LAS float*)lds; LAS float* SAB = (LAS float*)(lds + P7_SAB); LAS unsigned short* IL = (LAS unsigned short*)(lds + P7_IL); LAS unsigned char* CT = lds + P7_CT;
    __syncthreads();
    if (tid < 64) { int ia = 0, rem = tid; while (ia < 16 && rem >= 16 / (ia + 1)) { rem -= 16 / (ia + 1); ++ia; }
        CT[tid] = (unsigned char)(ia < 16 ? ia * 16 + rem : 255); }
    { const int mtile = wave & 3, c = wave >> 2, r31 = lane & 31, hh = lane >> 5;
      bf16x8 A[8];
      const bf16* qp = QP + (size_t)(t0 + 32 * mtile + r31) * DM + h * 256 + c * 128 + 8 * hh;
#pragma unroll
      for (int ks = 0; ks < 8; ++ks) A[ks] = *(const bf16x8*)(qp + 16 * ks);
#pragma unroll
      for (int nt = 0; nt < 4; ++nt) { f32x16 acc;
#pragma unroll
          for (int r = 0; r < 16; ++r) acc[r] = 0.f;
          const bf16* kp = KEYS + ((size_t)((h * 2 + c) * 128 + 32 * nt + r31)) * 128 + 8 * hh;
#pragma unroll
          for (int ks = 0; ks < 8; ++ks) { const bf16x8 bk = *(const bf16x8*)(kp + 16 * ks); acc = MFMA32(A[ks], bk, acc); }
#pragma unroll
          for (int r = 0; r < 16; ++r) { const int tok = 32 * mtile + (r & 3) + 8 * (r >> 2) + 4 * hh; SC[(c * 128 + tok) * SC_STR + 32 * nt + r31] = acc[r]; } } }
    __syncthreads();
    const int half = tid & 1, c = (tid >> 1) & 1, tok = tid >> 2;
    unsigned a[64];
    { const LAS float* sp = SC + (c * 128 + tok) * SC_STR + half * 64; const int rot = 8 * (2 * c + half);
#pragma unroll
      for (int i = 0; i < 64; ++i) { const int n = (i + rot) & 63; a[i] = (ord_key(sp[n]) & ~127u) | (unsigned)(127 - (half * 64 + n)); } }
    sort16_desc<0>(a); sort16_desc<16>(a); sort16_desc<32>(a); sort16_desc<48>(a);
    merge16_desc<0, 16>(a, a); merge16_desc<32, 48>(a, a); merge16_desc<0, 32>(a, a);
    { unsigned o[16];
#pragma unroll
      for (int j = 0; j < 16; ++j) o[j] = (unsigned)__shfl_xor((int)a[j], 1);
      merge16_desc<0, 0>(a, o); }
    if (half == 0) {
#pragma unroll
        for (int j = 0; j < 16; ++j) { const int n = 127 - (int)(a[j] & 127u); SAB[tok * 33 + c * 16 + j] = SC[(c * 128 + tok) * SC_STR + n]; IL[tok * 34 + c * 16 + j] = (unsigned short)n; } }
    __syncthreads();
    const int q = tid & 3;
    unsigned cd[16];
#pragma unroll
    for (int j = 0; j < 13; ++j) { const unsigned code = CT[q + 4 * j]; const float s = SAB[tok * 33 + ((code >> 4) & 15u)] + SAB[tok * 33 + 16 + (code & 15u)];
        cd[j] = code == 255u ? 0u : ((ord_key(s) & ~255u) | (255u - code)); }
    cd[13] = 0u; cd[14] = 0u; cd[15] = 0u;
    sort16_desc<0>(cd);
    { unsigned o[16];
#pragma unroll
      for (int j = 0; j < 16; ++j) o[j] = (unsigned)__shfl_xor((int)cd[j], 1);
      merge16_desc<0, 0>(cd, o);
#pragma unroll
      for (int j = 0; j < 16; ++j) o[j] = (unsigned)__shfl_xor((int)cd[j], 2);
      merge16_desc<0, 0>(cd, o); }
    if (q == 0) {
        float cv[16]; int id[16];
#pragma unroll
        for (int s = 0; s < 16; ++s) { const unsigned code = 255u - (cd[s] & 255u); const int ia = (int)(code >> 4), ib = (int)(code & 15u); const int na = IL[tok * 34 + ia], nb = IL[tok * 34 + 16 + ib];
            cv[s] = SAB[tok * 33 + ia] + SAB[tok * 33 + 16 + ib]; id[s] = na * 128 + nb; }
        float mx = cv[0];
#pragma unroll
        for (int s = 1; s < 16; ++s) mx = fmaxf(mx, cv[s]);
        float sum = 0.f;
#pragma unroll
        for (int s = 0; s < 16; ++s) { cv[s] = __builtin_amdgcn_exp2f((cv[s] - mx) * LOG2E); sum += cv[s]; }
        const float inv = 1.f / sum;
        int* ip = IDX + (size_t)(t0 + tok) * 128 + h * 16; float* gp = GW + (size_t)(t0 + tok) * 128 + h * 16;
#pragma unroll
        for (int s4 = 0; s4 < 4; ++s4) { *(int4*)(ip + 4 * s4) = make_int4(id[4 * s4], id[4 * s4 + 1], id[4 * s4 + 2], id[4 * s4 + 3]);
            *(f32x4*)(gp + 4 * s4) = (f32x4){cv[4 * s4] * inv, cv[4 * s4 + 1] * inv, cv[4 * s4 + 2] * inv, cv[4 * s4 + 3] * inv}; }
    }
}

__device__ __forceinline__ void fp8x16_to_f32(const v4u& w, float (&f)[16]) {
#pragma unroll
    for (int i = 0; i < 4; ++i) { const f32x2_t lo = __builtin_amdgcn_cvt_pk_f32_fp8((int)w[i], false), hi = __builtin_amdgcn_cvt_pk_f32_fp8((int)w[i], true);
        f[4 * i] = lo[0]; f[4 * i + 1] = lo[1]; f[4 * i + 2] = hi[0]; f[4 * i + 3] = hi[1]; }
}
#define LD16I(dst, p) do { _Pragma("unroll") for (int q_ = 0; q_ < 4; ++q_) { const int4 v_ = ((const int4*)(p))[q_]; dst[4 * q_] = v_.x; dst[4 * q_ + 1] = v_.y; dst[4 * q_ + 2] = v_.z; dst[4 * q_ + 3] = v_.w; } } while (0)
#define LD16F(dst, p) do { _Pragma("unroll") for (int q_ = 0; q_ < 4; ++q_) { const f32x4 v_ = ((const f32x4*)(p))[q_]; dst[4 * q_] = v_[0]; dst[4 * q_ + 1] = v_[1]; dst[4 * q_ + 2] = v_[2]; dst[4 * q_ + 3] = v_[3]; } } while (0)
__device__ __forceinline__ void peer_u_phase(const Params& P, int xg, int slot, int nslots, int lane) {
    unsigned char* ws = P.ws;
    const bf16* X1B = (const bf16*)(ws + WS_X1B); const unsigned char* U8 = ws + WS_U8; const int* IDX = (const int*)(ws + WS_IDX); float* PD = (float*)(ws + WS_PD) + (size_t)xg * T_TOK * 128;
    const int ntok = slot < T_TOK ? (T_TOK - slot + nslots - 1) / nslots : 0, N = 2 * ntok;
    if (N == 0) return;
    const int R = lane >> 3, p = lane & 7;
    const bool b2 = (lane & 4) != 0, b1 = (lane & 2) != 0, b0 = (lane & 1) != 0;
    int I0[16], I1[16], I2[16]; v4u X0[2], X1[2], X2[2]; v4u B0[8], B1[8], B2[8];
#define U_ITEM(n, t, s) const int n_##t = (n) < N ? (n) : N - 1; const int t = slot + (n_##t >= ntok ? n_##t - ntok : n_##t) * nslots, s = 2 * xg + (n_##t >= ntok ? 1 : 0)
#define U_ROWS(buf, ids, off, s) do { const unsigned char* ub_ = U8 + (size_t)(s) * NEXP * 128; _Pragma("unroll") for (int i = 0; i < 8; ++i) buf[i] = *(const v4u*)(ub_ + (unsigned)(((unsigned)ids[(off) + i] << 7) + 16u * p)); } while (0)
#define U_HALF(buf, off) do { _Pragma("unroll") for (int i = 0; i < 8; ++i) { int d = 0; _Pragma("unroll") for (int w = 0; w < 4; ++w) d = __builtin_amdgcn_sdot4((int)buf[i][w], xq[w], d, false); part[(off) + i] = d; } } while (0)
#define U_X(dst, t, s) do { const bf16* xp_ = X1B + (size_t)(t) * DM + 128 * (s) + 16 * p; dst[0] = *(const v4u*)xp_; dst[1] = *(const v4u*)(xp_ + 8); } while (0)
    const int i0 = ((lane & 4) ? 8 : 0) + ((lane & 2) ? 4 : 0) + ((lane & 1) ? 2 : 0);
    { U_ITEM(0, t0, s0); U_ITEM(1, t1, s1); U_ITEM(2, t2, s2);
      int id0[16];
      LD16I(id0, IDX + (size_t)t0 * 128 + 16 * R); LD16I(I0, IDX + (size_t)t1 * 128 + 16 * R); LD16I(I1, IDX + (size_t)t2 * 128 + 16 * R);
      U_X(X0, t0, s0); U_X(X1, t1, s1);
      U_ROWS(B0, id0, 0, s0); U_ROWS(B1, id0, 8, s0); }
#define U_BODY(n, Ba, Bb, Bc, Ia, Ib, Ic, Xa, Xb, Xc) do { \
        U_ITEM(n, t, s); U_ITEM((n) + 1, t1, s1); U_ITEM((n) + 2, t2, s2); U_ITEM((n) + 3, t3, s3); (void)s; (void)s3; \
        f32x2_t* pp = (f32x2_t*)(PD + (size_t)t * 128 + 16 * R + i0); \
        f32x2_t pold = (f32x2_t){0.f, 0.f}; if ((n) >= ntok) pold = *pp; \
        U_ROWS(Bc, Ia, 0, s1); \
        LD16I(Ic, IDX + (size_t)t3 * 128 + 16 * R); \
        U_X(Xc, t2, s2); \
        float x[16]; float am = 0.f; \
        _Pragma("unroll") for (int k = 0; k < 4; ++k) { x[2 * k] = bf_lo(Xa[0][k]); x[2 * k + 1] = bf_hi(Xa[0][k]); x[8 + 2 * k] = bf_lo(Xa[1][k]); x[8 + 2 * k + 1] = bf_hi(Xa[1][k]); } \
        _Pragma("unroll") for (int k = 0; k < 16; ++k) am = fmaxf(am, fabsf(x[k])); \
        am = fmaxf(am, __shfl_xor(am, 1)); am = fmaxf(am, __shfl_xor(am, 2)); am = fmaxf(am, __shfl_xor(am, 4)); \
        const float xs = am > 0.f ? am * (1.f / 127.f) : 1.f, xinv = 1.f / xs; \
        int xq[4]; \
        _Pragma("unroll") for (int w = 0; w < 4; ++w) { const int q0 = (int)rintf(x[4 * w] * xinv), q1 = (int)rintf(x[4 * w + 1] * xinv), q2 = (int)rintf(x[4 * w + 2] * xinv), q3 = (int)rintf(x[4 * w + 3] * xinv); \
            xq[w] = (int)((unsigned)(q0 & 255) | ((unsigned)(q1 & 255) << 8) | ((unsigned)(q2 & 255) << 16) | ((unsigned)q3 << 24)); } \
        int part[16]; \
        U_HALF(Ba, 0); \
        U_ROWS(Ba, Ia, 8, s1); \
        U_HALF(Bb, 8); \
        if ((n) < N) { \
            int a8[8], a4[4], a2i[2]; \
            _Pragma("unroll") for (int k = 0; k < 8; ++k) { const int send = b2 ? part[k] : part[k + 8], keep = b2 ? part[k + 8] : part[k]; a8[k] = keep + __shfl_xor(send, 4); } \
            _Pragma("unroll") for (int k = 0; k < 4; ++k) { const int send = b1 ? a8[k] : a8[k + 4], keep = b1 ? a8[k + 4] : a8[k]; a4[k] = keep + __shfl_xor(send, 2); } \
            _Pragma("unroll") for (int k = 0; k < 2; ++k) { const int send = b0 ? a4[k] : a4[k + 2], keep = b0 ? a4[k + 2] : a4[k]; a2i[k] = keep + __shfl_xor(send, 1); } \
            *pp = (f32x2_t){(float)a2i[0] * xs, (float)a2i[1] * xs} + pold; } } while (0)
    for (int n = 0; n < N; n += 3) { U_BODY(n, B0, B1, B2, I0, I1, I2, X0, X1, X2); U_BODY(n + 1, B2, B0, B1, I1, I2, I0, X1, X2, X0); U_BODY(n + 2, B1, B2, B0, I2, I0, I1, X2, X0, X1); }
#undef U_X
#undef U_ITEM
#undef U_ROWS
#undef U_HALF
#undef U_BODY
}
__device__ __forceinline__ void peer_act_tokens(const Params& P, int t, int t2, int lane) {
    unsigned char* ws = P.ws;
    const float* PD = (const float*)(ws + WS_PD); const int* IDX = (const int*)(ws + WS_IDX); const float* GW = (const float*)(ws + WS_G); const float* SSP = (const float*)(ws + WS_SSP);
    const float* US = (const float*)(ws + WS_US); const float* VS = (const float*)(ws + WS_VS); float* ACT = (float*)(ws + WS_ACT);
    const bool two = t2 >= 0; const int tt[2] = {t, two ? t2 : t};
    float ss[2], d[2][2], gw[2][2], us[2][2], vs[2][2]; int id[2][2];
#pragma unroll
    for (int k = 0; k < 2; ++k) { ss[k] = lane < 32 ? SSP[(size_t)tt[k] * 32 + lane] : 0.f;
#pragma unroll
        for (int s = 0; s < 2; ++s) { const int slot = 64 * s + lane; id[k][s] = IDX[(size_t)tt[k] * 128 + slot]; gw[k][s] = GW[(size_t)tt[k] * 128 + slot]; float a = 0.f;
#pragma unroll
            for (int xg = 0; xg < 8; ++xg) a += PD[((size_t)xg * T_TOK + tt[k]) * 128 + slot];
            d[k][s] = a; } }
#pragma unroll
    for (int k = 0; k < 2; ++k)
#pragma unroll
        for (int s = 0; s < 2; ++s) { us[k][s] = US[id[k][s]]; vs[k][s] = VS[id[k][s]]; }
#pragma unroll
    for (int k = 0; k < 2; ++k) { const float rs = __builtin_amdgcn_rsqf(wave_sum(ss[k]) * (1.f / 2048.f) + RMS_EPS);
        if (k == 0 || two) {
#pragma unroll
            for (int s = 0; s < 2; ++s) ACT[(size_t)tt[k] * 128 + 64 * s + lane] = pg8::gelu_tanh_f(d[k][s] * us[k][s] * rs) * gw[k][s] * vs[k][s]; } }
}
#define PIN16(a) asm volatile("" : "+v"(a[0]), "+v"(a[1]), "+v"(a[2]), "+v"(a[3]), "+v"(a[4]), "+v"(a[5]), "+v"(a[6]), "+v"(a[7]), "+v"(a[8]), "+v"(a[9]), "+v"(a[10]), "+v"(a[11]), "+v"(a[12]), "+v"(a[13]), "+v"(a[14]), "+v"(a[15]))
__device__ __forceinline__ void peer_v_phase(const Params& P, int xg, int slot, int nslots, int lane) {
    unsigned char* ws = P.ws;
    const unsigned char* V8 = ws + WS_V8; const int* IDX = (const int*)(ws + WS_IDX); const float* ACT = (const float*)(ws + WS_ACT); bf16* OUTP = (bf16*)(ws + WS_OUTP);
    const int ntok = slot < T_TOK ? (T_TOK - slot + nslots - 1) / nslots : 0, N = 2 * ntok;
    if (N == 0) return;
    const int R = lane >> 3, p = lane & 7;
    const bool b5 = (lane & 32) != 0, b4 = (lane & 16) != 0, b3 = (lane & 8) != 0;
    int I0[16], I1[16], I2[16]; float A0[16], A1[16], A2[16]; v4u B0[8], B1[8], B2[8];
#define V_ITEM(n, t, s) const int n_##t = (n) < N ? (n) : N - 1; const int t = slot + (n_##t >= ntok ? n_##t - ntok : n_##t) * nslots, s = 2 * xg + (n_##t >= ntok ? 1 : 0)
#define V_ROWS(buf, ids, off, s) do { const unsigned char* vb_ = V8 + (size_t)(s) * NEXP * 128; _Pragma("unroll") for (int i = 0; i < 8; ++i) buf[i] = *(const v4u*)(vb_ + (unsigned)(((unsigned)ids[(off) + i] << 7) + 16u * p)); } while (0)
#define PIN8X2(a) asm volatile("" : "+v"(a[0]), "+v"(a[1]), "+v"(a[2]), "+v"(a[3]), "+v"(a[4]), "+v"(a[5]), "+v"(a[6]), "+v"(a[7]))
#define V_HALF(buf, av, off) do { _Pragma("unroll") for (int i = 0; i < 8; ++i) { asm volatile("" : "+v"(buf[i][0]), "+v"(buf[i][1]), "+v"(buf[i][2]), "+v"(buf[i][3])); \
            const f32x2_t av2 = (f32x2_t){av[(off) + i], av[(off) + i]}; \
            _Pragma("unroll") for (int w = 0; w < 4; ++w) { const f32x2_t lo = __builtin_amdgcn_cvt_pk_f32_fp8((int)buf[i][w], false), hi = __builtin_amdgcn_cvt_pk_f32_fp8((int)buf[i][w], true); \
                acc2[2 * w] = __builtin_elementwise_fma(lo, av2, acc2[2 * w]); acc2[2 * w + 1] = __builtin_elementwise_fma(hi, av2, acc2[2 * w + 1]); }        \
            PIN8X2(acc2); } } while (0)
    { V_ITEM(0, t0, s0); V_ITEM(1, t1, s1); V_ITEM(2, t2, s2); (void)s1; (void)s2;
      int id0[16];
      LD16I(id0, IDX + (size_t)t0 * 128 + 16 * R); LD16I(I0, IDX + (size_t)t1 * 128 + 16 * R); LD16I(I1, IDX + (size_t)t2 * 128 + 16 * R);
      LD16F(A0, ACT + (size_t)t0 * 128 + 16 * R); LD16F(A1, ACT + (size_t)t1 * 128 + 16 * R);
      V_ROWS(B0, id0, 0, s0); V_ROWS(B1, id0, 8, s0); }
#define V_BODY(n, Ba, Bb, Bc, Ia, Ib, Ic, Aa, Ab, Ac) do { \
        V_ITEM(n, t, s); V_ITEM((n) + 1, t1, s1); V_ITEM((n) + 2, t2, s2); V_ITEM((n) + 3, t3, s3); (void)s2; (void)s3; \
        V_ROWS(Bc, Ia, 0, s1); \
        LD16I(Ic, IDX + (size_t)t3 * 128 + 16 * R); LD16F(Ac, ACT + (size_t)t2 * 128 + 16 * R); \
        f32x2_t acc2[8]; \
        _Pragma("unroll") for (int k = 0; k < 8; ++k) acc2[k] = (f32x2_t){0.f, 0.f}; \
        V_HALF(Ba, Aa, 0); \
        V_ROWS(Ba, Ia, 8, s1); \
        V_HALF(Bb, Aa, 8); \
        float acc[16]; \
        _Pragma("unroll") for (int k = 0; k < 8; ++k) { acc[2 * k] = acc2[k][0]; acc[2 * k + 1] = acc2[k][1]; } \
        if ((n) < N) { \
            float a8[8], a4[4], a2[2]; \
            _Pragma("unroll") for (int k = 0; k < 8; ++k) { const float send = b5 ? acc[k] : acc[k + 8], keep = b5 ? acc[k + 8] : acc[k]; a8[k] = keep + __shfl_xor(send, 32); } \
            _Pragma("unroll") for (int k = 0; k < 4; ++k) { const float send = b4 ? a8[k] : a8[k + 4], keep = b4 ? a8[k + 4] : a8[k]; a4[k] = keep + __shfl_xor(send, 16); } \
            _Pragma("unroll") for (int k = 0; k < 2; ++k) { const float send = b3 ? a4[k] : a4[k + 2], keep = b3 ? a4[k + 2] : a4[k]; a2[k] = keep + __shfl_xor(send, 8); } \
            const int col = 128 * s + 16 * p + (b5 ? 8 : 0) + (b4 ? 4 : 0) + (b3 ? 2 : 0); \
            *(unsigned*)(OUTP + (size_t)t * DM + col) = cvtpk(a2[0], a2[1]); } } while (0)
    for (int n = 0; n < N; n += 3) { V_BODY(n, B0, B1, B2, I0, I1, I2, A0, A1, A2); V_BODY(n + 1, B2, B0, B1, I1, I2, I0, A1, A2, A0); V_BODY(n + 2, B1, B2, B0, I2, I0, I1, A2, A0, A1); }
#undef V_ITEM
#undef V_ROWS
#undef V_HALF
#undef V_BODY
}
__device__ __forceinline__ void peer_final_tokens(const Params& P, int t, int t2, int lane, float* outp) {
    const bool two = t2 >= 0; const int tt[2] = {t, two ? t2 : t};
    v4u a[2][4], b[2][4];
#pragma unroll
    for (int k = 0; k < 2; ++k) { const bf16* xrow = (const bf16*)(P.ws + WS_X1B) + (size_t)tt[k] * DM; const bf16* prow = (const bf16*)(P.ws + WS_OUTP) + (size_t)tt[k] * DM;
#pragma unroll
        for (int j = 0; j < 4; ++j) { a[k][j] = *(const v4u*)(xrow + 512 * j + 8 * lane); b[k][j] = *(const v4u*)(prow + 512 * j + 8 * lane); } }
#pragma unroll
    for (int k = 0; k < 2; ++k) { if (k == 1 && !two) break;
        float v[4][8]; float ss = 0.f;
#pragma unroll
        for (int j = 0; j < 4; ++j) {
#pragma unroll
            for (int i = 0; i < 4; ++i) { v[j][2 * i] = bf_lo(a[k][j][i]) + bf_lo(b[k][j][i]); v[j][2 * i + 1] = bf_hi(a[k][j][i]) + bf_hi(b[k][j][i]); }
#pragma unroll
            for (int i = 0; i < 8; ++i) ss += v[j][i] * v[j][i]; }
        const float rf = __builtin_amdgcn_rsqf(wave_sum(ss) * (1.f / 2048.f) + RMS_EPS);
        float* orow = outp + (size_t)tt[k] * DM;
#pragma unroll
        for (int j = 0; j < 4; ++j) { const f32x4 g0 = *(const f32x4*)(P.g_fin + 512 * j + 8 * lane), g1 = *(const f32x4*)(P.g_fin + 512 * j + 8 * lane + 4); f32x4 o0, o1;
#pragma unroll
            for (int i = 0; i < 4; ++i) { o0[i] = v[j][i] * rf * g0[i]; o1[i] = v[j][4 + i] * rf * g1[i]; }
            *(f32x4*)(orow + 512 * j + 8 * lane) = o0; *(f32x4*)(orow + 512 * j + 8 * lane + 4) = o1; } }
}

#ifndef MK_PER_PHASE
#define MK_PER_PHASE 0
#endif
constexpr int N_PHASES = 12;
constexpr int P8_NCONV = 32;
__global__ void __launch_bounds__(NWAVES * 64, 2) fwd_kernel(Params P) {
    extern __shared__ __attribute__((aligned(16))) unsigned char lds_raw[];
    LAS unsigned char* lds = (LAS unsigned char*)lds_raw;
    volatile LAS unsigned* MISC = (volatile LAS unsigned*)(lds + MISC_OFF);
    const int tid = threadIdx.x, lane = tid & 63, wave = __builtin_amdgcn_readfirstlane(tid >> 6);
    const int G = gridDim.x; const int bx = blockIdx.x;
    const int vcu = (G % 8 == 0) ? (bx % 8) * (G / 8) + bx / 8 : bx;
    const int gw = vcu * NWAVES + wave, NGW = G * NWAVES;
    unsigned char* ws = P.ws;
    gu32* ctl = (gu32*)(ws + WS_CTL);
    for (int u = tid; u < 64; u += NWAVES * 64) MISC[u] = 0u;
    __syncthreads();
    XcdBarrier bar; bar.bar = (unsigned*)ctl + CW_BAR; bar.x = 0; bar.st = nullptr;
    if (!MK_PER_PHASE) bar = xcd_barrier_post((unsigned*)ctl + CW_BAR, MISC + 8);
    const unsigned my_xcc = xb_xcc_id();
    if (!MK_PER_PHASE) { if (tid == 0) { MISC[16] = __hip_atomic_fetch_add((unsigned*)(ctl + CW_XC + 64 * (my_xcc & 7u)), 1u, __ATOMIC_RELAXED, __HIP_MEMORY_SCOPE_AGENT);
        if (bx >= P8_NCONV) MISC[17] = __hip_atomic_fetch_add((unsigned*)(ctl + CW_XC + 512 + 64 * (my_xcc & 7u)), 1u, __ATOMIC_RELAXED, __HIP_MEMORY_SCOPE_AGENT); } }
    const int lo = P.ph_lo, hi = P.ph_hi;
#define FRESH_IDS const int lane = (int)__builtin_amdgcn_mbcnt_hi(~0u, __builtin_amdgcn_mbcnt_lo(~0u, 0u)); const int tid = wave * 64 + lane; (void)tid; (void)lane
#ifndef PH_MASK
#define PH_MASK 0xfff
#endif
#define IN(k) (((PH_MASK >> (k)) & 1) && lo <= (k) && (k) < hi)
#define BOTH(k) (IN(k) && IN((k) + 1))
#ifndef DUP_MASK
#define DUP_MASK 0
#endif
#define NREP(k) (((DUP_MASK >> (k)) & 1) ? 2 : 1)
#define GRID_BAR() do { if (!MK_PER_PHASE) xcd_barrier(bar); } while (0)
#ifdef TPROBE
#define TP_T0 (wave == 0 && __builtin_amdgcn_mbcnt_hi(~0u, __builtin_amdgcn_mbcnt_lo(~0u, 0u)) == 0u)
#define TP_ORD(k) ((k) < 7 ? (k) : (k) - 1)
    if (TP_T0) MISC[40] = (unsigned)__builtin_amdgcn_s_memrealtime();
#define TP_STAMP(w) do { MISC[(w)] = (unsigned)__builtin_amdgcn_s_memrealtime(); } while (0)
#define GRID_BAR_K(k) do { xcd_barrier(bar); MISC[41 + TP_ORD(k)] = (unsigned)__builtin_amdgcn_s_memrealtime(); } while (0)
#else
#define TP_STAMP(w) do { } while (0)
#define GRID_BAR_K(k) GRID_BAR()
#endif

    bf16* HN = (bf16*)(ws + WS_HN); bf16* WA = (bf16*)(ws + WS_WA); bf16* WV = (bf16*)(ws + WS_WV); bf16* WB = (bf16*)(ws + WS_WB); bf16* WO = (bf16*)(ws + WS_WO); bf16* WQ = (bf16*)(ws + WS_WQ);

    constexpr int NV_UNITS = (AW / 256) * (T_TOK / 256);
    const bool tab_fast = (G > NV_UNITS && (1024 % G) == 0);
    const int tab_r1 = tab_fast ? 0 : NEXP;
    if (IN(0)) { FRESH_IDS; for (int rep = 0; rep < NREP(0); ++rep) p0_prologue(P, lds, gw, NGW, wave, lane, tab_r1); TP_STAMP(53); if (BOTH(0)) GRID_BAR_K(0); }

    if (IN(1)) { FRESH_IDS;
      _Pragma("unroll") for (int rep = 0; rep < NREP(1); ++rep) {
        { pg8::Gemm g{HN, WA, T_TOK, NWA, DM / 2, WV, HN, ws, (unsigned)WS_END}; pg8::StaticOrder2 S; S.init(T_TOK, NWA, AW, T_TOK, G, bx);
          pg8::EpiProj E{(bf16*)(ws + WS_Q), (bf16*)(ws + WS_K), (bf16*)(ws + WS_XR), (bf16*)(ws + WS_GY), (bf16*)(ws + WS_SG), (bf16*)(ws + WS_VT), rep == 0 ? (float*)(ws + WS_CTL) + CW_KM : nullptr, QSCALE, 1.f / W8SCALE};
          pg8::gemm_phase<pg8::EpiProj, pg8::StaticOrder2, true, true, true>(lds, g, S, E); }
        TP_STAMP(54);
        if (tab_fast && bx >= NV_UNITS) peer_table_u<2>(P, 0, NEXP, (bx - NV_UNITS) * NWAVES + wave, (G - NV_UNITS) * NWAVES, lane);
      }
        TP_STAMP(55); if (BOTH(1)) GRID_BAR_K(1);
    }

    if (IN(2)) { FRESH_IDS;
        LAS int* tick = (LAS int*)(lds + MISC_OFF + 128);
#define NEXT_TICKET(dst, word) do { __syncthreads(); if (tid == 0) *tick = (int)__hip_atomic_fetch_add((unsigned*)(ctl + (word)), 1u, __ATOMIC_RELAXED, __HIP_MEMORY_SCOPE_AGENT); __syncthreads(); dst = *tick; } while (0)
#define TICKET_ISSUE(word) do { if (tid == 0) tk_next = (int)__hip_atomic_fetch_add((unsigned*)(ctl + (word)), 1u, __ATOMIC_RELAXED, __HIP_MEMORY_SCOPE_AGENT); } while (0)
#define TICKET_TAKE(dst) do { __syncthreads(); if (tid == 0) *tick = tk_next; __syncthreads(); dst = *tick; } while (0)
        int tk_next = 0;
#ifndef DUP_ATT
#define DUP_ATT 0
#endif
#ifndef DUP_LRU
#define DUP_LRU 0
#endif
#ifndef DUP_P2
#define DUP_P2 0
#endif
        _Pragma("unroll") for (int rp = 0; rp < 1 + DUP_P2; ++rp) {
        _Pragma("unroll") for (int rep = 0; rep < 1 + DUP_ATT; ++rep) {
            int tid2 = tid; asm volatile("" : "+v"(tid2));
            int it; NEXT_TICKET(it, CW_Q2 + 64 * (rep + 2 * rp));
            while (it < 256) { const int blk = 7 - (it >> 5), bh = it & 31; attn_unit(P, lds, bh >> 3, bh & 7, blk, tid2, wave, tid2 & 63); NEXT_TICKET(it, CW_Q2 + 64 * (rep + 2 * rp)); } }
        TP_STAMP(56);
        _Pragma("unroll") for (int rep = 0; rep < 1 + DUP_LRU; ++rep) {
            int tid2 = tid; asm volatile("" : "+v"(tid2));
            int it; NEXT_TICKET(it, CW_Q2 + 256 + 64 * (rep + 2 * rp));
            while (it < 512) { lru_pair(P, lds, it, tid2, wave, tid2 & 63, (unsigned*)(ctl + CW_Q2 + 256 + 64 * (rep + 2 * rp)), tk_next); TICKET_TAKE(it); } }
        if (DUP_P2 && rp == 0) GRID_BAR();
        }
#undef NEXT_TICKET
#undef TICKET_ISSUE
#undef TICKET_TAKE
        TP_STAMP(57); if (BOTH(2)) GRID_BAR_K(2);
    }

    if (IN(3)) { FRESH_IDS;
      _Pragma("unroll") for (int rep = 0; rep < NREP(3); ++rep) {
        const unsigned* HLAC = (const unsigned*)(ws + WS_HL); const float* SUM = (const float*)(ws + WS_SUM);
        const bf16* GY = (const bf16*)(ws + WS_GY); unsigned char* OCAT = ws + WS_OCAT;
        for (int u = vcu; u < 256; u += G) { const int b = u >> 6, c = (u >> 1) & 31, C = (u & 1) * 512 + 4 * (tid & 127), tq = tid >> 7;
            f32x4 carry = (f32x4){0.f, 0.f, 0.f, 0.f};
            for (int c0 = 0; c0 < c; c0 += 8) {
                f32x4 s0[8], s1[8];
#pragma unroll
                for (int j = 0; j < 8; ++j) { const int cc = c0 + j < c ? c0 + j : c - 1; const float* sm = SUM + ((size_t)(b * 32 + cc) * 1024 + C) * 2; s0[j] = *(const f32x4*)sm; s1[j] = *(const f32x4*)(sm + 4); }
#pragma unroll
                for (int j = 0; j < 8; ++j) if (c0 + j < c) { carry[0] = s0[j][0] * carry[0] + s0[j][1]; carry[1] = s0[j][2] * carry[1] + s0[j][3]; carry[2] = s1[j][0] * carry[2] + s1[j][1]; carry[3] = s1[j][2] * carry[3] + s1[j][3]; } }
            const size_t R0 = (size_t)b * SEQ + c * 64 + tq * 16;
#pragma unroll 8
            for (int t = 0; t < 16; ++t) { const size_t o = (R0 + t) * AW + C; const v4u ha = *(const v4u*)(HLAC + o);
                const f32x4 hv = (f32x4){bf_lo(ha.x) + bf_hi(ha.x) * carry[0], bf_lo(ha.y) + bf_hi(ha.y) * carry[1], bf_lo(ha.z) + bf_hi(ha.z) * carry[2], bf_lo(ha.w) + bf_hi(ha.w) * carry[3]};
                const unsigned long long gy = *(const unsigned long long*)(GY + o); const unsigned g0 = (unsigned)gy, g1 = (unsigned)(gy >> 32);
                int p = __builtin_amdgcn_cvt_pk_fp8_f32(clamp8(hv[0] * bf_lo(g0) * OC8SCALE), clamp8(hv[1] * bf_hi(g0) * OC8SCALE), 0, false); p = __builtin_amdgcn_cvt_pk_fp8_f32(clamp8(hv[2] * bf_lo(g1) * OC8SCALE), clamp8(hv[3] * bf_hi(g1) * OC8SCALE), p, true);
                *(unsigned*)(OCAT + (R0 + t) * DM + AW + C) = (unsigned)p; } }
      }
        TP_STAMP(58); if (BOTH(3)) GRID_BAR_K(3);
    }

    if (IN(4)) { FRESH_IDS;
      _Pragma("unroll") for (int rep = 0; rep < NREP(4); ++rep) {
        { pg8::Gemm g{(bf16*)(ws + WS_OCAT), WB, T_TOK, DM, DM / 2, nullptr, nullptr, ws, (unsigned)WS_END}; pg8::StaticOrder S; S.init(T_TOK, DM, G, bx);
          pg8::EpiMerge2 E{(const bf16*)(ws + WS_SG), (bf16*)(ws + WS_MG), MG8SCALE / (OC8SCALE * WB8SCALE)};
          pg8::gemm_phase<pg8::EpiMerge2, pg8::StaticOrder, true, true, true>(lds, g, S, E); }
      }
        if (BOTH(4)) GRID_BAR_K(4);
    }

    if (IN(5)) { FRESH_IDS;
      _Pragma("unroll") for (int rep = 0; rep < NREP(5); ++rep) {
        pg8::Gemm g{(bf16*)(ws + WS_MG), WO, T_TOK, DM, DM / 2, nullptr, nullptr, ws, (unsigned)WS_END}; pg8::StaticOrder S; S.init(T_TOK, DM, G, bx);
        pg8::EpiResid E{P.x, (bf16*)(ws + WS_X1B), (float*)(ws + WS_SSP), 1.f / (W8SCALE * MG8SCALE)};
        pg8::gemm_phase<pg8::EpiResid, pg8::StaticOrder, true, true, true>(lds, g, S, E);
      }
        if (BOTH(5)) GRID_BAR_K(5);
    }

    if (IN(6)) { FRESH_IDS;
      _Pragma("unroll") for (int rep = 0; rep < NREP(6); ++rep) {
        pg8::Gemm g{(bf16*)(ws + WS_X1B), WQ, T_TOK, DM, DM, nullptr, nullptr, ws, (unsigned)WS_END}; pg8::StaticOrder S; S.init(T_TOK, DM, G, bx);
        pg8::EpiRowScale E{(const float*)(ws + WS_SSP), (bf16*)(ws + WS_QP)};
        pg8::gemm_phase<pg8::EpiRowScale, pg8::StaticOrder, true, true>(lds, g, S, E);
        TP_STAMP(59);
        { pg8::Unit u; for (int i = 0; S.next(i, u); ++i) { peer_topk_unit(P, lds, u.pm * 256, u.pn, tid, wave, lane); peer_topk_unit(P, lds, u.pm * 256 + 128, u.pn, tid, wave, lane); } }
      }
        TP_STAMP(60); if (BOTH(6)) GRID_BAR_K(6);
    }

    int xg = bx & 7, nblk_g = (G - xg + 7) >> 3, rank_g = bx >> 3;
    if (!MK_PER_PHASE && lo == 0 && hi > 8) {
        unsigned cnt[8], sum = 0u; bool ok = my_xcc < 8u;
#pragma unroll
        for (int j = 0; j < 8; ++j) { cnt[j] = __hip_atomic_load((unsigned*)(ctl + CW_XC + 64 * j), __ATOMIC_RELAXED, __HIP_MEMORY_SCOPE_AGENT); sum += cnt[j]; ok = ok && cnt[j] > 0u; }
        if (ok && sum == (unsigned)G) { xg = (int)my_xcc; rank_g = (int)MISC[16];
            nblk_g = (int)(xg == 0 ? cnt[0] : xg == 1 ? cnt[1] : xg == 2 ? cnt[2] : xg == 3 ? cnt[3] : xg == 4 ? cnt[4] : xg == 5 ? cnt[5] : xg == 6 ? cnt[6] : cnt[7]); }
    }
    const int nslots = nblk_g * NWAVES, slot = rank_g * NWAVES + wave;
    const int nconv = tab_fast ? P8_NCONV : 0;
    int xg8 = bx & 7, nblk8 = ((G - xg8 + 7) >> 3) - nconv / 8, rank8 = (bx >> 3) - nconv / 8;
    if (!MK_PER_PHASE && lo == 0 && hi > 8 && nconv > 0) {
        unsigned cnt[8], sum = 0u; bool ok = my_xcc < 8u;
#pragma unroll
        for (int j = 0; j < 8; ++j) { cnt[j] = __hip_atomic_load((unsigned*)(ctl + CW_XC + 512 + 64 * j), __ATOMIC_RELAXED, __HIP_MEMORY_SCOPE_AGENT); sum += cnt[j]; ok = ok && cnt[j] > 0u; }
        if (ok && sum == (unsigned)(G - nconv)) { xg8 = (int)my_xcc; rank8 = (int)MISC[17];
            nblk8 = (int)(xg8 == 0 ? cnt[0] : xg8 == 1 ? cnt[1] : xg8 == 2 ? cnt[2] : xg8 == 3 ? cnt[3] : xg8 == 4 ? cnt[4] : xg8 == 5 ? cnt[5] : xg8 == 6 ? cnt[6] : cnt[7]); }
    }
    if (IN(8)) { FRESH_IDS;
        _Pragma("unroll") for (int rep = 0; rep < NREP(8); ++rep) {
        if (bx < nconv) peer_table_v<4>(P, 0, NEXP, bx * NWAVES + wave, nconv * NWAVES, lane);
        else peer_u_phase(P, xg8, rank8 * NWAVES + wave, nblk8 * NWAVES, lane); }
        TP_STAMP(61); if (BOTH(8)) GRID_BAR_K(8);
    }
#ifdef EXTRA_BARS
    for (int eb = 0; eb < EXTRA_BARS; ++eb) GRID_BAR();
#endif
    if (IN(9)) { FRESH_IDS;
        for (int t = gw; t < T_TOK; t += 2 * NGW) peer_act_tokens(P, t, t + NGW < T_TOK ? t + NGW : -1, lane);
        if (BOTH(9)) GRID_BAR_K(9);
    }
    if (IN(10)) { FRESH_IDS;
        _Pragma("unroll") for (int rep = 0; rep < NREP(10); ++rep)
        peer_v_phase(P, xg, slot, nslots, lane);
        TP_STAMP(62); if (BOTH(10)) GRID_BAR_K(10);
    }
    if (IN(11)) { FRESH_IDS;
        if (NREP(11) == 2) for (int t = gw; t < T_TOK; t += 2 * NGW) peer_final_tokens(P, t, t + NGW < T_TOK ? t + NGW : -1, lane, (float*)(ws + WS_MG));
        for (int t = gw; t < T_TOK; t += 2 * NGW) peer_final_tokens(P, t, t + NGW < T_TOK ? t + NGW : -1, lane, P.out);
    }
#ifdef TPROBE
    { GRID_BAR_K(11);
      gu32* tpw = (gu32*)(P.ws + WS_CTL) + 16384;
      if (TP_T0) { const int j = (int)__hip_atomic_load((unsigned*)tpw + 64, __ATOMIC_RELAXED, __HIP_MEMORY_SCOPE_AGENT); const unsigned val = j < 11 ? MISC[41 + j] - MISC[40 + j] : (j >= 4096 ? MISC[(j >> 6) & 63] - MISC[j & 63] : 0u);
          __hip_atomic_fetch_add((unsigned*)tpw, val, __ATOMIC_RELAXED, __HIP_MEMORY_SCOPE_AGENT); }
      GRID_BAR();
      const unsigned tot = __hip_atomic_load((unsigned*)tpw, __ATOMIC_RELAXED, __HIP_MEMORY_SCOPE_AGENT), avg = (unsigned)__builtin_amdgcn_readfirstlane((int)(tot >> 8));
      const unsigned ts = (unsigned)__builtin_amdgcn_s_memrealtime();
      while ((unsigned)__builtin_amdgcn_s_memrealtime() - ts < avg) __builtin_amdgcn_s_sleep(1); }
#endif
#undef IN
#undef BOTH
#undef GRID_BAR
}

extern "C" void kernel_launch(void* const* d_in, const int* in_sizes, int n_in, void* d_out, int out_size, void* d_ws, size_t ws_size, hipStream_t stream) {
    static int grid = 0;
    if (grid == 0) {
        if (n_in != 19 || out_size != T_TOK * DM || ws_size < WS_END) { fprintf(stderr, "kernel_launch: unexpected problem (n_in %d, out %d, ws %zu); nothing launched\n", n_in, out_size, ws_size); grid = -1; return; }
        int dev = 0, cus = 0, per_cu = 0;
        if (hipGetDevice(&dev) != hipSuccess || hipDeviceGetAttribute(&cus, hipDeviceAttributeMultiprocessorCount, dev) != hipSuccess) { grid = -1; return; }
        if (hipFuncSetAttribute((const void*)fwd_kernel, hipFuncAttributeMaxDynamicSharedMemorySize, LDS_BYTES) != hipSuccess) { fprintf(stderr, "kernel_launch: hipFuncSetAttribute failed\n"); grid = -1; return; }
        if (hipOccupancyMaxActiveBlocksPerMultiprocessor(&per_cu, (const void*)fwd_kernel, NWAVES * 64, LDS_BYTES) != hipSuccess || per_cu < 1) { fprintf(stderr, "kernel_launch: occupancy query says %d blocks per CU\n", per_cu); }
        (void)hipGetLastError();
        grid = cus;
    }
    if (grid < 0) return;
    if (hipMemsetAsync((char*)d_ws + WS_CTL, 0, CTL_ZERO_BYTES, stream) != hipSuccess) return;
#ifdef TPROBE
    if (hipMemsetD32Async((hipDeviceptr_t)((char*)d_ws + WS_CTL + 4 * (16384 + 64)), TPROBE, 1, stream) != hipSuccess) return;
#endif
    Params p{};
    const float** pp = (const float**)&p;
    for (int i = 0; i < 19; ++i) pp[i] = (const float*)d_in[i];
    p.out = (float*)d_out; p.ws = (unsigned char*)d_ws;
#if MK_PER_PHASE
    for (int ph = 0; ph < N_PHASES; ++ph) { p.ph_lo = ph; p.ph_hi = ph + 1; hipLaunchKernelGGL(fwd_kernel, dim3(grid), dim3(NWAVES * 64), LDS_BYTES, stream, p); }
#else
    p.ph_lo = 0; p.ph_hi = N_PHASES;
    hipLaunchKernelGGL(fwd_kernel, dim3(grid), dim3(NWAVES * 64), LDS_BYTES, stream, p);
#endif
}
```

```cpp
#include <hip/hip_runtime.h>
#include <cstdio>
#include <cstdint>
namespace pg8 {
#define PG8_LAS __attribute__((address_space(3)))
typedef unsigned short bf16_t;
typedef short bf16x8 __attribute__((ext_vector_type(8)));
typedef float f32x4 __attribute__((ext_vector_type(4)));
typedef unsigned u32x4 __attribute__((ext_vector_type(4)));
typedef int i32x4 __attribute__((ext_vector_type(4)));
typedef int i32x8 __attribute__((ext_vector_type(8)));
__device__ __forceinline__ i32x8 cat8(bf16x8 a, bf16x8 b) { return __builtin_shufflevector(__builtin_bit_cast(i32x4, a), __builtin_bit_cast(i32x4, b), 0, 1, 2, 3, 4, 5, 6, 7); }
constexpr int BM = 256, BK = 64, HALF = 128, HTB = HALF * BK * 2  , STAGE_BYTES = 8 * HTB, NXCD = 8, WGM = 8;

__host__ __device__ __forceinline__ int lds_byte(int r, int c) { const int st = (r >> 4) * 2 + (c >> 5), rr = r & 15, cc = c & 31, ob = rr * 64 + cc * 2; return st * 1024 + (ob ^ (((ob >> 9) & 1) << 5)); }
__host__ __device__ __forceinline__ void stage_rc(int b, int& R, int& C) { const int st = b / 1024, sb = b % 1024, swz = sb ^ (((sb >> 9) & 1) << 5); R = (st >> 1) * 16 + swz / 64; C = (st & 1) * 32 + (swz % 64) / 2; }
__host__ __device__ __forceinline__ int perm32(int rho) { const int n = rho >> 4, i = rho & 15; return 8 * (i >> 2) + 4 * n + (i & 3); }

struct Unit { int pm, pn, sel; };
struct Gemm { const bf16_t* A; const bf16_t* Bt; int M, N, K; const bf16_t* A2; const bf16_t* Bt2; const void* rbase; unsigned rbytes; };

struct StaticOrder {
    int nM, nN, nwg, G, c;
    __host__ __device__ __forceinline__ void init(int M, int N, int G_, int c_) { nM = M / BM; nN = N / BM; nwg = nM * nN; G = G_; c = c_; }
    __host__ __device__ __forceinline__ bool next(int i, Unit& u) const {
        const long L = (long)i * G + c; if (L >= nwg) return false;
        int wgid = (int)L; { const int q = nwg / NXCD, r = nwg % NXCD, xcd = wgid % NXCD, off = wgid / NXCD; wgid = (xcd < r ? xcd * (q + 1) : r * (q + 1) + (xcd - r) * q) + off; }
        const int nig = WGM * nN, gid = wgid / nig, fm = gid * WGM, gsz = (nM - fm) < WGM ? (nM - fm) : WGM;
        u.pm = fm + ((wgid % nig) % gsz); u.pn = (wgid % nig) / gsz; u.sel = 0; return true;
    }
    __device__ __forceinline__ void a_ready(const Unit&) const {}
    __device__ __forceinline__ void done(const Unit&) const {}
};

struct StaticOrder2 {
    StaticOrder s0, s1; int G, c;
    __host__ __device__ __forceinline__ void init(int M0, int N0, int M1, int N1, int G_, int c_) { s0.init(M0, N0, 1, 0); s1.init(M1, N1, 1, 0); G = G_; c = c_; }
    __host__ __device__ __forceinline__ bool next(int i, Unit& u) const {
        const long L = (long)i * G + c;
        if (L < s0.nwg) return s0.next((int)L, u);
        if (L < s0.nwg + s1.nwg) { const bool ok = s1.next((int)(L - s0.nwg), u); u.sel = 1; return ok; }
        return false;
    }
    __device__ __forceinline__ void a_ready(const Unit&) const {}
    __device__ __forceinline__ void done(const Unit&) const {}
};

__device__ __forceinline__ unsigned cvt_pk_bf16(float lo, float hi) { unsigned r; asm volatile("v_cvt_pk_bf16_f32 %0, %1, %2" : "=v"(r) : "v"(lo), "v"(hi)); return r; }
typedef float f32x2 __attribute__((ext_vector_type(2)));
constexpr long X18_DELTA = (long)(432 - 192) * 1048576;
constexpr float QP_OSCALE = 1.f / (16.f * 64.f);
__device__ __forceinline__ float c8(float v) { return __builtin_fminf(__builtin_fmaxf(v, -448.f), 448.f); }
__device__ __forceinline__ float sigmoid_f(float v) { return __builtin_amdgcn_rcpf(1.f + __builtin_amdgcn_exp2f(-1.4426950408889634f * v)); }
__device__ __forceinline__ float gelu_tanh_f(float v) { const float z = 1.5957691216057308f * (v + 0.044715f * v * v * v); return v * __builtin_amdgcn_rcpf(1.f + __builtin_amdgcn_exp2f(-1.4426950408889634f * z)); }
__device__ __forceinline__ u32x4 pack8(const f32x4& v0, const f32x4& v1) { u32x4 w; w.x = cvt_pk_bf16(v0[0], v0[1]); w.y = cvt_pk_bf16(v0[2], v0[3]); w.z = cvt_pk_bf16(v1[0], v1[1]); w.w = cvt_pk_bf16(v1[2], v1[3]); return w; }
__device__ __forceinline__ f32x4 bf4_lo(unsigned a, unsigned b) { f32x4 r; r[0] = __builtin_bit_cast(float, a << 16); r[1] = __builtin_bit_cast(float, a & 0xffff0000u); r[2] = __builtin_bit_cast(float, b << 16); r[3] = __builtin_bit_cast(float, b & 0xffff0000u); return r; }

template <size_t OQ, size_t OK, size_t OXR, size_t OGY, size_t OSG, size_t OVT, size_t OKM> struct EpiProjT {
    static constexpr bool PERM = true, AFTER_DRAIN = false, MIDK = false;
    unsigned char* wsb; bool km_on; float qscale, oscale;
    __device__ __forceinline__ void operator()(const f32x4 (&acc)[2][2][4][2], const Unit& u, int wr, int wc, int fr, int fq) const {
        { const int l_ = (int)__builtin_amdgcn_mbcnt_hi(~0u, __builtin_amdgcn_mbcnt_lo(~0u, 0u)); fr = l_ & 15; fq = l_ >> 4; }
        bf16_t* const Q = (bf16_t*)(wsb + OQ); bf16_t* const K = (bf16_t*)(wsb + OK); bf16_t* const XR = (bf16_t*)(wsb + OXR); bf16_t* const GY = (bf16_t*)(wsb + OGY); bf16_t* const SG = (bf16_t*)(wsb + OSG); bf16_t* const VT = (bf16_t*)(wsb + OVT);
        float* const KM = km_on ? (float*)(wsb + OKM) : nullptr;
        const int pn = u.pn; int kind, ldc, colt; bf16_t* base;
        if (u.sel) { kind = 2; base = VT; ldc = 8192; colt = pn * 256; }
        else if (pn < 4) { kind = 0; base = Q; ldc = 1024; colt = pn * 256; }
        else if (pn < 8) { kind = 1; base = K; ldc = 1024; colt = (pn - 4) * 256; }
        else if (pn < 12) { kind = 2; base = XR; ldc = 1024; colt = (pn - 8) * 256; }
        else if (pn < 16) { kind = 3; base = GY; ldc = 1024; colt = (pn - 12) * 256; }
        else { kind = 4; base = SG; ldc = 4096; colt = (pn - 16) * 256; }
        const int row0 = u.pm * BM + wr * 64 + fr, col0 = colt + wc * 32 + 8 * fq;
#pragma unroll
        for (int ai = 0; ai < 2; ++ai)
#pragma unroll
            for (int m = 0; m < 4; ++m) { bf16_t* rowp = base + (size_t)(row0 + ai * HALF + m * 16) * ldc + col0;
#pragma unroll
                for (int bj = 0; bj < 2; ++bj) { f32x4 v0 = acc[ai][bj][m][0] * oscale, v1 = acc[ai][bj][m][1] * oscale;
                    if (kind == 0) { v0 = v0 * qscale; v1 = v1 * qscale; }
                    else if (kind == 3) {
#pragma unroll
                        for (int e = 0; e < 4; ++e) { v0[e] = gelu_tanh_f(v0[e]); v1[e] = gelu_tanh_f(v1[e]); } }
                    else if (kind == 4) {
                        unsigned w0 = 0u, w1 = 0u;
#pragma unroll
                        for (int e = 0; e < 4; ++e) { const unsigned q0 = (unsigned)fmaxf(sigmoid_f(v0[e]) * 255.f + 0.5f, 1.f), q1 = (unsigned)fmaxf(sigmoid_f(v1[e]) * 255.f + 0.5f, 1.f); w0 |= q0 << (8 * e); w1 |= q1 << (8 * e); }
                        *(unsigned long long*)((unsigned char*)SG + (size_t)(row0 + ai * HALF + m * 16) * 4096 + col0 + bj * HALF) = (unsigned long long)w0 | ((unsigned long long)w1 << 32);
                        continue; }
                    *(u32x4*)(rowp + bj * HALF) = pack8(v0, v1); } }
        if (kind == 1 && KM != nullptr) {
            const int b = u.pm >> 3, blk = u.pm & 7;
#pragma unroll
            for (int bj = 0; bj < 2; ++bj)
#pragma unroll
                for (int n = 0; n < 2; ++n) { f32x4 s = (f32x4){0.f, 0.f, 0.f, 0.f};
#pragma unroll
                    for (int ai = 0; ai < 2; ++ai)
#pragma unroll
                        for (int m = 0; m < 4; ++m) s = s + acc[ai][bj][m][n];
#pragma unroll
                    for (int e = 0; e < 4; ++e) { float v = s[e]; v += __shfl_xor(v, 1); v += __shfl_xor(v, 2); v += __shfl_xor(v, 4); v += __shfl_xor(v, 8); s[e] = v; }
                    if (fr == 0) { const int c = colt + bj * HALF + wc * 32 + 8 * fq + 4 * n;
                        float* dst = KM + ((size_t)((b * 8 + (c >> 7)) * 8 + blk)) * 128 + (c & 127);
#pragma unroll
                        for (int e = 0; e < 4; ++e) atomicAdd(dst + e, s[e] * oscale); } }
        }
    }
};
struct EpiStore {
    static constexpr bool PERM = true, AFTER_DRAIN = false, MIDK = false;
    bf16_t* O; int ldc;
    __device__ __forceinline__ void operator()(const f32x4 (&acc)[2][2][4][2], const Unit& u, int wr, int wc, int fr, int fq) const {
        { const int l_ = (int)__builtin_amdgcn_mbcnt_hi(~0u, __builtin_amdgcn_mbcnt_lo(~0u, 0u)); fr = l_ & 15; fq = l_ >> 4; }
        const int row0 = u.pm * BM + wr * 64 + fr, col0 = u.pn * BM + wc * 32 + 8 * fq;
#pragma unroll
        for (int ai = 0; ai < 2; ++ai)
#pragma unroll
            for (int m = 0; m < 4; ++m) { bf16_t* rowp = O + (size_t)(row0 + ai * HALF + m * 16) * ldc + col0;
#pragma unroll
                for (int bj = 0; bj < 2; ++bj) *(u32x4*)(rowp + bj * HALF) = pack8(acc[ai][bj][m][0], acc[ai][bj][m][1]); }
    }
};
template <size_t OSG, size_t OMG> struct EpiMerge2T {
    static constexpr bool PERM = true, AFTER_DRAIN = false, MIDK = true;
    unsigned char* wsb; float mgscale;
    __device__ __forceinline__ void midk(f32x4 (&acc)[2][2][4][2], const Unit& u, int wr, int wc, int fr, int fq) const {
        const bf16_t* const SG = (const bf16_t*)(wsb + OSG);
        int row0 = u.pm * BM + wr * 64 + fr, col0 = u.pn * BM + wc * 32 + 8 * fq;
        asm volatile("" : "+v"(row0), "+v"(col0));
#pragma unroll
        for (int ai = 0; ai < 2; ++ai)
#pragma unroll
            for (int m = 0; m < 4; ++m) { const size_t row = (size_t)(row0 + ai * HALF + m * 16);
#pragma unroll
                for (int bj = 0; bj < 2; ++bj) { const int col = col0 + bj * HALF;
                    const unsigned long long g0 = *(const unsigned long long*)((const unsigned char*)SG + row * 4096 + col), g1 = *(const unsigned long long*)((const unsigned char*)SG + row * 4096 + 2048 + col);
                    const unsigned g0l = (unsigned)g0, g0h = (unsigned)(g0 >> 32), g1l = (unsigned)g1, g1h = (unsigned)(g1 >> 32);
#pragma unroll
                    for (int e2 = 0; e2 < 4; ++e2) { acc[ai][bj][m][0][e2] *= (float)((g0l >> (8 * e2)) & 255u) * __builtin_amdgcn_rcpf((float)((g1l >> (8 * e2)) & 255u));
                        acc[ai][bj][m][1][e2] *= (float)((g0h >> (8 * e2)) & 255u) * __builtin_amdgcn_rcpf((float)((g1h >> (8 * e2)) & 255u)); } } }
    }
    __device__ __forceinline__ void operator()(const f32x4 (&acc)[2][2][4][2], const Unit& u, int wr, int wc, int fr, int fq) const {
        const bf16_t* const SG = (const bf16_t*)(wsb + OSG); bf16_t* const MG = (bf16_t*)(wsb + OMG);
        { const int l_ = (int)__builtin_amdgcn_mbcnt_hi(~0u, __builtin_amdgcn_mbcnt_lo(~0u, 0u)); fr = l_ & 15; fq = l_ >> 4; }
        const int row0 = u.pm * BM + wr * 64 + fr, col0 = u.pn * BM + wc * 32 + 8 * fq;
#pragma unroll
        for (int ai = 0; ai < 2; ++ai)
#pragma unroll
            for (int m = 0; m < 4; ++m) { const size_t row = (size_t)(row0 + ai * HALF + m * 16);
#pragma unroll
                for (int bj = 0; bj < 2; ++bj) { const int col = col0 + bj * HALF;
                    const unsigned long long g1 = *(const unsigned long long*)((const unsigned char*)SG + row * 4096 + 2048 + col); const unsigned g1l = (unsigned)g1, g1h = (unsigned)(g1 >> 32);
                    const float ms = mgscale * (1.f / 255.f);
                    const f32x4 s0 = (f32x4){(float)(g1l & 255u), (float)((g1l >> 8) & 255u), (float)((g1l >> 16) & 255u), (float)(g1l >> 24)}, s1 = (f32x4){(float)(g1h & 255u), (float)((g1h >> 8) & 255u), (float)((g1h >> 16) & 255u), (float)(g1h >> 24)};
                    const f32x4 v0 = acc[ai][bj][m][0] * s0 * ms, v1 = acc[ai][bj][m][1] * s1 * ms;
                    int p0 = __builtin_amdgcn_cvt_pk_fp8_f32(c8(v0[0]), c8(v0[1]), 0, false); p0 = __builtin_amdgcn_cvt_pk_fp8_f32(c8(v0[2]), c8(v0[3]), p0, true);
                    int p1 = __builtin_amdgcn_cvt_pk_fp8_f32(c8(v1[0]), c8(v1[1]), 0, false); p1 = __builtin_amdgcn_cvt_pk_fp8_f32(c8(v1[2]), c8(v1[3]), p1, true);
                    *(unsigned long long*)((unsigned char*)MG + row * 2048 + col) = (unsigned long long)(unsigned)p0 | ((unsigned long long)(unsigned)p1 << 32); } }
    }
};
struct EpiResid {
    static constexpr bool PERM = true, AFTER_DRAIN = false, MIDK = false;
    const float* X; bf16_t* X1B; float* SSP; float oscale;
    __device__ __forceinline__ void operator()(const f32x4 (&acc)[2][2][4][2], const Unit& u, int wr, int wc, int fr, int fq) const {
        { const int l_ = (int)__builtin_amdgcn_mbcnt_hi(~0u, __builtin_amdgcn_mbcnt_lo(~0u, 0u)); fr = l_ & 15; fq = l_ >> 4; }
        const int row0 = u.pm * BM + wr * 64 + fr, col0 = u.pn * BM + wc * 32 + 8 * fq;
#pragma unroll
        for (int ai = 0; ai < 2; ++ai)
#pragma unroll
            for (int m = 0; m < 4; ++m) { const size_t row = (size_t)(row0 + ai * HALF + m * 16); float ss = 0.f;
#pragma unroll
                for (int bj = 0; bj < 2; ++bj) { const int col = col0 + bj * HALF; const float* xp = X + row * 2048 + col;
                    f32x4 v0 = acc[ai][bj][m][0] * oscale + *(const f32x4*)xp, v1 = acc[ai][bj][m][1] * oscale + *(const f32x4*)(xp + 4);
                    *(u32x4*)(X1B + row * 2048 + col) = pack8(v0, v1);
                    { int p0 = __builtin_amdgcn_cvt_pk_fp8_f32(c8(v0[0] * 16.f), c8(v0[1] * 16.f), 0, false); p0 = __builtin_amdgcn_cvt_pk_fp8_f32(c8(v0[2] * 16.f), c8(v0[3] * 16.f), p0, true);
                      int p1 = __builtin_amdgcn_cvt_pk_fp8_f32(c8(v1[0] * 16.f), c8(v1[1] * 16.f), 0, false); p1 = __builtin_amdgcn_cvt_pk_fp8_f32(c8(v1[2] * 16.f), c8(v1[3] * 16.f), p1, true);
                      *(unsigned long long*)((unsigned char*)X1B + X18_DELTA + row * 2048 + col) = (unsigned long long)(unsigned)p0 | ((unsigned long long)(unsigned)p1 << 32); }
                    ss += (v0[0] * v0[0] + v0[1] * v0[1]) + (v0[2] * v0[2] + v0[3] * v0[3]) + (v1[0] * v1[0] + v1[1] * v1[1]) + (v1[2] * v1[2] + v1[3] * v1[3]); }
                ss += __shfl_xor(ss, 16); ss += __shfl_xor(ss, 32);
                if (fq == 0) SSP[row * 32 + u.pn * 4 + wc] = ss; }
    }
};
struct EpiRowScale {
    static constexpr bool PERM = true, AFTER_DRAIN = false, MIDK = false;
    const float* SSP; bf16_t* O;
    __device__ __forceinline__ void operator()(const f32x4 (&acc)[2][2][4][2], const Unit& u, int wr, int wc, int fr, int fq) const {
        int l_ = (int)__builtin_amdgcn_mbcnt_hi(~0u, __builtin_amdgcn_mbcnt_lo(~0u, 0u)); asm volatile("" : "+v"(l_)); fr = l_ & 15; fq = l_ >> 4;
        const int x16_ = (l_ ^ 16) << 2, x32_ = (l_ ^ 32) << 2;
        const int row0 = u.pm * BM + wr * 64 + fr, col0 = u.pn * BM + wc * 32 + 8 * fq;
#pragma unroll
        for (int ai = 0; ai < 2; ++ai)
#pragma unroll
            for (int m = 0; m < 4; ++m) { const size_t row = (size_t)(row0 + ai * HALF + m * 16);
                const f32x4 a = *(const f32x4*)(SSP + row * 32 + 8 * fq), b = *(const f32x4*)(SSP + row * 32 + 8 * fq + 4);
                float ss = (a[0] + a[1]) + (a[2] + a[3]) + (b[0] + b[1]) + (b[2] + b[3]);
                ss += __builtin_bit_cast(float, __builtin_amdgcn_ds_bpermute(x16_, __builtin_bit_cast(int, ss))); ss += __builtin_bit_cast(float, __builtin_amdgcn_ds_bpermute(x32_, __builtin_bit_cast(int, ss)));
                const float rs = __builtin_amdgcn_rsqf(ss * (1.f / 2048.f) + 1e-6f) * QP_OSCALE;
#pragma unroll
                for (int bj = 0; bj < 2; ++bj) *(u32x4*)(O + row * 2048 + col0 + bj * HALF) = pack8(acc[ai][bj][m][0] * rs, acc[ai][bj][m][1] * rs); }
    }
};
template <class Epi, class Sched, bool ALIGN_EPI = false, bool SP2 = false, bool FP8 = false>
__device__ __forceinline__ void gemm_phase(PG8_LAS unsigned char* lds, const Gemm g, const Sched& S, const Epi& E) {
    const int tid = threadIdx.x, wid = __builtin_amdgcn_readfirstlane(tid >> 6), lane = tid & 63, wr = wid >> 2, wc = wid & 3, fr = lane & 15, fq = lane >> 4;
    const int K = g.K, nt = K / BK;
    const __amdgpu_buffer_rsrc_t rsrc = __builtin_amdgcn_make_buffer_rsrc((void*)g.rbase, 0, (int)g.rbytes, 0x00020000);
    unsigned voffA[2], voffB[2];
#pragma unroll
    for (int i = 0; i < 2; ++i) { int R, C; stage_rc(tid * 16 + i * 8192, R, C); const int Rb = Epi::PERM ? ((R & ~31) + perm32(R & 31)) : R;
        voffA[i] = (unsigned)(R * K + C) * 2u; voffB[i] = (unsigned)(Rb * K + C) * 2u; }
    const size_t kstep = (size_t)(BK * 2);
    const size_t hstep = (size_t)HALF * K * 2;
    const size_t tstep = 2 * hstep;
    const unsigned ldsw = (unsigned)wid * 1024u;
    const int aoff = lds_byte(wr * 64 + fr, fq * 8), boff = lds_byte(wc * 32 + fr, fq * 8);
#define PG8_SA(b, h) (((b) * 2 + (h)) * HTB)
#define PG8_SB(b, h) ((4 + (b) * 2 + (h)) * HTB)
#define PG8_STAGE(bufoff, gbase, voff) do { const unsigned so_ = (unsigned)((const char*)(gbase) - (const char*)g.rbase); _Pragma("unroll") for (int _i = 0; _i < 2; ++_i) \
        __builtin_amdgcn_raw_ptr_buffer_load_lds(rsrc, (PG8_LAS unsigned*)(lds + (bufoff) + ldsw + _i * 8192), 16, (voff)[_i], so_, 0, 0); } while (0)
#define PG8_LDA(dst, b, h) do { _Pragma("unroll") for (int m = 0; m < 4; ++m) { const PG8_LAS unsigned char* p_ = lds + PG8_SA(b, h) + aoff + m * 2048; \
        if constexpr (FP8) dst##8[m] = cat8(*(const PG8_LAS bf16x8*)p_, *(const PG8_LAS bf16x8*)(p_ + 1024)); else { dst[m][0] = *(const PG8_LAS bf16x8*)p_; dst[m][1] = *(const PG8_LAS bf16x8*)(p_ + 1024); } } } while (0)
#define PG8_LDB(dst, b, h) do { _Pragma("unroll") for (int n = 0; n < 2; ++n) { const PG8_LAS unsigned char* p_ = lds + PG8_SB(b, h) + boff + n * 2048; \
        if constexpr (FP8) dst##8[n] = cat8(*(const PG8_LAS bf16x8*)p_, *(const PG8_LAS bf16x8*)(p_ + 1024)); else { dst[n][0] = *(const PG8_LAS bf16x8*)p_; dst[n][1] = *(const PG8_LAS bf16x8*)(p_ + 1024); } } } while (0)
#define PG8_MMA(ai, bj, At, Bt) do { __builtin_amdgcn_s_setprio(1); _Pragma("unroll") for (int m = 0; m < 4; ++m) _Pragma("unroll") for (int n = 0; n < 2; ++n) { \
        if constexpr (FP8) acc[ai][bj][m][n] = __builtin_amdgcn_mfma_scale_f32_16x16x128_f8f6f4(Bt##8[n], At##8[m], acc[ai][bj][m][n], 0, 0, 0, 0x7f7f7f7f, 0, 0x7f7f7f7f); \
        else { _Pragma("unroll") for (int k = 0; k < 2; ++k) acc[ai][bj][m][n] = __builtin_amdgcn_mfma_f32_16x16x32_bf16(Bt[n][k], At[m][k], acc[ai][bj][m][n], 0, 0, 0); } } __builtin_amdgcn_s_setprio(0); } while (0)
#define PG8_WAIT_V(n) asm volatile("s_waitcnt vmcnt(" #n ")" ::: "memory")
#define PG8_WAIT_L(n) asm volatile("s_waitcnt lgkmcnt(" #n ")" ::: "memory")
#define PG8_BAR __builtin_amdgcn_s_barrier()
#define PG8_SCHED __builtin_amdgcn_sched_barrier(0)
    Unit cur, nxt; int ui = 0;
    if (!S.next(0, cur)) return;
    f32x4 acc[2][2][4][2];
#pragma unroll
    for (int a = 0; a < 2; ++a)
#pragma unroll
        for (int b = 0; b < 2; ++b)
#pragma unroll
            for (int m = 0; m < 4; ++m)
#pragma unroll
                for (int n = 0; n < 2; ++n) acc[a][b][m][n] = (f32x4){0.f, 0.f, 0.f, 0.f};
    bf16x8 At[4][2], B0[2][2], B1[2][2];
    i32x8 At8[4], B08[2], B18[2];
    const char* cA = (const char*)(cur.sel ? g.A2 : g.A) + (size_t)cur.pm * tstep; const char* cB = (const char*)(cur.sel ? g.Bt2 : g.Bt) + (size_t)cur.pn * tstep;
    S.a_ready(cur);
    if constexpr (SP2) {
        PG8_STAGE(PG8_SB(0, 0), cB, voffB); PG8_STAGE(PG8_SB(0, 1), cB + hstep, voffB); PG8_STAGE(PG8_SA(0, 0), cA, voffA); PG8_STAGE(PG8_SA(0, 1), cA + hstep, voffA);
        if (wr == 1) PG8_BAR;
        PG8_WAIT_V(2); PG8_BAR;
        PG8_STAGE(PG8_SB(1, 0), cB + kstep, voffB); PG8_STAGE(PG8_SA(1, 0), cA + kstep, voffA); PG8_STAGE(PG8_SB(1, 1), cB + hstep + kstep, voffB);
        PG8_WAIT_V(6); PG8_BAR;
    } else {
        PG8_STAGE(PG8_SB(0, 0), cB, voffB); PG8_STAGE(PG8_SA(0, 0), cA, voffA); PG8_STAGE(PG8_SB(0, 1), cB + hstep, voffB); PG8_STAGE(PG8_SA(0, 1), cA + hstep, voffA);
        if (wr == 1) PG8_BAR;
        PG8_WAIT_V(4); PG8_BAR;
        PG8_STAGE(PG8_SB(1, 0), cB + kstep, voffB); PG8_STAGE(PG8_SA(1, 0), cA + kstep, voffA); PG8_STAGE(PG8_SB(1, 1), cB + hstep + kstep, voffB);
        PG8_WAIT_V(6); PG8_BAR;
    }
    for (;;) {
        const bool has_next = S.next(ui + 1, nxt);
        const char* nA = has_next ? (const char*)(nxt.sel ? g.A2 : g.A) + (size_t)nxt.pm * tstep : cA; const char* nB = has_next ? (const char*)(nxt.sel ? g.Bt2 : g.Bt) + (size_t)nxt.pn * tstep : cB;
        for (int t = 0; t < nt; t += 2) {
            if constexpr (Epi::MIDK) { if (t == nt / 2) E.midk(acc, cur, wr, wc, fr, fq); }
            const bool last = (t == nt - 2);
            const char* a1 = cA + (size_t)(t + 1) * kstep;
            const char* a2 = last ? nA : cA + (size_t)(t + 2) * kstep; const char* b2 = last ? nB : cB + (size_t)(t + 2) * kstep;
            const char* a3 = a2 + kstep; const char* b3 = b2 + kstep;
            if (last && has_next) S.a_ready(nxt);
            if constexpr (SP2) {
            PG8_LDB(B0, 0, 0); PG8_LDB(B1, 0, 1); PG8_SCHED; PG8_LDA(At, 0, 0); PG8_STAGE(PG8_SA(1, 1), a1 + hstep, voffA);
            PG8_WAIT_V(8); PG8_WAIT_L(0); PG8_BAR; PG8_MMA(0, 0, At, B0); PG8_MMA(0, 1, At, B1); PG8_BAR; PG8_SCHED;
            PG8_LDA(At, 0, 1); PG8_STAGE(PG8_SB(0, 0), b2, voffB); PG8_STAGE(PG8_SB(0, 1), b2 + hstep, voffB); PG8_STAGE(PG8_SA(0, 0), a2, voffA);
            PG8_WAIT_V(8); PG8_WAIT_L(0); PG8_BAR; PG8_MMA(1, 0, At, B0); PG8_MMA(1, 1, At, B1); PG8_BAR; PG8_SCHED;
            PG8_LDB(B0, 1, 0); PG8_LDB(B1, 1, 1); PG8_SCHED; PG8_LDA(At, 1, 0); PG8_STAGE(PG8_SA(0, 1), a2 + hstep, voffA);
            PG8_WAIT_V(8); PG8_WAIT_L(0); PG8_BAR; PG8_MMA(0, 0, At, B0); PG8_MMA(0, 1, At, B1); PG8_BAR; PG8_SCHED;
            PG8_LDA(At, 1, 1); PG8_STAGE(PG8_SB(1, 0), b3, voffB); PG8_STAGE(PG8_SB(1, 1), b3 + hstep, voffB); PG8_STAGE(PG8_SA(1, 0), a3, voffA);
            PG8_WAIT_V(8); PG8_WAIT_L(0); PG8_BAR; PG8_MMA(1, 0, At, B0); PG8_MMA(1, 1, At, B1); PG8_BAR; PG8_SCHED;
            } else {
            PG8_LDB(B0, 0, 0); PG8_SCHED; PG8_LDA(At, 0, 0); PG8_STAGE(PG8_SA(1, 1), a1 + hstep, voffA);
            PG8_WAIT_L(8); PG8_BAR; PG8_WAIT_L(0); PG8_MMA(0, 0, At, B0); PG8_BAR; PG8_SCHED;
            PG8_LDB(B1, 0, 1); PG8_STAGE(PG8_SB(0, 0), b2, voffB);
            PG8_BAR; PG8_WAIT_L(0); PG8_MMA(0, 1, At, B1); PG8_BAR;
            PG8_LDA(At, 0, 1); PG8_STAGE(PG8_SA(0, 0), a2, voffA);
            PG8_BAR; PG8_WAIT_L(0); PG8_MMA(1, 0, At, B0); PG8_BAR; PG8_SCHED;
            PG8_STAGE(PG8_SB(0, 1), b2 + hstep, voffB);
            PG8_WAIT_V(6); PG8_BAR; PG8_MMA(1, 1, At, B1); PG8_BAR;
            PG8_LDB(B0, 1, 0); PG8_SCHED; PG8_LDA(At, 1, 0); PG8_STAGE(PG8_SA(0, 1), a2 + hstep, voffA);
            PG8_WAIT_L(8); PG8_BAR; PG8_WAIT_L(0); PG8_MMA(0, 0, At, B0); PG8_BAR; PG8_SCHED;
            PG8_LDB(B1, 1, 1); PG8_STAGE(PG8_SB(1, 0), b3, voffB);
            PG8_BAR; PG8_WAIT_L(0); PG8_MMA(0, 1, At, B1); PG8_BAR;
            PG8_LDA(At, 1, 1); PG8_STAGE(PG8_SA(1, 0), a3, voffA);
            PG8_BAR; PG8_WAIT_L(0); PG8_MMA(1, 0, At, B0); PG8_BAR; PG8_SCHED;
            PG8_STAGE(PG8_SB(1, 1), b3 + hstep, voffB);
            PG8_WAIT_V(6); PG8_BAR; PG8_MMA(1, 1, At, B1); PG8_BAR;
            }
        }
        if constexpr (ALIGN_EPI) { if (wr == 0) PG8_BAR; }
        if constexpr (!Epi::AFTER_DRAIN) { E(acc, cur, wr, wc, fr, fq); S.done(cur); }
        if (!has_next) break;
#pragma unroll
        for (int a = 0; a < 2; ++a)
#pragma unroll
            for (int b = 0; b < 2; ++b)
#pragma unroll
                for (int m = 0; m < 4; ++m)
#pragma unroll
                    for (int n = 0; n < 2; ++n) acc[a][b][m][n] = (f32x4){0.f, 0.f, 0.f, 0.f};
        cur = nxt; cA = nA; cB = nB; ++ui;
        if constexpr (ALIGN_EPI) { if (wr == 1) PG8_BAR; }
    }
    PG8_WAIT_V(0);
    if constexpr (!ALIGN_EPI) { if (wr == 0) PG8_BAR; }
    PG8_BAR;
    if constexpr (Epi::AFTER_DRAIN) { E.fused(acc, cur, wr, wc, fr, fq, lds, wid, lane); S.done(cur); }
#undef PG8_SA
#undef PG8_SB
#undef PG8_STAGE
#undef PG8_LDA
#undef PG8_LDB
#undef PG8_MMA
#undef PG8_WAIT_V
#undef PG8_WAIT_L
#undef PG8_BAR
#undef PG8_SCHED
}
}
#define GAS __attribute__((address_space(1)))
#define LAS __attribute__((address_space(3)))
typedef unsigned short bf16;
typedef unsigned v4u __attribute__((ext_vector_type(4)));
typedef float f32x4 __attribute__((ext_vector_type(4)));
typedef short bf16x8 __attribute__((ext_vector_type(8)));
typedef GAS unsigned gu32;
typedef GAS unsigned long long gu64;
#define RLX_AGENT __ATOMIC_RELAXED, __HIP_MEMORY_SCOPE_AGENT
#define LDS_WAIT() asm volatile("s_waitcnt lgkmcnt(0)" ::: "memory")
#define VM_WAIT() asm volatile("s_waitcnt vmcnt(0)" ::: "memory")
__device__ __forceinline__ unsigned long long rt() { return __builtin_amdgcn_s_memrealtime(); }
__device__ __forceinline__ unsigned f2bf(float f) { unsigned u = __builtin_bit_cast(unsigned, f); return (u + 0x7fffu + ((u >> 16) & 1u)) >> 16; }
__device__ __forceinline__ unsigned pk2(float lo, float hi) { return f2bf(lo) | (f2bf(hi) << 16); }

#define XB_TMO      128
#define XB_XCNT(j)  (256  + 64 * (j))
#define XB_XSUB(j)  (1280 + 64 * (j))
#define XB_XGEN(j)  (2304 + 64 * (j))
#define XB_TOP      3328
#define XB_TOPGEN   3392
#define XCD_BAR_WORDS 3456
#define XB_SPIN_CAP (1u << 18)

__device__ __forceinline__ unsigned xb_ld(unsigned* p)              { return __hip_atomic_load(p, __ATOMIC_RELAXED, __HIP_MEMORY_SCOPE_AGENT); }
__device__ __forceinline__ unsigned xb_add(unsigned* p, unsigned v) { return __hip_atomic_fetch_add(p, v, __ATOMIC_RELAXED, __HIP_MEMORY_SCOPE_AGENT); }
__device__ __forceinline__ unsigned xb_xcc_id() { return (unsigned)__builtin_amdgcn_s_getreg((3 << 11) | 20) & 0xFu; }
#define XB_SPIN(cond, bar) do { unsigned _sp = 0; while (cond) { __builtin_amdgcn_s_sleep(1); \
    if ((++_sp & 255u) == 0u) { if (xb_ld(&(bar)[XB_TMO])) break; if (_sp > XB_SPIN_CAP) { atomicAdd(&(bar)[XB_TMO], 1u); break; } } } } while (0)

struct XcdBarrier {
    unsigned* bar; unsigned x;
    volatile LAS unsigned* st;
};

__device__ __forceinline__ XcdBarrier xcd_barrier_post(unsigned* bar, volatile LAS unsigned* st) {
    XcdBarrier b; b.bar = bar; b.x = xb_xcc_id(); b.st = st;
    if (threadIdx.x == 0) (void)xb_add(&bar[XB_XCNT(b.x)], 1u);
    return b;
}
__device__ __forceinline__ void xcd_barrier_complete(unsigned* bar, unsigned x, unsigned& nloc, unsigned& nx) {
    const unsigned G = gridDim.x * gridDim.y * gridDim.z;
    unsigned sum, cnt, mine, sp = 0u;
    for (;;) {
        sum = 0u; cnt = 0u; mine = 0u;
#pragma unroll
        for (unsigned j = 0; j < 16; ++j) { const unsigned c = xb_ld(&bar[XB_XCNT(j)]); sum += c; cnt += (c > 0u) ? 1u : 0u; mine = (j == x) ? c : mine; }
        if (sum == G) break;
        __builtin_amdgcn_s_sleep(1);
        if ((++sp & 255u) == 0u) { if (xb_ld(&bar[XB_TMO])) break; if (sp > XB_SPIN_CAP) { atomicAdd(&bar[XB_TMO], 1u); break; } }
    }
    nloc = mine > 0u ? mine : 1u; nx = cnt > 0u ? cnt : 1u;
}

__device__ __forceinline__ void xcd_barrier(const XcdBarrier& b) {
    asm volatile("s_waitcnt vmcnt(0)" ::: "memory");
    __syncthreads();
    if (threadIdx.x == 0) {
        unsigned* bar = b.bar;
        __builtin_amdgcn_s_waitcnt(0);
        unsigned nloc = b.st[0], nx = b.st[1];
        if (nloc == 0u) { xcd_barrier_complete(bar, b.x, nloc, nx); b.st[0] = nloc; b.st[1] = nx; }
        const unsigned old = xb_add(&bar[XB_XSUB(b.x)], 1u);
        const unsigned gen = old / nloc;
        if (old + 1u == (gen + 1u) * nloc) {
            __builtin_amdgcn_fence(__ATOMIC_RELEASE, "agent");
            asm volatile("s_waitcnt vmcnt(0)" ::: "memory");
            const unsigned og = xb_add(&bar[XB_TOP], 1u);
            const unsigned tg = og / nx;
            if (og + 1u == (tg + 1u) * nx) xb_add(&bar[XB_TOPGEN], 1u);
            else XB_SPIN(xb_ld(&bar[XB_TOPGEN]) == tg, bar);
            __builtin_amdgcn_fence(__ATOMIC_ACQUIRE, "agent");
            xb_add(&bar[XB_XGEN(b.x)], 1u);
            asm volatile("s_waitcnt vmcnt(0)" ::: "memory");
        } else {
            XB_SPIN(xb_ld(&bar[XB_XGEN(b.x)]) == gen, bar);
            __builtin_amdgcn_fence(__ATOMIC_ACQUIRE, "agent");
            asm volatile("s_waitcnt vmcnt(0)" ::: "memory");
        }
    }
    __syncthreads();
}

constexpr int NWAVES = 8;
constexpr int T_TOK = 8192, DM = 2048, AW = 1024, SEQ = 2048, NHEAD = 8;
constexpr int NWA = 8192;
constexpr int NEXP = 16384;
constexpr float RMS_EPS = 1e-6f, LOG2E = 1.4426950408889634f;
constexpr float W8SCALE = 64.f;
constexpr float OC8SCALE = 8.f, WB8SCALE = 32.f;
constexpr float MG8SCALE = 16.f;
constexpr float QSCALE = 0.08838834764831845f * 1.4426950408889634f;

constexpr size_t MiB = 1u << 20;
constexpr size_t WS_CTL = 0, CTL_ZERO_BYTES = 1 * MiB;
constexpr size_t WS_WA = 2 * MiB;
constexpr size_t WS_WV = 34 * MiB;
constexpr size_t WS_WB = 38 * MiB;
constexpr size_t WS_WO = 46 * MiB;
constexpr size_t WS_WQ = 54 * MiB;
constexpr size_t WS_LWA = 62 * MiB;
constexpr size_t WS_LWX = 62 * MiB + 256 * 1024;
constexpr size_t WS_KEYS = 62 * MiB + 512 * 1024;
constexpr size_t WS_U8 = 64 * MiB;
constexpr size_t WS_V8 = 96 * MiB;
constexpr size_t WS_US = 128 * MiB;
constexpr size_t WS_VS = 128 * MiB + 65536;
constexpr size_t WS_HN = 192 * MiB;
constexpr size_t WS_X1B = WS_HN;
constexpr size_t WS_Q = 224 * MiB;
constexpr size_t WS_K = 240 * MiB;
constexpr size_t WS_VT = 256 * MiB;
constexpr size_t WS_XR = 272 * MiB;
constexpr size_t WS_GY = 288 * MiB;
constexpr size_t WS_SG = 304 * MiB;
constexpr size_t WS_QP = WS_SG;
constexpr size_t WS_OCAT = 368 * MiB;
constexpr size_t WS_HL = 400 * MiB;
constexpr size_t WS_AC = 432 * MiB;
constexpr size_t WS_TMP = WS_HL;
constexpr size_t WS_SUM = 464 * MiB;
constexpr size_t WS_MG = 466 * MiB;
constexpr size_t WS_SSP = 498 * MiB;
constexpr size_t WS_IDX = 500 * MiB;
constexpr size_t WS_G = 504 * MiB;
constexpr size_t WS_PD = WS_Q;
constexpr size_t WS_ACT = WS_VT;
constexpr size_t WS_OUTP = WS_HL;
constexpr size_t WS_END = 508 * MiB;
constexpr int CW_BAR = 4096;
constexpr int CW_XC = 12288;
constexpr int CW_Q2 = 8192;
constexpr int CW_KM = 65536;
static_assert((CW_KM + 32768) * 4 <= (int)CTL_ZERO_BYTES, "CTL");

constexpr int LDS_BYTES = 163840;
constexpr int MISC_OFF = 163840 - 256;
constexpr int SCR_BYTES = MISC_OFF;

typedef float f32x16 __attribute__((ext_vector_type(16)));
typedef float f32x2_t __attribute__((ext_vector_type(2)));
typedef __bf16 bf16x2_t __attribute__((ext_vector_type(2)));
typedef unsigned long long u64;
__device__ __forceinline__ float clamp8(float v) { return fminf(fmaxf(v, -448.f), 448.f); }
__device__ __forceinline__ unsigned cvtpk(float lo, float hi) { f32x2_t v = {lo, hi}; bf16x2_t b = __builtin_convertvector(v, bf16x2_t); return __builtin_bit_cast(unsigned, b); }
__device__ __forceinline__ float bf_lo(unsigned w) { return __builtin_bit_cast(float, w << 16); }
__device__ __forceinline__ float bf_hi(unsigned w) { return __builtin_bit_cast(float, w & 0xffff0000u); }
__device__ __forceinline__ f32x4 bf4_lo2(unsigned a, unsigned b) { f32x4 r; r[0] = bf_lo(a); r[1] = bf_hi(a); r[2] = bf_lo(b); r[3] = bf_hi(b); return r; }
__device__ __forceinline__ float wave_sum(float v) {
#pragma unroll
    for (int o = 1; o < 64; o <<= 1) v += __shfl_xor(v, o);
    return v;
}
__device__ __forceinline__ float dot2bf(unsigned a, unsigned b, float acc) { return __builtin_amdgcn_fdot2_f32_bf16(__builtin_bit_cast(bf16x2_t, a), __builtin_bit_cast(bf16x2_t, b), acc, false); }

struct Params {
    const float *x, *g_mix, *w_in, *conv_w, *conv_b, *lru_wa, *lru_ba, *lru_wx, *lru_bx, *lru_lam, *w_branch, *w_out, *rel_bias, *g_ffn, *peer_wq, *peer_keys, *peer_u, *peer_v, *g_fin;
    float* out; unsigned char* ws; int ph_lo, ph_hi;
};

struct TrD { const float* W; const float* ks; unsigned char* d; int N, k0, n0, ldd; float sc; bool f8; };
__device__ __forceinline__ void tr_load(const TrD& t, int lane, f32x4 (&wv)[8]) {
#pragma unroll
    for (int i = 0; i < 8; ++i) wv[i] = *(const f32x4*)(t.W + (size_t)(t.k0 + (lane >> 3) + 8 * i) * t.N + t.n0 + 4 * (lane & 7));
}
__device__ __forceinline__ void tr_finish(const TrD& t, f32x4 (&wv)[8], LAS float* scr, int lane) {
#pragma unroll
    for (int i = 0; i < 8; ++i) { const int kk = (lane >> 3) + 8 * i; f32x4 v = wv[i]; if (t.ks) v = v * t.ks[t.k0 + kk];
#pragma unroll
        for (int e = 0; e < 4; ++e) scr[kk * 33 + 4 * (lane & 7) + e] = v[e]; }
    LDS_WAIT(); asm volatile("" ::: "memory");
    const int c = lane & 7; const float f8scale = t.sc;
#pragma unroll
    for (int j = 0; j < 4; ++j) { const int n = (lane >> 3) + 8 * j; const LAS float* s = scr + (8 * c) * 33 + n;
        if (t.f8) {
            int p0 = __builtin_amdgcn_cvt_pk_fp8_f32(clamp8(s[0 * 33] * f8scale), clamp8(s[1 * 33] * f8scale), 0, false); p0 = __builtin_amdgcn_cvt_pk_fp8_f32(clamp8(s[2 * 33] * f8scale), clamp8(s[3 * 33] * f8scale), p0, true);
            int p1 = __builtin_amdgcn_cvt_pk_fp8_f32(clamp8(s[4 * 33] * f8scale), clamp8(s[5 * 33] * f8scale), 0, false); p1 = __builtin_amdgcn_cvt_pk_fp8_f32(clamp8(s[6 * 33] * f8scale), clamp8(s[7 * 33] * f8scale), p1, true);
            *(u64*)(t.d + (size_t)n * t.ldd + t.k0 + 8 * c) = (u64)(unsigned)p0 | ((u64)(unsigned)p1 << 32);
        } else {
        v4u o; o.x = cvtpk(s[0 * 33], s[1 * 33]); o.y = cvtpk(s[2 * 33], s[3 * 33]); o.z = cvtpk(s[4 * 33], s[5 * 33]); o.w = cvtpk(s[6 * 33], s[7 * 33]);
        *(v4u*)(t.d + (size_t)n * t.ldd + 2 * (t.k0 + 8 * c)) = o; } }
    LDS_WAIT(); asm volatile("" ::: "memory");
}
template <int MODE> __device__ __forceinline__ void row_to_bf16(const float* src, bf16* dst, const float* colscale, int lane) {
    const f32x4* s = (const f32x4*)src + lane;
    f32x4 v[8]; float ss = 0.f;
#pragma unroll
    for (int j = 0; j < 8; ++j) { v[j] = s[64 * j]; ss += (v[j][0] * v[j][0] + v[j][1] * v[j][1]) + (v[j][2] * v[j][2] + v[j][3] * v[j][3]); }
    float rs = 1.f;
    if (MODE == 1) rs = __builtin_amdgcn_rsqf(wave_sum(ss) * (1.f / 2048.f) + RMS_EPS);
    u64* o8 = (u64*)dst + lane;
#pragma unroll
    for (int j = 0; j < 8; ++j) { f32x4 w = v[j] * rs; if (colscale) w = w * ((const f32x4*)colscale)[64 * j + lane];
        o8[64 * j] = (u64)cvtpk(w[0], w[1]) | ((u64)cvtpk(w[2], w[3]) << 32); }
}
template <bool I8, bool NT = false> __device__ __forceinline__ void row_finish8(f32x4 (&v)[8], unsigned char* dst, float* scale_out, int lane) {
    float am = 0.f;
#pragma unroll
    for (int j = 0; j < 8; ++j) am = fmaxf(am, fmaxf(fmaxf(fabsf(v[j][0]), fabsf(v[j][1])), fmaxf(fabsf(v[j][2]), fabsf(v[j][3]))));
#pragma unroll
    for (int o = 1; o < 64; o <<= 1) am = fmaxf(am, __shfl_xor(am, o));
    const float qmax = I8 ? 127.f : 448.f;
    const float sc = am > 0.f ? am / qmax : 1.f, inv = 1.f / sc;
    unsigned* o4 = (unsigned*)(dst + (size_t)(lane >> 5) * NEXP * 128) + (lane & 31);
#pragma unroll
    for (int j = 0; j < 8; ++j) { unsigned w;
        if (I8) { const int q0 = (int)rintf(v[j][0] * inv), q1 = (int)rintf(v[j][1] * inv), q2 = (int)rintf(v[j][2] * inv), q3 = (int)rintf(v[j][3] * inv);
            w = (unsigned)(q0 & 255) | ((unsigned)(q1 & 255) << 8) | ((unsigned)(q2 & 255) << 16) | ((unsigned)q3 << 24); }
        else { int p = __builtin_amdgcn_cvt_pk_fp8_f32(v[j][0] * inv, v[j][1] * inv, 0, false); p = __builtin_amdgcn_cvt_pk_fp8_f32(v[j][2] * inv, v[j][3] * inv, p, true); w = (unsigned)p; }
        if (NT) __builtin_nontemporal_store(w, o4 + (size_t)(2 * j) * NEXP * 32); else o4[(size_t)(2 * j) * NEXP * 32] = w; }
    if (lane == 0) *scale_out = sc;
}
template <bool I8, int NR = 2, bool NT = false> __device__ __forceinline__ void table_rows8(const float* src, unsigned char* dst, float* scales, const float* colscale, int r0, int r1, int wv, int nwv, int lane) {
    f32x4 cs[8];
#pragma unroll
    for (int j = 0; j < 8; ++j) cs[j] = colscale ? ((const f32x4*)colscale)[64 * j + lane] : (f32x4){1.f, 1.f, 1.f, 1.f};
    f32x4 v[NR][8];
#define TR8_LOAD(q, mrow) do { _Pragma("unroll") for (int j = 0; j < 8; ++j) v[q][j] = NT ? __builtin_nontemporal_load((const f32x4*)(src + (size_t)(mrow) * DM) + 64 * j + lane) : ((const f32x4*)(src + (size_t)(mrow) * DM))[64 * j + lane]; } while (0)
#pragma unroll
    for (int q = 0; q < NR; ++q) { const int mq = r0 + wv + q * nwv; if (mq < r1) TR8_LOAD(q, mq); }
    for (int m = r0 + wv; m < r1; m += NR * nwv) {
#pragma unroll
        for (int q = 0; q < NR; ++q) { const int mq = m + q * nwv; if (mq < r1) {
            if (colscale) {
#pragma unroll
                for (int j = 0; j < 8; ++j) v[q][j] = v[q][j] * cs[j]; }
            row_finish8<I8, NT>(v[q], dst + (size_t)mq * 128, scales + mq, lane);
            const int mn = mq + NR * nwv; if (mn < r1) TR8_LOAD(q, mn); } }
    }
#undef TR8_LOAD
}
template <int NR> __device__ __forceinline__ void peer_table_u(const Params& P, int r0, int r1, int wv, int nwv, int lane) { table_rows8<true, NR>(P.peer_u, P.ws + WS_U8, (float*)(P.ws + WS_US), P.g_ffn, r0, r1, wv, nwv, lane); }
template <int NR, bool NT = false> __device__ __forceinline__ void peer_table_v(const Params& P, int r0, int r1, int wv, int nwv, int lane) { table_rows8<false, NR, NT>(P.peer_v, P.ws + WS_V8, (float*)(P.ws + WS_VS), nullptr, r0, r1, wv, nwv, lane); }
constexpr int TT_PITCH = 260;
constexpr int TT_IN = 16 * 36, TT_BR = 2 * 8 * 8, TT_SQ = 16 * 8, TT_N = TT_IN + TT_BR + 2 * TT_SQ;
static_assert(128 * TT_PITCH * 4 <= MISC_OFF, "transpose tile");
__device__ __forceinline__ TrD tt_decode(const Params& P, int T) {
    unsigned char* ws = P.ws;
    TrD t; t.ks = nullptr; t.f8 = true; t.ldd = 2048; t.sc = W8SCALE;
    if (T < TT_IN) { const int kt = T / 36, nt = T % 36, n0 = 256 * nt; t.W = P.w_in; t.N = 9216; t.k0 = 128 * kt; t.n0 = n0;
        t.d = (n0 < 2048) ? ws + WS_WA + (size_t)n0 * 2048 : (n0 < 3072 ? ws + WS_WV + (size_t)(n0 - 2048) * 2048 : ws + WS_WA + (size_t)(n0 - 1024) * 2048); return t; } T -= TT_IN;
    if (T < TT_BR) { const int br = T / 64, q = T % 64, kt = q / 8, nt = q % 8; t.W = P.w_branch + (size_t)br * 1024 * 2048; t.N = 2048; t.k0 = 128 * kt; t.n0 = 256 * nt; t.sc = WB8SCALE;
        t.d = ws + WS_WB + (size_t)(256 * nt) * 2048 + br * 1024; return t; } T -= TT_BR;
    if (T < TT_SQ) { const int kt = T / 8, nt = T % 8; t.W = P.w_out; t.N = 2048; t.k0 = 128 * kt; t.n0 = 256 * nt; t.d = ws + WS_WO + (size_t)(256 * nt) * 2048; return t; } T -= TT_SQ;
    { const int kt = T / 8, nt = T % 8; t.W = P.peer_wq; t.N = 2048; t.k0 = 128 * kt; t.n0 = 256 * nt; t.ks = P.g_ffn; t.d = ws + WS_WQ + (size_t)(256 * nt) * 2048; return t; }
}
__device__ __forceinline__ void tt_load(const TrD& t, int wave, int lane, f32x4 (&v)[16]) {
#pragma unroll
    for (int i = 0; i < 16; ++i) v[i] = *(const f32x4*)(t.W + (size_t)(t.k0 + 16 * wave + i) * t.N + t.n0 + 4 * lane);
}
__device__ __forceinline__ void tt_to_lds(const TrD& t, LAS float* tile, int wave, int lane, f32x4 (&v)[16]) {
#pragma unroll
    for (int i = 0; i < 16; ++i) { f32x4 w = v[i] * t.sc; if (t.ks) w = w * t.ks[t.k0 + 16 * wave + i]; *(LAS f32x4*)(tile + (16 * wave + i) * TT_PITCH + 4 * lane) = w; }
}
__device__ __forceinline__ void tt_emit(const TrD& t, const LAS float* tile, int tid) {
    const int n = tid & 255, kh = tid >> 8; const LAS float* s = tile + (64 * kh) * TT_PITCH + n;
    if (t.f8) { unsigned char* o = t.d + (size_t)n * t.ldd + t.k0 + 64 * kh;
#pragma unroll
        for (int q = 0; q < 4; ++q) { v4u w;
#pragma unroll
            for (int e = 0; e < 4; ++e) { const LAS float* z = s + (16 * q + 4 * e) * TT_PITCH;
                int pk = __builtin_amdgcn_cvt_pk_fp8_f32(clamp8(z[0]), clamp8(z[TT_PITCH]), 0, false); pk = __builtin_amdgcn_cvt_pk_fp8_f32(clamp8(z[2 * TT_PITCH]), clamp8(z[3 * TT_PITCH]), pk, true); w[e] = (unsigned)pk; }
            *(v4u*)(o + 16 * q) = w; }
    } else { unsigned char* o = t.d + (size_t)n * t.ldd + 2 * (t.k0 + 64 * kh);
#pragma unroll
        for (int q = 0; q < 8; ++q) { v4u w;
#pragma unroll
            for (int e = 0; e < 4; ++e) { const LAS float* z = s + (8 * q + 2 * e) * TT_PITCH; w[e] = cvtpk(z[0], z[TT_PITCH]); }
            *(v4u*)(o + 16 * q) = w; } }
}
__device__ __forceinline__ void tt_run(const Params& P, LAS unsigned char* lds, int T0, int T1, int first, int stride, int tid, int wave, int lane) {
    LAS float* tile = (LAS float*)lds; f32x4 v[16];
    int T = T0 + first; TrD a = tt_decode(P, T < T1 ? T : T0);
    if (T < T1) tt_load(a, wave, lane, v);
    while (T < T1) {
        tt_to_lds(a, tile, wave, lane, v);
        __syncthreads();
        const TrD cur = a; const int Tn = T + stride;
        if (Tn < T1) { a = tt_decode(P, Tn); tt_load(a, wave, lane, v); }
        tt_emit(cur, tile, tid);
        __syncthreads();
        T = Tn; }
}
__device__ __forceinline__ TrD tr_decode_lru(const Params& P, int r) {
    TrD t; t.ks = nullptr; t.f8 = false; t.sc = 1.f;
    const int which = r / 64, q = r % 64, g = q / 8, kb = (q % 8) / 4, nb = q % 4;
    t.W = (which ? P.lru_wx : P.lru_wa) + (size_t)g * 16384; t.N = 128; t.k0 = 64 * kb; t.n0 = 32 * nb; t.ldd = 256; t.d = P.ws + (which ? WS_LWX : WS_LWA) + ((size_t)g * 16384 + (size_t)(32 * nb) * 128) * 2; return t;
}
__device__ __forceinline__ void p0_prologue(const Params& P, LAS unsigned char* lds, int gw, int NGW, int wave, int lane, int r1) {
    unsigned char* ws = P.ws;
    const int vcu = gw / NWAVES, G = NGW / NWAVES, tid = wave * 64 + lane;
    tt_run(P, lds, 0, r1 == 0 ? TT_IN : TT_N, vcu, G, tid, wave, lane);
    if (gw < 128) { LAS float* scr = (LAS float*)(lds + wave * 16384); TrD a = tr_decode_lru(P, gw); f32x4 wa[8]; tr_load(a, lane, wa); tr_finish(a, wa, scr, lane); }
#ifdef TPROBE
    *(volatile LAS unsigned*)(lds + MISC_OFF + 4 * 52) = (unsigned)__builtin_amdgcn_s_memrealtime();
#endif
    { bf16* KB = (bf16*)(ws + WS_KEYS);
      for (int i = gw * 64 + lane; i < 262144 / 8; i += NGW * 64) { const f32x4 a = ((const f32x4*)P.peer_keys)[2 * i], b = ((const f32x4*)P.peer_keys)[2 * i + 1];
          v4u o; o.x = cvtpk(a[0], a[1]); o.y = cvtpk(a[2], a[3]); o.z = cvtpk(b[0], b[1]); o.w = cvtpk(b[2], b[3]); ((v4u*)KB)[i] = o; } }
    { unsigned char* HN = ws + WS_HN;
      const int ntp0 = r1 == 0 ? TT_IN : TT_N; const int tq = ntp0 / G, n_hi = ntp0 - tq * G, W = (T_TOK + 16 * ntp0 + G - 1) / G, r_hi = W - 16 * (tq + 1), r_lo = W - 16 * tq;
      int r0, cnt;
      if (r_hi >= 0 && n_hi * r_hi + (G - n_hi) * r_lo >= T_TOK) { r0 = vcu < n_hi ? vcu * r_hi : n_hi * r_hi + (vcu - n_hi) * r_lo; cnt = vcu < n_hi ? r_hi : r_lo; }
      else { const int per = (T_TOK + G - 1) / G; r0 = vcu * per; cnt = per; }
      const int rend = (r0 + cnt < T_TOK) ? r0 + cnt : T_TOK;
      for (int m = r0 + wave; m < rend; m += 4 * NWAVES) {
          f32x4 v[4][8];
#pragma unroll
          for (int q = 0; q < 4; ++q) { const int mq = m + q * NWAVES; if (mq < rend) {
#pragma unroll
              for (int j = 0; j < 8; ++j) v[q][j] = ((const f32x4*)(P.x + (size_t)mq * DM))[64 * j + lane]; } }
#pragma unroll
          for (int q = 0; q < 4; ++q) { const int mq = m + q * NWAVES; if (mq < rend) {
              float sa = 0.f;
#pragma unroll
              for (int j = 0; j < 8; ++j) sa += (v[q][j][0] * v[q][j][0] + v[q][j][1] * v[q][j][1]) + (v[q][j][2] * v[q][j][2] + v[q][j][3] * v[q][j][3]);
              const float ra = __builtin_amdgcn_rsqf(wave_sum(sa) * (1.f / 2048.f) + RMS_EPS);
              unsigned* oa = (unsigned*)(HN + (size_t)mq * DM) + lane;
#pragma unroll
              for (int j = 0; j < 8; ++j) { const f32x4 w = v[q][j] * ra * ((const f32x4*)P.g_mix)[64 * j + lane]; int p = __builtin_amdgcn_cvt_pk_fp8_f32(w[0], w[1], 0, false); p = __builtin_amdgcn_cvt_pk_fp8_f32(w[2], w[3], p, true); oa[64 * j] = (unsigned)p; } } } } }
    if (r1 > 0) { peer_table_u<2>(P, 0, r1, gw, NGW, lane); peer_table_v<2>(P, 0, r1, gw, NGW, lane); }
}

constexpr int AT_KT = 0, AT_VT = 2 * 17408, AT_KM = AT_VT + 2 * 18432, AT_B2 = AT_KM + 4096, AT_SEL = AT_B2 + 512, AT_ANY = AT_SEL + 1024;
#define MFMA32(a, b, c) __builtin_amdgcn_mfma_f32_32x32x16_bf16((a), (b), (c), 0, 0, 0)
__device__ __forceinline__ void attn_unit(const Params& P, LAS unsigned char* lds, int b, int h, int blk, int tid, int wave, int lane) {
    unsigned char* ws = P.ws;
    const bf16* Qb = (const bf16*)(ws + WS_Q); const bf16* Kb = (const bf16*)(ws + WS_K); const bf16* VTg = (const bf16*)(ws + WS_VT); bf16* OATT = (bf16*)(ws + WS_OCAT);
    const float* KMg = (const float*)(ws + WS_CTL) + CW_KM;
    LAS float* KMs = (LAS float*)(lds + AT_KM); LAS float* B2 = (LAS float*)(lds + AT_B2); LAS unsigned* SELM = (LAS unsigned*)(lds + AT_SEL); LAS unsigned* UANY = (LAS unsigned*)(lds + AT_ANY);
    const int row_blk0 = b * SEQ + blk * 256;
    __syncthreads();
    for (int i = tid; i < 1024; i += 512) KMs[i] = KMg[(size_t)(b * 8 + h) * 1024 + i] * (1.f / 256.f);
    if (tid < 128) { const int d = tid; int bucket = d;
        if (d >= 16) { bucket = 16 + (int)(__logf((float)d * (1.f / 16.f)) * (16.f / 2.0794415416798357f)); bucket = bucket > 31 ? 31 : bucket; }
        B2[d] = (P.rel_bias[bucket * 8 + h] - P.rel_bias[31 * 8 + h]) * LOG2E; }
    if (tid == 0) *UANY = 0u;
    __syncthreads();
    unsigned blist = (unsigned)blk; int nb = 1;
    const int qi = 32 * wave + (lane & 31), hh = lane >> 5;
    bf16x8 Qf[8];
    { const bf16* qp = Qb + (size_t)(row_blk0 + qi) * AW + h * 128 + 8 * hh;
#pragma unroll
      for (int ks = 0; ks < 8; ++ks) Qf[ks] = *(const bf16x8*)(qp + 16 * ks); }
    float m_run = -1.0e30f, lsum = 0.f;
    f32x16 O[4];
#pragma unroll
    for (int dt = 0; dt < 4; ++dt)
#pragma unroll
        for (int r = 0; r < 16; ++r) O[dt][r] = 0.f;
    const int kkey0 = tid >> 4, kpart = tid & 15;
    const int vd0 = tid >> 3, vcc = tid & 7;
    const unsigned kl0 = kkey0 * 272 + kpart * 16, kl1 = kl0 + 32 * 272;
    const unsigned vl0 = vd0 * 144 + ((((vcc >> 2) * 2 + ((vcc & 3) >> 1)) * 2) * 16) + (vcc & 1) * 8, vl1 = vl0 + 64 * 144;
    v4u ka0, ka1, va0, va1, kb0, kb1, vb0, vb1;
#define AT_LOAD(s, k0, k1, v0, v1) do { const int j_ = (blist >> (4 * ((s) >> 2))) & 15, kt_ = (s) & 3; const size_t krow0 = (size_t)b * SEQ + j_ * 256 + kt_ * 64; \
        k0 = *(const v4u*)(Kb + (krow0 + kkey0) * AW + h * 128 + kpart * 8); k1 = *(const v4u*)(Kb + (krow0 + kkey0 + 32) * AW + h * 128 + kpart * 8); \
        v0 = *(const v4u*)(VTg + (size_t)(h * 128 + vd0) * T_TOK + krow0 + vcc * 8); v1 = *(const v4u*)(VTg + (size_t)(h * 128 + vd0 + 64) * T_TOK + krow0 + vcc * 8); } while (0)
#define AT_STORE(bufi, k0, k1, v0, v1) do { LAS unsigned char* KT_ = lds + AT_KT + (bufi) * 17408; LAS unsigned char* VT_ = lds + AT_VT + (bufi) * 18432; \
        *(LAS v4u*)(KT_ + kl0) = k0; *(LAS v4u*)(KT_ + kl1) = k1; \
        *(LAS u64*)(VT_ + vl0) = (u64)v0.x | ((u64)v0.y << 32); *(LAS u64*)(VT_ + vl0 + 16) = (u64)v0.z | ((u64)v0.w << 32); \
        *(LAS u64*)(VT_ + vl1) = (u64)v1.x | ((u64)v1.y << 32); *(LAS u64*)(VT_ + vl1 + 16) = (u64)v1.z | ((u64)v1.w << 32); } while (0)
    AT_LOAD(0, ka0, ka1, va0, va1);
    {
        const int qq = tid >> 1, q2 = tid & 1;
        unsigned mask = (1u << blk) - 1u;
        if (blk > 3) {
            const bf16* qrow = Qb + (size_t)(row_blk0 + qq) * AW + h * 128;
            v4u qv[8];
#pragma unroll
            for (int c8 = 0; c8 < 8; ++c8) qv[c8] = *(const v4u*)(qrow + 8 * (q2 + 2 * c8));
            float g0 = 0.f, g1 = 0.f, g2 = 0.f, g3 = 0.f, g4 = 0.f, g5 = 0.f, g6 = 0.f;
#pragma unroll
            for (int c8 = 0; c8 < 8; ++c8) { const float q[8] = {bf_lo(qv[c8].x), bf_hi(qv[c8].x), bf_lo(qv[c8].y), bf_hi(qv[c8].y), bf_lo(qv[c8].z), bf_hi(qv[c8].z), bf_lo(qv[c8].w), bf_hi(qv[c8].w)};
#pragma unroll
                for (int e = 0; e < 8; ++e) { const LAS float* km = KMs + 8 * (q2 + 2 * c8) + e;
                    g0 += q[e] * km[0]; g1 += q[e] * km[128]; g2 += q[e] * km[256]; g3 += q[e] * km[384]; g4 += q[e] * km[512]; g5 += q[e] * km[640]; g6 += q[e] * km[768]; } }
            g0 += __shfl_xor(g0, 1); g1 += __shfl_xor(g1, 1); g2 += __shfl_xor(g2, 1); g3 += __shfl_xor(g3, 1); g4 += __shfl_xor(g4, 1); g5 += __shfl_xor(g5, 1); g6 += __shfl_xor(g6, 1);
            const float NEGG = -3.0e38f;
            if (blk < 7) g6 = NEGG; if (blk < 6) g5 = NEGG; if (blk < 5) g4 = NEGG;
            mask = 0u;
#pragma unroll
            for (int s = 0; s < 3; ++s) { float best = g0; int bj = 0;
                if (g1 > best) { best = g1; bj = 1; } if (g2 > best) { best = g2; bj = 2; } if (g3 > best) { best = g3; bj = 3; }
                if (g4 > best) { best = g4; bj = 4; } if (g5 > best) { best = g5; bj = 5; } if (g6 > best) { best = g6; bj = 6; }
                mask |= 1u << bj;
                g0 = bj == 0 ? NEGG : g0; g1 = bj == 1 ? NEGG : g1; g2 = bj == 2 ? NEGG : g2; g3 = bj == 3 ? NEGG : g3; g4 = bj == 4 ? NEGG : g4; g5 = bj == 5 ? NEGG : g5; g6 = bj == 6 ? NEGG : g6; }
        }
        if (q2 == 0) { SELM[qq] = mask; __hip_atomic_fetch_or(UANY, mask, __ATOMIC_RELAXED, __HIP_MEMORY_SCOPE_WORKGROUP); }
    }
    __syncthreads();
    const unsigned uany = *UANY;
    for (int j = blk - 1; j >= 0; --j) if ((uany >> j) & 1u) { blist |= (unsigned)j << (4 * nb); ++nb; }
    const int nsteps = 4 * nb;
    const unsigned mymask = SELM[qi];
    AT_STORE(0, ka0, ka1, va0, va1);
    if (1 < nsteps) AT_LOAD(1, ka0, ka1, va0, va1);
    if (2 < nsteps) AT_LOAD(2, kb0, kb1, vb0, vb1);
    for (int s = 0; s < nsteps; ++s) {
        const int j = (blist >> (4 * (s >> 2))) & 15, kt = s & 3;
        __syncthreads();
        if ((s & 1) == 0) { if (s + 1 < nsteps) AT_STORE((s + 1) & 1, ka0, ka1, va0, va1); if (s + 3 < nsteps) AT_LOAD(s + 3, ka0, ka1, va0, va1); }
        else              { if (s + 1 < nsteps) AT_STORE((s + 1) & 1, kb0, kb1, vb0, vb1); if (s + 3 < nsteps) AT_LOAD(s + 3, kb0, kb1, vb0, vb1); }
        const LAS unsigned char* KT = lds + AT_KT + (s & 1) * 17408; const LAS unsigned char* VTl = lds + AT_VT + (s & 1) * 18432;
        bool part;
        if (j == blk) part = (64 * kt <= 32 * wave + 31);
        else part = (__ballot((mymask >> j) & 1u) != 0ull);
        if (part) {
            f32x16 S0, S1;
#pragma unroll
            for (int r = 0; r < 16; ++r) { S0[r] = 0.f; S1[r] = 0.f; }
            const LAS unsigned char* kp = KT + (lane & 31) * 272 + hh * 16;
#pragma unroll
            for (int ks = 0; ks < 8; ++ks) { const bf16x8 a0 = *(const LAS bf16x8*)(kp + ks * 32), a1 = *(const LAS bf16x8*)(kp + 32 * 272 + ks * 32);
                S0 = MFMA32(a0, Qf[ks], S0); S1 = MFMA32(a1, Qf[ks], S1); }
            const bool sel = ((mymask >> j) & 1u) != 0u;
            float mx = -1.0e30f; bool ok_row = true;
            const int dmin = 32 * wave + 256 * (blk - j) - 64 * kt - 63;
            if (dmin < 113) {
                const int dbase = (j == blk) ? (qi - 64 * kt - 4 * hh) : (qi + 256 - 64 * kt - 4 * hh);
                const bool okrow = (j == blk) ? true : sel;
#pragma unroll
                for (int r = 0; r < 16; ++r) { const int kk = (r & 3) + 8 * (r >> 2);
                    { const int dist = dbase - kk; const int di = dist < 0 ? 0 : (dist > 127 ? 127 : dist); const float v = (okrow && dist >= 0) ? S0[r] + B2[di] : -1.0e30f; S0[r] = v; mx = fmaxf(mx, v); }
                    { const int dist = dbase - 32 - kk; const int di = dist < 0 ? 0 : (dist > 127 ? 127 : dist); const float v = (okrow && dist >= 0) ? S1[r] + B2[di] : -1.0e30f; S1[r] = v; mx = fmaxf(mx, v); } }
            } else {
                ok_row = sel || (j == blk);
#pragma unroll
                for (int r = 0; r < 16; ++r) mx = fmaxf(mx, fmaxf(S0[r], S1[r]));
                mx = ok_row ? mx : -1.0e30f;
            }
            mx = fmaxf(mx, __shfl_xor(mx, 32));
            const bool need = mx > m_run + 8.f;
            if (__any(need)) { const float m_new = need ? mx : m_run, alpha = __builtin_amdgcn_exp2f(m_run - m_new);
                m_run = m_new; lsum *= alpha;
#pragma unroll
                for (int dt = 0; dt < 4; ++dt)
#pragma unroll
                    for (int r = 0; r < 16; ++r) O[dt][r] *= alpha; }
            float ps = 0.f;
            const float m_eff = ok_row ? m_run : 1.0e30f;
#pragma unroll
            for (int r = 0; r < 16; ++r) { S0[r] = __builtin_amdgcn_exp2f(S0[r] - m_eff); S1[r] = __builtin_amdgcn_exp2f(S1[r] - m_eff); ps += S0[r] + S1[r]; }
            lsum += ps;
            bf16x8 Pf[2][2];
#pragma unroll
            for (int s2 = 0; s2 < 2; ++s2) {
                v4u p0, p1;
                p0.x = cvtpk(S0[8 * s2], S0[8 * s2 + 1]); p0.y = cvtpk(S0[8 * s2 + 2], S0[8 * s2 + 3]); p0.z = cvtpk(S0[8 * s2 + 4], S0[8 * s2 + 5]); p0.w = cvtpk(S0[8 * s2 + 6], S0[8 * s2 + 7]);
                p1.x = cvtpk(S1[8 * s2], S1[8 * s2 + 1]); p1.y = cvtpk(S1[8 * s2 + 2], S1[8 * s2 + 3]); p1.z = cvtpk(S1[8 * s2 + 4], S1[8 * s2 + 5]); p1.w = cvtpk(S1[8 * s2 + 6], S1[8 * s2 + 7]);
                Pf[0][s2] = __builtin_bit_cast(bf16x8, p0); Pf[1][s2] = __builtin_bit_cast(bf16x8, p1); }
            const LAS unsigned char* vp = VTl + (lane & 31) * 144 + hh * 16;
#pragma unroll
            for (int dt = 0; dt < 4; ++dt)
#pragma unroll
                for (int mt = 0; mt < 2; ++mt)
#pragma unroll
                    for (int s2 = 0; s2 < 2; ++s2) { const bf16x8 a = *(const LAS bf16x8*)(vp + dt * 32 * 144 + (mt * 2 + s2) * 32); O[dt] = MFMA32(a, Pf[mt][s2], O[dt]); }
        }
    }
#undef AT_LOAD
#undef AT_STORE
    const float ltot = lsum + __shfl_xor(lsum, 32), inv = 1.f / ltot;
    unsigned char* orow = (unsigned char*)OATT + (size_t)(row_blk0 + qi) * DM + h * 128 + 4 * hh;
    const float osc = inv * OC8SCALE;
#pragma unroll
    for (int dt = 0; dt < 4; ++dt)
#pragma unroll
        for (int g4 = 0; g4 < 4; ++g4) { int p = __builtin_amdgcn_cvt_pk_fp8_f32(clamp8(O[dt][4 * g4] * osc), clamp8(O[dt][4 * g4 + 1] * osc), 0, false); p = __builtin_amdgcn_cvt_pk_fp8_f32(clamp8(O[dt][4 * g4 + 2] * osc), clamp8(O[dt][4 * g4 + 3] * osc), p, true);
            *(unsigned*)(orow + 32 * dt + 8 * g4) = (unsigned)p; }
}
constexpr int LR_XC = 0, LR_SEG = 2 * 17408, LR_W = LR_SEG + 2 * 4096;
#define MFMA16(a, b, c) __builtin_amdgcn_mfma_f32_16x16x32_bf16((a), (b), (c), 0, 0, 0)
__device__ __forceinline__ void lru_pair(const Params& P, LAS unsigned char* lds, int pair, int tid, int wave, int lane, unsigned* tkword, int& tk_next) {
    unsigned char* ws = P.ws;
    const int grp = wave >> 2, wq = wave & 3, tg = tid & 255;
    const int unit = 2 * pair + grp, b = unit >> 8, g = (unit >> 5) & 7, c = unit & 31;
    const bf16* XR = (const bf16*)(ws + WS_XR); const bf16* LWA = (const bf16*)(ws + WS_LWA) + (size_t)g * 16384; const bf16* LWX = (const bf16*)(ws + WS_LWX) + (size_t)g * 16384;
    float* HL = (float*)(ws + WS_HL); float* SUM = (float*)(ws + WS_SUM);
    LAS unsigned short* XC = (LAS unsigned short*)(lds + LR_XC + grp * 17408);
    LAS float* SEG = (LAS float*)(lds + LR_SEG + grp * 4096);
    LAS unsigned char* WL = lds + LR_W;
    const int t0 = c * 64; const size_t R0 = (size_t)b * SEQ + t0;
    __syncthreads();
    {
      v4u wv[8];
#pragma unroll
      for (int i = 0; i < 8; ++i) { const int q = tid + 512 * i, mat = q >> 11, row = (q >> 4) & 127, part = q & 15; wv[i] = *(const v4u*)((mat ? LWX : LWA) + row * 128 + part * 8); }
      const int cpart = tg & 15, C8 = g * 128 + 8 * cpart;
      f32x4 cw[4][2], cbv[2];
#pragma unroll
      for (int w = 0; w < 4; ++w) { cw[w][0] = *(const f32x4*)(P.conv_w + w * 1024 + C8); cw[w][1] = *(const f32x4*)(P.conv_w + w * 1024 + C8 + 4); }
      cbv[0] = *(const f32x4*)(P.conv_b + C8); cbv[1] = *(const f32x4*)(P.conv_b + C8 + 4);
#define LR_CONV_LOAD(xr, base) do { _Pragma("unroll") for (int i2 = 0; i2 < 2; ++i2) { const int tl = (tg >> 4) + 16 * ((base) + i2); \
          _Pragma("unroll") for (int w = 0; w < 4; ++w) { const int ts = t0 + tl - 3 + w; xr[i2][w] = (ts >= 0) ? *(const v4u*)(XR + ((size_t)b * SEQ + ts) * AW + C8) : (v4u){0u, 0u, 0u, 0u}; } } } while (0)
#define LR_CONV_DO(xr, base) do { _Pragma("unroll") for (int i2 = 0; i2 < 2; ++i2) { const int tl = (tg >> 4) + 16 * ((base) + i2); f32x4 y0 = cbv[0], y1 = cbv[1]; \
          _Pragma("unroll") for (int w = 0; w < 4; ++w) { y0 = y0 + bf4_lo2(xr[i2][w].x, xr[i2][w].y) * cw[w][0]; y1 = y1 + bf4_lo2(xr[i2][w].z, xr[i2][w].w) * cw[w][1]; } \
          v4u o; o.x = cvtpk(y0[0], y0[1]); o.y = cvtpk(y0[2], y0[3]); o.z = cvtpk(y1[0], y1[1]); o.w = cvtpk(y1[2], y1[3]); \
          *(LAS v4u*)((LAS unsigned char*)XC + tl * 272 + cpart * 16) = o; } } while (0)
      { v4u xr[2][4]; LR_CONV_LOAD(xr, 0);
#pragma unroll
        for (int i = 0; i < 8; ++i) { const int q = tid + 512 * i, mat = q >> 11, row = (q >> 4) & 127, part = q & 15; *(LAS v4u*)(WL + (mat * 128 + row) * 272 + part * 16) = wv[i]; }
        LR_CONV_DO(xr, 0); }
      { v4u xr[2][4]; LR_CONV_LOAD(xr, 2); LR_CONV_DO(xr, 2); }
#undef LR_CONV_LOAD
#undef LR_CONV_DO
    }
    __syncthreads();
    if (tid == 0) tk_next = (int)__hip_atomic_fetch_add(tkword, 1u, __ATOMIC_RELAXED, __HIP_MEMORY_SCOPE_AGENT);
    const int fr = lane & 15, fq = lane >> 4;
    float Ar[2][4][4], Hr[2][4][4], AE[2][4], HE[2][4];
#pragma unroll
    for (int nh = 0; nh < 2; ++nh) {
        f32x4 aA[4], aX[4];
#pragma unroll
        for (int nt = 0; nt < 4; ++nt) { aA[nt] = (f32x4){0.f, 0.f, 0.f, 0.f}; aX[nt] = (f32x4){0.f, 0.f, 0.f, 0.f}; }
#pragma unroll 1
        for (int ks = 0; ks < 4; ++ks) { const bf16x8 a = *(const LAS bf16x8*)((LAS unsigned char*)XC + (16 * wq + fr) * 272 + (32 * ks + 8 * fq) * 2);
#pragma unroll
            for (int nt = 0; nt < 4; ++nt) { const int wo = (64 * nh + 16 * nt + fr) * 272 + (32 * ks + 8 * fq) * 2;
                const bf16x8 ba = *(const LAS bf16x8*)(WL + wo), bx = *(const LAS bf16x8*)(WL + 128 * 272 + wo);
                aA[nt] = MFMA16(a, ba, aA[nt]); aX[nt] = MFMA16(a, bx, aX[nt]); } }
#pragma unroll
        for (int nt = 0; nt < 4; ++nt) { const int ch = 64 * nh + 16 * nt + fr, C = g * 128 + ch;
            const float ba = P.lru_ba[C], bx = P.lru_bx[C], lam = P.lru_lam[C];
            const float sp8 = 8.f * log1pf(__expf(-lam));
            float Ac = 1.f, Hc = 0.f;
#pragma unroll
            for (int r = 0; r < 4; ++r) { const int tok = 16 * wq + 4 * fq + r;
                const float rg = pg8::sigmoid_f(aA[nt][r] + ba), ig = pg8::sigmoid_f(aX[nt][r] + bx);
                const float log_a = -rg * sp8, a = __builtin_amdgcn_exp2f(log_a * 1.4426950408889634f);
                const float y = 2.f * log_a;
                const float em = (y > -0.25f) ? -y * (1.f + y * (0.5f + y * (0.16666667f + y * (0.041666668f + y * (0.0083333338f + y * 0.0013888889f))))) : 1.f - a * a;
                const float u = __builtin_amdgcn_sqrtf(em) * (ig * bf_lo((unsigned)XC[tok * 136 + ch]));
                Hc = a * Hc + u; Ac *= a; Ar[nh][nt][r] = Ac; Hr[nh][nt][r] = Hc; }
            float AI = Ac, HI = Hc;
            { const float Ap = __shfl_up(AI, 16), Hp = __shfl_up(HI, 16); if (fq >= 1) { HI = AI * Hp + HI; AI = AI * Ap; } }
            { const float Ap = __shfl_up(AI, 32), Hp = __shfl_up(HI, 32); if (fq >= 2) { HI = AI * Hp + HI; AI = AI * Ap; } }
            { const float Ap = __shfl_up(AI, 16), Hp = __shfl_up(HI, 16); AE[nh][nt] = fq >= 1 ? Ap : 1.f; HE[nh][nt] = fq >= 1 ? Hp : 0.f; }
            if (fq == 3) { SEG[(wq * 128 + ch) * 2] = AI; SEG[(wq * 128 + ch) * 2 + 1] = HI; } }
    }
    __syncthreads();
#pragma unroll
    for (int nh = 0; nh < 2; ++nh)
#pragma unroll
        for (int nt = 0; nt < 4; ++nt) { const int ch = 64 * nh + 16 * nt + fr, C = g * 128 + ch;
            float Aw = 1.f, Hw = 0.f;
#pragma unroll
            for (int w2 = 0; w2 < 3; ++w2) if (w2 < wq) { const float As = SEG[(w2 * 128 + ch) * 2], Hs = SEG[(w2 * 128 + ch) * 2 + 1]; Hw = As * Hw + Hs; Aw *= As; }
            const float hin = AE[nh][nt] * Hw + HE[nh][nt], ain = AE[nh][nt] * Aw;
            unsigned* ha = (unsigned*)HL + (R0 + 16 * wq + 4 * fq) * AW + C;
#pragma unroll
            for (int r = 0; r < 4; ++r) ha[(size_t)r * AW] = cvtpk(Ar[nh][nt][r] * hin + Hr[nh][nt][r], Ar[nh][nt][r] * ain);
            if (wq == 3 && fq == 3) { float* sm = SUM + ((size_t)(b * 32 + c) * 1024 + C) * 2; sm[0] = Ar[nh][nt][3] * ain; sm[1] = Ar[nh][nt][3] * hin + Hr[nh][nt][3]; } }
}

constexpr int SC_STR = 129, P7_SAB = 2 * 128 * SC_STR * 4, P7_IL = P7_SAB + 128 * 33 * 4, P7_CT = P7_IL + 128 * 34 * 2;
static_assert(P7_CT + 64 <= MISC_OFF, "P7 LDS map");
__device__ __forceinline__ unsigned ord_key(float v) { const unsigned u = __builtin_bit_cast(unsigned, v); return (u & 0x80000000u) ? ~u : (u | 0x80000000u); }
#define CE_DESC(x, y) do { const unsigned _x = (x), _y = (y); (x) = _x > _y ? _x : _y; (y) = _x > _y ? _y : _x; } while (0)
template <int B, int NA> __device__ __forceinline__ void sort16_desc(unsigned (&a)[NA]) {
#pragma unroll
    for (int k = 2; k <= 16; k <<= 1)
#pragma unroll
        for (int j = k >> 1; j > 0; j >>= 1)
#pragma unroll
            for (int i = 0; i < 16; ++i) { const int l = i ^ j; if (l > i) { if ((i & k) == 0) CE_DESC(a[B + i], a[B + l]); else CE_DESC(a[B + l], a[B + i]); } }
}
template <int A, int Bo, int NA, int NB> __device__ __forceinline__ void merge16_desc(unsigned (&a)[NA], const unsigned (&b)[NB]) {
#pragma unroll
    for (int i = 0; i < 16; ++i) a[A + i] = a[A + i] > b[Bo + 15 - i] ? a[A + i] : b[Bo + 15 - i];
#pragma unroll
    for (int j = 8; j > 0; j >>= 1)
#pragma unroll
        for (int i = 0; i < 16; ++i) { const int l = i ^ j; if (l > i) CE_DESC(a[A + i], a[A + l]); }
}
__device__ __forceinline__ void peer_topk_unit(const Params& P, LAS unsigned char* lds, int t0, int h, int tid, int wave, int lane) {
    unsigned char* ws = P.ws;
    const bf16* QP = (const bf16*)(ws + WS_QP); const bf16* KEYS = (const bf16*)(ws + WS_KEYS);
    unsigned short* IDX = (unsigned short*)(ws + WS_IDX); float* GW = (float*)(ws + WS_G);
    LAS float* SC = (LAS float*)lds; LAS float* SAB = (LAS float*)(lds + P7_SAB); LAS unsigned short* IL = (LAS unsigned short*)(lds + P7_IL); LAS unsigned char* CT = lds + P7_CT;
    __syncthreads();
    if (tid < 64) { int ia = 0, rem = tid; while (ia < 16 && rem >= 16 / (ia + 1)) { rem -= 16 / (ia + 1); ++ia; }
        CT[tid] = (unsigned char)(ia < 16 ? ia * 16 + rem : 255); }
    { const int mtile = wave & 3, c = wave >> 2, r31 = lane & 31, hh = lane >> 5;
      bf16x8 A[8];
      const bf16* qp = QP + (size_t)(t0 + 32 * mtile + r31) * DM + h * 256 + c * 128 + 8 * hh;
#pragma unroll
      for (int ks = 0; ks < 8; ++ks) A[ks] = *(const bf16x8*)(qp + 16 * ks);
#pragma unroll
      for (int nt = 0; nt < 4; ++nt) { f32x16 acc;
#pragma unroll
          for (int r = 0; r < 16; ++r) acc[r] = 0.f;
          const bf16* kp = KEYS + ((size_t)((h * 2 + c) * 128 + 32 * nt + r31)) * 128 + 8 * hh;
#pragma unroll
          for (int ks = 0; ks < 8; ++ks) { const bf16x8 bk = *(const bf16x8*)(kp + 16 * ks); acc = MFMA32(A[ks], bk, acc); }
#pragma unroll
          for (int r = 0; r < 16; ++r) { const int tok = 32 * mtile + (r & 3) + 8 * (r >> 2) + 4 * hh; SC[(c * 128 + tok) * SC_STR + 32 * nt + r31] = acc[r]; } } }
    __syncthreads();
    const int half = tid & 1, c = (tid >> 1) & 1, tok = tid >> 2;
    unsigned a[64];
    { const LAS float* sp = SC + (c * 128 + tok) * SC_STR + half * 64; const int rot = 8 * (2 * c + half);
#pragma unroll
      for (int i = 0; i < 64; ++i) { const int n = (i + rot) & 63; a[i] = (ord_key(sp[n]) & ~127u) | (unsigned)(127 - (half * 64 + n)); } }
    sort16_desc<0>(a); sort16_desc<16>(a); sort16_desc<32>(a); sort16_desc<48>(a);
    merge16_desc<0, 16>(a, a); merge16_desc<32, 48>(a, a); merge16_desc<0, 32>(a, a);
    { unsigned o[16];
#pragma unroll
      for (int j = 0; j < 16; ++j) o[j] = (unsigned)__shfl_xor((int)a[j], 1);
      merge16_desc<0, 0>(a, o); }
    if (half == 0) {
#pragma unroll
        for (int j = 0; j < 16; ++j) { const int n = 127 - (int)(a[j] & 127u); SAB[tok * 33 + c * 16 + j] = SC[(c * 128 + tok) * SC_STR + n]; IL[tok * 34 + c * 16 + j] = (unsigned short)n; } }
    __syncthreads();
    const int q = tid & 3;
    unsigned cd[16];
#pragma unroll
    for (int j = 0; j < 13; ++j) { const unsigned code = CT[q + 4 * j]; const float s = SAB[tok * 33 + ((code >> 4) & 15u)] + SAB[tok * 33 + 16 + (code & 15u)];
        cd[j] = code == 255u ? 0u : ((ord_key(s) & ~255u) | (255u - code)); }
    cd[13] = 0u; cd[14] = 0u; cd[15] = 0u;
    sort16_desc<0>(cd);
    { unsigned o[16];
#pragma unroll
      for (int j = 0; j < 16; ++j) o[j] = (unsigned)__shfl_xor((int)cd[j], 1);
      merge16_desc<0, 0>(cd, o);
#pragma unroll
      for (int j = 0; j < 16; ++j) o[j] = (unsigned)__shfl_xor((int)cd[j], 2);
      merge16_desc<0, 0>(cd, o); }
    if (q == 0) {
        float cv[16]; int id[16];
#pragma unroll
        for (int s = 0; s < 16; ++s) { const unsigned code = 255u - (cd[s] & 255u); const int ia = (int)(code >> 4), ib = (int)(code & 15u); const int na = IL[tok * 34 + ia], nb = IL[tok * 34 + 16 + ib];
            cv[s] = SAB[tok * 33 + ia] + SAB[tok * 33 + 16 + ib]; id[s] = na * 128 + nb; }
        float mx = cv[0];
#pragma unroll
        for (int s = 1; s < 16; ++s) mx = fmaxf(mx, cv[s]);
        float sum = 0.f;
#pragma unroll
        for (int s = 0; s < 16; ++s) { cv[s] = __builtin_amdgcn_exp2f((cv[s] - mx) * LOG2E); sum += cv[s]; }
        const float inv = 1.f / sum;
        unsigned short* ip = IDX + (size_t)(t0 + tok) * 128 + h * 16; float* gp = GW + (size_t)(t0 + tok) * 128 + h * 16;
#pragma unroll
        for (int s8 = 0; s8 < 2; ++s8) { v4u w_; w_.x = (unsigned)id[8 * s8] | ((unsigned)id[8 * s8 + 1] << 16); w_.y = (unsigned)id[8 * s8 + 2] | ((unsigned)id[8 * s8 + 3] << 16); w_.z = (unsigned)id[8 * s8 + 4] | ((unsigned)id[8 * s8 + 5] << 16); w_.w = (unsigned)id[8 * s8 + 6] | ((unsigned)id[8 * s8 + 7] << 16);
            *(v4u*)(ip + 8 * s8) = w_; }
#pragma unroll
        for (int s4 = 0; s4 < 4; ++s4) *(f32x4*)(gp + 4 * s4) = (f32x4){cv[4 * s4] * inv, cv[4 * s4 + 1] * inv, cv[4 * s4 + 2] * inv, cv[4 * s4 + 3] * inv};
    }
}

__device__ __forceinline__ void fp8x16_to_f32(const v4u& w, float (&f)[16]) {
#pragma unroll
    for (int i = 0; i < 4; ++i) { const f32x2_t lo = __builtin_amdgcn_cvt_pk_f32_fp8((int)w[i], false), hi = __builtin_amdgcn_cvt_pk_f32_fp8((int)w[i], true);
        f[4 * i] = lo[0]; f[4 * i + 1] = lo[1]; f[4 * i + 2] = hi[0]; f[4 * i + 3] = hi[1]; }
}
#define LD16I(dst, p) do { const v4u a_ = ((const v4u*)(p))[0], b_ = ((const v4u*)(p))[1]; dst[0] = a_.x; dst[1] = a_.y; dst[2] = a_.z; dst[3] = a_.w; dst[4] = b_.x; dst[5] = b_.y; dst[6] = b_.z; dst[7] = b_.w; } while (0)
#define IDROW(ids, j) ((((j) & 1) ? ((unsigned)(ids)[(j) >> 1] >> 9) : ((unsigned)(ids)[(j) >> 1] << 7)) & 0x1fff80u)
#define LD16F(dst, p) do { _Pragma("unroll") for (int q_ = 0; q_ < 4; ++q_) { const f32x4 v_ = ((const f32x4*)(p))[q_]; dst[4 * q_] = v_[0]; dst[4 * q_ + 1] = v_[1]; dst[4 * q_ + 2] = v_[2]; dst[4 * q_ + 3] = v_[3]; } } while (0)
__device__ __forceinline__ void peer_u_phase(const Params& P, int xg, int slot, int nslots, int lane) {
    unsigned char* ws = P.ws;
    const bf16* X1B = (const bf16*)(ws + WS_X1B); const unsigned char* U8 = ws + WS_U8; const unsigned short* IDX = (const unsigned short*)(ws + WS_IDX); bf16* PD = (bf16*)(ws + WS_PD) + (size_t)xg * T_TOK * 128;
    const int ntok = slot < T_TOK ? (T_TOK - slot + nslots - 1) / nslots : 0, N = 2 * ntok;
    if (N == 0) return;
    const int R = lane >> 3, p = lane & 7;
    const bool b2 = (lane & 4) != 0, b1 = (lane & 2) != 0, b0 = (lane & 1) != 0;
    unsigned I0[8], I1[8], I2[8]; v4u X0[2], X1[2], X2[2]; v4u B0[8], B1[8], B2[8];
#define U_ITEM(n, t, s) const int n_##t = (n) < N ? (n) : N - 1; const int t = slot + (n_##t >= ntok ? n_##t - ntok : n_##t) * nslots, s = 2 * xg + (n_##t >= ntok ? 1 : 0)
#define U_ROWS(buf, ids, off, s) do { const unsigned char* ub_ = U8 + (size_t)(s) * NEXP * 128; _Pragma("unroll") for (int i = 0; i < 8; ++i) buf[i] = *(const v4u*)(ub_ + (IDROW(ids, (off) + i) + 16u * p)); } while (0)
#define U_HALF(buf, off) do { _Pragma("unroll") for (int i = 0; i < 8; ++i) { int d = 0; _Pragma("unroll") for (int w = 0; w < 4; ++w) d = __builtin_amdgcn_sdot4((int)buf[i][w], xq[w], d, false); part[(off) + i] = d; } } while (0)
#define U_X(dst, t, s) do { const bf16* xp_ = X1B + (size_t)(t) * DM + 128 * (s) + 16 * p; dst[0] = *(const v4u*)xp_; dst[1] = *(const v4u*)(xp_ + 8); } while (0)
    const int i0 = ((lane & 4) ? 8 : 0) + ((lane & 2) ? 4 : 0) + ((lane & 1) ? 2 : 0);
    { U_ITEM(0, t0, s0); U_ITEM(1, t1, s1); U_ITEM(2, t2, s2);
      unsigned id0[8];
      LD16I(id0, IDX + (size_t)t0 * 128 + 16 * R); LD16I(I0, IDX + (size_t)t1 * 128 + 16 * R); LD16I(I1, IDX + (size_t)t2 * 128 + 16 * R);
      U_X(X0, t0, s0); U_X(X1, t1, s1);
      U_ROWS(B0, id0, 0, s0); U_ROWS(B1, id0, 8, s0); }
#define U_BODY(n, Ba, Bb, Bc, Ia, Ib, Ic, Xa, Xb, Xc) do { \
        U_ITEM(n, t, s); U_ITEM((n) + 1, t1, s1); U_ITEM((n) + 2, t2, s2); U_ITEM((n) + 3, t3, s3); (void)s; (void)s3; \
        unsigned* pp = (unsigned*)(PD + (size_t)t * 128 + 16 * R + i0); \
        unsigned pold = 0u; if ((n) >= ntok) pold = *pp; \
        U_ROWS(Bc, Ia, 0, s1); \
        LD16I(Ic, IDX + (size_t)t3 * 128 + 16 * R); \
        U_X(Xc, t2, s2); \
        float x[16]; float am = 0.f; \
        _Pragma("unroll") for (int k = 0; k < 4; ++k) { x[2 * k] = bf_lo(Xa[0][k]); x[2 * k + 1] = bf_hi(Xa[0][k]); x[8 + 2 * k] = bf_lo(Xa[1][k]); x[8 + 2 * k + 1] = bf_hi(Xa[1][k]); } \
        _Pragma("unroll") for (int k = 0; k < 16; ++k) am = fmaxf(am, fabsf(x[k])); \
        am = fmaxf(am, __shfl_xor(am, 1)); am = fmaxf(am, __shfl_xor(am, 2)); am = fmaxf(am, __shfl_xor(am, 4)); \
        const float xs = am > 0.f ? am * (1.f / 127.f) : 1.f, xinv = 1.f / xs; \
        int xq[4]; \
        _Pragma("unroll") for (int w = 0; w < 4; ++w) { const int q0 = (int)rintf(x[4 * w] * xinv), q1 = (int)rintf(x[4 * w + 1] * xinv), q2 = (int)rintf(x[4 * w + 2] * xinv), q3 = (int)rintf(x[4 * w + 3] * xinv); \
            xq[w] = (int)((unsigned)(q0 & 255) | ((unsigned)(q1 & 255) << 8) | ((unsigned)(q2 & 255) << 16) | ((unsigned)q3 << 24)); } \
        int part[16]; \
        U_HALF(Ba, 0); \
        U_ROWS(Ba, Ia, 8, s1); \
        U_HALF(Bb, 8); \
        if ((n) < N) { \
            int a8[8], a4[4], a2i[2]; \
            _Pragma("unroll") for (int k = 0; k < 8; ++k) { const int send = b2 ? part[k] : part[k + 8], keep = b2 ? part[k + 8] : part[k]; a8[k] = keep + __shfl_xor(send, 4); } \
            _Pragma("unroll") for (int k = 0; k < 4; ++k) { const int send = b1 ? a8[k] : a8[k + 4], keep = b1 ? a8[k + 4] : a8[k]; a4[k] = keep + __shfl_xor(send, 2); } \
            _Pragma("unroll") for (int k = 0; k < 2; ++k) { const int send = b0 ? a4[k] : a4[k + 2], keep = b0 ? a4[k + 2] : a4[k]; a2i[k] = keep + __shfl_xor(send, 1); } \
            *pp = cvtpk((float)a2i[0] * xs + bf_lo(pold), (float)a2i[1] * xs + bf_hi(pold)); } } while (0)
    for (int n = 0; n < N; n += 3) { U_BODY(n, B0, B1, B2, I0, I1, I2, X0, X1, X2); U_BODY(n + 1, B2, B0, B1, I1, I2, I0, X1, X2, X0); U_BODY(n + 2, B1, B2, B0, I2, I0, I1, X2, X0, X1); }
#undef U_X
#undef U_ITEM
#undef U_ROWS
#undef U_HALF
#undef U_BODY
}
__device__ __forceinline__ void peer_act_tokens(const Params& P, int t, int t2, int lane) {
    unsigned char* ws = P.ws;
    const unsigned short* PD = (const unsigned short*)(ws + WS_PD); const unsigned short* IDX = (const unsigned short*)(ws + WS_IDX); const float* GW = (const float*)(ws + WS_G); const float* SSP = (const float*)(ws + WS_SSP);
    const float* US = (const float*)(ws + WS_US); const float* VS = (const float*)(ws + WS_VS); unsigned char* ACT8 = ws + WS_ACT; float* ASC = (float*)(ws + WS_ACT + 4 * MiB);
    const bool two = t2 >= 0; const int tt[2] = {t, two ? t2 : t};
    float ss[2], d[2][2], gw[2][2], us[2][2], vs[2][2]; int id[2][2];
#pragma unroll
    for (int k = 0; k < 2; ++k) { ss[k] = lane < 32 ? SSP[(size_t)tt[k] * 32 + lane] : 0.f;
#pragma unroll
        for (int s = 0; s < 2; ++s) { const int slot = 64 * s + lane; id[k][s] = (int)IDX[(size_t)tt[k] * 128 + slot]; gw[k][s] = GW[(size_t)tt[k] * 128 + slot]; float a = 0.f;
#pragma unroll
            for (int xg = 0; xg < 8; ++xg) a += __builtin_bit_cast(float, (unsigned)PD[((size_t)xg * T_TOK + tt[k]) * 128 + slot] << 16);
            d[k][s] = a; } }
#pragma unroll
    for (int k = 0; k < 2; ++k)
#pragma unroll
        for (int s = 0; s < 2; ++s) { us[k][s] = US[id[k][s]]; vs[k][s] = VS[id[k][s]]; }
#pragma unroll
    for (int k = 0; k < 2; ++k) { const float rs = __builtin_amdgcn_rsqf(wave_sum(ss[k]) * (1.f / 2048.f) + RMS_EPS);
        float av[2]; float am = 0.f;
#pragma unroll
        for (int s = 0; s < 2; ++s) { av[s] = pg8::gelu_tanh_f(d[k][s] * us[k][s] * rs) * gw[k][s] * vs[k][s]; am = fmaxf(am, fabsf(av[s])); }
#pragma unroll
        for (int o = 1; o < 64; o <<= 1) am = fmaxf(am, __shfl_xor(am, o));
        const float sc = am > 0.f ? am * (1.f / 448.f) : 1.f, inv = 1.f / sc;
        if (k == 0 || two) {
#pragma unroll
            for (int s = 0; s < 2; ++s) { const float q = av[s] * inv; const int hi = __builtin_amdgcn_cvt_pk_fp8_f32(q, q, 0, false) & 255; const float hv = __builtin_amdgcn_cvt_f32_fp8(hi, 0);
                const int lo = __builtin_amdgcn_cvt_pk_fp8_f32((q - hv) * 16.f, 0.f, 0, false) & 255;
                ACT8[((size_t)tt[k] * 2 + 0) * 128 + 64 * s + lane] = (unsigned char)hi; ACT8[((size_t)tt[k] * 2 + 1) * 128 + 64 * s + lane] = (unsigned char)lo; }
            if (lane == 0) ASC[tt[k]] = sc; } }
    if (t == 0 && lane < 8) ((unsigned*)(ws + WS_ACT + 8 * MiB))[lane] = 0u;
}
typedef int v2i_t __attribute__((ext_vector_type(2)));
constexpr int VP_PITCH = 144, VP_WAVE = 128 * VP_PITCH;
static_assert(NWAVES * VP_WAVE + NWAVES * 512 <= MISC_OFF, "v-phase LDS images + output staging");
__device__ __forceinline__ void peer_v_phase(const Params& P, LAS unsigned char* lds, int xg, int slot, int nslots, int wave, int lane) {
    unsigned char* ws = P.ws;
    const unsigned char* V8 = ws + WS_V8; const unsigned short* IDX = (const unsigned short*)(ws + WS_IDX); const unsigned char* ACT8 = ws + WS_ACT; const float* ASC = (const float*)(ws + WS_ACT + 4 * MiB); bf16* OUTP = (bf16*)(ws + WS_OUTP);
    const int ntok = slot < T_TOK ? (T_TOK - slot + nslots - 1) / nslots : 0, N = 2 * ntok;
    if (N == 0) return;
    const int R = lane >> 3, p = lane & 7;
    const int am = lane & 15, akq = lane >> 4;
    LAS unsigned char* const wb = lds + wave * VP_WAVE + (16 * R) * VP_PITCH + 16 * p;
    LAS unsigned char* const rb = lds + wave * VP_WAVE + (32 * akq + ((lane & 15) >> 1)) * VP_PITCH + 8 * (lane & 1);
    unsigned In[8], Iq[8]; v4u Aa[2], Ab[2]; float Sa = 0.f, Sb = 0.f; v4u B0[8], B1[8], B2[8], B3[8];
#define V_ITEM(n, t, s) const int n_##t = (n) < N ? (n) : N - 1; const int t = slot + (n_##t >= ntok ? n_##t - ntok : n_##t) * nslots, s = 2 * xg + (n_##t >= ntok ? 1 : 0)
#define V_ROWS(buf, ids, off, s) do { const unsigned char* vb_ = V8 + (size_t)(s) * NEXP * 128; _Pragma("unroll") for (int i = 0; i < 8; ++i) buf[i] = *(const v4u*)(vb_ + (IDROW(ids, (off) + i) + 16u * p)); } while (0)
#define V_AOP(dst, sdst, t) do { const unsigned ao_ = am < 2 ? (unsigned)(((t) * 2 + am) * 128 + 32 * akq) : (unsigned)(8 * MiB); const unsigned char* ap_ = ACT8 + ao_;        \
        dst[0] = *(const v4u*)ap_; dst[1] = *(const v4u*)(ap_ + 16); (void)sdst; } while (0)
#define V_TOLDS(buf, off) do { _Pragma("unroll") for (int i = 0; i < 8; ++i) *(LAS v4u*)(wb + ((off) + i) * VP_PITCH) = buf[i]; } while (0)
    { V_ITEM(0, t0, s0); V_ITEM(1, t1, s1); V_ITEM(2, t2, s2); (void)s2;
      unsigned id0[8], id1[8];
      LD16I(id0, IDX + (size_t)t0 * 128 + 16 * R); LD16I(id1, IDX + (size_t)t1 * 128 + 16 * R); LD16I(In, IDX + (size_t)t2 * 128 + 16 * R);
      V_AOP(Aa, Sa, t0);
      V_ROWS(B0, id0, 0, s0); V_ROWS(B1, id0, 8, s0); V_ROWS(B2, id1, 0, s1); V_ROWS(B3, id1, 8, s1); }
#define V_BODY(n, Ba, Bb) do { \
        V_ITEM(n, t, s); V_ITEM((n) + 1, t1, s1); V_ITEM((n) + 2, t2, s2); V_ITEM((n) + 3, t3, s3); (void)s1; (void)s3; \
        V_TOLDS(Ba, 0); \
        V_ROWS(Ba, In, 0, s2); \
        V_TOLDS(Bb, 8); \
        V_ROWS(Bb, In, 8, s2); \
        LD16I(Iq, IDX + (size_t)t3 * 128 + 16 * R); V_AOP(Ab, Sb, t1); \
        const pg8::i32x8 aop = __builtin_shufflevector(__builtin_bit_cast(pg8::i32x4, Aa[0]), __builtin_bit_cast(pg8::i32x4, Aa[1]), 0, 1, 2, 3, 4, 5, 6, 7); \
        unsigned char* op_ = (unsigned char*)OUTP + (unsigned)(((unsigned)t * DM + 128 * s + 8 * lane) * 2); const bool st_ = (n) < N && lane < 16; LAS unsigned char* ob_ = lds + NWAVES * VP_WAVE + wave * 512 + 2 * lane;        \
        _Pragma("unroll") for (int jj = 0; jj < 4; ++jj) {        \
            pg8::i32x8 bop0, bop1; \
            _Pragma("unroll") for (int blk = 0; blk < 4; ++blk) { const v2i_t r0_ = __builtin_amdgcn_ds_read_tr8_b64_v2i32((LAS v2i_t*)(rb + blk * 8 * VP_PITCH + 16 * (2 * jj))), r1_ = __builtin_amdgcn_ds_read_tr8_b64_v2i32((LAS v2i_t*)(rb + blk * 8 * VP_PITCH + 16 * (2 * jj + 1))); \
                bop0[2 * blk] = r0_.x; bop0[2 * blk + 1] = r0_.y; bop1[2 * blk] = r1_.x; bop1[2 * blk + 1] = r1_.y; } \
            const f32x4 c0_ = __builtin_amdgcn_mfma_scale_f32_16x16x128_f8f6f4(aop, bop0, (f32x4){0.f, 0.f, 0.f, 0.f}, 0, 0, 0, 0x7f7f7f7f, 0, 0x7f7f7f7f); \
            const f32x4 c1_ = __builtin_amdgcn_mfma_scale_f32_16x16x128_f8f6f4(aop, bop1, (f32x4){0.f, 0.f, 0.f, 0.f}, 0, 0, 0, 0x7f7f7f7f, 0, 0x7f7f7f7f); \
            if (lane < 16) { *(LAS unsigned short*)(ob_ + 64 * jj) = (unsigned short)(cvtpk(c0_[0] + c0_[1] * 0.0625f, 0.f) & 0xffffu); *(LAS unsigned short*)(ob_ + 64 * jj + 32) = (unsigned short)(cvtpk(c1_[0] + c1_[1] * 0.0625f, 0.f) & 0xffffu); } \
            __builtin_amdgcn_sched_barrier(0); } \
        asm volatile("" ::: "memory"); \
        if (st_) *(v4u*)op_ = *(const LAS v4u*)(lds + NWAVES * VP_WAVE + wave * 512 + 16 * lane);        \
        _Pragma("unroll") for (int i = 0; i < 8; ++i) In[i] = Iq[i]; \
        Aa[0] = Ab[0]; Aa[1] = Ab[1]; Sa = Sb; } while (0)
    for (int n = 0; n < N; n += 2) { V_BODY(n, B0, B1); V_BODY(n + 1, B2, B3); }
#undef V_ITEM
#undef V_ROWS
#undef V_AOP
#undef V_TOLDS
#undef V_BODY
}
__device__ __forceinline__ void peer_final_tokens(const Params& P, int t, int t2, int lane, float* outp) {
    const bool two = t2 >= 0; const int tt[2] = {t, two ? t2 : t};
    v4u a[2][4], b[2][4]; float asc[2];
#pragma unroll
    for (int k = 0; k < 2; ++k) { asc[k] = ((const float*)(P.ws + WS_ACT + 4 * MiB))[tt[k]]; const bf16* xrow = (const bf16*)(P.ws + WS_X1B) + (size_t)tt[k] * DM; const bf16* prow = (const bf16*)(P.ws + WS_OUTP) + (size_t)tt[k] * DM;
#pragma unroll
        for (int j = 0; j < 4; ++j) { a[k][j] = *(const v4u*)(xrow + 512 * j + 8 * lane); b[k][j] = *(const v4u*)(prow + 512 * j + 8 * lane); } }
#pragma unroll
    for (int k = 0; k < 2; ++k) { if (k == 1 && !two) break;
        float v[4][8]; float ss = 0.f;
#pragma unroll
        for (int j = 0; j < 4; ++j) {
#pragma unroll
            for (int i = 0; i < 4; ++i) { v[j][2 * i] = bf_lo(a[k][j][i]) + bf_lo(b[k][j][i]) * asc[k]; v[j][2 * i + 1] = bf_hi(a[k][j][i]) + bf_hi(b[k][j][i]) * asc[k]; }
#pragma unroll
            for (int i = 0; i < 8; ++i) ss += v[j][i] * v[j][i]; }
        const float rf = __builtin_amdgcn_rsqf(wave_sum(ss) * (1.f / 2048.f) + RMS_EPS);
        float* orow = outp + (size_t)tt[k] * DM;
#pragma unroll
        for (int j = 0; j < 4; ++j) { const f32x4 g0 = *(const f32x4*)(P.g_fin + 512 * j + 8 * lane), g1 = *(const f32x4*)(P.g_fin + 512 * j + 8 * lane + 4); f32x4 o0, o1;
#pragma unroll
            for (int i = 0; i < 4; ++i) { o0[i] = v[j][i] * rf * g0[i]; o1[i] = v[j][4 + i] * rf * g1[i]; }
            *(f32x4*)(orow + 512 * j + 8 * lane) = o0; *(f32x4*)(orow + 512 * j + 8 * lane + 4) = o1; } }
}

#ifndef MK_PER_PHASE
#define MK_PER_PHASE 0
#endif
constexpr int N_PHASES = 12;
constexpr int TAB_U_P1 = 9216;
constexpr int P2_NCONV = 80;
__global__ void __launch_bounds__(NWAVES * 64, 2) fwd_kernel(Params P) {
    extern __shared__ __attribute__((aligned(16))) unsigned char lds_raw[];
    LAS unsigned char* lds = (LAS unsigned char*)lds_raw;
    volatile LAS unsigned* MISC = (volatile LAS unsigned*)(lds + MISC_OFF);
    const int tid = threadIdx.x, lane = tid & 63, wave = __builtin_amdgcn_readfirstlane(tid >> 6);
    const int G = gridDim.x; const int bx = blockIdx.x;
    const int vcu = (G % 8 == 0) ? (bx % 8) * (G / 8) + bx / 8 : bx;
    const int gw = vcu * NWAVES + wave, NGW = G * NWAVES;
    unsigned char* ws = P.ws;
    gu32* ctl = (gu32*)(ws + WS_CTL);
    for (int u = tid; u < 64; u += NWAVES * 64) MISC[u] = 0u;
    __syncthreads();
    XcdBarrier bar; bar.bar = (unsigned*)ctl + CW_BAR; bar.x = 0; bar.st = nullptr;
    if (!MK_PER_PHASE) bar = xcd_barrier_post((unsigned*)ctl + CW_BAR, MISC + 8);
    const unsigned my_xcc = xb_xcc_id();
    if (!MK_PER_PHASE) { if (tid == 0) MISC[16] = __hip_atomic_fetch_add((unsigned*)(ctl + CW_XC + 64 * (my_xcc & 7u)), 1u, __ATOMIC_RELAXED, __HIP_MEMORY_SCOPE_AGENT); }
    const int lo = P.ph_lo, hi = P.ph_hi;
#define FRESH_IDS const int lane = (int)__builtin_amdgcn_mbcnt_hi(~0u, __builtin_amdgcn_mbcnt_lo(~0u, 0u)); const int tid = wave * 64 + lane; (void)tid; (void)lane
#ifndef PH_MASK
#define PH_MASK 0xfff
#endif
#define IN(k) (((PH_MASK >> (k)) & 1) && lo <= (k) && (k) < hi)
#define BOTH(k) (IN(k) && IN((k) + 1))
#ifndef DUP_MASK
#define DUP_MASK 0
#endif
#define NREP(k) (((DUP_MASK >> (k)) & 1) ? 2 : 1)
#define GRID_BAR() do { if (!MK_PER_PHASE) xcd_barrier(bar); } while (0)
#ifdef TPROBE
#define TP_T0 (wave == 0 && __builtin_amdgcn_mbcnt_hi(~0u, __builtin_amdgcn_mbcnt_lo(~0u, 0u)) == 0u)
#define TP_ORD(k) ((k) < 7 ? (k) : (k) - 1)
    if (TP_T0) MISC[40] = (unsigned)__builtin_amdgcn_s_memrealtime();
#define TP_STAMP(w) do { MISC[(w)] = (unsigned)__builtin_amdgcn_s_memrealtime(); } while (0)
#define GRID_BAR_K(k) do { xcd_barrier(bar); MISC[41 + TP_ORD(k)] = (unsigned)__builtin_amdgcn_s_memrealtime(); } while (0)
#else
#define TP_STAMP(w) do { } while (0)
#define GRID_BAR_K(k) GRID_BAR()
#endif

    bf16* HN = (bf16*)(ws + WS_HN); bf16* WA = (bf16*)(ws + WS_WA); bf16* WV = (bf16*)(ws + WS_WV); bf16* WB = (bf16*)(ws + WS_WB); bf16* WO = (bf16*)(ws + WS_WO); bf16* WQ = (bf16*)(ws + WS_WQ);

    constexpr int NV_UNITS = (AW / 256) * (T_TOK / 256);
    const bool tab_fast = G > NV_UNITS;
    const int tab_r1 = tab_fast ? 0 : NEXP;
    if (IN(0)) { FRESH_IDS; for (int rep = 0; rep < NREP(0); ++rep) p0_prologue(P, lds, gw, NGW, wave, lane, tab_r1); TP_STAMP(53); if (BOTH(0)) GRID_BAR_K(0); }

    if (IN(1)) { FRESH_IDS;
      _Pragma("unroll") for (int rep = 0; rep < NREP(1); ++rep) {
        { pg8::Gemm g{HN, WA, T_TOK, NWA, DM / 2, WV, HN, ws, (unsigned)WS_END}; pg8::StaticOrder2 S; S.init(T_TOK, NWA, AW, T_TOK, G, bx);
          typedef pg8::EpiProjT<WS_Q, WS_K, WS_XR, WS_GY, WS_SG, WS_VT, WS_CTL + 4 * (size_t)CW_KM> EpiProj;
          EpiProj E{ws, rep == 0, QSCALE, 1.f / W8SCALE};
          pg8::gemm_phase<EpiProj, pg8::StaticOrder2, true, true, true>(lds, g, S, E); }
        TP_STAMP(54);
        if (tab_fast && bx >= NV_UNITS) peer_table_u<2>(P, 0, TAB_U_P1, (bx - NV_UNITS) * NWAVES + wave, (G - NV_UNITS) * NWAVES, lane);
      }
        TP_STAMP(55); if (BOTH(1)) GRID_BAR_K(1);
    }

    if (IN(2)) { FRESH_IDS;
        LAS int* tick = (LAS int*)(lds + MISC_OFF + 128);
#define NEXT_TICKET(dst, word) do { __syncthreads(); if (tid == 0) *tick = (int)__hip_atomic_fetch_add((unsigned*)(ctl + (word)), 1u, __ATOMIC_RELAXED, __HIP_MEMORY_SCOPE_AGENT); __syncthreads(); dst = *tick; } while (0)
#define TICKET_ISSUE(word) do { if (tid == 0) tk_next = (int)__hip_atomic_fetch_add((unsigned*)(ctl + (word)), 1u, __ATOMIC_RELAXED, __HIP_MEMORY_SCOPE_AGENT); } while (0)
#define TICKET_TAKE(dst) do { __syncthreads(); if (tid == 0) *tick = tk_next; __syncthreads(); dst = *tick; } while (0)
        int tk_next = 0;
        if (G > NV_UNITS && (int)blockIdx.x < P2_NCONV) { tt_run(P, lds, TT_IN, TT_N, (int)blockIdx.x, P2_NCONV, tid, wave, lane);
            peer_table_v<4>(P, 0, NEXP, (int)blockIdx.x * NWAVES + wave, P2_NCONV * NWAVES, lane); peer_table_u<4>(P, TAB_U_P1, NEXP, (int)blockIdx.x * NWAVES + wave, P2_NCONV * NWAVES, lane); }
#ifndef DUP_ATT
#define DUP_ATT 0
#endif
#ifndef DUP_LRU
#define DUP_LRU 0
#endif
#ifndef DUP_P2
#define DUP_P2 0
#endif
        _Pragma("unroll") for (int rp = 0; rp < 1 + DUP_P2; ++rp) {
        _Pragma("unroll") for (int rep = 0; rep < 1 + DUP_ATT; ++rep) {
            int tid2 = tid; asm volatile("" : "+v"(tid2));
            int it; NEXT_TICKET(it, CW_Q2 + 64 * (rep + 2 * rp));
            while (it < 256) { const int blk = 7 - (it >> 5), bh = it & 31; attn_unit(P, lds, bh >> 3, bh & 7, blk, tid2, wave, tid2 & 63); NEXT_TICKET(it, CW_Q2 + 64 * (rep + 2 * rp)); } }
        TP_STAMP(56);
        _Pragma("unroll") for (int rep = 0; rep < 1 + DUP_LRU; ++rep) {
            int tid2 = tid; asm volatile("" : "+v"(tid2));
            int it; NEXT_TICKET(it, CW_Q2 + 256 + 64 * (rep + 2 * rp));
            while (it < 512) { lru_pair(P, lds, it, tid2, wave, tid2 & 63, (unsigned*)(ctl + CW_Q2 + 256 + 64 * (rep + 2 * rp)), tk_next); TICKET_TAKE(it); } }
        if (DUP_P2 && rp == 0) GRID_BAR();
        }
#undef NEXT_TICKET
#undef TICKET_ISSUE
#undef TICKET_TAKE
        TP_STAMP(57); if (BOTH(2)) GRID_BAR_K(2);
    }

    if (IN(3)) { FRESH_IDS;
      _Pragma("unroll") for (int rep = 0; rep < NREP(3); ++rep) {
        const unsigned* HLAC = (const unsigned*)(ws + WS_HL); const float* SUM = (const float*)(ws + WS_SUM);
        const bf16* GY = (const bf16*)(ws + WS_GY); unsigned char* OCAT = ws + WS_OCAT;
        for (int u = vcu; u < 256; u += G) { const int b = u >> 6, c = (u >> 1) & 31, C = (u & 1) * 512 + 4 * (tid & 127), tq = tid >> 7;
            f32x4 carry = (f32x4){0.f, 0.f, 0.f, 0.f};
            for (int c0 = 0; c0 < c; c0 += 8) {
                f32x4 s0[8], s1[8];
#pragma unroll
                for (int j = 0; j < 8; ++j) { const int cc = c0 + j < c ? c0 + j : c - 1; const float* sm = SUM + ((size_t)(b * 32 + cc) * 1024 + C) * 2; s0[j] = *(const f32x4*)sm; s1[j] = *(const f32x4*)(sm + 4); }
#pragma unroll
                for (int j = 0; j < 8; ++j) if (c0 + j < c) { carry[0] = s0[j][0] * carry[0] + s0[j][1]; carry[1] = s0[j][2] * carry[1] + s0[j][3]; carry[2] = s1[j][0] * carry[2] + s1[j][1]; carry[3] = s1[j][2] * carry[3] + s1[j][3]; } }
            const size_t R0 = (size_t)b * SEQ + c * 64 + tq * 16;
#pragma unroll 8
            for (int t = 0; t < 16; ++t) { const size_t o = (R0 + t) * AW + C; const v4u ha = *(const v4u*)(HLAC + o);
                const f32x4 hv = (f32x4){bf_lo(ha.x) + bf_hi(ha.x) * carry[0], bf_lo(ha.y) + bf_hi(ha.y) * carry[1], bf_lo(ha.z) + bf_hi(ha.z) * carry[2], bf_lo(ha.w) + bf_hi(ha.w) * carry[3]};
                const unsigned long long gy = *(const unsigned long long*)(GY + o); const unsigned g0 = (unsigned)gy, g1 = (unsigned)(gy >> 32);
                int p = __builtin_amdgcn_cvt_pk_fp8_f32(clamp8(hv[0] * bf_lo(g0) * OC8SCALE), clamp8(hv[1] * bf_hi(g0) * OC8SCALE), 0, false); p = __builtin_amdgcn_cvt_pk_fp8_f32(clamp8(hv[2] * bf_lo(g1) * OC8SCALE), clamp8(hv[3] * bf_hi(g1) * OC8SCALE), p, true);
                *(unsigned*)(OCAT + (R0 + t) * DM + AW + C) = (unsigned)p; } }
      }
        TP_STAMP(58); if (BOTH(3)) GRID_BAR_K(3);
    }

    if (IN(4)) { FRESH_IDS;
      _Pragma("unroll") for (int rep = 0; rep < NREP(4); ++rep) {
        { pg8::Gemm g{(bf16*)(ws + WS_OCAT), WB, T_TOK, DM, DM / 2, nullptr, nullptr, ws, (unsigned)WS_END}; pg8::StaticOrder S; S.init(T_TOK, DM, G, bx);
          typedef pg8::EpiMerge2T<WS_SG, WS_MG> EpiMerge2;
          EpiMerge2 E{ws, MG8SCALE / (OC8SCALE * WB8SCALE)};
          pg8::gemm_phase<EpiMerge2, pg8::StaticOrder, true, true, true>(lds, g, S, E); }
      }
        if (BOTH(4)) GRID_BAR_K(4);
    }

    if (IN(5)) { FRESH_IDS;
      _Pragma("unroll") for (int rep = 0; rep < NREP(5); ++rep) {
        pg8::Gemm g{(bf16*)(ws + WS_MG), WO, T_TOK, DM, DM / 2, nullptr, nullptr, ws, (unsigned)WS_END}; pg8::StaticOrder S; S.init(T_TOK, DM, G, bx);
        pg8::EpiResid E{P.x, (bf16*)(ws + WS_X1B), (float*)(ws + WS_SSP), 1.f / (W8SCALE * MG8SCALE)};
        pg8::gemm_phase<pg8::EpiResid, pg8::StaticOrder, true, true, true>(lds, g, S, E);
      }
        if (BOTH(5)) GRID_BAR_K(5);
    }

    if (IN(6)) { FRESH_IDS;
      _Pragma("unroll") for (int rep = 0; rep < NREP(6); ++rep) {
        pg8::Gemm g{(bf16*)(ws + WS_AC), WQ, T_TOK, DM, DM / 2, nullptr, nullptr, ws, (unsigned)WS_END}; pg8::StaticOrder S; S.init(T_TOK, DM, G, bx);
        pg8::EpiRowScale E{(const float*)(ws + WS_SSP), (bf16*)(ws + WS_QP)};
        pg8::gemm_phase<pg8::EpiRowScale, pg8::StaticOrder, true, true, true>(lds, g, S, E);
        TP_STAMP(59);
        { pg8::Unit u; for (int i = 0; S.next(i, u); ++i) { peer_topk_unit(P, lds, u.pm * 256, u.pn, tid, wave, lane); peer_topk_unit(P, lds, u.pm * 256 + 128, u.pn, tid, wave, lane); } }
      }
        TP_STAMP(60); if (BOTH(6)) GRID_BAR_K(6);
    }

    int xg = bx & 7, nblk_g = (G - xg + 7) >> 3, rank_g = bx >> 3;
    if (!MK_PER_PHASE && lo == 0 && hi > 8) {
        unsigned cnt[8], sum = 0u; bool ok = my_xcc < 8u;
#pragma unroll
        for (int j = 0; j < 8; ++j) { cnt[j] = __hip_atomic_load((unsigned*)(ctl + CW_XC + 64 * j), __ATOMIC_RELAXED, __HIP_MEMORY_SCOPE_AGENT); sum += cnt[j]; ok = ok && cnt[j] > 0u; }
        if (ok && sum == (unsigned)G) { xg = (int)my_xcc; rank_g = (int)MISC[16];
            nblk_g = (int)(xg == 0 ? cnt[0] : xg == 1 ? cnt[1] : xg == 2 ? cnt[2] : xg == 3 ? cnt[3] : xg == 4 ? cnt[4] : xg == 5 ? cnt[5] : xg == 6 ? cnt[6] : cnt[7]); }
    }
    const int nslots = nblk_g * NWAVES, slot = rank_g * NWAVES + wave;
    if (IN(8)) { FRESH_IDS;
        _Pragma("unroll") for (int rep = 0; rep < NREP(8); ++rep) peer_u_phase(P, xg, slot, nslots, lane);
        TP_STAMP(61); if (BOTH(8)) GRID_BAR_K(8);
    }
#ifdef EXTRA_BARS
    for (int eb = 0; eb < EXTRA_BARS; ++eb) GRID_BAR();
#endif
    if (IN(9)) { FRESH_IDS;
        for (int t = gw; t < T_TOK; t += 2 * NGW) peer_act_tokens(P, t, t + NGW < T_TOK ? t + NGW : -1, lane);
        if (BOTH(9)) GRID_BAR_K(9);
    }
    if (IN(10)) { FRESH_IDS;
        _Pragma("unroll") for (int rep = 0; rep < NREP(10); ++rep)
        peer_v_phase(P, lds, xg, slot, nslots, wave, lane);
        TP_STAMP(62); if (BOTH(10)) GRID_BAR_K(10);
    }
    if (IN(11)) { FRESH_IDS;
        if (NREP(11) == 2) for (int t = gw; t < T_TOK; t += 2 * NGW) peer_final_tokens(P, t, t + NGW < T_TOK ? t + NGW : -1, lane, (float*)(ws + WS_MG));
        for (int t = gw; t < T_TOK; t += 2 * NGW) peer_final_tokens(P, t, t + NGW < T_TOK ? t + NGW : -1, lane, P.out);
    }
#ifdef TPROBE
    { GRID_BAR_K(11);
      gu32* tpw = (gu32*)(ws + WS_CTL) + 16384;
      if (TP_T0) { const int j = (int)__hip_atomic_load((unsigned*)tpw + 64, __ATOMIC_RELAXED, __HIP_MEMORY_SCOPE_AGENT); const unsigned val = j < 11 ? MISC[41 + j] - MISC[40 + j] : (j >= 4096 ? MISC[(j >> 6) & 63] - MISC[j & 63] : 0u);
          __hip_atomic_fetch_add((unsigned*)tpw, val, __ATOMIC_RELAXED, __HIP_MEMORY_SCOPE_AGENT); }
      GRID_BAR();
      const unsigned tot = __hip_atomic_load((unsigned*)tpw, __ATOMIC_RELAXED, __HIP_MEMORY_SCOPE_AGENT), avg = (unsigned)__builtin_amdgcn_readfirstlane((int)(tot >> 8));
      const unsigned ts = (unsigned)__builtin_amdgcn_s_memrealtime();
      while ((unsigned)__builtin_amdgcn_s_memrealtime() - ts < avg) __builtin_amdgcn_s_sleep(1); }
#endif
#undef IN
#undef BOTH
#undef GRID_BAR
}

extern "C" void kernel_launch(void* const* d_in, const int* in_sizes, int n_in, void* d_out, int out_size, void* d_ws, size_t ws_size, hipStream_t stream) {
    static int grid = 0;
    if (grid == 0) {
        if (n_in != 19 || out_size != T_TOK * DM || ws_size < WS_END) { fprintf(stderr, "kernel_launch: unexpected problem (n_in %d, out %d, ws %zu); nothing launched\n", n_in, out_size, ws_size); grid = -1; return; }
        int dev = 0, cus = 0, per_cu = 0;
        if (hipGetDevice(&dev) != hipSuccess || hipDeviceGetAttribute(&cus, hipDeviceAttributeMultiprocessorCount, dev) != hipSuccess) { grid = -1; return; }
        if (hipFuncSetAttribute((const void*)fwd_kernel, hipFuncAttributeMaxDynamicSharedMemorySize, LDS_BYTES) != hipSuccess) { fprintf(stderr, "kernel_launch: hipFuncSetAttribute failed\n"); grid = -1; return; }
        if (hipOccupancyMaxActiveBlocksPerMultiprocessor(&per_cu, (const void*)fwd_kernel, NWAVES * 64, LDS_BYTES) != hipSuccess || per_cu < 1) { fprintf(stderr, "kernel_launch: occupancy query says %d blocks per CU\n", per_cu); }
        (void)hipGetLastError();
        grid = cus;
    }
    if (grid < 0) return;
    if (hipMemsetAsync((char*)d_ws + WS_CTL, 0, CTL_ZERO_BYTES, stream) != hipSuccess) return;
#ifdef TPROBE
    if (hipMemsetD32Async((hipDeviceptr_t)((char*)d_ws + WS_CTL + 4 * (16384 + 64)), TPROBE, 1, stream) != hipSuccess) return;
#endif
    Params p{};
    const float** pp = (const float**)&p;
    for (int i = 0; i < 19; ++i) pp[i] = (const float*)d_in[i];
    p.out = (float*)d_out; p.ws = (unsigned char*)d_ws;
#if MK_PER_PHASE
    for (int ph = 0; ph < N_PHASES; ++ph) { p.ph_lo = ph; p.ph_hi = ph + 1; hipLaunchKernelGGL(fwd_kernel, dim3(grid), dim3(NWAVES * 64), LDS_BYTES, stream, p); }
#else
    p.ph_lo = 0; p.ph_hi = N_PHASES;
    hipLaunchKernelGGL(fwd_kernel, dim3(grid), dim3(NWAVES * 64), LDS_BYTES, stream, p);
#endif
}
```
